# Optimizing an MI355X kernel written in HIP

```python
import functools
import math
import jax
import jax.numpy as jnp
from jax import lax
import numpy as np

D_MODEL = 1024
BATCH = 4
SEQ = 4096
DEPTH = 4

GRID_W = 64
CTX_LEN = 256
CHUNK = 64
CONV_K = 3
HEAD_DIM = D_MODEL // 8
GDN_HEADS = 4
RET_HEADS = 4
MLSTM_HEADS = 4
GDN_W = GDN_HEADS * HEAD_DIM
RET_W = RET_HEADS * HEAD_DIM
MLSTM_W = MLSTM_HEADS * HEAD_DIM
S5_CH = D_MODEL // 2
S5_GROUP = 16
S5_GROUPS = S5_CH // S5_GROUP
S5_STATE = 64
N_EXPERTS = 16
EXPERT_FF = 2 * D_MODEL
CAPACITY_FACTOR = 2
ALPHA = (2 * DEPTH) ** 0.25
BETA = (8 * DEPTH) ** -0.25
N_EVEN = (DEPTH + 1) // 2
N_ODD = DEPTH // 2
EPS = 1e-5
EVEN_COLS = (GDN_W, GDN_W, GDN_W, GDN_W, GDN_HEADS, GDN_HEADS, GDN_HEADS, GDN_HEADS,
             RET_W, RET_W, RET_W, RET_W)
ODD_COLS = (MLSTM_W, MLSTM_W, MLSTM_W, MLSTM_W, MLSTM_HEADS, MLSTM_HEADS, MLSTM_HEADS, MLSTM_HEADS, S5_CH)
EVEN_IN = sum(EVEN_COLS)
ODD_IN = sum(ODD_COLS)
EVEN_MIX = GDN_W + RET_W
ODD_MIX = MLSTM_W + S5_CH
F32 = jnp.float32

kernel_name = 'hybrid_gdn_retention_mlstm_s5_ecmoe_dit'


def split_cols(t, sizes):
    return jnp.split(t, np.cumsum(sizes)[:-1].tolist(), axis=-1)


def heads(t, n):
    return t.reshape(t.shape[:-1] + (n, t.shape[-1] // n))


def flip_t(t):
    return None if t is None else jnp.flip(t, axis=1)


def l2norm(t):
    return t * lax.rsqrt(jnp.sum(t * t, axis=-1, keepdims=True) + 1e-6)


def layer_norm(t, g, b):
    tf = t.astype(F32)
    mu = tf.mean(-1, keepdims=True)
    var = jnp.square(tf - mu).mean(-1, keepdims=True)
    return ((tf - mu) * lax.rsqrt(var + EPS)).astype(t.dtype) * g + b


def rms_norm_heads(o, g):
    y = o * lax.rsqrt(jnp.mean(o * o, axis=-1, keepdims=True) + EPS) * g
    return y.reshape(o.shape[:2] + (-1,))


def group_norm_heads(o, g):
    mu = o.mean(-1, keepdims=True)
    var = jnp.square(o - mu).mean(-1, keepdims=True)
    return ((o - mu) * lax.rsqrt(var + EPS)).reshape(o.shape[:2] + (-1,)) * g


def short_conv(t, w, on_grid):
    ch = t.shape[-1]
    w = w.astype(t.dtype)
    if on_grid:
        b, n = t.shape[:2]
        rows = n // GRID_W
        tg = t.reshape(b, rows, GRID_W, ch)
        y = lax.conv_general_dilated(tg, w[:, :, None, :], (1, 1), 'SAME',
                                     dimension_numbers=('NHWC', 'HWIO', 'NHWC'), feature_group_count=ch)
        return y.reshape(b, n, ch)
    return lax.conv_general_dilated(t, w[CONV_K // 2][:, None, :], (1,), 'SAME',
                                    dimension_numbers=('NWC', 'WIO', 'NWC'), feature_group_count=ch)


def to_chunks(t):
    b, n, h = t.shape[:3]
    t = t.reshape((b, n // CHUNK, CHUNK, h) + t.shape[3:])
    return jnp.moveaxis(jnp.moveaxis(t, 3, 1), 2, 0)


def from_chunks(t):
    t = jnp.moveaxis(jnp.moveaxis(t, 0, 2), 1, 3)
    return t.reshape((t.shape[0], -1) + t.shape[3:])


def linear_scan(q, k, v, g, beta, s0, want_out):
    b, _, h, dk = k.shape
    dv = v.shape[-1]
    kc, vc = to_chunks(k), to_chunks(v)
    gcum = jnp.cumsum(to_chunks(g), axis=-1)
    diff = gcum[..., :, None] - gcum[..., None, :]
    incl = jnp.tril(jnp.ones((CHUNK, CHUNK), bool))
    if beta is None:
        u, w = vc, None
    else:
        bc = to_chunks(beta)[..., None]
        kb = kc * bc
        strict = jnp.tril(jnp.ones((CHUNK, CHUNK), bool), -1)
        a = jnp.where(strict, jnp.einsum('...ik,...jk->...ij', kb, kc) * jnp.exp(jnp.where(strict, diff, 0.0)), 0.0)
        rhs = jnp.concatenate([vc * bc, kb * jnp.exp(gcum)[..., None]], axis=-1)
        sol = lax.linalg.triangular_solve(a + jnp.eye(CHUNK, dtype=a.dtype), rhs, left_side=True,
                                          lower=True, unit_diagonal=True)
        u, w = sol[..., :dv], sol[..., dv:]
    k_end = kc * jnp.exp(gcum[..., -1:] - gcum)[..., None]
    g_end = jnp.exp(gcum[..., -1])[..., None, None]
    if want_out:
        qc = to_chunks(q)
        q_dec = qc * jnp.exp(gcum)[..., None]
        a_qk = jnp.where(incl, jnp.einsum('...ik,...jk->...ij', qc, kc) * jnp.exp(jnp.where(incl, diff, 0.0)), 0.0)
    else:
        q_dec, a_qk = None, None
    if s0 is None:
        s0 = jnp.zeros((b, h, dk, dv), F32)

    def step(s, inp):
        qd, ke, uc, wc, aqk, ge = inp
        vn = uc if wc is None else uc - jnp.einsum('bhck,bhkv->bhcv', wc, s)
        s_new = ge * s + jnp.einsum('bhck,bhcv->bhkv', ke, vn)
        if qd is None:
            return s_new, None
        return s_new, jnp.einsum('bhck,bhkv->bhcv', qd, s) + jnp.einsum('bhij,bhjv->bhiv', aqk, vn)

    s_fin, o = lax.scan(step, s0, (q_dec, k_end, u, w, a_qk, g_end))
    return (from_chunks(o) if want_out else None), s_fin


def mlstm_scan(q, k, v, log_i, log_f, s0, want_out):
    b, _, h, dk = k.shape
    dv = v.shape[-1]
    if s0 is None:
        s0 = (jnp.zeros((b, h, dk, dv), F32), jnp.zeros((b, h, dk), F32), jnp.zeros((b, h), F32))
    incl = jnp.tril(jnp.ones((CHUNK, CHUNK), bool))

    def step(carry, inp):
        c_prev, n_prev, m_prev = carry
        qc, kc, vc, ic, fc = inp
        bcum = jnp.cumsum(fc, axis=-1)
        b_end = bcum[..., -1]
        a = b_end[..., None] - bcum + ic
        m_new = jnp.maximum(b_end + m_prev, a.max(-1))
        w_state = jnp.exp(a - m_new[..., None])
        decay = jnp.exp(b_end + m_prev - m_new)
        c_new = decay[..., None, None] * c_prev + jnp.einsum('bhck,bhcv->bhkv', kc * w_state[..., None], vc)
        n_new = decay[..., None] * n_prev + jnp.einsum('bhck,bhc->bhk', kc, w_state)
        carry_new = (c_new, n_new, m_new)
        if qc is None:
            return carry_new, None
        dlog = jnp.where(incl, bcum[..., :, None] - bcum[..., None, :] + ic[..., None, :], -jnp.inf)
        inter = bcum + m_prev[..., None]
        m_t = jnp.maximum(inter, dlog.max(-1))
        s = jnp.einsum('bhik,bhjk->bhij', qc, kc) * jnp.exp(dlog - m_t[..., None])
        w_inter = jnp.exp(inter - m_t)[..., None]
        num = jnp.einsum('bhij,bhjv->bhiv', s, vc) + w_inter * jnp.einsum('bhik,bhkv->bhiv', qc, c_prev)
        den = s.sum(-1, keepdims=True) + w_inter * jnp.einsum('bhik,bhk->bhi', qc, n_prev)[..., None]
        return carry_new, num / jnp.maximum(jnp.abs(den), jnp.exp(-m_t)[..., None])

    xs = (to_chunks(q) if want_out else None, to_chunks(k), to_chunks(v), to_chunks(log_i), to_chunks(log_f))
    s_fin, hs = lax.scan(step, s0, xs)
    return (from_chunks(hs) if want_out else None), s_fin


def s5_discretize(lam_re, lam_im, log_dt, b_re, b_im):
    lr = jnp.minimum(lam_re.astype(F32), -1e-4)
    li = lam_im.astype(F32)
    dt = jnp.exp(log_dt.astype(F32))[:, None]
    mag = jnp.exp(lr * dt)
    ab_re, ab_im = mag * jnp.cos(li * dt), mag * jnp.sin(li * dt)
    xr, xi, den = ab_re - 1.0, ab_im, lr * lr + li * li
    f_re = (xr * lr + xi * li) / den
    f_im = (xi * lr - xr * li) / den
    br, bi = b_re.astype(F32), b_im.astype(F32)
    bb_re = f_re[..., None] * br - f_im[..., None] * bi
    bb_im = f_re[..., None] * bi + f_im[..., None] * br
    return ab_re, ab_im, bb_re, bb_im


def complex_affine_combine(e1, e2):
    a1r, a1i, b1r, b1i = e1
    a2r, a2i, b2r, b2i = e2
    return (a1r * a2r - a1i * a2i, a1r * a2i + a1i * a2r,
            a2r * b1r - a2i * b1i + b2r, a2r * b1i + a2i * b1r + b2i)


def s5_scan(ab_re, ab_im, bb_re, bb_im, c_re, c_im, u, s0, want_out):
    bu_re = jnp.einsum('btgh,gph->btgp', u, bb_re)
    bu_im = jnp.einsum('btgh,gph->btgp', u, bb_im)
    if s0 is not None:
        h0r, h0i = s0
        bu_re = bu_re.at[:, 0].add(ab_re * h0r - ab_im * h0i)
        bu_im = bu_im.at[:, 0].add(ab_re * h0i + ab_im * h0r)
    n = u.shape[1]
    a_re = jnp.broadcast_to(ab_re, (1, n) + ab_re.shape)
    a_im = jnp.broadcast_to(ab_im, (1, n) + ab_im.shape)
    _, _, hr, hi = lax.associative_scan(complex_affine_combine, (a_re, a_im, bu_re, bu_im), axis=1)
    s_fin = (hr[:, -1], hi[:, -1])
    if not want_out:
        return None, s_fin
    y = jnp.einsum('btgp,ghp->btgh', hr, c_re) - jnp.einsum('btgp,ghp->btgh', hi, c_im)
    return y, s_fin


def two_pass(scan_fn, ctx_args, lat_args, ctx_out, reverse):
    if reverse:
        ctx_args = [flip_t(t) for t in ctx_args]
        lat_args = [flip_t(t) for t in lat_args]
    o_ctx, s_ctx = scan_fn(*ctx_args, None, ctx_out)
    o_lat, _ = scan_fn(*lat_args, s_ctx, True)
    if reverse:
        o_ctx, o_lat = flip_t(o_ctx), flip_t(o_lat)
    return o_ctx, o_lat


def retention_log_decay(direction):
    expo = 5.0 + 2.0 * jnp.arange(RET_HEADS, dtype=F32) + direction
    return jnp.log1p(-jnp.exp2(-expo))


def gdn_retention_mixer(h_ctx, h_lat, w_in, w_out, conv_w, a_log, dt_bias, gdn_gain, ret_gain, ctx_out):
    def prep(h, on_grid):
        qa, ka, va, za, af, ab, bf, bb, qr, kr, vr, zr = split_cols(h @ w_in, EVEN_COLS)
        qkv = jax.nn.silu(short_conv(jnp.concatenate([qa, ka, va], -1), conv_w, on_grid)).astype(F32)
        qa, ka, va = split_cols(qkv, EVEN_COLS[:3])
        q_g = l2norm(heads(qa, GDN_HEADS)) * HEAD_DIM ** -0.5
        k_g = l2norm(heads(ka, GDN_HEADS))
        v_g = heads(va, GDN_HEADS)
        gdn_dirs = []
        for d, (a_pre, b_pre) in enumerate(((af, bf), (ab, bb))):
            g = -jnp.exp(a_log[d].astype(F32)) * jax.nn.softplus(a_pre.astype(F32) + dt_bias[d].astype(F32))
            gdn_dirs.append((q_g, k_g, v_g, g, jax.nn.sigmoid(b_pre.astype(F32))))
        q_r = heads(qr, RET_HEADS).astype(F32)
        k_r = heads(kr, RET_HEADS).astype(F32) * HEAD_DIM ** -0.5
        v_r = heads(vr, RET_HEADS).astype(F32)
        ret_dirs = [(q_r, k_r, v_r, jnp.broadcast_to(retention_log_decay(d), v_r.shape[:3]), None) for d in range(2)]
        return gdn_dirs, ret_dirs, za, zr

    gc, rc, za_c, zr_c = prep(h_ctx, False)
    gl, rl, za_l, zr_l = prep(h_lat, True)
    gdn = [two_pass(linear_scan, gc[d], gl[d], ctx_out, d == 1) for d in range(2)]
    ret = [two_pass(linear_scan, rc[d], rl[d], ctx_out, d == 1) for d in range(2)]

    def merge(o_g, o_r, za, zr, dtype):
        y_g = rms_norm_heads(o_g, gdn_gain) * jax.nn.silu(za.astype(F32))
        y_r = group_norm_heads(o_r, ret_gain) * jax.nn.silu(zr.astype(F32))
        return jnp.concatenate([y_g, y_r], -1).astype(dtype) @ w_out

    y_lat = merge(gdn[0][1] + gdn[1][1], ret[0][1] + ret[1][1], za_l, zr_l, h_lat.dtype)
    y_ctx = merge(gdn[0][0] + gdn[1][0], ret[0][0] + ret[1][0], za_c, zr_c, h_ctx.dtype) if ctx_out else None
    return y_ctx, y_lat


def mlstm_s5_mixer(h_ctx, h_lat, w_in, w_out, conv_w, gate_bias, mlstm_gain, lam_re, lam_im, log_dt,
                   b_re, b_im, c_re, c_im, d_skip, w_glu, b_glu, ctx_out):
    gb = gate_bias.astype(F32)

    def prep(h, on_grid):
        qm, km, vm, om, i_f, i_b, f_f, f_b, u = split_cols(h @ w_in, ODD_COLS)
        qk = jax.nn.silu(short_conv(jnp.concatenate([qm, km], -1), conv_w, on_grid)).astype(F32)
        qm, km = split_cols(qk, ODD_COLS[:2])
        q = heads(qm, MLSTM_HEADS)
        k = heads(km, MLSTM_HEADS) * HEAD_DIM ** -0.5
        v = heads(vm, MLSTM_HEADS).astype(F32)
        dirs = [(q, k, v, i_pre.astype(F32) + gb[d, 0], jax.nn.log_sigmoid(f_pre.astype(F32) + gb[d, 1]))
                for d, (i_pre, f_pre) in enumerate(((i_f, f_f), (i_b, f_b)))]
        u = u.astype(F32)
        return dirs, u, om

    mc, u_c, o_c = prep(h_ctx, False)
    ml, u_l, o_l = prep(h_lat, True)
    grp = lambda t: t.reshape(t.shape[:2] + (S5_GROUPS, S5_GROUP))
    cr, ci = c_re.astype(F32), c_im.astype(F32)
    mls = [two_pass(mlstm_scan, mc[d], ml[d], ctx_out, d == 1) for d in range(2)]
    ssm = [two_pass(functools.partial(s5_scan, *s5_discretize(lam_re[d], lam_im[d], log_dt[d], b_re, b_im), cr, ci),
                    [grp(u_c)], [grp(u_l)], ctx_out, d == 1) for d in range(2)]

    def merge(h_m, y_s, u, og, dtype):
        y_m = group_norm_heads(h_m, mlstm_gain) * jax.nn.sigmoid(og.astype(F32))
        y = jax.nn.gelu(y_s.reshape(u.shape) + d_skip * u)
        y = y * jax.nn.sigmoid(y @ w_glu + b_glu)
        return jnp.concatenate([y_m, y], -1).astype(dtype) @ w_out

    y_lat = merge(mls[0][1] + mls[1][1], ssm[0][1] + ssm[1][1], u_l, o_l, h_lat.dtype)
    y_ctx = merge(mls[0][0] + mls[1][0], ssm[0][0] + ssm[1][0], u_c, o_c, h_ctx.dtype) if ctx_out else None
    return y_ctx, y_lat


def expert_choice_ffn(h, w_router, w_gate, w_up, w_down):
    n, dm = h.shape[1], h.shape[2]
    cap = CAPACITY_FACTOR * n // N_EXPERTS
    aff = jax.nn.softmax((h @ w_router).astype(F32), axis=-1)
    gate, idx = lax.top_k(jnp.swapaxes(aff, 1, 2), cap)
    xs = jax.vmap(lambda hb, ib: hb[ib])(h, idx)
    hid = jax.nn.silu(jnp.einsum('becd,edf->becf', xs, w_gate)) * jnp.einsum('becd,edf->becf', xs, w_up)
    ys = jnp.einsum('becf,efd->becd', hid, w_down) * gate[..., None].astype(h.dtype)
    return jax.vmap(lambda ib, yb: jnp.zeros((n, dm), yb.dtype).at[ib.reshape(-1)].add(yb.reshape(-1, dm)))(idx, ys)


def setup_inputs(seed: int = 0) -> dict:
    key = jax.random.key(seed)
    ks = iter(jax.random.split(key, 48))

    def nrm(shape, scale):
        return jax.random.normal(next(ks), shape, jnp.float32) * scale

    def unif(shape, lo, hi):
        return jax.random.uniform(next(ks), shape, jnp.float32, lo, hi)

    D = D_MODEL
    L = DEPTH
    dt_gdn = jnp.exp(unif((N_EVEN, 2, GDN_HEADS), math.log(1e-3), math.log(1e-1)))
    gate_bias = jnp.stack([nrm((N_ODD, 2, MLSTM_HEADS), 0.1),
                           jnp.linspace(3.0, 6.0, MLSTM_HEADS) + nrm((N_ODD, 2, MLSTM_HEADS), 0.1)], axis=2)
    lam_im = jnp.pi * jnp.arange(S5_STATE, dtype=jnp.float32) + nrm((N_ODD, 2, S5_GROUPS, S5_STATE), 0.01)
    return {
        'x': nrm((BATCH, SEQ, D), 1.0),
        'c': nrm((BATCH, D), 1.0),
        'ctx': nrm((BATCH, CTX_LEN, D), 1.0),
        'c_ctx': nrm((D,), 1.0),
        'w_mod': nrm((L, D, 6 * D), 0.5 * D ** -0.5),
        'b_mod': nrm((L, 6 * D), 0.02),
        'ln1_g': 1.0 + nrm((L, D), 0.02),
        'ln1_b': nrm((L, D), 0.02),
        'ln2_g': 1.0 + nrm((L, D), 0.02),
        'ln2_b': nrm((L, D), 0.02),
        'w_router': nrm((L, D, N_EXPERTS), D ** -0.5),
        'w_gate': nrm((L, N_EXPERTS, D, EXPERT_FF), D ** -0.5),
        'w_up': nrm((L, N_EXPERTS, D, EXPERT_FF), D ** -0.5),
        'w_down': nrm((L, N_EXPERTS, EXPERT_FF, D), BETA * EXPERT_FF ** -0.5),
        'ev_w_in': nrm((N_EVEN, D, EVEN_IN), D ** -0.5),
        'ev_w_out': nrm((N_EVEN, EVEN_MIX, D), BETA * EVEN_MIX ** -0.5),
        'ev_conv': nrm((N_EVEN, CONV_K, CONV_K, 3 * GDN_W), 1.0 / CONV_K),
        'ev_a_log': jnp.log(unif((N_EVEN, 2, GDN_HEADS), 1.0, 16.0)),
        'ev_dt_bias': dt_gdn + jnp.log(-jnp.expm1(-dt_gdn)),
        'ev_gdn_norm': 1.0 + nrm((N_EVEN, HEAD_DIM), 0.02),
        'ev_ret_norm': 1.0 + nrm((N_EVEN, RET_W), 0.02),
        'od_w_in': nrm((N_ODD, D, ODD_IN), D ** -0.5),
        'od_w_out': nrm((N_ODD, ODD_MIX, D), BETA * ODD_MIX ** -0.5),
        'od_conv': nrm((N_ODD, CONV_K, CONV_K, 2 * MLSTM_W), 1.0 / CONV_K),
        'od_gate_bias': gate_bias,
        'od_mlstm_norm': 1.0 + nrm((N_ODD, MLSTM_W), 0.02),
        'od_lam_re': -0.5 + nrm((N_ODD, 2, S5_GROUPS, S5_STATE), 0.01),
        'od_lam_im': lam_im,
        'od_log_dt': unif((N_ODD, 2, S5_GROUPS), math.log(1e-3), math.log(1e-1)),
        'od_b_re': nrm((N_ODD, S5_GROUPS, S5_STATE, S5_GROUP), (2 * S5_GROUP) ** -0.5),
        'od_b_im': nrm((N_ODD, S5_GROUPS, S5_STATE, S5_GROUP), (2 * S5_GROUP) ** -0.5),
        'od_c_re': nrm((N_ODD, S5_GROUPS, S5_GROUP, S5_STATE), S5_STATE ** -0.5),
        'od_c_im': nrm((N_ODD, S5_GROUPS, S5_GROUP, S5_STATE), S5_STATE ** -0.5),
        'od_d_skip': nrm((N_ODD, S5_CH), 1.0),
        'od_w_glu': nrm((N_ODD, S5_CH, S5_CH), S5_CH ** -0.5),
        'od_b_glu': nrm((N_ODD, S5_CH), 0.02),
    }


def reference(x, c, ctx, c_ctx, w_mod, b_mod, ln1_g, ln1_b, ln2_g, ln2_b, w_router, w_gate, w_up, w_down,
              ev_w_in, ev_w_out, ev_conv, ev_a_log, ev_dt_bias, ev_gdn_norm, ev_ret_norm,
              od_w_in, od_w_out, od_conv, od_gate_bias, od_mlstm_norm, od_lam_re, od_lam_im, od_log_dt,
              od_b_re, od_b_im, od_c_re, od_c_im, od_d_skip, od_w_glu, od_b_glu):
    h_lat, h_ctx = x, ctx
    s_lat = jax.nn.silu(c)
    s_ctx = jax.nn.silu(c_ctx)
    for l in range(DEPTH):
        last = l == DEPTH - 1
        sh1, sc1, g1, sh2, sc2, g2 = jnp.split((s_lat @ w_mod[l] + b_mod[l])[:, None, :], 6, axis=-1)
        csh1, csc1, cg1, csh2, csc2, cg2 = jnp.split(s_ctx @ w_mod[l] + b_mod[l], 6, axis=-1)
        in_lat = h_lat * (1.0 + sc1) + sh1
        in_ctx = h_ctx * (1.0 + csc1) + csh1
        if l % 2 == 0:
            e = l // 2
            y_ctx, y_lat = gdn_retention_mixer(in_ctx, in_lat, ev_w_in[e], ev_w_out[e], ev_conv[e], ev_a_log[e],
                                               ev_dt_bias[e], ev_gdn_norm[e], ev_ret_norm[e], not last)
        else:
            o = l // 2
            y_ctx, y_lat = mlstm_s5_mixer(in_ctx, in_lat, od_w_in[o], od_w_out[o], od_conv[o], od_gate_bias[o],
                                          od_mlstm_norm[o], od_lam_re[o], od_lam_im[o], od_log_dt[o],
                                          od_b_re[o], od_b_im[o], od_c_re[o], od_c_im[o], od_d_skip[o],
                                          od_w_glu[o], od_b_glu[o], not last)
        h_lat = layer_norm(ALPHA * h_lat + g1 * y_lat, ln1_g[l], ln1_b[l])
        f_lat = expert_choice_ffn(h_lat * (1.0 + sc2) + sh2, w_router[l], w_gate[l], w_up[l], w_down[l])
        h_lat = layer_norm(ALPHA * h_lat + g2 * f_lat, ln2_g[l], ln2_b[l])
        if not last:
            h_ctx = layer_norm(ALPHA * h_ctx + cg1 * y_ctx, ln1_g[l], ln1_b[l])
            f_ctx = expert_choice_ffn(h_ctx * (1.0 + csc2) + csh2, w_router[l], w_gate[l], w_up[l], w_down[l])
            h_ctx = layer_norm(ALPHA * h_ctx + cg2 * f_ctx, ln2_g[l], ln2_b[l])
    return h_lat
```

```cpp
#ifdef EMU
#include "emu.h"
#else
#include <hip/hip_runtime.h>
#endif
#include <cstdio>
#include <cstdint>
#include <cstddef>

#ifndef CFG_BATCH
#define CFG_BATCH 4
#define CFG_SEQ 4096
#define CFG_CTX 256
#define CFG_DEPTH 4
#define CFG_NEXP 16
#define CFG_FF 2048
#endif
constexpr int B_ = CFG_BATCH, SEQ = CFG_SEQ, CTX = CFG_CTX, DEPTH = CFG_DEPTH, NE = CFG_NEXP, FF = CFG_FF;
constexpr int D = 1024, TOK = CTX + SEQ, MROWS = B_ * TOK, MPAD = (MROWS + 255) / 256 * 256;
constexpr int NCH = TOK / 64;
constexpr int CAPL = 2 * SEQ / NE, CAPC = 2 * CTX / NE, EROWS = B_ * (CAPL + CAPC), EPAD = (EROWS + 255) / 256 * 256;
constexpr int NIN_E = 4096, NIN_O = 2560, NINMAX = 4096;
constexpr int N_EVEN = (DEPTH + 1) / 2, N_ODD = DEPTH / 2, N_ODDA = N_ODD > 0 ? N_ODD : 1;
constexpr int NR = B_ + 1;
constexpr float ALPHA = 1.681792830507429f;
constexpr float LN_EPS = 1e-5f;
constexpr float HD_SCALE = 0.08838834764831845f;
constexpr int NWAVES = 8, NTHREADS = 512;

enum { I_X = 0, I_C, I_CTX, I_CCTX, I_WMOD, I_BMOD, I_LN1G, I_LN1B, I_LN2G, I_LN2B, I_WROUTER, I_WGATE, I_WUP, I_WDOWN,
       I_EVWIN, I_EVWOUT, I_EVCONV, I_EVALOG, I_EVDTB, I_EVGDNN, I_EVRETN,
       I_ODWIN, I_ODWOUT, I_ODCONV, I_ODGB, I_ODMN, I_ODLRE, I_ODLIM, I_ODLDT, I_ODBRE, I_ODBIM, I_ODCRE, I_ODCIM, I_ODDSKIP, I_ODWGLU, I_ODBGLU, N_IN };

constexpr size_t al256(size_t x) { return (x + 255) & ~(size_t)255; }
constexpr size_t WS_CTL = 0, CTL_BYTES = 65536;
constexpr size_t WS_MOD = WS_CTL + CTL_BYTES;
constexpr size_t WS_WG = al256(WS_MOD + (size_t)DEPTH * NR * 6144 * 4);
constexpr size_t WS_WIN = al256(WS_WG + (size_t)DEPTH * 16 * 1024 * 4);
constexpr size_t WS_WOUT = al256(WS_WIN + (size_t)DEPTH * NINMAX * 1024 * 2);
constexpr size_t WS_WGLU = al256(WS_WOUT + (size_t)DEPTH * 1024 * 1024 * 2);
constexpr size_t WS_WGU = al256(WS_WGLU + (size_t)N_ODDA * 512 * 512 * 2);
constexpr size_t WS_WD = al256(WS_WGU + (size_t)DEPTH * NE * 2 * FF * 1024 * 2);
constexpr size_t WS_S5A = al256(WS_WD + (size_t)DEPTH * NE * 1024 * FF * 2);
constexpr size_t WS_S5B = al256(WS_S5A + (size_t)N_ODDA * 2 * 32 * 128 * 4);
constexpr size_t WS_S5C = al256(WS_S5B + (size_t)N_ODDA * 2 * 32 * 128 * 16 * 2);
constexpr size_t WS_H = al256(WS_S5C + (size_t)N_ODDA * 32 * 16 * 128 * 2);
constexpr size_t WS_XIN = al256(WS_H + (size_t)MPAD * 1024 * 4);
constexpr size_t WS_GATES = al256(WS_XIN + (size_t)MPAD * 1024 * 2);
constexpr size_t WS_MERGED = al256(WS_GATES + (size_t)MROWS * 16 * 4);
constexpr size_t WS_YS = al256(WS_MERGED + (size_t)MPAD * 1024 * 2);
constexpr size_t WS_Y = al256(WS_YS + (size_t)MPAD * 512 * 2);
constexpr size_t WS_AFF = al256(WS_Y + (size_t)MPAD * 1024 * 4);
constexpr size_t WS_SLOT = al256(WS_AFF + (size_t)MROWS * 16 * 4);
constexpr size_t WS_EGATE = al256(WS_SLOT + (size_t)MROWS * 16 * 4);
constexpr size_t WS_MCH = al256(WS_EGATE + (size_t)NE * EPAD * 4);
constexpr size_t WS_R = al256(WS_MCH + (size_t)B_ * 4 * 2 * NCH * 4);
constexpr int NCP = B_ * 8 * 2 * NCH, NCPG = B_ * 4 * 2 * NCH;
constexpr size_t WS_P = WS_R;
constexpr size_t WS_QKV = al256(WS_P + (size_t)MPAD * NINMAX * 2);
constexpr size_t WS_CLW = al256(WS_QKV + (size_t)MROWS * 1536 * 2);
constexpr size_t WS_CLQ = al256(WS_CLW + (size_t)NCP * 64 * 128 * 2);
constexpr size_t WS_CLK = al256(WS_CLQ + (size_t)NCP * 64 * 128 * 2);
constexpr size_t WS_CLA = al256(WS_CLK + (size_t)NCP * 64 * 128 * 2);
constexpr size_t WS_CLU = al256(WS_CLA + (size_t)NCP * 64 * 64 * 2);
constexpr size_t WS_CLS = al256(WS_CLU + (size_t)NCPG * 64 * 128 * 4);
constexpr size_t WS_O = al256(WS_CLS + (size_t)NCP * 256 * 4);
constexpr size_t WS_R_END1 = al256(WS_O + (size_t)2 * MROWS * 1024 * 4);
constexpr size_t WS_XS = WS_R;
constexpr size_t WS_HID = al256(WS_XS + (size_t)NE * EPAD * 1024 * 2);
constexpr size_t WS_YSE = al256(WS_HID + (size_t)NE * EPAD * FF * 2);
constexpr size_t WS_R_END2 = al256(WS_YSE + (size_t)NE * EPAD * 1024 * 4);
constexpr size_t WS_END = WS_R_END1 > WS_R_END2 ? WS_R_END1 : WS_R_END2;

constexpr int LDS_BYTES = 147456;
constexpr int LDS_MISC = 143360;

typedef unsigned short bf16_t;
typedef short bf16x8 __attribute__((ext_vector_type(8)));
typedef float f32x2 __attribute__((ext_vector_type(2)));
typedef float f32x4 __attribute__((ext_vector_type(4)));
typedef float f32x16 __attribute__((ext_vector_type(16)));
typedef unsigned u32x2 __attribute__((ext_vector_type(2)));
typedef unsigned u32x4 __attribute__((ext_vector_type(4)));
#define DEV __device__ __forceinline__

#ifdef EMU
#define LAS
static inline float bf2f_h(bf16_t b) { unsigned u = (unsigned)b << 16; float f; memcpy(&f, &u, 4); return f; }
static inline f32x4 mfma16(bf16x8 a, bf16x8 b, f32x4 c) {
    struct In { bf16x8 a, b; } in{a, b};
    auto s = emu::wave_xchg(&in, sizeof(in)); const int l = emu::cur->lane, col = l & 15, rg = l >> 4;
    for (int r = 0; r < 4; ++r) { const int row = 4 * rg + r; double acc = c[r];
        for (int kg = 0; kg < 4; ++kg) { const In* pa = (const In*)s[row + 16 * kg]; const In* pb = (const In*)s[col + 16 * kg];
            for (int j = 0; j < 8; ++j) acc += (double)bf2f_h((bf16_t)pa->a[j]) * (double)bf2f_h((bf16_t)pb->b[j]); }
        c[r] = (float)acc; }
    return c;
}
static inline f32x16 mfma32(bf16x8 a, bf16x8 b, f32x16 c) {
    struct In { bf16x8 a, b; } in{a, b};
    auto s = emu::wave_xchg(&in, sizeof(in)); const int l = emu::cur->lane, col = l & 31, h = l >> 5;
    for (int r = 0; r < 16; ++r) { const int row = (r & 3) + 8 * (r >> 2) + 4 * h; double acc = c[r];
        for (int kh = 0; kh < 2; ++kh) { const In* pa = (const In*)s[row + 32 * kh]; const In* pb = (const In*)s[col + 32 * kh];
            for (int j = 0; j < 8; ++j) acc += (double)bf2f_h((bf16_t)pa->a[j]) * (double)bf2f_h((bf16_t)pb->b[j]); }
        c[r] = (float)acc; }
    return c;
}
static inline void glds16(const void* g, void* l) { memcpy((char*)l + 16 * emu::cur->lane, g, 16); }
#define S_BARRIER() emu::block_barrier()
#define WAIT_VM(n) do {} while (0)
#define WAIT_LGKM(n) do {} while (0)
#define WAIT_ALL() do {} while (0)
#define SETPRIO(n) do {} while (0)
#define SCHED_BARRIER() do {} while (0)
#define COMPILER_FENCE() do {} while (0)
#define WAVE_LDS_SYNC() do { int _z = 0; (void)emu::wave_xchg(&_z, 4); } while (0)
#define LAUNDER(x) do {} while (0)
template <class T> static inline T shfl_xor_t(T v, int m) { auto s = emu::wave_xchg(&v, sizeof(T)); T r; memcpy(&r, s[emu::cur->lane ^ m], sizeof(T)); return r; }
template <class T> static inline T shfl_t(T v, int src) { auto s = emu::wave_xchg(&v, sizeof(T)); T r; memcpy(&r, s[src & 63], sizeof(T)); return r; }
static inline int readfirstlane_i(int v) { return v; }
static inline unsigned xb_ld(unsigned* p) { return *(volatile unsigned*)p; }
static inline unsigned xb_add(unsigned* p, unsigned v) { unsigned o = *p; *p = o + v; return o; }
static inline unsigned xb_xcc_id() { return (unsigned)emu::cur->bid & 7u; }
static inline void s_sleep1() { emu::yield(); }
static inline void fence_acquire() {}
static inline void fence_release() {}
static inline unsigned lds_atomic_add(unsigned* p, unsigned v) { unsigned o = *p; *p = o + v; return o; }
static inline float fast_exp2(float x) { return exp2f(x); }
static inline float fast_rcp(float x) { return 1.0f / x; }
#else
#define LAS __attribute__((address_space(3)))
DEV f32x4 mfma16(bf16x8 a, bf16x8 b, f32x4 c) { return __builtin_amdgcn_mfma_f32_16x16x32_bf16(a, b, c, 0, 0, 0); }
DEV f32x16 mfma32(bf16x8 a, bf16x8 b, f32x16 c) { return __builtin_amdgcn_mfma_f32_32x32x16_bf16(a, b, c, 0, 0, 0); }
#define glds16(g, l) __builtin_amdgcn_global_load_lds((const unsigned*)(g), (LAS unsigned*)(l), 16, 0, 0)
#define S_BARRIER() __builtin_amdgcn_s_barrier()
#define WAIT_VM(n) asm volatile("s_waitcnt vmcnt(" #n ")" ::: "memory")
#define WAIT_LGKM(n) asm volatile("s_waitcnt lgkmcnt(" #n ")" ::: "memory")
#define WAIT_ALL() asm volatile("s_waitcnt vmcnt(0) lgkmcnt(0)" ::: "memory")
#define SETPRIO(n) __builtin_amdgcn_s_setprio(n)
#define SCHED_BARRIER() __builtin_amdgcn_sched_barrier(0)
#define COMPILER_FENCE() asm volatile("" ::: "memory")
#define WAVE_LDS_SYNC() asm volatile("s_waitcnt lgkmcnt(0)" ::: "memory")
#define LAUNDER(x) asm volatile("" : "+v"(x))
template <class T> DEV T shfl_xor_t(T v, int m) { return __shfl_xor(v, m); }
template <class T> DEV T shfl_t(T v, int src) { return __shfl(v, src); }
DEV int readfirstlane_i(int v) { return __builtin_amdgcn_readfirstlane(v); }
DEV unsigned xb_ld(unsigned* p) { return __hip_atomic_load(p, __ATOMIC_RELAXED, __HIP_MEMORY_SCOPE_AGENT); }
DEV unsigned xb_add(unsigned* p, unsigned v) { return __hip_atomic_fetch_add(p, v, __ATOMIC_RELAXED, __HIP_MEMORY_SCOPE_AGENT); }
DEV unsigned xb_xcc_id() { return (unsigned)__builtin_amdgcn_s_getreg((3 << 11) | 20) & 0xFu; }
DEV void s_sleep1() { __builtin_amdgcn_s_sleep(1); }
DEV void fence_acquire() { __builtin_amdgcn_fence(__ATOMIC_ACQUIRE, "agent"); }
DEV void fence_release() { __builtin_amdgcn_fence(__ATOMIC_RELEASE, "agent"); }
DEV unsigned lds_atomic_add(LAS unsigned* p, unsigned v) { return __hip_atomic_fetch_add(p, v, __ATOMIC_RELAXED, __HIP_MEMORY_SCOPE_WORKGROUP); }
DEV float fast_exp2(float x) { return __builtin_amdgcn_exp2f(x); }
DEV float fast_rcp(float x) { return __builtin_amdgcn_rcpf(x); }
#endif

DEV unsigned f2bf(float f) { unsigned u = __builtin_bit_cast(unsigned, f); return (u + 0x7fffu + ((u >> 16) & 1u)) >> 16; }
DEV unsigned pk2(float lo, float hi) { return f2bf(lo) | (f2bf(hi) << 16); }
DEV float bf2f(unsigned b) { return __builtin_bit_cast(float, b << 16); }
DEV float bflo(unsigned w) { return __builtin_bit_cast(float, w << 16); }
DEV float bfhi(unsigned w) { return __builtin_bit_cast(float, w & 0xffff0000u); }
DEV float wave_sum(float v) {
#pragma unroll
    for (int o = 1; o < 64; o <<= 1) v += shfl_xor_t(v, o);
    return v;
}
DEV float wave_max(float v) {
#pragma unroll
    for (int o = 1; o < 64; o <<= 1) v = fmaxf(v, shfl_xor_t(v, o));
    return v;
}
DEV float sigmoid_f(float x) { return 1.0f / (1.0f + expf(-x)); }
DEV float silu_f(float x) { return x / (1.0f + expf(-x)); }
DEV float softplus_f(float x) { return fmaxf(x, 0.0f) + log1pf(expf(-fabsf(x))); }
DEV float gelu_tanh_f(float x) { const float u = 0.7978845608028654f * (x + 0.044715f * x * x * x); return 0.5f * x * (1.0f + tanhf(u)); }

#define XB_TMO      128
#define XB_XCNT(j)  (256  + 64 * (j))
#define XB_XSUB(j)  (1280 + 64 * (j))
#define XB_XGEN(j)  (2304 + 64 * (j))
#define XB_TOP      3328
#define XB_TOPGEN   3392
#define XCD_BAR_WORDS 3456
#define XB_SPIN_CAP (1u << 20)
#define XB_SPIN(cond, bar) do { unsigned _sp = 0; while (cond) { s_sleep1(); \
    if ((++_sp & 255u) == 0u) { if (xb_ld(&(bar)[XB_TMO])) break; if (_sp > XB_SPIN_CAP) { xb_add(&(bar)[XB_TMO], 1u); break; } } } } while (0)
struct XcdBarrier { unsigned* bar; unsigned x; volatile LAS unsigned* st; };
DEV XcdBarrier xcd_barrier_post(unsigned* bar, volatile LAS unsigned* st) {
    XcdBarrier b; b.bar = bar; b.x = xb_xcc_id(); b.st = st;
    if (threadIdx.x == 0) (void)xb_add(&bar[XB_XCNT(b.x)], 1u);
    return b;
}
DEV void xcd_barrier_complete(unsigned* bar, unsigned x, unsigned& nloc, unsigned& nx) {
    const unsigned G = gridDim.x;
    unsigned sum, cnt, mine, sp = 0u;
    for (;;) {
        sum = 0u; cnt = 0u; mine = 0u;
#pragma unroll
        for (unsigned j = 0; j < 16; ++j) { const unsigned c = xb_ld(&bar[XB_XCNT(j)]); sum += c; cnt += (c > 0u) ? 1u : 0u; mine = (j == x) ? c : mine; }
        if (sum == G) break;
        s_sleep1();
        if ((++sp & 255u) == 0u) { if (xb_ld(&bar[XB_TMO])) break; if (sp > XB_SPIN_CAP) { xb_add(&bar[XB_TMO], 1u); break; } }
    }
    nloc = mine > 0u ? mine : 1u; nx = cnt > 0u ? cnt : 1u;
}
DEV void xcd_barrier(const XcdBarrier& b) {
    WAIT_VM(0);
    __syncthreads();
    if (threadIdx.x == 0) {
        unsigned* bar = b.bar;
        WAIT_ALL();
        unsigned nloc = b.st[0], nx = b.st[1];
        if (nloc == 0u) { xcd_barrier_complete(bar, b.x, nloc, nx); b.st[0] = nloc; b.st[1] = nx; }
        const unsigned old = xb_add(&bar[XB_XSUB(b.x)], 1u);
        const unsigned gen = old / nloc;
        if (old + 1u == (gen + 1u) * nloc) {
            fence_release();
            WAIT_VM(0);
            const unsigned og = xb_add(&bar[XB_TOP], 1u);
            const unsigned tg = og / nx;
            if (og + 1u == (tg + 1u) * nx) xb_add(&bar[XB_TOPGEN], 1u);
            else XB_SPIN(xb_ld(&bar[XB_TOPGEN]) == tg, bar);
            fence_acquire();
            xb_add(&bar[XB_XGEN(b.x)], 1u);
            WAIT_VM(0);
        } else {
            XB_SPIN(xb_ld(&bar[XB_XGEN(b.x)]) == gen, bar);
            fence_acquire();
            WAIT_VM(0);
        }
    }
    __syncthreads();
}

namespace pg8 {
constexpr int BM = 256, BK = 64, HALF = 128, HTB = HALF * BK * 2, STAGE_BYTES = 8 * HTB;
DEV int lds_byte(int r, int c) { const int st = (r >> 4) * 2 + (c >> 5), rr = r & 15, cc = c & 31, ob = rr * 64 + cc * 2; return st * 1024 + (ob ^ (((ob >> 9) & 1) << 5)); }
DEV void stage_rc(int b, int& R, int& C) { const int st = b / 1024, sb = b % 1024, swz = sb ^ (((sb >> 9) & 1) << 5); R = (st >> 1) * 16 + swz / 64; C = (st & 1) * 32 + (swz % 64) / 2; }
DEV int perm32(int rho) { const int n = rho >> 4, i = rho & 15; return 8 * (i >> 2) + 4 * n + (i & 3); }
struct Unit { const char* A; const char* B; int pm, pn, e; };
#ifdef EMU
static inline unsigned cvt_pk_bf16(float lo, float hi) { return pk2(lo, hi); }
#else
DEV unsigned cvt_pk_bf16(float lo, float hi) { unsigned r; asm volatile("v_cvt_pk_bf16_f32 %0, %1, %2" : "=v"(r) : "v"(lo), "v"(hi)); return r; }
#endif
template <class Epi, class Sched>
DEV void gemm_phase(LAS unsigned char* lds, const int K, const Sched& S, const Epi& E) {
    int tid = threadIdx.x; LAUNDER(tid); const int wid = readfirstlane_i(tid >> 6), lane = tid & 63, wr = wid >> 2, wc = wid & 3, fr = lane & 15, fq = lane >> 4;
    const int nt = K / BK;
    unsigned voffA[2], voffB[2];
#pragma unroll
    for (int i = 0; i < 2; ++i) { int R, C; stage_rc(tid * 16 + i * 8192, R, C); const int Rb = Epi::PERM ? ((R & ~31) + perm32(R & 31)) : R;
        voffA[i] = (unsigned)(R * K + C) * 2u; voffB[i] = (unsigned)(Rb * K + C) * 2u; }
    const size_t kstep = (size_t)(BK * 2);
    const size_t hstep = (size_t)HALF * K * 2;
    const unsigned ldsw = (unsigned)wid * 1024u;
    const int aoff = lds_byte(wr * 64 + fr, fq * 8), boff = lds_byte(wc * 32 + fr, fq * 8);
#define PG8_SA(b, h) (((b) * 2 + (h)) * HTB)
#define PG8_SB(b, h) ((4 + (b) * 2 + (h)) * HTB)
#define PG8_STAGE(bufoff, gbase, voff) do { _Pragma("unroll") for (int _i = 0; _i < 2; ++_i) \
        glds16(((const char*)(gbase) + (voff)[_i]), (lds + (bufoff) + ldsw + _i * 8192)); } while (0)
#define PG8_LDA(dst, b, h) do { _Pragma("unroll") for (int m = 0; m < 4; ++m) _Pragma("unroll") for (int k = 0; k < 2; ++k) dst[m][k] = *(const LAS bf16x8*)(lds + PG8_SA(b, h) + aoff + m * 2048 + k * 1024); } while (0)
#define PG8_LDB(dst, b, h) do { _Pragma("unroll") for (int n = 0; n < 2; ++n) _Pragma("unroll") for (int k = 0; k < 2; ++k) dst[n][k] = *(const LAS bf16x8*)(lds + PG8_SB(b, h) + boff + n * 2048 + k * 1024); } while (0)
#define PG8_MMA(ai, bj, At, Bt) do { SETPRIO(1); _Pragma("unroll") for (int m = 0; m < 4; ++m) _Pragma("unroll") for (int n = 0; n < 2; ++n) _Pragma("unroll") for (int k = 0; k < 2; ++k) \
        acc[ai][bj][m][n] = mfma16(Bt[n][k], At[m][k], acc[ai][bj][m][n]); SETPRIO(0); } while (0)
    Unit cur, nxt; int ui = 0;
    if (!S.next(0, cur)) return;
    f32x4 acc[2][2][4][2];
#pragma unroll
    for (int a = 0; a < 2; ++a)
#pragma unroll
        for (int b = 0; b < 2; ++b)
#pragma unroll
            for (int m = 0; m < 4; ++m)
#pragma unroll
                for (int n = 0; n < 2; ++n) acc[a][b][m][n] = (f32x4){0.f, 0.f, 0.f, 0.f};
    bf16x8 At[4][2], B0[2][2], B1[2][2];
    const char* cA = cur.A; const char* cB = cur.B;
    PG8_STAGE(PG8_SB(0, 0), cB, voffB); PG8_STAGE(PG8_SB(0, 1), cB + hstep, voffB); PG8_STAGE(PG8_SA(0, 0), cA, voffA); PG8_STAGE(PG8_SA(0, 1), cA + hstep, voffA);
    if (wr == 1) S_BARRIER();
    WAIT_VM(2); S_BARRIER();
    PG8_STAGE(PG8_SB(1, 0), cB + kstep, voffB); PG8_STAGE(PG8_SA(1, 0), cA + kstep, voffA); PG8_STAGE(PG8_SB(1, 1), cB + hstep + kstep, voffB);
    WAIT_VM(6); S_BARRIER();
    for (;;) {
        const bool has_next = S.next(ui + 1, nxt);
        const char* nA = has_next ? nxt.A : cA; const char* nB = has_next ? nxt.B : cB;
        for (int t = 0; t < nt; t += 2) {
            const bool last = (t == nt - 2);
            const char* a1 = cA + (size_t)(t + 1) * kstep;
            const char* a2 = last ? nA : cA + (size_t)(t + 2) * kstep; const char* b2 = last ? nB : cB + (size_t)(t + 2) * kstep;
            const char* a3 = a2 + kstep; const char* b3 = b2 + kstep;
            PG8_LDB(B0, 0, 0); PG8_LDB(B1, 0, 1); SCHED_BARRIER(); PG8_LDA(At, 0, 0); PG8_STAGE(PG8_SA(1, 1), a1 + hstep, voffA);
            WAIT_VM(8); WAIT_LGKM(0); S_BARRIER(); PG8_MMA(0, 0, At, B0); PG8_MMA(0, 1, At, B1); S_BARRIER(); SCHED_BARRIER();
            PG8_LDA(At, 0, 1); PG8_STAGE(PG8_SB(0, 0), b2, voffB); PG8_STAGE(PG8_SB(0, 1), b2 + hstep, voffB); PG8_STAGE(PG8_SA(0, 0), a2, voffA);
            WAIT_VM(8); WAIT_LGKM(0); S_BARRIER(); PG8_MMA(1, 0, At, B0); PG8_MMA(1, 1, At, B1); S_BARRIER(); SCHED_BARRIER();
            PG8_LDB(B0, 1, 0); PG8_LDB(B1, 1, 1); SCHED_BARRIER(); PG8_LDA(At, 1, 0); PG8_STAGE(PG8_SA(0, 1), a2 + hstep, voffA);
            WAIT_VM(8); WAIT_LGKM(0); S_BARRIER(); PG8_MMA(0, 0, At, B0); PG8_MMA(0, 1, At, B1); S_BARRIER(); SCHED_BARRIER();
            PG8_LDA(At, 1, 1); PG8_STAGE(PG8_SB(1, 0), b3, voffB); PG8_STAGE(PG8_SB(1, 1), b3 + hstep, voffB); PG8_STAGE(PG8_SA(1, 0), a3, voffA);
            WAIT_VM(8); WAIT_LGKM(0); S_BARRIER(); PG8_MMA(1, 0, At, B0); PG8_MMA(1, 1, At, B1); S_BARRIER(); SCHED_BARRIER();
        }
        if (wr == 0) S_BARRIER();
        E(acc, cur, wr, wc, fr, fq);
        if (!has_next) break;
#pragma unroll
        for (int a = 0; a < 2; ++a)
#pragma unroll
            for (int b = 0; b < 2; ++b)
#pragma unroll
                for (int m = 0; m < 4; ++m)
#pragma unroll
                    for (int n = 0; n < 2; ++n) acc[a][b][m][n] = (f32x4){0.f, 0.f, 0.f, 0.f};
        cur = nxt; cA = nA; cB = nB; ++ui;
        if (wr == 1) S_BARRIER();
    }
    WAIT_VM(0);
    S_BARRIER();
#undef PG8_SA
#undef PG8_SB
#undef PG8_STAGE
#undef PG8_LDA
#undef PG8_LDB
#undef PG8_MMA
}

struct PlainOrder {
    const char* A; const char* Bt; int K, nM, nN, nwg, G, c;
    DEV void init(const void* A_, const void* Bt_, int K_, int M, int N, int G_, int c_) { A = (const char*)A_; Bt = (const char*)Bt_; K = K_; nM = M / BM; nN = N / BM; nwg = nM * nN; G = G_; c = c_; }
    DEV bool next(int i, Unit& u) const {
        const long L = (long)i * G + c; if (L >= nwg) return false;
        int wgid = (int)L; { const int q = nwg / 8, r = nwg % 8, xcd = wgid % 8, off = wgid / 8; wgid = (xcd < r ? xcd * (q + 1) : r * (q + 1) + (xcd - r) * q) + off; }
        const int nig = 8 * nN, gid = wgid / nig, fm = gid * 8, gsz = (nM - fm) < 8 ? (nM - fm) : 8;
        u.pm = fm + ((wgid % nig) % gsz); u.pn = (wgid % nig) / gsz; u.e = 0;
        u.A = A + (size_t)u.pm * BM * K * 2; u.B = Bt + (size_t)u.pn * BM * K * 2; return true;
    }
};
struct GroupedOrder {
    const char* A; const char* Bt; int K, nMe, nN, nwg, G, c; size_t bstride;
    DEV void init(const void* A_, const void* Bt_, int K_, int N, int G_, int c_) { A = (const char*)A_; Bt = (const char*)Bt_; K = K_; nMe = EPAD / BM; nN = N / BM; nwg = NE * nMe * nN; G = G_; c = c_; bstride = (size_t)N * K * 2; }
    DEV bool next(int i, Unit& u) const {
        const long L = (long)i * G + c; if (L >= nwg) return false;
        int wgid = (int)L; { const int q = nwg / 8, r = nwg % 8, xcd = wgid % 8, off = wgid / 8; wgid = (xcd < r ? xcd * (q + 1) : r * (q + 1) + (xcd - r) * q) + off; }
        const int per_e = nMe * nN; const int e = wgid / per_e, w = wgid % per_e;
        u.e = e; u.pm = w % nMe; u.pn = w / nMe;
        u.A = A + ((size_t)e * EPAD + (size_t)u.pm * BM) * K * 2; u.B = Bt + (size_t)e * bstride + (size_t)u.pn * BM * K * 2; return true;
    }
};
}

struct Args { const float* in[N_IN]; float* out; unsigned char* ws; };

struct Frame {
    const float* const* in; float* out; unsigned char* ws; LAS unsigned char* lds;
    int tid, lane, wave, G, bid, gw, NGW;
};

DEV Frame refresh(const Frame& F0) { Frame F = F0; int t = F0.tid; LAUNDER(t); F.tid = t; F.lane = t & 63; F.wave = readfirstlane_i(t >> 6); F.gw = F.bid * NWAVES + F.wave; return F; }

DEV int tok_row(int b, int d, int sp) {
    int s;
    if (sp < CTX) s = d ? (CTX - 1 - sp) : sp;
    else { const int j = sp - CTX; s = CTX + (d ? (SEQ - 1 - j) : j); }
    return b * TOK + s;
}

DEV void tr_item(const float* W, int ldw, int col0, int k0, bf16_t* WT, int K, int row0, LAS float* scr, int lane) {
#pragma unroll 8
    for (int i = 0; i < 32; ++i) { const int kk = 2 * i + (lane >> 5); scr[kk * 33 + (lane & 31)] = W[(size_t)(k0 + kk) * ldw + col0 + (lane & 31)]; }
    WAVE_LDS_SYNC();
    const int c = lane & 7;
#pragma unroll
    for (int j = 0; j < 4; ++j) { const int n = (lane >> 3) + 8 * j; const LAS float* s = scr + (8 * c) * 33 + n;
        u32x4 o; o.x = pk2(s[0 * 33], s[1 * 33]); o.y = pk2(s[2 * 33], s[3 * 33]); o.z = pk2(s[4 * 33], s[5 * 33]); o.w = pk2(s[6 * 33], s[7 * 33]);
        *(u32x4*)(WT + (size_t)(row0 + n) * K + k0 + 8 * c) = o; }
    WAVE_LDS_SYNC();
}

DEV void phase_prologue_a(const Frame& F0) {
    const Frame F = refresh(F0);
    LAS float* scr = (LAS float*)(F.lds + F.wave * 16384);
    for (int l = 0; l < DEPTH; ++l) {
        const int odd = l & 1, li = l >> 1;
        const float* win = odd ? F.in[I_ODWIN] + (size_t)li * 1024 * 2576 : F.in[I_EVWIN] + (size_t)li * 1024 * 4112;
        const int ldw = odd ? 2576 : 4112, nin = odd ? NIN_O : NIN_E;
        bf16_t* wint = (bf16_t*)(F.ws + WS_WIN) + (size_t)l * NINMAX * 1024;
        for (int it = F.gw; it < 16 * (nin / 32); it += F.NGW) { const int kb = it / (nin / 32), nb = it % (nin / 32); const int d0 = 32 * nb;
            tr_item(win, ldw, d0 < 2048 ? d0 : d0 + 16, 64 * kb, wint, 1024, d0, scr, F.lane); }
        const float* wout = odd ? F.in[I_ODWOUT] + (size_t)li * 1024 * 1024 : F.in[I_EVWOUT] + (size_t)li * 1024 * 1024;
        bf16_t* woutt = (bf16_t*)(F.ws + WS_WOUT) + (size_t)l * 1024 * 1024;
        for (int it = F.gw; it < 16 * 32; it += F.NGW) { const int kb = it / 32, nb = it % 32; tr_item(wout, 1024, 32 * nb, 64 * kb, woutt, 1024, 32 * nb, scr, F.lane); }
        if (odd) {
            const float* wglu = F.in[I_ODWGLU] + (size_t)li * 512 * 512; bf16_t* wglut = (bf16_t*)(F.ws + WS_WGLU) + (size_t)li * 512 * 512;
            for (int it = F.gw; it < 8 * 16; it += F.NGW) { const int kb = it / 16, nb = it % 16; tr_item(wglu, 512, 32 * nb, 64 * kb, wglut, 512, 32 * nb, scr, F.lane); }
        }
        constexpr int GU_NB = 2 * FF / 32, GU_ITEMS = 16 * GU_NB;
        for (int it = F.gw; it < NE * GU_ITEMS; it += F.NGW) { const int e = it / GU_ITEMS, r = it % GU_ITEMS, kb = r / GU_NB, nb = r % GU_NB; const int d0 = 32 * nb, j = d0 >> 8, w = d0 & 255;
            const float* src = (w < 128 ? F.in[I_WGATE] : F.in[I_WUP]) + ((size_t)l * NE + e) * 1024 * FF;
            tr_item(src, FF, 128 * j + (w & 127), 64 * kb, (bf16_t*)(F.ws + WS_WGU) + ((size_t)l * NE + e) * 2 * FF * 1024, 1024, d0, scr, F.lane); }
        constexpr int D_ITEMS = (FF / 64) * 32;
        for (int it = F.gw; it < NE * D_ITEMS; it += F.NGW) { const int e = it / D_ITEMS, r = it % D_ITEMS, kb = r / 32, nb = r % 32;
            tr_item(F.in[I_WDOWN] + ((size_t)l * NE + e) * FF * 1024, 1024, 32 * nb, 64 * kb, (bf16_t*)(F.ws + WS_WD) + ((size_t)l * NE + e) * 1024 * FF, FF, 32 * nb, scr, F.lane); }
    }
    const int gt = F.bid * NTHREADS + F.tid, NGT = F.G * NTHREADS;
    for (int i = gt; i < DEPTH * 16 * 1024; i += NGT) { const int l = i / 16384, g = (i >> 10) & 15, k = i & 1023; const int odd = l & 1, li = l >> 1;
        ((float*)(F.ws + WS_WG))[i] = odd ? F.in[I_ODWIN][((size_t)li * 1024 + k) * 2576 + 2048 + g] : F.in[I_EVWIN][((size_t)li * 1024 + k) * 4112 + 2048 + g]; }
    for (int i = gt; i < N_ODD * 2 * 32 * 64; i += NGT) { const int p = i & 63, g = (i >> 6) & 31, d = (i >> 11) & 1, o = i >> 12;
        const int idx = ((o * 2 + d) * 32 + g) * 64 + p;
        const float lr = fminf(F.in[I_ODLRE][idx], -1e-4f), li_ = F.in[I_ODLIM][idx], dt = expf(F.in[I_ODLDT][(o * 2 + d) * 32 + g]);
        const float mag = expf(lr * dt); float sn, cs; sincosf(li_ * dt, &sn, &cs); const float are = mag * cs, aim = mag * sn;
        float* A = (float*)(F.ws + WS_S5A) + (size_t)((o * 2 + d) * 32 + g) * 128; A[p] = are; A[64 + p] = aim;
        const float xr = are - 1.0f, xi = aim, den = lr * lr + li_ * li_; const float fre = (xr * lr + xi * li_) / den, fim = (xi * lr - xr * li_) / den;
        bf16_t* Bb = (bf16_t*)(F.ws + WS_S5B) + (size_t)((o * 2 + d) * 32 + g) * 128 * 16;
        for (int h = 0; h < 16; ++h) { const float br = F.in[I_ODBRE][((size_t)(o * 32 + g) * 64 + p) * 16 + h], bi = F.in[I_ODBIM][((size_t)(o * 32 + g) * 64 + p) * 16 + h];
            Bb[p * 16 + h] = (bf16_t)f2bf(fre * br - fim * bi); Bb[(64 + p) * 16 + h] = (bf16_t)f2bf(fre * bi + fim * br); } }
    for (int i = gt; i < N_ODD * 32 * 16 * 64; i += NGT) { const int p = i & 63, c = (i >> 6) & 15, g = (i >> 10) & 31, o = i >> 15;
        bf16_t* Cm = (bf16_t*)(F.ws + WS_S5C) + (size_t)((o * 32 + g) * 16 + c) * 128;
        Cm[p] = (bf16_t)f2bf(F.in[I_ODCRE][i]); Cm[64 + p] = (bf16_t)f2bf(-F.in[I_ODCIM][i]); }
    for (int r = F.gw; r < MPAD; r += F.NGW) {
        f32x4* dst = (f32x4*)((float*)(F.ws + WS_H) + (size_t)r * 1024) + F.lane;
        if (r < MROWS) { const int b = r / TOK, s = r % TOK; const f32x4* src = (const f32x4*)(s < CTX ? F.in[I_CTX] + ((size_t)b * CTX + s) * 1024 : F.in[I_X] + ((size_t)b * SEQ + (s - CTX)) * 1024) + F.lane;
#pragma unroll
            for (int j = 0; j < 4; ++j) dst[64 * j] = src[64 * j]; }
        else {
#pragma unroll
            for (int j = 0; j < 4; ++j) dst[64 * j] = (f32x4){0.f, 0.f, 0.f, 0.f};
            u32x4* xz = (u32x4*)((bf16_t*)(F.ws + WS_XIN) + (size_t)r * 1024) + F.lane; xz[0] = (u32x4){0u, 0u, 0u, 0u}; xz[64] = (u32x4){0u, 0u, 0u, 0u};
            u32x4* mz = (u32x4*)((bf16_t*)(F.ws + WS_MERGED) + (size_t)r * 1024) + F.lane; mz[0] = (u32x4){0u, 0u, 0u, 0u}; mz[64] = (u32x4){0u, 0u, 0u, 0u};
            u32x4* yz = (u32x4*)((bf16_t*)(F.ws + WS_YS) + (size_t)r * 512) + F.lane; yz[0] = (u32x4){0u, 0u, 0u, 0u};
        }
    }
    __syncthreads();
    LAS float* sv = (LAS float*)F.lds;
    LAS float* part = (LAS float*)(F.lds + 32768);
    for (int i = F.tid; i < NR * 1024; i += NTHREADS) { const int r = i >> 10, k = i & 1023; const float c = r < B_ ? F.in[I_C][r * 1024 + k] : F.in[I_CCTX][k]; sv[i] = silu_f(c); }
    __syncthreads();
    for (int it = F.bid; it < DEPTH * 96; it += F.G) {
        const int l = it / 96, j = (it % 96) * 64 + F.lane;
        const float* w = F.in[I_WMOD] + (size_t)l * 1024 * 6144 + j;
        float acc[NR];
#pragma unroll
        for (int r = 0; r < NR; ++r) acc[r] = 0.f;
        const int k0 = F.wave * 128;
#pragma unroll 8
        for (int k = 0; k < 128; ++k) { const float wv = w[(size_t)(k0 + k) * 6144];
#pragma unroll
            for (int r = 0; r < NR; ++r) acc[r] += sv[r * 1024 + k0 + k] * wv; }
#pragma unroll
        for (int r = 0; r < NR; ++r) part[(F.wave * NR + r) * 64 + F.lane] = acc[r];
        __syncthreads();
        for (int i = F.tid; i < NR * 64; i += NTHREADS) { const int r = i >> 6, jj = i & 63; float s = 0.f;
#pragma unroll
            for (int w8 = 0; w8 < 8; ++w8) s += part[(w8 * NR + r) * 64 + jj];
            const int col = (it % 96) * 64 + jj;
            ((float*)(F.ws + WS_MOD))[((size_t)l * NR + r) * 6144 + col] = s + F.in[I_BMOD][l * 6144 + col]; }
        __syncthreads();
    }
}

DEV void xg_row(const Frame& F, int l, int row, const f32x4 (&v)[4]) {
    const int b = row / TOK, s = row % TOK, mr = s < CTX ? B_ : b;
    const float* mod = (const float*)(F.ws + WS_MOD) + ((size_t)l * NR + mr) * 6144;
    f32x4 x[4];
#pragma unroll
    for (int j = 0; j < 4; ++j) { const f32x4 sh = *((const f32x4*)mod + F.lane + 64 * j), sc = *((const f32x4*)(mod + 1024) + F.lane + 64 * j); x[j] = v[j] * (1.0f + sc) + sh; }
    u32x2* xo = (u32x2*)((bf16_t*)(F.ws + WS_XIN) + (size_t)row * 1024) + F.lane;
#pragma unroll
    for (int j = 0; j < 4; ++j) xo[64 * j] = (u32x2){pk2(x[j].x, x[j].y), pk2(x[j].z, x[j].w)};
    const float* wg = (const float*)(F.ws + WS_WG) + (size_t)l * 16 * 1024;
    float mine = 0.f; const int gi = F.lane & 15;
#pragma unroll
    for (int g = 0; g < 16; ++g) { float p = 0.f;
#pragma unroll
        for (int j = 0; j < 4; ++j) { const f32x4 w = *((const f32x4*)(wg + g * 1024) + F.lane + 64 * j); p += x[j].x * w.x + x[j].y * w.y + x[j].z * w.z + x[j].w * w.w; }
        p = wave_sum(p); mine = (gi == g) ? p : mine; }
    const int ty = gi >> 2, hh = gi & 3, li = l >> 1; float o;
    if (!(l & 1)) {
        if (ty < 2) o = -expf(F.in[I_EVALOG][(li * 2 + ty) * 4 + hh]) * softplus_f(mine + F.in[I_EVDTB][(li * 2 + ty) * 4 + hh]);
        else o = sigmoid_f(mine);
    } else {
        const int d = ty & 1, k = ty >> 1; const float gb = F.in[I_ODGB][((li * 2 + d) * 2 + k) * 4 + hh];
        o = k ? -softplus_f(-(mine + gb)) : mine + gb;
    }
    if (F.lane < 16) ((float*)(F.ws + WS_GATES))[(size_t)row * 16 + gi] = o;
}

DEV void phase_xg0(const Frame& F0) {
    const Frame F = refresh(F0);
    for (int r = F.gw; r < MROWS; r += F.NGW) {
        const f32x4* hr = (const f32x4*)((const float*)(F.ws + WS_H) + (size_t)r * 1024) + F.lane; f32x4 v[4];
#pragma unroll
        for (int j = 0; j < 4; ++j) v[j] = hr[64 * j];
        xg_row(F, 0, r, v);
    }
}

DEV void phase_prep(const Frame& F0, int l) {
    const Frame F = refresh(F0);
    const int odd = l & 1, li = l >> 1; const int nin = odd ? NIN_O : NIN_E, nseg = odd ? 2 : 3, qld = odd ? 1024 : 1536;
    const bf16_t* P = (const bf16_t*)(F.ws + WS_P); bf16_t* Q = (bf16_t*)(F.ws + WS_QKV);
    const float* cw = odd ? F.in[I_ODCONV] + (size_t)li * 9 * 1024 : F.in[I_EVCONV] + (size_t)li * 9 * 1536; const int cch = odd ? 1024 : 1536;
    for (int r = F.gw; r < MROWS; r += F.NGW) {
        const int b = r / TOK, s = r % TOK; const bool lat = s >= CTX; const int rr = lat ? (s - CTX) >> 6 : 0, cc = lat ? (s - CTX) & 63 : s;
        for (int seg = 0; seg < nseg; ++seg) {
            const int ch0 = seg * 512 + F.lane * 8; float a[8];
#pragma unroll
            for (int i = 0; i < 8; ++i) a[i] = 0.f;
#pragma unroll
            for (int kh = 0; kh < 3; ++kh)
#pragma unroll
                for (int kw = 0; kw < 3; ++kw) {
                    int nrow; bool ok;
                    if (lat) { const int r2 = rr + kh - 1, c2 = cc + kw - 1; ok = r2 >= 0 && r2 < SEQ / 64 && c2 >= 0 && c2 < 64; nrow = b * TOK + CTX + r2 * 64 + c2; }
                    else { const int t2 = cc + kw - 1; ok = (kh == 1) && t2 >= 0 && t2 < CTX; nrow = b * TOK + t2; }
                    if (ok) { const u32x4 pv = *(const u32x4*)(P + (size_t)nrow * nin + ch0); const f32x4 w0 = *(const f32x4*)(cw + (kh * 3 + kw) * cch + ch0), w1 = *(const f32x4*)(cw + (kh * 3 + kw) * cch + ch0 + 4);
                        a[0] += bflo(pv.x) * w0.x; a[1] += bfhi(pv.x) * w0.y; a[2] += bflo(pv.y) * w0.z; a[3] += bfhi(pv.y) * w0.w;
                        a[4] += bflo(pv.z) * w1.x; a[5] += bfhi(pv.z) * w1.y; a[6] += bflo(pv.w) * w1.z; a[7] += bfhi(pv.w) * w1.w; }
                }
            float ss = 0.f;
#pragma unroll
            for (int i = 0; i < 8; ++i) { a[i] = silu_f(a[i]); ss += a[i] * a[i]; }
            float sc = 1.0f;
            if (!odd) { if (seg < 2) { ss += shfl_xor_t(ss, 1); ss += shfl_xor_t(ss, 2); ss += shfl_xor_t(ss, 4); ss += shfl_xor_t(ss, 8); sc = 1.0f / sqrtf(ss + 1e-6f); if (seg == 0) sc *= HD_SCALE; } }
            else if (seg == 1) sc = HD_SCALE;
            u32x4 o; o.x = pk2(a[0] * sc, a[1] * sc); o.y = pk2(a[2] * sc, a[3] * sc); o.z = pk2(a[4] * sc, a[5] * sc); o.w = pk2(a[6] * sc, a[7] * sc);
            *(u32x4*)(Q + (size_t)r * qld + ch0) = o;
        }
    }
    if (odd) {
        const float* GT = (const float*)(F.ws + WS_GATES); float* MC = (float*)(F.ws + WS_MCH);
        for (int c = F.gw; c < B_ * 4 * 2; c += F.NGW) { const int d = c & 1, hh = (c >> 1) & 3, b = c >> 3; float m = 0.f;
            for (int n = 0; n < NCH; ++n) { const int row = tok_row(b, d, n * 64 + F.lane);
                const float lin = GT[(size_t)row * 16 + d * 4 + hh], lf = GT[(size_t)row * 16 + 8 + d * 4 + hh];
                float bc = lf;
#pragma unroll
                for (int o = 1; o < 64; o <<= 1) { const float t = shfl_t(bc, F.lane - o); if (F.lane >= o) bc += t; }
                const float bend = shfl_t(bc, 63); const float amax = wave_max(bend - bc + lin);
                if (F.lane == 0) MC[(size_t)c * NCH + n] = m;
                m = fmaxf(bend + m, amax); }
        }
    }
}

DEV void phase_cl(const Frame& F0, int l) {
    const Frame F = refresh(F0);
    const int odd = l & 1; const int nhh = odd ? 4 : 8; const int nprob = B_ * nhh * 2 * NCH;
    LAS float* gc = (LAS float*)(F.lds);
    LAS float* bt = (LAS float*)(F.lds + 256);
    LAS int* rix = (LAS int*)(F.lds + 512);
    LAS float* qs = (LAS float*)(F.lds + 768);
    LAS float* ks = (LAS float*)(F.lds + 1024);
    LAS float* mt = (LAS float*)(F.lds + 1280);
    LAS float* sc = (LAS float*)(F.lds + 1536);
    LAS float* rsp = (LAS float*)(F.lds + 2048);
    LAS float* Am = (LAS float*)(F.lds + 4096);
    LAS bf16_t* An = (LAS bf16_t*)(F.lds + 20480);
    LAS bf16_t* XT = (LAS bf16_t*)(F.lds + 30720);
    LAS float* Rb = (LAS float*)(F.lds + 69632 + F.wave * 2048);
    const bf16_t* P = (const bf16_t*)(F.ws + WS_P); const bf16_t* Q = (const bf16_t*)(F.ws + WS_QKV); const float* GT = (const float*)(F.ws + WS_GATES);
    const int h = F.lane >> 5, l31 = F.lane & 31;
    for (int p = F.bid; p < nprob; p += F.G) {
        const int n = p % NCH, d = (p / NCH) & 1, hh = (p / (2 * NCH)) % nhh, b = p / (2 * NCH * nhh);
        const int kind = odd ? 2 : (hh < 4 ? 0 : 1);
        const bf16_t *qsrc, *ksrc, *vsrc; int qld, vld; float kscale = 1.0f;
        if (kind == 0) { qsrc = Q + hh * 128; ksrc = Q + 512 + hh * 128; vsrc = Q + 1024 + hh * 128; qld = 1536; vld = 1536; }
        else if (kind == 1) { qsrc = P + 2048 + (hh - 4) * 128; ksrc = P + 2560 + (hh - 4) * 128; vsrc = P + 3072 + (hh - 4) * 128; qld = NIN_E; vld = NIN_E; kscale = HD_SCALE; }
        else { qsrc = Q + hh * 128; ksrc = Q + 512 + hh * 128; vsrc = P + 1024 + hh * 128; qld = 1024; vld = NIN_O; }
        float* CS = (float*)(F.ws + WS_CLS) + (size_t)p * 256;
        if (F.wave == 0) {
            const int i = F.lane; const int row = tok_row(b, d, n * 64 + i); rix[i] = row;
            float g, be = 0.f;
            if (kind == 0) { g = GT[(size_t)row * 16 + d * 4 + hh]; be = GT[(size_t)row * 16 + 8 + d * 4 + hh]; }
            else if (kind == 1) g = log1pf(-exp2f(-(5.0f + 2.0f * (float)(hh - 4) + (float)d)));
            else { be = GT[(size_t)row * 16 + d * 4 + hh]; g = GT[(size_t)row * 16 + 8 + d * 4 + hh]; }
            float cum = g;
#pragma unroll
            for (int o = 1; o < 64; o <<= 1) { const float t = shfl_t(cum, i - o); if (i >= o) cum += t; }
            const float gend = shfl_t(cum, 63);
            gc[i] = cum; bt[i] = be;
            if (kind < 2) { qs[i] = expf(cum); ks[i] = expf(gend - cum) * kscale; if (i == 0) { sc[0] = expf(gend); CS[0] = expf(gend); } }
            else {
                const float mprev = ((const float*)(F.ws + WS_MCH))[(size_t)((b * 4 + hh) * 2 + d) * NCH + n];
                const float a = gend - cum + be; const float amax = wave_max(a); const float mnew = fmaxf(gend + mprev, amax);
                ks[i] = expf(a - mnew);
                float pm = be - cum;
#pragma unroll
                for (int o = 1; o < 64; o <<= 1) { const float t = shfl_t(pm, i - o); if (i >= o) pm = fmaxf(pm, t); }
                const float mti = cum + fmaxf(mprev, pm); mt[i] = mti; qs[i] = expf(cum + mprev - mti);
                CS[128 + i] = expf(-mti);
                if (i == 0) { const float dec = expf(gend + mprev - mnew); sc[0] = dec; CS[0] = dec; }
            }
        }
        __syncthreads();
        {
            const int w4 = F.wave & 3, mt_ = w4 >> 1, nt_ = w4 & 1; const bool doY = F.wave >= 4;
            if (!doY || kind == 0) {
                const int rj = rix[32 * mt_ + l31], ri = rix[32 * nt_ + l31];
                const bf16_t* ap = ksrc + (size_t)rj * qld + 8 * h; const bf16_t* bp = (doY ? ksrc : qsrc) + (size_t)ri * qld + 8 * h;
                f32x16 acc;
#pragma unroll
                for (int r = 0; r < 16; ++r) acc[r] = 0.f;
#pragma unroll
                for (int s = 0; s < 8; ++s) { const bf16x8 a = *(const bf16x8*)(ap + 16 * s), bb = *(const bf16x8*)(bp + 16 * s); acc = mfma32(a, bb, acc); }
                const int i = 32 * nt_ + l31; const float gi = gc[i];
                if (!doY) {
                    bf16_t* AQ = (bf16_t*)(F.ws + WS_CLA) + (size_t)p * 4096 + (size_t)i * 64; float rsum = 0.f; const float mti = kind == 2 ? mt[i] : 0.f;
#pragma unroll
                    for (int g4 = 0; g4 < 4; ++g4) { float v[4];
#pragma unroll
                        for (int r = 0; r < 4; ++r) { const int j = 32 * mt_ + 8 * g4 + 4 * h + r; float e;
                            if (kind < 2) e = expf(fminf(gi - gc[j], 0.f)); else e = expf(gi - gc[j] + bt[j] - mti);
                            v[r] = (i >= j) ? acc[4 * g4 + r] * kscale * e : 0.f; rsum += v[r]; }
                        *(u32x2*)(AQ + 32 * mt_ + 8 * g4 + 4 * h) = (u32x2){pk2(v[0], v[1]), pk2(v[2], v[3])}; }
                    if (kind == 2) rsp[i * 4 + mt_ * 2 + h] = rsum;
                } else {
                    const float bi = bt[i];
#pragma unroll
                    for (int r = 0; r < 16; ++r) { const int j = 32 * mt_ + 8 * (r >> 2) + 4 * h + (r & 3);
                        const float av = (i > j) ? bi * acc[r] * expf(fminf(gi - gc[j], 0.f)) : 0.f;
                        Am[i * 64 + j] = av; An[i * 72 + j] = (bf16_t)f2bf(-av); }
                }
            }
        }
        __syncthreads();
        if (kind == 0) {
            const int l15 = F.lane & 15, kg = F.lane >> 4; const int pg = ((b * 4 + hh) * 2 + d) * NCH + n;
            const bool isw = F.wave >= 4; const bf16_t* src = isw ? ksrc - 128 : vsrc;
            float* U = (float*)(F.ws + WS_CLU) + (size_t)pg * 8192; bf16_t* W = (bf16_t*)(F.ws + WS_CLW) + (size_t)p * 8192;
            for (int bb = 0; bb < 4; ++bb) {
#pragma unroll
                for (int nt2 = 0; nt2 < 2; ++nt2) {
                    const int c = 32 * F.wave + 16 * nt2 + l15; f32x4 acc;
#pragma unroll
                    for (int r = 0; r < 4; ++r) { const int i = 16 * bb + 4 * kg + r; acc[r] = bt[i] * bf2f(src[(size_t)rix[i] * 1536 + c]) * (isw ? qs[i] : 1.0f); }
                    for (int ks = 0; ks < 2; ++ks) if (32 * ks < 16 * bb) {
                        const bool in = 32 * ks + 8 * kg + 8 <= 16 * bb;
                        bf16x8 a = *(const LAS bf16x8*)(An + (16 * bb + l15) * 72 + 32 * ks + 8 * kg); if (!in) a = (bf16x8){0, 0, 0, 0, 0, 0, 0, 0};
                        const bf16x8 xb = *(const LAS bf16x8*)(XT + c * 72 + 32 * ks + 8 * kg);
                        acc = mfma16(a, in ? xb : (bf16x8){0, 0, 0, 0, 0, 0, 0, 0}, acc); }
#pragma unroll
                    for (int r = 0; r < 4; ++r) Rb[(4 * kg + r) * 32 + 16 * nt2 + l15] = acc[r];
                }
                WAVE_LDS_SYNC();
                if (F.lane < 32) {
                    const int c = 32 * F.wave + F.lane; float x[16];
#pragma unroll
                    for (int i = 0; i < 16; ++i) { float r = Rb[i * 32 + F.lane];
#pragma unroll
                        for (int j = 0; j < i; ++j) r -= Am[(16 * bb + i) * 64 + 16 * bb + j] * x[j];
                        x[i] = r; }
                    if (!isw) {
#pragma unroll
                        for (int i = 0; i < 16; ++i) U[(16 * bb + i) * 128 + c] = x[i]; }
                    else {
#pragma unroll
                        for (int i = 0; i < 16; ++i) W[(16 * bb + i) * 128 + (c - 128)] = (bf16_t)f2bf(-x[i]); }
                    *(LAS u32x4*)(XT + c * 72 + 16 * bb) = (u32x4){pk2(x[0], x[1]), pk2(x[2], x[3]), pk2(x[4], x[5]), pk2(x[6], x[7])};
                    *(LAS u32x4*)(XT + c * 72 + 16 * bb + 8) = (u32x4){pk2(x[8], x[9]), pk2(x[10], x[11]), pk2(x[12], x[13]), pk2(x[14], x[15])};
                }
                WAVE_LDS_SYNC();
            }
        }
        {
            const int c = F.tid & 127, q4 = F.tid >> 7; bf16_t* QD = (bf16_t*)(F.ws + WS_CLQ) + (size_t)p * 8192 + c;
            for (int i = 16 * q4; i < 16 * q4 + 16; ++i) QD[i * 128] = (bf16_t)f2bf(bf2f(qsrc[(size_t)rix[i] * qld + c]) * qs[i]);
            bf16_t* KT = (bf16_t*)(F.ws + WS_CLK) + (size_t)p * 8192 + (size_t)c * 64;
            for (int j8 = 2 * q4; j8 < 2 * q4 + 2; ++j8) { float v[8];
#pragma unroll
                for (int r = 0; r < 8; ++r) { const int j = 8 * j8 + r; v[r] = bf2f(ksrc[(size_t)rix[j] * qld + c]) * ks[j]; }
                *(u32x4*)(KT + 8 * j8) = (u32x4){pk2(v[0], v[1]), pk2(v[2], v[3]), pk2(v[4], v[5]), pk2(v[6], v[7])}; }
            if (kind == 2 && F.tid < 64) CS[64 + F.tid] = (rsp[F.tid * 4] + rsp[F.tid * 4 + 1]) + (rsp[F.tid * 4 + 2] + rsp[F.tid * 4 + 3]);
        }
        __syncthreads();
    }
}

DEV void seq_linear_item(const Frame& F, int l, int item) {
    const int odd = l & 1, nhh = odd ? 4 : 8;
    const int sl = item & 3, chain = item >> 2, d = chain & 1, hh = (chain >> 1) % nhh, b = chain / (2 * nhh);
    const int kind = odd ? 2 : (hh < 4 ? 0 : 1);
    LAS bf16_t* Sb = (LAS bf16_t*)(F.lds);
    LAS bf16_t* Vn = (LAS bf16_t*)(F.lds + 8704);
    LAS float* nvec = (LAS float*)(F.lds + 13312);
    LAS float* den = (LAS float*)(F.lds + 13824);
    const bf16_t* P = (const bf16_t*)(F.ws + WS_P); const bf16_t* Q = (const bf16_t*)(F.ws + WS_QKV);
    const bf16_t* vsrc; int vld;
    if (kind == 0) { vsrc = Q + 1024 + hh * 128; vld = 1536; } else if (kind == 1) { vsrc = P + 3072 + (hh - 4) * 128; vld = NIN_E; } else { vsrc = P + 1024 + hh * 128; vld = NIN_O; }
    const int h = F.lane >> 5, l31 = F.lane & 31;
    for (int i = F.tid; i < 32 * 136 / 2; i += NTHREADS) ((LAS unsigned*)Sb)[i] = 0u;
    if (F.tid < 128) nvec[F.tid] = 0.f;
    f32x16 accS;
#pragma unroll
    for (int r = 0; r < 16; ++r) accS[r] = 0.f;
    __syncthreads();
    float* Obase = (float*)(F.ws + WS_O) + (size_t)d * MROWS * 1024 + hh * 128 + 32 * sl + l31;
    for (int n = 0; n < NCH; ++n) {
        const int p = chain * NCH + n;
        const float* CS = (const float*)(F.ws + WS_CLS) + (size_t)p * 256;
        f32x16 acc;
        if (F.wave < 2) {
            const int mt_ = F.wave;
            if (kind == 0) { const int pg = ((b * 4 + hh) * 2 + d) * NCH + n; const float* U = (const float*)(F.ws + WS_CLU) + (size_t)pg * 8192 + 32 * sl + l31;
#pragma unroll
                for (int r = 0; r < 16; ++r) acc[r] = U[(32 * mt_ + 8 * (r >> 2) + 4 * h + (r & 3)) * 128];
                const bf16_t* W = (const bf16_t*)(F.ws + WS_CLW) + (size_t)p * 8192 + (size_t)(32 * mt_ + l31) * 128 + 8 * h;
#pragma unroll
                for (int s = 0; s < 8; ++s) { const bf16x8 a = *(const bf16x8*)(W + 16 * s); const bf16x8 bb = *(const LAS bf16x8*)(Sb + l31 * 136 + 16 * s + 8 * h); acc = mfma32(a, bb, acc); }
            } else {
#pragma unroll
                for (int r = 0; r < 16; ++r) { const int i = 32 * mt_ + 8 * (r >> 2) + 4 * h + (r & 3); acc[r] = bf2f(vsrc[(size_t)tok_row(b, d, n * 64 + i) * vld + 32 * sl + l31]); }
            }
#pragma unroll
            for (int g4 = 0; g4 < 4; ++g4) *(LAS u32x2*)(Vn + l31 * 72 + 32 * mt_ + 8 * g4 + 4 * h) = (u32x2){pk2(acc[4 * g4], acc[4 * g4 + 1]), pk2(acc[4 * g4 + 2], acc[4 * g4 + 3])};
        } else if (F.wave < 4) {
            const int mt_ = F.wave - 2;
#pragma unroll
            for (int r = 0; r < 16; ++r) acc[r] = 0.f;
            const bf16_t* QD = (const bf16_t*)(F.ws + WS_CLQ) + (size_t)p * 8192 + (size_t)(32 * mt_ + l31) * 128 + 8 * h;
#pragma unroll
            for (int s = 0; s < 8; ++s) { const bf16x8 a = *(const bf16x8*)(QD + 16 * s); const bf16x8 bb = *(const LAS bf16x8*)(Sb + l31 * 136 + 16 * s + 8 * h); acc = mfma32(a, bb, acc); }
        } else if (kind == 2) {
            const int t = F.tid - 256, i = t >> 2, q = t & 3; const bf16_t* QD = (const bf16_t*)(F.ws + WS_CLQ) + (size_t)p * 8192 + (size_t)i * 128 + 32 * q; float s = 0.f;
#pragma unroll
            for (int c8 = 0; c8 < 4; ++c8) { const u32x4 w = *(const u32x4*)(QD + 8 * c8); const LAS float* nv = nvec + 32 * q + 8 * c8;
                s += bflo(w.x) * nv[0] + bfhi(w.x) * nv[1] + bflo(w.y) * nv[2] + bfhi(w.y) * nv[3] + bflo(w.z) * nv[4] + bfhi(w.z) * nv[5] + bflo(w.w) * nv[6] + bfhi(w.w) * nv[7]; }
            s += shfl_xor_t(s, 1); s += shfl_xor_t(s, 2);
            if (q == 0) den[i] = CS[64 + i] + s;
        }
        __syncthreads();
        if (F.wave >= 2 && F.wave < 4) {
            const int mt_ = F.wave - 2;
            const bf16_t* AQ = (const bf16_t*)(F.ws + WS_CLA) + (size_t)p * 4096 + (size_t)(32 * mt_ + l31) * 64 + 8 * h;
#pragma unroll
            for (int s = 0; s < 4; ++s) { const bf16x8 a = *(const bf16x8*)(AQ + 16 * s); const bf16x8 bb = *(const LAS bf16x8*)(Vn + l31 * 72 + 16 * s + 8 * h); acc = mfma32(a, bb, acc); }
#pragma unroll
            for (int r = 0; r < 16; ++r) { const int i = 32 * mt_ + 8 * (r >> 2) + 4 * h + (r & 3); float v = acc[r];
                if (kind == 2) v = v / fmaxf(fabsf(den[i]), CS[128 + i]);
                Obase[(size_t)tok_row(b, d, n * 64 + i) * 1024] = v; }
        } else if (F.wave >= 4) {
            const int kb = F.wave - 4; const float ge = CS[0];
#pragma unroll
            for (int r = 0; r < 16; ++r) accS[r] *= ge;
            const bf16_t* KT = (const bf16_t*)(F.ws + WS_CLK) + (size_t)p * 8192 + (size_t)(32 * kb + l31) * 64 + 8 * h;
#pragma unroll
            for (int s = 0; s < 4; ++s) { const bf16x8 a = *(const bf16x8*)(KT + 16 * s); const bf16x8 bb = *(const LAS bf16x8*)(Vn + l31 * 72 + 16 * s + 8 * h); accS = mfma32(a, bb, accS); }
#pragma unroll
            for (int g4 = 0; g4 < 4; ++g4) *(LAS u32x2*)(Sb + l31 * 136 + 32 * kb + 8 * g4 + 4 * h) = (u32x2){pk2(accS[4 * g4], accS[4 * g4 + 1]), pk2(accS[4 * g4 + 2], accS[4 * g4 + 3])};
            if (kind == 2 && F.tid < 256 + 128) { const int dd = F.tid - 256; const bf16_t* KR = (const bf16_t*)(F.ws + WS_CLK) + (size_t)p * 8192 + (size_t)dd * 64; float s = 0.f;
#pragma unroll
                for (int c8 = 0; c8 < 8; ++c8) { const u32x4 w = *(const u32x4*)(KR + 8 * c8); s += (bflo(w.x) + bfhi(w.x)) + (bflo(w.y) + bfhi(w.y)) + (bflo(w.z) + bfhi(w.z)) + (bflo(w.w) + bfhi(w.w)); }
                nvec[dd] = ge * nvec[dd] + s; }
        }
        __syncthreads();
    }
}

DEV void seq_s5_item(const Frame& F, int l, int item) {
    const int o = l >> 1; const int g = item & 31, d = (item >> 5) & 1, b = item >> 6;
    LAS float* El = (LAS float*)(F.lds);
    LAS float* scr = (LAS float*)(F.lds + 36864 + F.wave * 8192);
    LAS bf16_t* hb = (LAS bf16_t*)(F.lds + 36864 + 65536 + F.wave * 4096);
    const bf16_t* P = (const bf16_t*)(F.ws + WS_P);
    const float* Ab = (const float*)(F.ws + WS_S5A) + (size_t)((o * 2 + d) * 32 + g) * 128;
    const bf16_t* Bb = (const bf16_t*)(F.ws + WS_S5B) + (size_t)((o * 2 + d) * 32 + g) * 128 * 16;
    const bf16_t* Cm = (const bf16_t*)(F.ws + WS_S5C) + (size_t)(o * 32 + g) * 16 * 128;
    const int l15 = F.lane & 15, kg = F.lane >> 4;
    const float ar = Ab[F.lane], ai = Ab[64 + F.lane];
    bf16x8 bB[8], cB[4]; const bf16x8 zero8 = (bf16x8){0, 0, 0, 0, 0, 0, 0, 0};
#pragma unroll
    for (int ct = 0; ct < 8; ++ct) bB[ct] = kg < 2 ? *(const bf16x8*)(Bb + (size_t)(16 * ct + l15) * 16 + 8 * kg) : zero8;
#pragma unroll
    for (int s = 0; s < 4; ++s) cB[s] = *(const bf16x8*)(Cm + (size_t)l15 * 128 + 32 * s + 8 * kg);
    float* Obase = (float*)(F.ws + WS_O) + (size_t)d * MROWS * 1024 + 512 + 16 * g;
    for (int pass = 0; pass < 2; ++pass) {
        for (int n = F.wave; n < NCH; n += NWAVES) {
            float hr = 0.f, hi = 0.f;
            if (pass) { hr = El[n * 128 + F.lane]; hi = El[n * 128 + 64 + F.lane]; }
            for (int st = 0; st < 4; ++st) {
                const int sp0 = n * 64 + 16 * st;
                const bf16x8 a = kg < 2 ? *(const bf16x8*)(P + (size_t)tok_row(b, d, sp0 + l15) * NIN_O + 2048 + 16 * g + 8 * kg) : zero8;
#pragma unroll
                for (int ct = 0; ct < 8; ++ct) { f32x4 acc = (f32x4){0.f, 0.f, 0.f, 0.f}; acc = mfma16(a, bB[ct], acc);
#pragma unroll
                    for (int r = 0; r < 4; ++r) scr[(4 * kg + r) * 128 + 16 * ct + l15] = acc[r]; }
                WAVE_LDS_SYNC();
#pragma unroll
                for (int t = 0; t < 16; ++t) { const float br = scr[t * 128 + F.lane], bi = scr[t * 128 + 64 + F.lane];
                    const float nr = ar * hr - ai * hi + br, ni = ar * hi + ai * hr + bi; hr = nr; hi = ni;
                    if (pass) { hb[t * 128 + F.lane] = (bf16_t)f2bf(hr); hb[t * 128 + 64 + F.lane] = (bf16_t)f2bf(hi); } }
                WAVE_LDS_SYNC();
                if (pass) { f32x4 acc = (f32x4){0.f, 0.f, 0.f, 0.f};
#pragma unroll
                    for (int s = 0; s < 4; ++s) { const bf16x8 ha = *(const LAS bf16x8*)(hb + l15 * 128 + 32 * s + 8 * kg); acc = mfma16(ha, cB[s], acc); }
#pragma unroll
                    for (int r = 0; r < 4; ++r) Obase[(size_t)tok_row(b, d, sp0 + 4 * kg + r) * 1024 + l15] = acc[r];
                    WAVE_LDS_SYNC(); }
            }
            if (!pass) { El[n * 128 + F.lane] = hr; El[n * 128 + 64 + F.lane] = hi; }
        }
        __syncthreads();
        if (!pass) {
            if (F.wave == 0) { float pr = ar, pi = ai;
#pragma unroll
                for (int q = 0; q < 6; ++q) { const float nr = pr * pr - pi * pi, ni = 2.0f * pr * pi; pr = nr; pi = ni; }
                float hr = 0.f, hi = 0.f;
                for (int n = 0; n < NCH; ++n) { const float er = El[n * 128 + F.lane], ei = El[n * 128 + 64 + F.lane];
                    El[n * 128 + F.lane] = hr; El[n * 128 + 64 + F.lane] = hi;
                    const float nr = pr * hr - pi * hi + er, ni = pr * hi + pi * hr + ei; hr = nr; hi = ni; } }
            __syncthreads();
        }
    }
}

DEV void phase_seq(const Frame& F0, int l) {
    const Frame F = refresh(F0);
    const int odd = l & 1; const int nlin = B_ * (odd ? 4 : 8) * 2 * 4; const int ns5 = odd ? B_ * 2 * 32 : 0;
    for (int it = F.bid; it < nlin + ns5; it += F.G) {
        if (it < nlin) seq_linear_item(F, l, it); else seq_s5_item(F, l, it - nlin);
        __syncthreads();
    }
}

DEV void phase_merge(const Frame& F0, int l) {
    const Frame F = refresh(F0);
    const int odd = l & 1, li = l >> 1; const bf16_t* P = (const bf16_t*)(F.ws + WS_P);
    const float* O0 = (const float*)(F.ws + WS_O); const float* O1 = O0 + (size_t)MROWS * 1024;
    bf16_t* MG = (bf16_t*)(F.ws + WS_MERGED);
    for (int r = F.gw; r < MROWS; r += F.NGW) {
        if (!odd) {
            const int c0 = 16 * F.lane; float v[16];
#pragma unroll
            for (int q = 0; q < 4; ++q) { const f32x4 a = *(const f32x4*)(O0 + (size_t)r * 1024 + c0 + 4 * q), bq = *(const f32x4*)(O1 + (size_t)r * 1024 + c0 + 4 * q);
                v[4 * q] = a.x + bq.x; v[4 * q + 1] = a.y + bq.y; v[4 * q + 2] = a.z + bq.z; v[4 * q + 3] = a.w + bq.w; }
            float s = 0.f;
#pragma unroll
            for (int i = 0; i < 16; ++i) s += v[i];
            s += shfl_xor_t(s, 1); s += shfl_xor_t(s, 2); s += shfl_xor_t(s, 4);
            const bool ret = F.lane >= 32; const float mu = ret ? s * (1.0f / 128.0f) : 0.f; float q2 = 0.f;
#pragma unroll
            for (int i = 0; i < 16; ++i) { v[i] -= mu; q2 += v[i] * v[i]; }
            q2 += shfl_xor_t(q2, 1); q2 += shfl_xor_t(q2, 2); q2 += shfl_xor_t(q2, 4);
            const float rstd = 1.0f / sqrtf(q2 * (1.0f / 128.0f) + LN_EPS);
            const bf16_t* zp = P + (size_t)r * NIN_E + (ret ? 3584 + (c0 - 512) : 1536 + c0);
            const float* gp = ret ? F.in[I_EVRETN] + li * 512 + (c0 - 512) : F.in[I_EVGDNN] + li * 128 + (c0 & 127);
            unsigned ow[8];
#pragma unroll
            for (int i = 0; i < 16; i += 2) { const float z0 = bf2f(zp[i]), z1 = bf2f(zp[i + 1]); ow[i >> 1] = pk2(v[i] * rstd * gp[i] * silu_f(z0), v[i + 1] * rstd * gp[i + 1] * silu_f(z1)); }
            u32x4* op = (u32x4*)(MG + (size_t)r * 1024 + c0); op[0] = (u32x4){ow[0], ow[1], ow[2], ow[3]}; op[1] = (u32x4){ow[4], ow[5], ow[6], ow[7]};
        } else {
            const int c0 = 8 * F.lane; float v[8];
#pragma unroll
            for (int q = 0; q < 2; ++q) { const f32x4 a = *(const f32x4*)(O0 + (size_t)r * 1024 + c0 + 4 * q), bq = *(const f32x4*)(O1 + (size_t)r * 1024 + c0 + 4 * q);
                v[4 * q] = a.x + bq.x; v[4 * q + 1] = a.y + bq.y; v[4 * q + 2] = a.z + bq.z; v[4 * q + 3] = a.w + bq.w; }
            float s = 0.f;
#pragma unroll
            for (int i = 0; i < 8; ++i) s += v[i];
            s += shfl_xor_t(s, 1); s += shfl_xor_t(s, 2); s += shfl_xor_t(s, 4); s += shfl_xor_t(s, 8);
            const float mu = s * (1.0f / 128.0f); float q2 = 0.f;
#pragma unroll
            for (int i = 0; i < 8; ++i) { v[i] -= mu; q2 += v[i] * v[i]; }
            q2 += shfl_xor_t(q2, 1); q2 += shfl_xor_t(q2, 2); q2 += shfl_xor_t(q2, 4); q2 += shfl_xor_t(q2, 8);
            const float rstd = 1.0f / sqrtf(q2 * (1.0f / 128.0f) + LN_EPS);
            const bf16_t* zp = P + (size_t)r * NIN_O + 1536 + c0; const float* gp = F.in[I_ODMN] + li * 512 + c0;
            unsigned ow[4];
#pragma unroll
            for (int i = 0; i < 8; i += 2) ow[i >> 1] = pk2(v[i] * rstd * gp[i] * sigmoid_f(bf2f(zp[i])), v[i + 1] * rstd * gp[i + 1] * sigmoid_f(bf2f(zp[i + 1])));
            *(u32x4*)(MG + (size_t)r * 1024 + c0) = (u32x4){ow[0], ow[1], ow[2], ow[3]};
            const bf16_t* up = P + (size_t)r * NIN_O + 2048 + c0; const float* dsk = F.in[I_ODDSKIP] + li * 512 + c0;
#pragma unroll
            for (int q = 0; q < 2; ++q) { const f32x4 a = *(const f32x4*)(O0 + (size_t)r * 1024 + 512 + c0 + 4 * q), bq = *(const f32x4*)(O1 + (size_t)r * 1024 + 512 + c0 + 4 * q);
                v[4 * q] = a.x + bq.x; v[4 * q + 1] = a.y + bq.y; v[4 * q + 2] = a.z + bq.z; v[4 * q + 3] = a.w + bq.w; }
#pragma unroll
            for (int i = 0; i < 8; i += 2) ow[i >> 1] = pk2(gelu_tanh_f(v[i] + dsk[i] * bf2f(up[i])), gelu_tanh_f(v[i + 1] + dsk[i + 1] * bf2f(up[i + 1])));
            *(u32x4*)((bf16_t*)(F.ws + WS_YS) + (size_t)r * 512 + c0) = (u32x4){ow[0], ow[1], ow[2], ow[3]};
        }
    }
}

DEV void phase_ln1(const Frame& F0, int l) {
    const Frame F = refresh(F0);
    const float* Y = (const float*)(F.ws + WS_Y); float* H = (float*)(F.ws + WS_H);
    const float* lg = F.in[I_LN1G] + l * 1024; const float* lb = F.in[I_LN1B] + l * 1024; const float* wr = F.in[I_WROUTER] + (size_t)l * 1024 * NE;
    for (int r = F.gw; r < MROWS; r += F.NGW) {
        const int b = r / TOK, s = r % TOK, mr = s < CTX ? B_ : b; const float* mod = (const float*)(F.ws + WS_MOD) + ((size_t)l * NR + mr) * 6144;
        f32x4 t[4]; float sum = 0.f;
#pragma unroll
        for (int j = 0; j < 4; ++j) { const f32x4 hv = *((const f32x4*)(H + (size_t)r * 1024) + F.lane + 64 * j), yv = *((const f32x4*)(Y + (size_t)r * 1024) + F.lane + 64 * j), g1 = *((const f32x4*)(mod + 2048) + F.lane + 64 * j);
            t[j] = ALPHA * hv + g1 * yv; sum += (t[j].x + t[j].y) + (t[j].z + t[j].w); }
        const float mean = wave_sum(sum) * (1.0f / 1024.0f); float s2 = 0.f;
#pragma unroll
        for (int j = 0; j < 4; ++j) { t[j] = t[j] - mean; s2 += (t[j].x * t[j].x + t[j].y * t[j].y) + (t[j].z * t[j].z + t[j].w * t[j].w); }
        const float rstd = 1.0f / sqrtf(wave_sum(s2) * (1.0f / 1024.0f) + LN_EPS);
        f32x4 x[4];
#pragma unroll
        for (int j = 0; j < 4; ++j) { const f32x4 gg = *((const f32x4*)lg + F.lane + 64 * j), bb = *((const f32x4*)lb + F.lane + 64 * j); t[j] = t[j] * rstd * gg + bb;
            *((f32x4*)(H + (size_t)r * 1024) + F.lane + 64 * j) = t[j];
            const f32x4 sh = *((const f32x4*)(mod + 3072) + F.lane + 64 * j), scv = *((const f32x4*)(mod + 4096) + F.lane + 64 * j); x[j] = t[j] * (1.0f + scv) + sh; }
        u32x2* xo = (u32x2*)((bf16_t*)(F.ws + WS_XIN) + (size_t)r * 1024) + F.lane;
#pragma unroll
        for (int j = 0; j < 4; ++j) xo[64 * j] = (u32x2){pk2(x[j].x, x[j].y), pk2(x[j].z, x[j].w)};
        float lgt[NE];
#pragma unroll
        for (int e = 0; e < NE; ++e) lgt[e] = 0.f;
#pragma unroll
        for (int j = 0; j < 4; ++j)
#pragma unroll
            for (int q = 0; q < 4; ++q) { const float xv = x[j][q]; const float* wrow = wr + (size_t)(4 * F.lane + 256 * j + q) * NE;
#pragma unroll
                for (int e = 0; e < NE; ++e) lgt[e] += xv * wrow[e]; }
        float mx = -1e30f;
#pragma unroll
        for (int e = 0; e < NE; ++e) { lgt[e] = wave_sum(lgt[e]); mx = fmaxf(mx, lgt[e]); }
        float se = 0.f;
#pragma unroll
        for (int e = 0; e < NE; ++e) { lgt[e] = expf(lgt[e] - mx); se += lgt[e]; }
        float mine = 0.f;
#pragma unroll
        for (int e = 0; e < NE; ++e) mine = ((F.lane % NE) == e) ? lgt[e] : mine;
        if (F.lane < NE) ((float*)(F.ws + WS_AFF))[(size_t)r * 16 + F.lane] = mine / se;
    }
}

DEV void phase_topk(const Frame& F0) {
    const Frame F = refresh(F0);
    LAS unsigned* hist = (LAS unsigned*)(F.lds);
    LAS unsigned* selw = (LAS unsigned*)(F.lds + 1024);
    LAS unsigned* cnt = (LAS unsigned*)(F.lds + 2048);
    LAS int* selrow = (LAS int*)(F.lds + 8192);
    const float* AFF = (const float*)(F.ws + WS_AFF); int* SLOT = (int*)(F.ws + WS_SLOT); float* EG = (float*)(F.ws + WS_EGATE);
    for (int it = F.bid; it < 2 * B_ * NE; it += F.G) {
        const int e = it % NE, set = it / NE, kind = set / B_, b = set % B_;
        const int n = kind ? CTX : SEQ, cap = kind ? CAPC : CAPL; const int row0 = b * TOK + (kind ? 0 : CTX);
        const int sbase = kind ? B_ * CAPL + b * CAPC : b * CAPL;
        const int per = n >= NTHREADS ? n / NTHREADS : 1; const bool act = F.tid * per < n;
        unsigned key[8];
#pragma unroll
        for (int k = 0; k < 8; ++k) key[k] = (act && k < per) ? __builtin_bit_cast(unsigned, AFF[(size_t)(row0 + F.tid * per + k) * 16 + e]) : 0u;
        unsigned prefix = 0u, remaining = (unsigned)cap;
        for (int pass = 0; pass < 4; ++pass) {
            const int shift = 24 - 8 * pass; const unsigned mask = pass == 0 ? 0u : (0xFFFFFFFFu << (shift + 8));
            if (F.tid < 256) hist[F.tid] = 0u;
            __syncthreads();
#pragma unroll
            for (int k = 0; k < 8; ++k) if (act && k < per && ((key[k] & mask) == (prefix & mask))) lds_atomic_add(&hist[(key[k] >> shift) & 255u], 1u);
            __syncthreads();
            if (F.tid == 0) { unsigned cum = 0u; int dsel = 0;
                for (int dgt = 255; dgt >= 0; --dgt) { const unsigned hc = hist[dgt]; if (cum + hc >= remaining) { dsel = dgt; break; } cum += hc; }
                selw[0] = prefix | ((unsigned)dsel << shift); selw[1] = remaining - cum; }
            __syncthreads();
            prefix = selw[0]; remaining = selw[1];
            __syncthreads();
        }
        const unsigned T = prefix, need_eq = remaining;
        unsigned ngt = 0u, neq = 0u;
#pragma unroll
        for (int k = 0; k < 8; ++k) if (act && k < per) { ngt += key[k] > T ? 1u : 0u; neq += key[k] == T ? 1u : 0u; }
        cnt[2 * F.tid] = ngt; cnt[2 * F.tid + 1] = neq;
        __syncthreads();
        if (F.tid == 0) { unsigned a = 0u, c = 0u; for (int t = 0; t < NTHREADS; ++t) { const unsigned x = cnt[2 * t], y = cnt[2 * t + 1]; cnt[2 * t] = a; cnt[2 * t + 1] = c; a += x; c += y; } }
        __syncthreads();
        unsigned gtb = cnt[2 * F.tid], eqb = cnt[2 * F.tid + 1];
#pragma unroll
        for (int k = 0; k < 8; ++k) if (act && k < per) {
            const int row = row0 + F.tid * per + k; int slot = -1;
            const bool isgt = key[k] > T, iseq = key[k] == T;
            if (isgt || (iseq && eqb < need_eq)) { slot = (int)(gtb + (eqb < need_eq ? eqb : need_eq)); selrow[slot] = row; EG[(size_t)e * EPAD + sbase + slot] = __builtin_bit_cast(float, key[k]); }
            SLOT[(size_t)row * 16 + e] = slot >= 0 ? sbase + slot : -1;
            gtb += isgt ? 1u : 0u; eqb += iseq ? 1u : 0u;
        }
        __syncthreads();
        for (int sl = F.wave; sl < cap; sl += NWAVES) { const int row = selrow[sl];
            const u32x4* src = (const u32x4*)((const bf16_t*)(F.ws + WS_XIN) + (size_t)row * 1024) + F.lane; u32x4* dst = (u32x4*)((bf16_t*)(F.ws + WS_XS) + ((size_t)e * EPAD + sbase + sl) * 1024) + F.lane;
            dst[0] = src[0]; dst[64] = src[64]; }
        if (it < NE) {
            for (int pr = EROWS + F.wave; pr < EPAD; pr += NWAVES) { u32x4* dst = (u32x4*)((bf16_t*)(F.ws + WS_XS) + ((size_t)e * EPAD + pr) * 1024) + F.lane; dst[0] = (u32x4){0u, 0u, 0u, 0u}; dst[64] = (u32x4){0u, 0u, 0u, 0u}; }
            for (int pr = EROWS + F.tid; pr < EPAD; pr += NTHREADS) EG[(size_t)e * EPAD + pr] = 0.f;
        }
        __syncthreads();
    }
}

DEV void phase_ln2(const Frame& F0, int l) {
    const Frame F = refresh(F0);
    float* H = (float*)(F.ws + WS_H); const int* SLOT = (const int*)(F.ws + WS_SLOT); const float* YSE = (const float*)(F.ws + WS_YSE);
    const float* lg = F.in[I_LN2G] + l * 1024; const float* lb = F.in[I_LN2B] + l * 1024;
    for (int r = F.gw; r < MROWS; r += F.NGW) {
        const int b = r / TOK, s = r % TOK, mr = s < CTX ? B_ : b; const float* mod = (const float*)(F.ws + WS_MOD) + ((size_t)l * NR + mr) * 6144;
        f32x4 f[4];
#pragma unroll
        for (int j = 0; j < 4; ++j) f[j] = (f32x4){0.f, 0.f, 0.f, 0.f};
        const int myslot = F.lane < NE ? SLOT[(size_t)r * 16 + F.lane] : -1;
        for (int e = 0; e < NE; ++e) { const int sl = shfl_t(myslot, e);
            if (sl >= 0) { const f32x4* yp = (const f32x4*)(YSE + ((size_t)e * EPAD + sl) * 1024) + F.lane;
#pragma unroll
                for (int j = 0; j < 4; ++j) f[j] += yp[64 * j]; } }
        f32x4 t[4]; float sum = 0.f;
#pragma unroll
        for (int j = 0; j < 4; ++j) { const f32x4 hv = *((const f32x4*)(H + (size_t)r * 1024) + F.lane + 64 * j), g2 = *((const f32x4*)(mod + 5120) + F.lane + 64 * j);
            t[j] = ALPHA * hv + g2 * f[j]; sum += (t[j].x + t[j].y) + (t[j].z + t[j].w); }
        const float mean = wave_sum(sum) * (1.0f / 1024.0f); float s2 = 0.f;
#pragma unroll
        for (int j = 0; j < 4; ++j) { t[j] = t[j] - mean; s2 += (t[j].x * t[j].x + t[j].y * t[j].y) + (t[j].z * t[j].z + t[j].w * t[j].w); }
        const float rstd = 1.0f / sqrtf(wave_sum(s2) * (1.0f / 1024.0f) + LN_EPS);
#pragma unroll
        for (int j = 0; j < 4; ++j) { const f32x4 gg = *((const f32x4*)lg + F.lane + 64 * j), bb = *((const f32x4*)lb + F.lane + 64 * j); t[j] = t[j] * rstd * gg + bb; }
        if (l == DEPTH - 1) {
            if (s >= CTX) { f32x4* op = (f32x4*)(F.out + ((size_t)b * SEQ + (s - CTX)) * 1024) + F.lane;
#pragma unroll
                for (int j = 0; j < 4; ++j) op[64 * j] = t[j]; }
        } else {
#pragma unroll
            for (int j = 0; j < 4; ++j) *((f32x4*)(H + (size_t)r * 1024) + F.lane + 64 * j) = t[j];
            xg_row(F, l + 1, r, t);
        }
    }
}

struct EpiP {
    static constexpr bool PERM = true;
    bf16_t* O; int ldc;
    DEV void operator()(const f32x4 (&acc)[2][2][4][2], const pg8::Unit& u, int wr, int wc, int fr, int fq) const {
        const int row0 = u.pm * 256 + wr * 64 + fr, col0 = u.pn * 256 + wc * 32 + 8 * fq;
#pragma unroll
        for (int ai = 0; ai < 2; ++ai)
#pragma unroll
            for (int m = 0; m < 4; ++m) { bf16_t* rowp = O + (size_t)(row0 + ai * 128 + m * 16) * ldc + col0;
#pragma unroll
                for (int bj = 0; bj < 2; ++bj) { const f32x4 v0 = acc[ai][bj][m][0], v1 = acc[ai][bj][m][1];
                    u32x4 w; w.x = pg8::cvt_pk_bf16(v0[0], v0[1]); w.y = pg8::cvt_pk_bf16(v0[2], v0[3]); w.z = pg8::cvt_pk_bf16(v1[0], v1[1]); w.w = pg8::cvt_pk_bf16(v1[2], v1[3]);
                    *(u32x4*)(rowp + bj * 128) = w; } }
    }
};
struct EpiGlu {
    static constexpr bool PERM = true;
    bf16_t* MG; const bf16_t* YS; const float* bias;
    DEV void operator()(const f32x4 (&acc)[2][2][4][2], const pg8::Unit& u, int wr, int wc, int fr, int fq) const {
        const int row0 = u.pm * 256 + wr * 64 + fr, col0 = u.pn * 256 + wc * 32 + 8 * fq;
#pragma unroll
        for (int ai = 0; ai < 2; ++ai)
#pragma unroll
            for (int m = 0; m < 4; ++m) { const int row = row0 + ai * 128 + m * 16;
#pragma unroll
                for (int bj = 0; bj < 2; ++bj) { const int c = col0 + bj * 128; const f32x4 v0 = acc[ai][bj][m][0], v1 = acc[ai][bj][m][1];
                    const u32x4 yv = *(const u32x4*)(YS + (size_t)row * 512 + c); const f32x4 b0 = *(const f32x4*)(bias + c), b1 = *(const f32x4*)(bias + c + 4);
                    u32x4 w; w.x = pk2(bflo(yv.x) * sigmoid_f(v0[0] + b0[0]), bfhi(yv.x) * sigmoid_f(v0[1] + b0[1])); w.y = pk2(bflo(yv.y) * sigmoid_f(v0[2] + b0[2]), bfhi(yv.y) * sigmoid_f(v0[3] + b0[3]));
                    w.z = pk2(bflo(yv.z) * sigmoid_f(v1[0] + b1[0]), bfhi(yv.z) * sigmoid_f(v1[1] + b1[1])); w.w = pk2(bflo(yv.w) * sigmoid_f(v1[2] + b1[2]), bfhi(yv.w) * sigmoid_f(v1[3] + b1[3]));
                    *(u32x4*)(MG + (size_t)row * 1024 + 512 + c) = w; } }
    }
};
struct EpiF32 {
    static constexpr bool PERM = false;
    float* C; int ldc; const float* rowscale;
    DEV void operator()(const f32x4 (&acc)[2][2][4][2], const pg8::Unit& u, int wr, int wc, int fr, int fq) const {
        const int row0 = u.pm * 256 + wr * 64 + fr, col0 = u.pn * 256 + wc * 32 + 4 * fq;
        const size_t ebase = rowscale ? (size_t)u.e * EPAD : 0;
#pragma unroll
        for (int ai = 0; ai < 2; ++ai)
#pragma unroll
            for (int m = 0; m < 4; ++m) { const size_t row = ebase + row0 + ai * 128 + m * 16; const float sc = rowscale ? rowscale[row] : 1.0f; float* rowp = C + row * ldc + col0;
#pragma unroll
                for (int bj = 0; bj < 2; ++bj)
#pragma unroll
                    for (int n = 0; n < 2; ++n) *(f32x4*)(rowp + bj * 128 + n * 16) = acc[ai][bj][m][n] * sc; }
    }
};
struct EpiSwiglu {
    static constexpr bool PERM = true;
    bf16_t* HID;
    DEV void operator()(const f32x4 (&acc)[2][2][4][2], const pg8::Unit& u, int wr, int wc, int fr, int fq) const {
        const int row0 = u.pm * 256 + wr * 64 + fr, col0 = u.pn * 128 + wc * 32 + 8 * fq;
#pragma unroll
        for (int ai = 0; ai < 2; ++ai)
#pragma unroll
            for (int m = 0; m < 4; ++m) { bf16_t* rowp = HID + ((size_t)u.e * EPAD + row0 + ai * 128 + m * 16) * FF + col0;
                const f32x4 g0 = acc[ai][0][m][0], g1 = acc[ai][0][m][1], u0 = acc[ai][1][m][0], u1 = acc[ai][1][m][1];
                u32x4 w; w.x = pk2(silu_f(g0[0]) * u0[0], silu_f(g0[1]) * u0[1]); w.y = pk2(silu_f(g0[2]) * u0[2], silu_f(g0[3]) * u0[3]);
                w.z = pk2(silu_f(g1[0]) * u1[0], silu_f(g1[1]) * u1[1]); w.w = pk2(silu_f(g1[2]) * u1[2], silu_f(g1[3]) * u1[3]);
                *(u32x4*)rowp = w; }
    }
};

__global__ void __launch_bounds__(NTHREADS, 2) mega_fwd(Args args) {
#ifdef EMU
    LAS unsigned char* lds = emu::lds();
#else
    extern __shared__ __attribute__((aligned(16))) unsigned char lds_raw[];
    LAS unsigned char* lds = (LAS unsigned char*)lds_raw;
#endif
    Frame F;
    F.in = args.in; F.out = args.out; F.ws = args.ws; F.lds = lds;
    F.tid = threadIdx.x; F.lane = F.tid & 63; F.wave = readfirstlane_i(F.tid >> 6); F.G = gridDim.x; F.bid = blockIdx.x;
    F.gw = F.bid * NWAVES + F.wave; F.NGW = F.G * NWAVES;
    for (int u = F.tid; u < (LDS_BYTES - LDS_MISC) / 4; u += NTHREADS) ((LAS unsigned*)(lds + LDS_MISC))[u] = 0u;
    __syncthreads();
    XcdBarrier bar = xcd_barrier_post((unsigned*)(F.ws + WS_CTL), (volatile LAS unsigned*)(lds + LDS_MISC));
#define GRID_BAR() xcd_barrier(bar)
    const int vcu = (F.G % 8 == 0) ? (F.bid % 8) * (F.G / 8) + F.bid / 8 : F.bid;

#ifndef PHASE_MASK
#define PHASE_MASK 0xFFFFF
#endif
#define PH(k) if ((PHASE_MASK >> (k)) & 1)
    PH(0) phase_prologue_a(F);
    GRID_BAR();
    PH(1) phase_xg0(F);
    GRID_BAR();
    for (int l = 0; l < DEPTH; ++l) {
        const int odd = l & 1, li = l >> 1; const int nin = odd ? NIN_O : NIN_E;
        PH(2) {
            pg8::PlainOrder S; S.init(F.ws + WS_XIN, (const bf16_t*)(F.ws + WS_WIN) + (size_t)l * NINMAX * 1024, 1024, MPAD, nin, F.G, vcu);
            EpiP E; E.O = (bf16_t*)(F.ws + WS_P); E.ldc = nin;
            pg8::gemm_phase(lds, 1024, S, E);
        }
        GRID_BAR();
        PH(3) phase_prep(F, l);
        GRID_BAR();
        PH(4) phase_cl(F, l);
        GRID_BAR();
        PH(5) phase_seq(F, l);
        GRID_BAR();
        PH(6) phase_merge(F, l);
        GRID_BAR();
        PH(7) if (odd) {
            pg8::PlainOrder S; S.init(F.ws + WS_YS, (const bf16_t*)(F.ws + WS_WGLU) + (size_t)li * 512 * 512, 512, MPAD, 512, F.G, vcu);
            EpiGlu E; E.MG = (bf16_t*)(F.ws + WS_MERGED); E.YS = (const bf16_t*)(F.ws + WS_YS); E.bias = F.in[I_ODBGLU] + li * 512;
            pg8::gemm_phase(lds, 512, S, E);
            GRID_BAR();
        }
        PH(8) {
            pg8::PlainOrder S; S.init(F.ws + WS_MERGED, (const bf16_t*)(F.ws + WS_WOUT) + (size_t)l * 1024 * 1024, 1024, MPAD, 1024, F.G, vcu);
            EpiF32 E; E.C = (float*)(F.ws + WS_Y); E.ldc = 1024; E.rowscale = nullptr;
            pg8::gemm_phase(lds, 1024, S, E);
        }
        GRID_BAR();
        PH(9) phase_ln1(F, l);
        GRID_BAR();
        PH(10) phase_topk(F);
        GRID_BAR();
        PH(11) {
            pg8::GroupedOrder S; S.init(F.ws + WS_XS, (const bf16_t*)(F.ws + WS_WGU) + (size_t)l * NE * 2 * FF * 1024, 1024, 2 * FF, F.G, vcu);
            EpiSwiglu E; E.HID = (bf16_t*)(F.ws + WS_HID);
            pg8::gemm_phase(lds, 1024, S, E);
        }
        GRID_BAR();
        PH(12) {
            pg8::GroupedOrder S; S.init(F.ws + WS_HID, (const bf16_t*)(F.ws + WS_WD) + (size_t)l * NE * 1024 * FF, FF, 1024, F.G, vcu);
            EpiF32 E; E.C = (float*)(F.ws + WS_YSE); E.ldc = 1024; E.rowscale = (const float*)(F.ws + WS_EGATE);
            pg8::gemm_phase(lds, FF, S, E);
        }
        GRID_BAR();
        PH(13) phase_ln2(F, l);
        GRID_BAR();
    }
}

#ifndef EMU
extern "C" void kernel_launch(void* const* d_in, const int* in_sizes, int n_in, void* d_out, int out_size, void* d_ws, size_t ws_size, hipStream_t stream) {
    static int grid = 0;
    if (grid == 0) {
        if (n_in != N_IN || ws_size < WS_END) { fprintf(stderr, "kernel_launch: need %d inputs and %zu bytes of workspace; got %d, %zu\n", (int)N_IN, (size_t)WS_END, n_in, ws_size); grid = -1; return; }
        int dev = 0, cus = 0, per_cu = 0;
        if (hipGetDevice(&dev) != hipSuccess || hipDeviceGetAttribute(&cus, hipDeviceAttributeMultiprocessorCount, dev) != hipSuccess) { grid = -1; return; }
        if (hipFuncSetAttribute((const void*)mega_fwd, hipFuncAttributeMaxDynamicSharedMemorySize, LDS_BYTES) != hipSuccess) { fprintf(stderr, "kernel_launch: hipFuncSetAttribute failed\n"); grid = -1; return; }
        if (hipOccupancyMaxActiveBlocksPerMultiprocessor(&per_cu, (const void*)mega_fwd, NTHREADS, LDS_BYTES) != hipSuccess || per_cu < 1) { fprintf(stderr, "kernel_launch: occupancy query says %d\n", per_cu); }
        (void)hipGetLastError();
        grid = cus;
    }
    if (grid < 0) return;
    (void)hipMemsetAsync((char*)d_ws + WS_CTL, 0, CTL_BYTES, stream);
    Args a{};
    for (int i = 0; i < N_IN; ++i) a.in[i] = (const float*)d_in[i];
    a.out = (float*)d_out; a.ws = (unsigned char*)d_ws;
    hipLaunchKernelGGL(mega_fwd, dim3(grid), dim3(NTHREADS), LDS_BYTES, stream, a);
}
#endif
```

```cpp
#ifdef EMU
#include "emu.h"
#else
#include <hip/hip_runtime.h>
#endif
#include <cstdio>
#include <cstdint>
#include <cstddef>

#ifndef CFG_BATCH
#define CFG_BATCH 4
#define CFG_SEQ 4096
#define CFG_CTX 256
#define CFG_DEPTH 4
#define CFG_NEXP 16
#define CFG_FF 2048
#endif
constexpr int B_ = CFG_BATCH, SEQ = CFG_SEQ, CTX = CFG_CTX, DEPTH = CFG_DEPTH, NE = CFG_NEXP, FF = CFG_FF;
constexpr int D = 1024, TOK = CTX + SEQ, MROWS = B_ * TOK, MPAD = (MROWS + 255) / 256 * 256;
constexpr int NCH = TOK / 64;
constexpr int CAPL = 2 * SEQ / NE, CAPC = 2 * CTX / NE, EROWS = B_ * (CAPL + CAPC), EPAD = (EROWS + 255) / 256 * 256;
constexpr int NIN_E = 4096, NIN_O = 2560, NINMAX = 4096;
constexpr int N_EVEN = (DEPTH + 1) / 2, N_ODD = DEPTH / 2, N_ODDA = N_ODD > 0 ? N_ODD : 1;
constexpr int NR = B_ + 1;
constexpr float ALPHA = 1.681792830507429f;
constexpr float LN_EPS = 1e-5f;
constexpr float HD_SCALE = 0.08838834764831845f;
constexpr int NWAVES = 8, NTHREADS = 512;

enum { I_X = 0, I_C, I_CTX, I_CCTX, I_WMOD, I_BMOD, I_LN1G, I_LN1B, I_LN2G, I_LN2B, I_WROUTER, I_WGATE, I_WUP, I_WDOWN,
       I_EVWIN, I_EVWOUT, I_EVCONV, I_EVALOG, I_EVDTB, I_EVGDNN, I_EVRETN,
       I_ODWIN, I_ODWOUT, I_ODCONV, I_ODGB, I_ODMN, I_ODLRE, I_ODLIM, I_ODLDT, I_ODBRE, I_ODBIM, I_ODCRE, I_ODCIM, I_ODDSKIP, I_ODWGLU, I_ODBGLU, N_IN };

constexpr size_t al256(size_t x) { return (x + 255) & ~(size_t)255; }
constexpr size_t WS_CTL = 0, CTL_BYTES = 65536;
constexpr size_t WS_MOD = WS_CTL + CTL_BYTES;
constexpr size_t WS_WG = al256(WS_MOD + (size_t)DEPTH * NR * 6144 * 4);
constexpr size_t WS_WIN = al256(WS_WG + (size_t)DEPTH * 16 * 1024 * 4);
constexpr size_t WS_WOUT = al256(WS_WIN + (size_t)DEPTH * NINMAX * 1024 * 2);
constexpr size_t WS_WGLU = al256(WS_WOUT + (size_t)DEPTH * 1024 * 1024 * 2);
constexpr size_t WS_WGU = al256(WS_WGLU + (size_t)N_ODDA * 512 * 512 * 2);
constexpr size_t WS_WD = al256(WS_WGU + (size_t)DEPTH * NE * 2 * FF * 1024 * 2);
constexpr size_t WS_S5A = al256(WS_WD + (size_t)DEPTH * NE * 1024 * FF * 2);
constexpr size_t WS_S5B = al256(WS_S5A + (size_t)N_ODDA * 2 * 32 * 128 * 4);
constexpr size_t WS_S5C = al256(WS_S5B + (size_t)N_ODDA * 2 * 32 * 128 * 16 * 2);
constexpr size_t WS_H = al256(WS_S5C + (size_t)N_ODDA * 32 * 16 * 128 * 2);
constexpr size_t WS_XIN = al256(WS_H + (size_t)MPAD * 1024 * 4);
constexpr size_t WS_GATES = al256(WS_XIN + (size_t)MPAD * 1024 * 2);
constexpr size_t WS_MERGED = al256(WS_GATES + (size_t)MROWS * 16 * 4);
constexpr size_t WS_YS = al256(WS_MERGED + (size_t)MPAD * 1024 * 2);
constexpr size_t WS_Y = al256(WS_YS + (size_t)MPAD * 512 * 2);
constexpr size_t WS_AFF = al256(WS_Y + (size_t)MPAD * 1024 * 4);
constexpr size_t WS_SLOT = al256(WS_AFF + (size_t)MROWS * 16 * 4);
constexpr size_t WS_EGATE = al256(WS_SLOT + (size_t)MROWS * 16 * 4);
constexpr size_t WS_MCH = al256(WS_EGATE + (size_t)NE * EPAD * 4);
constexpr size_t WS_WR = al256(WS_MCH + (size_t)B_ * 4 * 2 * NCH * 4);
constexpr size_t WS_EIDX = al256(WS_WR + (size_t)DEPTH * NE * 1024 * 4);
constexpr size_t WS_R = al256(WS_EIDX + (size_t)NE * EPAD * 4);
constexpr int NCP = B_ * 8 * 2 * NCH, NCPG = B_ * 4 * 2 * NCH;
constexpr size_t WS_P = WS_R;
constexpr size_t WS_QKV = al256(WS_P + (size_t)MPAD * NINMAX * 2);
constexpr size_t WS_CLW = al256(WS_QKV + (size_t)MROWS * 1536 * 2);
constexpr size_t WS_CLQ = al256(WS_CLW + (size_t)NCP * 64 * 128 * 2);
constexpr size_t WS_CLK = al256(WS_CLQ + (size_t)NCP * 64 * 128 * 2);
constexpr size_t WS_CLA = al256(WS_CLK + (size_t)NCP * 64 * 128 * 2);
constexpr size_t WS_CLU = al256(WS_CLA + (size_t)NCP * 64 * 64 * 2);
constexpr size_t WS_CLS = al256(WS_CLU + (size_t)NCPG * 64 * 128 * 4);
constexpr size_t WS_O = al256(WS_CLS + (size_t)NCP * 512 * 4);
constexpr size_t WS_R_END1 = al256(WS_O + (size_t)2 * MROWS * 1024 * 4);
constexpr size_t WS_XS = WS_R;
constexpr size_t WS_HID = al256(WS_XS + (size_t)NE * EPAD * 1024 * 2);
constexpr size_t WS_YSE = al256(WS_HID + (size_t)NE * EPAD * FF * 2);
constexpr size_t WS_R_END2 = al256(WS_YSE + (size_t)NE * EPAD * 1024 * 4);
constexpr size_t WS_END = WS_R_END1 > WS_R_END2 ? WS_R_END1 : WS_R_END2;

constexpr int LDS_BYTES = 163840;
constexpr int LDS_MISC = 163328;

typedef unsigned short bf16_t;
typedef short bf16x8 __attribute__((ext_vector_type(8)));
typedef float f32x2 __attribute__((ext_vector_type(2)));
typedef float f32x4 __attribute__((ext_vector_type(4)));
typedef float f32x16 __attribute__((ext_vector_type(16)));
typedef unsigned u32x2 __attribute__((ext_vector_type(2)));
typedef unsigned u32x4 __attribute__((ext_vector_type(4)));
#define DEV __device__ __forceinline__

#ifdef EMU
#define LAS
#define GAS
static inline float bf2f_h(bf16_t b) { unsigned u = (unsigned)b << 16; float f; memcpy(&f, &u, 4); return f; }
static inline f32x4 mfma16(bf16x8 a, bf16x8 b, f32x4 c) {
    struct In { bf16x8 a, b; } in{a, b};
    auto s = emu::wave_xchg(&in, sizeof(in)); const int l = emu::cur->lane, col = l & 15, rg = l >> 4;
    for (int r = 0; r < 4; ++r) { const int row = 4 * rg + r; double acc = c[r];
        for (int kg = 0; kg < 4; ++kg) { const In* pa = (const In*)s[row + 16 * kg]; const In* pb = (const In*)s[col + 16 * kg];
            for (int j = 0; j < 8; ++j) acc += (double)bf2f_h((bf16_t)pa->a[j]) * (double)bf2f_h((bf16_t)pb->b[j]); }
        c[r] = (float)acc; }
    return c;
}
static inline f32x16 mfma32(bf16x8 a, bf16x8 b, f32x16 c) {
    struct In { bf16x8 a, b; } in{a, b};
    auto s = emu::wave_xchg(&in, sizeof(in)); const int l = emu::cur->lane, col = l & 31, h = l >> 5;
    for (int r = 0; r < 16; ++r) { const int row = (r & 3) + 8 * (r >> 2) + 4 * h; double acc = c[r];
        for (int kh = 0; kh < 2; ++kh) { const In* pa = (const In*)s[row + 32 * kh]; const In* pb = (const In*)s[col + 32 * kh];
            for (int j = 0; j < 8; ++j) acc += (double)bf2f_h((bf16_t)pa->a[j]) * (double)bf2f_h((bf16_t)pb->b[j]); }
        c[r] = (float)acc; }
    return c;
}
static inline void glds16(const void* g, void* l) { memcpy((char*)l + 16 * emu::cur->lane, g, 16); }
#define S_BARRIER() emu::block_barrier()
#define WAIT_VM(n) do {} while (0)
#define WAIT_LGKM(n) do {} while (0)
#define WAIT_ALL() do {} while (0)
#define SETPRIO(n) do {} while (0)
#define SCHED_BARRIER() do {} while (0)
#define COMPILER_FENCE() do {} while (0)
#define WAVE_LDS_SYNC() do { int _z = 0; (void)emu::wave_xchg(&_z, 4); } while (0)
#define LAUNDER(x) do {} while (0)
#define LAUNDER_S(x) do {} while (0)
static inline int lane_id() { return emu::cur->lane; }
template <class T> static inline T shfl_xor_t(T v, int m) { auto s = emu::wave_xchg(&v, sizeof(T)); T r; memcpy(&r, s[emu::cur->lane ^ m], sizeof(T)); return r; }
template <class T> static inline T shfl_t(T v, int src) { auto s = emu::wave_xchg(&v, sizeof(T)); T r; memcpy(&r, s[src & 63], sizeof(T)); return r; }
static inline float wave_sum(float v) { for (int o = 1; o < 64; o <<= 1) v += shfl_xor_t(v, o); return v; }
static inline float wave_max(float v) { for (int o = 1; o < 64; o <<= 1) v = fmaxf(v, shfl_xor_t(v, o)); return v; }
template <int W> static inline float group_sum(float v) { for (int o = 1; o < W; o <<= 1) v += shfl_xor_t(v, o); return v; }
template <int W> static inline float group_max(float v) { for (int o = 1; o < W; o <<= 1) v = fmaxf(v, shfl_xor_t(v, o)); return v; }
static inline int bcast_lane(int v, int src) { return shfl_t(v, src); }
static inline int readfirstlane_i(int v) { return v; }
static inline unsigned xb_ld(unsigned* p) { return *(volatile unsigned*)p; }
static inline unsigned xb_add(unsigned* p, unsigned v) { unsigned o = *p; *p = o + v; return o; }
static inline unsigned xb_xcc_id() { return (unsigned)emu::cur->bid & 7u; }
static inline void s_sleep1() { emu::yield(); }
static inline void fence_acquire() {}
static inline void fence_release() {}
static inline unsigned lds_atomic_add(unsigned* p, unsigned v) { unsigned o = *p; *p = o + v; return o; }
static inline unsigned long long rt_now() { return 0ull; }
static inline float fast_exp2(float x) { return exp2f(x); }
static inline float fast_rcp(float x) { return 1.0f / x; }
#else
#define LAS __attribute__((address_space(3)))
#define GAS __attribute__((address_space(1)))
DEV f32x4 mfma16(bf16x8 a, bf16x8 b, f32x4 c) { return __builtin_amdgcn_mfma_f32_16x16x32_bf16(a, b, c, 0, 0, 0); }
DEV f32x16 mfma32(bf16x8 a, bf16x8 b, f32x16 c) { return __builtin_amdgcn_mfma_f32_32x32x16_bf16(a, b, c, 0, 0, 0); }
#define glds16(g, l) __builtin_amdgcn_global_load_lds((const unsigned*)(g), (LAS unsigned*)(l), 16, 0, 0)
#define S_BARRIER() __builtin_amdgcn_s_barrier()
#define WAIT_VM(n) asm volatile("s_waitcnt vmcnt(" #n ")" ::: "memory")
#define WAIT_LGKM(n) asm volatile("s_waitcnt lgkmcnt(" #n ")" ::: "memory")
#define WAIT_ALL() asm volatile("s_waitcnt vmcnt(0) lgkmcnt(0)" ::: "memory")
#define SETPRIO(n) __builtin_amdgcn_s_setprio(n)
#define SCHED_BARRIER() __builtin_amdgcn_sched_barrier(0)
#define COMPILER_FENCE() asm volatile("" ::: "memory")
#define WAVE_LDS_SYNC() asm volatile("s_waitcnt lgkmcnt(0)" ::: "memory")
#define LAUNDER(x) asm volatile("" : "+v"(x))
#define LAUNDER_S(x) asm volatile("" : "+s"(x))
DEV int lane_id() { return (int)__builtin_amdgcn_mbcnt_hi(~0u, __builtin_amdgcn_mbcnt_lo(~0u, 0u)); }
template <class T> DEV T shfl_xor_t(T v, int m) { return __shfl_xor(v, m); }
template <class T> DEV T shfl_t(T v, int src) { return __shfl(v, src); }
template <int CTRL, int ROWMASK> DEV float dpp_mov(float v) { return __builtin_bit_cast(float, __builtin_amdgcn_update_dpp(0, __builtin_bit_cast(int, v), CTRL, ROWMASK, 0xf, false)); }
template <int CTRL, int ROWMASK> DEV float dpp_mov_keep(float oldv, float v) { return __builtin_bit_cast(float, __builtin_amdgcn_update_dpp(__builtin_bit_cast(int, oldv), __builtin_bit_cast(int, v), CTRL, ROWMASK, 0xf, false)); }
template <int W> DEV float group_sum(float v) {
    v += dpp_mov<0xB1, 0xf>(v); v += dpp_mov<0x4E, 0xf>(v);
    if (W >= 8) v += dpp_mov<0x141, 0xf>(v);
    if (W >= 16) v += dpp_mov<0x140, 0xf>(v);
    return v;
}
DEV float wave_sum(float v) {
    v = group_sum<16>(v);
    v += dpp_mov<0x142, 0xa>(v);
    v += dpp_mov<0x143, 0xc>(v);
    return __builtin_bit_cast(float, __builtin_amdgcn_readlane(__builtin_bit_cast(int, v), 63));
}
DEV float wave_max(float v) {
    v = fmaxf(v, dpp_mov_keep<0xB1, 0xf>(v, v)); v = fmaxf(v, dpp_mov_keep<0x4E, 0xf>(v, v)); v = fmaxf(v, dpp_mov_keep<0x141, 0xf>(v, v)); v = fmaxf(v, dpp_mov_keep<0x140, 0xf>(v, v));
    v = fmaxf(v, dpp_mov_keep<0x142, 0xa>(v, v)); v = fmaxf(v, dpp_mov_keep<0x143, 0xc>(v, v));
    return __builtin_bit_cast(float, __builtin_amdgcn_readlane(__builtin_bit_cast(int, v), 63));
}
template <int W> DEV float group_max(float v) {
    v = fmaxf(v, dpp_mov_keep<0xB1, 0xf>(v, v)); v = fmaxf(v, dpp_mov_keep<0x4E, 0xf>(v, v));
    if (W >= 8) v = fmaxf(v, dpp_mov_keep<0x141, 0xf>(v, v));
    if (W >= 16) v = fmaxf(v, dpp_mov_keep<0x140, 0xf>(v, v));
    return v;
}
DEV int bcast_lane(int v, int src) { return __builtin_amdgcn_readlane(v, src); }
DEV int readfirstlane_i(int v) { return __builtin_amdgcn_readfirstlane(v); }
DEV unsigned xb_ld(unsigned* p) { return __hip_atomic_load(p, __ATOMIC_RELAXED, __HIP_MEMORY_SCOPE_AGENT); }
DEV unsigned xb_add(unsigned* p, unsigned v) { return __hip_atomic_fetch_add(p, v, __ATOMIC_RELAXED, __HIP_MEMORY_SCOPE_AGENT); }
DEV unsigned xb_xcc_id() { return (unsigned)__builtin_amdgcn_s_getreg((3 << 11) | 20) & 0xFu; }
DEV void s_sleep1() { __builtin_amdgcn_s_sleep(1); }
DEV void fence_acquire() { __builtin_amdgcn_fence(__ATOMIC_ACQUIRE, "agent"); }
DEV void fence_release() { __builtin_amdgcn_fence(__ATOMIC_RELEASE, "agent"); }
DEV unsigned lds_atomic_add(LAS unsigned* p, unsigned v) { return __hip_atomic_fetch_add(p, v, __ATOMIC_RELAXED, __HIP_MEMORY_SCOPE_WORKGROUP); }
DEV unsigned long long rt_now() { return __builtin_amdgcn_s_memrealtime(); }
DEV float fast_exp2(float x) { return __builtin_amdgcn_exp2f(x); }
DEV float fast_rcp(float x) { return __builtin_amdgcn_rcpf(x); }
#endif

DEV unsigned f2bf(float f) { unsigned u = __builtin_bit_cast(unsigned, f); return (u + 0x7fffu + ((u >> 16) & 1u)) >> 16; }
DEV unsigned pk2(float lo, float hi) { return f2bf(lo) | (f2bf(hi) << 16); }
DEV float bf2f(unsigned b) { return __builtin_bit_cast(float, b << 16); }
DEV float bflo(unsigned w) { return __builtin_bit_cast(float, w << 16); }
DEV float bfhi(unsigned w) { return __builtin_bit_cast(float, w & 0xffff0000u); }
DEV float sigmoid_f(float x) { return 1.0f / (1.0f + expf(-x)); }
DEV float silu_f(float x) { return x / (1.0f + expf(-x)); }
DEV float softplus_f(float x) { return fmaxf(x, 0.0f) + log1pf(expf(-fabsf(x))); }
DEV float gelu_tanh_f(float x) { const float u = 0.7978845608028654f * (x + 0.044715f * x * x * x); return 0.5f * x * (1.0f + tanhf(u)); }

#define XB_TMO      128
#define XB_XCNT(j)  (256  + 64 * (j))
#define XB_XSUB(j)  (1280 + 64 * (j))
#define XB_XGEN(j)  (2304 + 64 * (j))
#define XB_TOP      3328
#define XB_TOPGEN   3392
#define XCD_BAR_WORDS 3456
#define XB_SPIN_CAP (1u << 20)
#define XB_SPIN(cond, bar) do { unsigned _sp = 0; while (cond) { s_sleep1(); \
    if ((++_sp & 255u) == 0u) { if (xb_ld(&(bar)[XB_TMO])) break; if (_sp > XB_SPIN_CAP) { xb_add(&(bar)[XB_TMO], 1u); break; } } } } while (0)
struct XcdBarrier { unsigned* bar; unsigned x; volatile LAS unsigned* st; int wave; };
DEV XcdBarrier xcd_barrier_post(unsigned* bar, volatile LAS unsigned* st, int wave) {
    XcdBarrier b; b.wave = wave; b.bar = bar; b.x = (unsigned)readfirstlane_i((int)xb_xcc_id()); b.st = st;
    if (wave == 0 && lane_id() == 0) (void)xb_add(&bar[XB_XCNT(b.x)], 1u);
    return b;
}
DEV void xcd_barrier_complete(unsigned* bar, unsigned x, unsigned& nloc, unsigned& nx) {
    const unsigned G = gridDim.x;
    unsigned sum, cnt, mine, sp = 0u;
    for (;;) {
        sum = 0u; cnt = 0u; mine = 0u;
#pragma unroll
        for (unsigned j = 0; j < 16; ++j) { const unsigned c = xb_ld(&bar[XB_XCNT(j)]); sum += c; cnt += (c > 0u) ? 1u : 0u; mine = (j == x) ? c : mine; }
        if (sum == G) break;
        s_sleep1();
        if ((++sp & 255u) == 0u) { if (xb_ld(&bar[XB_TMO])) break; if (sp > XB_SPIN_CAP) { xb_add(&bar[XB_TMO], 1u); break; } }
    }
    nloc = mine > 0u ? mine : 1u; nx = cnt > 0u ? cnt : 1u;
}
DEV void xcd_barrier(const XcdBarrier& b) {
    WAIT_VM(0);
    __syncthreads();
    int bw = b.wave; LAUNDER_S(bw);
    if (bw == 0 && lane_id() == 0) {
        unsigned* bar = b.bar; LAUNDER_S(bar);
        unsigned bx = b.x; LAUNDER_S(bx);
        WAIT_ALL();
        unsigned nloc = b.st[0], nx = b.st[1];
        if (nloc == 0u) { xcd_barrier_complete(bar, bx, nloc, nx); b.st[0] = nloc; b.st[1] = nx; }
        const unsigned old = xb_add(&bar[XB_XSUB(bx)], 1u);
        const unsigned gen = old / nloc;
        if (old + 1u == (gen + 1u) * nloc) {
            fence_release();
            WAIT_VM(0);
            const unsigned og = xb_add(&bar[XB_TOP], 1u);
            const unsigned tg = og / nx;
            if (og + 1u == (tg + 1u) * nx) xb_add(&bar[XB_TOPGEN], 1u);
            else XB_SPIN(xb_ld(&bar[XB_TOPGEN]) == tg, bar);
            fence_acquire();
            xb_add(&bar[XB_XGEN(bx)], 1u);
            WAIT_VM(0);
        } else {
            XB_SPIN(xb_ld(&bar[XB_XGEN(bx)]) == gen, bar);
            fence_acquire();
            WAIT_VM(0);
        }
    }
    __syncthreads();
}

namespace pg8 {
constexpr int BM = 256, BK = 64, HALF = 128, HTB = HALF * BK * 2, STAGE_BYTES = 8 * HTB;
DEV int lds_byte(int r, int c) { const int st = (r >> 4) * 2 + (c >> 5), rr = r & 15, cc = c & 31, ob = rr * 64 + cc * 2; return st * 1024 + (ob ^ (((ob >> 9) & 1) << 5)); }
DEV void stage_rc(int b, int& R, int& C) { const int st = b / 1024, sb = b % 1024, swz = sb ^ (((sb >> 9) & 1) << 5); R = (st >> 1) * 16 + swz / 64; C = (st & 1) * 32 + (swz % 64) / 2; }
DEV int perm32(int rho) { const int n = rho >> 4, i = rho & 15; return 8 * (i >> 2) + 4 * n + (i & 3); }
struct Unit { const char* A; const char* B; int pm, pn, e; };
#ifdef EMU
static inline unsigned cvt_pk_bf16(float lo, float hi) { return pk2(lo, hi); }
#else
DEV unsigned cvt_pk_bf16(float lo, float hi) { unsigned r; asm volatile("v_cvt_pk_bf16_f32 %0, %1, %2" : "=v"(r) : "v"(lo), "v"(hi)); return r; }
#endif
template <class Epi, class Sched>
DEV void gemm_phase(LAS unsigned char* lds, const int K, const Sched& S, const Epi& E, const int wid, const int lane) {
    const int tid = wid * 64 + lane; const int wr = wid >> 2, wc = wid & 3, fr = lane & 15, fq = lane >> 4;
    const int nt = K / BK;
    unsigned voffA[2], voffB[2];
#pragma unroll
    for (int i = 0; i < 2; ++i) { int R, C; stage_rc(tid * 16 + i * 8192, R, C); const int Rb = Epi::PERM ? ((R & ~31) + perm32(R & 31)) : R;
        voffA[i] = (unsigned)(R * K + C) * 2u; voffB[i] = (unsigned)(Rb * K + C) * 2u; }
    const size_t kstep = (size_t)(BK * 2);
    const size_t hstep = (size_t)HALF * K * 2;
    const unsigned ldsw = (unsigned)wid * 1024u;
    const int aoff = lds_byte(wr * 64 + fr, fq * 8), boff = lds_byte(wc * 32 + fr, fq * 8);
#define PG8_SA(b, h) (((b) * 2 + (h)) * HTB)
#define PG8_SB(b, h) ((4 + (b) * 2 + (h)) * HTB)
#define PG8_STAGE(bufoff, gbase, voff) do { _Pragma("unroll") for (int _i = 0; _i < 2; ++_i) \
        glds16(((const char*)(gbase) + (voff)[_i]), (lds + (bufoff) + ldsw + _i * 8192)); } while (0)
#define PG8_LDA(dst, b, h) do { _Pragma("unroll") for (int m = 0; m < 4; ++m) _Pragma("unroll") for (int k = 0; k < 2; ++k) dst[m][k] = *(const LAS bf16x8*)(lds + PG8_SA(b, h) + aoff + m * 2048 + k * 1024); } while (0)
#define PG8_LDB(dst, b, h) do { _Pragma("unroll") for (int n = 0; n < 2; ++n) _Pragma("unroll") for (int k = 0; k < 2; ++k) dst[n][k] = *(const LAS bf16x8*)(lds + PG8_SB(b, h) + boff + n * 2048 + k * 1024); } while (0)
#define PG8_MMA(ai, bj, At, Bt) do { SETPRIO(1); _Pragma("unroll") for (int m = 0; m < 4; ++m) _Pragma("unroll") for (int n = 0; n < 2; ++n) _Pragma("unroll") for (int k = 0; k < 2; ++k) \
        acc[ai][bj][m][n] = mfma16(Bt[n][k], At[m][k], acc[ai][bj][m][n]); SETPRIO(0); } while (0)
    Unit cur, nxt; int ui = 0;
    if (!S.next(0, cur)) return;
    f32x4 acc[2][2][4][2];
#pragma unroll
    for (int a = 0; a < 2; ++a)
#pragma unroll
        for (int b = 0; b < 2; ++b)
#pragma unroll
            for (int m = 0; m < 4; ++m)
#pragma unroll
                for (int n = 0; n < 2; ++n) acc[a][b][m][n] = (f32x4){0.f, 0.f, 0.f, 0.f};
    bf16x8 At[4][2], B0[2][2], B1[2][2];
    const char* cA = cur.A; const char* cB = cur.B;
    PG8_STAGE(PG8_SB(0, 0), cB, voffB); PG8_STAGE(PG8_SB(0, 1), cB + hstep, voffB); PG8_STAGE(PG8_SA(0, 0), cA, voffA); PG8_STAGE(PG8_SA(0, 1), cA + hstep, voffA);
    if (wr == 1) S_BARRIER();
    WAIT_VM(2); S_BARRIER();
    PG8_STAGE(PG8_SB(1, 0), cB + kstep, voffB); PG8_STAGE(PG8_SA(1, 0), cA + kstep, voffA); PG8_STAGE(PG8_SB(1, 1), cB + hstep + kstep, voffB);
    WAIT_VM(6); S_BARRIER();
    for (;;) {
        const bool has_next = S.next(ui + 1, nxt);
        const char* nA = has_next ? nxt.A : cA; const char* nB = has_next ? nxt.B : cB;
        for (int t = 0; t < nt; t += 2) {
            const bool last = (t == nt - 2);
            const char* a1 = cA + (size_t)(t + 1) * kstep;
            const char* a2 = last ? nA : cA + (size_t)(t + 2) * kstep; const char* b2 = last ? nB : cB + (size_t)(t + 2) * kstep;
            const char* a3 = a2 + kstep; const char* b3 = b2 + kstep;
            PG8_LDB(B0, 0, 0); PG8_LDB(B1, 0, 1); SCHED_BARRIER(); PG8_LDA(At, 0, 0); PG8_STAGE(PG8_SA(1, 1), a1 + hstep, voffA);
            WAIT_VM(8); WAIT_LGKM(0); S_BARRIER(); PG8_MMA(0, 0, At, B0); PG8_MMA(0, 1, At, B1); S_BARRIER(); SCHED_BARRIER();
            PG8_LDA(At, 0, 1); PG8_STAGE(PG8_SB(0, 0), b2, voffB); PG8_STAGE(PG8_SB(0, 1), b2 + hstep, voffB); PG8_STAGE(PG8_SA(0, 0), a2, voffA);
            WAIT_VM(8); WAIT_LGKM(0); S_BARRIER(); PG8_MMA(1, 0, At, B0); PG8_MMA(1, 1, At, B1); S_BARRIER(); SCHED_BARRIER();
            PG8_LDB(B0, 1, 0); PG8_LDB(B1, 1, 1); SCHED_BARRIER(); PG8_LDA(At, 1, 0); PG8_STAGE(PG8_SA(0, 1), a2 + hstep, voffA);
            WAIT_VM(8); WAIT_LGKM(0); S_BARRIER(); PG8_MMA(0, 0, At, B0); PG8_MMA(0, 1, At, B1); S_BARRIER(); SCHED_BARRIER();
            PG8_LDA(At, 1, 1); PG8_STAGE(PG8_SB(1, 0), b3, voffB); PG8_STAGE(PG8_SB(1, 1), b3 + hstep, voffB); PG8_STAGE(PG8_SA(1, 0), a3, voffA);
            WAIT_VM(8); WAIT_LGKM(0); S_BARRIER(); PG8_MMA(1, 0, At, B0); PG8_MMA(1, 1, At, B1); S_BARRIER(); SCHED_BARRIER();
        }
        if (wr == 0) S_BARRIER();
        E(acc, cur, wr, wc, fr, fq);
        if (!has_next) break;
#pragma unroll
        for (int a = 0; a < 2; ++a)
#pragma unroll
            for (int b = 0; b < 2; ++b)
#pragma unroll
                for (int m = 0; m < 4; ++m)
#pragma unroll
                    for (int n = 0; n < 2; ++n) acc[a][b][m][n] = (f32x4){0.f, 0.f, 0.f, 0.f};
        cur = nxt; cA = nA; cB = nB; ++ui;
        if (wr == 1) S_BARRIER();
    }
    WAIT_VM(0);
    S_BARRIER();
#undef PG8_SA
#undef PG8_SB
#undef PG8_STAGE
#undef PG8_LDA
#undef PG8_LDB
#undef PG8_MMA
}

struct PlainOrder {
    const char* A; const char* Bt; int K, nM, nN, nwg, G, c;
    DEV void init(const void* A_, const void* Bt_, int K_, int M, int N, int G_, int c_) { A = (const char*)A_; Bt = (const char*)Bt_; K = K_; nM = M / BM; nN = N / BM; nwg = nM * nN; G = G_; c = c_; }
    DEV bool next(int i, Unit& u) const {
        const long L = (long)i * G + c; if (L >= nwg) return false;
        int wgid = (int)L; { const int q = nwg / 8, r = nwg % 8, xcd = wgid % 8, off = wgid / 8; wgid = (xcd < r ? xcd * (q + 1) : r * (q + 1) + (xcd - r) * q) + off; }
        const int nig = 8 * nN, gid = wgid / nig, fm = gid * 8, gsz = (nM - fm) < 8 ? (nM - fm) : 8;
        u.pm = fm + ((wgid % nig) % gsz); u.pn = (wgid % nig) / gsz; u.e = 0;
        u.A = A + (size_t)u.pm * BM * K * 2; u.B = Bt + (size_t)u.pn * BM * K * 2; return true;
    }
};
struct GroupedOrder {
    const char* A; const char* Bt; int K, nMe, nN, nwg, G, c; size_t bstride;
    DEV void init(const void* A_, const void* Bt_, int K_, int N, int G_, int c_) { A = (const char*)A_; Bt = (const char*)Bt_; K = K_; nMe = EPAD / BM; nN = N / BM; nwg = NE * nMe * nN; G = G_; c = c_; bstride = (size_t)N * K * 2; }
    DEV bool next(int i, Unit& u) const {
        const long L = (long)i * G + c; if (L >= nwg) return false;
        int wgid = (int)L; { const int q = nwg / 8, r = nwg % 8, xcd = wgid % 8, off = wgid / 8; wgid = (xcd < r ? xcd * (q + 1) : r * (q + 1) + (xcd - r) * q) + off; }
        const int per_e = nMe * nN; const int e = wgid / per_e, w = wgid % per_e;
        u.e = e; u.pm = w % nMe; u.pn = w / nMe;
        u.A = A + ((size_t)e * EPAD + (size_t)u.pm * BM) * K * 2; u.B = Bt + (size_t)e * bstride + (size_t)u.pn * BM * K * 2; return true;
    }
};
}

struct Args { const float* in[N_IN]; float* out; unsigned char* ws; };

struct Frame {
    const float* const* in; GAS float* out; GAS unsigned char* ws; LAS unsigned char* lds;
    int tid, lane, wave, G, bid, gw, NGW;
};

DEV Frame refresh(const Frame& F0) {
    Frame F = F0; int w = F0.wave; LAUNDER_S(w); int ln = lane_id(); LAUNDER(ln);
    F.wave = w; F.lane = ln; F.tid = w * 64 + ln; F.gw = F.bid * NWAVES + w;
    GAS unsigned char* ws = F0.ws; LAUNDER_S(ws); F.ws = ws;
    return F;
}

#define GIN(k) ((const float*)(GAS const float*)F.in[k])

#define ROW_LOOP(r, NROWS) for (int r = F.gw; r < (NROWS); r += F.NGW)

DEV int tok_row(int b, int d, int sp) {
    int s;
    if (sp < CTX) s = d ? (CTX - 1 - sp) : sp;
    else { const int j = sp - CTX; s = CTX + (d ? (SEQ - 1 - j) : j); }
    return b * TOK + s;
}

DEV void tr_item(const float* W, int ldw, int col0, int k0, bf16_t* WT, int K, int row0, LAS float* scr, int lane) {
#pragma unroll 8
    for (int i = 0; i < 32; ++i) { const int kk = 2 * i + (lane >> 5); scr[kk * 33 + (lane & 31)] = W[(size_t)(k0 + kk) * ldw + col0 + (lane & 31)]; }
    WAVE_LDS_SYNC();
    const int c = lane & 7;
#pragma unroll
    for (int j = 0; j < 4; ++j) { const int n = (lane >> 3) + 8 * j; const LAS float* s = scr + (8 * c) * 33 + n;
        u32x4 o; o.x = pk2(s[0 * 33], s[1 * 33]); o.y = pk2(s[2 * 33], s[3 * 33]); o.z = pk2(s[4 * 33], s[5 * 33]); o.w = pk2(s[6 * 33], s[7 * 33]);
        *(u32x4*)(WT + (size_t)(row0 + n) * K + k0 + 8 * c) = o; }
    WAVE_LDS_SYNC();
}

DEV void phase_prologue_a(const Frame& F0) {
    const Frame F = refresh(F0);
    LAS float* scr = (LAS float*)(F.lds + F.wave * 16384);
    for (int l = 0; l < DEPTH; ++l) {
        const int odd = l & 1, li = l >> 1;
        const float* win = odd ? GIN(I_ODWIN) + (size_t)li * 1024 * 2576 : GIN(I_EVWIN) + (size_t)li * 1024 * 4112;
        const int ldw = odd ? 2576 : 4112, nin = odd ? NIN_O : NIN_E;
        bf16_t* wint = (bf16_t*)(F.ws + WS_WIN) + (size_t)l * NINMAX * 1024;
        for (int it = F.gw; it < 16 * (nin / 32); it += F.NGW) { const int kb = it / (nin / 32), nb = it % (nin / 32); const int d0 = 32 * nb;
            tr_item(win, ldw, d0 < 2048 ? d0 : d0 + 16, 64 * kb, wint, 1024, d0, scr, F.lane); }
        const float* wout = odd ? GIN(I_ODWOUT) + (size_t)li * 1024 * 1024 : GIN(I_EVWOUT) + (size_t)li * 1024 * 1024;
        bf16_t* woutt = (bf16_t*)(F.ws + WS_WOUT) + (size_t)l * 1024 * 1024;
        for (int it = F.gw; it < 16 * 32; it += F.NGW) { const int kb = it / 32, nb = it % 32; tr_item(wout, 1024, 32 * nb, 64 * kb, woutt, 1024, 32 * nb, scr, F.lane); }
        if (odd) {
            const float* wglu = GIN(I_ODWGLU) + (size_t)li * 512 * 512; bf16_t* wglut = (bf16_t*)(F.ws + WS_WGLU) + (size_t)li * 512 * 512;
            for (int it = F.gw; it < 8 * 16; it += F.NGW) { const int kb = it / 16, nb = it % 16; tr_item(wglu, 512, 32 * nb, 64 * kb, wglut, 512, 32 * nb, scr, F.lane); }
        }
        constexpr int GU_NB = 2 * FF / 32, GU_ITEMS = 16 * GU_NB;
        for (int it = F.gw; it < NE * GU_ITEMS; it += F.NGW) { const int e = it / GU_ITEMS, r = it % GU_ITEMS, kb = r / GU_NB, nb = r % GU_NB; const int d0 = 32 * nb, j = d0 >> 8, w = d0 & 255;
            const float* src = (w < 128 ? GIN(I_WGATE) : GIN(I_WUP)) + ((size_t)l * NE + e) * 1024 * FF;
            tr_item(src, FF, 128 * j + (w & 127), 64 * kb, (bf16_t*)(F.ws + WS_WGU) + ((size_t)l * NE + e) * 2 * FF * 1024, 1024, d0, scr, F.lane); }
        constexpr int D_ITEMS = (FF / 64) * 32;
        for (int it = F.gw; it < NE * D_ITEMS; it += F.NGW) { const int e = it / D_ITEMS, r = it % D_ITEMS, kb = r / 32, nb = r % 32;
            tr_item(GIN(I_WDOWN) + ((size_t)l * NE + e) * FF * 1024, 1024, 32 * nb, 64 * kb, (bf16_t*)(F.ws + WS_WD) + ((size_t)l * NE + e) * 1024 * FF, FF, 32 * nb, scr, F.lane); }
    }
    const int gt = F.bid * NTHREADS + F.tid, NGT = F.G * NTHREADS;
    for (int i = gt; i < DEPTH * 16 * 1024; i += NGT) { const int l = i / 16384, g = (i >> 10) & 15, k = i & 1023; const int odd = l & 1, li = l >> 1;
        ((float*)(F.ws + WS_WG))[i] = odd ? GIN(I_ODWIN)[((size_t)li * 1024 + k) * 2576 + 2048 + g] : GIN(I_EVWIN)[((size_t)li * 1024 + k) * 4112 + 2048 + g]; }
    for (int i = gt; i < DEPTH * NE * 1024; i += NGT) { const int k = i & 1023, e = (i >> 10) % NE, l = i / (NE * 1024); ((float*)(F.ws + WS_WR))[i] = GIN(I_WROUTER)[((size_t)l * 1024 + k) * NE + e]; }
    for (int i = gt; i < N_ODD * 2 * 32 * 64; i += NGT) { const int p = i & 63, g = (i >> 6) & 31, d = (i >> 11) & 1, o = i >> 12;
        const int idx = ((o * 2 + d) * 32 + g) * 64 + p;
        const float lr = fminf(GIN(I_ODLRE)[idx], -1e-4f), li_ = GIN(I_ODLIM)[idx], dt = expf(GIN(I_ODLDT)[(o * 2 + d) * 32 + g]);
        const float mag = expf(lr * dt); float sn, cs; sincosf(li_ * dt, &sn, &cs); const float are = mag * cs, aim = mag * sn;
        float* A = (float*)(F.ws + WS_S5A) + (size_t)((o * 2 + d) * 32 + g) * 128; A[p] = are; A[64 + p] = aim;
        const float xr = are - 1.0f, xi = aim, den = lr * lr + li_ * li_; const float fre = (xr * lr + xi * li_) / den, fim = (xi * lr - xr * li_) / den;
        bf16_t* Bb = (bf16_t*)(F.ws + WS_S5B) + (size_t)((o * 2 + d) * 32 + g) * 128 * 16;
        for (int h = 0; h < 16; ++h) { const float br = GIN(I_ODBRE)[((size_t)(o * 32 + g) * 64 + p) * 16 + h], bi = GIN(I_ODBIM)[((size_t)(o * 32 + g) * 64 + p) * 16 + h];
            Bb[p * 16 + h] = (bf16_t)f2bf(fre * br - fim * bi); Bb[(64 + p) * 16 + h] = (bf16_t)f2bf(fre * bi + fim * br); } }
    for (int i = gt; i < N_ODD * 32 * 16 * 64; i += NGT) { const int p = i & 63, c = (i >> 6) & 15, g = (i >> 10) & 31, o = i >> 15;
        bf16_t* Cm = (bf16_t*)(F.ws + WS_S5C) + (size_t)((o * 32 + g) * 16 + c) * 128;
        Cm[p] = (bf16_t)f2bf(GIN(I_ODCRE)[i]); Cm[64 + p] = (bf16_t)f2bf(-GIN(I_ODCIM)[i]); }
    ROW_LOOP(r, MPAD) {
        f32x4* dst = (f32x4*)((float*)(F.ws + WS_H) + (size_t)r * 1024) + F.lane;
        if (r < MROWS) { const int b = r / TOK, s = r % TOK; const f32x4* src = (const f32x4*)(s < CTX ? GIN(I_CTX) + ((size_t)b * CTX + s) * 1024 : GIN(I_X) + ((size_t)b * SEQ + (s - CTX)) * 1024) + F.lane;
#pragma unroll
            for (int j = 0; j < 4; ++j) dst[64 * j] = src[64 * j]; }
        else {
#pragma unroll
            for (int j = 0; j < 4; ++j) dst[64 * j] = (f32x4){0.f, 0.f, 0.f, 0.f};
            u32x4* xz = (u32x4*)((bf16_t*)(F.ws + WS_XIN) + (size_t)r * 1024) + F.lane; xz[0] = (u32x4){0u, 0u, 0u, 0u}; xz[64] = (u32x4){0u, 0u, 0u, 0u};
            u32x4* mz = (u32x4*)((bf16_t*)(F.ws + WS_MERGED) + (size_t)r * 1024) + F.lane; mz[0] = (u32x4){0u, 0u, 0u, 0u}; mz[64] = (u32x4){0u, 0u, 0u, 0u};
            u32x4* yz = (u32x4*)((bf16_t*)(F.ws + WS_YS) + (size_t)r * 512) + F.lane; yz[0] = (u32x4){0u, 0u, 0u, 0u};
        }
    }
    __syncthreads();
    LAS float* sv = (LAS float*)F.lds;
    LAS float* part = (LAS float*)(F.lds + 32768);
    for (int i = F.tid; i < NR * 1024; i += NTHREADS) { const int r = i >> 10, k = i & 1023; const float c = r < B_ ? GIN(I_C)[r * 1024 + k] : GIN(I_CCTX)[k]; sv[i] = silu_f(c); }
    __syncthreads();
    for (int it = F.bid; it < DEPTH * 96; it += F.G) {
        const int l = it / 96, j = (it % 96) * 64 + F.lane;
        const float* w = GIN(I_WMOD) + (size_t)l * 1024 * 6144 + j;
        float acc[NR];
#pragma unroll
        for (int r = 0; r < NR; ++r) acc[r] = 0.f;
        const int k0 = F.wave * 128;
#pragma unroll 8
        for (int k = 0; k < 128; ++k) { const float wv = w[(size_t)(k0 + k) * 6144];
#pragma unroll
            for (int r = 0; r < NR; ++r) acc[r] += sv[r * 1024 + k0 + k] * wv; }
#pragma unroll
        for (int r = 0; r < NR; ++r) part[(F.wave * NR + r) * 64 + F.lane] = acc[r];
        __syncthreads();
        for (int i = F.tid; i < NR * 64; i += NTHREADS) { const int r = i >> 6, jj = i & 63; float s = 0.f;
#pragma unroll
            for (int w8 = 0; w8 < 8; ++w8) s += part[(w8 * NR + r) * 64 + jj];
            const int col = (it % 96) * 64 + jj;
            ((float*)(F.ws + WS_MOD))[((size_t)l * NR + r) * 6144 + col] = s + GIN(I_BMOD)[l * 6144 + col]; }
        __syncthreads();
    }
}

constexpr int RG = 4;
static_assert(TOK % RG == 0 && CTX % RG == 0 && MROWS % RG == 0, "row groups");
DEV void xg_rows(const Frame& F, int l, int row0, f32x4 (&v)[RG][4]) {
    const int b = row0 / TOK, s = row0 % TOK, mr = s < CTX ? B_ : b;
    const float* mod = (const float*)(F.ws + WS_MOD) + ((size_t)l * NR + mr) * 6144;
#pragma unroll
    for (int j = 0; j < 4; ++j) { const f32x4 sh = *((const f32x4*)mod + F.lane + 64 * j), sc = *((const f32x4*)(mod + 1024) + F.lane + 64 * j);
#pragma unroll
        for (int q = 0; q < RG; ++q) v[q][j] = v[q][j] * (1.0f + sc) + sh; }
#pragma unroll
    for (int q = 0; q < RG; ++q) { u32x2* xo = (u32x2*)((bf16_t*)(F.ws + WS_XIN) + (size_t)(row0 + q) * 1024) + F.lane;
#pragma unroll
        for (int j = 0; j < 4; ++j) xo[64 * j] = (u32x2){pk2(v[q][j].x, v[q][j].y), pk2(v[q][j].z, v[q][j].w)}; }
    const float* wg = (const float*)(F.ws + WS_WG) + (size_t)l * 16 * 1024;
    float mine[RG]; const int gi = F.lane & 15;
#pragma unroll
    for (int q = 0; q < RG; ++q) mine[q] = 0.f;
    f32x4 wc[4];
#pragma unroll
    for (int j = 0; j < 4; ++j) wc[j] = *((const f32x4*)wg + F.lane + 64 * j);
#pragma unroll 1
    for (int g = 0; g < 16; ++g) { f32x4 wn[4]; const int gn = g + 1 < 16 ? g + 1 : g;
#pragma unroll
        for (int j = 0; j < 4; ++j) wn[j] = *((const f32x4*)(wg + gn * 1024) + F.lane + 64 * j);
#pragma unroll
        for (int q = 0; q < RG; ++q) { float p = 0.f;
#pragma unroll
            for (int j = 0; j < 4; ++j) p += v[q][j].x * wc[j].x + v[q][j].y * wc[j].y + v[q][j].z * wc[j].z + v[q][j].w * wc[j].w;
            const float t = wave_sum(p); mine[q] = (gi == g) ? t : mine[q]; }
#pragma unroll
        for (int j = 0; j < 4; ++j) wc[j] = wn[j]; }
    const int ty = gi >> 2, hh = gi & 3, li = l >> 1;
#pragma unroll
    for (int q = 0; q < RG; ++q) { float o;
        if (!(l & 1)) {
            if (ty < 2) o = -expf(GIN(I_EVALOG)[(li * 2 + ty) * 4 + hh]) * softplus_f(mine[q] + GIN(I_EVDTB)[(li * 2 + ty) * 4 + hh]);
            else o = sigmoid_f(mine[q]);
        } else {
            const int d = ty & 1, k = ty >> 1; const float gb = GIN(I_ODGB)[((li * 2 + d) * 2 + k) * 4 + hh];
            o = k ? -softplus_f(-(mine[q] + gb)) : mine[q] + gb;
        }
        if (F.lane < 16) ((float*)(F.ws + WS_GATES))[(size_t)(row0 + q) * 16 + gi] = o; }
}

DEV void phase_xg0(const Frame& F0) {
    const Frame F = refresh(F0);
    for (int r = RG * F.gw; r < MROWS; r += RG * F.NGW) {
        f32x4 v[RG][4];
#pragma unroll
        for (int q = 0; q < RG; ++q) { const f32x4* hr = (const f32x4*)((const float*)(F.ws + WS_H) + (size_t)(r + q) * 1024) + F.lane;
#pragma unroll
            for (int j = 0; j < 4; ++j) v[q][j] = hr[64 * j]; }
        xg_rows(F, 0, r, v);
    }
}

DEV void phase_prep(const Frame& F0, int l) {
    const Frame F = refresh(F0);
    const int odd = l & 1, li = l >> 1; const int nin = odd ? NIN_O : NIN_E, nseg = odd ? 2 : 3, qld = odd ? 1024 : 1536;
    const bf16_t* P = (const bf16_t*)(F.ws + WS_P); bf16_t* Q = (bf16_t*)(F.ws + WS_QKV);
    const float* cw = odd ? GIN(I_ODCONV) + (size_t)li * 9 * 1024 : GIN(I_EVCONV) + (size_t)li * 9 * 1536; const int cch = odd ? 1024 : 1536;
    ROW_LOOP(r, MROWS) {
        const int b = r / TOK, s = r % TOK; const bool lat = s >= CTX; const int rr = lat ? (s - CTX) >> 6 : 0, cc = lat ? (s - CTX) & 63 : s;
        for (int seg = 0; seg < nseg; ++seg) {
            const int ch0 = seg * 512 + F.lane * 8; float a[8];
#pragma unroll
            for (int i = 0; i < 8; ++i) a[i] = 0.f;
#pragma unroll
            for (int kh = 0; kh < 3; ++kh)
#pragma unroll
                for (int kw = 0; kw < 3; ++kw) {
                    int nrow; bool ok;
                    if (lat) { const int r2 = rr + kh - 1, c2 = cc + kw - 1; ok = r2 >= 0 && r2 < SEQ / 64 && c2 >= 0 && c2 < 64; nrow = b * TOK + CTX + r2 * 64 + c2; }
                    else { const int t2 = cc + kw - 1; ok = (kh == 1) && t2 >= 0 && t2 < CTX; nrow = b * TOK + t2; }
                    if (ok) { const u32x4 pv = *(const u32x4*)(P + (size_t)nrow * nin + ch0); const f32x4 w0 = *(const f32x4*)(cw + (kh * 3 + kw) * cch + ch0), w1 = *(const f32x4*)(cw + (kh * 3 + kw) * cch + ch0 + 4);
                        a[0] += bflo(pv.x) * w0.x; a[1] += bfhi(pv.x) * w0.y; a[2] += bflo(pv.y) * w0.z; a[3] += bfhi(pv.y) * w0.w;
                        a[4] += bflo(pv.z) * w1.x; a[5] += bfhi(pv.z) * w1.y; a[6] += bflo(pv.w) * w1.z; a[7] += bfhi(pv.w) * w1.w; }
                }
            float ss = 0.f;
#pragma unroll
            for (int i = 0; i < 8; ++i) { a[i] = silu_f(a[i]); ss += a[i] * a[i]; }
            float sc = 1.0f;
            if (!odd) { if (seg < 2) { ss = group_sum<16>(ss); sc = 1.0f / sqrtf(ss + 1e-6f); if (seg == 0) sc *= HD_SCALE; } }
            else if (seg == 1) sc = HD_SCALE;
            u32x4 o; o.x = pk2(a[0] * sc, a[1] * sc); o.y = pk2(a[2] * sc, a[3] * sc); o.z = pk2(a[4] * sc, a[5] * sc); o.w = pk2(a[6] * sc, a[7] * sc);
            *(u32x4*)(Q + (size_t)r * qld + ch0) = o;
        }
    }
    if (odd) {
        const float* GT = (const float*)(F.ws + WS_GATES); float* MC = (float*)(F.ws + WS_MCH);
        for (int c = F.gw; c < B_ * 4 * 2; c += F.NGW) { const int d = c & 1, hh = (c >> 1) & 3, b = c >> 3; float m = 0.f;
            for (int n = 0; n < NCH; ++n) { const int row = tok_row(b, d, n * 64 + F.lane);
                const float lin = GT[(size_t)row * 16 + d * 4 + hh], lf = GT[(size_t)row * 16 + 8 + d * 4 + hh];
                float bc = lf;
#pragma unroll
                for (int o = 1; o < 64; o <<= 1) { const float t = shfl_t(bc, F.lane - o); if (F.lane >= o) bc += t; }
                const float bend = shfl_t(bc, 63); const float amax = wave_max(bend - bc + lin);
                if (F.lane == 0) MC[(size_t)c * NCH + n] = m;
                m = fmaxf(bend + m, amax); }
        }
    }
}

DEV void phase_cl(const Frame& F0, int l) {
    const Frame F = refresh(F0);
    const int odd = l & 1; const int nhh = odd ? 4 : 8; const int nprob = B_ * nhh * 2 * NCH;
    LAS float* gc = (LAS float*)(F.lds);
    LAS float* bt = (LAS float*)(F.lds + 256);
    LAS int* rix = (LAS int*)(F.lds + 512);
    LAS float* qs = (LAS float*)(F.lds + 768);
    LAS float* ks = (LAS float*)(F.lds + 1024);
    LAS float* mt = (LAS float*)(F.lds + 1280);
    LAS float* sc = (LAS float*)(F.lds + 1536);
    LAS float* rsp = (LAS float*)(F.lds + 2048);
    LAS float* Am = (LAS float*)(F.lds + 4096);
    LAS bf16_t* An = (LAS bf16_t*)(F.lds + 20480);
    LAS bf16_t* XT = (LAS bf16_t*)(F.lds + 30720);
    LAS float* Rb = (LAS float*)(F.lds + 69632 + F.wave * 2048);
    LAS float* ksp = (LAS float*)(F.lds + 86016);
    const bf16_t* P = (const bf16_t*)(F.ws + WS_P); const bf16_t* Q = (const bf16_t*)(F.ws + WS_QKV); const float* GT = (const float*)(F.ws + WS_GATES);
    const int h = F.lane >> 5, l31 = F.lane & 31;
    for (int p = F.bid; p < nprob; p += F.G) {
        const int n = p % NCH, d = (p / NCH) & 1, hh = (p / (2 * NCH)) % nhh, b = p / (2 * NCH * nhh);
        const int kind = odd ? 2 : (hh < 4 ? 0 : 1);
        const bf16_t *qsrc, *ksrc, *vsrc; int qld, vld; float kscale = 1.0f;
        if (kind == 0) { qsrc = Q + hh * 128; ksrc = Q + 512 + hh * 128; vsrc = Q + 1024 + hh * 128; qld = 1536; vld = 1536; }
        else if (kind == 1) { qsrc = P + 2048 + (hh - 4) * 128; ksrc = P + 2560 + (hh - 4) * 128; vsrc = P + 3072 + (hh - 4) * 128; qld = NIN_E; vld = NIN_E; kscale = HD_SCALE; }
        else { qsrc = Q + hh * 128; ksrc = Q + 512 + hh * 128; vsrc = P + 1024 + hh * 128; qld = 1024; vld = NIN_O; }
        float* CS = (float*)(F.ws + WS_CLS) + (size_t)p * 512;
        if (F.wave == 0) {
            const int i = F.lane; const int row = tok_row(b, d, n * 64 + i); rix[i] = row;
            float g, be = 0.f;
            if (kind == 0) { g = GT[(size_t)row * 16 + d * 4 + hh]; be = GT[(size_t)row * 16 + 8 + d * 4 + hh]; }
            else if (kind == 1) g = log1pf(-exp2f(-(5.0f + 2.0f * (float)(hh - 4) + (float)d)));
            else { be = GT[(size_t)row * 16 + d * 4 + hh]; g = GT[(size_t)row * 16 + 8 + d * 4 + hh]; }
            float cum = g;
#pragma unroll
            for (int o = 1; o < 64; o <<= 1) { const float t = shfl_t(cum, i - o); if (i >= o) cum += t; }
            const float gend = shfl_t(cum, 63);
            gc[i] = cum; bt[i] = be;
            if (kind < 2) { qs[i] = expf(cum); ks[i] = expf(gend - cum) * kscale; if (i == 0) { sc[0] = expf(gend); CS[0] = expf(gend); } }
            else {
                const float mprev = ((const float*)(F.ws + WS_MCH))[(size_t)((b * 4 + hh) * 2 + d) * NCH + n];
                const float a = gend - cum + be; const float amax = wave_max(a); const float mnew = fmaxf(gend + mprev, amax);
                ks[i] = expf(a - mnew);
                float pm = be - cum;
#pragma unroll
                for (int o = 1; o < 64; o <<= 1) { const float t = shfl_t(pm, i - o); if (i >= o) pm = fmaxf(pm, t); }
                const float mti = cum + fmaxf(mprev, pm); mt[i] = mti; qs[i] = expf(cum + mprev - mti);
                CS[128 + i] = expf(-mti);
                if (i == 0) { const float dec = expf(gend + mprev - mnew); sc[0] = dec; CS[0] = dec; }
            }
        }
        __syncthreads();
        {
            const int w4 = F.wave & 3, mt_ = w4 >> 1, nt_ = w4 & 1; const bool doY = F.wave >= 4;
            if (!doY || kind == 0) {
                const int rj = rix[32 * mt_ + l31], ri = rix[32 * nt_ + l31];
                const bf16_t* ap = ksrc + (size_t)rj * qld + 8 * h; const bf16_t* bp = (doY ? ksrc : qsrc) + (size_t)ri * qld + 8 * h;
                f32x16 acc;
#pragma unroll
                for (int r = 0; r < 16; ++r) acc[r] = 0.f;
#pragma unroll
                for (int s = 0; s < 8; ++s) { const bf16x8 a = *(const bf16x8*)(ap + 16 * s), bb = *(const bf16x8*)(bp + 16 * s); acc = mfma32(a, bb, acc); }
                const int i = 32 * nt_ + l31; const float gi = gc[i];
                if (!doY) {
                    bf16_t* AQ = (bf16_t*)(F.ws + WS_CLA) + (size_t)p * 4096 + (size_t)i * 64; float rsum = 0.f; const float mti = kind == 2 ? mt[i] : 0.f;
#pragma unroll
                    for (int g4 = 0; g4 < 4; ++g4) { float v[4];
#pragma unroll
                        for (int r = 0; r < 4; ++r) { const int j = 32 * mt_ + 8 * g4 + 4 * h + r; float e;
                            if (kind < 2) e = expf(fminf(gi - gc[j], 0.f)); else e = expf(gi - gc[j] + bt[j] - mti);
                            v[r] = (i >= j) ? acc[4 * g4 + r] * kscale * e : 0.f; rsum += v[r]; }
                        *(u32x2*)(AQ + 32 * mt_ + 8 * g4 + 4 * h) = (u32x2){pk2(v[0], v[1]), pk2(v[2], v[3])}; }
                    if (kind == 2) rsp[i * 4 + mt_ * 2 + h] = rsum;
                } else {
                    const float bi = bt[i];
#pragma unroll
                    for (int r = 0; r < 16; ++r) { const int j = 32 * mt_ + 8 * (r >> 2) + 4 * h + (r & 3);
                        const float av = (i > j) ? bi * acc[r] * expf(fminf(gi - gc[j], 0.f)) : 0.f;
                        Am[i * 64 + j] = av; An[i * 72 + j] = (bf16_t)f2bf(-av); }
                }
            }
        }
        __syncthreads();
        if (kind == 0) {
            const int l15 = F.lane & 15, kg = F.lane >> 4; const int pg = ((b * 4 + hh) * 2 + d) * NCH + n;
            const bool isw = F.wave >= 4; const bf16_t* src = isw ? ksrc - 128 : vsrc;
            float* U = (float*)(F.ws + WS_CLU) + (size_t)pg * 8192; bf16_t* W = (bf16_t*)(F.ws + WS_CLW) + (size_t)p * 8192;
            float rhsv[4][2][4];
#pragma unroll
            for (int bb = 0; bb < 4; ++bb)
#pragma unroll
                for (int nt2 = 0; nt2 < 2; ++nt2)
#pragma unroll
                    for (int r = 0; r < 4; ++r) { const int i = 16 * bb + 4 * kg + r; rhsv[bb][nt2][r] = bf2f(src[(size_t)rix[i] * 1536 + 32 * F.wave + 16 * nt2 + l15]); }
#pragma unroll
            for (int bb = 0; bb < 4; ++bb) {
#pragma unroll
                for (int nt2 = 0; nt2 < 2; ++nt2) {
                    const int c = 32 * F.wave + 16 * nt2 + l15; f32x4 acc;
#pragma unroll
                    for (int r = 0; r < 4; ++r) { const int i = 16 * bb + 4 * kg + r; acc[r] = bt[i] * rhsv[bb][nt2][r] * (isw ? qs[i] : 1.0f); }
                    for (int ks = 0; ks < 2; ++ks) if (32 * ks < 16 * bb) {
                        const bool in = 32 * ks + 8 * kg + 8 <= 16 * bb;
                        bf16x8 a = *(const LAS bf16x8*)(An + (16 * bb + l15) * 72 + 32 * ks + 8 * kg); if (!in) a = (bf16x8){0, 0, 0, 0, 0, 0, 0, 0};
                        const bf16x8 xb = *(const LAS bf16x8*)(XT + c * 72 + 32 * ks + 8 * kg);
                        acc = mfma16(a, in ? xb : (bf16x8){0, 0, 0, 0, 0, 0, 0, 0}, acc); }
#pragma unroll
                    for (int r = 0; r < 4; ++r) Rb[(4 * kg + r) * 32 + 16 * nt2 + l15] = acc[r];
                }
                WAVE_LDS_SYNC();
                if (F.lane < 32) {
                    const int c = 32 * F.wave + F.lane; float x[16];
#pragma unroll
                    for (int i = 0; i < 16; ++i) { float r = Rb[i * 32 + F.lane];
#pragma unroll
                        for (int j = 0; j < i; ++j) r -= Am[(16 * bb + i) * 64 + 16 * bb + j] * x[j];
                        x[i] = r; }
                    if (!isw) {
#pragma unroll
                        for (int i = 0; i < 16; ++i) U[(16 * bb + i) * 128 + c] = x[i]; }
                    else {
#pragma unroll
                        for (int i = 0; i < 16; ++i) W[(16 * bb + i) * 128 + (c - 128)] = (bf16_t)f2bf(-x[i]); }
                    *(LAS u32x4*)(XT + c * 72 + 16 * bb) = (u32x4){pk2(x[0], x[1]), pk2(x[2], x[3]), pk2(x[4], x[5]), pk2(x[6], x[7])};
                    *(LAS u32x4*)(XT + c * 72 + 16 * bb + 8) = (u32x4){pk2(x[8], x[9]), pk2(x[10], x[11]), pk2(x[12], x[13]), pk2(x[14], x[15])};
                }
                WAVE_LDS_SYNC();
            }
        }
        {
            const int c = F.tid & 127, q4 = F.tid >> 7; bf16_t* QD = (bf16_t*)(F.ws + WS_CLQ) + (size_t)p * 8192 + c;
            for (int i = 16 * q4; i < 16 * q4 + 16; ++i) QD[i * 128] = (bf16_t)f2bf(bf2f(qsrc[(size_t)rix[i] * qld + c]) * qs[i]);
            bf16_t* KT = (bf16_t*)(F.ws + WS_CLK) + (size_t)p * 8192 + (size_t)c * 64;
            float ksum = 0.f;
            for (int j8 = 2 * q4; j8 < 2 * q4 + 2; ++j8) { float v[8];
#pragma unroll
                for (int r = 0; r < 8; ++r) { const int j = 8 * j8 + r; v[r] = bf2f(ksrc[(size_t)rix[j] * qld + c]) * ks[j]; ksum += v[r]; }
                *(u32x4*)(KT + 8 * j8) = (u32x4){pk2(v[0], v[1]), pk2(v[2], v[3]), pk2(v[4], v[5]), pk2(v[6], v[7])}; }
            ksp[c * 4 + q4] = ksum;
            if (kind == 2 && F.tid < 64) CS[64 + F.tid] = (rsp[F.tid * 4] + rsp[F.tid * 4 + 1]) + (rsp[F.tid * 4 + 2] + rsp[F.tid * 4 + 3]);
        }
        __syncthreads();
        if (kind == 2 && F.tid < 128) CS[256 + F.tid] = (ksp[F.tid * 4] + ksp[F.tid * 4 + 1]) + (ksp[F.tid * 4 + 2] + ksp[F.tid * 4 + 3]);
    }
}

#define LDS_BARRIER() do { WAIT_LGKM(0); S_BARRIER(); COMPILER_FENCE(); } while (0)
constexpr int SQ_W = 0, SQ_Q = 16384, SQ_K = 32768, SQ_A = 49152, SQ_U = 57344, SQ_C = 65536, SQ_STAGE = 67584;
constexpr int SQ_SB = 2 * SQ_STAGE, SQ_VN = SQ_SB + 8704, SQ_NV = SQ_VN + 4608, SQ_DEN = SQ_NV + 512;
static_assert(SQ_DEN + 256 <= LDS_MISC, "SEQ LDS map");
struct SeqCtx { int kind, b, hh, d, sl, chain, vld; const GAS bf16_t* vsrc; };
DEV int swz256(int r, int k) { return r * 256 + 16 * (k ^ (r & 15)); }
DEV int swz128(int r, int k) { return r * 128 + 16 * (k ^ ((r >> 1) & 7)); }
template <int KIND>
DEV void seq_dma(const Frame& F, const SeqCtx& C, int n, LAS unsigned char* img) {
    const int p = C.chain * NCH + n, w = F.wave; int ln = F.lane; LAUNDER(ln);
    if (w < 2) {
        if (KIND == 0) { const GAS char* g = (const GAS char*)(F.ws + WS_CLW) + (size_t)p * 16384; LAUNDER_S(g);
#pragma unroll
            for (int i = 0; i < 8; ++i) { const int r = 4 * (8 * w + i) + (ln >> 4), pp = ln & 15; glds16(g + r * 256 + 16 * (pp ^ (r & 15)), img + SQ_W + 1024 * (8 * w + i)); } }
    } else if (w < 4) {
        const GAS char* g = (const GAS char*)(F.ws + WS_CLQ) + (size_t)p * 16384; LAUNDER_S(g);
#pragma unroll
        for (int i = 0; i < 8; ++i) { const int c = 8 * (w - 2) + i, r = 4 * c + (ln >> 4), pp = ln & 15; glds16(g + r * 256 + 16 * (pp ^ (r & 15)), img + SQ_Q + 1024 * c); }
    } else if (w < 6) {
        const GAS char* g = (const GAS char*)(F.ws + WS_CLK) + (size_t)p * 16384; LAUNDER_S(g);
#pragma unroll
        for (int i = 0; i < 8; ++i) { const int c = 8 * (w - 4) + i, r = 8 * c + (ln >> 3), pp = ln & 7; glds16(g + r * 128 + 16 * (pp ^ ((r >> 1) & 7)), img + SQ_K + 1024 * c); }
    } else if (w == 6) {
        const GAS char* g = (const GAS char*)(F.ws + WS_CLA) + (size_t)p * 8192; LAUNDER_S(g);
#pragma unroll
        for (int i = 0; i < 8; ++i) { const int r = 8 * i + (ln >> 3), pp = ln & 7; glds16(g + r * 128 + 16 * (pp ^ ((r >> 1) & 7)), img + SQ_A + 1024 * i); }
    } else {
        if (KIND == 0) { const int pg = ((C.b * 4 + C.hh) * 2 + C.d) * NCH + n; const GAS char* g = (const GAS char*)(F.ws + WS_CLU) + (size_t)pg * 32768 + 128 * C.sl; LAUNDER_S(g);
#pragma unroll
            for (int i = 0; i < 8; ++i) { const int r = 8 * i + (ln >> 3); glds16(g + r * 512 + 16 * (ln & 7), img + SQ_U + 1024 * i); }
        } else { const int r0 = tok_row(C.b, C.d, n * 64); const long st = C.d ? -(long)C.vld * 2 : (long)C.vld * 2;
            const GAS char* g = (const GAS char*)C.vsrc + (long)r0 * C.vld * 2 + 64 * C.sl; LAUNDER_S(g);
#pragma unroll
            for (int i = 0; i < 4; ++i) { const int r = 16 * i + (ln >> 2); glds16(g + (long)r * st + 16 * (ln & 3), img + SQ_U + 1024 * i); }
        }
        const GAS char* cs = (const GAS char*)(F.ws + WS_CLS) + (size_t)p * 2048; LAUNDER_S(cs);
        glds16(cs + 16 * ln, img + SQ_C);
        if (KIND == 2) glds16(cs + 1024 + 16 * ln, img + SQ_C + 1024);
    }
}
#define SEQ_WAIT_DMA(younger) do { if ((younger) == 16) WAIT_VM(16); else WAIT_VM(0); } while (0)
template <int KIND>
DEV void seq_step(const Frame& F, const SeqCtx& C, int n, f32x16& acc, LAS unsigned char* lds) {
    int lz = F.lane; LAUNDER(lz); const int h = lz >> 5, l31 = lz & 31;
    LAS unsigned char* img = lds + (n & 1) * SQ_STAGE; LAS unsigned char* nimg = lds + ((n + 1) & 1) * SQ_STAGE;
    LAS bf16_t* Sb = (LAS bf16_t*)(lds + SQ_SB); LAS bf16_t* Vn = (LAS bf16_t*)(lds + SQ_VN); LAS float* nvec = (LAS float*)(lds + SQ_NV); LAS float* den = (LAS float*)(lds + SQ_DEN);
    const LAS float* CS = (const LAS float*)(img + SQ_C);
    seq_dma<KIND>(F, C, n + 1 < NCH ? n + 1 : NCH - 1, nimg);
    if (F.wave < 2) {
        const int mt_ = F.wave;
        if (KIND == 0) {
#pragma unroll
            for (int r = 0; r < 16; ++r) acc[r] = *(const LAS float*)(img + SQ_U + (32 * mt_ + 8 * (r >> 2) + 4 * h + (r & 3)) * 128 + 4 * l31);
            bf16x8 sb[8], wf[8]; const int rr = 32 * mt_ + l31;
#pragma unroll
            for (int s = 0; s < 8; ++s) { sb[s] = *(const LAS bf16x8*)(Sb + l31 * 136 + 16 * s + 8 * h); wf[s] = *(const LAS bf16x8*)(img + SQ_W + swz256(rr, 2 * s + h)); }
#pragma unroll
            for (int s = 0; s < 8; ++s) acc = mfma32(wf[s], sb[s], acc);
        } else {
#pragma unroll
            for (int r = 0; r < 16; ++r) acc[r] = bf2f(*(const LAS bf16_t*)(img + SQ_U + (32 * mt_ + 8 * (r >> 2) + 4 * h + (r & 3)) * 64 + 2 * l31));
        }
#pragma unroll
        for (int g4 = 0; g4 < 4; ++g4) *(LAS u32x2*)(Vn + l31 * 72 + 32 * mt_ + 8 * g4 + 4 * h) = (u32x2){pk2(acc[4 * g4], acc[4 * g4 + 1]), pk2(acc[4 * g4 + 2], acc[4 * g4 + 3])};
    } else if (F.wave < 4) {
        const int rr = 32 * (F.wave - 2) + l31;
#pragma unroll
        for (int r = 0; r < 16; ++r) acc[r] = 0.f;
        bf16x8 sb[8], qf[8];
#pragma unroll
        for (int s = 0; s < 8; ++s) { sb[s] = *(const LAS bf16x8*)(Sb + l31 * 136 + 16 * s + 8 * h); qf[s] = *(const LAS bf16x8*)(img + SQ_Q + swz256(rr, 2 * s + h)); }
#pragma unroll
        for (int s = 0; s < 8; ++s) acc = mfma32(qf[s], sb[s], acc);
    } else if (KIND == 2) {
        const int t = F.tid - 256, i = t >> 2, q = t & 3; float s = 0.f;
#pragma unroll
        for (int c8 = 0; c8 < 4; ++c8) { const u32x4 w = *(const LAS u32x4*)(img + SQ_Q + swz256(i, 4 * q + c8)); const LAS float* nv = nvec + 32 * q + 8 * c8;
            s += bflo(w.x) * nv[0] + bfhi(w.x) * nv[1] + bflo(w.y) * nv[2] + bfhi(w.y) * nv[3] + bflo(w.z) * nv[4] + bfhi(w.z) * nv[5] + bflo(w.w) * nv[6] + bfhi(w.w) * nv[7]; }
        s = group_sum<4>(s);
        if (q == 0) den[i] = fmaxf(fabsf(CS[64 + i] + s), CS[128 + i]);
    }
    LDS_BARRIER();
    if (F.wave >= 2 && F.wave < 4) {
        const int mt_ = F.wave - 2, rr = 32 * mt_ + l31;
        bf16x8 vb[4], af[4];
#pragma unroll
        for (int s = 0; s < 4; ++s) { vb[s] = *(const LAS bf16x8*)(Vn + l31 * 72 + 16 * s + 8 * h); af[s] = *(const LAS bf16x8*)(img + SQ_A + swz128(rr, 2 * s + h)); }
#pragma unroll
        for (int s = 0; s < 4; ++s) acc = mfma32(af[s], vb[s], acc);
        const int r0 = tok_row(C.b, C.d, n * 64); const long st = C.d ? -4096l : 4096l;
        GAS char* Ob = (GAS char*)(F.ws + WS_O) + ((size_t)C.d * MROWS + r0) * 4096 + (long)(32 * mt_) * st; LAUNDER_S(Ob); const long lo = (long)(4 * h) * st + (long)((C.hh * 128 + 32 * C.sl + l31) * 4);
#pragma unroll
        for (int r = 0; r < 16; ++r) { const int i = 32 * mt_ + 8 * (r >> 2) + 4 * h + (r & 3); float v = acc[r];
            if (KIND == 2) v = v / den[i];
            *(GAS float*)(Ob + (long)(8 * (r >> 2) + (r & 3)) * st + lo) = v; }
        SEQ_WAIT_DMA(16);
    } else if (F.wave >= 4) {
        const int kb = F.wave - 4, rr = 32 * kb + l31; const float ge = CS[0];
        bf16x8 vb[4], kf[4];
#pragma unroll
        for (int s = 0; s < 4; ++s) { vb[s] = *(const LAS bf16x8*)(Vn + l31 * 72 + 16 * s + 8 * h); kf[s] = *(const LAS bf16x8*)(img + SQ_K + swz128(rr, 2 * s + h)); }
#pragma unroll
        for (int r = 0; r < 16; ++r) acc[r] *= ge;
#pragma unroll
        for (int s = 0; s < 4; ++s) acc = mfma32(kf[s], vb[s], acc);
#pragma unroll
        for (int g4 = 0; g4 < 4; ++g4) *(LAS u32x2*)(Sb + l31 * 136 + 32 * kb + 8 * g4 + 4 * h) = (u32x2){pk2(acc[4 * g4], acc[4 * g4 + 1]), pk2(acc[4 * g4 + 2], acc[4 * g4 + 3])};
        if (KIND == 2 && F.tid < 256 + 128) { const int dd = F.tid - 256; nvec[dd] = ge * nvec[dd] + CS[256 + dd]; }
        SEQ_WAIT_DMA(0);
    } else SEQ_WAIT_DMA(0);
    LDS_BARRIER();
}
template <int KIND>
DEV void seq_kind_loop(const Frame& F, const SeqCtx& C, LAS unsigned char* lds) {
    f32x16 acc;
#pragma unroll
    for (int r = 0; r < 16; ++r) acc[r] = 0.f;
    seq_dma<KIND>(F, C, 0, lds);
    WAIT_VM(0);
    LDS_BARRIER();
    for (int n = 0; n < NCH; ++n) seq_step<KIND>(F, C, n, acc, lds);
}
DEV void seq_linear_item(const Frame& F, int l, int item) {
    const int odd = l & 1, nhh = odd ? 4 : 8;
    SeqCtx C; C.sl = item & 3; C.chain = item >> 2; C.d = C.chain & 1; C.hh = (C.chain >> 1) % nhh; C.b = C.chain / (2 * nhh);
    C.kind = odd ? 2 : (C.hh < 4 ? 0 : 1);
    const GAS bf16_t* P = (const GAS bf16_t*)(F.ws + WS_P); const GAS bf16_t* Q = (const GAS bf16_t*)(F.ws + WS_QKV);
    if (C.kind == 0) { C.vsrc = Q + 1024 + C.hh * 128; C.vld = 1536; } else if (C.kind == 1) { C.vsrc = P + 3072 + (C.hh - 4) * 128; C.vld = NIN_E; } else { C.vsrc = P + 1024 + C.hh * 128; C.vld = NIN_O; }
    for (int i = F.tid; i < 32 * 136 / 2; i += NTHREADS) ((LAS unsigned*)(F.lds + SQ_SB))[i] = 0u;
    if (F.tid < 128) ((LAS float*)(F.lds + SQ_NV))[F.tid] = 0.f;
    __syncthreads();
    if (C.kind == 0) seq_kind_loop<0>(F, C, F.lds); else if (C.kind == 1) seq_kind_loop<1>(F, C, F.lds); else seq_kind_loop<2>(F, C, F.lds);
    WAIT_VM(0);
}

DEV void seq_s5_item(const Frame& F, int l, int item) {
    const int o = l >> 1; const int g = item & 31, d = (item >> 5) & 1, b = item >> 6;
    LAS float* El = (LAS float*)(F.lds);
    LAS float* scr = (LAS float*)(F.lds + 36864 + F.wave * 8192);
    LAS bf16_t* hb = (LAS bf16_t*)(F.lds + 36864 + 65536 + F.wave * 4096);
    const bf16_t* P = (const bf16_t*)(F.ws + WS_P);
    const float* Ab = (const float*)(F.ws + WS_S5A) + (size_t)((o * 2 + d) * 32 + g) * 128;
    const bf16_t* Bb = (const bf16_t*)(F.ws + WS_S5B) + (size_t)((o * 2 + d) * 32 + g) * 128 * 16;
    const bf16_t* Cm = (const bf16_t*)(F.ws + WS_S5C) + (size_t)(o * 32 + g) * 16 * 128;
    const int l15 = F.lane & 15, kg = F.lane >> 4;
    const float ar = Ab[F.lane], ai = Ab[64 + F.lane];
    bf16x8 bB[8], cB[4]; const bf16x8 zero8 = (bf16x8){0, 0, 0, 0, 0, 0, 0, 0};
#pragma unroll
    for (int ct = 0; ct < 8; ++ct) bB[ct] = kg < 2 ? *(const bf16x8*)(Bb + (size_t)(16 * ct + l15) * 16 + 8 * kg) : zero8;
#pragma unroll
    for (int s = 0; s < 4; ++s) cB[s] = *(const bf16x8*)(Cm + (size_t)l15 * 128 + 32 * s + 8 * kg);
    float* Obase = (float*)(F.ws + WS_O) + (size_t)d * MROWS * 1024 + 512 + 16 * g;
    for (int pass = 0; pass < 2; ++pass) {
        for (int n = F.wave; n < NCH; n += NWAVES) {
            float hr = 0.f, hi = 0.f;
            if (pass) { hr = El[n * 128 + F.lane]; hi = El[n * 128 + 64 + F.lane]; }
            for (int st = 0; st < 4; ++st) {
                const int sp0 = n * 64 + 16 * st;
                const bf16x8 a = kg < 2 ? *(const bf16x8*)(P + (size_t)tok_row(b, d, sp0 + l15) * NIN_O + 2048 + 16 * g + 8 * kg) : zero8;
#pragma unroll
                for (int ct = 0; ct < 8; ++ct) { f32x4 acc = (f32x4){0.f, 0.f, 0.f, 0.f}; acc = mfma16(a, bB[ct], acc);
#pragma unroll
                    for (int r = 0; r < 4; ++r) scr[(4 * kg + r) * 128 + 16 * ct + l15] = acc[r]; }
                WAVE_LDS_SYNC();
#pragma unroll
                for (int t = 0; t < 16; ++t) { const float br = scr[t * 128 + F.lane], bi = scr[t * 128 + 64 + F.lane];
                    const float nr = ar * hr - ai * hi + br, ni = ar * hi + ai * hr + bi; hr = nr; hi = ni;
                    if (pass) { hb[t * 128 + F.lane] = (bf16_t)f2bf(hr); hb[t * 128 + 64 + F.lane] = (bf16_t)f2bf(hi); } }
                WAVE_LDS_SYNC();
                if (pass) { f32x4 acc = (f32x4){0.f, 0.f, 0.f, 0.f};
#pragma unroll
                    for (int s = 0; s < 4; ++s) { const bf16x8 ha = *(const LAS bf16x8*)(hb + l15 * 128 + 32 * s + 8 * kg); acc = mfma16(ha, cB[s], acc); }
#pragma unroll
                    for (int r = 0; r < 4; ++r) Obase[(size_t)tok_row(b, d, sp0 + 4 * kg + r) * 1024 + l15] = acc[r];
                    WAVE_LDS_SYNC(); }
            }
            if (!pass) { El[n * 128 + F.lane] = hr; El[n * 128 + 64 + F.lane] = hi; }
        }
        __syncthreads();
        if (!pass) {
            if (F.wave == 0) { float pr = ar, pi = ai;
#pragma unroll
                for (int q = 0; q < 6; ++q) { const float nr = pr * pr - pi * pi, ni = 2.0f * pr * pi; pr = nr; pi = ni; }
                float hr = 0.f, hi = 0.f;
                for (int n = 0; n < NCH; ++n) { const float er = El[n * 128 + F.lane], ei = El[n * 128 + 64 + F.lane];
                    El[n * 128 + F.lane] = hr; El[n * 128 + 64 + F.lane] = hi;
                    const float nr = pr * hr - pi * hi + er, ni = pr * hi + pi * hr + ei; hr = nr; hi = ni; } }
            __syncthreads();
        }
    }
}

DEV void phase_seq(const Frame& F0, int l, int mode = 0) {
    const Frame F = refresh(F0);
    const int odd = l & 1; const int nlin = B_ * (odd ? 4 : 8) * 2 * 4; const int ns5 = odd ? B_ * 2 * 32 : 0;
    const int vcu = (F.G % 8 == 0) ? (F.bid % 8) * (F.G / 8) + F.bid / 8 : F.bid;
    for (int it = vcu; it < nlin + ns5; it += F.G) {
        if (it < nlin) { if (mode != 2) seq_linear_item(F, l, it); } else if (mode != 1) seq_s5_item(F, l, it - nlin);
        __syncthreads();
    }
}

DEV void phase_merge(const Frame& F0, int l) {
    const Frame F = refresh(F0);
    const int odd = l & 1, li = l >> 1; const bf16_t* P = (const bf16_t*)(F.ws + WS_P);
    const float* O0 = (const float*)(F.ws + WS_O); const float* O1 = O0 + (size_t)MROWS * 1024;
    bf16_t* MG = (bf16_t*)(F.ws + WS_MERGED);
    ROW_LOOP(r, MROWS) {
        if (!odd) {
            const int c0 = 16 * F.lane; float v[16];
#pragma unroll
            for (int q = 0; q < 4; ++q) { const f32x4 a = *(const f32x4*)(O0 + (size_t)r * 1024 + c0 + 4 * q), bq = *(const f32x4*)(O1 + (size_t)r * 1024 + c0 + 4 * q);
                v[4 * q] = a.x + bq.x; v[4 * q + 1] = a.y + bq.y; v[4 * q + 2] = a.z + bq.z; v[4 * q + 3] = a.w + bq.w; }
            float s = 0.f;
#pragma unroll
            for (int i = 0; i < 16; ++i) s += v[i];
            s = group_sum<8>(s);
            const bool ret = F.lane >= 32; const float mu = ret ? s * (1.0f / 128.0f) : 0.f; float q2 = 0.f;
#pragma unroll
            for (int i = 0; i < 16; ++i) { v[i] -= mu; q2 += v[i] * v[i]; }
            q2 = group_sum<8>(q2);
            const float rstd = 1.0f / sqrtf(q2 * (1.0f / 128.0f) + LN_EPS);
            const bf16_t* zp = P + (size_t)r * NIN_E + (ret ? 3584 + (c0 - 512) : 1536 + c0);
            const float* gp = ret ? GIN(I_EVRETN) + li * 512 + (c0 - 512) : GIN(I_EVGDNN) + li * 128 + (c0 & 127);
            unsigned ow[8];
#pragma unroll
            for (int i = 0; i < 16; i += 2) { const float z0 = bf2f(zp[i]), z1 = bf2f(zp[i + 1]); ow[i >> 1] = pk2(v[i] * rstd * gp[i] * silu_f(z0), v[i + 1] * rstd * gp[i + 1] * silu_f(z1)); }
            u32x4* op = (u32x4*)(MG + (size_t)r * 1024 + c0); op[0] = (u32x4){ow[0], ow[1], ow[2], ow[3]}; op[1] = (u32x4){ow[4], ow[5], ow[6], ow[7]};
        } else {
            const int c0 = 8 * F.lane; float v[8];
#pragma unroll
            for (int q = 0; q < 2; ++q) { const f32x4 a = *(const f32x4*)(O0 + (size_t)r * 1024 + c0 + 4 * q), bq = *(const f32x4*)(O1 + (size_t)r * 1024 + c0 + 4 * q);
                v[4 * q] = a.x + bq.x; v[4 * q + 1] = a.y + bq.y; v[4 * q + 2] = a.z + bq.z; v[4 * q + 3] = a.w + bq.w; }
            float s = 0.f;
#pragma unroll
            for (int i = 0; i < 8; ++i) s += v[i];
            s = group_sum<16>(s);
            const float mu = s * (1.0f / 128.0f); float q2 = 0.f;
#pragma unroll
            for (int i = 0; i < 8; ++i) { v[i] -= mu; q2 += v[i] * v[i]; }
            q2 = group_sum<16>(q2);
            const float rstd = 1.0f / sqrtf(q2 * (1.0f / 128.0f) + LN_EPS);
            const bf16_t* zp = P + (size_t)r * NIN_O + 1536 + c0; const float* gp = GIN(I_ODMN) + li * 512 + c0;
            unsigned ow[4];
#pragma unroll
            for (int i = 0; i < 8; i += 2) ow[i >> 1] = pk2(v[i] * rstd * gp[i] * sigmoid_f(bf2f(zp[i])), v[i + 1] * rstd * gp[i + 1] * sigmoid_f(bf2f(zp[i + 1])));
            *(u32x4*)(MG + (size_t)r * 1024 + c0) = (u32x4){ow[0], ow[1], ow[2], ow[3]};
            const bf16_t* up = P + (size_t)r * NIN_O + 2048 + c0; const float* dsk = GIN(I_ODDSKIP) + li * 512 + c0;
#pragma unroll
            for (int q = 0; q < 2; ++q) { const f32x4 a = *(const f32x4*)(O0 + (size_t)r * 1024 + 512 + c0 + 4 * q), bq = *(const f32x4*)(O1 + (size_t)r * 1024 + 512 + c0 + 4 * q);
                v[4 * q] = a.x + bq.x; v[4 * q + 1] = a.y + bq.y; v[4 * q + 2] = a.z + bq.z; v[4 * q + 3] = a.w + bq.w; }
#pragma unroll
            for (int i = 0; i < 8; i += 2) ow[i >> 1] = pk2(gelu_tanh_f(v[i] + dsk[i] * bf2f(up[i])), gelu_tanh_f(v[i + 1] + dsk[i + 1] * bf2f(up[i + 1])));
            *(u32x4*)((bf16_t*)(F.ws + WS_YS) + (size_t)r * 512 + c0) = (u32x4){ow[0], ow[1], ow[2], ow[3]};
        }
    }
}

DEV void ln_rows(const Frame& F, f32x4 (&t)[RG][4], const float* lg, const float* lb) {
    float mean[RG], rstd[RG];
#pragma unroll
    for (int q = 0; q < RG; ++q) { float sum = 0.f;
#pragma unroll
        for (int j = 0; j < 4; ++j) sum += (t[q][j].x + t[q][j].y) + (t[q][j].z + t[q][j].w);
        mean[q] = wave_sum(sum) * (1.0f / 1024.0f); }
#pragma unroll
    for (int q = 0; q < RG; ++q) { float s2 = 0.f;
#pragma unroll
        for (int j = 0; j < 4; ++j) { t[q][j] = t[q][j] - mean[q]; s2 += (t[q][j].x * t[q][j].x + t[q][j].y * t[q][j].y) + (t[q][j].z * t[q][j].z + t[q][j].w * t[q][j].w); }
        rstd[q] = 1.0f / sqrtf(wave_sum(s2) * (1.0f / 1024.0f) + LN_EPS); }
#pragma unroll
    for (int j = 0; j < 4; ++j) { const f32x4 gg = *((const f32x4*)lg + F.lane + 64 * j), bb = *((const f32x4*)lb + F.lane + 64 * j);
#pragma unroll
        for (int q = 0; q < RG; ++q) t[q][j] = t[q][j] * rstd[q] * gg + bb; }
}
DEV void phase_ln1(const Frame& F0, int l) {
    const Frame F = refresh(F0);
    const float* Y = (const float*)(F.ws + WS_Y); float* H = (float*)(F.ws + WS_H);
    const float* lg = GIN(I_LN1G) + l * 1024; const float* lb = GIN(I_LN1B) + l * 1024; const float* wr = (const float*)(F.ws + WS_WR) + (size_t)l * NE * 1024;
    for (int r = RG * F.gw; r < MROWS; r += RG * F.NGW) {
        const int b = r / TOK, s = r % TOK, mr = s < CTX ? B_ : b; const float* mod = (const float*)(F.ws + WS_MOD) + ((size_t)l * NR + mr) * 6144;
        f32x4 t[RG][4];
#pragma unroll
        for (int j = 0; j < 4; ++j) { const f32x4 g1 = *((const f32x4*)(mod + 2048) + F.lane + 64 * j);
#pragma unroll
            for (int q = 0; q < RG; ++q) { const f32x4 hv = *((const f32x4*)(H + (size_t)(r + q) * 1024) + F.lane + 64 * j), yv = *((const f32x4*)(Y + (size_t)(r + q) * 1024) + F.lane + 64 * j); t[q][j] = ALPHA * hv + g1 * yv; }
            if (j & 1) COMPILER_FENCE(); }
        ln_rows(F, t, lg, lb);
        COMPILER_FENCE();
#pragma unroll
        for (int j = 0; j < 4; ++j) { const f32x4 sh = *((const f32x4*)(mod + 3072) + F.lane + 64 * j), scv = *((const f32x4*)(mod + 4096) + F.lane + 64 * j);
#pragma unroll
            for (int q = 0; q < RG; ++q) { *((f32x4*)(H + (size_t)(r + q) * 1024) + F.lane + 64 * j) = t[q][j]; t[q][j] = t[q][j] * (1.0f + scv) + sh; } }
        COMPILER_FENCE();
#pragma unroll
        for (int q = 0; q < RG; ++q) { u32x2* xo = (u32x2*)((bf16_t*)(F.ws + WS_XIN) + (size_t)(r + q) * 1024) + F.lane;
#pragma unroll
            for (int j = 0; j < 4; ++j) xo[64 * j] = (u32x2){pk2(t[q][j].x, t[q][j].y), pk2(t[q][j].z, t[q][j].w)}; }
        float mine[RG]; const int ei = F.lane % NE;
#pragma unroll
        for (int q = 0; q < RG; ++q) mine[q] = 0.f;
        f32x4 wc[4];
#pragma unroll
        for (int j = 0; j < 4; ++j) wc[j] = *((const f32x4*)wr + F.lane + 64 * j);
#pragma unroll 1
        for (int e = 0; e < NE; ++e) { f32x4 wn[4]; const int en = e + 1 < NE ? e + 1 : e;
#pragma unroll
            for (int j = 0; j < 4; ++j) wn[j] = *((const f32x4*)(wr + en * 1024) + F.lane + 64 * j);
#pragma unroll
            for (int q = 0; q < RG; ++q) { float p = 0.f;
#pragma unroll
                for (int j = 0; j < 4; ++j) p += t[q][j].x * wc[j].x + t[q][j].y * wc[j].y + t[q][j].z * wc[j].z + t[q][j].w * wc[j].w;
                const float ws_ = wave_sum(p); mine[q] = (ei == e) ? ws_ : mine[q]; }
#pragma unroll
            for (int j = 0; j < 4; ++j) wc[j] = wn[j]; }
#pragma unroll
        for (int q = 0; q < RG; ++q) { const float mx = group_max<NE>(mine[q]); const float ex = expf(mine[q] - mx); const float se = group_sum<NE>(ex);
            if (F.lane < NE) ((float*)(F.ws + WS_AFF))[(size_t)(r + q) * 16 + F.lane] = ex / se; }
    }
}

DEV void phase_topk(const Frame& F0) {
    const Frame F = refresh(F0);
    LAS unsigned* hist = (LAS unsigned*)(F.lds);
    LAS unsigned* selw = (LAS unsigned*)(F.lds + 1024);
    LAS unsigned* cnt = (LAS unsigned*)(F.lds + 2048);
    LAS int* selrow = (LAS int*)(F.lds + 8192);
    const float* AFF = (const float*)(F.ws + WS_AFF); int* SLOT = (int*)(F.ws + WS_SLOT); float* EG = (float*)(F.ws + WS_EGATE);
    for (int it = F.bid; it < 2 * B_ * NE; it += F.G) {
        const int e = it % NE, set = it / NE, kind = set / B_, b = set % B_;
        const int n = kind ? CTX : SEQ, cap = kind ? CAPC : CAPL; const int row0 = b * TOK + (kind ? 0 : CTX);
        const int sbase = kind ? B_ * CAPL + b * CAPC : b * CAPL;
        const int per = n >= NTHREADS ? n / NTHREADS : 1; const bool act = F.tid * per < n;
        unsigned key[8];
#pragma unroll
        for (int k = 0; k < 8; ++k) key[k] = (act && k < per) ? __builtin_bit_cast(unsigned, AFF[(size_t)(row0 + F.tid * per + k) * 16 + e]) : 0u;
        unsigned prefix = 0u, remaining = (unsigned)cap;
        for (int pass = 0; pass < 4; ++pass) {
            const int shift = 24 - 8 * pass; const unsigned mask = pass == 0 ? 0u : (0xFFFFFFFFu << (shift + 8));
            if (F.tid < 256) hist[F.tid] = 0u;
            __syncthreads();
#pragma unroll
            for (int k = 0; k < 8; ++k) if (act && k < per && ((key[k] & mask) == (prefix & mask))) lds_atomic_add(&hist[(key[k] >> shift) & 255u], 1u);
            __syncthreads();
            if (F.tid == 0) { unsigned cum = 0u; int dsel = 0;
                for (int dgt = 255; dgt >= 0; --dgt) { const unsigned hc = hist[dgt]; if (cum + hc >= remaining) { dsel = dgt; break; } cum += hc; }
                selw[0] = prefix | ((unsigned)dsel << shift); selw[1] = remaining - cum; }
            __syncthreads();
            prefix = selw[0]; remaining = selw[1];
            __syncthreads();
        }
        const unsigned T = prefix, need_eq = remaining;
        unsigned ngt = 0u, neq = 0u;
#pragma unroll
        for (int k = 0; k < 8; ++k) if (act && k < per) { ngt += key[k] > T ? 1u : 0u; neq += key[k] == T ? 1u : 0u; }
        cnt[2 * F.tid] = ngt; cnt[2 * F.tid + 1] = neq;
        __syncthreads();
        if (F.tid == 0) { unsigned a = 0u, c = 0u; for (int t = 0; t < NTHREADS; ++t) { const unsigned x = cnt[2 * t], y = cnt[2 * t + 1]; cnt[2 * t] = a; cnt[2 * t + 1] = c; a += x; c += y; } }
        __syncthreads();
        unsigned gtb = cnt[2 * F.tid], eqb = cnt[2 * F.tid + 1];
#pragma unroll
        for (int k = 0; k < 8; ++k) if (act && k < per) {
            const int row = row0 + F.tid * per + k; int slot = -1;
            const bool isgt = key[k] > T, iseq = key[k] == T;
            if (isgt || (iseq && eqb < need_eq)) { slot = (int)(gtb + (eqb < need_eq ? eqb : need_eq)); selrow[slot] = row; EG[(size_t)e * EPAD + sbase + slot] = __builtin_bit_cast(float, key[k]); }
            SLOT[(size_t)row * 16 + e] = slot >= 0 ? sbase + slot : -1;
            gtb += isgt ? 1u : 0u; eqb += iseq ? 1u : 0u;
        }
        __syncthreads();
        for (int sl = F.tid; sl < cap; sl += NTHREADS) ((int*)(F.ws + WS_EIDX))[(size_t)e * EPAD + sbase + sl] = selrow[sl];
        if (it < NE) for (int pr = EROWS + F.tid; pr < EPAD; pr += NTHREADS) EG[(size_t)e * EPAD + pr] = 0.f;
        __syncthreads();
    }
}

DEV void phase_gather(const Frame& F0) {
    const Frame F = refresh(F0);
    const int* EI = (const int*)(F.ws + WS_EIDX);
    for (int r0 = 4 * F.gw; r0 < NE * EPAD; r0 += 4 * F.NGW) {
        u32x4 v[4][2];
#pragma unroll
        for (int q = 0; q < 4; ++q) { const int r = r0 + q, sl = r % EPAD; v[q][0] = (u32x4){0u, 0u, 0u, 0u}; v[q][1] = v[q][0];
            if (sl < EROWS) { const u32x4* src = (const u32x4*)((const bf16_t*)(F.ws + WS_XIN) + (size_t)EI[r] * 1024) + F.lane; v[q][0] = src[0]; v[q][1] = src[64]; } }
#pragma unroll
        for (int q = 0; q < 4; ++q) { u32x4* dst = (u32x4*)((bf16_t*)(F.ws + WS_XS) + (size_t)(r0 + q) * 1024) + F.lane; dst[0] = v[q][0]; dst[64] = v[q][1]; }
    }
}

DEV void phase_ln2(const Frame& F0, int l) {
    const Frame F = refresh(F0);
    float* H = (float*)(F.ws + WS_H); const int* SLOT = (const int*)(F.ws + WS_SLOT); const float* YSE = (const float*)(F.ws + WS_YSE);
    const float* lg = GIN(I_LN2G) + l * 1024; const float* lb = GIN(I_LN2B) + l * 1024;
    for (int r = RG * F.gw; r < MROWS; r += RG * F.NGW) {
        const int b = r / TOK, s = r % TOK, mr = s < CTX ? B_ : b; const float* mod = (const float*)(F.ws + WS_MOD) + ((size_t)l * NR + mr) * 6144;
        f32x4 t[RG][4];
#pragma unroll
        for (int q = 0; q < RG; ++q) {
#pragma unroll
            for (int j = 0; j < 4; ++j) t[q][j] = (f32x4){0.f, 0.f, 0.f, 0.f}; }
        const int myslot = F.lane < RG * 16 ? SLOT[(size_t)r * 16 + F.lane] : -1;
#pragma unroll
        for (int q = 0; q < RG; ++q)
#pragma unroll
            for (int e = 0; e < NE; ++e) { const int sl = bcast_lane(myslot, 16 * q + e);
                if (sl >= 0) { const f32x4* yp = (const f32x4*)(YSE + ((size_t)e * EPAD + sl) * 1024) + F.lane;
#pragma unroll
                    for (int j = 0; j < 4; ++j) t[q][j] += yp[64 * j]; } }
#pragma unroll
        for (int j = 0; j < 4; ++j) { const f32x4 g2 = *((const f32x4*)(mod + 5120) + F.lane + 64 * j);
#pragma unroll
            for (int q = 0; q < RG; ++q) { const f32x4 hv = *((const f32x4*)(H + (size_t)(r + q) * 1024) + F.lane + 64 * j); t[q][j] = ALPHA * hv + g2 * t[q][j]; } }
        ln_rows(F, t, lg, lb);
        if (l == DEPTH - 1) {
            if (s >= CTX) {
#pragma unroll
                for (int q = 0; q < RG; ++q) { GAS f32x4* op = (GAS f32x4*)(F.out + ((size_t)b * SEQ + (s - CTX + q)) * 1024) + F.lane;
#pragma unroll
                    for (int j = 0; j < 4; ++j) op[64 * j] = t[q][j]; } }
        } else {
#pragma unroll
            for (int q = 0; q < RG; ++q)
#pragma unroll
                for (int j = 0; j < 4; ++j) *((f32x4*)(H + (size_t)(r + q) * 1024) + F.lane + 64 * j) = t[q][j];
            xg_rows(F, l + 1, r, t);
        }
    }
}

struct EpiP {
    static constexpr bool PERM = true;
    bf16_t* O; int ldc;
    DEV void operator()(const f32x4 (&acc)[2][2][4][2], const pg8::Unit& u, int wr, int wc, int fr, int fq) const {
        const int row0 = u.pm * 256 + wr * 64 + fr, col0 = u.pn * 256 + wc * 32 + 8 * fq;
#pragma unroll
        for (int ai = 0; ai < 2; ++ai)
#pragma unroll
            for (int m = 0; m < 4; ++m) { bf16_t* rowp = O + (size_t)(row0 + ai * 128 + m * 16) * ldc + col0;
#pragma unroll
                for (int bj = 0; bj < 2; ++bj) { const f32x4 v0 = acc[ai][bj][m][0], v1 = acc[ai][bj][m][1];
                    u32x4 w; w.x = pg8::cvt_pk_bf16(v0[0], v0[1]); w.y = pg8::cvt_pk_bf16(v0[2], v0[3]); w.z = pg8::cvt_pk_bf16(v1[0], v1[1]); w.w = pg8::cvt_pk_bf16(v1[2], v1[3]);
                    *(u32x4*)(rowp + bj * 128) = w; } }
    }
};
struct EpiGlu {
    static constexpr bool PERM = true;
    bf16_t* MG; const bf16_t* YS; const float* bias;
    DEV void operator()(const f32x4 (&acc)[2][2][4][2], const pg8::Unit& u, int wr, int wc, int fr, int fq) const {
        const int row0 = u.pm * 256 + wr * 64 + fr, col0 = u.pn * 256 + wc * 32 + 8 * fq;
#pragma unroll
        for (int ai = 0; ai < 2; ++ai)
#pragma unroll
            for (int m = 0; m < 4; ++m) { const int row = row0 + ai * 128 + m * 16;
#pragma unroll
                for (int bj = 0; bj < 2; ++bj) { const int c = col0 + bj * 128; const f32x4 v0 = acc[ai][bj][m][0], v1 = acc[ai][bj][m][1];
                    const u32x4 yv = *(const u32x4*)(YS + (size_t)row * 512 + c); const f32x4 b0 = *(const f32x4*)(bias + c), b1 = *(const f32x4*)(bias + c + 4);
                    u32x4 w; w.x = pk2(bflo(yv.x) * sigmoid_f(v0[0] + b0[0]), bfhi(yv.x) * sigmoid_f(v0[1] + b0[1])); w.y = pk2(bflo(yv.y) * sigmoid_f(v0[2] + b0[2]), bfhi(yv.y) * sigmoid_f(v0[3] + b0[3]));
                    w.z = pk2(bflo(yv.z) * sigmoid_f(v1[0] + b1[0]), bfhi(yv.z) * sigmoid_f(v1[1] + b1[1])); w.w = pk2(bflo(yv.w) * sigmoid_f(v1[2] + b1[2]), bfhi(yv.w) * sigmoid_f(v1[3] + b1[3]));
                    *(u32x4*)(MG + (size_t)row * 1024 + 512 + c) = w; } }
    }
};
struct EpiF32 {
    static constexpr bool PERM = false;
    float* C; int ldc; const float* rowscale;
    DEV void operator()(const f32x4 (&acc)[2][2][4][2], const pg8::Unit& u, int wr, int wc, int fr, int fq) const {
        const int row0 = u.pm * 256 + wr * 64 + fr, col0 = u.pn * 256 + wc * 32 + 4 * fq;
        const size_t ebase = rowscale ? (size_t)u.e * EPAD : 0;
#pragma unroll
        for (int ai = 0; ai < 2; ++ai)
#pragma unroll
            for (int m = 0; m < 4; ++m) { const size_t row = ebase + row0 + ai * 128 + m * 16; const float sc = rowscale ? rowscale[row] : 1.0f; float* rowp = C + row * ldc + col0;
#pragma unroll
                for (int bj = 0; bj < 2; ++bj)
#pragma unroll
                    for (int n = 0; n < 2; ++n) *(f32x4*)(rowp + bj * 128 + n * 16) = acc[ai][bj][m][n] * sc; }
    }
};
struct EpiSwiglu {
    static constexpr bool PERM = true;
    bf16_t* HID;
    DEV void operator()(const f32x4 (&acc)[2][2][4][2], const pg8::Unit& u, int wr, int wc, int fr, int fq) const {
        const int row0 = u.pm * 256 + wr * 64 + fr, col0 = u.pn * 128 + wc * 32 + 8 * fq;
#pragma unroll
        for (int ai = 0; ai < 2; ++ai)
#pragma unroll
            for (int m = 0; m < 4; ++m) { bf16_t* rowp = HID + ((size_t)u.e * EPAD + row0 + ai * 128 + m * 16) * FF + col0;
                const f32x4 g0 = acc[ai][0][m][0], g1 = acc[ai][0][m][1], u0 = acc[ai][1][m][0], u1 = acc[ai][1][m][1];
                u32x4 w; w.x = pk2(silu_f(g0[0]) * u0[0], silu_f(g0[1]) * u0[1]); w.y = pk2(silu_f(g0[2]) * u0[2], silu_f(g0[3]) * u0[3]);
                w.z = pk2(silu_f(g1[0]) * u1[0], silu_f(g1[1]) * u1[1]); w.w = pk2(silu_f(g1[2]) * u1[2], silu_f(g1[3]) * u1[3]);
                *(u32x4*)rowp = w; }
    }
};

DEV void gemm_g1(const Frame& F0, int l, int vcu) {
    const Frame F = refresh(F0);
    const int nin = (l & 1) ? NIN_O : NIN_E;
    pg8::PlainOrder S; S.init((const void*)(F.ws + WS_XIN), (const bf16_t*)(F.ws + WS_WIN) + (size_t)l * NINMAX * 1024, 1024, MPAD, nin, F.G, vcu);
    EpiP E; E.O = (bf16_t*)(F.ws + WS_P); E.ldc = nin;
    pg8::gemm_phase(F.lds, 1024, S, E, F.wave, F.lane);
}
DEV void gemm_glu(const Frame& F0, int l, int vcu) {
    const Frame F = refresh(F0);
    const int li = l >> 1;
    pg8::PlainOrder S; S.init((const void*)(F.ws + WS_YS), (const bf16_t*)(F.ws + WS_WGLU) + (size_t)li * 512 * 512, 512, MPAD, 512, F.G, vcu);
    EpiGlu E; E.MG = (bf16_t*)(F.ws + WS_MERGED); E.YS = (const bf16_t*)(F.ws + WS_YS); E.bias = GIN(I_ODBGLU) + li * 512;
    pg8::gemm_phase(F.lds, 512, S, E, F.wave, F.lane);
}
DEV void gemm_g3(const Frame& F0, int l, int vcu) {
    const Frame F = refresh(F0);
    pg8::PlainOrder S; S.init((const void*)(F.ws + WS_MERGED), (const bf16_t*)(F.ws + WS_WOUT) + (size_t)l * 1024 * 1024, 1024, MPAD, 1024, F.G, vcu);
    EpiF32 E; E.C = (float*)(F.ws + WS_Y); E.ldc = 1024; E.rowscale = nullptr;
    pg8::gemm_phase(F.lds, 1024, S, E, F.wave, F.lane);
}
DEV void gemm_g4(const Frame& F0, int l, int vcu) {
    const Frame F = refresh(F0);
    pg8::GroupedOrder S; S.init((const void*)(F.ws + WS_XS), (const bf16_t*)(F.ws + WS_WGU) + (size_t)l * NE * 2 * FF * 1024, 1024, 2 * FF, F.G, vcu);
    EpiSwiglu E; E.HID = (bf16_t*)(F.ws + WS_HID);
    pg8::gemm_phase(F.lds, 1024, S, E, F.wave, F.lane);
}
DEV void gemm_g5(const Frame& F0, int l, int vcu) {
    const Frame F = refresh(F0);
    pg8::GroupedOrder S; S.init((const void*)(F.ws + WS_HID), (const bf16_t*)(F.ws + WS_WD) + (size_t)l * NE * 1024 * FF, FF, 1024, F.G, vcu);
    EpiF32 E; E.C = (float*)(F.ws + WS_YSE); E.ldc = 1024; E.rowscale = (const float*)(F.ws + WS_EGATE);
    pg8::gemm_phase(F.lds, FF, S, E, F.wave, F.lane);
}

__global__ void __launch_bounds__(NTHREADS, 2) mega_fwd(Args args) {
#ifdef EMU
    LAS unsigned char* lds = emu::lds();
#else
    extern __shared__ __attribute__((aligned(16))) unsigned char lds_raw[];
    LAS unsigned char* lds = (LAS unsigned char*)lds_raw;
#endif
    Frame F;
    F.in = args.in; F.out = (GAS float*)args.out; F.ws = (GAS unsigned char*)args.ws; F.lds = lds;
    F.tid = threadIdx.x; F.lane = F.tid & 63; F.wave = readfirstlane_i(F.tid >> 6); F.G = gridDim.x; F.bid = blockIdx.x;
    F.gw = F.bid * NWAVES + F.wave; F.NGW = F.G * NWAVES;
    for (int u = F.tid; u < (LDS_BYTES - LDS_MISC) / 4; u += NTHREADS) ((LAS unsigned*)(lds + LDS_MISC))[u] = 0u;
    __syncthreads();
    XcdBarrier bar = xcd_barrier_post((unsigned*)(F.ws + WS_CTL), (volatile LAS unsigned*)(lds + LDS_MISC), F.wave);
#define GRID_BAR() xcd_barrier(bar)
    const int vcu = (F.G % 8 == 0) ? (F.bid % 8) * (F.G / 8) + F.bid / 8 : F.bid;

#ifndef PHASE_MASK
#define PHASE_MASK 0xFFFFF
#endif
#ifndef REPEAT_MASK
#define REPEAT_MASK 0x0
#endif
#ifndef TIMING_PROBE
#define TIMING_PROBE -1
#endif
    unsigned long long pt_acc = 0ull, pt_t0 = 0ull;
#define PT(k) do { if (TIMING_PROBE == (k)) pt_t0 = rt_now(); } while (0)
#define PTE(k) do { if (TIMING_PROBE == (k)) pt_acc += rt_now() - pt_t0; } while (0)
#define PH(k) if ((PHASE_MASK >> (k)) & 1)
#define RP(k) if ((REPEAT_MASK >> (k)) & 1)
    PT(0); PH(0) phase_prologue_a(F);
    RP(0) { GRID_BAR(); phase_prologue_a(F); }
    GRID_BAR(); PTE(0);
    PT(1); PH(1) phase_xg0(F);
    GRID_BAR(); PTE(1);
    for (int l = 0; l < DEPTH; ++l) {
        const int odd = l & 1;
        PT(2); PH(2) gemm_g1(F, l, vcu);
        RP(2) { GRID_BAR(); gemm_g1(F, l, vcu); }
        GRID_BAR(); PTE(2);
        PT(3); PH(3) phase_prep(F, l);
        RP(3) { GRID_BAR(); phase_prep(F, l); }
        GRID_BAR(); PTE(3);
        PT(4); PH(4) phase_cl(F, l);
        RP(4) { GRID_BAR(); phase_cl(F, l); }
        GRID_BAR(); PTE(4);
        PT(5); PH(5) phase_seq(F, l);
        RP(5) { GRID_BAR(); phase_seq(F, l); }
        GRID_BAR(); PTE(5);
        PT(6); PH(6) phase_merge(F, l);
        RP(6) { GRID_BAR(); phase_merge(F, l); }
        GRID_BAR(); PTE(6);
        if (odd) { PT(7); PH(7) gemm_glu(F, l, vcu); RP(7) { GRID_BAR(); gemm_glu(F, l, vcu); } GRID_BAR(); PTE(7); }
        PT(8); PH(8) gemm_g3(F, l, vcu);
        RP(8) { GRID_BAR(); gemm_g3(F, l, vcu); }
        GRID_BAR(); PTE(8);
        PT(9); PH(9) phase_ln1(F, l);
        GRID_BAR(); PTE(9);
        PT(10); PH(10) phase_topk(F);
        RP(10) { GRID_BAR(); phase_topk(F); }
        GRID_BAR(); PTE(10);
        PT(14); PH(10) phase_gather(F);
        GRID_BAR(); PTE(14);
        PT(11); PH(11) gemm_g4(F, l, vcu);
        RP(11) { GRID_BAR(); gemm_g4(F, l, vcu); }
        GRID_BAR(); PTE(11);
        PT(12); PH(12) gemm_g5(F, l, vcu);
        RP(12) { GRID_BAR(); gemm_g5(F, l, vcu); }
        GRID_BAR(); PTE(12);
        PT(13); PH(13) phase_ln2(F, l);
        GRID_BAR(); PTE(13);
    }
    if (TIMING_PROBE >= 0 && F.bid == 0) { const unsigned long long t1 = rt_now() + pt_acc; while (rt_now() < t1) s_sleep1(); }
}

#ifndef EMU
extern "C" void kernel_launch(void* const* d_in, const int* in_sizes, int n_in, void* d_out, int out_size, void* d_ws, size_t ws_size, hipStream_t stream) {
    static int grid = 0;
    if (grid == 0) {
        if (n_in != N_IN || ws_size < WS_END) { fprintf(stderr, "kernel_launch: need %d inputs and %zu bytes of workspace; got %d, %zu\n", (int)N_IN, (size_t)WS_END, n_in, ws_size); grid = -1; return; }
        int dev = 0, cus = 0, per_cu = 0;
        if (hipGetDevice(&dev) != hipSuccess || hipDeviceGetAttribute(&cus, hipDeviceAttributeMultiprocessorCount, dev) != hipSuccess) { grid = -1; return; }
        if (hipFuncSetAttribute((const void*)mega_fwd, hipFuncAttributeMaxDynamicSharedMemorySize, LDS_BYTES) != hipSuccess) { fprintf(stderr, "kernel_launch: hipFuncSetAttribute failed\n"); grid = -1; return; }
        if (hipOccupancyMaxActiveBlocksPerMultiprocessor(&per_cu, (const void*)mega_fwd, NTHREADS, LDS_BYTES) != hipSuccess || per_cu < 1) { fprintf(stderr, "kernel_launch: occupancy query says %d\n", per_cu); }
        (void)hipGetLastError();
        grid = cus;
    }
    if (grid < 0) return;
    (void)hipMemsetAsync((char*)d_ws + WS_CTL, 0, CTL_BYTES, stream);
    Args a{};
    for (int i = 0; i < N_IN; ++i) a.in[i] = (const float*)d_in[i];
    a.out = (float*)d_out; a.ws = (unsigned char*)d_ws;
    hipLaunchKernelGGL(mega_fwd, dim3(grid), dim3(NTHREADS), LDS_BYTES, stream, a);
}
#endif
```

```cpp
#ifdef EMU
#include "emu.h"
#else
#include <hip/hip_runtime.h>
#endif
#include <cstdio>
#include <cstdint>
#include <cstddef>

#ifndef CFG_BATCH
#define CFG_BATCH 4
#define CFG_SEQ 4096
#define CFG_CTX 256
#define CFG_DEPTH 4
#define CFG_NEXP 16
#define CFG_FF 2048
#endif
constexpr int B_ = CFG_BATCH, SEQ = CFG_SEQ, CTX = CFG_CTX, DEPTH = CFG_DEPTH, NE = CFG_NEXP, FF = CFG_FF;
constexpr int D = 1024, TOK = CTX + SEQ, MROWS = B_ * TOK, MPAD = (MROWS + 255) / 256 * 256;
constexpr int NCH = TOK / 64;
constexpr int LATR = B_ * SEQ;
constexpr int LATPAD = (LATR + 255) / 256 * 256;
constexpr int CAPL = 2 * SEQ / NE, CAPC = 2 * CTX / NE, EROWS = B_ * (CAPL + CAPC), EPAD = (EROWS + 255) / 256 * 256;
constexpr int NIN_E = 4096, NIN_O = 2560, NINMAX = 4096;
constexpr int N_EVEN = (DEPTH + 1) / 2, N_ODD = DEPTH / 2, N_ODDA = N_ODD > 0 ? N_ODD : 1;
constexpr int NR = B_ + 1;
constexpr float ALPHA = 1.681792830507429f;
constexpr float LN_EPS = 1e-5f;
constexpr float HD_SCALE = 0.08838834764831845f;
constexpr int NWAVES = 8, NTHREADS = 512;

enum { I_X = 0, I_C, I_CTX, I_CCTX, I_WMOD, I_BMOD, I_LN1G, I_LN1B, I_LN2G, I_LN2B, I_WROUTER, I_WGATE, I_WUP, I_WDOWN,
       I_EVWIN, I_EVWOUT, I_EVCONV, I_EVALOG, I_EVDTB, I_EVGDNN, I_EVRETN,
       I_ODWIN, I_ODWOUT, I_ODCONV, I_ODGB, I_ODMN, I_ODLRE, I_ODLIM, I_ODLDT, I_ODBRE, I_ODBIM, I_ODCRE, I_ODCIM, I_ODDSKIP, I_ODWGLU, I_ODBGLU, N_IN };

constexpr size_t al256(size_t x) { return (x + 255) & ~(size_t)255; }
constexpr size_t WS_CTL = 0, CTL_BYTES = 65536;
constexpr size_t WS_MOD = WS_CTL + CTL_BYTES;
constexpr size_t WS_WG = al256(WS_MOD + (size_t)DEPTH * NR * 6144 * 4);
constexpr size_t WS_WIN = al256(WS_WG + (size_t)DEPTH * 16 * 1024 * 4);
constexpr size_t WS_WOUT = al256(WS_WIN + (size_t)DEPTH * NINMAX * 1024 * 2);
constexpr size_t WS_WGLU = al256(WS_WOUT + (size_t)DEPTH * 1024 * 1024 * 2);
constexpr size_t WS_WGU = al256(WS_WGLU + (size_t)N_ODDA * 512 * 512 * 2);
constexpr size_t WS_WD = al256(WS_WGU + (size_t)DEPTH * NE * 2 * FF * 1024 * 2);
constexpr size_t WS_S5A = al256(WS_WD + (size_t)DEPTH * NE * 1024 * FF * 2);
constexpr size_t WS_S5B = al256(WS_S5A + (size_t)N_ODDA * 2 * 32 * 128 * 4);
constexpr size_t WS_S5C = al256(WS_S5B + (size_t)N_ODDA * 2 * 32 * 128 * 16 * 2);
constexpr size_t WS_H = al256(WS_S5C + (size_t)N_ODDA * 32 * 16 * 128 * 2);
constexpr size_t WS_XIN = al256(WS_H + (size_t)MPAD * 1024 * 4);
constexpr size_t WS_GATES = al256(WS_XIN + (size_t)MPAD * 1024 * 2);
constexpr size_t WS_MERGED = al256(WS_GATES + (size_t)MROWS * 16 * 4);
constexpr size_t WS_YS = al256(WS_MERGED + (size_t)MPAD * 1024 * 2);
constexpr size_t WS_Y = al256(WS_YS + (size_t)MPAD * 512 * 2);
constexpr size_t WS_AFF = al256(WS_Y + (size_t)MPAD * 1024 * 4);
constexpr size_t WS_SLOT = al256(WS_AFF + (size_t)MROWS * 16 * 4);
constexpr size_t WS_EGATE = al256(WS_SLOT + (size_t)MROWS * 16 * 4);
constexpr size_t WS_MCH = al256(WS_EGATE + (size_t)NE * EPAD * 4);
constexpr size_t WS_WR = al256(WS_MCH + (size_t)B_ * 4 * 2 * NCH * 4);
constexpr size_t WS_EIDX = al256(WS_WR + (size_t)DEPTH * NE * 1024 * 4);
constexpr size_t WS_R = al256(WS_EIDX + (size_t)NE * EPAD * 4);
constexpr int NCP = B_ * 8 * 2 * NCH, NCPG = B_ * 4 * 2 * NCH;
constexpr size_t WS_P = WS_R;
constexpr size_t WS_QKV = al256(WS_P + (size_t)MPAD * NINMAX * 2);
constexpr size_t WS_CLW = al256(WS_QKV + (size_t)MROWS * 1536 * 2);
constexpr size_t WS_CLQ = al256(WS_CLW + (size_t)NCP * 64 * 128 * 2);
constexpr size_t WS_CLK = al256(WS_CLQ + (size_t)NCP * 64 * 128 * 2);
constexpr size_t WS_CLA = al256(WS_CLK + (size_t)NCP * 64 * 128 * 2);
constexpr size_t WS_CLU = al256(WS_CLA + (size_t)NCP * 64 * 64 * 2);
constexpr size_t WS_CLS = al256(WS_CLU + (size_t)NCPG * 64 * 128 * 4);
constexpr size_t WS_O = al256(WS_CLS + (size_t)NCP * 512 * 4);
constexpr size_t WS_R_END1 = al256(WS_O + (size_t)2 * MROWS * 1024 * 4);
constexpr size_t WS_XS = WS_R;
constexpr size_t WS_HID = al256(WS_XS + (size_t)NE * EPAD * 1024 * 2);
constexpr size_t WS_YSE = al256(WS_HID + (size_t)NE * EPAD * FF * 2);
constexpr size_t WS_R_END2 = al256(WS_YSE + (size_t)NE * EPAD * 1024 * 4);
constexpr size_t WS_END = WS_R_END1 > WS_R_END2 ? WS_R_END1 : WS_R_END2;

constexpr int LDS_BYTES = 163840;
constexpr int LDS_MISC = 163328;

typedef unsigned short bf16_t;
typedef short bf16x8 __attribute__((ext_vector_type(8)));
typedef float f32x2 __attribute__((ext_vector_type(2)));
typedef float f32x4 __attribute__((ext_vector_type(4)));
typedef float f32x16 __attribute__((ext_vector_type(16)));
typedef unsigned u32x2 __attribute__((ext_vector_type(2)));
typedef unsigned u32x4 __attribute__((ext_vector_type(4)));
#define DEV __device__ __forceinline__

#ifdef EMU
#define LAS
#define GAS
static inline float bf2f_h(bf16_t b) { unsigned u = (unsigned)b << 16; float f; memcpy(&f, &u, 4); return f; }
static inline f32x4 mfma16(bf16x8 a, bf16x8 b, f32x4 c) {
    struct In { bf16x8 a, b; } in{a, b};
    auto s = emu::wave_xchg(&in, sizeof(in)); const int l = emu::cur->lane, col = l & 15, rg = l >> 4;
    for (int r = 0; r < 4; ++r) { const int row = 4 * rg + r; double acc = c[r];
        for (int kg = 0; kg < 4; ++kg) { const In* pa = (const In*)s[row + 16 * kg]; const In* pb = (const In*)s[col + 16 * kg];
            for (int j = 0; j < 8; ++j) acc += (double)bf2f_h((bf16_t)pa->a[j]) * (double)bf2f_h((bf16_t)pb->b[j]); }
        c[r] = (float)acc; }
    return c;
}
static inline f32x16 mfma32(bf16x8 a, bf16x8 b, f32x16 c) {
    struct In { bf16x8 a, b; } in{a, b};
    auto s = emu::wave_xchg(&in, sizeof(in)); const int l = emu::cur->lane, col = l & 31, h = l >> 5;
    for (int r = 0; r < 16; ++r) { const int row = (r & 3) + 8 * (r >> 2) + 4 * h; double acc = c[r];
        for (int kh = 0; kh < 2; ++kh) { const In* pa = (const In*)s[row + 32 * kh]; const In* pb = (const In*)s[col + 32 * kh];
            for (int j = 0; j < 8; ++j) acc += (double)bf2f_h((bf16_t)pa->a[j]) * (double)bf2f_h((bf16_t)pb->b[j]); }
        c[r] = (float)acc; }
    return c;
}
static inline void glds16(const void* g, void* l) { memcpy((char*)l + 16 * emu::cur->lane, g, 16); }
#define S_BARRIER() emu::block_barrier()
#define WAIT_VM(n) do {} while (0)
#define WAIT_LGKM(n) do {} while (0)
#define WAIT_ALL() do {} while (0)
#define SETPRIO(n) do {} while (0)
#define SCHED_BARRIER() do {} while (0)
#define COMPILER_FENCE() do {} while (0)
#define WAVE_LDS_SYNC() do { int _z = 0; (void)emu::wave_xchg(&_z, 4); } while (0)
#define LAUNDER(x) do {} while (0)
#define LAUNDER_S(x) do {} while (0)
static inline int lane_id() { return emu::cur->lane; }
template <class T> static inline T shfl_xor_t(T v, int m) { auto s = emu::wave_xchg(&v, sizeof(T)); T r; memcpy(&r, s[emu::cur->lane ^ m], sizeof(T)); return r; }
template <class T> static inline T shfl_t(T v, int src) { auto s = emu::wave_xchg(&v, sizeof(T)); T r; memcpy(&r, s[src & 63], sizeof(T)); return r; }
static inline float wave_sum(float v) { for (int o = 1; o < 64; o <<= 1) v += shfl_xor_t(v, o); return v; }
static inline float wave_max(float v) { for (int o = 1; o < 64; o <<= 1) v = fmaxf(v, shfl_xor_t(v, o)); return v; }
template <int W> static inline float group_sum(float v) { for (int o = 1; o < W; o <<= 1) v += shfl_xor_t(v, o); return v; }
template <int W> static inline float group_max(float v) { for (int o = 1; o < W; o <<= 1) v = fmaxf(v, shfl_xor_t(v, o)); return v; }
static inline int bcast_lane(int v, int src) { return shfl_t(v, src); }
static inline int readfirstlane_i(int v) { return v; }
static inline unsigned xb_ld(unsigned* p) { return *(volatile unsigned*)p; }
static inline unsigned xb_add(unsigned* p, unsigned v) { unsigned o = *p; *p = o + v; return o; }
static inline unsigned xb_xcc_id() { return (unsigned)emu::cur->bid & 7u; }
static inline void s_sleep1() { emu::yield(); }
static inline void fence_acquire() {}
static inline void fence_release() {}
static inline unsigned lds_atomic_add(unsigned* p, unsigned v) { unsigned o = *p; *p = o + v; return o; }
static inline unsigned long long rt_now() { return 0ull; }
static inline float fast_exp2(float x) { return exp2f(x); }
static inline float fast_rcp(float x) { return 1.0f / x; }
#else
#define LAS __attribute__((address_space(3)))
#define GAS __attribute__((address_space(1)))
DEV f32x4 mfma16(bf16x8 a, bf16x8 b, f32x4 c) { return __builtin_amdgcn_mfma_f32_16x16x32_bf16(a, b, c, 0, 0, 0); }
DEV f32x16 mfma32(bf16x8 a, bf16x8 b, f32x16 c) { return __builtin_amdgcn_mfma_f32_32x32x16_bf16(a, b, c, 0, 0, 0); }
#define glds16(g, l) __builtin_amdgcn_global_load_lds((const unsigned*)(g), (LAS unsigned*)(l), 16, 0, 0)
#define S_BARRIER() __builtin_amdgcn_s_barrier()
#define WAIT_VM(n) asm volatile("s_waitcnt vmcnt(" #n ")" ::: "memory")
#define WAIT_LGKM(n) asm volatile("s_waitcnt lgkmcnt(" #n ")" ::: "memory")
#define WAIT_ALL() asm volatile("s_waitcnt vmcnt(0) lgkmcnt(0)" ::: "memory")
#define SETPRIO(n) __builtin_amdgcn_s_setprio(n)
#define SCHED_BARRIER() __builtin_amdgcn_sched_barrier(0)
#define COMPILER_FENCE() asm volatile("" ::: "memory")
#define WAVE_LDS_SYNC() asm volatile("s_waitcnt lgkmcnt(0)" ::: "memory")
#define LAUNDER(x) asm volatile("" : "+v"(x))
#define LAUNDER_S(x) asm volatile("" : "+s"(x))
DEV int lane_id() { return (int)__builtin_amdgcn_mbcnt_hi(~0u, __builtin_amdgcn_mbcnt_lo(~0u, 0u)); }
template <class T> DEV T shfl_xor_t(T v, int m) { return __shfl_xor(v, m); }
template <class T> DEV T shfl_t(T v, int src) { return __shfl(v, src); }
template <int CTRL, int ROWMASK> DEV float dpp_mov(float v) { return __builtin_bit_cast(float, __builtin_amdgcn_update_dpp(0, __builtin_bit_cast(int, v), CTRL, ROWMASK, 0xf, false)); }
template <int CTRL, int ROWMASK> DEV float dpp_mov_keep(float oldv, float v) { return __builtin_bit_cast(float, __builtin_amdgcn_update_dpp(__builtin_bit_cast(int, oldv), __builtin_bit_cast(int, v), CTRL, ROWMASK, 0xf, false)); }
template <int W> DEV float group_sum(float v) {
    v += dpp_mov<0xB1, 0xf>(v); v += dpp_mov<0x4E, 0xf>(v);
    if (W >= 8) v += dpp_mov<0x141, 0xf>(v);
    if (W >= 16) v += dpp_mov<0x140, 0xf>(v);
    return v;
}
DEV float wave_sum(float v) {
    v = group_sum<16>(v);
    v += dpp_mov<0x142, 0xa>(v);
    v += dpp_mov<0x143, 0xc>(v);
    return __builtin_bit_cast(float, __builtin_amdgcn_readlane(__builtin_bit_cast(int, v), 63));
}
DEV float wave_max(float v) {
    v = fmaxf(v, dpp_mov_keep<0xB1, 0xf>(v, v)); v = fmaxf(v, dpp_mov_keep<0x4E, 0xf>(v, v)); v = fmaxf(v, dpp_mov_keep<0x141, 0xf>(v, v)); v = fmaxf(v, dpp_mov_keep<0x140, 0xf>(v, v));
    v = fmaxf(v, dpp_mov_keep<0x142, 0xa>(v, v)); v = fmaxf(v, dpp_mov_keep<0x143, 0xc>(v, v));
    return __builtin_bit_cast(float, __builtin_amdgcn_readlane(__builtin_bit_cast(int, v), 63));
}
template <int W> DEV float group_max(float v) {
    v = fmaxf(v, dpp_mov_keep<0xB1, 0xf>(v, v)); v = fmaxf(v, dpp_mov_keep<0x4E, 0xf>(v, v));
    if (W >= 8) v = fmaxf(v, dpp_mov_keep<0x141, 0xf>(v, v));
    if (W >= 16) v = fmaxf(v, dpp_mov_keep<0x140, 0xf>(v, v));
    return v;
}
DEV int bcast_lane(int v, int src) { return __builtin_amdgcn_readlane(v, src); }
DEV int readfirstlane_i(int v) { return __builtin_amdgcn_readfirstlane(v); }
DEV unsigned xb_ld(unsigned* p) { return __hip_atomic_load(p, __ATOMIC_RELAXED, __HIP_MEMORY_SCOPE_AGENT); }
DEV unsigned xb_add(unsigned* p, unsigned v) { return __hip_atomic_fetch_add(p, v, __ATOMIC_RELAXED, __HIP_MEMORY_SCOPE_AGENT); }
DEV unsigned xb_xcc_id() { return (unsigned)__builtin_amdgcn_s_getreg((3 << 11) | 20) & 0xFu; }
DEV void s_sleep1() { __builtin_amdgcn_s_sleep(1); }
DEV void fence_acquire() { __builtin_amdgcn_fence(__ATOMIC_ACQUIRE, "agent"); }
DEV void fence_release() { __builtin_amdgcn_fence(__ATOMIC_RELEASE, "agent"); }
DEV unsigned lds_atomic_add(LAS unsigned* p, unsigned v) { return __hip_atomic_fetch_add(p, v, __ATOMIC_RELAXED, __HIP_MEMORY_SCOPE_WORKGROUP); }
DEV unsigned long long rt_now() { return __builtin_amdgcn_s_memrealtime(); }
DEV float fast_exp2(float x) { return __builtin_amdgcn_exp2f(x); }
DEV float fast_rcp(float x) { return __builtin_amdgcn_rcpf(x); }
#endif

DEV unsigned f2bf(float f) { unsigned u = __builtin_bit_cast(unsigned, f); return (u + 0x7fffu + ((u >> 16) & 1u)) >> 16; }
DEV unsigned pk2(float lo, float hi) { return f2bf(lo) | (f2bf(hi) << 16); }
DEV float bf2f(unsigned b) { return __builtin_bit_cast(float, b << 16); }
DEV float bflo(unsigned w) { return __builtin_bit_cast(float, w << 16); }
DEV float bfhi(unsigned w) { return __builtin_bit_cast(float, w & 0xffff0000u); }
DEV float sigmoid_f(float x) { return 1.0f / (1.0f + expf(-x)); }
DEV float silu_f(float x) { return x / (1.0f + expf(-x)); }
DEV float softplus_f(float x) { return fmaxf(x, 0.0f) + log1pf(expf(-fabsf(x))); }
DEV float fast_sigmoid(float x) { return fast_rcp(1.0f + fast_exp2(-1.4426950408889634f * x)); }
DEV float fast_silu(float x) { return x * fast_sigmoid(x); }
DEV float gelu_tanh_f(float x) { const float u = 0.7978845608028654f * (x + 0.044715f * x * x * x); return 0.5f * x * (1.0f + tanhf(u)); }

#define XB_TMO      128
#define XB_XCNT(j)  (256  + 64 * (j))
#define XB_XSUB(j)  (1280 + 64 * (j))
#define XB_XGEN(j)  (2304 + 64 * (j))
#define XB_TOP      3328
#define XB_TOPGEN   3392
#define XCD_BAR_WORDS 3456
#define XB_SPIN_CAP (1u << 20)
#define XB_SPIN(cond, bar) do { unsigned _sp = 0; while (cond) { s_sleep1(); \
    if ((++_sp & 255u) == 0u) { if (xb_ld(&(bar)[XB_TMO])) break; if (_sp > XB_SPIN_CAP) { xb_add(&(bar)[XB_TMO], 1u); break; } } } } while (0)
struct XcdBarrier { unsigned* bar; unsigned x; volatile LAS unsigned* st; int wave; };
DEV XcdBarrier xcd_barrier_post(unsigned* bar, volatile LAS unsigned* st, int wave) {
    XcdBarrier b; b.wave = wave; b.bar = bar; b.x = (unsigned)readfirstlane_i((int)xb_xcc_id()); b.st = st;
    if (wave == 0 && lane_id() == 0) (void)xb_add(&bar[XB_XCNT(b.x)], 1u);
    return b;
}
DEV void xcd_barrier_complete(unsigned* bar, unsigned x, unsigned& nloc, unsigned& nx) {
    const unsigned G = gridDim.x;
    unsigned sum, cnt, mine, sp = 0u;
    for (;;) {
        sum = 0u; cnt = 0u; mine = 0u;
#pragma unroll
        for (unsigned j = 0; j < 16; ++j) { const unsigned c = xb_ld(&bar[XB_XCNT(j)]); sum += c; cnt += (c > 0u) ? 1u : 0u; mine = (j == x) ? c : mine; }
        if (sum == G) break;
        s_sleep1();
        if ((++sp & 255u) == 0u) { if (xb_ld(&bar[XB_TMO])) break; if (sp > XB_SPIN_CAP) { xb_add(&bar[XB_TMO], 1u); break; } }
    }
    nloc = mine > 0u ? mine : 1u; nx = cnt > 0u ? cnt : 1u;
}
DEV void xcd_barrier(const XcdBarrier& b) {
    WAIT_VM(0);
    __syncthreads();
    int bw = b.wave; LAUNDER_S(bw);
    if (bw == 0 && lane_id() == 0) {
        unsigned* bar = b.bar; LAUNDER_S(bar);
        unsigned bx = b.x; LAUNDER_S(bx);
        WAIT_ALL();
        unsigned nloc = b.st[0], nx = b.st[1];
        if (nloc == 0u) { xcd_barrier_complete(bar, bx, nloc, nx); b.st[0] = nloc; b.st[1] = nx; }
        const unsigned old = xb_add(&bar[XB_XSUB(bx)], 1u);
        const unsigned gen = old / nloc;
        if (old + 1u == (gen + 1u) * nloc) {
            fence_release();
            WAIT_VM(0);
            const unsigned og = xb_add(&bar[XB_TOP], 1u);
            const unsigned tg = og / nx;
            if (og + 1u == (tg + 1u) * nx) xb_add(&bar[XB_TOPGEN], 1u);
            else XB_SPIN(xb_ld(&bar[XB_TOPGEN]) == tg, bar);
            fence_acquire();
            xb_add(&bar[XB_XGEN(bx)], 1u);
            WAIT_VM(0);
        } else {
            XB_SPIN(xb_ld(&bar[XB_XGEN(bx)]) == gen, bar);
            fence_acquire();
            WAIT_VM(0);
        }
    }
    __syncthreads();
}

namespace pg8 {
constexpr int BM = 256, BK = 64, HALF = 128, HTB = HALF * BK * 2, STAGE_BYTES = 8 * HTB;
DEV int lds_byte(int r, int c) { const int st = (r >> 4) * 2 + (c >> 5), rr = r & 15, cc = c & 31, ob = rr * 64 + cc * 2; return st * 1024 + (ob ^ (((ob >> 9) & 1) << 5)); }
DEV void stage_rc(int b, int& R, int& C) { const int st = b / 1024, sb = b % 1024, swz = sb ^ (((sb >> 9) & 1) << 5); R = (st >> 1) * 16 + swz / 64; C = (st & 1) * 32 + (swz % 64) / 2; }
DEV int perm32(int rho) { const int n = rho >> 4, i = rho & 15; return 8 * (i >> 2) + 4 * n + (i & 3); }
struct Unit { const char* A; const char* B; int pm, pn, e; };
#ifdef EMU
static inline unsigned cvt_pk_bf16(float lo, float hi) { return pk2(lo, hi); }
#else
DEV unsigned cvt_pk_bf16(float lo, float hi) { unsigned r; asm volatile("v_cvt_pk_bf16_f32 %0, %1, %2" : "=v"(r) : "v"(lo), "v"(hi)); return r; }
#endif
template <class Epi, class Sched>
DEV void gemm_phase(LAS unsigned char* lds, const int K, const Sched& S, const Epi& E, const int wid, const int lane) {
    const int tid = wid * 64 + lane; const int wr = wid >> 2, wc = wid & 3, fr = lane & 15, fq = lane >> 4;
    const int nt = K / BK;
    unsigned voffA[2], voffB[2];
#pragma unroll
    for (int i = 0; i < 2; ++i) { int R, C; stage_rc(tid * 16 + i * 8192, R, C); const int Rb = Epi::PERM ? ((R & ~31) + perm32(R & 31)) : R;
        voffA[i] = (unsigned)(R * K + C) * 2u; voffB[i] = (unsigned)(Rb * K + C) * 2u; }
    const size_t kstep = (size_t)(BK * 2);
    const size_t hstep = (size_t)HALF * K * 2;
    const unsigned ldsw = (unsigned)wid * 1024u;
    const int aoff = lds_byte(wr * 64 + fr, fq * 8), boff = lds_byte(wc * 32 + fr, fq * 8);
#define PG8_SA(b, h) (((b) * 2 + (h)) * HTB)
#define PG8_SB(b, h) ((4 + (b) * 2 + (h)) * HTB)
#define PG8_STAGE(bufoff, gbase, voff) do { _Pragma("unroll") for (int _i = 0; _i < 2; ++_i) \
        glds16(((const char*)(gbase) + (voff)[_i]), (lds + (bufoff) + ldsw + _i * 8192)); } while (0)
#define PG8_LDA(dst, b, h) do { _Pragma("unroll") for (int m = 0; m < 4; ++m) _Pragma("unroll") for (int k = 0; k < 2; ++k) dst[m][k] = *(const LAS bf16x8*)(lds + PG8_SA(b, h) + aoff + m * 2048 + k * 1024); } while (0)
#define PG8_LDB(dst, b, h) do { _Pragma("unroll") for (int n = 0; n < 2; ++n) _Pragma("unroll") for (int k = 0; k < 2; ++k) dst[n][k] = *(const LAS bf16x8*)(lds + PG8_SB(b, h) + boff + n * 2048 + k * 1024); } while (0)
#define PG8_MMA(ai, bj, At, Bt) do { SETPRIO(1); _Pragma("unroll") for (int m = 0; m < 4; ++m) _Pragma("unroll") for (int n = 0; n < 2; ++n) _Pragma("unroll") for (int k = 0; k < 2; ++k) \
        acc[ai][bj][m][n] = mfma16(Bt[n][k], At[m][k], acc[ai][bj][m][n]); SETPRIO(0); } while (0)
    Unit cur, nxt; int ui = 0;
    if (!S.next(0, cur)) return;
    f32x4 acc[2][2][4][2];
#pragma unroll
    for (int a = 0; a < 2; ++a)
#pragma unroll
        for (int b = 0; b < 2; ++b)
#pragma unroll
            for (int m = 0; m < 4; ++m)
#pragma unroll
                for (int n = 0; n < 2; ++n) acc[a][b][m][n] = (f32x4){0.f, 0.f, 0.f, 0.f};
    bf16x8 At[4][2], B0[2][2], B1[2][2];
    const char* cA = cur.A; const char* cB = cur.B;
    PG8_STAGE(PG8_SB(0, 0), cB, voffB); PG8_STAGE(PG8_SB(0, 1), cB + hstep, voffB); PG8_STAGE(PG8_SA(0, 0), cA, voffA); PG8_STAGE(PG8_SA(0, 1), cA + hstep, voffA);
    if (wr == 1) S_BARRIER();
    WAIT_VM(2); S_BARRIER();
    PG8_STAGE(PG8_SB(1, 0), cB + kstep, voffB); PG8_STAGE(PG8_SA(1, 0), cA + kstep, voffA); PG8_STAGE(PG8_SB(1, 1), cB + hstep + kstep, voffB);
    WAIT_VM(6); S_BARRIER();
    for (;;) {
        const bool has_next = S.next(ui + 1, nxt);
        const char* nA = has_next ? nxt.A : cA; const char* nB = has_next ? nxt.B : cB;
        for (int t = 0; t < nt; t += 2) {
            const bool last = (t == nt - 2);
            const char* a1 = cA + (size_t)(t + 1) * kstep;
            const char* a2 = last ? nA : cA + (size_t)(t + 2) * kstep; const char* b2 = last ? nB : cB + (size_t)(t + 2) * kstep;
            const char* a3 = a2 + kstep; const char* b3 = b2 + kstep;
            PG8_LDB(B0, 0, 0); PG8_LDB(B1, 0, 1); SCHED_BARRIER(); PG8_LDA(At, 0, 0); PG8_STAGE(PG8_SA(1, 1), a1 + hstep, voffA);
            WAIT_VM(8); WAIT_LGKM(0); S_BARRIER(); PG8_MMA(0, 0, At, B0); PG8_MMA(0, 1, At, B1); S_BARRIER(); SCHED_BARRIER();
            PG8_LDA(At, 0, 1); PG8_STAGE(PG8_SB(0, 0), b2, voffB); PG8_STAGE(PG8_SB(0, 1), b2 + hstep, voffB); PG8_STAGE(PG8_SA(0, 0), a2, voffA);
            WAIT_VM(8); WAIT_LGKM(0); S_BARRIER(); PG8_MMA(1, 0, At, B0); PG8_MMA(1, 1, At, B1); S_BARRIER(); SCHED_BARRIER();
            PG8_LDB(B0, 1, 0); PG8_LDB(B1, 1, 1); SCHED_BARRIER(); PG8_LDA(At, 1, 0); PG8_STAGE(PG8_SA(0, 1), a2 + hstep, voffA);
            WAIT_VM(8); WAIT_LGKM(0); S_BARRIER(); PG8_MMA(0, 0, At, B0); PG8_MMA(0, 1, At, B1); S_BARRIER(); SCHED_BARRIER();
            PG8_LDA(At, 1, 1); PG8_STAGE(PG8_SB(1, 0), b3, voffB); PG8_STAGE(PG8_SB(1, 1), b3 + hstep, voffB); PG8_STAGE(PG8_SA(1, 0), a3, voffA);
            WAIT_VM(8); WAIT_LGKM(0); S_BARRIER(); PG8_MMA(1, 0, At, B0); PG8_MMA(1, 1, At, B1); S_BARRIER(); SCHED_BARRIER();
        }
        if (wr == 0) S_BARRIER();
        E(acc, cur, wr, wc, fr, fq);
        if (!has_next) break;
#pragma unroll
        for (int a = 0; a < 2; ++a)
#pragma unroll
            for (int b = 0; b < 2; ++b)
#pragma unroll
                for (int m = 0; m < 4; ++m)
#pragma unroll
                    for (int n = 0; n < 2; ++n) acc[a][b][m][n] = (f32x4){0.f, 0.f, 0.f, 0.f};
        cur = nxt; cA = nA; cB = nB; ++ui;
        if (wr == 1) S_BARRIER();
    }
    WAIT_VM(0);
    S_BARRIER();
#undef PG8_SA
#undef PG8_SB
#undef PG8_STAGE
#undef PG8_LDA
#undef PG8_LDB
#undef PG8_MMA
}

struct PlainOrder {
    const char* A; const char* Bt; int K, nM, nN, nwg, G, c;
    DEV void init(const void* A_, const void* Bt_, int K_, int M, int N, int G_, int c_) { A = (const char*)A_; Bt = (const char*)Bt_; K = K_; nM = M / BM; nN = N / BM; nwg = nM * nN; G = G_; c = c_; }
    DEV bool next(int i, Unit& u) const {
        const long L = (long)i * G + c; if (L >= nwg) return false;
        int wgid = (int)L; { const int q = nwg / 8, r = nwg % 8, xcd = wgid % 8, off = wgid / 8; wgid = (xcd < r ? xcd * (q + 1) : r * (q + 1) + (xcd - r) * q) + off; }
        const int nig = 8 * nN, gid = wgid / nig, fm = gid * 8, gsz = (nM - fm) < 8 ? (nM - fm) : 8;
        u.pm = fm + ((wgid % nig) % gsz); u.pn = (wgid % nig) / gsz; u.e = 0;
        u.A = A + (size_t)u.pm * BM * K * 2; u.B = Bt + (size_t)u.pn * BM * K * 2; return true;
    }
};
struct GroupedOrder {
    const char* A; const char* Bt; int K, nMe, nN, nwg, G, c; size_t bstride;
    DEV void init(const void* A_, const void* Bt_, int K_, int N, int G_, int c_, int erows) { A = (const char*)A_; Bt = (const char*)Bt_; K = K_; nMe = (erows + BM - 1) / BM; nN = N / BM; nwg = NE * nMe * nN; G = G_; c = c_; bstride = (size_t)N * K * 2; }
    DEV bool next(int i, Unit& u) const {
        const long L = (long)i * G + c; if (L >= nwg) return false;
        int wgid = (int)L; { const int q = nwg / 8, r = nwg % 8, xcd = wgid % 8, off = wgid / 8; wgid = (xcd < r ? xcd * (q + 1) : r * (q + 1) + (xcd - r) * q) + off; }
        const int per_e = nMe * nN; const int e = wgid / per_e, w = wgid % per_e;
        u.e = e; u.pm = w % nMe; u.pn = w / nMe;
        u.A = A + ((size_t)e * EPAD + (size_t)u.pm * BM) * K * 2; u.B = Bt + (size_t)e * bstride + (size_t)u.pn * BM * K * 2; return true;
    }
};
}

struct Args { const float* in[N_IN]; float* out; unsigned char* ws; };

struct Frame {
    const float* const* in; GAS float* out; GAS unsigned char* ws; LAS unsigned char* lds;
    int tid, lane, wave, G, bid, gw, NGW;
};

DEV Frame refresh(const Frame& F0) {
    Frame F = F0; int w = F0.wave; LAUNDER_S(w); int ln = lane_id(); LAUNDER(ln);
    F.wave = w; F.lane = ln; F.tid = w * 64 + ln; F.gw = F.bid * NWAVES + w;
    GAS unsigned char* ws = F0.ws; LAUNDER_S(ws); F.ws = ws;
    return F;
}

#define GIN(k) ((const float*)(GAS const float*)F.in[k])

#define ROW_LOOP(r, NROWS) for (int r = F.gw; r < (NROWS); r += F.NGW)

DEV int tok_row(int b, int d, int sp) {
    if (sp < CTX) return LATR + b * CTX + (d ? (CTX - 1 - sp) : sp);
    const int j = sp - CTX; return b * SEQ + (d ? (SEQ - 1 - j) : j);
}
DEV void row_bs(int r, int& b, int& s) { if (r < LATR) { b = r / SEQ; s = CTX + r % SEQ; } else { const int q = r - LATR; b = q / CTX; s = q % CTX; } }

DEV void tr_item(const float* W, int ldw, int col0, int k0, bf16_t* WT, int K, int row0, LAS float* scr, int lane) {
#pragma unroll 8
    for (int i = 0; i < 32; ++i) { const int kk = 2 * i + (lane >> 5); scr[kk * 33 + (lane & 31)] = W[(size_t)(k0 + kk) * ldw + col0 + (lane & 31)]; }
    WAVE_LDS_SYNC();
    const int c = lane & 7;
#pragma unroll
    for (int j = 0; j < 4; ++j) { const int n = (lane >> 3) + 8 * j; const LAS float* s = scr + (8 * c) * 33 + n;
        u32x4 o; o.x = pk2(s[0 * 33], s[1 * 33]); o.y = pk2(s[2 * 33], s[3 * 33]); o.z = pk2(s[4 * 33], s[5 * 33]); o.w = pk2(s[6 * 33], s[7 * 33]);
        *(u32x4*)(WT + (size_t)(row0 + n) * K + k0 + 8 * c) = o; }
    WAVE_LDS_SYNC();
}

DEV void phase_prologue_a(const Frame& F0) {
    const Frame F = refresh(F0);
    LAS float* scr = (LAS float*)(F.lds + F.wave * 16384);
    for (int l = 0; l < DEPTH; ++l) {
        const int odd = l & 1, li = l >> 1;
        const float* win = odd ? GIN(I_ODWIN) + (size_t)li * 1024 * 2576 : GIN(I_EVWIN) + (size_t)li * 1024 * 4112;
        const int ldw = odd ? 2576 : 4112, nin = odd ? NIN_O : NIN_E;
        bf16_t* wint = (bf16_t*)(F.ws + WS_WIN) + (size_t)l * NINMAX * 1024;
        for (int it = F.gw; it < 16 * (nin / 32); it += F.NGW) { const int kb = it / (nin / 32), nb = it % (nin / 32); const int d0 = 32 * nb;
            tr_item(win, ldw, d0 < 2048 ? d0 : d0 + 16, 64 * kb, wint, 1024, d0, scr, F.lane); }
        const float* wout = odd ? GIN(I_ODWOUT) + (size_t)li * 1024 * 1024 : GIN(I_EVWOUT) + (size_t)li * 1024 * 1024;
        bf16_t* woutt = (bf16_t*)(F.ws + WS_WOUT) + (size_t)l * 1024 * 1024;
        for (int it = F.gw; it < 16 * 32; it += F.NGW) { const int kb = it / 32, nb = it % 32; tr_item(wout, 1024, 32 * nb, 64 * kb, woutt, 1024, 32 * nb, scr, F.lane); }
        if (odd) {
            const float* wglu = GIN(I_ODWGLU) + (size_t)li * 512 * 512; bf16_t* wglut = (bf16_t*)(F.ws + WS_WGLU) + (size_t)li * 512 * 512;
            for (int it = F.gw; it < 8 * 16; it += F.NGW) { const int kb = it / 16, nb = it % 16; tr_item(wglu, 512, 32 * nb, 64 * kb, wglut, 512, 32 * nb, scr, F.lane); }
        }
        constexpr int GU_NB = 2 * FF / 32, GU_ITEMS = 16 * GU_NB;
        for (int it = F.gw; it < NE * GU_ITEMS; it += F.NGW) { const int e = it / GU_ITEMS, r = it % GU_ITEMS, kb = r / GU_NB, nb = r % GU_NB; const int d0 = 32 * nb, j = d0 >> 8, w = d0 & 255;
            const float* src = (w < 128 ? GIN(I_WGATE) : GIN(I_WUP)) + ((size_t)l * NE + e) * 1024 * FF;
            tr_item(src, FF, 128 * j + (w & 127), 64 * kb, (bf16_t*)(F.ws + WS_WGU) + ((size_t)l * NE + e) * 2 * FF * 1024, 1024, d0, scr, F.lane); }
        constexpr int D_ITEMS = (FF / 64) * 32;
        for (int it = F.gw; it < NE * D_ITEMS; it += F.NGW) { const int e = it / D_ITEMS, r = it % D_ITEMS, kb = r / 32, nb = r % 32;
            tr_item(GIN(I_WDOWN) + ((size_t)l * NE + e) * FF * 1024, 1024, 32 * nb, 64 * kb, (bf16_t*)(F.ws + WS_WD) + ((size_t)l * NE + e) * 1024 * FF, FF, 32 * nb, scr, F.lane); }
    }
    const int gt = F.bid * NTHREADS + F.tid, NGT = F.G * NTHREADS;
    for (int i = gt; i < DEPTH * 16 * 1024; i += NGT) { const int l = i / 16384, g = (i >> 10) & 15, k = i & 1023; const int odd = l & 1, li = l >> 1;
        ((float*)(F.ws + WS_WG))[i] = odd ? GIN(I_ODWIN)[((size_t)li * 1024 + k) * 2576 + 2048 + g] : GIN(I_EVWIN)[((size_t)li * 1024 + k) * 4112 + 2048 + g]; }
    for (int i = gt; i < DEPTH * NE * 1024; i += NGT) { const int k = i & 1023, e = (i >> 10) % NE, l = i / (NE * 1024); ((float*)(F.ws + WS_WR))[i] = GIN(I_WROUTER)[((size_t)l * 1024 + k) * NE + e]; }
    for (int i = gt; i < N_ODD * 2 * 32 * 64; i += NGT) { const int p = i & 63, g = (i >> 6) & 31, d = (i >> 11) & 1, o = i >> 12;
        const int idx = ((o * 2 + d) * 32 + g) * 64 + p;
        const float lr = fminf(GIN(I_ODLRE)[idx], -1e-4f), li_ = GIN(I_ODLIM)[idx], dt = expf(GIN(I_ODLDT)[(o * 2 + d) * 32 + g]);
        const float mag = expf(lr * dt); float sn, cs; sincosf(li_ * dt, &sn, &cs); const float are = mag * cs, aim = mag * sn;
        float* A = (float*)(F.ws + WS_S5A) + (size_t)((o * 2 + d) * 32 + g) * 128; A[p] = are; A[64 + p] = aim;
        const float xr = are - 1.0f, xi = aim, den = lr * lr + li_ * li_; const float fre = (xr * lr + xi * li_) / den, fim = (xi * lr - xr * li_) / den;
        bf16_t* Bb = (bf16_t*)(F.ws + WS_S5B) + (size_t)((o * 2 + d) * 32 + g) * 128 * 16;
        for (int h = 0; h < 16; ++h) { const float br = GIN(I_ODBRE)[((size_t)(o * 32 + g) * 64 + p) * 16 + h], bi = GIN(I_ODBIM)[((size_t)(o * 32 + g) * 64 + p) * 16 + h];
            Bb[p * 16 + h] = (bf16_t)f2bf(fre * br - fim * bi); Bb[(64 + p) * 16 + h] = (bf16_t)f2bf(fre * bi + fim * br); } }
    for (int i = gt; i < N_ODD * 32 * 16 * 64; i += NGT) { const int p = i & 63, c = (i >> 6) & 15, g = (i >> 10) & 31, o = i >> 15;
        bf16_t* Cm = (bf16_t*)(F.ws + WS_S5C) + (size_t)((o * 32 + g) * 16 + c) * 128;
        Cm[2 * p] = (bf16_t)f2bf(GIN(I_ODCRE)[i]); Cm[2 * p + 1] = (bf16_t)f2bf(-GIN(I_ODCIM)[i]); }
    ROW_LOOP(r, MPAD) {
        f32x4* dst = (f32x4*)((float*)(F.ws + WS_H) + (size_t)r * 1024) + F.lane;
        if (r < MROWS) { int b, s; row_bs(r, b, s); const f32x4* src = (const f32x4*)(s < CTX ? GIN(I_CTX) + ((size_t)b * CTX + s) * 1024 : GIN(I_X) + ((size_t)b * SEQ + (s - CTX)) * 1024) + F.lane;
#pragma unroll
            for (int j = 0; j < 4; ++j) dst[64 * j] = src[64 * j]; }
        else {
#pragma unroll
            for (int j = 0; j < 4; ++j) dst[64 * j] = (f32x4){0.f, 0.f, 0.f, 0.f};
            u32x4* xz = (u32x4*)((bf16_t*)(F.ws + WS_XIN) + (size_t)r * 1024) + F.lane; xz[0] = (u32x4){0u, 0u, 0u, 0u}; xz[64] = (u32x4){0u, 0u, 0u, 0u};
            u32x4* mz = (u32x4*)((bf16_t*)(F.ws + WS_MERGED) + (size_t)r * 1024) + F.lane; mz[0] = (u32x4){0u, 0u, 0u, 0u}; mz[64] = (u32x4){0u, 0u, 0u, 0u};
            u32x4* yz = (u32x4*)((bf16_t*)(F.ws + WS_YS) + (size_t)r * 512) + F.lane; yz[0] = (u32x4){0u, 0u, 0u, 0u};
        }
    }
    __syncthreads();
    LAS float* sv = (LAS float*)F.lds;
    LAS float* part = (LAS float*)(F.lds + 32768);
    for (int i = F.tid; i < NR * 1024; i += NTHREADS) { const int r = i >> 10, k = i & 1023; const float c = r < B_ ? GIN(I_C)[r * 1024 + k] : GIN(I_CCTX)[k]; sv[i] = silu_f(c); }
    __syncthreads();
    for (int it = F.bid; it < DEPTH * 96; it += F.G) {
        const int l = it / 96, j = (it % 96) * 64 + F.lane;
        const float* w = GIN(I_WMOD) + (size_t)l * 1024 * 6144 + j;
        float acc[NR];
#pragma unroll
        for (int r = 0; r < NR; ++r) acc[r] = 0.f;
        const int k0 = F.wave * 128;
#pragma unroll 8
        for (int k = 0; k < 128; ++k) { const float wv = w[(size_t)(k0 + k) * 6144];
#pragma unroll
            for (int r = 0; r < NR; ++r) acc[r] += sv[r * 1024 + k0 + k] * wv; }
#pragma unroll
        for (int r = 0; r < NR; ++r) part[(F.wave * NR + r) * 64 + F.lane] = acc[r];
        __syncthreads();
        for (int i = F.tid; i < NR * 64; i += NTHREADS) { const int r = i >> 6, jj = i & 63; float s = 0.f;
#pragma unroll
            for (int w8 = 0; w8 < 8; ++w8) s += part[(w8 * NR + r) * 64 + jj];
            const int col = (it % 96) * 64 + jj;
            ((float*)(F.ws + WS_MOD))[((size_t)l * NR + r) * 6144 + col] = s + GIN(I_BMOD)[l * 6144 + col]; }
        __syncthreads();
    }
}

constexpr int RG = 4;
static_assert(TOK % RG == 0 && CTX % RG == 0 && MROWS % RG == 0, "row groups");
DEV void xg_rows(const Frame& F, int l, int row0, f32x4 (&v)[RG][4]) {
    int b, s; row_bs(row0, b, s); const int mr = s < CTX ? B_ : b;
    const float* mod = (const float*)(F.ws + WS_MOD) + ((size_t)l * NR + mr) * 6144;
#pragma unroll
    for (int j = 0; j < 4; ++j) { const f32x4 sh = *((const f32x4*)mod + F.lane + 64 * j), sc = *((const f32x4*)(mod + 1024) + F.lane + 64 * j);
#pragma unroll
        for (int q = 0; q < RG; ++q) v[q][j] = v[q][j] * (1.0f + sc) + sh; }
#pragma unroll
    for (int q = 0; q < RG; ++q) { u32x2* xo = (u32x2*)((bf16_t*)(F.ws + WS_XIN) + (size_t)(row0 + q) * 1024) + F.lane;
#pragma unroll
        for (int j = 0; j < 4; ++j) xo[64 * j] = (u32x2){pk2(v[q][j].x, v[q][j].y), pk2(v[q][j].z, v[q][j].w)}; }
    const float* wg = (const float*)(F.ws + WS_WG) + (size_t)l * 16 * 1024;
    float mine[RG]; const int gi = F.lane & 15;
#pragma unroll
    for (int q = 0; q < RG; ++q) mine[q] = 0.f;
    f32x4 wc[4];
#pragma unroll
    for (int j = 0; j < 4; ++j) wc[j] = *((const f32x4*)wg + F.lane + 64 * j);
#pragma unroll 1
    for (int g = 0; g < 16; ++g) { f32x4 wn[4]; const int gn = g + 1 < 16 ? g + 1 : g;
#pragma unroll
        for (int j = 0; j < 4; ++j) wn[j] = *((const f32x4*)(wg + gn * 1024) + F.lane + 64 * j);
#pragma unroll
        for (int q = 0; q < RG; ++q) { float p = 0.f;
#pragma unroll
            for (int j = 0; j < 4; ++j) p += v[q][j].x * wc[j].x + v[q][j].y * wc[j].y + v[q][j].z * wc[j].z + v[q][j].w * wc[j].w;
            const float t = wave_sum(p); mine[q] = (gi == g) ? t : mine[q]; }
#pragma unroll
        for (int j = 0; j < 4; ++j) wc[j] = wn[j]; }
    const int ty = gi >> 2, hh = gi & 3, li = l >> 1;
#pragma unroll
    for (int q = 0; q < RG; ++q) { float o;
        if (!(l & 1)) {
            if (ty < 2) o = -expf(GIN(I_EVALOG)[(li * 2 + ty) * 4 + hh]) * softplus_f(mine[q] + GIN(I_EVDTB)[(li * 2 + ty) * 4 + hh]);
            else o = sigmoid_f(mine[q]);
        } else {
            const int d = ty & 1, k = ty >> 1; const float gb = GIN(I_ODGB)[((li * 2 + d) * 2 + k) * 4 + hh];
            o = k ? -softplus_f(-(mine[q] + gb)) : mine[q] + gb;
        }
        if (F.lane < 16) ((float*)(F.ws + WS_GATES))[(size_t)(row0 + q) * 16 + gi] = o; }
}

DEV void phase_xg0(const Frame& F0) {
    const Frame F = refresh(F0);
    for (int r = RG * F.gw; r < MROWS; r += RG * F.NGW) {
        f32x4 v[RG][4];
#pragma unroll
        for (int q = 0; q < RG; ++q) { const f32x4* hr = (const f32x4*)((const float*)(F.ws + WS_H) + (size_t)(r + q) * 1024) + F.lane;
#pragma unroll
            for (int j = 0; j < 4; ++j) v[q][j] = hr[64 * j]; }
        xg_rows(F, 0, r, v);
    }
}

DEV void phase_prep(const Frame& F0, int l) {
    const Frame F = refresh(F0);
    const int odd = l & 1, li = l >> 1; const int nin = odd ? NIN_O : NIN_E, nseg = odd ? 2 : 3, qld = odd ? 1024 : 1536;
    const bf16_t* P = (const bf16_t*)(F.ws + WS_P); bf16_t* Q = (bf16_t*)(F.ws + WS_QKV);
    const float* cw = odd ? GIN(I_ODCONV) + (size_t)li * 9 * 1024 : GIN(I_EVCONV) + (size_t)li * 9 * 1536; const int cch = odd ? 1024 : 1536;
    for (int r = RG * F.gw; r < MROWS; r += RG * F.NGW) {
        int b, s; row_bs(r, b, s); const bool lat = s >= CTX; const int rr = lat ? (s - CTX) >> 6 : 0, cc = lat ? (s - CTX) & 63 : s;
        const int ncol = lat ? 64 : CTX;
        for (int seg = 0; seg < nseg; ++seg) {
            const int ch0 = seg * 512 + F.lane * 8; float a[RG][8];
#pragma unroll
            for (int q = 0; q < RG; ++q)
#pragma unroll
                for (int i = 0; i < 8; ++i) a[q][i] = 0.f;
#pragma unroll
            for (int kh = 0; kh < 3; ++kh) {
                const int r2 = rr + kh - 1; const bool rok = lat ? (r2 >= 0 && r2 < SEQ / 64) : (kh == 1);
                if (rok) {
                    f32x4 w0[3], w1[3];
#pragma unroll
                    for (int kw = 0; kw < 3; ++kw) { w0[kw] = *(const f32x4*)(cw + (kh * 3 + kw) * cch + ch0); w1[kw] = *(const f32x4*)(cw + (kh * 3 + kw) * cch + ch0 + 4); }
                    const int rowbase = lat ? b * SEQ + r2 * 64 : LATR + b * CTX;
#pragma unroll
                    for (int dc = 0; dc < RG + 2; ++dc) { const int c2 = cc - 1 + dc;
                        if (c2 >= 0 && c2 < ncol) { const u32x4 pv = *(const u32x4*)(P + (size_t)(rowbase + c2) * nin + ch0);
                            const float x0 = bflo(pv.x), x1 = bfhi(pv.x), x2 = bflo(pv.y), x3 = bfhi(pv.y), x4 = bflo(pv.z), x5 = bfhi(pv.z), x6 = bflo(pv.w), x7 = bfhi(pv.w);
#pragma unroll
                            for (int q = 0; q < RG; ++q) { const int kw = dc - q;
                                if (kw >= 0 && kw <= 2) { a[q][0] += x0 * w0[kw].x; a[q][1] += x1 * w0[kw].y; a[q][2] += x2 * w0[kw].z; a[q][3] += x3 * w0[kw].w;
                                    a[q][4] += x4 * w1[kw].x; a[q][5] += x5 * w1[kw].y; a[q][6] += x6 * w1[kw].z; a[q][7] += x7 * w1[kw].w; } } } }
                }
            }
#pragma unroll
            for (int q = 0; q < RG; ++q) {
                float ss = 0.f;
#pragma unroll
                for (int i = 0; i < 8; ++i) { a[q][i] = silu_f(a[q][i]); ss += a[q][i] * a[q][i]; }
                float sc = 1.0f;
                if (!odd) { if (seg < 2) { ss = group_sum<16>(ss); sc = 1.0f / sqrtf(ss + 1e-6f); if (seg == 0) sc *= HD_SCALE; } }
                else if (seg == 1) sc = HD_SCALE;
                u32x4 o; o.x = pk2(a[q][0] * sc, a[q][1] * sc); o.y = pk2(a[q][2] * sc, a[q][3] * sc); o.z = pk2(a[q][4] * sc, a[q][5] * sc); o.w = pk2(a[q][6] * sc, a[q][7] * sc);
                *(u32x4*)(Q + (size_t)(r + q) * qld + ch0) = o;
            }
        }
    }
    if (odd) {
        const float* GT = (const float*)(F.ws + WS_GATES); float* MC = (float*)(F.ws + WS_MCH);
        for (int c = F.gw; c < B_ * 4 * 2; c += F.NGW) { const int d = c & 1, hh = (c >> 1) & 3, b = c >> 3; float m = 0.f;
            for (int n = 0; n < NCH; ++n) { const int row = tok_row(b, d, n * 64 + F.lane);
                const float lin = GT[(size_t)row * 16 + d * 4 + hh], lf = GT[(size_t)row * 16 + 8 + d * 4 + hh];
                float bc = lf;
#pragma unroll
                for (int o = 1; o < 64; o <<= 1) { const float t = shfl_t(bc, F.lane - o); if (F.lane >= o) bc += t; }
                const float bend = shfl_t(bc, 63); const float amax = wave_max(bend - bc + lin);
                if (F.lane == 0) MC[(size_t)c * NCH + n] = m;
                m = fmaxf(bend + m, amax); }
        }
    }
}

DEV void phase_cl(const Frame& F0, int l) {
    const Frame F = refresh(F0);
    const int odd = l & 1; const int nhh = odd ? 4 : 8; const int nprob = B_ * nhh * 2 * NCH;
    LAS float* gc = (LAS float*)(F.lds);
    LAS float* bt = (LAS float*)(F.lds + 256);
    LAS int* rix = (LAS int*)(F.lds + 512);
    LAS float* qs = (LAS float*)(F.lds + 768);
    LAS float* ks = (LAS float*)(F.lds + 1024);
    LAS float* mt = (LAS float*)(F.lds + 1280);
    LAS float* sc = (LAS float*)(F.lds + 1536);
    LAS float* rsp = (LAS float*)(F.lds + 2048);
    LAS float* Am = (LAS float*)(F.lds + 4096);
    LAS bf16_t* An = (LAS bf16_t*)(F.lds + 20480);
    LAS bf16_t* XT = (LAS bf16_t*)(F.lds + 30720);
    LAS float* Rb = (LAS float*)(F.lds + 69632 + F.wave * 2048);
    LAS float* ksp = (LAS float*)(F.lds + 86016);
    const bf16_t* P = (const bf16_t*)(F.ws + WS_P); const bf16_t* Q = (const bf16_t*)(F.ws + WS_QKV); const float* GT = (const float*)(F.ws + WS_GATES);
    const int h = F.lane >> 5, l31 = F.lane & 31;
    for (int p = F.bid; p < nprob; p += F.G) {
        const int n = p % NCH, d = (p / NCH) & 1, hh = (p / (2 * NCH)) % nhh, b = p / (2 * NCH * nhh);
        const int kind = odd ? 2 : (hh < 4 ? 0 : 1);
        const bf16_t *qsrc, *ksrc, *vsrc; int qld, vld; float kscale = 1.0f;
        if (kind == 0) { qsrc = Q + hh * 128; ksrc = Q + 512 + hh * 128; vsrc = Q + 1024 + hh * 128; qld = 1536; vld = 1536; }
        else if (kind == 1) { qsrc = P + 2048 + (hh - 4) * 128; ksrc = P + 2560 + (hh - 4) * 128; vsrc = P + 3072 + (hh - 4) * 128; qld = NIN_E; vld = NIN_E; kscale = HD_SCALE; }
        else { qsrc = Q + hh * 128; ksrc = Q + 512 + hh * 128; vsrc = P + 1024 + hh * 128; qld = 1024; vld = NIN_O; }
        float* CS = (float*)(F.ws + WS_CLS) + (size_t)p * 512;
        if (F.wave == 0) {
            const int i = F.lane; const int row = tok_row(b, d, n * 64 + i); rix[i] = row;
            float g, be = 0.f;
            if (kind == 0) { g = GT[(size_t)row * 16 + d * 4 + hh]; be = GT[(size_t)row * 16 + 8 + d * 4 + hh]; }
            else if (kind == 1) g = log1pf(-exp2f(-(5.0f + 2.0f * (float)(hh - 4) + (float)d)));
            else { be = GT[(size_t)row * 16 + d * 4 + hh]; g = GT[(size_t)row * 16 + 8 + d * 4 + hh]; }
            float cum = g;
#pragma unroll
            for (int o = 1; o < 64; o <<= 1) { const float t = shfl_t(cum, i - o); if (i >= o) cum += t; }
            const float gend = shfl_t(cum, 63);
            gc[i] = cum; bt[i] = be;
            if (kind < 2) { qs[i] = expf(cum); ks[i] = expf(gend - cum) * kscale; if (i == 0) { sc[0] = expf(gend); CS[0] = expf(gend); } }
            else {
                const float mprev = ((const float*)(F.ws + WS_MCH))[(size_t)((b * 4 + hh) * 2 + d) * NCH + n];
                const float a = gend - cum + be; const float amax = wave_max(a); const float mnew = fmaxf(gend + mprev, amax);
                ks[i] = expf(a - mnew);
                float pm = be - cum;
#pragma unroll
                for (int o = 1; o < 64; o <<= 1) { const float t = shfl_t(pm, i - o); if (i >= o) pm = fmaxf(pm, t); }
                const float mti = cum + fmaxf(mprev, pm); mt[i] = mti; qs[i] = expf(cum + mprev - mti);
                CS[128 + i] = expf(-mti);
                if (i == 0) { const float dec = expf(gend + mprev - mnew); sc[0] = dec; CS[0] = dec; }
            }
        }
        __syncthreads();
        {
            const int w4 = F.wave & 3, mt_ = w4 >> 1, nt_ = w4 & 1; const bool doY = F.wave >= 4;
            if (!doY || kind == 0) {
                const int rj = rix[32 * mt_ + l31], ri = rix[32 * nt_ + l31];
                const bf16_t* ap = ksrc + (size_t)rj * qld + 8 * h; const bf16_t* bp = (doY ? ksrc : qsrc) + (size_t)ri * qld + 8 * h;
                f32x16 acc;
#pragma unroll
                for (int r = 0; r < 16; ++r) acc[r] = 0.f;
#pragma unroll
                for (int s = 0; s < 8; ++s) { const bf16x8 a = *(const bf16x8*)(ap + 16 * s), bb = *(const bf16x8*)(bp + 16 * s); acc = mfma32(a, bb, acc); }
                const int i = 32 * nt_ + l31; const float gi = gc[i];
                if (!doY) {
                    bf16_t* AQ = (bf16_t*)(F.ws + WS_CLA) + (size_t)p * 4096 + (size_t)i * 64; float rsum = 0.f; const float mti = kind == 2 ? mt[i] : 0.f;
#pragma unroll
                    for (int g4 = 0; g4 < 4; ++g4) { float v[4];
#pragma unroll
                        for (int r = 0; r < 4; ++r) { const int j = 32 * mt_ + 8 * g4 + 4 * h + r; float e;
                            if (kind < 2) e = expf(fminf(gi - gc[j], 0.f)); else e = expf(gi - gc[j] + bt[j] - mti);
                            v[r] = (i >= j) ? acc[4 * g4 + r] * kscale * e : 0.f; rsum += v[r]; }
                        *(u32x2*)(AQ + 32 * mt_ + 8 * g4 + 4 * h) = (u32x2){pk2(v[0], v[1]), pk2(v[2], v[3])}; }
                    if (kind == 2) rsp[i * 4 + mt_ * 2 + h] = rsum;
                } else {
                    const float bi = bt[i];
#pragma unroll
                    for (int r = 0; r < 16; ++r) { const int j = 32 * mt_ + 8 * (r >> 2) + 4 * h + (r & 3);
                        const float av = (i > j) ? bi * acc[r] * expf(fminf(gi - gc[j], 0.f)) : 0.f;
                        Am[i * 64 + j] = av; An[i * 72 + j] = (bf16_t)f2bf(-av); }
                }
            }
        }
        __syncthreads();
        if (kind == 0) {
            const int l15 = F.lane & 15, kg = F.lane >> 4; const int pg = ((b * 4 + hh) * 2 + d) * NCH + n;
            const bool isw = F.wave >= 4; const bf16_t* src = isw ? ksrc - 128 : vsrc;
            float* U = (float*)(F.ws + WS_CLU) + (size_t)pg * 8192; bf16_t* W = (bf16_t*)(F.ws + WS_CLW) + (size_t)p * 8192;
            float rhsv[4][2][4];
#pragma unroll
            for (int bb = 0; bb < 4; ++bb)
#pragma unroll
                for (int nt2 = 0; nt2 < 2; ++nt2)
#pragma unroll
                    for (int r = 0; r < 4; ++r) { const int i = 16 * bb + 4 * kg + r; rhsv[bb][nt2][r] = bf2f(src[(size_t)rix[i] * 1536 + 32 * F.wave + 16 * nt2 + l15]); }
#pragma unroll
            for (int bb = 0; bb < 4; ++bb) {
#pragma unroll
                for (int nt2 = 0; nt2 < 2; ++nt2) {
                    const int c = 32 * F.wave + 16 * nt2 + l15; f32x4 acc;
#pragma unroll
                    for (int r = 0; r < 4; ++r) { const int i = 16 * bb + 4 * kg + r; acc[r] = bt[i] * rhsv[bb][nt2][r] * (isw ? qs[i] : 1.0f); }
                    for (int ks = 0; ks < 2; ++ks) if (32 * ks < 16 * bb) {
                        const bool in = 32 * ks + 8 * kg + 8 <= 16 * bb;
                        bf16x8 a = *(const LAS bf16x8*)(An + (16 * bb + l15) * 72 + 32 * ks + 8 * kg); if (!in) a = (bf16x8){0, 0, 0, 0, 0, 0, 0, 0};
                        const bf16x8 xb = *(const LAS bf16x8*)(XT + c * 72 + 32 * ks + 8 * kg);
                        acc = mfma16(a, in ? xb : (bf16x8){0, 0, 0, 0, 0, 0, 0, 0}, acc); }
#pragma unroll
                    for (int r = 0; r < 4; ++r) Rb[(4 * kg + r) * 32 + 16 * nt2 + l15] = acc[r];
                }
                WAVE_LDS_SYNC();
                if (F.lane < 32) {
                    const int c = 32 * F.wave + F.lane; float x[16];
#pragma unroll
                    for (int i = 0; i < 16; ++i) { float r = Rb[i * 32 + F.lane];
#pragma unroll
                        for (int j = 0; j < i; ++j) r -= Am[(16 * bb + i) * 64 + 16 * bb + j] * x[j];
                        x[i] = r; }
                    if (!isw) {
#pragma unroll
                        for (int i = 0; i < 16; ++i) U[(16 * bb + i) * 128 + c] = x[i]; }
                    else {
#pragma unroll
                        for (int i = 0; i < 16; ++i) W[(16 * bb + i) * 128 + (c - 128)] = (bf16_t)f2bf(-x[i]); }
                    *(LAS u32x4*)(XT + c * 72 + 16 * bb) = (u32x4){pk2(x[0], x[1]), pk2(x[2], x[3]), pk2(x[4], x[5]), pk2(x[6], x[7])};
                    *(LAS u32x4*)(XT + c * 72 + 16 * bb + 8) = (u32x4){pk2(x[8], x[9]), pk2(x[10], x[11]), pk2(x[12], x[13]), pk2(x[14], x[15])};
                }
                WAVE_LDS_SYNC();
            }
        }
        {
            const int c = F.tid & 127, q4 = F.tid >> 7; bf16_t* QD = (bf16_t*)(F.ws + WS_CLQ) + (size_t)p * 8192 + c;
            for (int i = 16 * q4; i < 16 * q4 + 16; ++i) QD[i * 128] = (bf16_t)f2bf(bf2f(qsrc[(size_t)rix[i] * qld + c]) * qs[i]);
            bf16_t* KT = (bf16_t*)(F.ws + WS_CLK) + (size_t)p * 8192 + (size_t)c * 64;
            float ksum = 0.f;
            for (int j8 = 2 * q4; j8 < 2 * q4 + 2; ++j8) { float v[8];
#pragma unroll
                for (int r = 0; r < 8; ++r) { const int j = 8 * j8 + r; v[r] = bf2f(ksrc[(size_t)rix[j] * qld + c]) * ks[j]; ksum += v[r]; }
                *(u32x4*)(KT + 8 * j8) = (u32x4){pk2(v[0], v[1]), pk2(v[2], v[3]), pk2(v[4], v[5]), pk2(v[6], v[7])}; }
            ksp[c * 4 + q4] = ksum;
            if (kind == 2 && F.tid < 64) CS[64 + F.tid] = (rsp[F.tid * 4] + rsp[F.tid * 4 + 1]) + (rsp[F.tid * 4 + 2] + rsp[F.tid * 4 + 3]);
        }
        __syncthreads();
        if (kind == 2 && F.tid < 128) CS[256 + F.tid] = (ksp[F.tid * 4] + ksp[F.tid * 4 + 1]) + (ksp[F.tid * 4 + 2] + ksp[F.tid * 4 + 3]);
    }
}

#define LDS_BARRIER() do { WAIT_LGKM(0); S_BARRIER(); COMPILER_FENCE(); } while (0)
constexpr int SQ_W = 0, SQ_Q = 16384, SQ_K = 32768, SQ_A = 49152, SQ_U = 57344, SQ_C = 65536, SQ_STAGE = 67584;
constexpr int SQ_SB = 2 * SQ_STAGE, SQ_VN = SQ_SB + 8704, SQ_NV = SQ_VN + 4608, SQ_DEN = SQ_NV + 512;
static_assert(SQ_DEN + 256 <= LDS_MISC, "SEQ LDS map");
struct SeqCtx { int kind, b, hh, d, sl, chain, vld; const GAS bf16_t* vsrc; int probe; };
DEV int swz256(int r, int k) { return r * 256 + 16 * (k ^ (r & 15)); }
DEV int swz128(int r, int k) { return r * 128 + 16 * (k ^ ((r >> 1) & 7)); }
template <int KIND>
DEV void seq_dma(const Frame& F, const SeqCtx& C, int n, LAS unsigned char* img) {
    const int p = C.chain * NCH + n, w = F.wave; int ln = F.lane; LAUNDER(ln);
    if (w < 2) {
        if (KIND == 0) { const GAS char* g = (const GAS char*)(F.ws + WS_CLW) + (size_t)p * 16384; LAUNDER_S(g);
#pragma unroll
            for (int i = 0; i < 8; ++i) { const int r = 4 * (8 * w + i) + (ln >> 4), pp = ln & 15; glds16(g + r * 256 + 16 * (pp ^ (r & 15)), img + SQ_W + 1024 * (8 * w + i)); } }
    } else if (w < 4) {
        const GAS char* g = (const GAS char*)(F.ws + WS_CLQ) + (size_t)p * 16384; LAUNDER_S(g);
#pragma unroll
        for (int i = 0; i < 8; ++i) { const int c = 8 * (w - 2) + i, r = 4 * c + (ln >> 4), pp = ln & 15; glds16(g + r * 256 + 16 * (pp ^ (r & 15)), img + SQ_Q + 1024 * c); }
    } else if (w < 6) {
        const GAS char* g = (const GAS char*)(F.ws + WS_CLK) + (size_t)p * 16384; LAUNDER_S(g);
#pragma unroll
        for (int i = 0; i < 8; ++i) { const int c = 8 * (w - 4) + i, r = 8 * c + (ln >> 3), pp = ln & 7; glds16(g + r * 128 + 16 * (pp ^ ((r >> 1) & 7)), img + SQ_K + 1024 * c); }
    } else if (w == 6) {
        const GAS char* g = (const GAS char*)(F.ws + WS_CLA) + (size_t)p * 8192; LAUNDER_S(g);
#pragma unroll
        for (int i = 0; i < 8; ++i) { const int r = 8 * i + (ln >> 3), pp = ln & 7; glds16(g + r * 128 + 16 * (pp ^ ((r >> 1) & 7)), img + SQ_A + 1024 * i); }
    } else {
        if (KIND == 0) { const int pg = ((C.b * 4 + C.hh) * 2 + C.d) * NCH + n; const GAS char* g = (const GAS char*)(F.ws + WS_CLU) + (size_t)pg * 32768 + 128 * C.sl; LAUNDER_S(g);
#pragma unroll
            for (int i = 0; i < 8; ++i) { const int r = 8 * i + (ln >> 3); glds16(g + r * 512 + 16 * (ln & 7), img + SQ_U + 1024 * i); }
        } else { const int r0 = tok_row(C.b, C.d, n * 64); const long st = C.d ? -(long)C.vld * 2 : (long)C.vld * 2;
            const GAS char* g = (const GAS char*)C.vsrc + (long)r0 * C.vld * 2 + 64 * C.sl; LAUNDER_S(g);
#pragma unroll
            for (int i = 0; i < 4; ++i) { const int r = 16 * i + (ln >> 2); glds16(g + (long)r * st + 16 * (ln & 3), img + SQ_U + 1024 * i); }
        }
        const GAS char* cs = (const GAS char*)(F.ws + WS_CLS) + (size_t)p * 2048; LAUNDER_S(cs);
        glds16(cs + 16 * ln, img + SQ_C);
        if (KIND == 2) glds16(cs + 1024 + 16 * ln, img + SQ_C + 1024);
    }
}
#define SEQ_WAIT_DMA(younger) do { if ((younger) == 16) WAIT_VM(16); else WAIT_VM(0); } while (0)
template <int KIND>
DEV void seq_step(const Frame& F, const SeqCtx& C, int n, f32x16& acc, LAS unsigned char* lds) {
    int lz = F.lane; LAUNDER(lz); const int h = lz >> 5, l31 = lz & 31;
    LAS unsigned char* img = lds + (n & 1) * SQ_STAGE; LAS unsigned char* nimg = lds + ((n + 1) & 1) * SQ_STAGE;
    LAS bf16_t* Sb = (LAS bf16_t*)(lds + SQ_SB); LAS bf16_t* Vn = (LAS bf16_t*)(lds + SQ_VN); LAS float* nvec = (LAS float*)(lds + SQ_NV); LAS float* den = (LAS float*)(lds + SQ_DEN);
    const LAS float* CS = (const LAS float*)(img + SQ_C);
    if (C.probe != 3) seq_dma<KIND>(F, C, C.probe == 2 ? 0 : (n + 1 < NCH ? n + 1 : NCH - 1), nimg);
    if (F.wave < 2) {
        const int mt_ = F.wave;
        if (KIND == 0) {
#pragma unroll
            for (int r = 0; r < 16; ++r) acc[r] = *(const LAS float*)(img + SQ_U + (32 * mt_ + 8 * (r >> 2) + 4 * h + (r & 3)) * 128 + 4 * l31);
            bf16x8 sb[8], wf[8]; const int rr = 32 * mt_ + l31;
#pragma unroll
            for (int s = 0; s < 8; ++s) { sb[s] = *(const LAS bf16x8*)(Sb + l31 * 136 + 16 * s + 8 * h); wf[s] = *(const LAS bf16x8*)(img + SQ_W + swz256(rr, 2 * s + h)); }
#pragma unroll
            for (int s = 0; s < 8; ++s) acc = mfma32(wf[s], sb[s], acc);
        } else {
#pragma unroll
            for (int r = 0; r < 16; ++r) acc[r] = bf2f(*(const LAS bf16_t*)(img + SQ_U + (32 * mt_ + 8 * (r >> 2) + 4 * h + (r & 3)) * 64 + 2 * l31));
        }
#pragma unroll
        for (int g4 = 0; g4 < 4; ++g4) *(LAS u32x2*)(Vn + l31 * 72 + 32 * mt_ + 8 * g4 + 4 * h) = (u32x2){pk2(acc[4 * g4], acc[4 * g4 + 1]), pk2(acc[4 * g4 + 2], acc[4 * g4 + 3])};
    } else if (F.wave < 4) {
        const int rr = 32 * (F.wave - 2) + l31;
#pragma unroll
        for (int r = 0; r < 16; ++r) acc[r] = 0.f;
        bf16x8 sb[8], qf[8];
#pragma unroll
        for (int s = 0; s < 8; ++s) { sb[s] = *(const LAS bf16x8*)(Sb + l31 * 136 + 16 * s + 8 * h); qf[s] = *(const LAS bf16x8*)(img + SQ_Q + swz256(rr, 2 * s + h)); }
#pragma unroll
        for (int s = 0; s < 8; ++s) acc = mfma32(qf[s], sb[s], acc);
    } else if (KIND == 2) {
        const int t = F.tid - 256, i = t >> 2, q = t & 3; float s = 0.f;
#pragma unroll
        for (int c8 = 0; c8 < 4; ++c8) { const u32x4 w = *(const LAS u32x4*)(img + SQ_Q + swz256(i, 4 * q + c8)); const LAS float* nv = nvec + 32 * q + 8 * c8;
            s += bflo(w.x) * nv[0] + bfhi(w.x) * nv[1] + bflo(w.y) * nv[2] + bfhi(w.y) * nv[3] + bflo(w.z) * nv[4] + bfhi(w.z) * nv[5] + bflo(w.w) * nv[6] + bfhi(w.w) * nv[7]; }
        s = group_sum<4>(s);
        if (q == 0) den[i] = fmaxf(fabsf(CS[64 + i] + s), CS[128 + i]);
    }
    LDS_BARRIER();
    if (F.wave >= 2 && F.wave < 4) {
        const int mt_ = F.wave - 2, rr = 32 * mt_ + l31;
        bf16x8 vb[4], af[4];
#pragma unroll
        for (int s = 0; s < 4; ++s) { vb[s] = *(const LAS bf16x8*)(Vn + l31 * 72 + 16 * s + 8 * h); af[s] = *(const LAS bf16x8*)(img + SQ_A + swz128(rr, 2 * s + h)); }
#pragma unroll
        for (int s = 0; s < 4; ++s) acc = mfma32(af[s], vb[s], acc);
        const int r0 = tok_row(C.b, C.d, n * 64); const long st = C.d ? -2048l : 2048l;
        GAS char* Ob = (GAS char*)(F.ws + WS_O) + ((size_t)C.d * MROWS + r0) * 2048 + (long)(32 * mt_) * st; LAUNDER_S(Ob); const long lo = (long)(4 * h) * st + (long)((C.hh * 128 + 32 * C.sl + l31) * 2);
#pragma unroll
        for (int r = 0; r < 16; ++r) { const int i = 32 * mt_ + 8 * (r >> 2) + 4 * h + (r & 3); float v = acc[r];
            if (KIND == 2) v = v / den[i];
            if (!C.probe) *(GAS bf16_t*)(Ob + (long)(8 * (r >> 2) + (r & 3)) * st + lo) = (bf16_t)f2bf(v); }
        SEQ_WAIT_DMA(16);
    } else if (F.wave >= 4) {
        const int kb = F.wave - 4, rr = 32 * kb + l31; const float ge = CS[0];
        bf16x8 vb[4], kf[4];
#pragma unroll
        for (int s = 0; s < 4; ++s) { vb[s] = *(const LAS bf16x8*)(Vn + l31 * 72 + 16 * s + 8 * h); kf[s] = *(const LAS bf16x8*)(img + SQ_K + swz128(rr, 2 * s + h)); }
#pragma unroll
        for (int r = 0; r < 16; ++r) acc[r] *= ge;
#pragma unroll
        for (int s = 0; s < 4; ++s) acc = mfma32(kf[s], vb[s], acc);
#pragma unroll
        for (int g4 = 0; g4 < 4; ++g4) *(LAS u32x2*)(Sb + l31 * 136 + 32 * kb + 8 * g4 + 4 * h) = (u32x2){pk2(acc[4 * g4], acc[4 * g4 + 1]), pk2(acc[4 * g4 + 2], acc[4 * g4 + 3])};
        if (KIND == 2 && F.tid < 256 + 128) { const int dd = F.tid - 256; nvec[dd] = ge * nvec[dd] + CS[256 + dd]; }
        SEQ_WAIT_DMA(0);
    } else SEQ_WAIT_DMA(0);
    LDS_BARRIER();
}
template <int KIND>
DEV void seq_kind_loop(const Frame& F, const SeqCtx& C, LAS unsigned char* lds) {
    f32x16 acc;
#pragma unroll
    for (int r = 0; r < 16; ++r) acc[r] = 0.f;
    seq_dma<KIND>(F, C, 0, lds);
    WAIT_VM(0);
    LDS_BARRIER();
    for (int n = 0; n < NCH; ++n) seq_step<KIND>(F, C, n, acc, lds);
}
DEV void seq_linear_item(const Frame& F, int l, int item, int probe = 0) {
    const int odd = l & 1, nhh = odd ? 4 : 8;
    SeqCtx C; C.probe = probe; C.sl = item & 3; C.chain = item >> 2; C.d = C.chain & 1; C.hh = (C.chain >> 1) % nhh; C.b = C.chain / (2 * nhh);
    C.kind = odd ? 2 : (C.hh < 4 ? 0 : 1);
    const GAS bf16_t* P = (const GAS bf16_t*)(F.ws + WS_P); const GAS bf16_t* Q = (const GAS bf16_t*)(F.ws + WS_QKV);
    if (C.kind == 0) { C.vsrc = Q + 1024 + C.hh * 128; C.vld = 1536; } else if (C.kind == 1) { C.vsrc = P + 3072 + (C.hh - 4) * 128; C.vld = NIN_E; } else { C.vsrc = P + 1024 + C.hh * 128; C.vld = NIN_O; }
    for (int i = F.tid; i < 32 * 136 / 2; i += NTHREADS) ((LAS unsigned*)(F.lds + SQ_SB))[i] = 0u;
    if (F.tid < 128) ((LAS float*)(F.lds + SQ_NV))[F.tid] = 0.f;
    __syncthreads();
    if (C.kind == 0) seq_kind_loop<0>(F, C, F.lds); else if (C.kind == 1) seq_kind_loop<1>(F, C, F.lds); else seq_kind_loop<2>(F, C, F.lds);
    WAIT_VM(0);
}

DEV void seq_s5_item(const Frame& F, int l, int item) {
    const int o = l >> 1; const int g = item & 31, d = (item >> 5) & 1, b = item >> 6;
    LAS float* El = (LAS float*)(F.lds);
    LAS unsigned char* wl = F.lds + 36864 + F.wave * 14336;
    LAS float* scr = (LAS float*)wl; LAS bf16_t* hb = (LAS bf16_t*)(wl + 10240);
    const bf16_t* P = (const bf16_t*)(F.ws + WS_P);
    const float* Ab = (const float*)(F.ws + WS_S5A) + (size_t)((o * 2 + d) * 32 + g) * 128;
    const bf16_t* Bb = (const bf16_t*)(F.ws + WS_S5B) + (size_t)((o * 2 + d) * 32 + g) * 128 * 16;
    const bf16_t* Cm = (const bf16_t*)(F.ws + WS_S5C) + (size_t)(o * 32 + g) * 16 * 128;
    const int l15 = F.lane & 15, kg = F.lane >> 4;
    const float ar = Ab[F.lane], ai = Ab[64 + F.lane];
    bf16x8 bB[8], cB[4]; const bf16x8 zero8 = (bf16x8){0, 0, 0, 0, 0, 0, 0, 0};
#pragma unroll
    for (int ct = 0; ct < 8; ++ct) bB[ct] = kg < 2 ? *(const bf16x8*)(Bb + (size_t)(16 * ct + l15) * 16 + 8 * kg) : zero8;
#pragma unroll
    for (int s = 0; s < 4; ++s) cB[s] = *(const bf16x8*)(Cm + (size_t)l15 * 128 + 32 * s + 8 * kg);
    bf16_t* Obase = (bf16_t*)(F.ws + WS_O) + (size_t)d * MROWS * 1024 + 512 + 16 * g;
    for (int pass = 0; pass < 2; ++pass) {
        bf16x8 an[4];
#pragma unroll
        for (int st = 0; st < 4; ++st) an[st] = kg < 2 ? *(const bf16x8*)(P + (size_t)tok_row(b, d, F.wave * 64 + 16 * st + l15) * NIN_O + 2048 + 16 * g + 8 * kg) : zero8;
        for (int n = F.wave; n < NCH; n += NWAVES) {
            float hr = 0.f, hi = 0.f;
            if (pass) { hr = El[n * 128 + F.lane]; hi = El[n * 128 + 64 + F.lane]; }
            bf16x8 ac[4];
#pragma unroll
            for (int st = 0; st < 4; ++st) ac[st] = an[st];
            { const int nn = n + NWAVES < NCH ? n + NWAVES : n;
#pragma unroll
              for (int st = 0; st < 4; ++st) an[st] = kg < 2 ? *(const bf16x8*)(P + (size_t)tok_row(b, d, nn * 64 + 16 * st + l15) * NIN_O + 2048 + 16 * g + 8 * kg) : zero8; }
            const int r0 = tok_row(b, d, n * 64); const int sg = d ? -1 : 1;
#pragma unroll
            for (int st = 0; st < 4; ++st) {
#pragma unroll
                for (int ct = 0; ct < 8; ++ct) { f32x4 acc = (f32x4){0.f, 0.f, 0.f, 0.f}; acc = mfma16(ac[st], bB[ct], acc);
                    *(LAS f32x4*)(scr + (ct >> 2) * 1280 + (16 * (ct & 3) + l15) * 20 + 4 * kg) = acc; }
                WAVE_LDS_SYNC();
                f32x4 br[4], bi[4];
#pragma unroll
                for (int q = 0; q < 4; ++q) { br[q] = *(const LAS f32x4*)(scr + F.lane * 20 + 4 * q); bi[q] = *(const LAS f32x4*)(scr + 1280 + F.lane * 20 + 4 * q); }
#pragma unroll
                for (int t = 0; t < 16; ++t) { const float nr = ar * hr - ai * hi + br[t >> 2][t & 3], ni = ar * hi + ai * hr + bi[t >> 2][t & 3]; hr = nr; hi = ni;
                    if (pass) *(LAS unsigned*)(hb + t * 128 + 2 * F.lane) = pk2(hr, hi); }
                WAVE_LDS_SYNC();
                if (pass) { f32x4 acc = (f32x4){0.f, 0.f, 0.f, 0.f};
#pragma unroll
                    for (int s = 0; s < 4; ++s) { const bf16x8 ha = *(const LAS bf16x8*)(hb + l15 * 128 + 32 * s + 8 * kg); acc = mfma16(ha, cB[s], acc); }
#pragma unroll
                    for (int r = 0; r < 4; ++r) Obase[(size_t)(r0 + sg * (16 * st + 4 * kg + r)) * 1024 + l15] = (bf16_t)f2bf(acc[r]);
                    WAVE_LDS_SYNC(); }
            }
            if (!pass) { El[n * 128 + F.lane] = hr; El[n * 128 + 64 + F.lane] = hi; }
        }
        __syncthreads();
        if (!pass) {
            if (F.wave == 0) { float pr = ar, pi = ai;
#pragma unroll
                for (int q = 0; q < 6; ++q) { const float nr = pr * pr - pi * pi, ni = 2.0f * pr * pi; pr = nr; pi = ni; }
                float hr = 0.f, hi = 0.f;
                for (int n = 0; n < NCH; ++n) { const float er = El[n * 128 + F.lane], ei = El[n * 128 + 64 + F.lane];
                    El[n * 128 + F.lane] = hr; El[n * 128 + 64 + F.lane] = hi;
                    const float nr = pr * hr - pi * hi + er, ni = pr * hi + pi * hr + ei; hr = nr; hi = ni; } }
            __syncthreads();
        }
    }
}

DEV void phase_seq(const Frame& F0, int l, int mode = 0) {
    const Frame F = refresh(F0);
    const int odd = l & 1; const int nlin = B_ * (odd ? 4 : 8) * 2 * 4; const int ns5 = odd ? B_ * 2 * 32 : 0;
    const int vcu = (F.G % 8 == 0) ? (F.bid % 8) * (F.G / 8) + F.bid / 8 : F.bid;
    if (!odd || F.G <= nlin) {
        for (int it = vcu; it < nlin + ns5; it += F.G) {
            if (it < nlin) { if (mode != 2) seq_linear_item(F, l, it, mode >= 10 ? mode - 10 : 0); } else if (mode != 1 && mode < 10) seq_s5_item(F, l, it - nlin);
            __syncthreads();
        }
    } else if (vcu < nlin) { if (mode != 2) seq_linear_item(F, l, vcu, mode >= 10 ? mode - 10 : 0); }
    else { for (int it = vcu - nlin; it < ns5; it += F.G - nlin) { if (mode != 1 && mode < 10) seq_s5_item(F, l, it); __syncthreads(); } }
}

DEV void phase_merge(const Frame& F0, int l) {
    const Frame F = refresh(F0);
    const int odd = l & 1, li = l >> 1; const bf16_t* P = (const bf16_t*)(F.ws + WS_P);
    const bf16_t* O0 = (const bf16_t*)(F.ws + WS_O); const bf16_t* O1 = O0 + (size_t)MROWS * 1024;
    bf16_t* MG = (bf16_t*)(F.ws + WS_MERGED);
    const int nrows = (l == DEPTH - 1) ? LATR : MROWS;
    ROW_LOOP(r, nrows) {
        if (!odd) {
            const int c0 = 16 * F.lane; float v[16];
#pragma unroll
            for (int q = 0; q < 4; ++q) { const u32x2 a = *(const u32x2*)(O0 + (size_t)r * 1024 + c0 + 4 * q), bq = *(const u32x2*)(O1 + (size_t)r * 1024 + c0 + 4 * q);
                v[4 * q] = bflo(a.x) + bflo(bq.x); v[4 * q + 1] = bfhi(a.x) + bfhi(bq.x); v[4 * q + 2] = bflo(a.y) + bflo(bq.y); v[4 * q + 3] = bfhi(a.y) + bfhi(bq.y); }
            float s = 0.f;
#pragma unroll
            for (int i = 0; i < 16; ++i) s += v[i];
            s = group_sum<8>(s);
            const bool ret = F.lane >= 32; const float mu = ret ? s * (1.0f / 128.0f) : 0.f; float q2 = 0.f;
#pragma unroll
            for (int i = 0; i < 16; ++i) { v[i] -= mu; q2 += v[i] * v[i]; }
            q2 = group_sum<8>(q2);
            const float rstd = 1.0f / sqrtf(q2 * (1.0f / 128.0f) + LN_EPS);
            const bf16_t* zp = P + (size_t)r * NIN_E + (ret ? 3584 + (c0 - 512) : 1536 + c0);
            const float* gp = ret ? GIN(I_EVRETN) + li * 512 + (c0 - 512) : GIN(I_EVGDNN) + li * 128 + (c0 & 127);
            unsigned ow[8];
#pragma unroll
            for (int i = 0; i < 16; i += 2) { const float z0 = bf2f(zp[i]), z1 = bf2f(zp[i + 1]); ow[i >> 1] = pk2(v[i] * rstd * gp[i] * silu_f(z0), v[i + 1] * rstd * gp[i + 1] * silu_f(z1)); }
            u32x4* op = (u32x4*)(MG + (size_t)r * 1024 + c0); op[0] = (u32x4){ow[0], ow[1], ow[2], ow[3]}; op[1] = (u32x4){ow[4], ow[5], ow[6], ow[7]};
        } else {
            const int c0 = 8 * F.lane; float v[8];
#pragma unroll
            for (int q = 0; q < 2; ++q) { const u32x2 a = *(const u32x2*)(O0 + (size_t)r * 1024 + c0 + 4 * q), bq = *(const u32x2*)(O1 + (size_t)r * 1024 + c0 + 4 * q);
                v[4 * q] = bflo(a.x) + bflo(bq.x); v[4 * q + 1] = bfhi(a.x) + bfhi(bq.x); v[4 * q + 2] = bflo(a.y) + bflo(bq.y); v[4 * q + 3] = bfhi(a.y) + bfhi(bq.y); }
            float s = 0.f;
#pragma unroll
            for (int i = 0; i < 8; ++i) s += v[i];
            s = group_sum<16>(s);
            const float mu = s * (1.0f / 128.0f); float q2 = 0.f;
#pragma unroll
            for (int i = 0; i < 8; ++i) { v[i] -= mu; q2 += v[i] * v[i]; }
            q2 = group_sum<16>(q2);
            const float rstd = 1.0f / sqrtf(q2 * (1.0f / 128.0f) + LN_EPS);
            const bf16_t* zp = P + (size_t)r * NIN_O + 1536 + c0; const float* gp = GIN(I_ODMN) + li * 512 + c0;
            unsigned ow[4];
#pragma unroll
            for (int i = 0; i < 8; i += 2) ow[i >> 1] = pk2(v[i] * rstd * gp[i] * sigmoid_f(bf2f(zp[i])), v[i + 1] * rstd * gp[i + 1] * sigmoid_f(bf2f(zp[i + 1])));
            *(u32x4*)(MG + (size_t)r * 1024 + c0) = (u32x4){ow[0], ow[1], ow[2], ow[3]};
            const bf16_t* up = P + (size_t)r * NIN_O + 2048 + c0; const float* dsk = GIN(I_ODDSKIP) + li * 512 + c0;
#pragma unroll
            for (int q = 0; q < 2; ++q) { const u32x2 a = *(const u32x2*)(O0 + (size_t)r * 1024 + 512 + c0 + 4 * q), bq = *(const u32x2*)(O1 + (size_t)r * 1024 + 512 + c0 + 4 * q);
                v[4 * q] = bflo(a.x) + bflo(bq.x); v[4 * q + 1] = bfhi(a.x) + bfhi(bq.x); v[4 * q + 2] = bflo(a.y) + bflo(bq.y); v[4 * q + 3] = bfhi(a.y) + bfhi(bq.y); }
#pragma unroll
            for (int i = 0; i < 8; i += 2) ow[i >> 1] = pk2(gelu_tanh_f(v[i] + dsk[i] * bf2f(up[i])), gelu_tanh_f(v[i + 1] + dsk[i + 1] * bf2f(up[i + 1])));
            *(u32x4*)((bf16_t*)(F.ws + WS_YS) + (size_t)r * 512 + c0) = (u32x4){ow[0], ow[1], ow[2], ow[3]};
        }
    }
}

DEV void ln_rows(const Frame& F, f32x4 (&t)[RG][4], const float* lg, const float* lb) {
    float mean[RG], rstd[RG];
#pragma unroll
    for (int q = 0; q < RG; ++q) { float sum = 0.f;
#pragma unroll
        for (int j = 0; j < 4; ++j) sum += (t[q][j].x + t[q][j].y) + (t[q][j].z + t[q][j].w);
        mean[q] = wave_sum(sum) * (1.0f / 1024.0f); }
#pragma unroll
    for (int q = 0; q < RG; ++q) { float s2 = 0.f;
#pragma unroll
        for (int j = 0; j < 4; ++j) { t[q][j] = t[q][j] - mean[q]; s2 += (t[q][j].x * t[q][j].x + t[q][j].y * t[q][j].y) + (t[q][j].z * t[q][j].z + t[q][j].w * t[q][j].w); }
        rstd[q] = 1.0f / sqrtf(wave_sum(s2) * (1.0f / 1024.0f) + LN_EPS); }
#pragma unroll
    for (int j = 0; j < 4; ++j) { const f32x4 gg = *((const f32x4*)lg + F.lane + 64 * j), bb = *((const f32x4*)lb + F.lane + 64 * j);
#pragma unroll
        for (int q = 0; q < RG; ++q) t[q][j] = t[q][j] * rstd[q] * gg + bb; }
}
DEV void phase_ln1(const Frame& F0, int l) {
    const Frame F = refresh(F0);
    const float* Y = (const float*)(F.ws + WS_Y); float* H = (float*)(F.ws + WS_H);
    const float* lg = GIN(I_LN1G) + l * 1024; const float* lb = GIN(I_LN1B) + l * 1024; const float* wr = (const float*)(F.ws + WS_WR) + (size_t)l * NE * 1024;
    const int nrows = (l == DEPTH - 1) ? LATR : MROWS;
    for (int r = RG * F.gw; r < nrows; r += RG * F.NGW) {
        int b, s; row_bs(r, b, s); const int mr = s < CTX ? B_ : b; const float* mod = (const float*)(F.ws + WS_MOD) + ((size_t)l * NR + mr) * 6144;
        f32x4 t[RG][4];
#pragma unroll
        for (int j = 0; j < 4; ++j) { const f32x4 g1 = *((const f32x4*)(mod + 2048) + F.lane + 64 * j);
#pragma unroll
            for (int q = 0; q < RG; ++q) { const f32x4 hv = *((const f32x4*)(H + (size_t)(r + q) * 1024) + F.lane + 64 * j), yv = *((const f32x4*)(Y + (size_t)(r + q) * 1024) + F.lane + 64 * j); t[q][j] = ALPHA * hv + g1 * yv; }
            if (j & 1) COMPILER_FENCE(); }
        ln_rows(F, t, lg, lb);
        COMPILER_FENCE();
#pragma unroll
        for (int j = 0; j < 4; ++j) { const f32x4 sh = *((const f32x4*)(mod + 3072) + F.lane + 64 * j), scv = *((const f32x4*)(mod + 4096) + F.lane + 64 * j);
#pragma unroll
            for (int q = 0; q < RG; ++q) { *((f32x4*)(H + (size_t)(r + q) * 1024) + F.lane + 64 * j) = t[q][j]; t[q][j] = t[q][j] * (1.0f + scv) + sh; } }
        COMPILER_FENCE();
#pragma unroll
        for (int q = 0; q < RG; ++q) { u32x2* xo = (u32x2*)((bf16_t*)(F.ws + WS_XIN) + (size_t)(r + q) * 1024) + F.lane;
#pragma unroll
            for (int j = 0; j < 4; ++j) xo[64 * j] = (u32x2){pk2(t[q][j].x, t[q][j].y), pk2(t[q][j].z, t[q][j].w)}; }
        float mine[RG]; const int ei = F.lane % NE;
#pragma unroll
        for (int q = 0; q < RG; ++q) mine[q] = 0.f;
        f32x4 wc[4];
#pragma unroll
        for (int j = 0; j < 4; ++j) wc[j] = *((const f32x4*)wr + F.lane + 64 * j);
#pragma unroll 1
        for (int e = 0; e < NE; ++e) { f32x4 wn[4]; const int en = e + 1 < NE ? e + 1 : e;
#pragma unroll
            for (int j = 0; j < 4; ++j) wn[j] = *((const f32x4*)(wr + en * 1024) + F.lane + 64 * j);
#pragma unroll
            for (int q = 0; q < RG; ++q) { float p = 0.f;
#pragma unroll
                for (int j = 0; j < 4; ++j) p += t[q][j].x * wc[j].x + t[q][j].y * wc[j].y + t[q][j].z * wc[j].z + t[q][j].w * wc[j].w;
                const float ws_ = wave_sum(p); mine[q] = (ei == e) ? ws_ : mine[q]; }
#pragma unroll
            for (int j = 0; j < 4; ++j) wc[j] = wn[j]; }
#pragma unroll
        for (int q = 0; q < RG; ++q) { const float mx = group_max<NE>(mine[q]); const float ex = expf(mine[q] - mx); const float se = group_sum<NE>(ex);
            if (F.lane < NE) ((float*)(F.ws + WS_AFF))[(size_t)(r + q) * 16 + F.lane] = ex / se; }
    }
}

DEV void phase_topk(const Frame& F0, int l) {
    const Frame F = refresh(F0);
    const int nitems = (l == DEPTH - 1) ? B_ * NE : 2 * B_ * NE;
    LAS unsigned* hist = (LAS unsigned*)(F.lds);
    LAS unsigned* selw = (LAS unsigned*)(F.lds + 1024);
    LAS unsigned* cnt = (LAS unsigned*)(F.lds + 2048);
    LAS int* selrow = (LAS int*)(F.lds + 8192);
    const float* AFF = (const float*)(F.ws + WS_AFF); int* SLOT = (int*)(F.ws + WS_SLOT); float* EG = (float*)(F.ws + WS_EGATE);
    for (int it = F.bid; it < nitems; it += F.G) {
        const int e = it % NE, set = it / NE, kind = set / B_, b = set % B_;
        const int n = kind ? CTX : SEQ, cap = kind ? CAPC : CAPL; const int row0 = kind ? LATR + b * CTX : b * SEQ;
        const int sbase = kind ? B_ * CAPL + b * CAPC : b * CAPL;
        const int per = n >= NTHREADS ? n / NTHREADS : 1; const bool act = F.tid * per < n;
        unsigned key[8];
#pragma unroll
        for (int k = 0; k < 8; ++k) key[k] = (act && k < per) ? __builtin_bit_cast(unsigned, AFF[(size_t)(row0 + F.tid * per + k) * 16 + e]) : 0u;
        unsigned prefix = 0u, remaining = (unsigned)cap;
        for (int pass = 0; pass < 4; ++pass) {
            const int shift = 24 - 8 * pass; const unsigned mask = pass == 0 ? 0u : (0xFFFFFFFFu << (shift + 8));
            if (F.tid < 256) hist[F.tid] = 0u;
            __syncthreads();
#pragma unroll
            for (int k = 0; k < 8; ++k) if (act && k < per && ((key[k] & mask) == (prefix & mask))) lds_atomic_add(&hist[(key[k] >> shift) & 255u], 1u);
            __syncthreads();
            if (F.wave == 0) {
                const unsigned h0 = hist[4 * F.lane], h1 = hist[4 * F.lane + 1], h2 = hist[4 * F.lane + 2], h3 = hist[4 * F.lane + 3];
                unsigned suf = h0 + h1 + h2 + h3;
#pragma unroll
                for (int o = 1; o < 64; o <<= 1) { const unsigned tv = shfl_t(suf, F.lane + o); if (F.lane + o < 64) suf += tv; }
                unsigned cum = suf - (h0 + h1 + h2 + h3);
                int dsel = -1; unsigned above = 0u;
                if (cum < remaining) {
                    if (cum + h3 >= remaining) { dsel = 4 * F.lane + 3; above = cum; }
                    else if (cum + h3 + h2 >= remaining) { dsel = 4 * F.lane + 2; above = cum + h3; }
                    else if (cum + h3 + h2 + h1 >= remaining) { dsel = 4 * F.lane + 1; above = cum + h3 + h2; }
                    else if (cum + h3 + h2 + h1 + h0 >= remaining) { dsel = 4 * F.lane; above = cum + h3 + h2 + h1; }
                }
                if (dsel >= 0) { selw[0] = prefix | ((unsigned)dsel << shift); selw[1] = remaining - above; }
            }
            __syncthreads();
            prefix = selw[0]; remaining = selw[1];
            __syncthreads();
        }
        const unsigned T = prefix, need_eq = remaining;
        unsigned ngt = 0u, neq = 0u;
#pragma unroll
        for (int k = 0; k < 8; ++k) if (act && k < per) { ngt += key[k] > T ? 1u : 0u; neq += key[k] == T ? 1u : 0u; }
        unsigned pk = (ngt << 16) | neq;
#pragma unroll
        for (int o = 1; o < 64; o <<= 1) { const unsigned tv = shfl_t(pk, F.lane - o); if (F.lane >= o) pk += tv; }
        if (F.lane == 63) cnt[F.wave] = pk;
        __syncthreads();
        unsigned base = 0u;
#pragma unroll
        for (int w8 = 0; w8 < NWAVES; ++w8) base += (w8 < F.wave) ? cnt[w8] : 0u;
        const unsigned excl = base + pk - ((ngt << 16) | neq);
        unsigned gtb = excl >> 16, eqb = excl & 0xffffu;
#pragma unroll
        for (int k = 0; k < 8; ++k) if (act && k < per) {
            const int row = row0 + F.tid * per + k; int slot = -1;
            const bool isgt = key[k] > T, iseq = key[k] == T;
            if (isgt || (iseq && eqb < need_eq)) { slot = (int)(gtb + (eqb < need_eq ? eqb : need_eq)); selrow[slot] = row; EG[(size_t)e * EPAD + sbase + slot] = __builtin_bit_cast(float, key[k]); }
            SLOT[(size_t)row * 16 + e] = slot >= 0 ? sbase + slot : -1;
            gtb += isgt ? 1u : 0u; eqb += iseq ? 1u : 0u;
        }
        __syncthreads();
        for (int sl = F.tid; sl < cap; sl += NTHREADS) ((int*)(F.ws + WS_EIDX))[(size_t)e * EPAD + sbase + sl] = selrow[sl];
        if (it < NE) for (int pr = EROWS + F.tid; pr < EPAD; pr += NTHREADS) EG[(size_t)e * EPAD + pr] = 0.f;
        __syncthreads();
    }
}

DEV void phase_gather(const Frame& F0, int l) {
    const Frame F = refresh(F0);
    const int erows = (l == DEPTH - 1) ? B_ * CAPL : EROWS;
    const int* EI = (const int*)(F.ws + WS_EIDX);
    for (int r0 = 4 * F.gw; r0 < NE * EPAD; r0 += 4 * F.NGW) {
        u32x4 v[4][2];
#pragma unroll
        for (int q = 0; q < 4; ++q) { const int r = r0 + q, sl = r % EPAD; v[q][0] = (u32x4){0u, 0u, 0u, 0u}; v[q][1] = v[q][0];
            if (sl < erows) { const u32x4* src = (const u32x4*)((const bf16_t*)(F.ws + WS_XIN) + (size_t)EI[r] * 1024) + F.lane; v[q][0] = src[0]; v[q][1] = src[64]; } }
#pragma unroll
        for (int q = 0; q < 4; ++q) { u32x4* dst = (u32x4*)((bf16_t*)(F.ws + WS_XS) + (size_t)(r0 + q) * 1024) + F.lane; dst[0] = v[q][0]; dst[64] = v[q][1]; }
    }
}

DEV void phase_ln2(const Frame& F0, int l) {
    const Frame F = refresh(F0);
    float* H = (float*)(F.ws + WS_H); const int* SLOT = (const int*)(F.ws + WS_SLOT); const bf16_t* YSE = (const bf16_t*)(F.ws + WS_YSE);
    const float* lg = GIN(I_LN2G) + l * 1024; const float* lb = GIN(I_LN2B) + l * 1024;
    const int nrows = (l == DEPTH - 1) ? LATR : MROWS;
    for (int r = RG * F.gw; r < nrows; r += RG * F.NGW) {
        int b, s; row_bs(r, b, s); const int mr = s < CTX ? B_ : b; const float* mod = (const float*)(F.ws + WS_MOD) + ((size_t)l * NR + mr) * 6144;
        f32x4 t[RG][4];
#pragma unroll
        for (int q = 0; q < RG; ++q) {
#pragma unroll
            for (int j = 0; j < 4; ++j) t[q][j] = (f32x4){0.f, 0.f, 0.f, 0.f}; }
        const int myslot = F.lane < RG * 16 ? SLOT[(size_t)r * 16 + F.lane] : -1;
#pragma unroll
        for (int q = 0; q < RG; ++q)
#pragma unroll
            for (int e = 0; e < NE; ++e) { const int sl = bcast_lane(myslot, 16 * q + e);
                if (sl >= 0) { const u32x2* yp = (const u32x2*)(YSE + ((size_t)e * EPAD + sl) * 1024) + F.lane;
#pragma unroll
                    for (int j = 0; j < 4; ++j) { const u32x2 w = yp[64 * j]; t[q][j] += (f32x4){bflo(w.x), bfhi(w.x), bflo(w.y), bfhi(w.y)}; } } }
#pragma unroll
        for (int j = 0; j < 4; ++j) { const f32x4 g2 = *((const f32x4*)(mod + 5120) + F.lane + 64 * j);
#pragma unroll
            for (int q = 0; q < RG; ++q) { const f32x4 hv = *((const f32x4*)(H + (size_t)(r + q) * 1024) + F.lane + 64 * j); t[q][j] = ALPHA * hv + g2 * t[q][j]; } }
        ln_rows(F, t, lg, lb);
        if (l == DEPTH - 1) {
            {
#pragma unroll
                for (int q = 0; q < RG; ++q) { GAS f32x4* op = (GAS f32x4*)(F.out + (size_t)(r + q) * 1024) + F.lane;
#pragma unroll
                    for (int j = 0; j < 4; ++j) op[64 * j] = t[q][j]; } }
        } else {
#pragma unroll
            for (int q = 0; q < RG; ++q)
#pragma unroll
                for (int j = 0; j < 4; ++j) *((f32x4*)(H + (size_t)(r + q) * 1024) + F.lane + 64 * j) = t[q][j];
            xg_rows(F, l + 1, r, t);
        }
    }
}

struct EpiP {
    static constexpr bool PERM = true;
    bf16_t* O; int ldc;
    DEV void operator()(const f32x4 (&acc)[2][2][4][2], const pg8::Unit& u, int wr, int wc, int fr, int fq) const {
        const int row0 = u.pm * 256 + wr * 64 + fr, col0 = u.pn * 256 + wc * 32 + 8 * fq;
#pragma unroll
        for (int ai = 0; ai < 2; ++ai)
#pragma unroll
            for (int m = 0; m < 4; ++m) { bf16_t* rowp = O + (size_t)(row0 + ai * 128 + m * 16) * ldc + col0;
#pragma unroll
                for (int bj = 0; bj < 2; ++bj) { const f32x4 v0 = acc[ai][bj][m][0], v1 = acc[ai][bj][m][1];
                    u32x4 w; w.x = pg8::cvt_pk_bf16(v0[0], v0[1]); w.y = pg8::cvt_pk_bf16(v0[2], v0[3]); w.z = pg8::cvt_pk_bf16(v1[0], v1[1]); w.w = pg8::cvt_pk_bf16(v1[2], v1[3]);
                    *(u32x4*)(rowp + bj * 128) = w; } }
    }
};
struct EpiGlu {
    static constexpr bool PERM = true;
    bf16_t* MG; const bf16_t* YS; const float* bias;
    DEV void operator()(const f32x4 (&acc)[2][2][4][2], const pg8::Unit& u, int wr, int wc, int fr, int fq) const {
        const int row0 = u.pm * 256 + wr * 64 + fr, col0 = u.pn * 256 + wc * 32 + 8 * fq;
#pragma unroll
        for (int ai = 0; ai < 2; ++ai)
#pragma unroll
            for (int m = 0; m < 4; ++m) { const int row = row0 + ai * 128 + m * 16;
#pragma unroll
                for (int bj = 0; bj < 2; ++bj) { const int c = col0 + bj * 128; const f32x4 v0 = acc[ai][bj][m][0], v1 = acc[ai][bj][m][1];
                    const u32x4 yv = *(const u32x4*)(YS + (size_t)row * 512 + c); const f32x4 b0 = *(const f32x4*)(bias + c), b1 = *(const f32x4*)(bias + c + 4);
                    u32x4 w; w.x = pk2(bflo(yv.x) * fast_sigmoid(v0[0] + b0[0]), bfhi(yv.x) * fast_sigmoid(v0[1] + b0[1])); w.y = pk2(bflo(yv.y) * fast_sigmoid(v0[2] + b0[2]), bfhi(yv.y) * fast_sigmoid(v0[3] + b0[3]));
                    w.z = pk2(bflo(yv.z) * fast_sigmoid(v1[0] + b1[0]), bfhi(yv.z) * fast_sigmoid(v1[1] + b1[1])); w.w = pk2(bflo(yv.w) * fast_sigmoid(v1[2] + b1[2]), bfhi(yv.w) * fast_sigmoid(v1[3] + b1[3]));
                    *(u32x4*)(MG + (size_t)row * 1024 + 512 + c) = w; } }
    }
};
struct EpiF32 {
    static constexpr bool PERM = false;
    float* C; int ldc; const float* rowscale;
    DEV void operator()(const f32x4 (&acc)[2][2][4][2], const pg8::Unit& u, int wr, int wc, int fr, int fq) const {
        const int row0 = u.pm * 256 + wr * 64 + fr, col0 = u.pn * 256 + wc * 32 + 4 * fq;
        const size_t ebase = rowscale ? (size_t)u.e * EPAD : 0;
#pragma unroll
        for (int ai = 0; ai < 2; ++ai)
#pragma unroll
            for (int m = 0; m < 4; ++m) { const size_t row = ebase + row0 + ai * 128 + m * 16; const float sc = rowscale ? rowscale[row] : 1.0f; float* rowp = C + row * ldc + col0;
#pragma unroll
                for (int bj = 0; bj < 2; ++bj)
#pragma unroll
                    for (int n = 0; n < 2; ++n) *(f32x4*)(rowp + bj * 128 + n * 16) = acc[ai][bj][m][n] * sc; }
    }
};
struct EpiYse {
    static constexpr bool PERM = true;
    bf16_t* O; const float* rowscale;
    DEV void operator()(const f32x4 (&acc)[2][2][4][2], const pg8::Unit& u, int wr, int wc, int fr, int fq) const {
        const int row0 = u.pm * 256 + wr * 64 + fr, col0 = u.pn * 256 + wc * 32 + 8 * fq; const size_t ebase = (size_t)u.e * EPAD;
#pragma unroll
        for (int ai = 0; ai < 2; ++ai)
#pragma unroll
            for (int m = 0; m < 4; ++m) { const size_t row = ebase + row0 + ai * 128 + m * 16; const float sc = rowscale[row]; bf16_t* rowp = O + row * 1024 + col0;
#pragma unroll
                for (int bj = 0; bj < 2; ++bj) { const f32x4 v0 = acc[ai][bj][m][0] * sc, v1 = acc[ai][bj][m][1] * sc;
                    u32x4 w; w.x = pg8::cvt_pk_bf16(v0[0], v0[1]); w.y = pg8::cvt_pk_bf16(v0[2], v0[3]); w.z = pg8::cvt_pk_bf16(v1[0], v1[1]); w.w = pg8::cvt_pk_bf16(v1[2], v1[3]);
                    *(u32x4*)(rowp + bj * 128) = w; } }
    }
};
struct EpiSwiglu {
    static constexpr bool PERM = true;
    bf16_t* HID;
    DEV void operator()(const f32x4 (&acc)[2][2][4][2], const pg8::Unit& u, int wr, int wc, int fr, int fq) const {
        const int row0 = u.pm * 256 + wr * 64 + fr, col0 = u.pn * 128 + wc * 32 + 8 * fq;
#pragma unroll
        for (int ai = 0; ai < 2; ++ai)
#pragma unroll
            for (int m = 0; m < 4; ++m) { bf16_t* rowp = HID + ((size_t)u.e * EPAD + row0 + ai * 128 + m * 16) * FF + col0;
                const f32x4 g0 = acc[ai][0][m][0], g1 = acc[ai][0][m][1], u0 = acc[ai][1][m][0], u1 = acc[ai][1][m][1];
                u32x4 w; w.x = pk2(fast_silu(g0[0]) * u0[0], fast_silu(g0[1]) * u0[1]); w.y = pk2(fast_silu(g0[2]) * u0[2], fast_silu(g0[3]) * u0[3]);
                w.z = pk2(fast_silu(g1[0]) * u1[0], fast_silu(g1[1]) * u1[1]); w.w = pk2(fast_silu(g1[2]) * u1[2], fast_silu(g1[3]) * u1[3]);
                *(u32x4*)rowp = w; }
    }
};

DEV void gemm_g1(const Frame& F0, int l, int vcu) {
    const Frame F = refresh(F0);
    const int nin = (l & 1) ? NIN_O : NIN_E;
    pg8::PlainOrder S; S.init((const void*)(F.ws + WS_XIN), (const bf16_t*)(F.ws + WS_WIN) + (size_t)l * NINMAX * 1024, 1024, MPAD, nin, F.G, vcu);
    EpiP E; E.O = (bf16_t*)(F.ws + WS_P); E.ldc = nin;
    pg8::gemm_phase(F.lds, 1024, S, E, F.wave, F.lane);
}
DEV void gemm_glu(const Frame& F0, int l, int vcu) {
    const Frame F = refresh(F0);
    const int li = l >> 1;
    pg8::PlainOrder S; S.init((const void*)(F.ws + WS_YS), (const bf16_t*)(F.ws + WS_WGLU) + (size_t)li * 512 * 512, 512, (l == DEPTH - 1) ? LATPAD : MPAD, 512, F.G, vcu);
    EpiGlu E; E.MG = (bf16_t*)(F.ws + WS_MERGED); E.YS = (const bf16_t*)(F.ws + WS_YS); E.bias = GIN(I_ODBGLU) + li * 512;
    pg8::gemm_phase(F.lds, 512, S, E, F.wave, F.lane);
}
DEV void gemm_g3(const Frame& F0, int l, int vcu) {
    const Frame F = refresh(F0);
    pg8::PlainOrder S; S.init((const void*)(F.ws + WS_MERGED), (const bf16_t*)(F.ws + WS_WOUT) + (size_t)l * 1024 * 1024, 1024, (l == DEPTH - 1) ? LATPAD : MPAD, 1024, F.G, vcu);
    EpiF32 E; E.C = (float*)(F.ws + WS_Y); E.ldc = 1024; E.rowscale = nullptr;
    pg8::gemm_phase(F.lds, 1024, S, E, F.wave, F.lane);
}
DEV void gemm_g4(const Frame& F0, int l, int vcu) {
    const Frame F = refresh(F0);
    pg8::GroupedOrder S; S.init((const void*)(F.ws + WS_XS), (const bf16_t*)(F.ws + WS_WGU) + (size_t)l * NE * 2 * FF * 1024, 1024, 2 * FF, F.G, vcu, (l == DEPTH - 1) ? B_ * CAPL : EROWS);
    EpiSwiglu E; E.HID = (bf16_t*)(F.ws + WS_HID);
    pg8::gemm_phase(F.lds, 1024, S, E, F.wave, F.lane);
}
DEV void gemm_g5(const Frame& F0, int l, int vcu) {
    const Frame F = refresh(F0);
    pg8::GroupedOrder S; S.init((const void*)(F.ws + WS_HID), (const bf16_t*)(F.ws + WS_WD) + (size_t)l * NE * 1024 * FF, FF, 1024, F.G, vcu, (l == DEPTH - 1) ? B_ * CAPL : EROWS);
    EpiYse E; E.O = (bf16_t*)(F.ws + WS_YSE); E.rowscale = (const float*)(F.ws + WS_EGATE);
    pg8::gemm_phase(F.lds, FF, S, E, F.wave, F.lane);
}

__global__ void __launch_bounds__(NTHREADS, 2) mega_fwd(Args args) {
#ifdef EMU
    LAS unsigned char* lds = emu::lds();
#else
    extern __shared__ __attribute__((aligned(16))) unsigned char lds_raw[];
    LAS unsigned char* lds = (LAS unsigned char*)lds_raw;
#endif
    Frame F;
    F.in = args.in; F.out = (GAS float*)args.out; F.ws = (GAS unsigned char*)args.ws; F.lds = lds;
    F.tid = threadIdx.x; F.lane = F.tid & 63; F.wave = readfirstlane_i(F.tid >> 6); F.G = gridDim.x; F.bid = blockIdx.x;
    F.gw = F.bid * NWAVES + F.wave; F.NGW = F.G * NWAVES;
    for (int u = F.tid; u < (LDS_BYTES - LDS_MISC) / 4; u += NTHREADS) ((LAS unsigned*)(lds + LDS_MISC))[u] = 0u;
    __syncthreads();
    XcdBarrier bar = xcd_barrier_post((unsigned*)(F.ws + WS_CTL), (volatile LAS unsigned*)(lds + LDS_MISC), F.wave);
#define GRID_BAR() xcd_barrier(bar)
    const int vcu = (F.G % 8 == 0) ? (F.bid % 8) * (F.G / 8) + F.bid / 8 : F.bid;

#ifndef PHASE_MASK
#define PHASE_MASK 0xFFFFF
#endif
#ifndef REPEAT_MASK
#define REPEAT_MASK 0x0
#endif
#ifndef TIMING_PROBE
#define TIMING_PROBE -1
#endif
    unsigned long long pt_acc = 0ull, pt_t0 = 0ull;
#define PT(k) do { if (TIMING_PROBE == (k)) pt_t0 = rt_now(); } while (0)
#define PTE(k) do { if (TIMING_PROBE == (k)) pt_acc += rt_now() - pt_t0; } while (0)
#define PH(k) if ((PHASE_MASK >> (k)) & 1)
#define RP(k) if ((REPEAT_MASK >> (k)) & 1)
    PT(0); PH(0) phase_prologue_a(F);
    RP(0) { GRID_BAR(); phase_prologue_a(F); }
    GRID_BAR(); PTE(0);
    PT(1); PH(1) phase_xg0(F);
    GRID_BAR(); PTE(1);
    for (int l = 0; l < DEPTH; ++l) {
        const int odd = l & 1;
        PT(2); PH(2) gemm_g1(F, l, vcu);
        RP(2) { GRID_BAR(); gemm_g1(F, l, vcu); }
        GRID_BAR(); PTE(2);
        PT(3); PH(3) phase_prep(F, l);
        RP(3) { GRID_BAR(); phase_prep(F, l); }
        GRID_BAR(); PTE(3);
        PT(4); PH(4) phase_cl(F, l);
        RP(4) { GRID_BAR(); phase_cl(F, l); }
        GRID_BAR(); PTE(4);
        PT(5); PH(5) phase_seq(F, l);
        RP(5) { GRID_BAR(); phase_seq(F, l); }
        GRID_BAR(); PTE(5);
#ifdef SEQ_XPROBE
        if ((l & 1) == SEQ_XPARITY) { PT(20); phase_seq(F, l, 10 + SEQ_XPROBE); GRID_BAR(); PTE(20); }
#endif
        PT(6); PH(6) phase_merge(F, l);
        RP(6) { GRID_BAR(); phase_merge(F, l); }
        GRID_BAR(); PTE(6);
        if (odd) { PT(7); PH(7) gemm_glu(F, l, vcu); RP(7) { GRID_BAR(); gemm_glu(F, l, vcu); } GRID_BAR(); PTE(7); }
        PT(8); PH(8) gemm_g3(F, l, vcu);
        RP(8) { GRID_BAR(); gemm_g3(F, l, vcu); }
        GRID_BAR(); PTE(8);
        PT(9); PH(9) phase_ln1(F, l);
        GRID_BAR(); PTE(9);
        PT(10); PH(10) phase_topk(F, l);
        RP(10) { GRID_BAR(); phase_topk(F, l); }
        GRID_BAR(); PTE(10);
        PT(14); PH(10) phase_gather(F, l);
        GRID_BAR(); PTE(14);
        PT(11); PH(11) gemm_g4(F, l, vcu);
        RP(11) { GRID_BAR(); gemm_g4(F, l, vcu); }
        GRID_BAR(); PTE(11);
        PT(12); PH(12) gemm_g5(F, l, vcu);
        RP(12) { GRID_BAR(); gemm_g5(F, l, vcu); }
        GRID_BAR(); PTE(12);
        PT(13); PH(13) phase_ln2(F, l);
        GRID_BAR(); PTE(13);
    }
    if (TIMING_PROBE >= 0 && F.bid == 0) { const unsigned long long t1 = rt_now() + pt_acc; while (rt_now() < t1) s_sleep1(); }
}

#ifndef EMU
extern "C" void kernel_launch(void* const* d_in, const int* in_sizes, int n_in, void* d_out, int out_size, void* d_ws, size_t ws_size, hipStream_t stream) {
    static int grid = 0;
    if (grid == 0) {
        if (n_in != N_IN || ws_size < WS_END) { fprintf(stderr, "kernel_launch: need %d inputs and %zu bytes of workspace; got %d, %zu\n", (int)N_IN, (size_t)WS_END, n_in, ws_size); grid = -1; return; }
        int dev = 0, cus = 0, per_cu = 0;
        if (hipGetDevice(&dev) != hipSuccess || hipDeviceGetAttribute(&cus, hipDeviceAttributeMultiprocessorCount, dev) != hipSuccess) { grid = -1; return; }
        if (hipFuncSetAttribute((const void*)mega_fwd, hipFuncAttributeMaxDynamicSharedMemorySize, LDS_BYTES) != hipSuccess) { fprintf(stderr, "kernel_launch: hipFuncSetAttribute failed\n"); grid = -1; return; }
        if (hipOccupancyMaxActiveBlocksPerMultiprocessor(&per_cu, (const void*)mega_fwd, NTHREADS, LDS_BYTES) != hipSuccess || per_cu < 1) { fprintf(stderr, "kernel_launch: occupancy query says %d\n", per_cu); }
        (void)hipGetLastError();
        grid = cus;
    }
    if (grid < 0) return;
    (void)hipMemsetAsync((char*)d_ws + WS_CTL, 0, CTL_BYTES, stream);
    Args a{};
    for (int i = 0; i < N_IN; ++i) a.in[i] = (const float*)d_in[i];
    a.out = (float*)d_out; a.ws = (unsigned char*)d_ws;
    hipLaunchKernelGGL(mega_fwd, dim3(grid), dim3(NTHREADS), LDS_BYTES, stream, a);
}
#endif
```

```cpp
#ifdef EMU
#include "emu.h"
#else
#include <hip/hip_runtime.h>
#endif
#include <cstdio>
#include <cstdint>
#include <cstddef>

#ifndef CFG_BATCH
#define CFG_BATCH 4
#define CFG_SEQ 4096
#define CFG_CTX 256
#define CFG_DEPTH 4
#define CFG_NEXP 16
#define CFG_FF 2048
#endif
constexpr int B_ = CFG_BATCH, SEQ = CFG_SEQ, CTX = CFG_CTX, DEPTH = CFG_DEPTH, NE = CFG_NEXP, FF = CFG_FF;
constexpr int D = 1024, TOK = CTX + SEQ, MROWS = B_ * TOK, MPAD = (MROWS + 255) / 256 * 256;
constexpr int NCH = TOK / 64;
constexpr int LATR = B_ * SEQ;
constexpr int LATPAD = (LATR + 255) / 256 * 256;
constexpr int CAPL = 2 * SEQ / NE, CAPC = 2 * CTX / NE, EROWS = B_ * (CAPL + CAPC), EPAD = (EROWS + 255) / 256 * 256;
constexpr int NIN_E = 4096, NIN_O = 2560, NINMAX = 4096;
constexpr int N_EVEN = (DEPTH + 1) / 2, N_ODD = DEPTH / 2, N_ODDA = N_ODD > 0 ? N_ODD : 1;
constexpr int NR = B_ + 1;
constexpr float ALPHA = 1.681792830507429f;
constexpr float LN_EPS = 1e-5f;
constexpr float HD_SCALE = 0.08838834764831845f;
constexpr int NWAVES = 8, NTHREADS = 512;

enum { I_X = 0, I_C, I_CTX, I_CCTX, I_WMOD, I_BMOD, I_LN1G, I_LN1B, I_LN2G, I_LN2B, I_WROUTER, I_WGATE, I_WUP, I_WDOWN,
       I_EVWIN, I_EVWOUT, I_EVCONV, I_EVALOG, I_EVDTB, I_EVGDNN, I_EVRETN,
       I_ODWIN, I_ODWOUT, I_ODCONV, I_ODGB, I_ODMN, I_ODLRE, I_ODLIM, I_ODLDT, I_ODBRE, I_ODBIM, I_ODCRE, I_ODCIM, I_ODDSKIP, I_ODWGLU, I_ODBGLU, N_IN };

constexpr size_t al256(size_t x) { return (x + 255) & ~(size_t)255; }
constexpr size_t WS_CTL = 0, CTL_BYTES = 65536;
constexpr size_t WS_MOD = WS_CTL + CTL_BYTES;
constexpr size_t WS_WG = al256(WS_MOD + (size_t)DEPTH * NR * 6144 * 4);
constexpr size_t WS_WIN = al256(WS_WG + (size_t)DEPTH * 16 * 1024 * 4);
constexpr size_t WS_WOUT = al256(WS_WIN + (size_t)DEPTH * NINMAX * 1024 * 2);
constexpr size_t WS_WGLU = al256(WS_WOUT + (size_t)DEPTH * 1024 * 1024 * 2);
constexpr size_t WS_WGU = al256(WS_WGLU + (size_t)N_ODDA * 512 * 512 * 2);
constexpr size_t WS_WD = al256(WS_WGU + (size_t)DEPTH * NE * 2 * FF * 1024 * 2);
constexpr size_t WS_S5A = al256(WS_WD + (size_t)DEPTH * NE * 1024 * FF * 2);
constexpr size_t WS_S5B = al256(WS_S5A + (size_t)N_ODDA * 2 * 32 * 128 * 4);
constexpr size_t WS_S5C = al256(WS_S5B + (size_t)N_ODDA * 2 * 32 * 128 * 16 * 2);
constexpr size_t WS_H = al256(WS_S5C + (size_t)N_ODDA * 32 * 16 * 128 * 2);
constexpr size_t WS_XIN = al256(WS_H + (size_t)MPAD * 1024 * 4);
constexpr size_t WS_GATES = al256(WS_XIN + (size_t)MPAD * 1024 * 2);
constexpr size_t WS_MERGED = al256(WS_GATES + (size_t)MROWS * 16 * 4);
constexpr size_t WS_YS = al256(WS_MERGED + (size_t)MPAD * 1024 * 2);
constexpr size_t WS_Y = al256(WS_YS + (size_t)MPAD * 512 * 2);
constexpr size_t WS_AFF = al256(WS_Y + (size_t)MPAD * 1024 * 4);
constexpr size_t WS_SLOT = al256(WS_AFF + (size_t)MROWS * 16 * 4);
constexpr size_t WS_EGATE = al256(WS_SLOT + (size_t)MROWS * 16 * 4);
constexpr size_t WS_MCH = al256(WS_EGATE + (size_t)NE * EPAD * 4);
constexpr size_t WS_WR = al256(WS_MCH + (size_t)B_ * 4 * 2 * NCH * 4);
constexpr size_t WS_EIDX = al256(WS_WR + (size_t)DEPTH * NE * 1024 * 4);
constexpr size_t WS_R = al256(WS_EIDX + (size_t)NE * EPAD * 4);
constexpr int NCP = B_ * 8 * 2 * NCH, NCPG = B_ * 4 * 2 * NCH;
constexpr size_t WS_P = WS_R;
constexpr size_t WS_QKV = al256(WS_P + (size_t)MPAD * NINMAX * 2);
constexpr size_t WS_CLW = al256(WS_QKV + (size_t)MROWS * 1536 * 2);
constexpr size_t WS_CLQ = al256(WS_CLW + (size_t)NCP * 64 * 128 * 2);
constexpr size_t WS_CLK = al256(WS_CLQ + (size_t)NCP * 64 * 128 * 2);
constexpr size_t WS_CLA = al256(WS_CLK + (size_t)NCP * 64 * 128 * 2);
constexpr size_t WS_CLU = al256(WS_CLA + (size_t)NCP * 64 * 64 * 2);
constexpr size_t WS_CLS = al256(WS_CLU + (size_t)NCPG * 64 * 128 * 4);
constexpr size_t WS_O = al256(WS_CLS + (size_t)NCP * 512 * 4);
constexpr size_t WS_R_END1 = al256(WS_O + (size_t)2 * MROWS * 1024 * 4);
constexpr size_t WS_XS = WS_R;
constexpr size_t WS_HID = al256(WS_XS + (size_t)NE * EPAD * 1024 * 2);
constexpr size_t WS_YSE = al256(WS_HID + (size_t)NE * EPAD * FF * 2);
constexpr size_t WS_R_END2 = al256(WS_YSE + (size_t)NE * EPAD * 1024 * 4);
constexpr size_t WS_END = WS_R_END1 > WS_R_END2 ? WS_R_END1 : WS_R_END2;

constexpr int LDS_BYTES = 163840;
constexpr int LDS_MISC = 163328;

typedef unsigned short bf16_t;
typedef short bf16x8 __attribute__((ext_vector_type(8)));
typedef float f32x2 __attribute__((ext_vector_type(2)));
typedef float f32x4 __attribute__((ext_vector_type(4)));
typedef float f32x16 __attribute__((ext_vector_type(16)));
typedef unsigned u32x2 __attribute__((ext_vector_type(2)));
typedef unsigned u32x4 __attribute__((ext_vector_type(4)));
#define DEV __device__ __forceinline__

#ifdef EMU
#define LAS
#define GAS
static inline float bf2f_h(bf16_t b) { unsigned u = (unsigned)b << 16; float f; memcpy(&f, &u, 4); return f; }
static inline f32x4 mfma16(bf16x8 a, bf16x8 b, f32x4 c) {
    struct In { bf16x8 a, b; } in{a, b};
    auto s = emu::wave_xchg(&in, sizeof(in)); const int l = emu::cur->lane, col = l & 15, rg = l >> 4;
    for (int r = 0; r < 4; ++r) { const int row = 4 * rg + r; double acc = c[r];
        for (int kg = 0; kg < 4; ++kg) { const In* pa = (const In*)s[row + 16 * kg]; const In* pb = (const In*)s[col + 16 * kg];
            for (int j = 0; j < 8; ++j) acc += (double)bf2f_h((bf16_t)pa->a[j]) * (double)bf2f_h((bf16_t)pb->b[j]); }
        c[r] = (float)acc; }
    return c;
}
static inline f32x16 mfma32(bf16x8 a, bf16x8 b, f32x16 c) {
    struct In { bf16x8 a, b; } in{a, b};
    auto s = emu::wave_xchg(&in, sizeof(in)); const int l = emu::cur->lane, col = l & 31, h = l >> 5;
    for (int r = 0; r < 16; ++r) { const int row = (r & 3) + 8 * (r >> 2) + 4 * h; double acc = c[r];
        for (int kh = 0; kh < 2; ++kh) { const In* pa = (const In*)s[row + 32 * kh]; const In* pb = (const In*)s[col + 32 * kh];
            for (int j = 0; j < 8; ++j) acc += (double)bf2f_h((bf16_t)pa->a[j]) * (double)bf2f_h((bf16_t)pb->b[j]); }
        c[r] = (float)acc; }
    return c;
}
static inline void glds16(const void* g, void* l) { memcpy((char*)l + 16 * emu::cur->lane, g, 16); }
#define S_BARRIER() emu::block_barrier()
#define WAIT_VM(n) do {} while (0)
#define WAIT_LGKM(n) do {} while (0)
#define WAIT_ALL() do {} while (0)
#define SETPRIO(n) do {} while (0)
#define SCHED_BARRIER() do {} while (0)
#define COMPILER_FENCE() do {} while (0)
#define WAVE_LDS_SYNC() do { int _z = 0; (void)emu::wave_xchg(&_z, 4); } while (0)
#define LAUNDER(x) do {} while (0)
#define LAUNDER_S(x) do {} while (0)
static inline int lane_id() { return emu::cur->lane; }
template <class T> static inline T shfl_xor_t(T v, int m) { auto s = emu::wave_xchg(&v, sizeof(T)); T r; memcpy(&r, s[emu::cur->lane ^ m], sizeof(T)); return r; }
template <class T> static inline T shfl_t(T v, int src) { auto s = emu::wave_xchg(&v, sizeof(T)); T r; memcpy(&r, s[src & 63], sizeof(T)); return r; }
static inline float wave_sum(float v) { for (int o = 1; o < 64; o <<= 1) v += shfl_xor_t(v, o); return v; }
static inline float wave_max(float v) { for (int o = 1; o < 64; o <<= 1) v = fmaxf(v, shfl_xor_t(v, o)); return v; }
template <int W> static inline float group_sum(float v) { for (int o = 1; o < W; o <<= 1) v += shfl_xor_t(v, o); return v; }
template <int W> static inline float group_max(float v) { for (int o = 1; o < W; o <<= 1) v = fmaxf(v, shfl_xor_t(v, o)); return v; }
static inline int bcast_lane(int v, int src) { return shfl_t(v, src); }
static inline float bcast_lane_f(float v, int src) { return shfl_t(v, src); }
static inline float wave_scan_add(float v) { const int ln = emu::cur->lane; for (int o = 1; o < 64; o <<= 1) { const float t = shfl_t(v, ln - o); if (ln >= o) v += t; } return v; }
static inline float wave_scan_max(float v) { const int ln = emu::cur->lane; for (int o = 1; o < 64; o <<= 1) { const float t = shfl_t(v, ln - o); if (ln >= o) v = fmaxf(v, t); } return v; }
static inline int readfirstlane_i(int v) { return v; }
static inline unsigned xb_ld(unsigned* p) { return *(volatile unsigned*)p; }
static inline unsigned xb_add(unsigned* p, unsigned v) { unsigned o = *p; *p = o + v; return o; }
static inline unsigned xb_xcc_id() { return (unsigned)emu::cur->bid & 7u; }
static inline void s_sleep1() { emu::yield(); }
static inline void fence_acquire() {}
static inline void fence_release() {}
static inline unsigned lds_atomic_add(unsigned* p, unsigned v) { unsigned o = *p; *p = o + v; return o; }
static inline unsigned long long rt_now() { return 0ull; }
static inline float fast_exp2(float x) { return exp2f(x); }
static inline float fast_rcp(float x) { return 1.0f / x; }
#else
#define LAS __attribute__((address_space(3)))
#define GAS __attribute__((address_space(1)))
DEV f32x4 mfma16(bf16x8 a, bf16x8 b, f32x4 c) { return __builtin_amdgcn_mfma_f32_16x16x32_bf16(a, b, c, 0, 0, 0); }
DEV f32x16 mfma32(bf16x8 a, bf16x8 b, f32x16 c) { return __builtin_amdgcn_mfma_f32_32x32x16_bf16(a, b, c, 0, 0, 0); }
#define glds16(g, l) __builtin_amdgcn_global_load_lds((const unsigned*)(g), (LAS unsigned*)(l), 16, 0, 0)
#define S_BARRIER() __builtin_amdgcn_s_barrier()
#define WAIT_VM(n) asm volatile("s_waitcnt vmcnt(" #n ")" ::: "memory")
#define WAIT_LGKM(n) asm volatile("s_waitcnt lgkmcnt(" #n ")" ::: "memory")
#define WAIT_ALL() asm volatile("s_waitcnt vmcnt(0) lgkmcnt(0)" ::: "memory")
#define SETPRIO(n) __builtin_amdgcn_s_setprio(n)
#define SCHED_BARRIER() __builtin_amdgcn_sched_barrier(0)
#define COMPILER_FENCE() asm volatile("" ::: "memory")
#define WAVE_LDS_SYNC() asm volatile("s_waitcnt lgkmcnt(0)" ::: "memory")
#define LAUNDER(x) asm volatile("" : "+v"(x))
#define LAUNDER_S(x) asm volatile("" : "+s"(x))
DEV int lane_id() { return (int)__builtin_amdgcn_mbcnt_hi(~0u, __builtin_amdgcn_mbcnt_lo(~0u, 0u)); }
template <class T> DEV T shfl_xor_t(T v, int m) { return __shfl_xor(v, m); }
template <class T> DEV T shfl_t(T v, int src) { return __shfl(v, src); }
template <int CTRL, int ROWMASK> DEV float dpp_mov(float v) { return __builtin_bit_cast(float, __builtin_amdgcn_update_dpp(0, __builtin_bit_cast(int, v), CTRL, ROWMASK, 0xf, false)); }
template <int CTRL, int ROWMASK> DEV float dpp_mov_keep(float oldv, float v) { return __builtin_bit_cast(float, __builtin_amdgcn_update_dpp(__builtin_bit_cast(int, oldv), __builtin_bit_cast(int, v), CTRL, ROWMASK, 0xf, false)); }
template <int W> DEV float group_sum(float v) {
    v += dpp_mov<0xB1, 0xf>(v); v += dpp_mov<0x4E, 0xf>(v);
    if (W >= 8) v += dpp_mov<0x141, 0xf>(v);
    if (W >= 16) v += dpp_mov<0x140, 0xf>(v);
    return v;
}
DEV float wave_sum(float v) {
    v = group_sum<16>(v);
    v += dpp_mov<0x142, 0xa>(v);
    v += dpp_mov<0x143, 0xc>(v);
    return __builtin_bit_cast(float, __builtin_amdgcn_readlane(__builtin_bit_cast(int, v), 63));
}
DEV float wave_max(float v) {
    v = fmaxf(v, dpp_mov_keep<0xB1, 0xf>(v, v)); v = fmaxf(v, dpp_mov_keep<0x4E, 0xf>(v, v)); v = fmaxf(v, dpp_mov_keep<0x141, 0xf>(v, v)); v = fmaxf(v, dpp_mov_keep<0x140, 0xf>(v, v));
    v = fmaxf(v, dpp_mov_keep<0x142, 0xa>(v, v)); v = fmaxf(v, dpp_mov_keep<0x143, 0xc>(v, v));
    return __builtin_bit_cast(float, __builtin_amdgcn_readlane(__builtin_bit_cast(int, v), 63));
}
template <int W> DEV float group_max(float v) {
    v = fmaxf(v, dpp_mov_keep<0xB1, 0xf>(v, v)); v = fmaxf(v, dpp_mov_keep<0x4E, 0xf>(v, v));
    if (W >= 8) v = fmaxf(v, dpp_mov_keep<0x141, 0xf>(v, v));
    if (W >= 16) v = fmaxf(v, dpp_mov_keep<0x140, 0xf>(v, v));
    return v;
}
DEV int bcast_lane(int v, int src) { return __builtin_amdgcn_readlane(v, src); }
DEV float bcast_lane_f(float v, int src) { return __builtin_bit_cast(float, __builtin_amdgcn_readlane(__builtin_bit_cast(int, v), src)); }
DEV float wave_scan_add(float v) {
    v += dpp_mov<0x111, 0xf>(v); v += dpp_mov<0x112, 0xf>(v); v += dpp_mov<0x114, 0xf>(v); v += dpp_mov<0x118, 0xf>(v);
    v += dpp_mov<0x142, 0xa>(v); v += dpp_mov<0x143, 0xc>(v); return v;
}
DEV float wave_scan_max(float v) {
    v = fmaxf(v, dpp_mov_keep<0x111, 0xf>(v, v)); v = fmaxf(v, dpp_mov_keep<0x112, 0xf>(v, v)); v = fmaxf(v, dpp_mov_keep<0x114, 0xf>(v, v)); v = fmaxf(v, dpp_mov_keep<0x118, 0xf>(v, v));
    v = fmaxf(v, dpp_mov_keep<0x142, 0xa>(v, v)); v = fmaxf(v, dpp_mov_keep<0x143, 0xc>(v, v)); return v;
}
DEV int readfirstlane_i(int v) { return __builtin_amdgcn_readfirstlane(v); }
DEV unsigned xb_ld(unsigned* p) { return __hip_atomic_load(p, __ATOMIC_RELAXED, __HIP_MEMORY_SCOPE_AGENT); }
DEV unsigned xb_add(unsigned* p, unsigned v) { return __hip_atomic_fetch_add(p, v, __ATOMIC_RELAXED, __HIP_MEMORY_SCOPE_AGENT); }
DEV unsigned xb_xcc_id() { return (unsigned)__builtin_amdgcn_s_getreg((3 << 11) | 20) & 0xFu; }
DEV void s_sleep1() { __builtin_amdgcn_s_sleep(1); }
DEV void fence_acquire() { __builtin_amdgcn_fence(__ATOMIC_ACQUIRE, "agent"); }
DEV void fence_release() { __builtin_amdgcn_fence(__ATOMIC_RELEASE, "agent"); }
DEV unsigned lds_atomic_add(LAS unsigned* p, unsigned v) { return __hip_atomic_fetch_add(p, v, __ATOMIC_RELAXED, __HIP_MEMORY_SCOPE_WORKGROUP); }
DEV unsigned long long rt_now() { return __builtin_amdgcn_s_memrealtime(); }
DEV float fast_exp2(float x) { return __builtin_amdgcn_exp2f(x); }
DEV float fast_rcp(float x) { return __builtin_amdgcn_rcpf(x); }
#endif

DEV unsigned f2bf(float f) { unsigned u = __builtin_bit_cast(unsigned, f); return (u + 0x7fffu + ((u >> 16) & 1u)) >> 16; }
DEV unsigned pk2(float lo, float hi) { return f2bf(lo) | (f2bf(hi) << 16); }
DEV float bf2f(unsigned b) { return __builtin_bit_cast(float, b << 16); }
DEV float bflo(unsigned w) { return __builtin_bit_cast(float, w << 16); }
DEV float bfhi(unsigned w) { return __builtin_bit_cast(float, w & 0xffff0000u); }
DEV float sigmoid_f(float x) { return 1.0f / (1.0f + expf(-x)); }
DEV float silu_f(float x) { return x / (1.0f + expf(-x)); }
DEV float softplus_f(float x) { return fmaxf(x, 0.0f) + log1pf(expf(-fabsf(x))); }
DEV float fast_sigmoid(float x) { return fast_rcp(1.0f + fast_exp2(-1.4426950408889634f * x)); }
DEV float fast_silu(float x) { return x * fast_sigmoid(x); }
DEV float gelu_tanh_f(float x) { const float u = 0.7978845608028654f * (x + 0.044715f * x * x * x); return 0.5f * x * (1.0f + tanhf(u)); }

#define XB_TMO      128
#define XB_XCNT(j)  (256  + 64 * (j))
#define XB_XSUB(j)  (1280 + 64 * (j))
#define XB_XGEN(j)  (2304 + 64 * (j))
#define XB_TOP      3328
#define XB_TOPGEN   3392
#define XCD_BAR_WORDS 3456
#define XB_SPIN_CAP (1u << 20)
#define XB_SPIN(cond, bar) do { unsigned _sp = 0; while (cond) { s_sleep1(); \
    if ((++_sp & 255u) == 0u) { if (xb_ld(&(bar)[XB_TMO])) break; if (_sp > XB_SPIN_CAP) { xb_add(&(bar)[XB_TMO], 1u); break; } } } } while (0)
struct XcdBarrier { unsigned* bar; unsigned x; volatile LAS unsigned* st; int wave; };
DEV XcdBarrier xcd_barrier_post(unsigned* bar, volatile LAS unsigned* st, int wave) {
    XcdBarrier b; b.wave = wave; b.bar = bar; b.x = (unsigned)readfirstlane_i((int)xb_xcc_id()); b.st = st;
    if (wave == 0 && lane_id() == 0) (void)xb_add(&bar[XB_XCNT(b.x)], 1u);
    return b;
}
DEV void xcd_barrier_complete(unsigned* bar, unsigned x, unsigned& nloc, unsigned& nx) {
    const unsigned G = gridDim.x;
    unsigned sum, cnt, mine, sp = 0u;
    for (;;) {
        sum = 0u; cnt = 0u; mine = 0u;
#pragma unroll
        for (unsigned j = 0; j < 16; ++j) { const unsigned c = xb_ld(&bar[XB_XCNT(j)]); sum += c; cnt += (c > 0u) ? 1u : 0u; mine = (j == x) ? c : mine; }
        if (sum == G) break;
        s_sleep1();
        if ((++sp & 255u) == 0u) { if (xb_ld(&bar[XB_TMO])) break; if (sp > XB_SPIN_CAP) { xb_add(&bar[XB_TMO], 1u); break; } }
    }
    nloc = mine > 0u ? mine : 1u; nx = cnt > 0u ? cnt : 1u;
}
DEV void xcd_barrier(const XcdBarrier& b) {
    WAIT_VM(0);
    __syncthreads();
    int bw = b.wave; LAUNDER_S(bw);
    if (bw == 0 && lane_id() == 0) {
        unsigned* bar = b.bar; LAUNDER_S(bar);
        unsigned bx = b.x; LAUNDER_S(bx);
        WAIT_ALL();
        unsigned nloc = b.st[0], nx = b.st[1];
        if (nloc == 0u) { xcd_barrier_complete(bar, bx, nloc, nx); b.st[0] = nloc; b.st[1] = nx; }
        const unsigned old = xb_add(&bar[XB_XSUB(bx)], 1u);
        const unsigned gen = old / nloc;
        if (old + 1u == (gen + 1u) * nloc) {
            fence_release();
            WAIT_VM(0);
            const unsigned og = xb_add(&bar[XB_TOP], 1u);
            const unsigned tg = og / nx;
            if (og + 1u == (tg + 1u) * nx) xb_add(&bar[XB_TOPGEN], 1u);
            else XB_SPIN(xb_ld(&bar[XB_TOPGEN]) == tg, bar);
            fence_acquire();
            xb_add(&bar[XB_XGEN(bx)], 1u);
            WAIT_VM(0);
        } else {
            XB_SPIN(xb_ld(&bar[XB_XGEN(bx)]) == gen, bar);
            fence_acquire();
            WAIT_VM(0);
        }
    }
    __syncthreads();
}

namespace pg8 {
constexpr int BM = 256, BK = 64, HALF = 128, HTB = HALF * BK * 2, STAGE_BYTES = 8 * HTB;
DEV int lds_byte(int r, int c) { const int st = (r >> 4) * 2 + (c >> 5), rr = r & 15, cc = c & 31, ob = rr * 64 + cc * 2; return st * 1024 + (ob ^ (((ob >> 9) & 1) << 5)); }
DEV void stage_rc(int b, int& R, int& C) { const int st = b / 1024, sb = b % 1024, swz = sb ^ (((sb >> 9) & 1) << 5); R = (st >> 1) * 16 + swz / 64; C = (st & 1) * 32 + (swz % 64) / 2; }
DEV int perm32(int rho) { const int n = rho >> 4, i = rho & 15; return 8 * (i >> 2) + 4 * n + (i & 3); }
struct Unit { const char* A; const char* B; int pm, pn, e; };
#ifdef EMU
static inline unsigned cvt_pk_bf16(float lo, float hi) { return pk2(lo, hi); }
#else
DEV unsigned cvt_pk_bf16(float lo, float hi) { unsigned r; asm volatile("v_cvt_pk_bf16_f32 %0, %1, %2" : "=v"(r) : "v"(lo), "v"(hi)); return r; }
#endif
template <class Epi, class Sched>
DEV void gemm_phase(LAS unsigned char* lds, const int K, const Sched& S, const Epi& E, const int wid, const int lane) {
    const int tid = wid * 64 + lane; const int wr = wid >> 2, wc = wid & 3, fr = lane & 15, fq = lane >> 4;
    const int nt = K / BK;
    unsigned voffA[2], voffB[2];
#pragma unroll
    for (int i = 0; i < 2; ++i) { int R, C; stage_rc(tid * 16 + i * 8192, R, C); const int Rb = Epi::PERM ? ((R & ~31) + perm32(R & 31)) : R;
        voffA[i] = (unsigned)(R * K + C) * 2u; voffB[i] = (unsigned)(Rb * K + C) * 2u; }
    const size_t kstep = (size_t)(BK * 2);
    const size_t hstep = (size_t)HALF * K * 2;
    const unsigned ldsw = (unsigned)wid * 1024u;
    const int aoff = lds_byte(wr * 64 + fr, fq * 8), boff = lds_byte(wc * 32 + fr, fq * 8);
#define PG8_SA(b, h) (((b) * 2 + (h)) * HTB)
#define PG8_SB(b, h) ((4 + (b) * 2 + (h)) * HTB)
#define PG8_STAGE(bufoff, gbase, voff) do { _Pragma("unroll") for (int _i = 0; _i < 2; ++_i) \
        glds16(((const char*)(gbase) + (voff)[_i]), (lds + (bufoff) + ldsw + _i * 8192)); } while (0)
#define PG8_LDA(dst, b, h) do { _Pragma("unroll") for (int m = 0; m < 4; ++m) _Pragma("unroll") for (int k = 0; k < 2; ++k) dst[m][k] = *(const LAS bf16x8*)(lds + PG8_SA(b, h) + aoff + m * 2048 + k * 1024); } while (0)
#define PG8_LDB(dst, b, h) do { _Pragma("unroll") for (int n = 0; n < 2; ++n) _Pragma("unroll") for (int k = 0; k < 2; ++k) dst[n][k] = *(const LAS bf16x8*)(lds + PG8_SB(b, h) + boff + n * 2048 + k * 1024); } while (0)
#define PG8_MMA(ai, bj, At, Bt) do { SETPRIO(1); _Pragma("unroll") for (int m = 0; m < 4; ++m) _Pragma("unroll") for (int n = 0; n < 2; ++n) _Pragma("unroll") for (int k = 0; k < 2; ++k) \
        acc[ai][bj][m][n] = mfma16(Bt[n][k], At[m][k], acc[ai][bj][m][n]); SETPRIO(0); } while (0)
    Unit cur, nxt; int ui = 0;
    if (!S.next(0, cur)) return;
    f32x4 acc[2][2][4][2];
#pragma unroll
    for (int a = 0; a < 2; ++a)
#pragma unroll
        for (int b = 0; b < 2; ++b)
#pragma unroll
            for (int m = 0; m < 4; ++m)
#pragma unroll
                for (int n = 0; n < 2; ++n) acc[a][b][m][n] = (f32x4){0.f, 0.f, 0.f, 0.f};
    bf16x8 At[4][2], B0[2][2], B1[2][2];
    const char* cA = cur.A; const char* cB = cur.B;
    PG8_STAGE(PG8_SB(0, 0), cB, voffB); PG8_STAGE(PG8_SB(0, 1), cB + hstep, voffB); PG8_STAGE(PG8_SA(0, 0), cA, voffA); PG8_STAGE(PG8_SA(0, 1), cA + hstep, voffA);
    if (wr == 1) S_BARRIER();
    WAIT_VM(2); S_BARRIER();
    PG8_STAGE(PG8_SB(1, 0), cB + kstep, voffB); PG8_STAGE(PG8_SA(1, 0), cA + kstep, voffA); PG8_STAGE(PG8_SB(1, 1), cB + hstep + kstep, voffB);
    WAIT_VM(6); S_BARRIER();
    for (;;) {
        const bool has_next = S.next(ui + 1, nxt);
        const char* nA = has_next ? nxt.A : cA; const char* nB = has_next ? nxt.B : cB;
        for (int t = 0; t < nt; t += 2) {
            const bool last = (t == nt - 2);
            const char* a1 = cA + (size_t)(t + 1) * kstep;
            const char* a2 = last ? nA : cA + (size_t)(t + 2) * kstep; const char* b2 = last ? nB : cB + (size_t)(t + 2) * kstep;
            const char* a3 = a2 + kstep; const char* b3 = b2 + kstep;
            PG8_LDB(B0, 0, 0); PG8_LDB(B1, 0, 1); SCHED_BARRIER(); PG8_LDA(At, 0, 0); PG8_STAGE(PG8_SA(1, 1), a1 + hstep, voffA);
            WAIT_VM(8); WAIT_LGKM(0); S_BARRIER(); PG8_MMA(0, 0, At, B0); PG8_MMA(0, 1, At, B1); S_BARRIER(); SCHED_BARRIER();
            PG8_LDA(At, 0, 1); PG8_STAGE(PG8_SB(0, 0), b2, voffB); PG8_STAGE(PG8_SB(0, 1), b2 + hstep, voffB); PG8_STAGE(PG8_SA(0, 0), a2, voffA);
            WAIT_VM(8); WAIT_LGKM(0); S_BARRIER(); PG8_MMA(1, 0, At, B0); PG8_MMA(1, 1, At, B1); S_BARRIER(); SCHED_BARRIER();
            PG8_LDB(B0, 1, 0); PG8_LDB(B1, 1, 1); SCHED_BARRIER(); PG8_LDA(At, 1, 0); PG8_STAGE(PG8_SA(0, 1), a2 + hstep, voffA);
            WAIT_VM(8); WAIT_LGKM(0); S_BARRIER(); PG8_MMA(0, 0, At, B0); PG8_MMA(0, 1, At, B1); S_BARRIER(); SCHED_BARRIER();
            PG8_LDA(At, 1, 1); PG8_STAGE(PG8_SB(1, 0), b3, voffB); PG8_STAGE(PG8_SB(1, 1), b3 + hstep, voffB); PG8_STAGE(PG8_SA(1, 0), a3, voffA);
            WAIT_VM(8); WAIT_LGKM(0); S_BARRIER(); PG8_MMA(1, 0, At, B0); PG8_MMA(1, 1, At, B1); S_BARRIER(); SCHED_BARRIER();
        }
        if (wr == 0) S_BARRIER();
        E(acc, cur, wr, wc, fr, fq);
        if (!has_next) break;
#pragma unroll
        for (int a = 0; a < 2; ++a)
#pragma unroll
            for (int b = 0; b < 2; ++b)
#pragma unroll
                for (int m = 0; m < 4; ++m)
#pragma unroll
                    for (int n = 0; n < 2; ++n) acc[a][b][m][n] = (f32x4){0.f, 0.f, 0.f, 0.f};
        cur = nxt; cA = nA; cB = nB; ++ui;
        if (wr == 1) S_BARRIER();
    }
    WAIT_VM(0);
    S_BARRIER();
#undef PG8_SA
#undef PG8_SB
#undef PG8_STAGE
#undef PG8_LDA
#undef PG8_LDB
#undef PG8_MMA
}

struct PlainOrder {
    const char* A; const char* Bt; int K, nM, nN, nwg, G, c;
    DEV void init(const void* A_, const void* Bt_, int K_, int M, int N, int G_, int c_) { A = (const char*)A_; Bt = (const char*)Bt_; K = K_; nM = M / BM; nN = N / BM; nwg = nM * nN; G = G_; c = c_; }
    DEV bool next(int i, Unit& u) const {
        const long L = (long)i * G + c; if (L >= nwg) return false;
        int wgid = (int)L; { const int q = nwg / 8, r = nwg % 8, xcd = wgid % 8, off = wgid / 8; wgid = (xcd < r ? xcd * (q + 1) : r * (q + 1) + (xcd - r) * q) + off; }
        const int nig = 8 * nN, gid = wgid / nig, fm = gid * 8, gsz = (nM - fm) < 8 ? (nM - fm) : 8;
        u.pm = fm + ((wgid % nig) % gsz); u.pn = (wgid % nig) / gsz; u.e = 0;
        u.A = A + (size_t)u.pm * BM * K * 2; u.B = Bt + (size_t)u.pn * BM * K * 2; return true;
    }
};
struct GroupedOrder {
    const char* A; const char* Bt; int K, nMe, nN, nwg, G, c; size_t bstride;
    DEV void init(const void* A_, const void* Bt_, int K_, int N, int G_, int c_, int erows) { A = (const char*)A_; Bt = (const char*)Bt_; K = K_; nMe = (erows + BM - 1) / BM; nN = N / BM; nwg = NE * nMe * nN; G = G_; c = c_; bstride = (size_t)N * K * 2; }
    DEV bool next(int i, Unit& u) const {
        const long L = (long)i * G + c; if (L >= nwg) return false;
        int wgid = (int)L; { const int q = nwg / 8, r = nwg % 8, xcd = wgid % 8, off = wgid / 8; wgid = (xcd < r ? xcd * (q + 1) : r * (q + 1) + (xcd - r) * q) + off; }
        const int per_e = nMe * nN; const int e = wgid / per_e, w = wgid % per_e;
        u.e = e; u.pm = w % nMe; u.pn = w / nMe;
        u.A = A + ((size_t)e * EPAD + (size_t)u.pm * BM) * K * 2; u.B = Bt + (size_t)e * bstride + (size_t)u.pn * BM * K * 2; return true;
    }
};
}

struct Args { const float* in[N_IN]; float* out; unsigned char* ws; };

struct Frame {
    const float* const* in; GAS float* out; GAS unsigned char* ws; LAS unsigned char* lds;
    int tid, lane, wave, G, bid, gw, NGW;
};

DEV Frame refresh(const Frame& F0) {
    Frame F = F0; int w = F0.wave; LAUNDER_S(w); int ln = lane_id(); LAUNDER(ln);
    F.wave = w; F.lane = ln; F.tid = w * 64 + ln; F.gw = F.bid * NWAVES + w;
    GAS unsigned char* ws = F0.ws; LAUNDER_S(ws); F.ws = ws;
    return F;
}

#define GIN(k) ((const float*)(GAS const float*)F.in[k])

#define ROW_LOOP(r, NROWS) for (int r = F.gw; r < (NROWS); r += F.NGW)

DEV int tok_row(int b, int d, int sp) {
    if (sp < CTX) return LATR + b * CTX + (d ? (CTX - 1 - sp) : sp);
    const int j = sp - CTX; return b * SEQ + (d ? (SEQ - 1 - j) : j);
}
DEV void row_bs(int r, int& b, int& s) { if (r < LATR) { b = r / SEQ; s = CTX + r % SEQ; } else { const int q = r - LATR; b = q / CTX; s = q % CTX; } }

DEV void tr_item(const float* W, int ldw, int col0, int k0, bf16_t* WT, int K, int row0, LAS float* scr, int lane) {
#pragma unroll 8
    for (int i = 0; i < 32; ++i) { const int kk = 2 * i + (lane >> 5); scr[kk * 33 + (lane & 31)] = W[(size_t)(k0 + kk) * ldw + col0 + (lane & 31)]; }
    WAVE_LDS_SYNC();
    const int c = lane & 7;
#pragma unroll
    for (int j = 0; j < 4; ++j) { const int n = (lane >> 3) + 8 * j; const LAS float* s = scr + (8 * c) * 33 + n;
        u32x4 o; o.x = pk2(s[0 * 33], s[1 * 33]); o.y = pk2(s[2 * 33], s[3 * 33]); o.z = pk2(s[4 * 33], s[5 * 33]); o.w = pk2(s[6 * 33], s[7 * 33]);
        *(u32x4*)(WT + (size_t)(row0 + n) * K + k0 + 8 * c) = o; }
    WAVE_LDS_SYNC();
}

DEV void phase_prologue_a(const Frame& F0) {
    const Frame F = refresh(F0);
    LAS float* scr = (LAS float*)(F.lds + F.wave * 16384);
    for (int l = 0; l < DEPTH; ++l) {
        const int odd = l & 1, li = l >> 1;
        const float* win = odd ? GIN(I_ODWIN) + (size_t)li * 1024 * 2576 : GIN(I_EVWIN) + (size_t)li * 1024 * 4112;
        const int ldw = odd ? 2576 : 4112, nin = odd ? NIN_O : NIN_E;
        bf16_t* wint = (bf16_t*)(F.ws + WS_WIN) + (size_t)l * NINMAX * 1024;
        for (int it = F.gw; it < 16 * (nin / 32); it += F.NGW) { const int kb = it / (nin / 32), nb = it % (nin / 32); const int d0 = 32 * nb;
            tr_item(win, ldw, d0 < 2048 ? d0 : d0 + 16, 64 * kb, wint, 1024, d0, scr, F.lane); }
        const float* wout = odd ? GIN(I_ODWOUT) + (size_t)li * 1024 * 1024 : GIN(I_EVWOUT) + (size_t)li * 1024 * 1024;
        bf16_t* woutt = (bf16_t*)(F.ws + WS_WOUT) + (size_t)l * 1024 * 1024;
        for (int it = F.gw; it < 16 * 32; it += F.NGW) { const int kb = it / 32, nb = it % 32; tr_item(wout, 1024, 32 * nb, 64 * kb, woutt, 1024, 32 * nb, scr, F.lane); }
        if (odd) {
            const float* wglu = GIN(I_ODWGLU) + (size_t)li * 512 * 512; bf16_t* wglut = (bf16_t*)(F.ws + WS_WGLU) + (size_t)li * 512 * 512;
            for (int it = F.gw; it < 8 * 16; it += F.NGW) { const int kb = it / 16, nb = it % 16; tr_item(wglu, 512, 32 * nb, 64 * kb, wglut, 512, 32 * nb, scr, F.lane); }
        }
        constexpr int GU_NB = 2 * FF / 32, GU_ITEMS = 16 * GU_NB;
        for (int it = F.gw; it < NE * GU_ITEMS; it += F.NGW) { const int e = it / GU_ITEMS, r = it % GU_ITEMS, kb = r / GU_NB, nb = r % GU_NB; const int d0 = 32 * nb, j = d0 >> 8, w = d0 & 255;
            const float* src = (w < 128 ? GIN(I_WGATE) : GIN(I_WUP)) + ((size_t)l * NE + e) * 1024 * FF;
            tr_item(src, FF, 128 * j + (w & 127), 64 * kb, (bf16_t*)(F.ws + WS_WGU) + ((size_t)l * NE + e) * 2 * FF * 1024, 1024, d0, scr, F.lane); }
        constexpr int D_ITEMS = (FF / 64) * 32;
        for (int it = F.gw; it < NE * D_ITEMS; it += F.NGW) { const int e = it / D_ITEMS, r = it % D_ITEMS, kb = r / 32, nb = r % 32;
            tr_item(GIN(I_WDOWN) + ((size_t)l * NE + e) * FF * 1024, 1024, 32 * nb, 64 * kb, (bf16_t*)(F.ws + WS_WD) + ((size_t)l * NE + e) * 1024 * FF, FF, 32 * nb, scr, F.lane); }
    }
    const int gt = F.bid * NTHREADS + F.tid, NGT = F.G * NTHREADS;
    for (int i = gt; i < DEPTH * 16 * 1024; i += NGT) { const int l = i / 16384, g = (i >> 10) & 15, k = i & 1023; const int odd = l & 1, li = l >> 1;
        ((float*)(F.ws + WS_WG))[i] = odd ? GIN(I_ODWIN)[((size_t)li * 1024 + k) * 2576 + 2048 + g] : GIN(I_EVWIN)[((size_t)li * 1024 + k) * 4112 + 2048 + g]; }
    for (int i = gt; i < DEPTH * NE * 1024; i += NGT) { const int k = i & 1023, e = (i >> 10) % NE, l = i / (NE * 1024); ((float*)(F.ws + WS_WR))[i] = GIN(I_WROUTER)[((size_t)l * 1024 + k) * NE + e]; }
    for (int i = gt; i < N_ODD * 2 * 32 * 64; i += NGT) { const int p = i & 63, g = (i >> 6) & 31, d = (i >> 11) & 1, o = i >> 12;
        const int idx = ((o * 2 + d) * 32 + g) * 64 + p;
        const float lr = fminf(GIN(I_ODLRE)[idx], -1e-4f), li_ = GIN(I_ODLIM)[idx], dt = expf(GIN(I_ODLDT)[(o * 2 + d) * 32 + g]);
        const float mag = expf(lr * dt); float sn, cs; sincosf(li_ * dt, &sn, &cs); const float are = mag * cs, aim = mag * sn;
        float* A = (float*)(F.ws + WS_S5A) + (size_t)((o * 2 + d) * 32 + g) * 128; A[p] = are; A[64 + p] = aim;
        const float xr = are - 1.0f, xi = aim, den = lr * lr + li_ * li_; const float fre = (xr * lr + xi * li_) / den, fim = (xi * lr - xr * li_) / den;
        bf16_t* Bb = (bf16_t*)(F.ws + WS_S5B) + (size_t)((o * 2 + d) * 32 + g) * 128 * 16;
        for (int h = 0; h < 16; ++h) { const float br = GIN(I_ODBRE)[((size_t)(o * 32 + g) * 64 + p) * 16 + h], bi = GIN(I_ODBIM)[((size_t)(o * 32 + g) * 64 + p) * 16 + h];
            Bb[p * 16 + h] = (bf16_t)f2bf(fre * br - fim * bi); Bb[(64 + p) * 16 + h] = (bf16_t)f2bf(fre * bi + fim * br); } }
    for (int i = gt; i < N_ODD * 32 * 16 * 64; i += NGT) { const int p = i & 63, c = (i >> 6) & 15, g = (i >> 10) & 31, o = i >> 15;
        bf16_t* Cm = (bf16_t*)(F.ws + WS_S5C) + (size_t)((o * 32 + g) * 16 + c) * 128;
        Cm[2 * p] = (bf16_t)f2bf(GIN(I_ODCRE)[i]); Cm[2 * p + 1] = (bf16_t)f2bf(-GIN(I_ODCIM)[i]); }
    ROW_LOOP(r, MPAD) {
        f32x4* dst = (f32x4*)((float*)(F.ws + WS_H) + (size_t)r * 1024) + F.lane;
        if (r < MROWS) { int b, s; row_bs(r, b, s); const f32x4* src = (const f32x4*)(s < CTX ? GIN(I_CTX) + ((size_t)b * CTX + s) * 1024 : GIN(I_X) + ((size_t)b * SEQ + (s - CTX)) * 1024) + F.lane;
#pragma unroll
            for (int j = 0; j < 4; ++j) dst[64 * j] = src[64 * j]; }
        else {
#pragma unroll
            for (int j = 0; j < 4; ++j) dst[64 * j] = (f32x4){0.f, 0.f, 0.f, 0.f};
            u32x4* xz = (u32x4*)((bf16_t*)(F.ws + WS_XIN) + (size_t)r * 1024) + F.lane; xz[0] = (u32x4){0u, 0u, 0u, 0u}; xz[64] = (u32x4){0u, 0u, 0u, 0u};
            u32x4* mz = (u32x4*)((bf16_t*)(F.ws + WS_MERGED) + (size_t)r * 1024) + F.lane; mz[0] = (u32x4){0u, 0u, 0u, 0u}; mz[64] = (u32x4){0u, 0u, 0u, 0u};
            u32x4* yz = (u32x4*)((bf16_t*)(F.ws + WS_YS) + (size_t)r * 512) + F.lane; yz[0] = (u32x4){0u, 0u, 0u, 0u};
        }
    }
    __syncthreads();
    LAS float* sv = (LAS float*)F.lds;
    LAS float* part = (LAS float*)(F.lds + 32768);
    for (int i = F.tid; i < NR * 1024; i += NTHREADS) { const int r = i >> 10, k = i & 1023; const float c = r < B_ ? GIN(I_C)[r * 1024 + k] : GIN(I_CCTX)[k]; sv[i] = silu_f(c); }
    __syncthreads();
    for (int it = F.bid; it < DEPTH * 96; it += F.G) {
        const int l = it / 96, j = (it % 96) * 64 + F.lane;
        const float* w = GIN(I_WMOD) + (size_t)l * 1024 * 6144 + j;
        float acc[NR];
#pragma unroll
        for (int r = 0; r < NR; ++r) acc[r] = 0.f;
        const int k0 = F.wave * 128;
#pragma unroll 8
        for (int k = 0; k < 128; ++k) { const float wv = w[(size_t)(k0 + k) * 6144];
#pragma unroll
            for (int r = 0; r < NR; ++r) acc[r] += sv[r * 1024 + k0 + k] * wv; }
#pragma unroll
        for (int r = 0; r < NR; ++r) part[(F.wave * NR + r) * 64 + F.lane] = acc[r];
        __syncthreads();
        for (int i = F.tid; i < NR * 64; i += NTHREADS) { const int r = i >> 6, jj = i & 63; float s = 0.f;
#pragma unroll
            for (int w8 = 0; w8 < 8; ++w8) s += part[(w8 * NR + r) * 64 + jj];
            const int col = (it % 96) * 64 + jj;
            ((float*)(F.ws + WS_MOD))[((size_t)l * NR + r) * 6144 + col] = s + GIN(I_BMOD)[l * 6144 + col]; }
        __syncthreads();
    }
}

constexpr int RG = 4;
static_assert(TOK % RG == 0 && CTX % RG == 0 && MROWS % RG == 0, "row groups");
DEV void xg_rows(const Frame& F, int l, int row0, f32x4 (&v)[RG][4]) {
    int b, s; row_bs(row0, b, s); const int mr = s < CTX ? B_ : b;
    const float* mod = (const float*)(F.ws + WS_MOD) + ((size_t)l * NR + mr) * 6144;
#pragma unroll
    for (int j = 0; j < 4; ++j) { const f32x4 sh = *((const f32x4*)mod + F.lane + 64 * j), sc = *((const f32x4*)(mod + 1024) + F.lane + 64 * j);
#pragma unroll
        for (int q = 0; q < RG; ++q) v[q][j] = v[q][j] * (1.0f + sc) + sh; }
#pragma unroll
    for (int q = 0; q < RG; ++q) { u32x2* xo = (u32x2*)((bf16_t*)(F.ws + WS_XIN) + (size_t)(row0 + q) * 1024) + F.lane;
#pragma unroll
        for (int j = 0; j < 4; ++j) xo[64 * j] = (u32x2){pk2(v[q][j].x, v[q][j].y), pk2(v[q][j].z, v[q][j].w)}; }
    const float* wg = (const float*)(F.ws + WS_WG) + (size_t)l * 16 * 1024;
    float mine[RG]; const int gi = F.lane & 15;
#pragma unroll
    for (int q = 0; q < RG; ++q) mine[q] = 0.f;
    f32x4 wc[4];
#pragma unroll
    for (int j = 0; j < 4; ++j) wc[j] = *((const f32x4*)wg + F.lane + 64 * j);
#pragma unroll 1
    for (int g = 0; g < 16; ++g) { f32x4 wn[4]; const int gn = g + 1 < 16 ? g + 1 : g;
#pragma unroll
        for (int j = 0; j < 4; ++j) wn[j] = *((const f32x4*)(wg + gn * 1024) + F.lane + 64 * j);
#pragma unroll
        for (int q = 0; q < RG; ++q) { float p = 0.f;
#pragma unroll
            for (int j = 0; j < 4; ++j) p += v[q][j].x * wc[j].x + v[q][j].y * wc[j].y + v[q][j].z * wc[j].z + v[q][j].w * wc[j].w;
            const float t = wave_sum(p); mine[q] = (gi == g) ? t : mine[q]; }
#pragma unroll
        for (int j = 0; j < 4; ++j) wc[j] = wn[j]; }
    const int ty = gi >> 2, hh = gi & 3, li = l >> 1;
#pragma unroll
    for (int q = 0; q < RG; ++q) { float o;
        if (!(l & 1)) {
            if (ty < 2) o = -expf(GIN(I_EVALOG)[(li * 2 + ty) * 4 + hh]) * softplus_f(mine[q] + GIN(I_EVDTB)[(li * 2 + ty) * 4 + hh]);
            else o = sigmoid_f(mine[q]);
        } else {
            const int d = ty & 1, k = ty >> 1; const float gb = GIN(I_ODGB)[((li * 2 + d) * 2 + k) * 4 + hh];
            o = k ? -softplus_f(-(mine[q] + gb)) : mine[q] + gb;
        }
        if (F.lane < 16) ((float*)(F.ws + WS_GATES))[(size_t)(row0 + q) * 16 + gi] = o; }
}

DEV void phase_xg0(const Frame& F0) {
    const Frame F = refresh(F0);
    for (int r = RG * F.gw; r < MROWS; r += RG * F.NGW) {
        f32x4 v[RG][4];
#pragma unroll
        for (int q = 0; q < RG; ++q) { const f32x4* hr = (const f32x4*)((const float*)(F.ws + WS_H) + (size_t)(r + q) * 1024) + F.lane;
#pragma unroll
            for (int j = 0; j < 4; ++j) v[q][j] = hr[64 * j]; }
        xg_rows(F, 0, r, v);
    }
}

DEV void phase_prep(const Frame& F0, int l) {
    const Frame F = refresh(F0);
    const int odd = l & 1, li = l >> 1; const int nin = odd ? NIN_O : NIN_E, nseg = odd ? 2 : 3, qld = odd ? 1024 : 1536;
    const bf16_t* P = (const bf16_t*)(F.ws + WS_P); bf16_t* Q = (bf16_t*)(F.ws + WS_QKV);
    const float* cw = odd ? GIN(I_ODCONV) + (size_t)li * 9 * 1024 : GIN(I_EVCONV) + (size_t)li * 9 * 1536; const int cch = odd ? 1024 : 1536;
    for (int r = RG * F.gw; r < MROWS; r += RG * F.NGW) {
        int b, s; row_bs(r, b, s); const bool lat = s >= CTX; const int rr = lat ? (s - CTX) >> 6 : 0, cc = lat ? (s - CTX) & 63 : s;
        const int ncol = lat ? 64 : CTX;
        for (int seg = 0; seg < nseg; ++seg) {
            const int ch0 = seg * 512 + F.lane * 8; float a[RG][8];
#pragma unroll
            for (int q = 0; q < RG; ++q)
#pragma unroll
                for (int i = 0; i < 8; ++i) a[q][i] = 0.f;
#pragma unroll
            for (int kh = 0; kh < 3; ++kh) {
                const int r2 = rr + kh - 1; const bool rok = lat ? (r2 >= 0 && r2 < SEQ / 64) : (kh == 1);
                if (rok) {
                    f32x4 w0[3], w1[3];
#pragma unroll
                    for (int kw = 0; kw < 3; ++kw) { w0[kw] = *(const f32x4*)(cw + (kh * 3 + kw) * cch + ch0); w1[kw] = *(const f32x4*)(cw + (kh * 3 + kw) * cch + ch0 + 4); }
                    const int rowbase = lat ? b * SEQ + r2 * 64 : LATR + b * CTX;
#pragma unroll
                    for (int dc = 0; dc < RG + 2; ++dc) { const int c2 = cc - 1 + dc;
                        if (c2 >= 0 && c2 < ncol) { const u32x4 pv = *(const u32x4*)(P + (size_t)(rowbase + c2) * nin + ch0);
                            const float x0 = bflo(pv.x), x1 = bfhi(pv.x), x2 = bflo(pv.y), x3 = bfhi(pv.y), x4 = bflo(pv.z), x5 = bfhi(pv.z), x6 = bflo(pv.w), x7 = bfhi(pv.w);
#pragma unroll
                            for (int q = 0; q < RG; ++q) { const int kw = dc - q;
                                if (kw >= 0 && kw <= 2) { a[q][0] += x0 * w0[kw].x; a[q][1] += x1 * w0[kw].y; a[q][2] += x2 * w0[kw].z; a[q][3] += x3 * w0[kw].w;
                                    a[q][4] += x4 * w1[kw].x; a[q][5] += x5 * w1[kw].y; a[q][6] += x6 * w1[kw].z; a[q][7] += x7 * w1[kw].w; } } } }
                }
            }
#pragma unroll
            for (int q = 0; q < RG; ++q) {
                float ss = 0.f;
#pragma unroll
                for (int i = 0; i < 8; ++i) { a[q][i] = silu_f(a[q][i]); ss += a[q][i] * a[q][i]; }
                float sc = 1.0f;
                if (!odd) { if (seg < 2) { ss = group_sum<16>(ss); sc = 1.0f / sqrtf(ss + 1e-6f); if (seg == 0) sc *= HD_SCALE; } }
                else if (seg == 1) sc = HD_SCALE;
                u32x4 o; o.x = pk2(a[q][0] * sc, a[q][1] * sc); o.y = pk2(a[q][2] * sc, a[q][3] * sc); o.z = pk2(a[q][4] * sc, a[q][5] * sc); o.w = pk2(a[q][6] * sc, a[q][7] * sc);
                *(u32x4*)(Q + (size_t)(r + q) * qld + ch0) = o;
            }
        }
    }
    if (odd) {
        const float* GT = (const float*)(F.ws + WS_GATES); float* MC = (float*)(F.ws + WS_MCH);
        for (int c = F.gw; c < B_ * 4 * 2; c += F.NGW) { const int d = c & 1, hh = (c >> 1) & 3, b = c >> 3; float m = 0.f;
            for (int n = 0; n < NCH; ++n) { const int row = tok_row(b, d, n * 64 + F.lane);
                const float lin = GT[(size_t)row * 16 + d * 4 + hh], lf = GT[(size_t)row * 16 + 8 + d * 4 + hh];
                const float bc = wave_scan_add(lf);
                const float bend = bcast_lane_f(bc, 63); const float amax = wave_max(bend - bc + lin);
                if (F.lane == 0) MC[(size_t)c * NCH + n] = m;
                m = fmaxf(bend + m, amax); }
        }
    }
}

DEV int swz256(int r, int k) { return r * 256 + 16 * (k ^ (r & 15)); }
DEV int swz128(int r, int k) { return r * 128 + 16 * (k ^ ((r >> 1) & 7)); }
constexpr int CL_IMG = 90112;
struct ClProb { int n, d, hh, b, kind, qld, vld; const bf16_t *qsrc, *ksrc, *vsrc; float kscale; };
DEV ClProb cl_decode(const Frame& F, int p, int odd, int nhh) {
    ClProb c; c.n = p % NCH; c.d = (p / NCH) & 1; c.hh = (p / (2 * NCH)) % nhh; c.b = p / (2 * NCH * nhh); c.kind = odd ? 2 : (c.hh < 4 ? 0 : 1); c.kscale = 1.0f;
    const bf16_t* P = (const bf16_t*)(F.ws + WS_P); const bf16_t* Q = (const bf16_t*)(F.ws + WS_QKV);
    if (c.kind == 0) { c.qsrc = Q + c.hh * 128; c.ksrc = Q + 512 + c.hh * 128; c.vsrc = Q + 1024 + c.hh * 128; c.qld = 1536; c.vld = 1536; }
    else if (c.kind == 1) { c.qsrc = P + 2048 + (c.hh - 4) * 128; c.ksrc = P + 2560 + (c.hh - 4) * 128; c.vsrc = P + 3072 + (c.hh - 4) * 128; c.qld = NIN_E; c.vld = NIN_E; c.kscale = HD_SCALE; }
    else { c.qsrc = Q + c.hh * 128; c.ksrc = Q + 512 + c.hh * 128; c.vsrc = P + 1024 + c.hh * 128; c.qld = 1024; c.vld = NIN_O; }
    return c;
}
DEV void cl_dma(const Frame& F, const ClProb c) {
    int ln = F.lane; LAUNDER(ln);
    const int r0 = tok_row(c.b, c.d, c.n * 64), sg = c.d ? -1 : 1; const int per = c.kind == 0 ? 6 : 4;
#pragma unroll
    for (int i = 0; i < 6; ++i) if (i < per) { const int ch = F.wave * per + i, reg = ch >> 4, cc = ch & 15, r = 4 * cc + (ln >> 4), kk = (ln & 15) ^ (r & 15);
        const bf16_t* src = reg == 0 ? c.qsrc : (reg == 1 ? c.ksrc : c.vsrc); const int ld = reg == 2 ? c.vld : c.qld;
        glds16((const GAS char*)(src + (size_t)(r0 + sg * r) * ld + 8 * kk), F.lds + CL_IMG + reg * 16384 + 1024 * cc); }
}
DEV void phase_cl(const Frame& F0, int l) {
    const Frame F = refresh(F0);
    const int odd = l & 1; const int nhh = odd ? 4 : 8; const int nprob = B_ * nhh * 2 * NCH;
    LAS float* gc = (LAS float*)(F.lds);
    LAS float* bt = (LAS float*)(F.lds + 256);
    LAS float* qs = (LAS float*)(F.lds + 768);
    LAS float* ks = (LAS float*)(F.lds + 1024);
    LAS float* mt = (LAS float*)(F.lds + 1280);
    LAS float* rsp = (LAS float*)(F.lds + 2048);
    LAS float* Am = (LAS float*)(F.lds + 4096);
    LAS bf16_t* An = (LAS bf16_t*)(F.lds + 20480);
    LAS bf16_t* XT = (LAS bf16_t*)(F.lds + 30720);
    LAS float* Rb = (LAS float*)(F.lds + 69632 + F.wave * 2048);
    LAS float* ksp = (LAS float*)(F.lds + 86016);
    LAS unsigned char* IQ = F.lds + CL_IMG; LAS unsigned char* IK = IQ + 16384; LAS unsigned char* IV = IQ + 32768;
    const float* GT = (const float*)(F.ws + WS_GATES);
    if (F.bid < nprob) cl_dma(F, cl_decode(F, F.bid, odd, nhh));
    for (int p = F.bid; p < nprob; p += F.G) {
        int lz = F.lane; LAUNDER(lz); const int h = lz >> 5, l31 = lz & 31;
        const ClProb c = cl_decode(F, p, odd, nhh); const int n = c.n, d = c.d, hh = c.hh, b = c.b, kind = c.kind; const float kscale = c.kscale;
        float* CS = (float*)(F.ws + WS_CLS) + (size_t)p * 512;
        if (F.wave == 0) {
            const int i = F.lane; const int row = tok_row(b, d, n * 64 + i);
            float g, be = 0.f;
            if (kind == 0) { g = GT[(size_t)row * 16 + d * 4 + hh]; be = GT[(size_t)row * 16 + 8 + d * 4 + hh]; }
            else if (kind == 1) g = log1pf(-exp2f(-(5.0f + 2.0f * (float)(hh - 4) + (float)d)));
            else { be = GT[(size_t)row * 16 + d * 4 + hh]; g = GT[(size_t)row * 16 + 8 + d * 4 + hh]; }
            const float cum = wave_scan_add(g);
            const float gend = bcast_lane_f(cum, 63);
            gc[i] = cum; bt[i] = be;
            if (kind < 2) { qs[i] = expf(cum); ks[i] = expf(gend - cum) * kscale; if (i == 0) CS[0] = expf(gend); }
            else {
                const float mprev = ((const float*)(F.ws + WS_MCH))[(size_t)((b * 4 + hh) * 2 + d) * NCH + n];
                const float a = gend - cum + be; const float amax = wave_max(a); const float mnew = fmaxf(gend + mprev, amax);
                ks[i] = expf(a - mnew);
                const float pm = wave_scan_max(be - cum);
                const float mti = cum + fmaxf(mprev, pm); mt[i] = mti; qs[i] = expf(cum + mprev - mti);
                CS[128 + i] = expf(-mti);
                if (i == 0) CS[0] = expf(gend + mprev - mnew);
            }
        }
        WAIT_VM(0);
        __syncthreads();
        {
            const int w4 = F.wave & 3, mt_ = w4 >> 1, nt_ = w4 & 1; const bool doY = F.wave >= 4;
            if (!doY || kind == 0) {
                const int rj = 32 * mt_ + l31, ri = 32 * nt_ + l31; LAS unsigned char* IB = doY ? IK : IQ;
                f32x16 acc;
#pragma unroll
                for (int r = 0; r < 16; ++r) acc[r] = 0.f;
                bf16x8 af[8], bfr[8];
#pragma unroll
                for (int s = 0; s < 8; ++s) { af[s] = *(const LAS bf16x8*)(IK + swz256(rj, 2 * s + h)); bfr[s] = *(const LAS bf16x8*)(IB + swz256(ri, 2 * s + h)); }
#pragma unroll
                for (int s = 0; s < 8; ++s) acc = mfma32(af[s], bfr[s], acc);
                const int i = ri; const float gi = gc[i];
                if (!doY) {
                    bf16_t* AQ = (bf16_t*)(F.ws + WS_CLA) + (size_t)p * 4096 + (size_t)i * 64; float rsum = 0.f; const float mti = kind == 2 ? mt[i] : 0.f;
#pragma unroll
                    for (int g4 = 0; g4 < 4; ++g4) { float v[4];
#pragma unroll
                        for (int r = 0; r < 4; ++r) { const int j = 32 * mt_ + 8 * g4 + 4 * h + r; float e;
                            if (kind < 2) e = expf(fminf(gi - gc[j], 0.f)); else e = expf(gi - gc[j] + bt[j] - mti);
                            v[r] = (i >= j) ? acc[4 * g4 + r] * kscale * e : 0.f; rsum += v[r]; }
                        *(u32x2*)(AQ + 32 * mt_ + 8 * g4 + 4 * h) = (u32x2){pk2(v[0], v[1]), pk2(v[2], v[3])}; }
                    if (kind == 2) rsp[i * 4 + mt_ * 2 + h] = rsum;
                } else {
                    const float bi = bt[i];
#pragma unroll
                    for (int r = 0; r < 16; ++r) { const int j = 32 * mt_ + 8 * (r >> 2) + 4 * h + (r & 3);
                        const float av = (i > j) ? bi * acc[r] * expf(fminf(gi - gc[j], 0.f)) : 0.f;
                        Am[i * 64 + j] = av; An[i * 72 + j] = (bf16_t)f2bf(-av); }
                }
            }
        }
        __syncthreads();
        int lz2 = F.lane; LAUNDER(lz2); const int l15 = lz2 & 15, kg = lz2 >> 4; const bool isw = F.wave >= 4;
        float rhsv[4][2][4];
        {
            const int tz = F.wave * 64 + lz2; const int cq = tz & 127, q4 = tz >> 7; bf16_t* QD = (bf16_t*)(F.ws + WS_CLQ) + (size_t)p * 8192 + cq;
            for (int i = 16 * q4; i < 16 * q4 + 16; ++i) QD[i * 128] = (bf16_t)f2bf(bf2f(*(const LAS bf16_t*)(IQ + swz256(i, cq >> 3) + 2 * (cq & 7))) * qs[i]);
            bf16_t* KT = (bf16_t*)(F.ws + WS_CLK) + (size_t)p * 8192 + (size_t)cq * 64;
            float ksum = 0.f;
            for (int j8 = 2 * q4; j8 < 2 * q4 + 2; ++j8) { float v[8];
#pragma unroll
                for (int r = 0; r < 8; ++r) { const int j = 8 * j8 + r; v[r] = bf2f(*(const LAS bf16_t*)(IK + swz256(j, cq >> 3) + 2 * (cq & 7))) * ks[j]; ksum += v[r]; }
                *(u32x4*)(KT + 8 * j8) = (u32x4){pk2(v[0], v[1]), pk2(v[2], v[3]), pk2(v[4], v[5]), pk2(v[6], v[7])}; }
            ksp[cq * 4 + q4] = ksum;
            if (kind == 2 && tz < 64) CS[64 + tz] = (rsp[tz * 4] + rsp[tz * 4 + 1]) + (rsp[tz * 4 + 2] + rsp[tz * 4 + 3]);
            if (kind == 0) { LAS unsigned char* IS = isw ? IK : IV;
#pragma unroll
                for (int bb = 0; bb < 4; ++bb)
#pragma unroll
                    for (int nt2 = 0; nt2 < 2; ++nt2)
#pragma unroll
                        for (int r = 0; r < 4; ++r) { const int i = 16 * bb + 4 * kg + r, cc = (32 * F.wave + 16 * nt2 + l15) & 127;
                            rhsv[bb][nt2][r] = bt[i] * bf2f(*(const LAS bf16_t*)(IS + swz256(i, cc >> 3) + 2 * (cc & 7))) * (isw ? qs[i] : 1.0f); } }
        }
        __syncthreads();
        if (p + F.G < nprob) cl_dma(F, cl_decode(F, p + F.G, odd, nhh));
        if (kind == 2 && F.tid < 128) CS[256 + F.tid] = (ksp[F.tid * 4] + ksp[F.tid * 4 + 1]) + (ksp[F.tid * 4 + 2] + ksp[F.tid * 4 + 3]);
        if (kind == 0) {
            const int pg = ((b * 4 + hh) * 2 + d) * NCH + n;
            float* U = (float*)(F.ws + WS_CLU) + (size_t)pg * 8192; bf16_t* W = (bf16_t*)(F.ws + WS_CLW) + (size_t)p * 8192;
#pragma unroll
            for (int bb = 0; bb < 4; ++bb) {
#pragma unroll
                for (int nt2 = 0; nt2 < 2; ++nt2) {
                    const int cidx = 32 * F.wave + 16 * nt2 + l15; f32x4 acc;
#pragma unroll
                    for (int r = 0; r < 4; ++r) acc[r] = rhsv[bb][nt2][r];
                    for (int k2 = 0; k2 < 2; ++k2) if (32 * k2 < 16 * bb) {
                        const bool in = 32 * k2 + 8 * kg + 8 <= 16 * bb;
                        bf16x8 a = *(const LAS bf16x8*)(An + (16 * bb + l15) * 72 + 32 * k2 + 8 * kg); if (!in) a = (bf16x8){0, 0, 0, 0, 0, 0, 0, 0};
                        const bf16x8 xb = *(const LAS bf16x8*)(XT + cidx * 72 + 32 * k2 + 8 * kg);
                        acc = mfma16(a, in ? xb : (bf16x8){0, 0, 0, 0, 0, 0, 0, 0}, acc); }
#pragma unroll
                    for (int r = 0; r < 4; ++r) Rb[(4 * kg + r) * 32 + 16 * nt2 + l15] = acc[r];
                }
                WAVE_LDS_SYNC();
                if (F.lane < 32) {
                    const int cidx = 32 * F.wave + F.lane; float x[16];
#pragma unroll
                    for (int i = 0; i < 16; ++i) { float r = Rb[i * 32 + F.lane];
#pragma unroll
                        for (int j = 0; j < i; ++j) r -= Am[(16 * bb + i) * 64 + 16 * bb + j] * x[j];
                        x[i] = r; }
                    if (!isw) {
#pragma unroll
                        for (int i = 0; i < 16; ++i) U[(16 * bb + i) * 128 + cidx] = x[i]; }
                    else {
#pragma unroll
                        for (int i = 0; i < 16; ++i) W[(16 * bb + i) * 128 + (cidx - 128)] = (bf16_t)f2bf(-x[i]); }
                    *(LAS u32x4*)(XT + cidx * 72 + 16 * bb) = (u32x4){pk2(x[0], x[1]), pk2(x[2], x[3]), pk2(x[4], x[5]), pk2(x[6], x[7])};
                    *(LAS u32x4*)(XT + cidx * 72 + 16 * bb + 8) = (u32x4){pk2(x[8], x[9]), pk2(x[10], x[11]), pk2(x[12], x[13]), pk2(x[14], x[15])};
                }
                WAVE_LDS_SYNC();
            }
        }
    }
    WAIT_VM(0);
    __syncthreads();
}

#define LDS_BARRIER() do { WAIT_LGKM(0); S_BARRIER(); COMPILER_FENCE(); } while (0)
constexpr int SQ_W = 0, SQ_Q = 16384, SQ_K = 32768, SQ_A = 49152, SQ_U = 57344, SQ_C = 65536, SQ_STAGE = 67584;
constexpr int SQ_SB = 2 * SQ_STAGE, SQ_VN = SQ_SB + 8704, SQ_NV = SQ_VN + 4608, SQ_DEN = SQ_NV + 512;
static_assert(SQ_DEN + 256 <= LDS_MISC, "SEQ LDS map");
struct SeqCtx { int kind, b, hh, d, sl, chain, vld; const GAS bf16_t* vsrc; int probe; };
template <int KIND>
DEV void seq_dma(const Frame& F, const SeqCtx& C, int n, LAS unsigned char* img) {
    const int p = C.chain * NCH + n, w = F.wave; int ln = F.lane; LAUNDER(ln);
    if (w < 2) {
        if (KIND == 0) { const GAS char* g = (const GAS char*)(F.ws + WS_CLW) + (size_t)p * 16384; LAUNDER_S(g);
#pragma unroll
            for (int i = 0; i < 8; ++i) { const int r = 4 * (8 * w + i) + (ln >> 4), pp = ln & 15; glds16(g + r * 256 + 16 * (pp ^ (r & 15)), img + SQ_W + 1024 * (8 * w + i)); } }
    } else if (w < 4) {
        const GAS char* g = (const GAS char*)(F.ws + WS_CLQ) + (size_t)p * 16384; LAUNDER_S(g);
#pragma unroll
        for (int i = 0; i < 8; ++i) { const int c = 8 * (w - 2) + i, r = 4 * c + (ln >> 4), pp = ln & 15; glds16(g + r * 256 + 16 * (pp ^ (r & 15)), img + SQ_Q + 1024 * c); }
    } else if (w < 6) {
        const GAS char* g = (const GAS char*)(F.ws + WS_CLK) + (size_t)p * 16384; LAUNDER_S(g);
#pragma unroll
        for (int i = 0; i < 8; ++i) { const int c = 8 * (w - 4) + i, r = 8 * c + (ln >> 3), pp = ln & 7; glds16(g + r * 128 + 16 * (pp ^ ((r >> 1) & 7)), img + SQ_K + 1024 * c); }
    } else if (w == 6) {
        const GAS char* g = (const GAS char*)(F.ws + WS_CLA) + (size_t)p * 8192; LAUNDER_S(g);
#pragma unroll
        for (int i = 0; i < 8; ++i) { const int r = 8 * i + (ln >> 3), pp = ln & 7; glds16(g + r * 128 + 16 * (pp ^ ((r >> 1) & 7)), img + SQ_A + 1024 * i); }
    } else {
        if (KIND == 0) { const int pg = ((C.b * 4 + C.hh) * 2 + C.d) * NCH + n; const GAS char* g = (const GAS char*)(F.ws + WS_CLU) + (size_t)pg * 32768 + 128 * C.sl; LAUNDER_S(g);
#pragma unroll
            for (int i = 0; i < 8; ++i) { const int r = 8 * i + (ln >> 3); glds16(g + r * 512 + 16 * (ln & 7), img + SQ_U + 1024 * i); }
        } else { const int r0 = tok_row(C.b, C.d, n * 64); const long st = C.d ? -(long)C.vld * 2 : (long)C.vld * 2;
            const GAS char* g = (const GAS char*)C.vsrc + (long)r0 * C.vld * 2 + 64 * C.sl; LAUNDER_S(g);
#pragma unroll
            for (int i = 0; i < 4; ++i) { const int r = 16 * i + (ln >> 2); glds16(g + (long)r * st + 16 * (ln & 3), img + SQ_U + 1024 * i); }
        }
        const GAS char* cs = (const GAS char*)(F.ws + WS_CLS) + (size_t)p * 2048; LAUNDER_S(cs);
        glds16(cs + 16 * ln, img + SQ_C);
        if (KIND == 2) glds16(cs + 1024 + 16 * ln, img + SQ_C + 1024);
    }
}
#define SEQ_WAIT_DMA(younger) do { if ((younger) == 16) WAIT_VM(16); else WAIT_VM(0); } while (0)
template <int KIND>
DEV void seq_step(const Frame& F, const SeqCtx& C, int n, f32x16& acc, LAS unsigned char* lds) {
    int lz = F.lane; LAUNDER(lz); const int h = lz >> 5, l31 = lz & 31;
    LAS unsigned char* img = lds + (n & 1) * SQ_STAGE; LAS unsigned char* nimg = lds + ((n + 1) & 1) * SQ_STAGE;
    LAS bf16_t* Sb = (LAS bf16_t*)(lds + SQ_SB); LAS bf16_t* Vn = (LAS bf16_t*)(lds + SQ_VN); LAS float* nvec = (LAS float*)(lds + SQ_NV); LAS float* den = (LAS float*)(lds + SQ_DEN);
    const LAS float* CS = (const LAS float*)(img + SQ_C);
    if (C.probe != 3) seq_dma<KIND>(F, C, C.probe == 2 ? 0 : (n + 1 < NCH ? n + 1 : NCH - 1), nimg);
    if (F.wave < 2) {
        const int mt_ = F.wave;
        if (KIND == 0) {
#pragma unroll
            for (int r = 0; r < 16; ++r) acc[r] = *(const LAS float*)(img + SQ_U + (32 * mt_ + 8 * (r >> 2) + 4 * h + (r & 3)) * 128 + 4 * l31);
            bf16x8 sb[8], wf[8]; const int rr = 32 * mt_ + l31;
#pragma unroll
            for (int s = 0; s < 8; ++s) { sb[s] = *(const LAS bf16x8*)(Sb + l31 * 136 + 16 * s + 8 * h); wf[s] = *(const LAS bf16x8*)(img + SQ_W + swz256(rr, 2 * s + h)); }
#pragma unroll
            for (int s = 0; s < 8; ++s) acc = mfma32(wf[s], sb[s], acc);
        } else {
#pragma unroll
            for (int r = 0; r < 16; ++r) acc[r] = bf2f(*(const LAS bf16_t*)(img + SQ_U + (32 * mt_ + 8 * (r >> 2) + 4 * h + (r & 3)) * 64 + 2 * l31));
        }
#pragma unroll
        for (int g4 = 0; g4 < 4; ++g4) *(LAS u32x2*)(Vn + l31 * 72 + 32 * mt_ + 8 * g4 + 4 * h) = (u32x2){pk2(acc[4 * g4], acc[4 * g4 + 1]), pk2(acc[4 * g4 + 2], acc[4 * g4 + 3])};
    } else if (F.wave < 4) {
        const int rr = 32 * (F.wave - 2) + l31;
#pragma unroll
        for (int r = 0; r < 16; ++r) acc[r] = 0.f;
        bf16x8 sb[8], qf[8];
#pragma unroll
        for (int s = 0; s < 8; ++s) { sb[s] = *(const LAS bf16x8*)(Sb + l31 * 136 + 16 * s + 8 * h); qf[s] = *(const LAS bf16x8*)(img + SQ_Q + swz256(rr, 2 * s + h)); }
#pragma unroll
        for (int s = 0; s < 8; ++s) acc = mfma32(qf[s], sb[s], acc);
    } else if (KIND == 2) {
        const int t = F.tid - 256, i = t >> 2, q = t & 3; float s = 0.f;
#pragma unroll
        for (int c8 = 0; c8 < 4; ++c8) { const u32x4 w = *(const LAS u32x4*)(img + SQ_Q + swz256(i, 4 * q + c8)); const LAS float* nv = nvec + 32 * q + 8 * c8;
            s += bflo(w.x) * nv[0] + bfhi(w.x) * nv[1] + bflo(w.y) * nv[2] + bfhi(w.y) * nv[3] + bflo(w.z) * nv[4] + bfhi(w.z) * nv[5] + bflo(w.w) * nv[6] + bfhi(w.w) * nv[7]; }
        s = group_sum<4>(s);
        if (q == 0) den[i] = fmaxf(fabsf(CS[64 + i] + s), CS[128 + i]);
    }
    LDS_BARRIER();
    if (F.wave >= 2 && F.wave < 4) {
        const int mt_ = F.wave - 2, rr = 32 * mt_ + l31;
        bf16x8 vb[4], af[4];
#pragma unroll
        for (int s = 0; s < 4; ++s) { vb[s] = *(const LAS bf16x8*)(Vn + l31 * 72 + 16 * s + 8 * h); af[s] = *(const LAS bf16x8*)(img + SQ_A + swz128(rr, 2 * s + h)); }
#pragma unroll
        for (int s = 0; s < 4; ++s) acc = mfma32(af[s], vb[s], acc);
        const int r0 = tok_row(C.b, C.d, n * 64); const long st = C.d ? -2048l : 2048l;
        GAS char* Ob = (GAS char*)(F.ws + WS_O) + ((size_t)C.d * MROWS + r0) * 2048 + (long)(32 * mt_) * st; LAUNDER_S(Ob); const long lo = (long)(4 * h) * st + (long)((C.hh * 128 + 32 * C.sl + l31) * 2);
#pragma unroll
        for (int r = 0; r < 16; ++r) { const int i = 32 * mt_ + 8 * (r >> 2) + 4 * h + (r & 3); float v = acc[r];
            if (KIND == 2) v = v / den[i];
            if (!C.probe) *(GAS bf16_t*)(Ob + (long)(8 * (r >> 2) + (r & 3)) * st + lo) = (bf16_t)f2bf(v); }
        SEQ_WAIT_DMA(16);
    } else if (F.wave >= 4) {
        const int kb = F.wave - 4, rr = 32 * kb + l31; const float ge = CS[0];
        bf16x8 vb[4], kf[4];
#pragma unroll
        for (int s = 0; s < 4; ++s) { vb[s] = *(const LAS bf16x8*)(Vn + l31 * 72 + 16 * s + 8 * h); kf[s] = *(const LAS bf16x8*)(img + SQ_K + swz128(rr, 2 * s + h)); }
#pragma unroll
        for (int r = 0; r < 16; ++r) acc[r] *= ge;
#pragma unroll
        for (int s = 0; s < 4; ++s) acc = mfma32(kf[s], vb[s], acc);
#pragma unroll
        for (int g4 = 0; g4 < 4; ++g4) *(LAS u32x2*)(Sb + l31 * 136 + 32 * kb + 8 * g4 + 4 * h) = (u32x2){pk2(acc[4 * g4], acc[4 * g4 + 1]), pk2(acc[4 * g4 + 2], acc[4 * g4 + 3])};
        if (KIND == 2 && F.tid < 256 + 128) { const int dd = F.tid - 256; nvec[dd] = ge * nvec[dd] + CS[256 + dd]; }
        SEQ_WAIT_DMA(0);
    } else SEQ_WAIT_DMA(0);
    LDS_BARRIER();
}
template <int KIND>
DEV void seq_kind_loop(const Frame& F, const SeqCtx& C, LAS unsigned char* lds) {
    f32x16 acc;
#pragma unroll
    for (int r = 0; r < 16; ++r) acc[r] = 0.f;
    seq_dma<KIND>(F, C, 0, lds);
    WAIT_VM(0);
    LDS_BARRIER();
    for (int n = 0; n < NCH; ++n) seq_step<KIND>(F, C, n, acc, lds);
}
DEV void seq_linear_item(const Frame& F, int l, int item, int probe = 0) {
    const int odd = l & 1, nhh = odd ? 4 : 8;
    SeqCtx C; C.probe = probe; C.sl = item & 3; C.chain = item >> 2; C.d = C.chain & 1; C.hh = (C.chain >> 1) % nhh; C.b = C.chain / (2 * nhh);
    C.kind = odd ? 2 : (C.hh < 4 ? 0 : 1);
    const GAS bf16_t* P = (const GAS bf16_t*)(F.ws + WS_P); const GAS bf16_t* Q = (const GAS bf16_t*)(F.ws + WS_QKV);
    if (C.kind == 0) { C.vsrc = Q + 1024 + C.hh * 128; C.vld = 1536; } else if (C.kind == 1) { C.vsrc = P + 3072 + (C.hh - 4) * 128; C.vld = NIN_E; } else { C.vsrc = P + 1024 + C.hh * 128; C.vld = NIN_O; }
    for (int i = F.tid; i < 32 * 136 / 2; i += NTHREADS) ((LAS unsigned*)(F.lds + SQ_SB))[i] = 0u;
    if (F.tid < 128) ((LAS float*)(F.lds + SQ_NV))[F.tid] = 0.f;
    __syncthreads();
    if (C.kind == 0) seq_kind_loop<0>(F, C, F.lds); else if (C.kind == 1) seq_kind_loop<1>(F, C, F.lds); else seq_kind_loop<2>(F, C, F.lds);
    WAIT_VM(0);
}

DEV void seq_s5_item(const Frame& F, int l, int item) {
    const int o = l >> 1; const int g = item & 31, d = (item >> 5) & 1, b = item >> 6;
    LAS float* El = (LAS float*)(F.lds);
    LAS unsigned char* wl = F.lds + 36864 + F.wave * 14336;
    LAS float* scr = (LAS float*)wl; LAS bf16_t* hb = (LAS bf16_t*)(wl + 10240);
    const bf16_t* P = (const bf16_t*)(F.ws + WS_P);
    const float* Ab = (const float*)(F.ws + WS_S5A) + (size_t)((o * 2 + d) * 32 + g) * 128;
    const bf16_t* Bb = (const bf16_t*)(F.ws + WS_S5B) + (size_t)((o * 2 + d) * 32 + g) * 128 * 16;
    const bf16_t* Cm = (const bf16_t*)(F.ws + WS_S5C) + (size_t)(o * 32 + g) * 16 * 128;
    const int l15 = F.lane & 15, kg = F.lane >> 4;
    const float ar = Ab[F.lane], ai = Ab[64 + F.lane];
    bf16x8 bB[8], cB[4]; const bf16x8 zero8 = (bf16x8){0, 0, 0, 0, 0, 0, 0, 0};
#pragma unroll
    for (int ct = 0; ct < 8; ++ct) bB[ct] = kg < 2 ? *(const bf16x8*)(Bb + (size_t)(16 * ct + l15) * 16 + 8 * kg) : zero8;
#pragma unroll
    for (int s = 0; s < 4; ++s) cB[s] = *(const bf16x8*)(Cm + (size_t)l15 * 128 + 32 * s + 8 * kg);
    bf16_t* Obase = (bf16_t*)(F.ws + WS_O) + (size_t)d * MROWS * 1024 + 512 + 16 * g;
    for (int pass = 0; pass < 2; ++pass) {
        bf16x8 an[4];
#pragma unroll
        for (int st = 0; st < 4; ++st) an[st] = kg < 2 ? *(const bf16x8*)(P + (size_t)tok_row(b, d, F.wave * 64 + 16 * st + l15) * NIN_O + 2048 + 16 * g + 8 * kg) : zero8;
        for (int n = F.wave; n < NCH; n += NWAVES) {
            float hr = 0.f, hi = 0.f;
            if (pass) { hr = El[n * 128 + F.lane]; hi = El[n * 128 + 64 + F.lane]; }
            bf16x8 ac[4];
#pragma unroll
            for (int st = 0; st < 4; ++st) ac[st] = an[st];
            { const int nn = n + NWAVES < NCH ? n + NWAVES : n;
#pragma unroll
              for (int st = 0; st < 4; ++st) an[st] = kg < 2 ? *(const bf16x8*)(P + (size_t)tok_row(b, d, nn * 64 + 16 * st + l15) * NIN_O + 2048 + 16 * g + 8 * kg) : zero8; }
            const int r0 = tok_row(b, d, n * 64); const int sg = d ? -1 : 1;
#pragma unroll
            for (int st = 0; st < 4; ++st) {
#pragma unroll
                for (int ct = 0; ct < 8; ++ct) { f32x4 acc = (f32x4){0.f, 0.f, 0.f, 0.f}; acc = mfma16(ac[st], bB[ct], acc);
                    *(LAS f32x4*)(scr + (ct >> 2) * 1280 + (16 * (ct & 3) + l15) * 20 + 4 * kg) = acc; }
                WAVE_LDS_SYNC();
                f32x4 br[4], bi[4];
#pragma unroll
                for (int q = 0; q < 4; ++q) { br[q] = *(const LAS f32x4*)(scr + F.lane * 20 + 4 * q); bi[q] = *(const LAS f32x4*)(scr + 1280 + F.lane * 20 + 4 * q); }
#pragma unroll
                for (int t = 0; t < 16; ++t) { const float nr = ar * hr - ai * hi + br[t >> 2][t & 3], ni = ar * hi + ai * hr + bi[t >> 2][t & 3]; hr = nr; hi = ni;
                    if (pass) *(LAS unsigned*)(hb + t * 128 + 2 * F.lane) = pk2(hr, hi); }
                WAVE_LDS_SYNC();
                if (pass) { f32x4 acc = (f32x4){0.f, 0.f, 0.f, 0.f};
#pragma unroll
                    for (int s = 0; s < 4; ++s) { const bf16x8 ha = *(const LAS bf16x8*)(hb + l15 * 128 + 32 * s + 8 * kg); acc = mfma16(ha, cB[s], acc); }
#pragma unroll
                    for (int r = 0; r < 4; ++r) Obase[(size_t)(r0 + sg * (16 * st + 4 * kg + r)) * 1024 + l15] = (bf16_t)f2bf(acc[r]);
                    WAVE_LDS_SYNC(); }
            }
            if (!pass) { El[n * 128 + F.lane] = hr; El[n * 128 + 64 + F.lane] = hi; }
        }
        __syncthreads();
        if (!pass) {
            if (F.wave == 0) { float pr = ar, pi = ai;
#pragma unroll
                for (int q = 0; q < 6; ++q) { const float nr = pr * pr - pi * pi, ni = 2.0f * pr * pi; pr = nr; pi = ni; }
                float hr = 0.f, hi = 0.f;
                for (int n = 0; n < NCH; ++n) { const float er = El[n * 128 + F.lane], ei = El[n * 128 + 64 + F.lane];
                    El[n * 128 + F.lane] = hr; El[n * 128 + 64 + F.lane] = hi;
                    const float nr = pr * hr - pi * hi + er, ni = pr * hi + pi * hr + ei; hr = nr; hi = ni; } }
            __syncthreads();
        }
    }
}

DEV void phase_seq(const Frame& F0, int l, int mode = 0) {
    const Frame F = refresh(F0);
    const int odd = l & 1; const int nlin = B_ * (odd ? 4 : 8) * 2 * 4; const int ns5 = odd ? B_ * 2 * 32 : 0;
    const int vcu = (F.G % 8 == 0) ? (F.bid % 8) * (F.G / 8) + F.bid / 8 : F.bid;
    if (!odd || F.G <= nlin) {
        for (int it = vcu; it < nlin + ns5; it += F.G) {
            if (it < nlin) { if (mode != 2) seq_linear_item(F, l, it, mode >= 10 ? mode - 10 : 0); } else if (mode != 1 && mode < 10) seq_s5_item(F, l, it - nlin);
            __syncthreads();
        }
    } else if (vcu < nlin) { if (mode != 2) seq_linear_item(F, l, vcu, mode >= 10 ? mode - 10 : 0); }
    else { for (int it = vcu - nlin; it < ns5; it += F.G - nlin) { if (mode != 1 && mode < 10) seq_s5_item(F, l, it); __syncthreads(); } }
}

DEV void phase_merge(const Frame& F0, int l) {
    const Frame F = refresh(F0);
    const int odd = l & 1, li = l >> 1; const bf16_t* P = (const bf16_t*)(F.ws + WS_P);
    const bf16_t* O0 = (const bf16_t*)(F.ws + WS_O); const bf16_t* O1 = O0 + (size_t)MROWS * 1024;
    bf16_t* MG = (bf16_t*)(F.ws + WS_MERGED);
    const int nrows = (l == DEPTH - 1) ? LATR : MROWS;
    ROW_LOOP(r, nrows) {
        if (!odd) {
            const int c0 = 16 * F.lane; float v[16];
#pragma unroll
            for (int q = 0; q < 4; ++q) { const u32x2 a = *(const u32x2*)(O0 + (size_t)r * 1024 + c0 + 4 * q), bq = *(const u32x2*)(O1 + (size_t)r * 1024 + c0 + 4 * q);
                v[4 * q] = bflo(a.x) + bflo(bq.x); v[4 * q + 1] = bfhi(a.x) + bfhi(bq.x); v[4 * q + 2] = bflo(a.y) + bflo(bq.y); v[4 * q + 3] = bfhi(a.y) + bfhi(bq.y); }
            float s = 0.f;
#pragma unroll
            for (int i = 0; i < 16; ++i) s += v[i];
            s = group_sum<8>(s);
            const bool ret = F.lane >= 32; const float mu = ret ? s * (1.0f / 128.0f) : 0.f; float q2 = 0.f;
#pragma unroll
            for (int i = 0; i < 16; ++i) { v[i] -= mu; q2 += v[i] * v[i]; }
            q2 = group_sum<8>(q2);
            const float rstd = 1.0f / sqrtf(q2 * (1.0f / 128.0f) + LN_EPS);
            const bf16_t* zp = P + (size_t)r * NIN_E + (ret ? 3584 + (c0 - 512) : 1536 + c0);
            const float* gp = ret ? GIN(I_EVRETN) + li * 512 + (c0 - 512) : GIN(I_EVGDNN) + li * 128 + (c0 & 127);
            unsigned ow[8];
#pragma unroll
            for (int i = 0; i < 16; i += 2) { const float z0 = bf2f(zp[i]), z1 = bf2f(zp[i + 1]); ow[i >> 1] = pk2(v[i] * rstd * gp[i] * silu_f(z0), v[i + 1] * rstd * gp[i + 1] * silu_f(z1)); }
            u32x4* op = (u32x4*)(MG + (size_t)r * 1024 + c0); op[0] = (u32x4){ow[0], ow[1], ow[2], ow[3]}; op[1] = (u32x4){ow[4], ow[5], ow[6], ow[7]};
        } else {
            const int c0 = 8 * F.lane; float v[8];
#pragma unroll
            for (int q = 0; q < 2; ++q) { const u32x2 a = *(const u32x2*)(O0 + (size_t)r * 1024 + c0 + 4 * q), bq = *(const u32x2*)(O1 + (size_t)r * 1024 + c0 + 4 * q);
                v[4 * q] = bflo(a.x) + bflo(bq.x); v[4 * q + 1] = bfhi(a.x) + bfhi(bq.x); v[4 * q + 2] = bflo(a.y) + bflo(bq.y); v[4 * q + 3] = bfhi(a.y) + bfhi(bq.y); }
            float s = 0.f;
#pragma unroll
            for (int i = 0; i < 8; ++i) s += v[i];
            s = group_sum<16>(s);
            const float mu = s * (1.0f / 128.0f); float q2 = 0.f;
#pragma unroll
            for (int i = 0; i < 8; ++i) { v[i] -= mu; q2 += v[i] * v[i]; }
            q2 = group_sum<16>(q2);
            const float rstd = 1.0f / sqrtf(q2 * (1.0f / 128.0f) + LN_EPS);
            const bf16_t* zp = P + (size_t)r * NIN_O + 1536 + c0; const float* gp = GIN(I_ODMN) + li * 512 + c0;
            unsigned ow[4];
#pragma unroll
            for (int i = 0; i < 8; i += 2) ow[i >> 1] = pk2(v[i] * rstd * gp[i] * sigmoid_f(bf2f(zp[i])), v[i + 1] * rstd * gp[i + 1] * sigmoid_f(bf2f(zp[i + 1])));
            *(u32x4*)(MG + (size_t)r * 1024 + c0) = (u32x4){ow[0], ow[1], ow[2], ow[3]};
            const bf16_t* up = P + (size_t)r * NIN_O + 2048 + c0; const float* dsk = GIN(I_ODDSKIP) + li * 512 + c0;
#pragma unroll
            for (int q = 0; q < 2; ++q) { const u32x2 a = *(const u32x2*)(O0 + (size_t)r * 1024 + 512 + c0 + 4 * q), bq = *(const u32x2*)(O1 + (size_t)r * 1024 + 512 + c0 + 4 * q);
                v[4 * q] = bflo(a.x) + bflo(bq.x); v[4 * q + 1] = bfhi(a.x) + bfhi(bq.x); v[4 * q + 2] = bflo(a.y) + bflo(bq.y); v[4 * q + 3] = bfhi(a.y) + bfhi(bq.y); }
#pragma unroll
            for (int i = 0; i < 8; i += 2) ow[i >> 1] = pk2(gelu_tanh_f(v[i] + dsk[i] * bf2f(up[i])), gelu_tanh_f(v[i + 1] + dsk[i + 1] * bf2f(up[i + 1])));
            *(u32x4*)((bf16_t*)(F.ws + WS_YS) + (size_t)r * 512 + c0) = (u32x4){ow[0], ow[1], ow[2], ow[3]};
        }
    }
}

DEV void ln_rows(const Frame& F, f32x4 (&t)[RG][4], const float* lg, const float* lb) {
    float mean[RG], rstd[RG];
#pragma unroll
    for (int q = 0; q < RG; ++q) { float sum = 0.f;
#pragma unroll
        for (int j = 0; j < 4; ++j) sum += (t[q][j].x + t[q][j].y) + (t[q][j].z + t[q][j].w);
        mean[q] = wave_sum(sum) * (1.0f / 1024.0f); }
#pragma unroll
    for (int q = 0; q < RG; ++q) { float s2 = 0.f;
#pragma unroll
        for (int j = 0; j < 4; ++j) { t[q][j] = t[q][j] - mean[q]; s2 += (t[q][j].x * t[q][j].x + t[q][j].y * t[q][j].y) + (t[q][j].z * t[q][j].z + t[q][j].w * t[q][j].w); }
        rstd[q] = 1.0f / sqrtf(wave_sum(s2) * (1.0f / 1024.0f) + LN_EPS); }
#pragma unroll
    for (int j = 0; j < 4; ++j) { const f32x4 gg = *((const f32x4*)lg + F.lane + 64 * j), bb = *((const f32x4*)lb + F.lane + 64 * j);
#pragma unroll
        for (int q = 0; q < RG; ++q) t[q][j] = t[q][j] * rstd[q] * gg + bb; }
}
DEV void phase_ln1(const Frame& F0, int l) {
    const Frame F = refresh(F0);
    const float* Y = (const float*)(F.ws + WS_Y); float* H = (float*)(F.ws + WS_H);
    const float* lg = GIN(I_LN1G) + l * 1024; const float* lb = GIN(I_LN1B) + l * 1024; const float* wr = (const float*)(F.ws + WS_WR) + (size_t)l * NE * 1024;
    const int nrows = (l == DEPTH - 1) ? LATR : MROWS;
    for (int r = RG * F.gw; r < nrows; r += RG * F.NGW) {
        int b, s; row_bs(r, b, s); const int mr = s < CTX ? B_ : b; const float* mod = (const float*)(F.ws + WS_MOD) + ((size_t)l * NR + mr) * 6144;
        f32x4 t[RG][4];
#pragma unroll
        for (int j = 0; j < 4; ++j) { const f32x4 g1 = *((const f32x4*)(mod + 2048) + F.lane + 64 * j);
#pragma unroll
            for (int q = 0; q < RG; ++q) { const f32x4 hv = *((const f32x4*)(H + (size_t)(r + q) * 1024) + F.lane + 64 * j), yv = *((const f32x4*)(Y + (size_t)(r + q) * 1024) + F.lane + 64 * j); t[q][j] = ALPHA * hv + g1 * yv; }
            if (j & 1) COMPILER_FENCE(); }
        ln_rows(F, t, lg, lb);
        COMPILER_FENCE();
#pragma unroll
        for (int j = 0; j < 4; ++j) { const f32x4 sh = *((const f32x4*)(mod + 3072) + F.lane + 64 * j), scv = *((const f32x4*)(mod + 4096) + F.lane + 64 * j);
#pragma unroll
            for (int q = 0; q < RG; ++q) { *((f32x4*)(H + (size_t)(r + q) * 1024) + F.lane + 64 * j) = t[q][j]; t[q][j] = t[q][j] * (1.0f + scv) + sh; } }
        COMPILER_FENCE();
#pragma unroll
        for (int q = 0; q < RG; ++q) { u32x2* xo = (u32x2*)((bf16_t*)(F.ws + WS_XIN) + (size_t)(r + q) * 1024) + F.lane;
#pragma unroll
            for (int j = 0; j < 4; ++j) xo[64 * j] = (u32x2){pk2(t[q][j].x, t[q][j].y), pk2(t[q][j].z, t[q][j].w)}; }
        float mine[RG]; const int ei = F.lane % NE;
#pragma unroll
        for (int q = 0; q < RG; ++q) mine[q] = 0.f;
        f32x4 wc[4];
#pragma unroll
        for (int j = 0; j < 4; ++j) wc[j] = *((const f32x4*)wr + F.lane + 64 * j);
#pragma unroll 1
        for (int e = 0; e < NE; ++e) { f32x4 wn[4]; const int en = e + 1 < NE ? e + 1 : e;
#pragma unroll
            for (int j = 0; j < 4; ++j) wn[j] = *((const f32x4*)(wr + en * 1024) + F.lane + 64 * j);
#pragma unroll
            for (int q = 0; q < RG; ++q) { float p = 0.f;
#pragma unroll
                for (int j = 0; j < 4; ++j) p += t[q][j].x * wc[j].x + t[q][j].y * wc[j].y + t[q][j].z * wc[j].z + t[q][j].w * wc[j].w;
                const float ws_ = wave_sum(p); mine[q] = (ei == e) ? ws_ : mine[q]; }
#pragma unroll
            for (int j = 0; j < 4; ++j) wc[j] = wn[j]; }
#pragma unroll
        for (int q = 0; q < RG; ++q) { const float mx = group_max<NE>(mine[q]); const float ex = expf(mine[q] - mx); const float se = group_sum<NE>(ex);
            if (F.lane < NE) ((float*)(F.ws + WS_AFF))[(size_t)(r + q) * 16 + F.lane] = ex / se; }
    }
}

DEV void phase_topk(const Frame& F0, int l) {
    const Frame F = refresh(F0);
    const int nitems = (l == DEPTH - 1) ? B_ * NE : 2 * B_ * NE;
    LAS unsigned* hist = (LAS unsigned*)(F.lds);
    LAS unsigned* selw = (LAS unsigned*)(F.lds + 1024);
    LAS unsigned* cnt = (LAS unsigned*)(F.lds + 2048);
    LAS int* selrow = (LAS int*)(F.lds + 8192);
    const float* AFF = (const float*)(F.ws + WS_AFF); int* SLOT = (int*)(F.ws + WS_SLOT); float* EG = (float*)(F.ws + WS_EGATE);
    for (int it = F.bid; it < nitems; it += F.G) {
        const int e = it % NE, set = it / NE, kind = set / B_, b = set % B_;
        const int n = kind ? CTX : SEQ, cap = kind ? CAPC : CAPL; const int row0 = kind ? LATR + b * CTX : b * SEQ;
        const int sbase = kind ? B_ * CAPL + b * CAPC : b * CAPL;
        const int per = n >= NTHREADS ? n / NTHREADS : 1; const bool act = F.tid * per < n;
        unsigned key[8];
#pragma unroll
        for (int k = 0; k < 8; ++k) key[k] = (act && k < per) ? __builtin_bit_cast(unsigned, AFF[(size_t)(row0 + F.tid * per + k) * 16 + e]) : 0u;
        unsigned prefix = 0u, remaining = (unsigned)cap;
        for (int pass = 0; pass < 4; ++pass) {
            const int shift = 24 - 8 * pass; const unsigned mask = pass == 0 ? 0u : (0xFFFFFFFFu << (shift + 8));
            if (F.tid < 256) hist[F.tid] = 0u;
            __syncthreads();
#pragma unroll
            for (int k = 0; k < 8; ++k) if (act && k < per && ((key[k] & mask) == (prefix & mask))) lds_atomic_add(&hist[(key[k] >> shift) & 255u], 1u);
            __syncthreads();
            if (F.wave == 0) {
                const unsigned h0 = hist[4 * F.lane], h1 = hist[4 * F.lane + 1], h2 = hist[4 * F.lane + 2], h3 = hist[4 * F.lane + 3];
                unsigned suf = h0 + h1 + h2 + h3;
#pragma unroll
                for (int o = 1; o < 64; o <<= 1) { const unsigned tv = shfl_t(suf, F.lane + o); if (F.lane + o < 64) suf += tv; }
                unsigned cum = suf - (h0 + h1 + h2 + h3);
                int dsel = -1; unsigned above = 0u;
                if (cum < remaining) {
                    if (cum + h3 >= remaining) { dsel = 4 * F.lane + 3; above = cum; }
                    else if (cum + h3 + h2 >= remaining) { dsel = 4 * F.lane + 2; above = cum + h3; }
                    else if (cum + h3 + h2 + h1 >= remaining) { dsel = 4 * F.lane + 1; above = cum + h3 + h2; }
                    else if (cum + h3 + h2 + h1 + h0 >= remaining) { dsel = 4 * F.lane; above = cum + h3 + h2 + h1; }
                }
                if (dsel >= 0) { selw[0] = prefix | ((unsigned)dsel << shift); selw[1] = remaining - above; }
            }
            __syncthreads();
            prefix = selw[0]; remaining = selw[1];
            __syncthreads();
        }
        const unsigned T = prefix, need_eq = remaining;
        unsigned ngt = 0u, neq = 0u;
#pragma unroll
        for (int k = 0; k < 8; ++k) if (act && k < per) { ngt += key[k] > T ? 1u : 0u; neq += key[k] == T ? 1u : 0u; }
        unsigned pk = (ngt << 16) | neq;
#pragma unroll
        for (int o = 1; o < 64; o <<= 1) { const unsigned tv = shfl_t(pk, F.lane - o); if (F.lane >= o) pk += tv; }
        if (F.lane == 63) cnt[F.wave] = pk;
        __syncthreads();
        unsigned base = 0u;
#pragma unroll
        for (int w8 = 0; w8 < NWAVES; ++w8) base += (w8 < F.wave) ? cnt[w8] : 0u;
        const unsigned excl = base + pk - ((ngt << 16) | neq);
        unsigned gtb = excl >> 16, eqb = excl & 0xffffu;
#pragma unroll
        for (int k = 0; k < 8; ++k) if (act && k < per) {
            const int row = row0 + F.tid * per + k; int slot = -1;
            const bool isgt = key[k] > T, iseq = key[k] == T;
            if (isgt || (iseq && eqb < need_eq)) { slot = (int)(gtb + (eqb < need_eq ? eqb : need_eq)); selrow[slot] = row; EG[(size_t)e * EPAD + sbase + slot] = __builtin_bit_cast(float, key[k]); }
            SLOT[(size_t)row * 16 + e] = slot >= 0 ? sbase + slot : -1;
            gtb += isgt ? 1u : 0u; eqb += iseq ? 1u : 0u;
        }
        __syncthreads();
        for (int sl = F.tid; sl < cap; sl += NTHREADS) ((int*)(F.ws + WS_EIDX))[(size_t)e * EPAD + sbase + sl] = selrow[sl];
        if (it < NE) for (int pr = EROWS + F.tid; pr < EPAD; pr += NTHREADS) EG[(size_t)e * EPAD + pr] = 0.f;
        __syncthreads();
    }
}

DEV void phase_gather(const Frame& F0, int l) {
    const Frame F = refresh(F0);
    const int erows = (l == DEPTH - 1) ? B_ * CAPL : EROWS;
    const int* EI = (const int*)(F.ws + WS_EIDX);
    for (int r0 = 4 * F.gw; r0 < NE * EPAD; r0 += 4 * F.NGW) {
        u32x4 v[4][2];
#pragma unroll
        for (int q = 0; q < 4; ++q) { const int r = r0 + q, sl = r % EPAD; v[q][0] = (u32x4){0u, 0u, 0u, 0u}; v[q][1] = v[q][0];
            if (sl < erows) { const u32x4* src = (const u32x4*)((const bf16_t*)(F.ws + WS_XIN) + (size_t)EI[r] * 1024) + F.lane; v[q][0] = src[0]; v[q][1] = src[64]; } }
#pragma unroll
        for (int q = 0; q < 4; ++q) { u32x4* dst = (u32x4*)((bf16_t*)(F.ws + WS_XS) + (size_t)(r0 + q) * 1024) + F.lane; dst[0] = v[q][0]; dst[64] = v[q][1]; }
    }
}

DEV void phase_ln2(const Frame& F0, int l) {
    const Frame F = refresh(F0);
    float* H = (float*)(F.ws + WS_H); const int* SLOT = (const int*)(F.ws + WS_SLOT); const bf16_t* YSE = (const bf16_t*)(F.ws + WS_YSE);
    const float* lg = GIN(I_LN2G) + l * 1024; const float* lb = GIN(I_LN2B) + l * 1024;
    const int nrows = (l == DEPTH - 1) ? LATR : MROWS;
    for (int r = RG * F.gw; r < nrows; r += RG * F.NGW) {
        int b, s; row_bs(r, b, s); const int mr = s < CTX ? B_ : b; const float* mod = (const float*)(F.ws + WS_MOD) + ((size_t)l * NR + mr) * 6144;
        f32x4 t[RG][4];
#pragma unroll
        for (int q = 0; q < RG; ++q) {
#pragma unroll
            for (int j = 0; j < 4; ++j) t[q][j] = (f32x4){0.f, 0.f, 0.f, 0.f}; }
        const int myslot = F.lane < RG * 16 ? SLOT[(size_t)r * 16 + F.lane] : -1;
#pragma unroll
        for (int q = 0; q < RG; ++q)
#pragma unroll
            for (int e = 0; e < NE; ++e) { const int sl = bcast_lane(myslot, 16 * q + e);
                if (sl >= 0) { const u32x2* yp = (const u32x2*)(YSE + ((size_t)e * EPAD + sl) * 1024) + F.lane;
#pragma unroll
                    for (int j = 0; j < 4; ++j) { const u32x2 w = yp[64 * j]; t[q][j] += (f32x4){bflo(w.x), bfhi(w.x), bflo(w.y), bfhi(w.y)}; } } }
#pragma unroll
        for (int j = 0; j < 4; ++j) { const f32x4 g2 = *((const f32x4*)(mod + 5120) + F.lane + 64 * j);
#pragma unroll
            for (int q = 0; q < RG; ++q) { const f32x4 hv = *((const f32x4*)(H + (size_t)(r + q) * 1024) + F.lane + 64 * j); t[q][j] = ALPHA * hv + g2 * t[q][j]; } }
        ln_rows(F, t, lg, lb);
        if (l == DEPTH - 1) {
            {
#pragma unroll
                for (int q = 0; q < RG; ++q) { GAS f32x4* op = (GAS f32x4*)(F.out + (size_t)(r + q) * 1024) + F.lane;
#pragma unroll
                    for (int j = 0; j < 4; ++j) op[64 * j] = t[q][j]; } }
        } else {
#pragma unroll
            for (int q = 0; q < RG; ++q)
#pragma unroll
                for (int j = 0; j < 4; ++j) *((f32x4*)(H + (size_t)(r + q) * 1024) + F.lane + 64 * j) = t[q][j];
            xg_rows(F, l + 1, r, t);
        }
    }
}

struct EpiP {
    static constexpr bool PERM = true;
    bf16_t* O; int ldc;
    DEV void operator()(const f32x4 (&acc)[2][2][4][2], const pg8::Unit& u, int wr, int wc, int fr, int fq) const {
        const int row0 = u.pm * 256 + wr * 64 + fr, col0 = u.pn * 256 + wc * 32 + 8 * fq;
#pragma unroll
        for (int ai = 0; ai < 2; ++ai)
#pragma unroll
            for (int m = 0; m < 4; ++m) { bf16_t* rowp = O + (size_t)(row0 + ai * 128 + m * 16) * ldc + col0;
#pragma unroll
                for (int bj = 0; bj < 2; ++bj) { const f32x4 v0 = acc[ai][bj][m][0], v1 = acc[ai][bj][m][1];
                    u32x4 w; w.x = pg8::cvt_pk_bf16(v0[0], v0[1]); w.y = pg8::cvt_pk_bf16(v0[2], v0[3]); w.z = pg8::cvt_pk_bf16(v1[0], v1[1]); w.w = pg8::cvt_pk_bf16(v1[2], v1[3]);
                    *(u32x4*)(rowp + bj * 128) = w; } }
    }
};
struct EpiGlu {
    static constexpr bool PERM = true;
    bf16_t* MG; const bf16_t* YS; const float* bias;
    DEV void operator()(const f32x4 (&acc)[2][2][4][2], const pg8::Unit& u, int wr, int wc, int fr, int fq) const {
        const int row0 = u.pm * 256 + wr * 64 + fr, col0 = u.pn * 256 + wc * 32 + 8 * fq;
#pragma unroll
        for (int ai = 0; ai < 2; ++ai)
#pragma unroll
            for (int m = 0; m < 4; ++m) { const int row = row0 + ai * 128 + m * 16;
#pragma unroll
                for (int bj = 0; bj < 2; ++bj) { const int c = col0 + bj * 128; const f32x4 v0 = acc[ai][bj][m][0], v1 = acc[ai][bj][m][1];
                    const u32x4 yv = *(const u32x4*)(YS + (size_t)row * 512 + c); const f32x4 b0 = *(const f32x4*)(bias + c), b1 = *(const f32x4*)(bias + c + 4);
                    u32x4 w; w.x = pk2(bflo(yv.x) * fast_sigmoid(v0[0] + b0[0]), bfhi(yv.x) * fast_sigmoid(v0[1] + b0[1])); w.y = pk2(bflo(yv.y) * fast_sigmoid(v0[2] + b0[2]), bfhi(yv.y) * fast_sigmoid(v0[3] + b0[3]));
                    w.z = pk2(bflo(yv.z) * fast_sigmoid(v1[0] + b1[0]), bfhi(yv.z) * fast_sigmoid(v1[1] + b1[1])); w.w = pk2(bflo(yv.w) * fast_sigmoid(v1[2] + b1[2]), bfhi(yv.w) * fast_sigmoid(v1[3] + b1[3]));
                    *(u32x4*)(MG + (size_t)row * 1024 + 512 + c) = w; } }
    }
};
struct EpiF32 {
    static constexpr bool PERM = false;
    float* C; int ldc; const float* rowscale;
    DEV void operator()(const f32x4 (&acc)[2][2][4][2], const pg8::Unit& u, int wr, int wc, int fr, int fq) const {
        const int row0 = u.pm * 256 + wr * 64 + fr, col0 = u.pn * 256 + wc * 32 + 4 * fq;
        const size_t ebase = rowscale ? (size_t)u.e * EPAD : 0;
#pragma unroll
        for (int ai = 0; ai < 2; ++ai)
#pragma unroll
            for (int m = 0; m < 4; ++m) { const size_t row = ebase + row0 + ai * 128 + m * 16; const float sc = rowscale ? rowscale[row] : 1.0f; float* rowp = C + row * ldc + col0;
#pragma unroll
                for (int bj = 0; bj < 2; ++bj)
#pragma unroll
                    for (int n = 0; n < 2; ++n) *(f32x4*)(rowp + bj * 128 + n * 16) = acc[ai][bj][m][n] * sc; }
    }
};
struct EpiYse {
    static constexpr bool PERM = true;
    bf16_t* O; const float* rowscale;
    DEV void operator()(const f32x4 (&acc)[2][2][4][2], const pg8::Unit& u, int wr, int wc, int fr, int fq) const {
        const int row0 = u.pm * 256 + wr * 64 + fr, col0 = u.pn * 256 + wc * 32 + 8 * fq; const size_t ebase = (size_t)u.e * EPAD;
#pragma unroll
        for (int ai = 0; ai < 2; ++ai)
#pragma unroll
            for (int m = 0; m < 4; ++m) { const size_t row = ebase + row0 + ai * 128 + m * 16; const float sc = rowscale[row]; bf16_t* rowp = O + row * 1024 + col0;
#pragma unroll
                for (int bj = 0; bj < 2; ++bj) { const f32x4 v0 = acc[ai][bj][m][0] * sc, v1 = acc[ai][bj][m][1] * sc;
                    u32x4 w; w.x = pg8::cvt_pk_bf16(v0[0], v0[1]); w.y = pg8::cvt_pk_bf16(v0[2], v0[3]); w.z = pg8::cvt_pk_bf16(v1[0], v1[1]); w.w = pg8::cvt_pk_bf16(v1[2], v1[3]);
                    *(u32x4*)(rowp + bj * 128) = w; } }
    }
};
struct EpiSwiglu {
    static constexpr bool PERM = true;
    bf16_t* HID;
    DEV void operator()(const f32x4 (&acc)[2][2][4][2], const pg8::Unit& u, int wr, int wc, int fr, int fq) const {
        const int row0 = u.pm * 256 + wr * 64 + fr, col0 = u.pn * 128 + wc * 32 + 8 * fq;
#pragma unroll
        for (int ai = 0; ai < 2; ++ai)
#pragma unroll
            for (int m = 0; m < 4; ++m) { bf16_t* rowp = HID + ((size_t)u.e * EPAD + row0 + ai * 128 + m * 16) * FF + col0;
                const f32x4 g0 = acc[ai][0][m][0], g1 = acc[ai][0][m][1], u0 = acc[ai][1][m][0], u1 = acc[ai][1][m][1];
                u32x4 w; w.x = pk2(fast_silu(g0[0]) * u0[0], fast_silu(g0[1]) * u0[1]); w.y = pk2(fast_silu(g0[2]) * u0[2], fast_silu(g0[3]) * u0[3]);
                w.z = pk2(fast_silu(g1[0]) * u1[0], fast_silu(g1[1]) * u1[1]); w.w = pk2(fast_silu(g1[2]) * u1[2], fast_silu(g1[3]) * u1[3]);
                *(u32x4*)rowp = w; }
    }
};

DEV void gemm_g1(const Frame& F0, int l, int vcu) {
    const Frame F = refresh(F0);
    const int nin = (l & 1) ? NIN_O : NIN_E;
    pg8::PlainOrder S; S.init((const void*)(F.ws + WS_XIN), (const bf16_t*)(F.ws + WS_WIN) + (size_t)l * NINMAX * 1024, 1024, MPAD, nin, F.G, vcu);
    EpiP E; E.O = (bf16_t*)(F.ws + WS_P); E.ldc = nin;
    pg8::gemm_phase(F.lds, 1024, S, E, F.wave, F.lane);
}
DEV void gemm_glu(const Frame& F0, int l, int vcu) {
    const Frame F = refresh(F0);
    const int li = l >> 1;
    pg8::PlainOrder S; S.init((const void*)(F.ws + WS_YS), (const bf16_t*)(F.ws + WS_WGLU) + (size_t)li * 512 * 512, 512, (l == DEPTH - 1) ? LATPAD : MPAD, 512, F.G, vcu);
    EpiGlu E; E.MG = (bf16_t*)(F.ws + WS_MERGED); E.YS = (const bf16_t*)(F.ws + WS_YS); E.bias = GIN(I_ODBGLU) + li * 512;
    pg8::gemm_phase(F.lds, 512, S, E, F.wave, F.lane);
}
DEV void gemm_g3(const Frame& F0, int l, int vcu) {
    const Frame F = refresh(F0);
    pg8::PlainOrder S; S.init((const void*)(F.ws + WS_MERGED), (const bf16_t*)(F.ws + WS_WOUT) + (size_t)l * 1024 * 1024, 1024, (l == DEPTH - 1) ? LATPAD : MPAD, 1024, F.G, vcu);
    EpiF32 E; E.C = (float*)(F.ws + WS_Y); E.ldc = 1024; E.rowscale = nullptr;
    pg8::gemm_phase(F.lds, 1024, S, E, F.wave, F.lane);
}
DEV void gemm_g4(const Frame& F0, int l, int vcu) {
    const Frame F = refresh(F0);
    pg8::GroupedOrder S; S.init((const void*)(F.ws + WS_XS), (const bf16_t*)(F.ws + WS_WGU) + (size_t)l * NE * 2 * FF * 1024, 1024, 2 * FF, F.G, vcu, (l == DEPTH - 1) ? B_ * CAPL : EROWS);
    EpiSwiglu E; E.HID = (bf16_t*)(F.ws + WS_HID);
    pg8::gemm_phase(F.lds, 1024, S, E, F.wave, F.lane);
}
DEV void gemm_g5(const Frame& F0, int l, int vcu) {
    const Frame F = refresh(F0);
    pg8::GroupedOrder S; S.init((const void*)(F.ws + WS_HID), (const bf16_t*)(F.ws + WS_WD) + (size_t)l * NE * 1024 * FF, FF, 1024, F.G, vcu, (l == DEPTH - 1) ? B_ * CAPL : EROWS);
    EpiYse E; E.O = (bf16_t*)(F.ws + WS_YSE); E.rowscale = (const float*)(F.ws + WS_EGATE);
    pg8::gemm_phase(F.lds, FF, S, E, F.wave, F.lane);
}

__global__ void __launch_bounds__(NTHREADS, 2) mega_fwd(Args args) {
#ifdef EMU
    LAS unsigned char* lds = emu::lds();
#else
    extern __shared__ __attribute__((aligned(16))) unsigned char lds_raw[];
    LAS unsigned char* lds = (LAS unsigned char*)lds_raw;
#endif
    Frame F;
    F.in = args.in; F.out = (GAS float*)args.out; F.ws = (GAS unsigned char*)args.ws; F.lds = lds;
    F.tid = threadIdx.x; F.lane = F.tid & 63; F.wave = readfirstlane_i(F.tid >> 6); F.G = gridDim.x; F.bid = blockIdx.x;
    F.gw = F.bid * NWAVES + F.wave; F.NGW = F.G * NWAVES;
    for (int u = F.tid; u < (LDS_BYTES - LDS_MISC) / 4; u += NTHREADS) ((LAS unsigned*)(lds + LDS_MISC))[u] = 0u;
    __syncthreads();
    XcdBarrier bar = xcd_barrier_post((unsigned*)(F.ws + WS_CTL), (volatile LAS unsigned*)(lds + LDS_MISC), F.wave);
#define GRID_BAR() xcd_barrier(bar)
    const int vcu = (F.G % 8 == 0) ? (F.bid % 8) * (F.G / 8) + F.bid / 8 : F.bid;

#ifndef PHASE_MASK
#define PHASE_MASK 0xFFFFF
#endif
#ifndef REPEAT_MASK
#define REPEAT_MASK 0x0
#endif
#ifndef TIMING_PROBE
#define TIMING_PROBE -1
#endif
    unsigned long long pt_acc = 0ull, pt_t0 = 0ull;
#define PT(k) do { if (TIMING_PROBE == (k)) pt_t0 = rt_now(); } while (0)
#define PTE(k) do { if (TIMING_PROBE == (k)) pt_acc += rt_now() - pt_t0; } while (0)
#define PH(k) if ((PHASE_MASK >> (k)) & 1)
#define RP(k) if ((REPEAT_MASK >> (k)) & 1)
    PT(0); PH(0) phase_prologue_a(F);
    RP(0) { GRID_BAR(); phase_prologue_a(F); }
    GRID_BAR(); PTE(0);
    PT(1); PH(1) phase_xg0(F);
    GRID_BAR(); PTE(1);
    for (int l = 0; l < DEPTH; ++l) {
        const int odd = l & 1;
        PT(2); PH(2) gemm_g1(F, l, vcu);
        RP(2) { GRID_BAR(); gemm_g1(F, l, vcu); }
        GRID_BAR(); PTE(2);
        PT(3); PH(3) phase_prep(F, l);
        RP(3) { GRID_BAR(); phase_prep(F, l); }
        GRID_BAR(); PTE(3);
        PT(4); PH(4) phase_cl(F, l);
        RP(4) { GRID_BAR(); phase_cl(F, l); }
        GRID_BAR(); PTE(4);
        PT(5); PH(5) phase_seq(F, l);
        RP(5) { GRID_BAR(); phase_seq(F, l); }
        GRID_BAR(); PTE(5);
#ifdef SEQ_XPROBE
        if ((l & 1) == SEQ_XPARITY) { PT(20); phase_seq(F, l, 10 + SEQ_XPROBE); GRID_BAR(); PTE(20); }
#endif
        PT(6); PH(6) phase_merge(F, l);
        RP(6) { GRID_BAR(); phase_merge(F, l); }
        GRID_BAR(); PTE(6);
        if (odd) { PT(7); PH(7) gemm_glu(F, l, vcu); RP(7) { GRID_BAR(); gemm_glu(F, l, vcu); } GRID_BAR(); PTE(7); }
        PT(8); PH(8) gemm_g3(F, l, vcu);
        RP(8) { GRID_BAR(); gemm_g3(F, l, vcu); }
        GRID_BAR(); PTE(8);
        PT(9); PH(9) phase_ln1(F, l);
        GRID_BAR(); PTE(9);
        PT(10); PH(10) phase_topk(F, l);
        RP(10) { GRID_BAR(); phase_topk(F, l); }
        GRID_BAR(); PTE(10);
        PT(14); PH(10) phase_gather(F, l);
        GRID_BAR(); PTE(14);
        PT(11); PH(11) gemm_g4(F, l, vcu);
        RP(11) { GRID_BAR(); gemm_g4(F, l, vcu); }
        GRID_BAR(); PTE(11);
        PT(12); PH(12) gemm_g5(F, l, vcu);
        RP(12) { GRID_BAR(); gemm_g5(F, l, vcu); }
        GRID_BAR(); PTE(12);
        PT(13); PH(13) phase_ln2(F, l);
        GRID_BAR(); PTE(13);
    }
    if (TIMING_PROBE >= 0 && F.bid == 0) { const unsigned long long t1 = rt_now() + pt_acc; while (rt_now() < t1) s_sleep1(); }
}

#ifndef EMU
extern "C" void kernel_launch(void* const* d_in, const int* in_sizes, int n_in, void* d_out, int out_size, void* d_ws, size_t ws_size, hipStream_t stream) {
    static int grid = 0;
    if (grid == 0) {
        if (n_in != N_IN || ws_size < WS_END) { fprintf(stderr, "kernel_launch: need %d inputs and %zu bytes of workspace; got %d, %zu\n", (int)N_IN, (size_t)WS_END, n_in, ws_size); grid = -1; return; }
        int dev = 0, cus = 0, per_cu = 0;
        if (hipGetDevice(&dev) != hipSuccess || hipDeviceGetAttribute(&cus, hipDeviceAttributeMultiprocessorCount, dev) != hipSuccess) { grid = -1; return; }
        if (hipFuncSetAttribute((const void*)mega_fwd, hipFuncAttributeMaxDynamicSharedMemorySize, LDS_BYTES) != hipSuccess) { fprintf(stderr, "kernel_launch: hipFuncSetAttribute failed\n"); grid = -1; return; }
        if (hipOccupancyMaxActiveBlocksPerMultiprocessor(&per_cu, (const void*)mega_fwd, NTHREADS, LDS_BYTES) != hipSuccess || per_cu < 1) { fprintf(stderr, "kernel_launch: occupancy query says %d\n", per_cu); }
        (void)hipGetLastError();
        grid = cus;
    }
    if (grid < 0) return;
    (void)hipMemsetAsync((char*)d_ws + WS_CTL, 0, CTL_BYTES, stream);
    Args a{};
    for (int i = 0; i < N_IN; ++i) a.in[i] = (const float*)d_in[i];
    a.out = (float*)d_out; a.ws = (unsigned char*)d_ws;
    hipLaunchKernelGGL(mega_fwd, dim3(grid), dim3(NTHREADS), LDS_BYTES, stream, a);
}
#endif
```

```cpp
#ifdef EMU
#include "emu.h"
#else
#include <hip/hip_runtime.h>
#endif
#include <cstdio>
#include <cstdint>
#include <cstddef>

#ifndef CFG_BATCH
#define CFG_BATCH 4
#define CFG_SEQ 4096
#define CFG_CTX 256
#define CFG_DEPTH 4
#define CFG_NEXP 16
#define CFG_FF 2048
#endif
constexpr int B_ = CFG_BATCH, SEQ = CFG_SEQ, CTX = CFG_CTX, DEPTH = CFG_DEPTH, NE = CFG_NEXP, FF = CFG_FF;
constexpr int D = 1024, TOK = CTX + SEQ, MROWS = B_ * TOK, MPAD = (MROWS + 255) / 256 * 256;
constexpr int NCH = TOK / 64;
constexpr int LATR = B_ * SEQ;
constexpr int LATPAD = (LATR + 255) / 256 * 256;
constexpr int CAPL = 2 * SEQ / NE, CAPC = 2 * CTX / NE, EROWS = B_ * (CAPL + CAPC), EPAD = (EROWS + 255) / 256 * 256;
constexpr int NIN_E = 4096, NIN_O = 2560, NINMAX = 4096;
constexpr int N_EVEN = (DEPTH + 1) / 2, N_ODD = DEPTH / 2, N_ODDA = N_ODD > 0 ? N_ODD : 1;
constexpr int NR = B_ + 1;
constexpr float ALPHA = 1.681792830507429f;
constexpr float LN_EPS = 1e-5f;
constexpr float HD_SCALE = 0.08838834764831845f;
constexpr int NWAVES = 8, NTHREADS = 512;

enum { I_X = 0, I_C, I_CTX, I_CCTX, I_WMOD, I_BMOD, I_LN1G, I_LN1B, I_LN2G, I_LN2B, I_WROUTER, I_WGATE, I_WUP, I_WDOWN,
       I_EVWIN, I_EVWOUT, I_EVCONV, I_EVALOG, I_EVDTB, I_EVGDNN, I_EVRETN,
       I_ODWIN, I_ODWOUT, I_ODCONV, I_ODGB, I_ODMN, I_ODLRE, I_ODLIM, I_ODLDT, I_ODBRE, I_ODBIM, I_ODCRE, I_ODCIM, I_ODDSKIP, I_ODWGLU, I_ODBGLU, N_IN };

constexpr size_t al256(size_t x) { return (x + 255) & ~(size_t)255; }
constexpr size_t WS_CTL = 0, CTL_BYTES = 65536;
constexpr size_t WS_MOD = WS_CTL + CTL_BYTES;
constexpr size_t WS_WG = al256(WS_MOD + (size_t)DEPTH * NR * 6144 * 4);
constexpr size_t WS_WIN = al256(WS_WG + (size_t)DEPTH * 16 * 1024 * 4);
constexpr size_t WS_WOUT = al256(WS_WIN + (size_t)DEPTH * NINMAX * 1024 * 2);
constexpr size_t WS_WGLU = al256(WS_WOUT + (size_t)DEPTH * 1024 * 1024 * 2);
constexpr size_t WS_WGU = al256(WS_WGLU + (size_t)N_ODDA * 512 * 512 * 2);
constexpr size_t WS_WD = al256(WS_WGU + (size_t)DEPTH * NE * 2 * FF * 1024 * 2);
constexpr size_t WS_S5A = al256(WS_WD + (size_t)DEPTH * NE * 1024 * FF * 2);
constexpr size_t WS_S5B = al256(WS_S5A + (size_t)N_ODDA * 2 * 32 * 128 * 4);
constexpr size_t WS_S5C = al256(WS_S5B + (size_t)N_ODDA * 2 * 32 * 128 * 16 * 2);
constexpr size_t WS_H = al256(WS_S5C + (size_t)N_ODDA * 32 * 16 * 128 * 2);
constexpr size_t WS_XIN = al256(WS_H + (size_t)MPAD * 1024 * 4);
constexpr size_t WS_GATES = al256(WS_XIN + (size_t)MPAD * 1024 * 2);
constexpr size_t WS_MERGED = al256(WS_GATES + (size_t)MROWS * 16 * 4);
constexpr size_t WS_YS = al256(WS_MERGED + (size_t)MPAD * 1024 * 2);
constexpr size_t WS_Y = al256(WS_YS + (size_t)MPAD * 512 * 2);
constexpr size_t WS_AFF = al256(WS_Y + (size_t)MPAD * 1024 * 4);
constexpr size_t WS_SLOT = al256(WS_AFF + (size_t)MROWS * 16 * 4);
constexpr size_t WS_EGATE = al256(WS_SLOT + (size_t)MROWS * 16 * 4);
constexpr size_t WS_MCH = al256(WS_EGATE + (size_t)NE * EPAD * 4);
constexpr size_t WS_WR = al256(WS_MCH + (size_t)B_ * 4 * 2 * NCH * 4);
constexpr size_t WS_EIDX = al256(WS_WR + (size_t)DEPTH * NE * 1024 * 4);
constexpr size_t WS_S5E = al256(WS_EIDX + (size_t)NE * EPAD * 4);
constexpr size_t WS_R = al256(WS_S5E + (size_t)B_ * 2 * 32 * NCH * 128 * 4);
constexpr int NCP = B_ * 8 * 2 * NCH, NCPG = B_ * 4 * 2 * NCH;
constexpr size_t WS_P = WS_R;
constexpr size_t WS_QKV = al256(WS_P + (size_t)MPAD * NINMAX * 2);
constexpr size_t WS_CLW = al256(WS_QKV + (size_t)MROWS * 1536 * 2);
constexpr size_t WS_CLQ = al256(WS_CLW + (size_t)NCP * 64 * 128 * 2);
constexpr size_t WS_CLK = al256(WS_CLQ + (size_t)NCP * 64 * 128 * 2);
constexpr size_t WS_CLA = al256(WS_CLK + (size_t)NCP * 64 * 128 * 2);
constexpr size_t WS_CLU = al256(WS_CLA + (size_t)NCP * 64 * 64 * 2);
constexpr size_t WS_CLS = al256(WS_CLU + (size_t)NCPG * 64 * 128 * 4);
constexpr size_t WS_O = al256(WS_CLS + (size_t)NCP * 512 * 4);
constexpr size_t WS_R_END1 = al256(WS_O + (size_t)2 * MROWS * 1024 * 4);
constexpr size_t WS_XS = WS_R;
constexpr size_t WS_HID = al256(WS_XS + (size_t)NE * EPAD * 1024 * 2);
constexpr size_t WS_YSE = al256(WS_HID + (size_t)NE * EPAD * FF * 2);
constexpr size_t WS_R_END2 = al256(WS_YSE + (size_t)NE * EPAD * 1024 * 4);
constexpr size_t WS_END = WS_R_END1 > WS_R_END2 ? WS_R_END1 : WS_R_END2;

constexpr int LDS_BYTES = 163840;
constexpr int LDS_MISC = 163328;

typedef unsigned short bf16_t;
typedef short bf16x8 __attribute__((ext_vector_type(8)));
typedef float f32x2 __attribute__((ext_vector_type(2)));
typedef float f32x4 __attribute__((ext_vector_type(4)));
typedef float f32x16 __attribute__((ext_vector_type(16)));
typedef unsigned u32x2 __attribute__((ext_vector_type(2)));
typedef unsigned u32x4 __attribute__((ext_vector_type(4)));
#define DEV __device__ __forceinline__

#ifdef EMU
#define LAS
#define GAS
static inline float bf2f_h(bf16_t b) { unsigned u = (unsigned)b << 16; float f; memcpy(&f, &u, 4); return f; }
static inline f32x4 mfma16(bf16x8 a, bf16x8 b, f32x4 c) {
    struct In { bf16x8 a, b; } in{a, b};
    auto s = emu::wave_xchg(&in, sizeof(in)); const int l = emu::cur->lane, col = l & 15, rg = l >> 4;
    for (int r = 0; r < 4; ++r) { const int row = 4 * rg + r; double acc = c[r];
        for (int kg = 0; kg < 4; ++kg) { const In* pa = (const In*)s[row + 16 * kg]; const In* pb = (const In*)s[col + 16 * kg];
            for (int j = 0; j < 8; ++j) acc += (double)bf2f_h((bf16_t)pa->a[j]) * (double)bf2f_h((bf16_t)pb->b[j]); }
        c[r] = (float)acc; }
    return c;
}
static inline f32x16 mfma32(bf16x8 a, bf16x8 b, f32x16 c) {
    struct In { bf16x8 a, b; } in{a, b};
    auto s = emu::wave_xchg(&in, sizeof(in)); const int l = emu::cur->lane, col = l & 31, h = l >> 5;
    for (int r = 0; r < 16; ++r) { const int row = (r & 3) + 8 * (r >> 2) + 4 * h; double acc = c[r];
        for (int kh = 0; kh < 2; ++kh) { const In* pa = (const In*)s[row + 32 * kh]; const In* pb = (const In*)s[col + 32 * kh];
            for (int j = 0; j < 8; ++j) acc += (double)bf2f_h((bf16_t)pa->a[j]) * (double)bf2f_h((bf16_t)pb->b[j]); }
        c[r] = (float)acc; }
    return c;
}
static inline void glds16(const void* g, void* l) { memcpy((char*)l + 16 * emu::cur->lane, g, 16); }
#define S_BARRIER() emu::block_barrier()
#define WAIT_VM(n) do {} while (0)
#define WAIT_LGKM(n) do {} while (0)
#define WAIT_ALL() do {} while (0)
#define SETPRIO(n) do {} while (0)
#define SCHED_BARRIER() do {} while (0)
#define COMPILER_FENCE() do {} while (0)
#define WAVE_LDS_SYNC() do { int _z = 0; (void)emu::wave_xchg(&_z, 4); } while (0)
#define LAUNDER(x) do {} while (0)
#define CODE_ALIGN() do {} while (0)
#define LAUNDER_S(x) do {} while (0)
static inline int lane_id() { return emu::cur->lane; }
template <class T> static inline T shfl_xor_t(T v, int m) { auto s = emu::wave_xchg(&v, sizeof(T)); T r; memcpy(&r, s[emu::cur->lane ^ m], sizeof(T)); return r; }
template <class T> static inline T shfl_t(T v, int src) { auto s = emu::wave_xchg(&v, sizeof(T)); T r; memcpy(&r, s[src & 63], sizeof(T)); return r; }
static inline float wave_sum(float v) { for (int o = 1; o < 64; o <<= 1) v += shfl_xor_t(v, o); return v; }
static inline float wave_max(float v) { for (int o = 1; o < 64; o <<= 1) v = fmaxf(v, shfl_xor_t(v, o)); return v; }
template <int W> static inline float group_sum(float v) { for (int o = 1; o < W; o <<= 1) v += shfl_xor_t(v, o); return v; }
template <int W> static inline float group_max(float v) { for (int o = 1; o < W; o <<= 1) v = fmaxf(v, shfl_xor_t(v, o)); return v; }
static inline int bcast_lane(int v, int src) { return shfl_t(v, src); }
static inline float bcast_lane_f(float v, int src) { return shfl_t(v, src); }
static inline float wave_scan_add(float v) { const int ln = emu::cur->lane; for (int o = 1; o < 64; o <<= 1) { const float t = shfl_t(v, ln - o); if (ln >= o) v += t; } return v; }
static inline float wave_scan_max(float v) { const int ln = emu::cur->lane; for (int o = 1; o < 64; o <<= 1) { const float t = shfl_t(v, ln - o); if (ln >= o) v = fmaxf(v, t); } return v; }
static inline int readfirstlane_i(int v) { return v; }
static inline unsigned xb_ld(unsigned* p) { return *(volatile unsigned*)p; }
static inline unsigned xb_add(unsigned* p, unsigned v) { unsigned o = *p; *p = o + v; return o; }
static inline unsigned xb_xcc_id() { return (unsigned)emu::cur->bid & 7u; }
static inline void s_sleep1() { emu::yield(); }
static inline void fence_acquire() {}
static inline void fence_release() {}
static inline unsigned lds_atomic_add(unsigned* p, unsigned v) { unsigned o = *p; *p = o + v; return o; }
static inline unsigned long long rt_now() { return 0ull; }
static inline float fast_exp2(float x) { return exp2f(x); }
static inline float fast_rcp(float x) { return 1.0f / x; }
#else
#define LAS __attribute__((address_space(3)))
#define GAS __attribute__((address_space(1)))
DEV f32x4 mfma16(bf16x8 a, bf16x8 b, f32x4 c) { return __builtin_amdgcn_mfma_f32_16x16x32_bf16(a, b, c, 0, 0, 0); }
DEV f32x16 mfma32(bf16x8 a, bf16x8 b, f32x16 c) { return __builtin_amdgcn_mfma_f32_32x32x16_bf16(a, b, c, 0, 0, 0); }
#define glds16(g, l) __builtin_amdgcn_global_load_lds((const unsigned*)(g), (LAS unsigned*)(l), 16, 0, 0)
#define S_BARRIER() __builtin_amdgcn_s_barrier()
#define WAIT_VM(n) asm volatile("s_waitcnt vmcnt(" #n ")" ::: "memory")
#define WAIT_LGKM(n) asm volatile("s_waitcnt lgkmcnt(" #n ")" ::: "memory")
#define WAIT_ALL() asm volatile("s_waitcnt vmcnt(0) lgkmcnt(0)" ::: "memory")
#define SETPRIO(n) __builtin_amdgcn_s_setprio(n)
#define SCHED_BARRIER() __builtin_amdgcn_sched_barrier(0)
#define COMPILER_FENCE() asm volatile("" ::: "memory")
#define WAVE_LDS_SYNC() asm volatile("s_waitcnt lgkmcnt(0)" ::: "memory")
#define LAUNDER(x) asm volatile("" : "+v"(x))
#define CODE_ALIGN() asm volatile(".p2align 8")
#define LAUNDER_S(x) asm volatile("" : "+s"(x))
DEV int lane_id() { return (int)__builtin_amdgcn_mbcnt_hi(~0u, __builtin_amdgcn_mbcnt_lo(~0u, 0u)); }
template <class T> DEV T shfl_xor_t(T v, int m) { return __shfl_xor(v, m); }
template <class T> DEV T shfl_t(T v, int src) { return __shfl(v, src); }
template <int CTRL, int ROWMASK> DEV float dpp_mov(float v) { return __builtin_bit_cast(float, __builtin_amdgcn_update_dpp(0, __builtin_bit_cast(int, v), CTRL, ROWMASK, 0xf, false)); }
template <int CTRL, int ROWMASK> DEV float dpp_mov_keep(float oldv, float v) { return __builtin_bit_cast(float, __builtin_amdgcn_update_dpp(__builtin_bit_cast(int, oldv), __builtin_bit_cast(int, v), CTRL, ROWMASK, 0xf, false)); }
template <int W> DEV float group_sum(float v) {
    v += dpp_mov<0xB1, 0xf>(v); v += dpp_mov<0x4E, 0xf>(v);
    if (W >= 8) v += dpp_mov<0x141, 0xf>(v);
    if (W >= 16) v += dpp_mov<0x140, 0xf>(v);
    return v;
}
DEV float wave_sum(float v) {
    v = group_sum<16>(v);
    v += dpp_mov<0x142, 0xa>(v);
    v += dpp_mov<0x143, 0xc>(v);
    return __builtin_bit_cast(float, __builtin_amdgcn_readlane(__builtin_bit_cast(int, v), 63));
}
DEV float wave_max(float v) {
    v = fmaxf(v, dpp_mov_keep<0xB1, 0xf>(v, v)); v = fmaxf(v, dpp_mov_keep<0x4E, 0xf>(v, v)); v = fmaxf(v, dpp_mov_keep<0x141, 0xf>(v, v)); v = fmaxf(v, dpp_mov_keep<0x140, 0xf>(v, v));
    v = fmaxf(v, dpp_mov_keep<0x142, 0xa>(v, v)); v = fmaxf(v, dpp_mov_keep<0x143, 0xc>(v, v));
    return __builtin_bit_cast(float, __builtin_amdgcn_readlane(__builtin_bit_cast(int, v), 63));
}
template <int W> DEV float group_max(float v) {
    v = fmaxf(v, dpp_mov_keep<0xB1, 0xf>(v, v)); v = fmaxf(v, dpp_mov_keep<0x4E, 0xf>(v, v));
    if (W >= 8) v = fmaxf(v, dpp_mov_keep<0x141, 0xf>(v, v));
    if (W >= 16) v = fmaxf(v, dpp_mov_keep<0x140, 0xf>(v, v));
    return v;
}
DEV int bcast_lane(int v, int src) { return __builtin_amdgcn_readlane(v, src); }
DEV float bcast_lane_f(float v, int src) { return __builtin_bit_cast(float, __builtin_amdgcn_readlane(__builtin_bit_cast(int, v), src)); }
DEV float wave_scan_add(float v) {
    v += dpp_mov<0x111, 0xf>(v); v += dpp_mov<0x112, 0xf>(v); v += dpp_mov<0x114, 0xf>(v); v += dpp_mov<0x118, 0xf>(v);
    v += dpp_mov<0x142, 0xa>(v); v += dpp_mov<0x143, 0xc>(v); return v;
}
DEV float wave_scan_max(float v) {
    v = fmaxf(v, dpp_mov_keep<0x111, 0xf>(v, v)); v = fmaxf(v, dpp_mov_keep<0x112, 0xf>(v, v)); v = fmaxf(v, dpp_mov_keep<0x114, 0xf>(v, v)); v = fmaxf(v, dpp_mov_keep<0x118, 0xf>(v, v));
    v = fmaxf(v, dpp_mov_keep<0x142, 0xa>(v, v)); v = fmaxf(v, dpp_mov_keep<0x143, 0xc>(v, v)); return v;
}
DEV int readfirstlane_i(int v) { return __builtin_amdgcn_readfirstlane(v); }
DEV unsigned xb_ld(unsigned* p) { return __hip_atomic_load(p, __ATOMIC_RELAXED, __HIP_MEMORY_SCOPE_AGENT); }
DEV unsigned xb_add(unsigned* p, unsigned v) { return __hip_atomic_fetch_add(p, v, __ATOMIC_RELAXED, __HIP_MEMORY_SCOPE_AGENT); }
DEV unsigned xb_xcc_id() { return (unsigned)__builtin_amdgcn_s_getreg((3 << 11) | 20) & 0xFu; }
DEV void s_sleep1() { __builtin_amdgcn_s_sleep(1); }
DEV void fence_acquire() { __builtin_amdgcn_fence(__ATOMIC_ACQUIRE, "agent"); }
DEV void fence_release() { __builtin_amdgcn_fence(__ATOMIC_RELEASE, "agent"); }
DEV unsigned lds_atomic_add(LAS unsigned* p, unsigned v) { return __hip_atomic_fetch_add(p, v, __ATOMIC_RELAXED, __HIP_MEMORY_SCOPE_WORKGROUP); }
DEV unsigned long long rt_now() { return __builtin_amdgcn_s_memrealtime(); }
DEV float fast_exp2(float x) { return __builtin_amdgcn_exp2f(x); }
DEV float fast_rcp(float x) { return __builtin_amdgcn_rcpf(x); }
#endif

DEV unsigned f2bf(float f) { unsigned u = __builtin_bit_cast(unsigned, f); return (u + 0x7fffu + ((u >> 16) & 1u)) >> 16; }
DEV unsigned pk2(float lo, float hi) { return f2bf(lo) | (f2bf(hi) << 16); }
DEV float bf2f(unsigned b) { return __builtin_bit_cast(float, b << 16); }
DEV float bflo(unsigned w) { return __builtin_bit_cast(float, w << 16); }
DEV float bfhi(unsigned w) { return __builtin_bit_cast(float, w & 0xffff0000u); }
DEV float sigmoid_f(float x) { return 1.0f / (1.0f + expf(-x)); }
DEV float silu_f(float x) { return x / (1.0f + expf(-x)); }
DEV float softplus_f(float x) { return fmaxf(x, 0.0f) + log1pf(expf(-fabsf(x))); }
DEV float fast_sigmoid(float x) { return fast_rcp(1.0f + fast_exp2(-1.4426950408889634f * x)); }
DEV float fast_silu(float x) { return x * fast_sigmoid(x); }
DEV float gelu_tanh_f(float x) { const float u = 0.7978845608028654f * (x + 0.044715f * x * x * x); return 0.5f * x * (1.0f + tanhf(u)); }

#define XB_TMO      128
#define XB_XCNT(j)  (256  + 64 * (j))
#define XB_XSUB(j)  (1280 + 64 * (j))
#define XB_XGEN(j)  (2304 + 64 * (j))
#define XB_TOP      3328
#define XB_TOPGEN   3392
#define XCD_BAR_WORDS 3456
#define XB_SPIN_CAP (1u << 20)
#define XB_SPIN(cond, bar) do { unsigned _sp = 0; while (cond) { s_sleep1(); \
    if ((++_sp & 255u) == 0u) { if (xb_ld(&(bar)[XB_TMO])) break; if (_sp > XB_SPIN_CAP) { xb_add(&(bar)[XB_TMO], 1u); break; } } } } while (0)
struct XcdBarrier { unsigned* bar; unsigned x; volatile LAS unsigned* st; int wave; };
DEV XcdBarrier xcd_barrier_post(unsigned* bar, volatile LAS unsigned* st, int wave) {
    XcdBarrier b; b.wave = wave; b.bar = bar; b.x = (unsigned)readfirstlane_i((int)xb_xcc_id()); b.st = st;
    if (wave == 0 && lane_id() == 0) (void)xb_add(&bar[XB_XCNT(b.x)], 1u);
    return b;
}
DEV void xcd_barrier_complete(unsigned* bar, unsigned x, unsigned& nloc, unsigned& nx) {
    const unsigned G = gridDim.x;
    unsigned sum, cnt, mine, sp = 0u;
    for (;;) {
        sum = 0u; cnt = 0u; mine = 0u;
#pragma unroll
        for (unsigned j = 0; j < 16; ++j) { const unsigned c = xb_ld(&bar[XB_XCNT(j)]); sum += c; cnt += (c > 0u) ? 1u : 0u; mine = (j == x) ? c : mine; }
        if (sum == G) break;
        s_sleep1();
        if ((++sp & 255u) == 0u) { if (xb_ld(&bar[XB_TMO])) break; if (sp > XB_SPIN_CAP) { xb_add(&bar[XB_TMO], 1u); break; } }
    }
    nloc = mine > 0u ? mine : 1u; nx = cnt > 0u ? cnt : 1u;
}
DEV void xcd_barrier(const XcdBarrier& b) {
    WAIT_VM(0);
    __syncthreads();
    int bw = b.wave; LAUNDER_S(bw);
    if (bw == 0 && lane_id() == 0) {
        unsigned* bar = b.bar; LAUNDER_S(bar);
        unsigned bx = b.x; LAUNDER_S(bx);
        WAIT_ALL();
        unsigned nloc = b.st[0], nx = b.st[1];
        if (nloc == 0u) { xcd_barrier_complete(bar, bx, nloc, nx); b.st[0] = nloc; b.st[1] = nx; }
        const unsigned old = xb_add(&bar[XB_XSUB(bx)], 1u);
        const unsigned gen = old / nloc;
        if (old + 1u == (gen + 1u) * nloc) {
            fence_release();
            WAIT_VM(0);
            const unsigned og = xb_add(&bar[XB_TOP], 1u);
            const unsigned tg = og / nx;
            if (og + 1u == (tg + 1u) * nx) xb_add(&bar[XB_TOPGEN], 1u);
            else XB_SPIN(xb_ld(&bar[XB_TOPGEN]) == tg, bar);
            fence_acquire();
            xb_add(&bar[XB_XGEN(bx)], 1u);
            WAIT_VM(0);
        } else {
            XB_SPIN(xb_ld(&bar[XB_XGEN(bx)]) == gen, bar);
            fence_acquire();
            WAIT_VM(0);
        }
    }
    __syncthreads();
}

namespace pg8 {
constexpr int BM = 256, BK = 64, HALF = 128, HTB = HALF * BK * 2, STAGE_BYTES = 8 * HTB;
DEV int lds_byte(int r, int c) { const int st = (r >> 4) * 2 + (c >> 5), rr = r & 15, cc = c & 31, ob = rr * 64 + cc * 2; return st * 1024 + (ob ^ (((ob >> 9) & 1) << 5)); }
DEV void stage_rc(int b, int& R, int& C) { const int st = b / 1024, sb = b % 1024, swz = sb ^ (((sb >> 9) & 1) << 5); R = (st >> 1) * 16 + swz / 64; C = (st & 1) * 32 + (swz % 64) / 2; }
DEV int perm32(int rho) { const int n = rho >> 4, i = rho & 15; return 8 * (i >> 2) + 4 * n + (i & 3); }
struct Unit { const char* A; const char* B; int pm, pn, e; };
#ifdef EMU
static inline unsigned cvt_pk_bf16(float lo, float hi) { return pk2(lo, hi); }
#else
DEV unsigned cvt_pk_bf16(float lo, float hi) { unsigned r; asm volatile("v_cvt_pk_bf16_f32 %0, %1, %2" : "=v"(r) : "v"(lo), "v"(hi)); return r; }
#endif
template <class Epi, class Sched>
DEV void gemm_phase(LAS unsigned char* lds, const int K, const Sched& S, const Epi& E, const int wid, const int lane) {
    const int tid = wid * 64 + lane; const int wr = wid >> 2, wc = wid & 3, fr = lane & 15, fq = lane >> 4;
    const int nt = K / BK;
    unsigned voffA[2], voffB[2];
#pragma unroll
    for (int i = 0; i < 2; ++i) { int R, C; stage_rc(tid * 16 + i * 8192, R, C); const int Rb = Epi::PERM ? ((R & ~31) + perm32(R & 31)) : R;
        voffA[i] = (unsigned)(R * K + C) * 2u; voffB[i] = (unsigned)(Rb * K + C) * 2u; }
    const size_t kstep = (size_t)(BK * 2);
    const size_t hstep = (size_t)HALF * K * 2;
    const unsigned ldsw = (unsigned)wid * 1024u;
    const int aoff = lds_byte(wr * 64 + fr, fq * 8), boff = lds_byte(wc * 32 + fr, fq * 8);
#define PG8_SA(b, h) (((b) * 2 + (h)) * HTB)
#define PG8_SB(b, h) ((4 + (b) * 2 + (h)) * HTB)
#define PG8_STAGE(bufoff, gbase, voff) do { _Pragma("unroll") for (int _i = 0; _i < 2; ++_i) \
        glds16(((const char*)(gbase) + (voff)[_i]), (lds + (bufoff) + ldsw + _i * 8192)); } while (0)
#define PG8_LDA(dst, b, h) do { _Pragma("unroll") for (int m = 0; m < 4; ++m) _Pragma("unroll") for (int k = 0; k < 2; ++k) dst[m][k] = *(const LAS bf16x8*)(lds + PG8_SA(b, h) + aoff + m * 2048 + k * 1024); } while (0)
#define PG8_LDB(dst, b, h) do { _Pragma("unroll") for (int n = 0; n < 2; ++n) _Pragma("unroll") for (int k = 0; k < 2; ++k) dst[n][k] = *(const LAS bf16x8*)(lds + PG8_SB(b, h) + boff + n * 2048 + k * 1024); } while (0)
#define PG8_MMA(ai, bj, At, Bt) do { SETPRIO(1); _Pragma("unroll") for (int m = 0; m < 4; ++m) _Pragma("unroll") for (int n = 0; n < 2; ++n) _Pragma("unroll") for (int k = 0; k < 2; ++k) \
        acc[ai][bj][m][n] = mfma16(Bt[n][k], At[m][k], acc[ai][bj][m][n]); SETPRIO(0); } while (0)
    Unit cur, nxt; int ui = 0;
    if (!S.next(0, cur)) return;
    f32x4 acc[2][2][4][2];
#pragma unroll
    for (int a = 0; a < 2; ++a)
#pragma unroll
        for (int b = 0; b < 2; ++b)
#pragma unroll
            for (int m = 0; m < 4; ++m)
#pragma unroll
                for (int n = 0; n < 2; ++n) acc[a][b][m][n] = (f32x4){0.f, 0.f, 0.f, 0.f};
    bf16x8 At[4][2], B0[2][2], B1[2][2];
    const char* cA = cur.A; const char* cB = cur.B;
    PG8_STAGE(PG8_SB(0, 0), cB, voffB); PG8_STAGE(PG8_SB(0, 1), cB + hstep, voffB); PG8_STAGE(PG8_SA(0, 0), cA, voffA); PG8_STAGE(PG8_SA(0, 1), cA + hstep, voffA);
    if (wr == 1) S_BARRIER();
    WAIT_VM(2); S_BARRIER();
    PG8_STAGE(PG8_SB(1, 0), cB + kstep, voffB); PG8_STAGE(PG8_SA(1, 0), cA + kstep, voffA); PG8_STAGE(PG8_SB(1, 1), cB + hstep + kstep, voffB);
    WAIT_VM(6); S_BARRIER();
    CODE_ALIGN();
    for (;;) {
        const bool has_next = S.next(ui + 1, nxt);
        const char* nA = has_next ? nxt.A : cA; const char* nB = has_next ? nxt.B : cB;
        for (int t = 0; t < nt; t += 2) {
            const bool last = (t == nt - 2);
            const char* a1 = cA + (size_t)(t + 1) * kstep;
            const char* a2 = last ? nA : cA + (size_t)(t + 2) * kstep; const char* b2 = last ? nB : cB + (size_t)(t + 2) * kstep;
            const char* a3 = a2 + kstep; const char* b3 = b2 + kstep;
            PG8_LDB(B0, 0, 0); PG8_LDB(B1, 0, 1); SCHED_BARRIER(); PG8_LDA(At, 0, 0); PG8_STAGE(PG8_SA(1, 1), a1 + hstep, voffA);
            WAIT_VM(8); WAIT_LGKM(0); S_BARRIER(); PG8_MMA(0, 0, At, B0); PG8_MMA(0, 1, At, B1); S_BARRIER(); SCHED_BARRIER();
            PG8_LDA(At, 0, 1); PG8_STAGE(PG8_SB(0, 0), b2, voffB); PG8_STAGE(PG8_SB(0, 1), b2 + hstep, voffB); PG8_STAGE(PG8_SA(0, 0), a2, voffA);
            WAIT_VM(8); WAIT_LGKM(0); S_BARRIER(); PG8_MMA(1, 0, At, B0); PG8_MMA(1, 1, At, B1); S_BARRIER(); SCHED_BARRIER();
            PG8_LDB(B0, 1, 0); PG8_LDB(B1, 1, 1); SCHED_BARRIER(); PG8_LDA(At, 1, 0); PG8_STAGE(PG8_SA(0, 1), a2 + hstep, voffA);
            WAIT_VM(8); WAIT_LGKM(0); S_BARRIER(); PG8_MMA(0, 0, At, B0); PG8_MMA(0, 1, At, B1); S_BARRIER(); SCHED_BARRIER();
            PG8_LDA(At, 1, 1); PG8_STAGE(PG8_SB(1, 0), b3, voffB); PG8_STAGE(PG8_SB(1, 1), b3 + hstep, voffB); PG8_STAGE(PG8_SA(1, 0), a3, voffA);
            WAIT_VM(8); WAIT_LGKM(0); S_BARRIER(); PG8_MMA(1, 0, At, B0); PG8_MMA(1, 1, At, B1); S_BARRIER(); SCHED_BARRIER();
        }
        if (wr == 0) S_BARRIER();
        E(acc, cur, wr, wc, fr, fq);
        if (!has_next) break;
#pragma unroll
        for (int a = 0; a < 2; ++a)
#pragma unroll
            for (int b = 0; b < 2; ++b)
#pragma unroll
                for (int m = 0; m < 4; ++m)
#pragma unroll
                    for (int n = 0; n < 2; ++n) acc[a][b][m][n] = (f32x4){0.f, 0.f, 0.f, 0.f};
        cur = nxt; cA = nA; cB = nB; ++ui;
        if (wr == 1) S_BARRIER();
    }
    WAIT_VM(0);
    S_BARRIER();
#undef PG8_SA
#undef PG8_SB
#undef PG8_STAGE
#undef PG8_LDA
#undef PG8_LDB
#undef PG8_MMA
}

struct PlainOrder {
    const char* A; const char* Bt; int K, nM, nN, nwg, G, c;
    DEV void init(const void* A_, const void* Bt_, int K_, int M, int N, int G_, int c_) { A = (const char*)A_; Bt = (const char*)Bt_; K = K_; nM = M / BM; nN = N / BM; nwg = nM * nN; G = G_; c = c_; }
    DEV bool next(int i, Unit& u) const {
        const long L = (long)i * G + c; if (L >= nwg) return false;
        int wgid = (int)L; { const int q = nwg / 8, r = nwg % 8, xcd = wgid % 8, off = wgid / 8; wgid = (xcd < r ? xcd * (q + 1) : r * (q + 1) + (xcd - r) * q) + off; }
        const int nig = 8 * nN, gid = wgid / nig, fm = gid * 8, gsz = (nM - fm) < 8 ? (nM - fm) : 8;
        u.pm = fm + ((wgid % nig) % gsz); u.pn = (wgid % nig) / gsz; u.e = 0;
        u.A = A + (size_t)u.pm * BM * K * 2; u.B = Bt + (size_t)u.pn * BM * K * 2; return true;
    }
};
struct GroupedOrder {
    const char* A; const char* Bt; int K, nMe, nN, nwg, G, c; size_t bstride;
    DEV void init(const void* A_, const void* Bt_, int K_, int N, int G_, int c_, int erows) { A = (const char*)A_; Bt = (const char*)Bt_; K = K_; nMe = (erows + BM - 1) / BM; nN = N / BM; nwg = NE * nMe * nN; G = G_; c = c_; bstride = (size_t)N * K * 2; }
    DEV bool next(int i, Unit& u) const {
        const long L = (long)i * G + c; if (L >= nwg) return false;
        int wgid = (int)L; { const int q = nwg / 8, r = nwg % 8, xcd = wgid % 8, off = wgid / 8; wgid = (xcd < r ? xcd * (q + 1) : r * (q + 1) + (xcd - r) * q) + off; }
        const int per_e = nMe * nN; const int e = wgid / per_e, w = wgid % per_e;
        u.e = e; u.pm = w % nMe; u.pn = w / nMe;
        u.A = A + ((size_t)e * EPAD + (size_t)u.pm * BM) * K * 2; u.B = Bt + (size_t)e * bstride + (size_t)u.pn * BM * K * 2; return true;
    }
};
}

struct Args { const float* in[N_IN]; float* out; unsigned char* ws; };

struct Frame {
    const float* const* in; GAS float* out; GAS unsigned char* ws; LAS unsigned char* lds;
    int tid, lane, wave, G, bid, gw, NGW;
};

DEV Frame refresh(const Frame& F0) {
    Frame F = F0; int w = F0.wave; LAUNDER_S(w); int ln = lane_id(); LAUNDER(ln);
    F.wave = w; F.lane = ln; F.tid = w * 64 + ln; F.gw = F.bid * NWAVES + w;
    GAS unsigned char* ws = F0.ws; LAUNDER_S(ws); F.ws = ws;
    return F;
}

#define GIN(k) ((const float*)(GAS const float*)F.in[k])

#define ROW_LOOP(r, NROWS) for (int r = F.gw; r < (NROWS); r += F.NGW)

DEV int tok_row(int b, int d, int sp) {
    if (sp < CTX) return LATR + b * CTX + (d ? (CTX - 1 - sp) : sp);
    const int j = sp - CTX; return b * SEQ + (d ? (SEQ - 1 - j) : j);
}
DEV void row_bs(int r, int& b, int& s) { if (r < LATR) { b = r / SEQ; s = CTX + r % SEQ; } else { const int q = r - LATR; b = q / CTX; s = q % CTX; } }

DEV void tr_item(const float* W, int ldw, int col0, int k0, bf16_t* WT, int K, int row0, LAS float* scr, int lane) {
#pragma unroll 8
    for (int i = 0; i < 32; ++i) { const int kk = 2 * i + (lane >> 5); scr[kk * 33 + (lane & 31)] = W[(size_t)(k0 + kk) * ldw + col0 + (lane & 31)]; }
    WAVE_LDS_SYNC();
    const int c = lane & 7;
#pragma unroll
    for (int j = 0; j < 4; ++j) { const int n = (lane >> 3) + 8 * j; const LAS float* s = scr + (8 * c) * 33 + n;
        u32x4 o; o.x = pk2(s[0 * 33], s[1 * 33]); o.y = pk2(s[2 * 33], s[3 * 33]); o.z = pk2(s[4 * 33], s[5 * 33]); o.w = pk2(s[6 * 33], s[7 * 33]);
        *(u32x4*)(WT + (size_t)(row0 + n) * K + k0 + 8 * c) = o; }
    WAVE_LDS_SYNC();
}

DEV void phase_prologue_a(const Frame& F0) {
    const Frame F = refresh(F0);
    LAS float* scr = (LAS float*)(F.lds + F.wave * 16384);
    for (int l = 0; l < DEPTH; ++l) {
        const int odd = l & 1, li = l >> 1;
        const float* win = odd ? GIN(I_ODWIN) + (size_t)li * 1024 * 2576 : GIN(I_EVWIN) + (size_t)li * 1024 * 4112;
        const int ldw = odd ? 2576 : 4112, nin = odd ? NIN_O : NIN_E;
        bf16_t* wint = (bf16_t*)(F.ws + WS_WIN) + (size_t)l * NINMAX * 1024;
        for (int it = F.gw; it < 16 * (nin / 32); it += F.NGW) { const int kb = it / (nin / 32), nb = it % (nin / 32); const int d0 = 32 * nb;
            tr_item(win, ldw, d0 < 2048 ? d0 : d0 + 16, 64 * kb, wint, 1024, d0, scr, F.lane); }
        const float* wout = odd ? GIN(I_ODWOUT) + (size_t)li * 1024 * 1024 : GIN(I_EVWOUT) + (size_t)li * 1024 * 1024;
        bf16_t* woutt = (bf16_t*)(F.ws + WS_WOUT) + (size_t)l * 1024 * 1024;
        for (int it = F.gw; it < 16 * 32; it += F.NGW) { const int kb = it / 32, nb = it % 32; tr_item(wout, 1024, 32 * nb, 64 * kb, woutt, 1024, 32 * nb, scr, F.lane); }
        if (odd) {
            const float* wglu = GIN(I_ODWGLU) + (size_t)li * 512 * 512; bf16_t* wglut = (bf16_t*)(F.ws + WS_WGLU) + (size_t)li * 512 * 512;
            for (int it = F.gw; it < 8 * 16; it += F.NGW) { const int kb = it / 16, nb = it % 16; tr_item(wglu, 512, 32 * nb, 64 * kb, wglut, 512, 32 * nb, scr, F.lane); }
        }
        constexpr int GU_NB = 2 * FF / 32, GU_ITEMS = 16 * GU_NB;
        for (int it = F.gw; it < NE * GU_ITEMS; it += F.NGW) { const int e = it / GU_ITEMS, r = it % GU_ITEMS, kb = r / GU_NB, nb = r % GU_NB; const int d0 = 32 * nb, j = d0 >> 8, w = d0 & 255;
            const float* src = (w < 128 ? GIN(I_WGATE) : GIN(I_WUP)) + ((size_t)l * NE + e) * 1024 * FF;
            tr_item(src, FF, 128 * j + (w & 127), 64 * kb, (bf16_t*)(F.ws + WS_WGU) + ((size_t)l * NE + e) * 2 * FF * 1024, 1024, d0, scr, F.lane); }
        constexpr int D_ITEMS = (FF / 64) * 32;
        for (int it = F.gw; it < NE * D_ITEMS; it += F.NGW) { const int e = it / D_ITEMS, r = it % D_ITEMS, kb = r / 32, nb = r % 32;
            tr_item(GIN(I_WDOWN) + ((size_t)l * NE + e) * FF * 1024, 1024, 32 * nb, 64 * kb, (bf16_t*)(F.ws + WS_WD) + ((size_t)l * NE + e) * 1024 * FF, FF, 32 * nb, scr, F.lane); }
    }
    const int gt = F.bid * NTHREADS + F.tid, NGT = F.G * NTHREADS;
    for (int i = gt; i < DEPTH * 16 * 1024; i += NGT) { const int l = i / 16384, g = (i >> 10) & 15, k = i & 1023; const int odd = l & 1, li = l >> 1;
        ((float*)(F.ws + WS_WG))[i] = odd ? GIN(I_ODWIN)[((size_t)li * 1024 + k) * 2576 + 2048 + g] : GIN(I_EVWIN)[((size_t)li * 1024 + k) * 4112 + 2048 + g]; }
    for (int i = gt; i < DEPTH * NE * 1024; i += NGT) { const int k = i & 1023, e = (i >> 10) % NE, l = i / (NE * 1024); ((float*)(F.ws + WS_WR))[i] = GIN(I_WROUTER)[((size_t)l * 1024 + k) * NE + e]; }
    for (int i = gt; i < N_ODD * 2 * 32 * 64; i += NGT) { const int p = i & 63, g = (i >> 6) & 31, d = (i >> 11) & 1, o = i >> 12;
        const int idx = ((o * 2 + d) * 32 + g) * 64 + p;
        const float lr = fminf(GIN(I_ODLRE)[idx], -1e-4f), li_ = GIN(I_ODLIM)[idx], dt = expf(GIN(I_ODLDT)[(o * 2 + d) * 32 + g]);
        const float mag = expf(lr * dt); float sn, cs; sincosf(li_ * dt, &sn, &cs); const float are = mag * cs, aim = mag * sn;
        float* A = (float*)(F.ws + WS_S5A) + (size_t)((o * 2 + d) * 32 + g) * 128; A[p] = are; A[64 + p] = aim;
        const float xr = are - 1.0f, xi = aim, den = lr * lr + li_ * li_; const float fre = (xr * lr + xi * li_) / den, fim = (xi * lr - xr * li_) / den;
        bf16_t* Bb = (bf16_t*)(F.ws + WS_S5B) + (size_t)((o * 2 + d) * 32 + g) * 128 * 16;
        for (int h = 0; h < 16; ++h) { const float br = GIN(I_ODBRE)[((size_t)(o * 32 + g) * 64 + p) * 16 + h], bi = GIN(I_ODBIM)[((size_t)(o * 32 + g) * 64 + p) * 16 + h];
            Bb[p * 16 + h] = (bf16_t)f2bf(fre * br - fim * bi); Bb[(64 + p) * 16 + h] = (bf16_t)f2bf(fre * bi + fim * br); } }
    for (int i = gt; i < N_ODD * 32 * 16 * 64; i += NGT) { const int p = i & 63, c = (i >> 6) & 15, g = (i >> 10) & 31, o = i >> 15;
        bf16_t* Cm = (bf16_t*)(F.ws + WS_S5C) + (size_t)((o * 32 + g) * 16 + c) * 128;
        Cm[2 * p] = (bf16_t)f2bf(GIN(I_ODCRE)[i]); Cm[2 * p + 1] = (bf16_t)f2bf(-GIN(I_ODCIM)[i]); }
    ROW_LOOP(r, MPAD) {
        f32x4* dst = (f32x4*)((float*)(F.ws + WS_H) + (size_t)r * 1024) + F.lane;
        if (r < MROWS) { int b, s; row_bs(r, b, s); const f32x4* src = (const f32x4*)(s < CTX ? GIN(I_CTX) + ((size_t)b * CTX + s) * 1024 : GIN(I_X) + ((size_t)b * SEQ + (s - CTX)) * 1024) + F.lane;
#pragma unroll
            for (int j = 0; j < 4; ++j) dst[64 * j] = src[64 * j]; }
        else {
#pragma unroll
            for (int j = 0; j < 4; ++j) dst[64 * j] = (f32x4){0.f, 0.f, 0.f, 0.f};
            u32x4* xz = (u32x4*)((bf16_t*)(F.ws + WS_XIN) + (size_t)r * 1024) + F.lane; xz[0] = (u32x4){0u, 0u, 0u, 0u}; xz[64] = (u32x4){0u, 0u, 0u, 0u};
            u32x4* mz = (u32x4*)((bf16_t*)(F.ws + WS_MERGED) + (size_t)r * 1024) + F.lane; mz[0] = (u32x4){0u, 0u, 0u, 0u}; mz[64] = (u32x4){0u, 0u, 0u, 0u};
            u32x4* yz = (u32x4*)((bf16_t*)(F.ws + WS_YS) + (size_t)r * 512) + F.lane; yz[0] = (u32x4){0u, 0u, 0u, 0u};
        }
    }
    __syncthreads();
    LAS float* sv = (LAS float*)F.lds;
    LAS float* part = (LAS float*)(F.lds + 32768);
    for (int i = F.tid; i < NR * 1024; i += NTHREADS) { const int r = i >> 10, k = i & 1023; const float c = r < B_ ? GIN(I_C)[r * 1024 + k] : GIN(I_CCTX)[k]; sv[i] = silu_f(c); }
    __syncthreads();
    for (int it = F.bid; it < DEPTH * 96; it += F.G) {
        const int l = it / 96, j = (it % 96) * 64 + F.lane;
        const float* w = GIN(I_WMOD) + (size_t)l * 1024 * 6144 + j;
        float acc[NR];
#pragma unroll
        for (int r = 0; r < NR; ++r) acc[r] = 0.f;
        const int k0 = F.wave * 128;
#pragma unroll 8
        for (int k = 0; k < 128; ++k) { const float wv = w[(size_t)(k0 + k) * 6144];
#pragma unroll
            for (int r = 0; r < NR; ++r) acc[r] += sv[r * 1024 + k0 + k] * wv; }
#pragma unroll
        for (int r = 0; r < NR; ++r) part[(F.wave * NR + r) * 64 + F.lane] = acc[r];
        __syncthreads();
        for (int i = F.tid; i < NR * 64; i += NTHREADS) { const int r = i >> 6, jj = i & 63; float s = 0.f;
#pragma unroll
            for (int w8 = 0; w8 < 8; ++w8) s += part[(w8 * NR + r) * 64 + jj];
            const int col = (it % 96) * 64 + jj;
            ((float*)(F.ws + WS_MOD))[((size_t)l * NR + r) * 6144 + col] = s + GIN(I_BMOD)[l * 6144 + col]; }
        __syncthreads();
    }
}

static_assert(TOK % 4 == 0 && CTX % 4 == 0 && MROWS % 4 == 0, "row groups");
#define ROW_GROUPS(nrows, CALL4, CALL2) do { const int _r4 = ((nrows) / (4 * F.NGW)) * (4 * F.NGW); \
    for (int r = 4 * F.gw; r < _r4; r += 4 * F.NGW) { CALL4; } for (int r = _r4 + 2 * F.gw; r < (nrows); r += 2 * F.NGW) { CALL2; } } while (0)
template <int RG> DEV void xg_rows(const Frame& F, int l, int row0, f32x4 (&v)[RG][4]) {
    int b, s; row_bs(row0, b, s); const int mr = s < CTX ? B_ : b;
    const float* mod = (const float*)(F.ws + WS_MOD) + ((size_t)l * NR + mr) * 6144;
#pragma unroll
    for (int j = 0; j < 4; ++j) { const f32x4 sh = *((const f32x4*)mod + F.lane + 64 * j), sc = *((const f32x4*)(mod + 1024) + F.lane + 64 * j);
#pragma unroll
        for (int q = 0; q < RG; ++q) v[q][j] = v[q][j] * (1.0f + sc) + sh; }
#pragma unroll
    for (int q = 0; q < RG; ++q) { u32x2* xo = (u32x2*)((bf16_t*)(F.ws + WS_XIN) + (size_t)(row0 + q) * 1024) + F.lane;
#pragma unroll
        for (int j = 0; j < 4; ++j) xo[64 * j] = (u32x2){pk2(v[q][j].x, v[q][j].y), pk2(v[q][j].z, v[q][j].w)}; }
    const float* wg = (const float*)(F.ws + WS_WG) + (size_t)l * 16 * 1024;
    float mine[RG]; const int gi = F.lane & 15;
#pragma unroll
    for (int q = 0; q < RG; ++q) mine[q] = 0.f;
    f32x4 wc[4];
#pragma unroll
    for (int j = 0; j < 4; ++j) wc[j] = *((const f32x4*)wg + F.lane + 64 * j);
#pragma unroll 1
    for (int g = 0; g < 16; ++g) { f32x4 wn[4]; const int gn = g + 1 < 16 ? g + 1 : g;
#pragma unroll
        for (int j = 0; j < 4; ++j) wn[j] = *((const f32x4*)(wg + gn * 1024) + F.lane + 64 * j);
#pragma unroll
        for (int q = 0; q < RG; ++q) { float p = 0.f;
#pragma unroll
            for (int j = 0; j < 4; ++j) p += v[q][j].x * wc[j].x + v[q][j].y * wc[j].y + v[q][j].z * wc[j].z + v[q][j].w * wc[j].w;
            const float t = wave_sum(p); mine[q] = (gi == g) ? t : mine[q]; }
#pragma unroll
        for (int j = 0; j < 4; ++j) wc[j] = wn[j]; }
    const int ty = gi >> 2, hh = gi & 3, li = l >> 1;
#pragma unroll
    for (int q = 0; q < RG; ++q) { float o;
        if (!(l & 1)) {
            if (ty < 2) o = -expf(GIN(I_EVALOG)[(li * 2 + ty) * 4 + hh]) * softplus_f(mine[q] + GIN(I_EVDTB)[(li * 2 + ty) * 4 + hh]);
            else o = sigmoid_f(mine[q]);
        } else {
            const int d = ty & 1, k = ty >> 1; const float gb = GIN(I_ODGB)[((li * 2 + d) * 2 + k) * 4 + hh];
            o = k ? -softplus_f(-(mine[q] + gb)) : mine[q] + gb;
        }
        if (F.lane < 16) ((float*)(F.ws + WS_GATES))[(size_t)(row0 + q) * 16 + gi] = o; }
}

template <int RG> DEV void xg0_group(const Frame& F, int r) {
        f32x4 v[RG][4];
#pragma unroll
        for (int q = 0; q < RG; ++q) { const f32x4* hr = (const f32x4*)((const float*)(F.ws + WS_H) + (size_t)(r + q) * 1024) + F.lane;
#pragma unroll
            for (int j = 0; j < 4; ++j) v[q][j] = hr[64 * j]; }
        xg_rows<RG>(F, 0, r, v);
    }
DEV void phase_xg0(const Frame& F0) {
    const Frame F = refresh(F0);
    ROW_GROUPS(MROWS, xg0_group<4>(F, r), xg0_group<2>(F, r));
}

template <int RG> DEV void prep_group(const Frame& F, int l, int r) {

    const int odd = l & 1, li = l >> 1; const int nin = odd ? NIN_O : NIN_E, nseg = odd ? 2 : 3, qld = odd ? 1024 : 1536;
    const bf16_t* P = (const bf16_t*)(F.ws + WS_P); bf16_t* Q = (bf16_t*)(F.ws + WS_QKV);
    const float* cw = odd ? GIN(I_ODCONV) + (size_t)li * 9 * 1024 : GIN(I_EVCONV) + (size_t)li * 9 * 1536; const int cch = odd ? 1024 : 1536;
    {
        int b, s; row_bs(r, b, s); const bool lat = s >= CTX; const int rr = lat ? (s - CTX) >> 6 : 0, cc = lat ? (s - CTX) & 63 : s;
        const int ncol = lat ? 64 : CTX;
        for (int seg = 0; seg < nseg; ++seg) {
            const int ch0 = seg * 512 + F.lane * 8; float a[RG][8];
#pragma unroll
            for (int q = 0; q < RG; ++q)
#pragma unroll
                for (int i = 0; i < 8; ++i) a[q][i] = 0.f;
#pragma unroll
            for (int kh = 0; kh < 3; ++kh) {
                const int r2 = rr + kh - 1; const bool rok = lat ? (r2 >= 0 && r2 < SEQ / 64) : (kh == 1); const int r2c = rok ? r2 : rr;
                f32x4 w0[3], w1[3];
#pragma unroll
                for (int kw = 0; kw < 3; ++kw) { w0[kw] = *(const f32x4*)(cw + (kh * 3 + kw) * cch + ch0); w1[kw] = *(const f32x4*)(cw + (kh * 3 + kw) * cch + ch0 + 4); }
                const int rowbase = lat ? b * SEQ + r2c * 64 : LATR + b * CTX;
                u32x4 pv[RG + 2];
#pragma unroll
                for (int dc = 0; dc < RG + 2; ++dc) { const int c2 = cc - 1 + dc; const bool ok = rok && c2 >= 0 && c2 < ncol; const int c2c = ok ? c2 : cc;
                    const u32x4 t4 = *(const u32x4*)(P + (size_t)(rowbase + c2c) * nin + ch0); pv[dc] = ok ? t4 : (u32x4){0u, 0u, 0u, 0u}; }
#pragma unroll
                for (int dc = 0; dc < RG + 2; ++dc) {
                    const float x0 = bflo(pv[dc].x), x1 = bfhi(pv[dc].x), x2 = bflo(pv[dc].y), x3 = bfhi(pv[dc].y), x4 = bflo(pv[dc].z), x5 = bfhi(pv[dc].z), x6 = bflo(pv[dc].w), x7 = bfhi(pv[dc].w);
#pragma unroll
                    for (int q = 0; q < RG; ++q) { const int kw = dc - q;
                        if (kw >= 0 && kw <= 2) { a[q][0] += x0 * w0[kw].x; a[q][1] += x1 * w0[kw].y; a[q][2] += x2 * w0[kw].z; a[q][3] += x3 * w0[kw].w;
                            a[q][4] += x4 * w1[kw].x; a[q][5] += x5 * w1[kw].y; a[q][6] += x6 * w1[kw].z; a[q][7] += x7 * w1[kw].w; } } }
            }
#pragma unroll
            for (int q = 0; q < RG; ++q) {
                float ss = 0.f;
#pragma unroll
                for (int i = 0; i < 8; ++i) { a[q][i] = silu_f(a[q][i]); ss += a[q][i] * a[q][i]; }
                float sc = 1.0f;
                if (!odd) { if (seg < 2) { ss = group_sum<16>(ss); sc = 1.0f / sqrtf(ss + 1e-6f); if (seg == 0) sc *= HD_SCALE; } }
                else if (seg == 1) sc = HD_SCALE;
                u32x4 o; o.x = pk2(a[q][0] * sc, a[q][1] * sc); o.y = pk2(a[q][2] * sc, a[q][3] * sc); o.z = pk2(a[q][4] * sc, a[q][5] * sc); o.w = pk2(a[q][6] * sc, a[q][7] * sc);
                *(u32x4*)(Q + (size_t)(r + q) * qld + ch0) = o;
            }
        }
    }
}
DEV void phase_prep(const Frame& F0, int l) {
    const Frame F = refresh(F0);
    const int odd = l & 1;
    ROW_GROUPS(MROWS, prep_group<4>(F, l, r), prep_group<2>(F, l, r));

    if (odd) {
        const float* GT = (const float*)(F.ws + WS_GATES); float* MC = (float*)(F.ws + WS_MCH);
        for (int c = F.gw; c < B_ * 4 * 2; c += F.NGW) { const int d = c & 1, hh = (c >> 1) & 3, b = c >> 3; float m = 0.f;
            for (int n = 0; n < NCH; ++n) { const int row = tok_row(b, d, n * 64 + F.lane);
                const float lin = GT[(size_t)row * 16 + d * 4 + hh], lf = GT[(size_t)row * 16 + 8 + d * 4 + hh];
                const float bc = wave_scan_add(lf);
                const float bend = bcast_lane_f(bc, 63); const float amax = wave_max(bend - bc + lin);
                if (F.lane == 0) MC[(size_t)c * NCH + n] = m;
                m = fmaxf(bend + m, amax); }
        }
    }
}

DEV int swz256(int r, int k) { return r * 256 + 16 * (k ^ (r & 15)); }
DEV int swz128(int r, int k) { return r * 128 + 16 * (k ^ ((r >> 1) & 7)); }
constexpr int CL_IMG = 90112;
struct ClProb { int n, d, hh, b, kind, qld, vld; const bf16_t *qsrc, *ksrc, *vsrc; float kscale; };
DEV ClProb cl_decode(const Frame& F, int p, int odd, int nhh) {
    ClProb c; c.n = p % NCH; c.d = (p / NCH) & 1; c.hh = (p / (2 * NCH)) % nhh; c.b = p / (2 * NCH * nhh); c.kind = odd ? 2 : (c.hh < 4 ? 0 : 1); c.kscale = 1.0f;
    const bf16_t* P = (const bf16_t*)(F.ws + WS_P); const bf16_t* Q = (const bf16_t*)(F.ws + WS_QKV);
    if (c.kind == 0) { c.qsrc = Q + c.hh * 128; c.ksrc = Q + 512 + c.hh * 128; c.vsrc = Q + 1024 + c.hh * 128; c.qld = 1536; c.vld = 1536; }
    else if (c.kind == 1) { c.qsrc = P + 2048 + (c.hh - 4) * 128; c.ksrc = P + 2560 + (c.hh - 4) * 128; c.vsrc = P + 3072 + (c.hh - 4) * 128; c.qld = NIN_E; c.vld = NIN_E; c.kscale = HD_SCALE; }
    else { c.qsrc = Q + c.hh * 128; c.ksrc = Q + 512 + c.hh * 128; c.vsrc = P + 1024 + c.hh * 128; c.qld = 1024; c.vld = NIN_O; }
    return c;
}
DEV void cl_dma(const Frame& F, const ClProb c) {
    int ln = F.lane; LAUNDER(ln);
    const int r0 = tok_row(c.b, c.d, c.n * 64), sg = c.d ? -1 : 1; const int per = c.kind == 0 ? 6 : 4;
#pragma unroll
    for (int i = 0; i < 6; ++i) if (i < per) { const int ch = F.wave * per + i, reg = ch >> 4, cc = ch & 15, r = 4 * cc + (ln >> 4), kk = (ln & 15) ^ (r & 15);
        const bf16_t* src = reg == 0 ? c.qsrc : (reg == 1 ? c.ksrc : c.vsrc); const int ld = reg == 2 ? c.vld : c.qld;
        glds16((const GAS char*)(src + (size_t)(r0 + sg * r) * ld + 8 * kk), F.lds + CL_IMG + reg * 16384 + 1024 * cc); }
}
DEV void seq_s5_item(const Frame& F, int l, int item, int which);
DEV void phase_cl(const Frame& F0, int l) {
    const Frame F = refresh(F0);
    const int odd = l & 1; const int nhh = odd ? 4 : 8; const int nprob = B_ * nhh * 2 * NCH;
    if (odd) {
        for (int it = F.bid; it < B_ * 2 * 32; it += F.G) { seq_s5_item(F, l, it, 0); __syncthreads(); }
    }
    LAS float* gc = (LAS float*)(F.lds);
    LAS float* bt = (LAS float*)(F.lds + 256);
    LAS float* qs = (LAS float*)(F.lds + 768);
    LAS float* ks = (LAS float*)(F.lds + 1024);
    LAS float* mt = (LAS float*)(F.lds + 1280);
    LAS float* rsp = (LAS float*)(F.lds + 2048);
    LAS float* Am = (LAS float*)(F.lds + 4096);
    LAS bf16_t* An = (LAS bf16_t*)(F.lds + 20480);
    LAS bf16_t* XT = (LAS bf16_t*)(F.lds + 30720);
    LAS float* Rb = (LAS float*)(F.lds + 69632 + F.wave * 2048);
    LAS float* ksp = (LAS float*)(F.lds + 86016);
    LAS unsigned char* IQ = F.lds + CL_IMG; LAS unsigned char* IK = IQ + 16384; LAS unsigned char* IV = IQ + 32768;
    const float* GT = (const float*)(F.ws + WS_GATES);
    float gq = 0.f, bq = 0.f, mq = 0.f;
#define CL_GATES(pp) do { const ClProb cn = cl_decode(F, (pp), odd, nhh); const int rown = tok_row(cn.b, cn.d, cn.n * 64 + F.lane); \
        if (cn.kind == 0) { gq = GT[(size_t)rown * 16 + cn.d * 4 + cn.hh]; bq = GT[(size_t)rown * 16 + 8 + cn.d * 4 + cn.hh]; } \
        else if (cn.kind == 2) { bq = GT[(size_t)rown * 16 + cn.d * 4 + cn.hh]; gq = GT[(size_t)rown * 16 + 8 + cn.d * 4 + cn.hh]; \
            mq = ((const float*)(F.ws + WS_MCH))[(size_t)((cn.b * 4 + cn.hh) * 2 + cn.d) * NCH + cn.n]; } } while (0)
    if (F.bid < nprob) { cl_dma(F, cl_decode(F, F.bid, odd, nhh)); if (F.wave == 0) CL_GATES(F.bid); }
    for (int p = F.bid; p < nprob; p += F.G) {
        int lz = F.lane; LAUNDER(lz); const int h = lz >> 5, l31 = lz & 31;
        const ClProb c = cl_decode(F, p, odd, nhh); const int n = c.n, d = c.d, hh = c.hh, b = c.b, kind = c.kind; const float kscale = c.kscale;
        float* CS = (float*)(F.ws + WS_CLS) + (size_t)p * 512;
        if (F.wave == 0) {
            const int i = F.lane;
            float g = gq, be = bq;
            if (kind == 1) { g = log1pf(-exp2f(-(5.0f + 2.0f * (float)(hh - 4) + (float)d))); be = 0.f; }
            const float cum = wave_scan_add(g);
            const float gend = bcast_lane_f(cum, 63);
            gc[i] = cum; bt[i] = be;
            if (kind < 2) { qs[i] = expf(cum); ks[i] = expf(gend - cum) * kscale; if (i == 0) CS[0] = expf(gend); }
            else {
                const float mprev = mq;
                const float a = gend - cum + be; const float amax = wave_max(a); const float mnew = fmaxf(gend + mprev, amax);
                ks[i] = expf(a - mnew);
                const float pm = wave_scan_max(be - cum);
                const float mti = cum + fmaxf(mprev, pm); mt[i] = mti; qs[i] = expf(cum + mprev - mti);
                CS[128 + i] = expf(-mti);
                if (i == 0) CS[0] = expf(gend + mprev - mnew);
            }
        }
        WAIT_VM(0);
        __syncthreads();
        {
            const int w4 = F.wave & 3, mt_ = w4 >> 1, nt_ = w4 & 1; const bool doY = F.wave >= 4;
            if (!doY || kind == 0) {
                const int rj = 32 * mt_ + l31, ri = 32 * nt_ + l31; LAS unsigned char* IB = doY ? IK : IQ;
                f32x16 acc;
#pragma unroll
                for (int r = 0; r < 16; ++r) acc[r] = 0.f;
                bf16x8 af[8], bfr[8];
#pragma unroll
                for (int s = 0; s < 8; ++s) { af[s] = *(const LAS bf16x8*)(IK + swz256(rj, 2 * s + h)); bfr[s] = *(const LAS bf16x8*)(IB + swz256(ri, 2 * s + h)); }
#pragma unroll
                for (int s = 0; s < 8; ++s) acc = mfma32(af[s], bfr[s], acc);
                const int i = ri; const float gi = gc[i];
                if (!doY) {
                    bf16_t* AQ = (bf16_t*)(F.ws + WS_CLA) + (size_t)p * 4096 + (size_t)i * 64; float rsum = 0.f; const float mti = kind == 2 ? mt[i] : 0.f;
#pragma unroll
                    for (int g4 = 0; g4 < 4; ++g4) { float v[4];
#pragma unroll
                        for (int r = 0; r < 4; ++r) { const int j = 32 * mt_ + 8 * g4 + 4 * h + r; float e;
                            if (kind < 2) e = expf(fminf(gi - gc[j], 0.f)); else e = expf(gi - gc[j] + bt[j] - mti);
                            v[r] = (i >= j) ? acc[4 * g4 + r] * kscale * e : 0.f; rsum += v[r]; }
                        *(u32x2*)(AQ + 32 * mt_ + 8 * g4 + 4 * h) = (u32x2){pk2(v[0], v[1]), pk2(v[2], v[3])}; }
                    if (kind == 2) rsp[i * 4 + mt_ * 2 + h] = rsum;
                } else {
                    const float bi = bt[i];
#pragma unroll
                    for (int r = 0; r < 16; ++r) { const int j = 32 * mt_ + 8 * (r >> 2) + 4 * h + (r & 3);
                        const float av = (i > j) ? bi * acc[r] * expf(fminf(gi - gc[j], 0.f)) : 0.f;
                        Am[i * 64 + j] = av; An[i * 72 + j] = (bf16_t)f2bf(-av); }
                }
            }
        }
        __syncthreads();
        int lz2 = F.lane; LAUNDER(lz2); const int l15 = lz2 & 15, kg = lz2 >> 4; const bool isw = F.wave >= 4;
        float rhsv[4][2][4];
        {
            const int tz = F.wave * 64 + lz2; const int cq = tz & 127, q4 = tz >> 7; bf16_t* QD = (bf16_t*)(F.ws + WS_CLQ) + (size_t)p * 8192 + cq;
            for (int i = 16 * q4; i < 16 * q4 + 16; ++i) QD[i * 128] = (bf16_t)f2bf(bf2f(*(const LAS bf16_t*)(IQ + swz256(i, cq >> 3) + 2 * (cq & 7))) * qs[i]);
            bf16_t* KT = (bf16_t*)(F.ws + WS_CLK) + (size_t)p * 8192 + (size_t)cq * 64;
            float ksum = 0.f;
            for (int j8 = 2 * q4; j8 < 2 * q4 + 2; ++j8) { float v[8];
#pragma unroll
                for (int r = 0; r < 8; ++r) { const int j = 8 * j8 + r; v[r] = bf2f(*(const LAS bf16_t*)(IK + swz256(j, cq >> 3) + 2 * (cq & 7))) * ks[j]; ksum += v[r]; }
                *(u32x4*)(KT + 8 * j8) = (u32x4){pk2(v[0], v[1]), pk2(v[2], v[3]), pk2(v[4], v[5]), pk2(v[6], v[7])}; }
            ksp[cq * 4 + q4] = ksum;
            if (kind == 2 && tz < 64) CS[64 + tz] = (rsp[tz * 4] + rsp[tz * 4 + 1]) + (rsp[tz * 4 + 2] + rsp[tz * 4 + 3]);
            if (kind == 0) { LAS unsigned char* IS = isw ? IK : IV;
#pragma unroll
                for (int bb = 0; bb < 4; ++bb)
#pragma unroll
                    for (int nt2 = 0; nt2 < 2; ++nt2)
#pragma unroll
                        for (int r = 0; r < 4; ++r) { const int i = 16 * bb + 4 * kg + r, cc = (32 * F.wave + 16 * nt2 + l15) & 127;
                            rhsv[bb][nt2][r] = bt[i] * bf2f(*(const LAS bf16_t*)(IS + swz256(i, cc >> 3) + 2 * (cc & 7))) * (isw ? qs[i] : 1.0f); } }
        }
        __syncthreads();
        if (p + F.G < nprob) { cl_dma(F, cl_decode(F, p + F.G, odd, nhh)); if (F.wave == 0) CL_GATES(p + F.G); }
        if (kind == 2 && F.tid < 128) CS[256 + F.tid] = (ksp[F.tid * 4] + ksp[F.tid * 4 + 1]) + (ksp[F.tid * 4 + 2] + ksp[F.tid * 4 + 3]);
        if (kind == 0) {
            const int pg = ((b * 4 + hh) * 2 + d) * NCH + n;
            float* U = (float*)(F.ws + WS_CLU) + (size_t)pg * 8192; bf16_t* W = (bf16_t*)(F.ws + WS_CLW) + (size_t)p * 8192;
#pragma unroll
            for (int bb = 0; bb < 4; ++bb) {
#pragma unroll
                for (int nt2 = 0; nt2 < 2; ++nt2) {
                    const int cidx = 32 * F.wave + 16 * nt2 + l15; f32x4 acc;
#pragma unroll
                    for (int r = 0; r < 4; ++r) acc[r] = rhsv[bb][nt2][r];
                    for (int k2 = 0; k2 < 2; ++k2) if (32 * k2 < 16 * bb) {
                        const bool in = 32 * k2 + 8 * kg + 8 <= 16 * bb;
                        bf16x8 a = *(const LAS bf16x8*)(An + (16 * bb + l15) * 72 + 32 * k2 + 8 * kg); if (!in) a = (bf16x8){0, 0, 0, 0, 0, 0, 0, 0};
                        const bf16x8 xb = *(const LAS bf16x8*)(XT + cidx * 72 + 32 * k2 + 8 * kg);
                        acc = mfma16(a, in ? xb : (bf16x8){0, 0, 0, 0, 0, 0, 0, 0}, acc); }
#pragma unroll
                    for (int r = 0; r < 4; ++r) Rb[(4 * kg + r) * 32 + 16 * nt2 + l15] = acc[r];
                }
                WAVE_LDS_SYNC();
                if (F.lane < 32) {
                    const int cidx = 32 * F.wave + F.lane; float x[16];
#pragma unroll
                    for (int i = 0; i < 16; ++i) { float r = Rb[i * 32 + F.lane];
#pragma unroll
                        for (int j = 0; j < i; ++j) r -= Am[(16 * bb + i) * 64 + 16 * bb + j] * x[j];
                        x[i] = r; }
                    if (!isw) {
#pragma unroll
                        for (int i = 0; i < 16; ++i) U[(16 * bb + i) * 128 + cidx] = x[i]; }
                    else {
#pragma unroll
                        for (int i = 0; i < 16; ++i) W[(16 * bb + i) * 128 + (cidx - 128)] = (bf16_t)f2bf(-x[i]); }
                    *(LAS u32x4*)(XT + cidx * 72 + 16 * bb) = (u32x4){pk2(x[0], x[1]), pk2(x[2], x[3]), pk2(x[4], x[5]), pk2(x[6], x[7])};
                    *(LAS u32x4*)(XT + cidx * 72 + 16 * bb + 8) = (u32x4){pk2(x[8], x[9]), pk2(x[10], x[11]), pk2(x[12], x[13]), pk2(x[14], x[15])};
                }
                WAVE_LDS_SYNC();
            }
        }
    }
    WAIT_VM(0);
    __syncthreads();
}

#define LDS_BARRIER() do { WAIT_LGKM(0); S_BARRIER(); COMPILER_FENCE(); } while (0)
constexpr int SQ_W = 0, SQ_Q = 16384, SQ_K = 32768, SQ_A = 49152, SQ_U = 57344, SQ_C = 65536, SQ_STAGE = 67584;
constexpr int SQ_SB = 2 * SQ_STAGE, SQ_VN = SQ_SB + 8704, SQ_NV = SQ_VN + 4608, SQ_DEN = SQ_NV + 512;
static_assert(SQ_DEN + 256 <= LDS_MISC, "SEQ LDS map");
struct SeqCtx { int kind, b, hh, d, sl, chain, vld; const GAS bf16_t* vsrc; int probe; };
template <int KIND>
DEV void seq_dma(const Frame& F, const SeqCtx& C, int n, LAS unsigned char* img) {
    const int p = C.chain * NCH + n, w = F.wave; int ln = F.lane; LAUNDER(ln);
    if (w < 2) {
        if (KIND == 0) { const GAS char* g = (const GAS char*)(F.ws + WS_CLW) + (size_t)p * 16384; LAUNDER_S(g);
#pragma unroll
            for (int i = 0; i < 8; ++i) { const int r = 4 * (8 * w + i) + (ln >> 4), pp = ln & 15; glds16(g + r * 256 + 16 * (pp ^ (r & 15)), img + SQ_W + 1024 * (8 * w + i)); } }
    } else if (w < 4) {
        const GAS char* g = (const GAS char*)(F.ws + WS_CLQ) + (size_t)p * 16384; LAUNDER_S(g);
#pragma unroll
        for (int i = 0; i < 8; ++i) { const int c = 8 * (w - 2) + i, r = 4 * c + (ln >> 4), pp = ln & 15; glds16(g + r * 256 + 16 * (pp ^ (r & 15)), img + SQ_Q + 1024 * c); }
    } else if (w < 6) {
        const GAS char* g = (const GAS char*)(F.ws + WS_CLK) + (size_t)p * 16384; LAUNDER_S(g);
#pragma unroll
        for (int i = 0; i < 8; ++i) { const int c = 8 * (w - 4) + i, r = 8 * c + (ln >> 3), pp = ln & 7; glds16(g + r * 128 + 16 * (pp ^ ((r >> 1) & 7)), img + SQ_K + 1024 * c); }
    } else if (w == 6) {
        const GAS char* g = (const GAS char*)(F.ws + WS_CLA) + (size_t)p * 8192; LAUNDER_S(g);
#pragma unroll
        for (int i = 0; i < 8; ++i) { const int r = 8 * i + (ln >> 3), pp = ln & 7; glds16(g + r * 128 + 16 * (pp ^ ((r >> 1) & 7)), img + SQ_A + 1024 * i); }
    } else {
        if (KIND == 0) { const int pg = ((C.b * 4 + C.hh) * 2 + C.d) * NCH + n; const GAS char* g = (const GAS char*)(F.ws + WS_CLU) + (size_t)pg * 32768 + 128 * C.sl; LAUNDER_S(g);
#pragma unroll
            for (int i = 0; i < 8; ++i) { const int r = 8 * i + (ln >> 3); glds16(g + r * 512 + 16 * (ln & 7), img + SQ_U + 1024 * i); }
        } else { const int r0 = tok_row(C.b, C.d, n * 64); const long st = C.d ? -(long)C.vld * 2 : (long)C.vld * 2;
            const GAS char* g = (const GAS char*)C.vsrc + (long)r0 * C.vld * 2 + 64 * C.sl; LAUNDER_S(g);
#pragma unroll
            for (int i = 0; i < 4; ++i) { const int r = 16 * i + (ln >> 2); glds16(g + (long)r * st + 16 * (ln & 3), img + SQ_U + 1024 * i); }
        }
        const GAS char* cs = (const GAS char*)(F.ws + WS_CLS) + (size_t)p * 2048; LAUNDER_S(cs);
        glds16(cs + 16 * ln, img + SQ_C);
        if (KIND == 2) glds16(cs + 1024 + 16 * ln, img + SQ_C + 1024);
    }
}
#define SEQ_WAIT_DMA(younger) do { if ((younger) == 16) WAIT_VM(16); else WAIT_VM(0); } while (0)
template <int KIND>
DEV void seq_step(const Frame& F, const SeqCtx& C, int n, f32x16& acc, LAS unsigned char* lds) {
    int lz = F.lane; LAUNDER(lz); const int h = lz >> 5, l31 = lz & 31;
    LAS unsigned char* img = lds + (n & 1) * SQ_STAGE; LAS unsigned char* nimg = lds + ((n + 1) & 1) * SQ_STAGE;
    LAS bf16_t* Sb = (LAS bf16_t*)(lds + SQ_SB); LAS bf16_t* Vn = (LAS bf16_t*)(lds + SQ_VN); LAS float* nvec = (LAS float*)(lds + SQ_NV); LAS float* den = (LAS float*)(lds + SQ_DEN);
    const LAS float* CS = (const LAS float*)(img + SQ_C);
    if (C.probe != 3) seq_dma<KIND>(F, C, C.probe == 2 ? 0 : (n + 1 < NCH ? n + 1 : NCH - 1), nimg);
    if (F.wave < 2) {
        const int mt_ = F.wave;
        if (KIND == 0) {
#pragma unroll
            for (int r = 0; r < 16; ++r) acc[r] = *(const LAS float*)(img + SQ_U + (32 * mt_ + 8 * (r >> 2) + 4 * h + (r & 3)) * 128 + 4 * l31);
            bf16x8 sb[8], wf[8]; const int rr = 32 * mt_ + l31;
#pragma unroll
            for (int s = 0; s < 8; ++s) { sb[s] = *(const LAS bf16x8*)(Sb + l31 * 136 + 16 * s + 8 * h); wf[s] = *(const LAS bf16x8*)(img + SQ_W + swz256(rr, 2 * s + h)); }
#pragma unroll
            for (int s = 0; s < 8; ++s) acc = mfma32(wf[s], sb[s], acc);
        } else {
#pragma unroll
            for (int r = 0; r < 16; ++r) acc[r] = bf2f(*(const LAS bf16_t*)(img + SQ_U + (32 * mt_ + 8 * (r >> 2) + 4 * h + (r & 3)) * 64 + 2 * l31));
        }
#pragma unroll
        for (int g4 = 0; g4 < 4; ++g4) *(LAS u32x2*)(Vn + l31 * 72 + 32 * mt_ + 8 * g4 + 4 * h) = (u32x2){pk2(acc[4 * g4], acc[4 * g4 + 1]), pk2(acc[4 * g4 + 2], acc[4 * g4 + 3])};
    } else if (F.wave < 4) {
        const int rr = 32 * (F.wave - 2) + l31;
#pragma unroll
        for (int r = 0; r < 16; ++r) acc[r] = 0.f;
        bf16x8 sb[8], qf[8];
#pragma unroll
        for (int s = 0; s < 8; ++s) { sb[s] = *(const LAS bf16x8*)(Sb + l31 * 136 + 16 * s + 8 * h); qf[s] = *(const LAS bf16x8*)(img + SQ_Q + swz256(rr, 2 * s + h)); }
#pragma unroll
        for (int s = 0; s < 8; ++s) acc = mfma32(qf[s], sb[s], acc);
    } else if (KIND == 2) {
        const int t = F.tid - 256, i = t >> 2, q = t & 3; float s = 0.f;
#pragma unroll
        for (int c8 = 0; c8 < 4; ++c8) { const u32x4 w = *(const LAS u32x4*)(img + SQ_Q + swz256(i, 4 * q + c8)); const LAS float* nv = nvec + 32 * q + 8 * c8;
            s += bflo(w.x) * nv[0] + bfhi(w.x) * nv[1] + bflo(w.y) * nv[2] + bfhi(w.y) * nv[3] + bflo(w.z) * nv[4] + bfhi(w.z) * nv[5] + bflo(w.w) * nv[6] + bfhi(w.w) * nv[7]; }
        s = group_sum<4>(s);
        if (q == 0) den[i] = fmaxf(fabsf(CS[64 + i] + s), CS[128 + i]);
    }
    LDS_BARRIER();
    if (F.wave >= 2 && F.wave < 4) {
        const int mt_ = F.wave - 2, rr = 32 * mt_ + l31;
        bf16x8 vb[4], af[4];
#pragma unroll
        for (int s = 0; s < 4; ++s) { vb[s] = *(const LAS bf16x8*)(Vn + l31 * 72 + 16 * s + 8 * h); af[s] = *(const LAS bf16x8*)(img + SQ_A + swz128(rr, 2 * s + h)); }
#pragma unroll
        for (int s = 0; s < 4; ++s) acc = mfma32(af[s], vb[s], acc);
        const int r0 = tok_row(C.b, C.d, n * 64); const long st = C.d ? -2048l : 2048l;
        GAS char* Ob = (GAS char*)(F.ws + WS_O) + ((size_t)C.d * MROWS + r0) * 2048 + (long)(32 * mt_) * st; LAUNDER_S(Ob); const long lo = (long)(4 * h) * st + (long)((C.hh * 128 + 32 * C.sl + l31) * 2);
#pragma unroll
        for (int r = 0; r < 16; ++r) { const int i = 32 * mt_ + 8 * (r >> 2) + 4 * h + (r & 3); float v = acc[r];
            if (KIND == 2) v = v / den[i];
            if (!C.probe) *(GAS bf16_t*)(Ob + (long)(8 * (r >> 2) + (r & 3)) * st + lo) = (bf16_t)f2bf(v); }
        SEQ_WAIT_DMA(16);
    } else if (F.wave >= 4) {
        const int kb = F.wave - 4, rr = 32 * kb + l31; const float ge = CS[0];
        bf16x8 vb[4], kf[4];
#pragma unroll
        for (int s = 0; s < 4; ++s) { vb[s] = *(const LAS bf16x8*)(Vn + l31 * 72 + 16 * s + 8 * h); kf[s] = *(const LAS bf16x8*)(img + SQ_K + swz128(rr, 2 * s + h)); }
#pragma unroll
        for (int r = 0; r < 16; ++r) acc[r] *= ge;
#pragma unroll
        for (int s = 0; s < 4; ++s) acc = mfma32(kf[s], vb[s], acc);
#pragma unroll
        for (int g4 = 0; g4 < 4; ++g4) *(LAS u32x2*)(Sb + l31 * 136 + 32 * kb + 8 * g4 + 4 * h) = (u32x2){pk2(acc[4 * g4], acc[4 * g4 + 1]), pk2(acc[4 * g4 + 2], acc[4 * g4 + 3])};
        if (KIND == 2 && F.tid < 256 + 128) { const int dd = F.tid - 256; nvec[dd] = ge * nvec[dd] + CS[256 + dd]; }
        SEQ_WAIT_DMA(0);
    } else SEQ_WAIT_DMA(0);
    LDS_BARRIER();
}
template <int KIND>
DEV void seq_kind_loop(const Frame& F, const SeqCtx& C, LAS unsigned char* lds) {
    f32x16 acc;
#pragma unroll
    for (int r = 0; r < 16; ++r) acc[r] = 0.f;
    seq_dma<KIND>(F, C, 0, lds);
    WAIT_VM(0);
    LDS_BARRIER();
    for (int n = 0; n < NCH; ++n) seq_step<KIND>(F, C, n, acc, lds);
}
DEV void seq_linear_item(const Frame& F, int l, int item, int probe = 0) {
    const int odd = l & 1, nhh = odd ? 4 : 8;
    SeqCtx C; C.probe = probe; C.sl = item & 3; C.chain = item >> 2; C.d = C.chain & 1; C.hh = (C.chain >> 1) % nhh; C.b = C.chain / (2 * nhh);
    C.kind = odd ? 2 : (C.hh < 4 ? 0 : 1);
    const GAS bf16_t* P = (const GAS bf16_t*)(F.ws + WS_P); const GAS bf16_t* Q = (const GAS bf16_t*)(F.ws + WS_QKV);
    if (C.kind == 0) { C.vsrc = Q + 1024 + C.hh * 128; C.vld = 1536; } else if (C.kind == 1) { C.vsrc = P + 3072 + (C.hh - 4) * 128; C.vld = NIN_E; } else { C.vsrc = P + 1024 + C.hh * 128; C.vld = NIN_O; }
    for (int i = F.tid; i < 32 * 136 / 2; i += NTHREADS) ((LAS unsigned*)(F.lds + SQ_SB))[i] = 0u;
    if (F.tid < 128) ((LAS float*)(F.lds + SQ_NV))[F.tid] = 0.f;
    __syncthreads();
    if (C.kind == 0) seq_kind_loop<0>(F, C, F.lds); else if (C.kind == 1) seq_kind_loop<1>(F, C, F.lds); else seq_kind_loop<2>(F, C, F.lds);
    WAIT_VM(0);
}

DEV void seq_s5_item(const Frame& F, int l, int item, int which) {
    const int o = l >> 1; const int g = item & 31, d = (item >> 5) & 1, b = item >> 6;
    LAS float* El = (LAS float*)(F.lds);
    LAS unsigned char* wl = F.lds + 36864 + F.wave * 14336;
    LAS float* scr = (LAS float*)wl; LAS bf16_t* hb = (LAS bf16_t*)(wl + 10240);
    const bf16_t* P = (const bf16_t*)(F.ws + WS_P);
    const float* Ab = (const float*)(F.ws + WS_S5A) + (size_t)((o * 2 + d) * 32 + g) * 128;
    const bf16_t* Bb = (const bf16_t*)(F.ws + WS_S5B) + (size_t)((o * 2 + d) * 32 + g) * 128 * 16;
    const bf16_t* Cm = (const bf16_t*)(F.ws + WS_S5C) + (size_t)(o * 32 + g) * 16 * 128;
    const int l15 = F.lane & 15, kg = F.lane >> 4;
    const float ar = Ab[F.lane], ai = Ab[64 + F.lane];
    bf16x8 bB[8], cB[4]; const bf16x8 zero8 = (bf16x8){0, 0, 0, 0, 0, 0, 0, 0};
#pragma unroll
    for (int ct = 0; ct < 8; ++ct) bB[ct] = kg < 2 ? *(const bf16x8*)(Bb + (size_t)(16 * ct + l15) * 16 + 8 * kg) : zero8;
#pragma unroll
    for (int s = 0; s < 4; ++s) cB[s] = *(const bf16x8*)(Cm + (size_t)l15 * 128 + 32 * s + 8 * kg);
    bf16_t* Obase = (bf16_t*)(F.ws + WS_O) + (size_t)d * MROWS * 1024 + 512 + 16 * g;
    float* SE = (float*)(F.ws + WS_S5E) + (size_t)item * NCH * 128;
    if (which == 1) { for (int i = F.tid; i < NCH * 128; i += NTHREADS) El[i] = SE[i]; __syncthreads(); }
    for (int pass = which; pass < which + 1; ++pass) {
        bf16x8 an[4];
#pragma unroll
        for (int st = 0; st < 4; ++st) an[st] = kg < 2 ? *(const bf16x8*)(P + (size_t)tok_row(b, d, F.wave * 64 + 16 * st + l15) * NIN_O + 2048 + 16 * g + 8 * kg) : zero8;
        for (int n = F.wave; n < NCH; n += NWAVES) {
            float hr = 0.f, hi = 0.f;
            if (pass) { hr = El[n * 128 + F.lane]; hi = El[n * 128 + 64 + F.lane]; }
            bf16x8 ac[4];
#pragma unroll
            for (int st = 0; st < 4; ++st) ac[st] = an[st];
            { const int nn = n + NWAVES < NCH ? n + NWAVES : n;
#pragma unroll
              for (int st = 0; st < 4; ++st) an[st] = kg < 2 ? *(const bf16x8*)(P + (size_t)tok_row(b, d, nn * 64 + 16 * st + l15) * NIN_O + 2048 + 16 * g + 8 * kg) : zero8; }
            const int r0 = tok_row(b, d, n * 64); const int sg = d ? -1 : 1;
#pragma unroll
            for (int st = 0; st < 4; ++st) {
#pragma unroll
                for (int ct = 0; ct < 8; ++ct) { f32x4 acc = (f32x4){0.f, 0.f, 0.f, 0.f}; acc = mfma16(ac[st], bB[ct], acc);
                    *(LAS f32x4*)(scr + (ct >> 2) * 1280 + (16 * (ct & 3) + l15) * 20 + 4 * kg) = acc; }
                WAVE_LDS_SYNC();
                f32x4 br[4], bi[4];
#pragma unroll
                for (int q = 0; q < 4; ++q) { br[q] = *(const LAS f32x4*)(scr + F.lane * 20 + 4 * q); bi[q] = *(const LAS f32x4*)(scr + 1280 + F.lane * 20 + 4 * q); }
#pragma unroll
                for (int t = 0; t < 16; ++t) { const float nr = ar * hr - ai * hi + br[t >> 2][t & 3], ni = ar * hi + ai * hr + bi[t >> 2][t & 3]; hr = nr; hi = ni;
                    if (pass) *(LAS unsigned*)(hb + t * 128 + 2 * F.lane) = pk2(hr, hi); }
                WAVE_LDS_SYNC();
                if (pass) { f32x4 acc = (f32x4){0.f, 0.f, 0.f, 0.f};
#pragma unroll
                    for (int s = 0; s < 4; ++s) { const bf16x8 ha = *(const LAS bf16x8*)(hb + l15 * 128 + 32 * s + 8 * kg); acc = mfma16(ha, cB[s], acc); }
#pragma unroll
                    for (int r = 0; r < 4; ++r) Obase[(size_t)(r0 + sg * (16 * st + 4 * kg + r)) * 1024 + l15] = (bf16_t)f2bf(acc[r]);
                    WAVE_LDS_SYNC(); }
            }
            if (!pass) { El[n * 128 + F.lane] = hr; El[n * 128 + 64 + F.lane] = hi; }
        }
        __syncthreads();
        if (!pass) {
            if (F.wave == 0) { float pr = ar, pi = ai;
#pragma unroll
                for (int q = 0; q < 6; ++q) { const float nr = pr * pr - pi * pi, ni = 2.0f * pr * pi; pr = nr; pi = ni; }
                float hr = 0.f, hi = 0.f;
                for (int n = 0; n < NCH; ++n) { const float er = El[n * 128 + F.lane], ei = El[n * 128 + 64 + F.lane];
                    El[n * 128 + F.lane] = hr; El[n * 128 + 64 + F.lane] = hi;
                    const float nr = pr * hr - pi * hi + er, ni = pr * hi + pi * hr + ei; hr = nr; hi = ni; } }
            __syncthreads();
            for (int i = F.tid; i < NCH * 128; i += NTHREADS) SE[i] = El[i];
        }
    }
}

DEV void phase_seq(const Frame& F0, int l, int mode = 0) {
    const Frame F = refresh(F0);
    const int odd = l & 1; const int nlin = B_ * (odd ? 4 : 8) * 2 * 4; const int ns5 = odd ? B_ * 2 * 32 : 0;
    const int vcu = (F.G % 8 == 0) ? (F.bid % 8) * (F.G / 8) + F.bid / 8 : F.bid;
    if (!odd || F.G <= nlin) {
        for (int it = vcu; it < nlin + ns5; it += F.G) {
            if (it < nlin) { if (mode != 2) seq_linear_item(F, l, it, mode >= 10 ? mode - 10 : 0); } else if (mode != 1 && mode < 10) seq_s5_item(F, l, it - nlin, 1);
            __syncthreads();
        }
    } else if (vcu < nlin) { if (mode != 2) seq_linear_item(F, l, vcu, mode >= 10 ? mode - 10 : 0); }
    else { for (int it = vcu - nlin; it < ns5; it += F.G - nlin) { if (mode != 1 && mode < 10) seq_s5_item(F, l, it, 1); __syncthreads(); } }
}

DEV void phase_merge(const Frame& F0, int l) {
    const Frame F = refresh(F0);
    const int odd = l & 1, li = l >> 1; const bf16_t* P = (const bf16_t*)(F.ws + WS_P);
    const bf16_t* O0 = (const bf16_t*)(F.ws + WS_O); const bf16_t* O1 = O0 + (size_t)MROWS * 1024;
    bf16_t* MG = (bf16_t*)(F.ws + WS_MERGED);
    const int nrows = (l == DEPTH - 1) ? LATR : MROWS;
    ROW_LOOP(r, nrows) {
        if (!odd) {
            const int c0 = 16 * F.lane; float v[16];
#pragma unroll
            for (int q = 0; q < 4; ++q) { const u32x2 a = *(const u32x2*)(O0 + (size_t)r * 1024 + c0 + 4 * q), bq = *(const u32x2*)(O1 + (size_t)r * 1024 + c0 + 4 * q);
                v[4 * q] = bflo(a.x) + bflo(bq.x); v[4 * q + 1] = bfhi(a.x) + bfhi(bq.x); v[4 * q + 2] = bflo(a.y) + bflo(bq.y); v[4 * q + 3] = bfhi(a.y) + bfhi(bq.y); }
            float s = 0.f;
#pragma unroll
            for (int i = 0; i < 16; ++i) s += v[i];
            s = group_sum<8>(s);
            const bool ret = F.lane >= 32; const float mu = ret ? s * (1.0f / 128.0f) : 0.f; float q2 = 0.f;
#pragma unroll
            for (int i = 0; i < 16; ++i) { v[i] -= mu; q2 += v[i] * v[i]; }
            q2 = group_sum<8>(q2);
            const float rstd = 1.0f / sqrtf(q2 * (1.0f / 128.0f) + LN_EPS);
            const bf16_t* zp = P + (size_t)r * NIN_E + (ret ? 3584 + (c0 - 512) : 1536 + c0);
            const float* gp = ret ? GIN(I_EVRETN) + li * 512 + (c0 - 512) : GIN(I_EVGDNN) + li * 128 + (c0 & 127);
            unsigned ow[8];
#pragma unroll
            for (int i = 0; i < 16; i += 2) { const float z0 = bf2f(zp[i]), z1 = bf2f(zp[i + 1]); ow[i >> 1] = pk2(v[i] * rstd * gp[i] * silu_f(z0), v[i + 1] * rstd * gp[i + 1] * silu_f(z1)); }
            u32x4* op = (u32x4*)(MG + (size_t)r * 1024 + c0); op[0] = (u32x4){ow[0], ow[1], ow[2], ow[3]}; op[1] = (u32x4){ow[4], ow[5], ow[6], ow[7]};
        } else {
            const int c0 = 8 * F.lane; float v[8];
#pragma unroll
            for (int q = 0; q < 2; ++q) { const u32x2 a = *(const u32x2*)(O0 + (size_t)r * 1024 + c0 + 4 * q), bq = *(const u32x2*)(O1 + (size_t)r * 1024 + c0 + 4 * q);
                v[4 * q] = bflo(a.x) + bflo(bq.x); v[4 * q + 1] = bfhi(a.x) + bfhi(bq.x); v[4 * q + 2] = bflo(a.y) + bflo(bq.y); v[4 * q + 3] = bfhi(a.y) + bfhi(bq.y); }
            float s = 0.f;
#pragma unroll
            for (int i = 0; i < 8; ++i) s += v[i];
            s = group_sum<16>(s);
            const float mu = s * (1.0f / 128.0f); float q2 = 0.f;
#pragma unroll
            for (int i = 0; i < 8; ++i) { v[i] -= mu; q2 += v[i] * v[i]; }
            q2 = group_sum<16>(q2);
            const float rstd = 1.0f / sqrtf(q2 * (1.0f / 128.0f) + LN_EPS);
            const bf16_t* zp = P + (size_t)r * NIN_O + 1536 + c0; const float* gp = GIN(I_ODMN) + li * 512 + c0;
            unsigned ow[4];
#pragma unroll
            for (int i = 0; i < 8; i += 2) ow[i >> 1] = pk2(v[i] * rstd * gp[i] * sigmoid_f(bf2f(zp[i])), v[i + 1] * rstd * gp[i + 1] * sigmoid_f(bf2f(zp[i + 1])));
            *(u32x4*)(MG + (size_t)r * 1024 + c0) = (u32x4){ow[0], ow[1], ow[2], ow[3]};
            const bf16_t* up = P + (size_t)r * NIN_O + 2048 + c0; const float* dsk = GIN(I_ODDSKIP) + li * 512 + c0;
#pragma unroll
            for (int q = 0; q < 2; ++q) { const u32x2 a = *(const u32x2*)(O0 + (size_t)r * 1024 + 512 + c0 + 4 * q), bq = *(const u32x2*)(O1 + (size_t)r * 1024 + 512 + c0 + 4 * q);
                v[4 * q] = bflo(a.x) + bflo(bq.x); v[4 * q + 1] = bfhi(a.x) + bfhi(bq.x); v[4 * q + 2] = bflo(a.y) + bflo(bq.y); v[4 * q + 3] = bfhi(a.y) + bfhi(bq.y); }
#pragma unroll
            for (int i = 0; i < 8; i += 2) ow[i >> 1] = pk2(gelu_tanh_f(v[i] + dsk[i] * bf2f(up[i])), gelu_tanh_f(v[i + 1] + dsk[i + 1] * bf2f(up[i + 1])));
            *(u32x4*)((bf16_t*)(F.ws + WS_YS) + (size_t)r * 512 + c0) = (u32x4){ow[0], ow[1], ow[2], ow[3]};
        }
    }
}

template <int RG> DEV void ln_rows(const Frame& F, f32x4 (&t)[RG][4], const float* lg, const float* lb) {
    float mean[RG], rstd[RG];
#pragma unroll
    for (int q = 0; q < RG; ++q) { float sum = 0.f;
#pragma unroll
        for (int j = 0; j < 4; ++j) sum += (t[q][j].x + t[q][j].y) + (t[q][j].z + t[q][j].w);
        mean[q] = wave_sum(sum) * (1.0f / 1024.0f); }
#pragma unroll
    for (int q = 0; q < RG; ++q) { float s2 = 0.f;
#pragma unroll
        for (int j = 0; j < 4; ++j) { t[q][j] = t[q][j] - mean[q]; s2 += (t[q][j].x * t[q][j].x + t[q][j].y * t[q][j].y) + (t[q][j].z * t[q][j].z + t[q][j].w * t[q][j].w); }
        rstd[q] = 1.0f / sqrtf(wave_sum(s2) * (1.0f / 1024.0f) + LN_EPS); }
#pragma unroll
    for (int j = 0; j < 4; ++j) { const f32x4 gg = *((const f32x4*)lg + F.lane + 64 * j), bb = *((const f32x4*)lb + F.lane + 64 * j);
#pragma unroll
        for (int q = 0; q < RG; ++q) t[q][j] = t[q][j] * rstd[q] * gg + bb; }
}
template <int RG> DEV void ln1_group(const Frame& F, int l, int r) {

    const float* Y = (const float*)(F.ws + WS_Y); float* H = (float*)(F.ws + WS_H);
    const float* lg = GIN(I_LN1G) + l * 1024; const float* lb = GIN(I_LN1B) + l * 1024; const float* wr = (const float*)(F.ws + WS_WR) + (size_t)l * NE * 1024;
    {
        int b, s; row_bs(r, b, s); const int mr = s < CTX ? B_ : b; const float* mod = (const float*)(F.ws + WS_MOD) + ((size_t)l * NR + mr) * 6144;
        f32x4 t[RG][4];
#pragma unroll
        for (int j = 0; j < 4; ++j) { const f32x4 g1 = *((const f32x4*)(mod + 2048) + F.lane + 64 * j);
#pragma unroll
            for (int q = 0; q < RG; ++q) { const f32x4 hv = *((const f32x4*)(H + (size_t)(r + q) * 1024) + F.lane + 64 * j), yv = *((const f32x4*)(Y + (size_t)(r + q) * 1024) + F.lane + 64 * j); t[q][j] = ALPHA * hv + g1 * yv; }
            if (j & 1) COMPILER_FENCE(); }
        ln_rows<RG>(F, t, lg, lb);
        COMPILER_FENCE();
#pragma unroll
        for (int j = 0; j < 4; ++j) { const f32x4 sh = *((const f32x4*)(mod + 3072) + F.lane + 64 * j), scv = *((const f32x4*)(mod + 4096) + F.lane + 64 * j);
#pragma unroll
            for (int q = 0; q < RG; ++q) { *((f32x4*)(H + (size_t)(r + q) * 1024) + F.lane + 64 * j) = t[q][j]; t[q][j] = t[q][j] * (1.0f + scv) + sh; } }
        COMPILER_FENCE();
#pragma unroll
        for (int q = 0; q < RG; ++q) { u32x2* xo = (u32x2*)((bf16_t*)(F.ws + WS_XIN) + (size_t)(r + q) * 1024) + F.lane;
#pragma unroll
            for (int j = 0; j < 4; ++j) xo[64 * j] = (u32x2){pk2(t[q][j].x, t[q][j].y), pk2(t[q][j].z, t[q][j].w)}; }
        float mine[RG]; const int ei = F.lane % NE;
#pragma unroll
        for (int q = 0; q < RG; ++q) mine[q] = 0.f;
        f32x4 wc[4];
#pragma unroll
        for (int j = 0; j < 4; ++j) wc[j] = *((const f32x4*)wr + F.lane + 64 * j);
#pragma unroll 1
        for (int e = 0; e < NE; ++e) { f32x4 wn[4]; const int en = e + 1 < NE ? e + 1 : e;
#pragma unroll
            for (int j = 0; j < 4; ++j) wn[j] = *((const f32x4*)(wr + en * 1024) + F.lane + 64 * j);
#pragma unroll
            for (int q = 0; q < RG; ++q) { float p = 0.f;
#pragma unroll
                for (int j = 0; j < 4; ++j) p += t[q][j].x * wc[j].x + t[q][j].y * wc[j].y + t[q][j].z * wc[j].z + t[q][j].w * wc[j].w;
                const float ws_ = wave_sum(p); mine[q] = (ei == e) ? ws_ : mine[q]; }
#pragma unroll
            for (int j = 0; j < 4; ++j) wc[j] = wn[j]; }
#pragma unroll
        for (int q = 0; q < RG; ++q) { const float mx = group_max<NE>(mine[q]); const float ex = expf(mine[q] - mx); const float se = group_sum<NE>(ex);
            if (F.lane < NE) ((float*)(F.ws + WS_AFF))[(size_t)(r + q) * 16 + F.lane] = ex / se; }
    }
}
DEV void phase_ln1(const Frame& F0, int l) {
    const Frame F = refresh(F0);
    const int nrows = (l == DEPTH - 1) ? LATR : MROWS;
    ROW_GROUPS(nrows, ln1_group<4>(F, l, r), ln1_group<2>(F, l, r));
}

DEV void phase_topk(const Frame& F0, int l) {
    const Frame F = refresh(F0);
    const int nitems = (l == DEPTH - 1) ? B_ * NE : 2 * B_ * NE;
    LAS unsigned* hist = (LAS unsigned*)(F.lds);
    LAS unsigned* selw = (LAS unsigned*)(F.lds + 1024);
    LAS unsigned* cnt = (LAS unsigned*)(F.lds + 2048);
    LAS int* selrow = (LAS int*)(F.lds + 8192);
    const float* AFF = (const float*)(F.ws + WS_AFF); int* SLOT = (int*)(F.ws + WS_SLOT); float* EG = (float*)(F.ws + WS_EGATE);
    for (int it = F.bid; it < nitems; it += F.G) {
        const int e = it % NE, set = it / NE, kind = set / B_, b = set % B_;
        const int n = kind ? CTX : SEQ, cap = kind ? CAPC : CAPL; const int row0 = kind ? LATR + b * CTX : b * SEQ;
        const int sbase = kind ? B_ * CAPL + b * CAPC : b * CAPL;
        const int per = n >= NTHREADS ? n / NTHREADS : 1; const bool act = F.tid * per < n;
        unsigned key[8];
#pragma unroll
        for (int k = 0; k < 8; ++k) key[k] = (act && k < per) ? __builtin_bit_cast(unsigned, AFF[(size_t)(row0 + F.tid * per + k) * 16 + e]) : 0u;
        unsigned prefix = 0u, remaining = (unsigned)cap;
        for (int pass = 0; pass < 4; ++pass) {
            const int shift = 24 - 8 * pass; const unsigned mask = pass == 0 ? 0u : (0xFFFFFFFFu << (shift + 8));
            if (F.tid < 256) hist[F.tid] = 0u;
            __syncthreads();
#pragma unroll
            for (int k = 0; k < 8; ++k) if (act && k < per && ((key[k] & mask) == (prefix & mask))) lds_atomic_add(&hist[(key[k] >> shift) & 255u], 1u);
            __syncthreads();
            if (F.wave == 0) {
                const unsigned h0 = hist[4 * F.lane], h1 = hist[4 * F.lane + 1], h2 = hist[4 * F.lane + 2], h3 = hist[4 * F.lane + 3];
                unsigned suf = h0 + h1 + h2 + h3;
#pragma unroll
                for (int o = 1; o < 64; o <<= 1) { const unsigned tv = shfl_t(suf, F.lane + o); if (F.lane + o < 64) suf += tv; }
                unsigned cum = suf - (h0 + h1 + h2 + h3);
                int dsel = -1; unsigned above = 0u;
                if (cum < remaining) {
                    if (cum + h3 >= remaining) { dsel = 4 * F.lane + 3; above = cum; }
                    else if (cum + h3 + h2 >= remaining) { dsel = 4 * F.lane + 2; above = cum + h3; }
                    else if (cum + h3 + h2 + h1 >= remaining) { dsel = 4 * F.lane + 1; above = cum + h3 + h2; }
                    else if (cum + h3 + h2 + h1 + h0 >= remaining) { dsel = 4 * F.lane; above = cum + h3 + h2 + h1; }
                }
                if (dsel >= 0) { selw[0] = prefix | ((unsigned)dsel << shift); selw[1] = remaining - above; }
            }
            __syncthreads();
            prefix = selw[0]; remaining = selw[1];
            __syncthreads();
        }
        const unsigned T = prefix, need_eq = remaining;
        unsigned ngt = 0u, neq = 0u;
#pragma unroll
        for (int k = 0; k < 8; ++k) if (act && k < per) { ngt += key[k] > T ? 1u : 0u; neq += key[k] == T ? 1u : 0u; }
        unsigned pk = (ngt << 16) | neq;
#pragma unroll
        for (int o = 1; o < 64; o <<= 1) { const unsigned tv = shfl_t(pk, F.lane - o); if (F.lane >= o) pk += tv; }
        if (F.lane == 63) cnt[F.wave] = pk;
        __syncthreads();
        unsigned base = 0u;
#pragma unroll
        for (int w8 = 0; w8 < NWAVES; ++w8) base += (w8 < F.wave) ? cnt[w8] : 0u;
        const unsigned excl = base + pk - ((ngt << 16) | neq);
        unsigned gtb = excl >> 16, eqb = excl & 0xffffu;
#pragma unroll
        for (int k = 0; k < 8; ++k) if (act && k < per) {
            const int row = row0 + F.tid * per + k; int slot = -1;
            const bool isgt = key[k] > T, iseq = key[k] == T;
            if (isgt || (iseq && eqb < need_eq)) { slot = (int)(gtb + (eqb < need_eq ? eqb : need_eq)); selrow[slot] = row; EG[(size_t)e * EPAD + sbase + slot] = __builtin_bit_cast(float, key[k]); }
            SLOT[(size_t)row * 16 + e] = slot >= 0 ? sbase + slot : -1;
            gtb += isgt ? 1u : 0u; eqb += iseq ? 1u : 0u;
        }
        __syncthreads();
        for (int sl = F.tid; sl < cap; sl += NTHREADS) ((int*)(F.ws + WS_EIDX))[(size_t)e * EPAD + sbase + sl] = selrow[sl];
        if (it < NE) for (int pr = EROWS + F.tid; pr < EPAD; pr += NTHREADS) EG[(size_t)e * EPAD + pr] = 0.f;
        __syncthreads();
    }
}

DEV void phase_gather(const Frame& F0, int l) {
    const Frame F = refresh(F0);
    const int erows = (l == DEPTH - 1) ? B_ * CAPL : EROWS;
    const int* EI = (const int*)(F.ws + WS_EIDX);
    for (int r0 = 4 * F.gw; r0 < NE * EPAD; r0 += 4 * F.NGW) {
        u32x4 v[4][2];
#pragma unroll
        for (int q = 0; q < 4; ++q) { const int r = r0 + q, sl = r % EPAD; v[q][0] = (u32x4){0u, 0u, 0u, 0u}; v[q][1] = v[q][0];
            if (sl < erows) { const u32x4* src = (const u32x4*)((const bf16_t*)(F.ws + WS_XIN) + (size_t)EI[r] * 1024) + F.lane; v[q][0] = src[0]; v[q][1] = src[64]; } }
#pragma unroll
        for (int q = 0; q < 4; ++q) { u32x4* dst = (u32x4*)((bf16_t*)(F.ws + WS_XS) + (size_t)(r0 + q) * 1024) + F.lane; dst[0] = v[q][0]; dst[64] = v[q][1]; }
    }
}

template <int RG> DEV void ln2_group(const Frame& F, int l, int r) {

    float* H = (float*)(F.ws + WS_H); const int* SLOT = (const int*)(F.ws + WS_SLOT); const bf16_t* YSE = (const bf16_t*)(F.ws + WS_YSE);
    const float* lg = GIN(I_LN2G) + l * 1024; const float* lb = GIN(I_LN2B) + l * 1024;
    {
        int b, s; row_bs(r, b, s); const int mr = s < CTX ? B_ : b; const float* mod = (const float*)(F.ws + WS_MOD) + ((size_t)l * NR + mr) * 6144;
        f32x4 t[RG][4];
#pragma unroll
        for (int q = 0; q < RG; ++q) {
#pragma unroll
            for (int j = 0; j < 4; ++j) t[q][j] = (f32x4){0.f, 0.f, 0.f, 0.f}; }
        const int myslot = F.lane < RG * 16 ? SLOT[(size_t)r * 16 + F.lane] : -1;
#pragma unroll
        for (int q = 0; q < RG; ++q)
#pragma unroll
            for (int e = 0; e < NE; ++e) { const int sl = bcast_lane(myslot, 16 * q + e);
                if (sl >= 0) { const u32x2* yp = (const u32x2*)(YSE + ((size_t)e * EPAD + sl) * 1024) + F.lane;
#pragma unroll
                    for (int j = 0; j < 4; ++j) { const u32x2 w = yp[64 * j]; t[q][j] += (f32x4){bflo(w.x), bfhi(w.x), bflo(w.y), bfhi(w.y)}; } } }
#pragma unroll
        for (int j = 0; j < 4; ++j) { const f32x4 g2 = *((const f32x4*)(mod + 5120) + F.lane + 64 * j);
#pragma unroll
            for (int q = 0; q < RG; ++q) { const f32x4 hv = *((const f32x4*)(H + (size_t)(r + q) * 1024) + F.lane + 64 * j); t[q][j] = ALPHA * hv + g2 * t[q][j]; } }
        ln_rows<RG>(F, t, lg, lb);
        if (l == DEPTH - 1) {
            {
#pragma unroll
                for (int q = 0; q < RG; ++q) { GAS f32x4* op = (GAS f32x4*)(F.out + (size_t)(r + q) * 1024) + F.lane;
#pragma unroll
                    for (int j = 0; j < 4; ++j) op[64 * j] = t[q][j]; } }
        } else {
#pragma unroll
            for (int q = 0; q < RG; ++q)
#pragma unroll
                for (int j = 0; j < 4; ++j) *((f32x4*)(H + (size_t)(r + q) * 1024) + F.lane + 64 * j) = t[q][j];
            xg_rows<RG>(F, l + 1, r, t);
        }
    }
}
DEV void phase_ln2(const Frame& F0, int l) {
    const Frame F = refresh(F0);
    const int nrows = (l == DEPTH - 1) ? LATR : MROWS;
    ROW_GROUPS(nrows, ln2_group<4>(F, l, r), ln2_group<2>(F, l, r));
}

struct EpiP {
    static constexpr bool PERM = true;
    bf16_t* O; int ldc;
    DEV void operator()(const f32x4 (&acc)[2][2][4][2], const pg8::Unit& u, int wr, int wc, int fr, int fq) const {
        const int row0 = u.pm * 256 + wr * 64 + fr, col0 = u.pn * 256 + wc * 32 + 8 * fq;
#pragma unroll
        for (int ai = 0; ai < 2; ++ai)
#pragma unroll
            for (int m = 0; m < 4; ++m) { bf16_t* rowp = O + (size_t)(row0 + ai * 128 + m * 16) * ldc + col0;
#pragma unroll
                for (int bj = 0; bj < 2; ++bj) { const f32x4 v0 = acc[ai][bj][m][0], v1 = acc[ai][bj][m][1];
                    u32x4 w; w.x = pg8::cvt_pk_bf16(v0[0], v0[1]); w.y = pg8::cvt_pk_bf16(v0[2], v0[3]); w.z = pg8::cvt_pk_bf16(v1[0], v1[1]); w.w = pg8::cvt_pk_bf16(v1[2], v1[3]);
                    *(u32x4*)(rowp + bj * 128) = w; } }
    }
};
struct EpiGlu {
    static constexpr bool PERM = true;
    bf16_t* MG; const bf16_t* YS; const float* bias;
    DEV void operator()(const f32x4 (&acc)[2][2][4][2], const pg8::Unit& u, int wr, int wc, int fr, int fq) const {
        const int row0 = u.pm * 256 + wr * 64 + fr, col0 = u.pn * 256 + wc * 32 + 8 * fq;
#pragma unroll
        for (int ai = 0; ai < 2; ++ai)
#pragma unroll
            for (int m = 0; m < 4; ++m) { const int row = row0 + ai * 128 + m * 16;
#pragma unroll
                for (int bj = 0; bj < 2; ++bj) { const int c = col0 + bj * 128; const f32x4 v0 = acc[ai][bj][m][0], v1 = acc[ai][bj][m][1];
                    const u32x4 yv = *(const u32x4*)(YS + (size_t)row * 512 + c); const f32x4 b0 = *(const f32x4*)(bias + c), b1 = *(const f32x4*)(bias + c + 4);
                    u32x4 w; w.x = pk2(bflo(yv.x) * fast_sigmoid(v0[0] + b0[0]), bfhi(yv.x) * fast_sigmoid(v0[1] + b0[1])); w.y = pk2(bflo(yv.y) * fast_sigmoid(v0[2] + b0[2]), bfhi(yv.y) * fast_sigmoid(v0[3] + b0[3]));
                    w.z = pk2(bflo(yv.z) * fast_sigmoid(v1[0] + b1[0]), bfhi(yv.z) * fast_sigmoid(v1[1] + b1[1])); w.w = pk2(bflo(yv.w) * fast_sigmoid(v1[2] + b1[2]), bfhi(yv.w) * fast_sigmoid(v1[3] + b1[3]));
                    *(u32x4*)(MG + (size_t)row * 1024 + 512 + c) = w; } }
    }
};
struct EpiF32 {
    static constexpr bool PERM = false;
    float* C; int ldc; const float* rowscale;
    DEV void operator()(const f32x4 (&acc)[2][2][4][2], const pg8::Unit& u, int wr, int wc, int fr, int fq) const {
        const int row0 = u.pm * 256 + wr * 64 + fr, col0 = u.pn * 256 + wc * 32 + 4 * fq;
        const size_t ebase = rowscale ? (size_t)u.e * EPAD : 0;
#pragma unroll
        for (int ai = 0; ai < 2; ++ai)
#pragma unroll
            for (int m = 0; m < 4; ++m) { const size_t row = ebase + row0 + ai * 128 + m * 16; const float sc = rowscale ? rowscale[row] : 1.0f; float* rowp = C + row * ldc + col0;
#pragma unroll
                for (int bj = 0; bj < 2; ++bj)
#pragma unroll
                    for (int n = 0; n < 2; ++n) *(f32x4*)(rowp + bj * 128 + n * 16) = acc[ai][bj][m][n] * sc; }
    }
};
struct EpiYse {
    static constexpr bool PERM = true;
    bf16_t* O; const float* rowscale;
    DEV void operator()(const f32x4 (&acc)[2][2][4][2], const pg8::Unit& u, int wr, int wc, int fr, int fq) const {
        const int row0 = u.pm * 256 + wr * 64 + fr, col0 = u.pn * 256 + wc * 32 + 8 * fq; const size_t ebase = (size_t)u.e * EPAD;
#pragma unroll
        for (int ai = 0; ai < 2; ++ai)
#pragma unroll
            for (int m = 0; m < 4; ++m) { const size_t row = ebase + row0 + ai * 128 + m * 16; const float sc = rowscale[row]; bf16_t* rowp = O + row * 1024 + col0;
#pragma unroll
                for (int bj = 0; bj < 2; ++bj) { const f32x4 v0 = acc[ai][bj][m][0] * sc, v1 = acc[ai][bj][m][1] * sc;
                    u32x4 w; w.x = pg8::cvt_pk_bf16(v0[0], v0[1]); w.y = pg8::cvt_pk_bf16(v0[2], v0[3]); w.z = pg8::cvt_pk_bf16(v1[0], v1[1]); w.w = pg8::cvt_pk_bf16(v1[2], v1[3]);
                    *(u32x4*)(rowp + bj * 128) = w; } }
    }
};
struct EpiSwiglu {
    static constexpr bool PERM = true;
    bf16_t* HID;
    DEV void operator()(const f32x4 (&acc)[2][2][4][2], const pg8::Unit& u, int wr, int wc, int fr, int fq) const {
        const int row0 = u.pm * 256 + wr * 64 + fr, col0 = u.pn * 128 + wc * 32 + 8 * fq;
#pragma unroll
        for (int ai = 0; ai < 2; ++ai)
#pragma unroll
            for (int m = 0; m < 4; ++m) { bf16_t* rowp = HID + ((size_t)u.e * EPAD + row0 + ai * 128 + m * 16) * FF + col0;
                const f32x4 g0 = acc[ai][0][m][0], g1 = acc[ai][0][m][1], u0 = acc[ai][1][m][0], u1 = acc[ai][1][m][1];
                u32x4 w; w.x = pk2(fast_silu(g0[0]) * u0[0], fast_silu(g0[1]) * u0[1]); w.y = pk2(fast_silu(g0[2]) * u0[2], fast_silu(g0[3]) * u0[3]);
                w.z = pk2(fast_silu(g1[0]) * u1[0], fast_silu(g1[1]) * u1[1]); w.w = pk2(fast_silu(g1[2]) * u1[2], fast_silu(g1[3]) * u1[3]);
                *(u32x4*)rowp = w; }
    }
};

DEV void gemm_g1(const Frame& F0, int l, int vcu) {
    const Frame F = refresh(F0);
    const int nin = (l & 1) ? NIN_O : NIN_E;
    pg8::PlainOrder S; S.init((const void*)(F.ws + WS_XIN), (const bf16_t*)(F.ws + WS_WIN) + (size_t)l * NINMAX * 1024, 1024, MPAD, nin, F.G, vcu);
    EpiP E; E.O = (bf16_t*)(F.ws + WS_P); E.ldc = nin;
    pg8::gemm_phase(F.lds, 1024, S, E, F.wave, F.lane);
}
DEV void gemm_glu(const Frame& F0, int l, int vcu) {
    const Frame F = refresh(F0);
    const int li = l >> 1;
    pg8::PlainOrder S; S.init((const void*)(F.ws + WS_YS), (const bf16_t*)(F.ws + WS_WGLU) + (size_t)li * 512 * 512, 512, (l == DEPTH - 1) ? LATPAD : MPAD, 512, F.G, vcu);
    EpiGlu E; E.MG = (bf16_t*)(F.ws + WS_MERGED); E.YS = (const bf16_t*)(F.ws + WS_YS); E.bias = GIN(I_ODBGLU) + li * 512;
    pg8::gemm_phase(F.lds, 512, S, E, F.wave, F.lane);
}
DEV void gemm_g3(const Frame& F0, int l, int vcu) {
    const Frame F = refresh(F0);
    pg8::PlainOrder S; S.init((const void*)(F.ws + WS_MERGED), (const bf16_t*)(F.ws + WS_WOUT) + (size_t)l * 1024 * 1024, 1024, (l == DEPTH - 1) ? LATPAD : MPAD, 1024, F.G, vcu);
    EpiF32 E; E.C = (float*)(F.ws + WS_Y); E.ldc = 1024; E.rowscale = nullptr;
    pg8::gemm_phase(F.lds, 1024, S, E, F.wave, F.lane);
}
DEV void gemm_g4(const Frame& F0, int l, int vcu) {
    const Frame F = refresh(F0);
    pg8::GroupedOrder S; S.init((const void*)(F.ws + WS_XS), (const bf16_t*)(F.ws + WS_WGU) + (size_t)l * NE * 2 * FF * 1024, 1024, 2 * FF, F.G, vcu, (l == DEPTH - 1) ? B_ * CAPL : EROWS);
    EpiSwiglu E; E.HID = (bf16_t*)(F.ws + WS_HID);
    pg8::gemm_phase(F.lds, 1024, S, E, F.wave, F.lane);
}
DEV void gemm_g5(const Frame& F0, int l, int vcu) {
    const Frame F = refresh(F0);
    pg8::GroupedOrder S; S.init((const void*)(F.ws + WS_HID), (const bf16_t*)(F.ws + WS_WD) + (size_t)l * NE * 1024 * FF, FF, 1024, F.G, vcu, (l == DEPTH - 1) ? B_ * CAPL : EROWS);
    EpiYse E; E.O = (bf16_t*)(F.ws + WS_YSE); E.rowscale = (const float*)(F.ws + WS_EGATE);
    pg8::gemm_phase(F.lds, FF, S, E, F.wave, F.lane);
}

__global__ void __launch_bounds__(NTHREADS, 2) mega_fwd(Args args) {
#ifdef EMU
    LAS unsigned char* lds = emu::lds();
#else
    extern __shared__ __attribute__((aligned(16))) unsigned char lds_raw[];
    LAS unsigned char* lds = (LAS unsigned char*)lds_raw;
#endif
    Frame F;
    F.in = args.in; F.out = (GAS float*)args.out; F.ws = (GAS unsigned char*)args.ws; F.lds = lds;
    F.tid = threadIdx.x; F.lane = F.tid & 63; F.wave = readfirstlane_i(F.tid >> 6); F.G = gridDim.x; F.bid = blockIdx.x;
    F.gw = F.bid * NWAVES + F.wave; F.NGW = F.G * NWAVES;
    for (int u = F.tid; u < (LDS_BYTES - LDS_MISC) / 4; u += NTHREADS) ((LAS unsigned*)(lds + LDS_MISC))[u] = 0u;
    __syncthreads();
    XcdBarrier bar = xcd_barrier_post((unsigned*)(F.ws + WS_CTL), (volatile LAS unsigned*)(lds + LDS_MISC), F.wave);
#define GRID_BAR() xcd_barrier(bar)
    const int vcu = (F.G % 8 == 0) ? (F.bid % 8) * (F.G / 8) + F.bid / 8 : F.bid;

#ifndef PHASE_MASK
#define PHASE_MASK 0xFFFFF
#endif
#ifndef REPEAT_MASK
#define REPEAT_MASK 0x0
#endif
#ifndef TIMING_PROBE
#define TIMING_PROBE -1
#endif
    unsigned long long pt_acc = 0ull, pt_t0 = 0ull;
#define PT(k) do { if (TIMING_PROBE == (k)) pt_t0 = rt_now(); } while (0)
#define PTE(k) do { if (TIMING_PROBE == (k)) pt_acc += rt_now() - pt_t0; } while (0)
#define PH(k) if ((PHASE_MASK >> (k)) & 1)
#define RP(k) if ((REPEAT_MASK >> (k)) & 1)
    PT(0); PH(0) phase_prologue_a(F);
    RP(0) { GRID_BAR(); phase_prologue_a(F); }
    GRID_BAR(); PTE(0);
    PT(1); PH(1) phase_xg0(F);
    GRID_BAR(); PTE(1);
    for (int l = 0; l < DEPTH; ++l) {
        const int odd = l & 1;
        PT(2); PH(2) gemm_g1(F, l, F.bid);
        RP(2) { GRID_BAR(); gemm_g1(F, l, F.bid); }
        GRID_BAR(); PTE(2);
        PT(3); PH(3) phase_prep(F, l);
        RP(3) { GRID_BAR(); phase_prep(F, l); }
        GRID_BAR(); PTE(3);
        PT(4); PH(4) phase_cl(F, l);
        RP(4) { GRID_BAR(); phase_cl(F, l); }
        GRID_BAR(); PTE(4);
        PT(5); PH(5) phase_seq(F, l);
        RP(5) { GRID_BAR(); phase_seq(F, l); }
        GRID_BAR(); PTE(5);
#ifdef SEQ_XPROBE
        if ((l & 1) == SEQ_XPARITY) { PT(20); phase_seq(F, l, 10 + SEQ_XPROBE); GRID_BAR(); PTE(20); }
#endif
        PT(6); PH(6) phase_merge(F, l);
        RP(6) { GRID_BAR(); phase_merge(F, l); }
        GRID_BAR(); PTE(6);
        if (odd) { PT(7); PH(7) gemm_glu(F, l, F.bid); RP(7) { GRID_BAR(); gemm_glu(F, l, F.bid); } GRID_BAR(); PTE(7); }
        PT(8); PH(8) gemm_g3(F, l, F.bid);
        RP(8) { GRID_BAR(); gemm_g3(F, l, F.bid); }
        GRID_BAR(); PTE(8);
        PT(9); PH(9) phase_ln1(F, l);
        GRID_BAR(); PTE(9);
        PT(10); PH(10) phase_topk(F, l);
        RP(10) { GRID_BAR(); phase_topk(F, l); }
        GRID_BAR(); PTE(10);
        PT(14); PH(10) phase_gather(F, l);
        GRID_BAR(); PTE(14);
        PT(11); PH(11) gemm_g4(F, l, F.bid);
        RP(11) { GRID_BAR(); gemm_g4(F, l, F.bid); }
        GRID_BAR(); PTE(11);
        PT(12); PH(12) gemm_g5(F, l, F.bid);
        RP(12) { GRID_BAR(); gemm_g5(F, l, F.bid); }
        GRID_BAR(); PTE(12);
        PT(13); PH(13) phase_ln2(F, l);
        GRID_BAR(); PTE(13);
    }
    if (TIMING_PROBE >= 0 && F.bid == 0) { const unsigned long long t1 = rt_now() + pt_acc; while (rt_now() < t1) s_sleep1(); }
}

#ifndef EMU
extern "C" void kernel_launch(void* const* d_in, const int* in_sizes, int n_in, void* d_out, int out_size, void* d_ws, size_t ws_size, hipStream_t stream) {
    static int grid = 0;
    if (grid == 0) {
        if (n_in != N_IN || ws_size < WS_END) { fprintf(stderr, "kernel_launch: need %d inputs and %zu bytes of workspace; got %d, %zu\n", (int)N_IN, (size_t)WS_END, n_in, ws_size); grid = -1; return; }
        int dev = 0, cus = 0, per_cu = 0;
        if (hipGetDevice(&dev) != hipSuccess || hipDeviceGetAttribute(&cus, hipDeviceAttributeMultiprocessorCount, dev) != hipSuccess) { grid = -1; return; }
        if (hipFuncSetAttribute((const void*)mega_fwd, hipFuncAttributeMaxDynamicSharedMemorySize, LDS_BYTES) != hipSuccess) { fprintf(stderr, "kernel_launch: hipFuncSetAttribute failed\n"); grid = -1; return; }
        if (hipOccupancyMaxActiveBlocksPerMultiprocessor(&per_cu, (const void*)mega_fwd, NTHREADS, LDS_BYTES) != hipSuccess || per_cu < 1) { fprintf(stderr, "kernel_launch: occupancy query says %d\n", per_cu); }
        (void)hipGetLastError();
        grid = cus;
    }
    if (grid < 0) return;
    (void)hipMemsetAsync((char*)d_ws + WS_CTL, 0, CTL_BYTES, stream);
    Args a{};
    for (int i = 0; i < N_IN; ++i) a.in[i] = (const float*)d_in[i];
    a.out = (float*)d_out; a.ws = (unsigned char*)d_ws;
    hipLaunchKernelGGL(mega_fwd, dim3(grid), dim3(NTHREADS), LDS_BYTES, stream, a);
}
#endif
```

```cpp
#ifdef EMU
#include "emu.h"
#else
#include <hip/hip_runtime.h>
#endif
#include <cstdio>
#include <cstdint>
#include <cstddef>

#ifndef CFG_BATCH
#define CFG_BATCH 4
#define CFG_SEQ 4096
#define CFG_CTX 256
#define CFG_DEPTH 4
#define CFG_NEXP 16
#define CFG_FF 2048
#endif
constexpr int B_ = CFG_BATCH, SEQ = CFG_SEQ, CTX = CFG_CTX, DEPTH = CFG_DEPTH, NE = CFG_NEXP, FF = CFG_FF;
constexpr int D = 1024, TOK = CTX + SEQ, MROWS = B_ * TOK, MPAD = (MROWS + 255) / 256 * 256;
constexpr int NCH = TOK / 64;
constexpr int LATR = B_ * SEQ;
constexpr int LATPAD = (LATR + 255) / 256 * 256;
constexpr int CAPL = 2 * SEQ / NE, CAPC = 2 * CTX / NE, EROWS = B_ * (CAPL + CAPC), EPAD = (EROWS + 255) / 256 * 256;
constexpr int NIN_E = 4096, NIN_O = 2560, NINMAX = 4096;
constexpr int N_EVEN = (DEPTH + 1) / 2, N_ODD = DEPTH / 2, N_ODDA = N_ODD > 0 ? N_ODD : 1;
constexpr int NR = B_ + 1;
constexpr float ALPHA = 1.681792830507429f;
constexpr float LN_EPS = 1e-5f;
constexpr float HD_SCALE = 0.08838834764831845f;
constexpr int NWAVES = 8, NTHREADS = 512;

enum { I_X = 0, I_C, I_CTX, I_CCTX, I_WMOD, I_BMOD, I_LN1G, I_LN1B, I_LN2G, I_LN2B, I_WROUTER, I_WGATE, I_WUP, I_WDOWN,
       I_EVWIN, I_EVWOUT, I_EVCONV, I_EVALOG, I_EVDTB, I_EVGDNN, I_EVRETN,
       I_ODWIN, I_ODWOUT, I_ODCONV, I_ODGB, I_ODMN, I_ODLRE, I_ODLIM, I_ODLDT, I_ODBRE, I_ODBIM, I_ODCRE, I_ODCIM, I_ODDSKIP, I_ODWGLU, I_ODBGLU, N_IN };

constexpr size_t al256(size_t x) { return (x + 255) & ~(size_t)255; }
constexpr size_t WS_CTL = 0, CTL_BYTES = 65536;
constexpr size_t WS_MOD = WS_CTL + CTL_BYTES;
constexpr size_t WS_WG = al256(WS_MOD + (size_t)DEPTH * NR * 6144 * 4);
constexpr size_t WS_WIN = al256(WS_WG + (size_t)DEPTH * 16 * 1024 * 4);
constexpr size_t WS_WOUT = al256(WS_WIN + (size_t)DEPTH * NINMAX * 1024 * 2);
constexpr size_t WS_WGLU = al256(WS_WOUT + (size_t)DEPTH * 1024 * 1024 * 2);
constexpr size_t WS_WGU = al256(WS_WGLU + (size_t)N_ODDA * 512 * 512 * 2);
constexpr size_t WS_WD = al256(WS_WGU + (size_t)DEPTH * NE * 2 * FF * 1024 * 2);
constexpr size_t WS_S5A = al256(WS_WD + (size_t)DEPTH * NE * 1024 * FF * 2);
constexpr size_t WS_S5B = al256(WS_S5A + (size_t)N_ODDA * 2 * 32 * 128 * 4);
constexpr size_t WS_S5C = al256(WS_S5B + (size_t)N_ODDA * 2 * 32 * 128 * 16 * 2);
constexpr size_t WS_H = al256(WS_S5C + (size_t)N_ODDA * 32 * 16 * 128 * 2);
constexpr size_t WS_XIN = al256(WS_H + (size_t)MPAD * 1024 * 4);
constexpr size_t WS_GATES = al256(WS_XIN + (size_t)MPAD * 1024 * 2);
constexpr size_t WS_MERGED = al256(WS_GATES + (size_t)MROWS * 16 * 4);
constexpr size_t WS_YS = al256(WS_MERGED + (size_t)MPAD * 1024 * 2);
constexpr size_t WS_Y = al256(WS_YS + (size_t)MPAD * 512 * 2);
constexpr size_t WS_AFF = al256(WS_Y + (size_t)MPAD * 1024 * 4);
constexpr size_t WS_SLOT = al256(WS_AFF + (size_t)MROWS * 16 * 4);
constexpr size_t WS_EGATE = al256(WS_SLOT + (size_t)MROWS * 16 * 4);
constexpr size_t WS_MCH = al256(WS_EGATE + (size_t)NE * EPAD * 4);
constexpr size_t WS_WR = al256(WS_MCH + (size_t)B_ * 4 * 2 * NCH * 4);
constexpr size_t WS_EIDX = al256(WS_WR + (size_t)DEPTH * NE * 1024 * 4);
constexpr size_t WS_S5E = al256(WS_EIDX + (size_t)NE * EPAD * 4);
constexpr size_t WS_R = al256(WS_S5E + (size_t)B_ * 2 * 32 * NCH * 128 * 4);
constexpr int NCP = B_ * 8 * 2 * NCH, NCPG = B_ * 4 * 2 * NCH;
constexpr size_t WS_P = WS_R;
constexpr size_t WS_QKV = al256(WS_P + (size_t)MPAD * NINMAX * 2);
constexpr size_t WS_CLW = al256(WS_QKV + (size_t)MROWS * 1536 * 2);
constexpr size_t WS_CLQ = al256(WS_CLW + (size_t)NCP * 64 * 128 * 2);
constexpr size_t WS_CLK = al256(WS_CLQ + (size_t)NCP * 64 * 128 * 2);
constexpr size_t WS_CLA = al256(WS_CLK + (size_t)NCP * 64 * 128 * 2);
constexpr size_t WS_CLU = al256(WS_CLA + (size_t)NCP * 64 * 64 * 2);
constexpr size_t WS_CLS = al256(WS_CLU + (size_t)NCPG * 64 * 128 * 4);
constexpr size_t WS_O = al256(WS_CLS + (size_t)NCP * 512 * 4);
constexpr size_t WS_R_END1 = al256(WS_O + (size_t)2 * MROWS * 1024 * 4);
constexpr size_t WS_XS = WS_R;
constexpr size_t WS_HID = al256(WS_XS + (size_t)NE * EPAD * 1024 * 2);
constexpr size_t WS_YSE = al256(WS_HID + (size_t)NE * EPAD * FF * 2);
constexpr size_t WS_R_END2 = al256(WS_YSE + (size_t)NE * EPAD * 1024 * 4);
constexpr size_t WS_END = WS_R_END1 > WS_R_END2 ? WS_R_END1 : WS_R_END2;

constexpr int LDS_BYTES = 163840;
constexpr int LDS_MISC = 163328;

typedef unsigned short bf16_t;
typedef short bf16x8 __attribute__((ext_vector_type(8)));
typedef float f32x2 __attribute__((ext_vector_type(2)));
typedef float f32x4 __attribute__((ext_vector_type(4)));
typedef float f32x16 __attribute__((ext_vector_type(16)));
typedef unsigned u32x2 __attribute__((ext_vector_type(2)));
typedef unsigned u32x4 __attribute__((ext_vector_type(4)));
#define DEV __device__ __forceinline__

#ifdef EMU
#define LAS
#define GAS
static inline float bf2f_h(bf16_t b) { unsigned u = (unsigned)b << 16; float f; memcpy(&f, &u, 4); return f; }
static inline f32x4 mfma16(bf16x8 a, bf16x8 b, f32x4 c) {
    struct In { bf16x8 a, b; } in{a, b};
    auto s = emu::wave_xchg(&in, sizeof(in)); const int l = emu::cur->lane, col = l & 15, rg = l >> 4;
    for (int r = 0; r < 4; ++r) { const int row = 4 * rg + r; double acc = c[r];
        for (int kg = 0; kg < 4; ++kg) { const In* pa = (const In*)s[row + 16 * kg]; const In* pb = (const In*)s[col + 16 * kg];
            for (int j = 0; j < 8; ++j) acc += (double)bf2f_h((bf16_t)pa->a[j]) * (double)bf2f_h((bf16_t)pb->b[j]); }
        c[r] = (float)acc; }
    return c;
}
static inline f32x16 mfma32(bf16x8 a, bf16x8 b, f32x16 c) {
    struct In { bf16x8 a, b; } in{a, b};
    auto s = emu::wave_xchg(&in, sizeof(in)); const int l = emu::cur->lane, col = l & 31, h = l >> 5;
    for (int r = 0; r < 16; ++r) { const int row = (r & 3) + 8 * (r >> 2) + 4 * h; double acc = c[r];
        for (int kh = 0; kh < 2; ++kh) { const In* pa = (const In*)s[row + 32 * kh]; const In* pb = (const In*)s[col + 32 * kh];
            for (int j = 0; j < 8; ++j) acc += (double)bf2f_h((bf16_t)pa->a[j]) * (double)bf2f_h((bf16_t)pb->b[j]); }
        c[r] = (float)acc; }
    return c;
}
static inline void glds16(const void* g, void* l) { memcpy((char*)l + 16 * emu::cur->lane, g, 16); }
#define S_BARRIER() emu::block_barrier()
#define WAIT_VM(n) do {} while (0)
#define WAIT_LGKM(n) do {} while (0)
#define WAIT_ALL() do {} while (0)
#define SETPRIO(n) do {} while (0)
#define SCHED_BARRIER() do {} while (0)
#define COMPILER_FENCE() do {} while (0)
#define WAVE_LDS_SYNC() do { int _z = 0; (void)emu::wave_xchg(&_z, 4); } while (0)
#define LAUNDER(x) do {} while (0)
#define CODE_ALIGN() do {} while (0)
#define LAUNDER_S(x) do {} while (0)
static inline int lane_id() { return emu::cur->lane; }
template <class T> static inline T shfl_xor_t(T v, int m) { auto s = emu::wave_xchg(&v, sizeof(T)); T r; memcpy(&r, s[emu::cur->lane ^ m], sizeof(T)); return r; }
template <class T> static inline T shfl_t(T v, int src) { auto s = emu::wave_xchg(&v, sizeof(T)); T r; memcpy(&r, s[src & 63], sizeof(T)); return r; }
static inline float wave_sum(float v) { for (int o = 1; o < 64; o <<= 1) v += shfl_xor_t(v, o); return v; }
static inline float wave_max(float v) { for (int o = 1; o < 64; o <<= 1) v = fmaxf(v, shfl_xor_t(v, o)); return v; }
template <int W> static inline float group_sum(float v) { for (int o = 1; o < W; o <<= 1) v += shfl_xor_t(v, o); return v; }
template <int W> static inline float group_max(float v) { for (int o = 1; o < W; o <<= 1) v = fmaxf(v, shfl_xor_t(v, o)); return v; }
static inline int bcast_lane(int v, int src) { return shfl_t(v, src); }
static inline float bcast_lane_f(float v, int src) { return shfl_t(v, src); }
static inline float wave_scan_add(float v) { const int ln = emu::cur->lane; for (int o = 1; o < 64; o <<= 1) { const float t = shfl_t(v, ln - o); if (ln >= o) v += t; } return v; }
static inline float wave_scan_max(float v) { const int ln = emu::cur->lane; for (int o = 1; o < 64; o <<= 1) { const float t = shfl_t(v, ln - o); if (ln >= o) v = fmaxf(v, t); } return v; }
static inline int readfirstlane_i(int v) { return v; }
static inline unsigned xb_ld(unsigned* p) { return *(volatile unsigned*)p; }
static inline unsigned xb_add(unsigned* p, unsigned v) { unsigned o = *p; *p = o + v; return o; }
static inline unsigned xb_xcc_id() { return (unsigned)emu::cur->bid & 7u; }
static inline void s_sleep1() { emu::yield(); }
static inline void fence_acquire() {}
static inline void fence_release() {}
static inline unsigned lds_atomic_add(unsigned* p, unsigned v) { unsigned o = *p; *p = o + v; return o; }
static inline unsigned long long rt_now() { return 0ull; }
static inline float fast_exp2(float x) { return exp2f(x); }
static inline float fast_rcp(float x) { return 1.0f / x; }
#else
#define LAS __attribute__((address_space(3)))
#define GAS __attribute__((address_space(1)))
DEV f32x4 mfma16(bf16x8 a, bf16x8 b, f32x4 c) { return __builtin_amdgcn_mfma_f32_16x16x32_bf16(a, b, c, 0, 0, 0); }
DEV f32x16 mfma32(bf16x8 a, bf16x8 b, f32x16 c) { return __builtin_amdgcn_mfma_f32_32x32x16_bf16(a, b, c, 0, 0, 0); }
#define glds16(g, l) __builtin_amdgcn_global_load_lds((const unsigned*)(g), (LAS unsigned*)(l), 16, 0, 0)
#define S_BARRIER() __builtin_amdgcn_s_barrier()
#define WAIT_VM(n) asm volatile("s_waitcnt vmcnt(" #n ")" ::: "memory")
#define WAIT_LGKM(n) asm volatile("s_waitcnt lgkmcnt(" #n ")" ::: "memory")
#define WAIT_ALL() asm volatile("s_waitcnt vmcnt(0) lgkmcnt(0)" ::: "memory")
#define SETPRIO(n) __builtin_amdgcn_s_setprio(n)
#define SCHED_BARRIER() __builtin_amdgcn_sched_barrier(0)
#define COMPILER_FENCE() asm volatile("" ::: "memory")
#define WAVE_LDS_SYNC() asm volatile("s_waitcnt lgkmcnt(0)" ::: "memory")
#define LAUNDER(x) asm volatile("" : "+v"(x))
#define CODE_ALIGN() asm volatile(".p2align 8")
#define LAUNDER_S(x) asm volatile("" : "+s"(x))
DEV int lane_id() { return (int)__builtin_amdgcn_mbcnt_hi(~0u, __builtin_amdgcn_mbcnt_lo(~0u, 0u)); }
template <class T> DEV T shfl_xor_t(T v, int m) { return __shfl_xor(v, m); }
template <class T> DEV T shfl_t(T v, int src) { return __shfl(v, src); }
template <int CTRL, int ROWMASK> DEV float dpp_mov(float v) { return __builtin_bit_cast(float, __builtin_amdgcn_update_dpp(0, __builtin_bit_cast(int, v), CTRL, ROWMASK, 0xf, false)); }
template <int CTRL, int ROWMASK> DEV float dpp_mov_keep(float oldv, float v) { return __builtin_bit_cast(float, __builtin_amdgcn_update_dpp(__builtin_bit_cast(int, oldv), __builtin_bit_cast(int, v), CTRL, ROWMASK, 0xf, false)); }
template <int W> DEV float group_sum(float v) {
    v += dpp_mov<0xB1, 0xf>(v); v += dpp_mov<0x4E, 0xf>(v);
    if (W >= 8) v += dpp_mov<0x141, 0xf>(v);
    if (W >= 16) v += dpp_mov<0x140, 0xf>(v);
    return v;
}
DEV float wave_sum(float v) {
    v = group_sum<16>(v);
    v += dpp_mov<0x142, 0xa>(v);
    v += dpp_mov<0x143, 0xc>(v);
    return __builtin_bit_cast(float, __builtin_amdgcn_readlane(__builtin_bit_cast(int, v), 63));
}
DEV float wave_max(float v) {
    v = fmaxf(v, dpp_mov_keep<0xB1, 0xf>(v, v)); v = fmaxf(v, dpp_mov_keep<0x4E, 0xf>(v, v)); v = fmaxf(v, dpp_mov_keep<0x141, 0xf>(v, v)); v = fmaxf(v, dpp_mov_keep<0x140, 0xf>(v, v));
    v = fmaxf(v, dpp_mov_keep<0x142, 0xa>(v, v)); v = fmaxf(v, dpp_mov_keep<0x143, 0xc>(v, v));
    return __builtin_bit_cast(float, __builtin_amdgcn_readlane(__builtin_bit_cast(int, v), 63));
}
template <int W> DEV float group_max(float v) {
    v = fmaxf(v, dpp_mov_keep<0xB1, 0xf>(v, v)); v = fmaxf(v, dpp_mov_keep<0x4E, 0xf>(v, v));
    if (W >= 8) v = fmaxf(v, dpp_mov_keep<0x141, 0xf>(v, v));
    if (W >= 16) v = fmaxf(v, dpp_mov_keep<0x140, 0xf>(v, v));
    return v;
}
DEV int bcast_lane(int v, int src) { return __builtin_amdgcn_readlane(v, src); }
DEV float bcast_lane_f(float v, int src) { return __builtin_bit_cast(float, __builtin_amdgcn_readlane(__builtin_bit_cast(int, v), src)); }
DEV float wave_scan_add(float v) {
    v += dpp_mov<0x111, 0xf>(v); v += dpp_mov<0x112, 0xf>(v); v += dpp_mov<0x114, 0xf>(v); v += dpp_mov<0x118, 0xf>(v);
    v += dpp_mov<0x142, 0xa>(v); v += dpp_mov<0x143, 0xc>(v); return v;
}
DEV float wave_scan_max(float v) {
    v = fmaxf(v, dpp_mov_keep<0x111, 0xf>(v, v)); v = fmaxf(v, dpp_mov_keep<0x112, 0xf>(v, v)); v = fmaxf(v, dpp_mov_keep<0x114, 0xf>(v, v)); v = fmaxf(v, dpp_mov_keep<0x118, 0xf>(v, v));
    v = fmaxf(v, dpp_mov_keep<0x142, 0xa>(v, v)); v = fmaxf(v, dpp_mov_keep<0x143, 0xc>(v, v)); return v;
}
DEV int readfirstlane_i(int v) { return __builtin_amdgcn_readfirstlane(v); }
DEV unsigned xb_ld(unsigned* p) { return __hip_atomic_load(p, __ATOMIC_RELAXED, __HIP_MEMORY_SCOPE_AGENT); }
DEV unsigned xb_add(unsigned* p, unsigned v) { return __hip_atomic_fetch_add(p, v, __ATOMIC_RELAXED, __HIP_MEMORY_SCOPE_AGENT); }
DEV unsigned xb_xcc_id() { return (unsigned)__builtin_amdgcn_s_getreg((3 << 11) | 20) & 0xFu; }
DEV void s_sleep1() { __builtin_amdgcn_s_sleep(1); }
DEV void fence_acquire() { __builtin_amdgcn_fence(__ATOMIC_ACQUIRE, "agent"); }
DEV void fence_release() { __builtin_amdgcn_fence(__ATOMIC_RELEASE, "agent"); }
DEV unsigned lds_atomic_add(LAS unsigned* p, unsigned v) { return __hip_atomic_fetch_add(p, v, __ATOMIC_RELAXED, __HIP_MEMORY_SCOPE_WORKGROUP); }
DEV unsigned long long rt_now() { return __builtin_amdgcn_s_memrealtime(); }
DEV float fast_exp2(float x) { return __builtin_amdgcn_exp2f(x); }
DEV float fast_rcp(float x) { return __builtin_amdgcn_rcpf(x); }
#endif

#ifdef EMU
DEV unsigned f2bf(float f) { unsigned u = __builtin_bit_cast(unsigned, f); return (u + 0x7fffu + ((u >> 16) & 1u)) >> 16; }
DEV unsigned pk2(float lo, float hi) { return f2bf(lo) | (f2bf(hi) << 16); }
DEV unsigned f2bf_sw(float f) { return f2bf(f); }
DEV unsigned pk2_sw(float lo, float hi) { return pk2(lo, hi); }
#else
typedef float f32x2n_t __attribute__((ext_vector_type(2)));
typedef __bf16 bf16x2n_t __attribute__((ext_vector_type(2)));
DEV unsigned pk2(float lo, float hi) { const f32x2n_t v = {lo, hi}; return __builtin_bit_cast(unsigned, __builtin_convertvector(v, bf16x2n_t)); }
DEV unsigned f2bf(float f) { return (unsigned)__builtin_bit_cast(unsigned short, (__bf16)f); }
DEV unsigned f2bf_sw(float f) { unsigned u = __builtin_bit_cast(unsigned, f); return (u + 0x7fffu + ((u >> 16) & 1u)) >> 16; }
DEV unsigned pk2_sw(float lo, float hi) { return f2bf_sw(lo) | (f2bf_sw(hi) << 16); }
#endif
DEV float bf2f(unsigned b) { return __builtin_bit_cast(float, b << 16); }
DEV float bflo(unsigned w) { return __builtin_bit_cast(float, w << 16); }
DEV float bfhi(unsigned w) { return __builtin_bit_cast(float, w & 0xffff0000u); }
DEV float sigmoid_f(float x) { return 1.0f / (1.0f + expf(-x)); }
DEV float silu_f(float x) { return x / (1.0f + expf(-x)); }
DEV float softplus_f(float x) { return fmaxf(x, 0.0f) + log1pf(expf(-fabsf(x))); }
DEV float fast_sigmoid(float x) { return fast_rcp(1.0f + fast_exp2(-1.4426950408889634f * x)); }
DEV float fast_silu(float x) { return x * fast_sigmoid(x); }
DEV float gelu_tanh_f(float x) { const float u = 0.7978845608028654f * (x + 0.044715f * x * x * x); return x * fast_sigmoid(2.0f * u); }
DEV float fast_exp(float x) { return fast_exp2(1.4426950408889634f * x); }

#define XB_TMO      128
#define XB_XCNT(j)  (256  + 64 * (j))
#define XB_XSUB(j)  (1280 + 64 * (j))
#define XB_XGEN(j)  (2304 + 64 * (j))
#define XB_TOP      3328
#define XB_TOPGEN   3392
#define XCD_BAR_WORDS 3456
#define XB_SPIN_CAP (1u << 20)
#define XB_SPIN(cond, bar) do { unsigned _sp = 0; while (cond) { s_sleep1(); \
    if ((++_sp & 255u) == 0u) { if (xb_ld(&(bar)[XB_TMO])) break; if (_sp > XB_SPIN_CAP) { xb_add(&(bar)[XB_TMO], 1u); break; } } } } while (0)
struct XcdBarrier { unsigned* bar; unsigned x; volatile LAS unsigned* st; int wave; };
DEV XcdBarrier xcd_barrier_post(unsigned* bar, volatile LAS unsigned* st, int wave) {
    XcdBarrier b; b.wave = wave; b.bar = bar; b.x = (unsigned)readfirstlane_i((int)xb_xcc_id()); b.st = st;
    if (wave == 0 && lane_id() == 0) (void)xb_add(&bar[XB_XCNT(b.x)], 1u);
    return b;
}
DEV void xcd_barrier_complete(unsigned* bar, unsigned x, unsigned& nloc, unsigned& nx) {
    const unsigned G = gridDim.x;
    unsigned sum, cnt, mine, sp = 0u;
    for (;;) {
        sum = 0u; cnt = 0u; mine = 0u;
#pragma unroll
        for (unsigned j = 0; j < 16; ++j) { const unsigned c = xb_ld(&bar[XB_XCNT(j)]); sum += c; cnt += (c > 0u) ? 1u : 0u; mine = (j == x) ? c : mine; }
        if (sum == G) break;
        s_sleep1();
        if ((++sp & 255u) == 0u) { if (xb_ld(&bar[XB_TMO])) break; if (sp > XB_SPIN_CAP) { xb_add(&bar[XB_TMO], 1u); break; } }
    }
    nloc = mine > 0u ? mine : 1u; nx = cnt > 0u ? cnt : 1u;
}
DEV void xcd_barrier(const XcdBarrier& b) {
    WAIT_VM(0);
    __syncthreads();
    int bw = b.wave; LAUNDER_S(bw);
    if (bw == 0 && lane_id() == 0) {
        unsigned* bar = b.bar; LAUNDER_S(bar);
        unsigned bx = b.x; LAUNDER_S(bx);
        WAIT_ALL();
        unsigned nloc = b.st[0], nx = b.st[1];
        if (nloc == 0u) { xcd_barrier_complete(bar, bx, nloc, nx); b.st[0] = nloc; b.st[1] = nx; }
        const unsigned old = xb_add(&bar[XB_XSUB(bx)], 1u);
        const unsigned gen = old / nloc;
        if (old + 1u == (gen + 1u) * nloc) {
            fence_release();
            WAIT_VM(0);
            const unsigned og = xb_add(&bar[XB_TOP], 1u);
            const unsigned tg = og / nx;
            if (og + 1u == (tg + 1u) * nx) xb_add(&bar[XB_TOPGEN], 1u);
            else XB_SPIN(xb_ld(&bar[XB_TOPGEN]) == tg, bar);
            fence_acquire();
            xb_add(&bar[XB_XGEN(bx)], 1u);
            WAIT_VM(0);
        } else {
            XB_SPIN(xb_ld(&bar[XB_XGEN(bx)]) == gen, bar);
            fence_acquire();
            WAIT_VM(0);
        }
    }
    __syncthreads();
}

namespace pg8 {
constexpr int BM = 256, BK = 64, HALF = 128, HTB = HALF * BK * 2, STAGE_BYTES = 8 * HTB;
DEV int lds_byte(int r, int c) { const int st = (r >> 4) * 2 + (c >> 5), rr = r & 15, cc = c & 31, ob = rr * 64 + cc * 2; return st * 1024 + (ob ^ (((ob >> 9) & 1) << 5)); }
DEV void stage_rc(int b, int& R, int& C) { const int st = b / 1024, sb = b % 1024, swz = sb ^ (((sb >> 9) & 1) << 5); R = (st >> 1) * 16 + swz / 64; C = (st & 1) * 32 + (swz % 64) / 2; }
DEV int perm32(int rho) { const int n = rho >> 4, i = rho & 15; return 8 * (i >> 2) + 4 * n + (i & 3); }
struct Unit { const char* A; const char* B; int pm, pn, e; };
#ifdef EMU
static inline unsigned cvt_pk_bf16(float lo, float hi) { return pk2(lo, hi); }
#else
DEV unsigned cvt_pk_bf16(float lo, float hi) { return pk2(lo, hi); }
#endif
template <class Epi, class Sched>
DEV void gemm_phase(LAS unsigned char* lds, const int K, const Sched& S, const Epi& E, const int wid, const int lane) {
    const int tid = wid * 64 + lane; const int wr = wid >> 2, wc = wid & 3, fr = lane & 15, fq = lane >> 4;
    const int nt = K / BK;
    unsigned voffA[2], voffB[2];
#pragma unroll
    for (int i = 0; i < 2; ++i) { int R, C; stage_rc(tid * 16 + i * 8192, R, C); const int Rb = Epi::PERM ? ((R & ~31) + perm32(R & 31)) : R;
        voffA[i] = (unsigned)(R * K + C) * 2u; voffB[i] = (unsigned)(Rb * K + C) * 2u; }
    const size_t kstep = (size_t)(BK * 2);
    const size_t hstep = (size_t)HALF * K * 2;
    const unsigned ldsw = (unsigned)wid * 1024u;
    const int aoff = lds_byte(wr * 64 + fr, fq * 8), boff = lds_byte(wc * 32 + fr, fq * 8);
#define PG8_SA(b, h) (((b) * 2 + (h)) * HTB)
#define PG8_SB(b, h) ((4 + (b) * 2 + (h)) * HTB)
#define PG8_STAGE(bufoff, gbase, voff) do { _Pragma("unroll") for (int _i = 0; _i < 2; ++_i) \
        glds16(((const char*)(gbase) + (voff)[_i]), (lds + (bufoff) + ldsw + _i * 8192)); } while (0)
#define PG8_LDA(dst, b, h) do { _Pragma("unroll") for (int m = 0; m < 4; ++m) _Pragma("unroll") for (int k = 0; k < 2; ++k) dst[m][k] = *(const LAS bf16x8*)(lds + PG8_SA(b, h) + aoff + m * 2048 + k * 1024); } while (0)
#define PG8_LDB(dst, b, h) do { _Pragma("unroll") for (int n = 0; n < 2; ++n) _Pragma("unroll") for (int k = 0; k < 2; ++k) dst[n][k] = *(const LAS bf16x8*)(lds + PG8_SB(b, h) + boff + n * 2048 + k * 1024); } while (0)
#define PG8_MMA(ai, bj, At, Bt) do { SETPRIO(1); _Pragma("unroll") for (int m = 0; m < 4; ++m) _Pragma("unroll") for (int n = 0; n < 2; ++n) _Pragma("unroll") for (int k = 0; k < 2; ++k) \
        acc[ai][bj][m][n] = mfma16(Bt[n][k], At[m][k], acc[ai][bj][m][n]); SETPRIO(0); } while (0)
    Unit cur, nxt; int ui = 0;
    if (!S.next(0, cur)) return;
    f32x4 acc[2][2][4][2];
#pragma unroll
    for (int a = 0; a < 2; ++a)
#pragma unroll
        for (int b = 0; b < 2; ++b)
#pragma unroll
            for (int m = 0; m < 4; ++m)
#pragma unroll
                for (int n = 0; n < 2; ++n) acc[a][b][m][n] = (f32x4){0.f, 0.f, 0.f, 0.f};
    bf16x8 At[4][2], B0[2][2], B1[2][2];
    const char* cA = cur.A; const char* cB = cur.B;
    PG8_STAGE(PG8_SB(0, 0), cB, voffB); PG8_STAGE(PG8_SB(0, 1), cB + hstep, voffB); PG8_STAGE(PG8_SA(0, 0), cA, voffA); PG8_STAGE(PG8_SA(0, 1), cA + hstep, voffA);
    if (wr == 1) S_BARRIER();
    WAIT_VM(2); S_BARRIER();
    PG8_STAGE(PG8_SB(1, 0), cB + kstep, voffB); PG8_STAGE(PG8_SA(1, 0), cA + kstep, voffA); PG8_STAGE(PG8_SB(1, 1), cB + hstep + kstep, voffB);
    WAIT_VM(6); S_BARRIER();
    CODE_ALIGN();
    for (;;) {
        const bool has_next = S.next(ui + 1, nxt);
        const char* nA = has_next ? nxt.A : cA; const char* nB = has_next ? nxt.B : cB;
        for (int t = 0; t < nt; t += 2) {
            const bool last = (t == nt - 2);
            const char* a1 = cA + (size_t)(t + 1) * kstep;
            const char* a2 = last ? nA : cA + (size_t)(t + 2) * kstep; const char* b2 = last ? nB : cB + (size_t)(t + 2) * kstep;
            const char* a3 = a2 + kstep; const char* b3 = b2 + kstep;
            PG8_LDB(B0, 0, 0); PG8_LDB(B1, 0, 1); SCHED_BARRIER(); PG8_LDA(At, 0, 0); PG8_STAGE(PG8_SA(1, 1), a1 + hstep, voffA);
            WAIT_VM(8); WAIT_LGKM(0); S_BARRIER(); PG8_MMA(0, 0, At, B0); PG8_MMA(0, 1, At, B1); S_BARRIER(); SCHED_BARRIER();
            PG8_LDA(At, 0, 1); PG8_STAGE(PG8_SB(0, 0), b2, voffB); PG8_STAGE(PG8_SB(0, 1), b2 + hstep, voffB); PG8_STAGE(PG8_SA(0, 0), a2, voffA);
            WAIT_VM(8); WAIT_LGKM(0); S_BARRIER(); PG8_MMA(1, 0, At, B0); PG8_MMA(1, 1, At, B1); S_BARRIER(); SCHED_BARRIER();
            PG8_LDB(B0, 1, 0); PG8_LDB(B1, 1, 1); SCHED_BARRIER(); PG8_LDA(At, 1, 0); PG8_STAGE(PG8_SA(0, 1), a2 + hstep, voffA);
            WAIT_VM(8); WAIT_LGKM(0); S_BARRIER(); PG8_MMA(0, 0, At, B0); PG8_MMA(0, 1, At, B1); S_BARRIER(); SCHED_BARRIER();
            PG8_LDA(At, 1, 1); PG8_STAGE(PG8_SB(1, 0), b3, voffB); PG8_STAGE(PG8_SB(1, 1), b3 + hstep, voffB); PG8_STAGE(PG8_SA(1, 0), a3, voffA);
            WAIT_VM(8); WAIT_LGKM(0); S_BARRIER(); PG8_MMA(1, 0, At, B0); PG8_MMA(1, 1, At, B1); S_BARRIER(); SCHED_BARRIER();
        }
        if (wr == 0) S_BARRIER();
        E(acc, cur, wr, wc, fr, fq);
        if (!has_next) break;
#pragma unroll
        for (int a = 0; a < 2; ++a)
#pragma unroll
            for (int b = 0; b < 2; ++b)
#pragma unroll
                for (int m = 0; m < 4; ++m)
#pragma unroll
                    for (int n = 0; n < 2; ++n) acc[a][b][m][n] = (f32x4){0.f, 0.f, 0.f, 0.f};
        cur = nxt; cA = nA; cB = nB; ++ui;
        if (wr == 1) S_BARRIER();
    }
    WAIT_VM(0);
    S_BARRIER();
#undef PG8_SA
#undef PG8_SB
#undef PG8_STAGE
#undef PG8_LDA
#undef PG8_LDB
#undef PG8_MMA
}

struct PlainOrder {
    const char* A; const char* Bt; int K, nM, nN, nwg, G, c;
    DEV void init(const void* A_, const void* Bt_, int K_, int M, int N, int G_, int c_) { A = (const char*)A_; Bt = (const char*)Bt_; K = K_; nM = M / BM; nN = N / BM; nwg = nM * nN; G = G_; c = c_; }
    DEV bool next(int i, Unit& u) const {
        const long L = (long)i * G + c; if (L >= nwg) return false;
        int wgid = (int)L; { const int q = nwg / 8, r = nwg % 8, xcd = wgid % 8, off = wgid / 8; wgid = (xcd < r ? xcd * (q + 1) : r * (q + 1) + (xcd - r) * q) + off; }
        const int nig = 8 * nN, gid = wgid / nig, fm = gid * 8, gsz = (nM - fm) < 8 ? (nM - fm) : 8;
        u.pm = fm + ((wgid % nig) % gsz); u.pn = (wgid % nig) / gsz; u.e = 0;
        u.A = A + (size_t)u.pm * BM * K * 2; u.B = Bt + (size_t)u.pn * BM * K * 2; return true;
    }
};
struct GroupedOrder {
    const char* A; const char* Bt; int K, nMe, nN, nwg, G, c; size_t bstride;
    DEV void init(const void* A_, const void* Bt_, int K_, int N, int G_, int c_, int erows) { A = (const char*)A_; Bt = (const char*)Bt_; K = K_; nMe = (erows + BM - 1) / BM; nN = N / BM; nwg = NE * nMe * nN; G = G_; c = c_; bstride = (size_t)N * K * 2; }
    DEV bool next(int i, Unit& u) const {
        const long L = (long)i * G + c; if (L >= nwg) return false;
        int wgid = (int)L; { const int q = nwg / 8, r = nwg % 8, xcd = wgid % 8, off = wgid / 8; wgid = (xcd < r ? xcd * (q + 1) : r * (q + 1) + (xcd - r) * q) + off; }
        const int per_e = nMe * nN; const int e = wgid / per_e, w = wgid % per_e;
        u.e = e; u.pm = w % nMe; u.pn = w / nMe;
        u.A = A + ((size_t)e * EPAD + (size_t)u.pm * BM) * K * 2; u.B = Bt + (size_t)e * bstride + (size_t)u.pn * BM * K * 2; return true;
    }
};
}

struct Args { const float* in[N_IN]; float* out; unsigned char* ws; };

struct Frame {
    const float* const* in; GAS float* out; GAS unsigned char* ws; LAS unsigned char* lds;
    int tid, lane, wave, G, bid, gw, NGW;
};

#define HROW(F, l, r) ((l) == 0 ? ((r) < LATR ? GIN(I_X) + (size_t)(r) * 1024 : GIN(I_CTX) + (size_t)((r) - LATR) * 1024) : (const float*)((F).ws + WS_H) + (size_t)(r) * 1024)

DEV Frame refresh(const Frame& F0) {
    Frame F = F0; int w = F0.wave; LAUNDER_S(w); int ln = lane_id(); LAUNDER(ln);
    F.wave = w; F.lane = ln; F.tid = w * 64 + ln; F.gw = F.bid * NWAVES + w;
    GAS unsigned char* ws = F0.ws; LAUNDER_S(ws); F.ws = ws;
    return F;
}

#define GIN(k) ((const float*)(GAS const float*)F.in[k])

#define ROW_LOOP(r, NROWS) for (int r = F.gw; r < (NROWS); r += F.NGW)

DEV int tok_row(int b, int d, int sp) {
    if (sp < CTX) return LATR + b * CTX + (d ? (CTX - 1 - sp) : sp);
    const int j = sp - CTX; return b * SEQ + (d ? (SEQ - 1 - j) : j);
}
DEV void row_bs(int r, int& b, int& s) { if (r < LATR) { b = r / SEQ; s = CTX + r % SEQ; } else { const int q = r - LATR; b = q / CTX; s = q % CTX; } }

DEV void tr_item(const float* W, int ldw, int col0, int k0, bf16_t* WT, int K, int row0, LAS float* scr, int lane) {
#pragma unroll 8
    for (int i = 0; i < 32; ++i) { const int kk = 2 * i + (lane >> 5); scr[kk * 33 + (lane & 31)] = W[(size_t)(k0 + kk) * ldw + col0 + (lane & 31)]; }
    WAVE_LDS_SYNC();
    const int c = lane & 7;
#pragma unroll
    for (int j = 0; j < 4; ++j) { const int n = (lane >> 3) + 8 * j; const LAS float* s = scr + (8 * c) * 33 + n;
        u32x4 o; o.x = pk2(s[0 * 33], s[1 * 33]); o.y = pk2(s[2 * 33], s[3 * 33]); o.z = pk2(s[4 * 33], s[5 * 33]); o.w = pk2(s[6 * 33], s[7 * 33]);
        *(u32x4*)(WT + (size_t)(row0 + n) * K + k0 + 8 * c) = o; }
    WAVE_LDS_SYNC();
}

DEV void phase_prologue_a(const Frame& F0) {
    const Frame F = refresh(F0);
    LAS float* scr = (LAS float*)(F.lds + F.wave * 16384);
    for (int l = 0; l < DEPTH; ++l) {
        const int odd = l & 1, li = l >> 1;
        const float* win = odd ? GIN(I_ODWIN) + (size_t)li * 1024 * 2576 : GIN(I_EVWIN) + (size_t)li * 1024 * 4112;
        const int ldw = odd ? 2576 : 4112, nin = odd ? NIN_O : NIN_E;
        bf16_t* wint = (bf16_t*)(F.ws + WS_WIN) + (size_t)l * NINMAX * 1024;
        for (int it = F.gw; it < 16 * (nin / 32); it += F.NGW) { const int kb = it / (nin / 32), nb = it % (nin / 32); const int d0 = 32 * nb;
            tr_item(win, ldw, d0 < 2048 ? d0 : d0 + 16, 64 * kb, wint, 1024, d0, scr, F.lane); }
        const float* wout = odd ? GIN(I_ODWOUT) + (size_t)li * 1024 * 1024 : GIN(I_EVWOUT) + (size_t)li * 1024 * 1024;
        bf16_t* woutt = (bf16_t*)(F.ws + WS_WOUT) + (size_t)l * 1024 * 1024;
        for (int it = F.gw; it < 16 * 32; it += F.NGW) { const int kb = it / 32, nb = it % 32; tr_item(wout, 1024, 32 * nb, 64 * kb, woutt, 1024, 32 * nb, scr, F.lane); }
        if (odd) {
            const float* wglu = GIN(I_ODWGLU) + (size_t)li * 512 * 512; bf16_t* wglut = (bf16_t*)(F.ws + WS_WGLU) + (size_t)li * 512 * 512;
            for (int it = F.gw; it < 8 * 16; it += F.NGW) { const int kb = it / 16, nb = it % 16; tr_item(wglu, 512, 32 * nb, 64 * kb, wglut, 512, 32 * nb, scr, F.lane); }
        }
        constexpr int GU_NB = 2 * FF / 32, GU_ITEMS = 16 * GU_NB;
        for (int it = F.gw; it < NE * GU_ITEMS; it += F.NGW) { const int e = it / GU_ITEMS, r = it % GU_ITEMS, kb = r / GU_NB, nb = r % GU_NB; const int d0 = 32 * nb, j = d0 >> 8, w = d0 & 255;
            const float* src = (w < 128 ? GIN(I_WGATE) : GIN(I_WUP)) + ((size_t)l * NE + e) * 1024 * FF;
            tr_item(src, FF, 128 * j + (w & 127), 64 * kb, (bf16_t*)(F.ws + WS_WGU) + ((size_t)l * NE + e) * 2 * FF * 1024, 1024, d0, scr, F.lane); }
        constexpr int D_ITEMS = (FF / 64) * 32;
        for (int it = F.gw; it < NE * D_ITEMS; it += F.NGW) { const int e = it / D_ITEMS, r = it % D_ITEMS, kb = r / 32, nb = r % 32;
            tr_item(GIN(I_WDOWN) + ((size_t)l * NE + e) * FF * 1024, 1024, 32 * nb, 64 * kb, (bf16_t*)(F.ws + WS_WD) + ((size_t)l * NE + e) * 1024 * FF, FF, 32 * nb, scr, F.lane); }
    }
    const int gt = F.bid * NTHREADS + F.tid, NGT = F.G * NTHREADS;
    for (int i = gt; i < DEPTH * 16 * 1024; i += NGT) { const int l = i / 16384, g = (i >> 10) & 15, k = i & 1023; const int odd = l & 1, li = l >> 1;
        ((float*)(F.ws + WS_WG))[i] = odd ? GIN(I_ODWIN)[((size_t)li * 1024 + k) * 2576 + 2048 + g] : GIN(I_EVWIN)[((size_t)li * 1024 + k) * 4112 + 2048 + g]; }
    for (int i = gt; i < DEPTH * NE * 1024; i += NGT) { const int k = i & 1023, e = (i >> 10) % NE, l = i / (NE * 1024); ((float*)(F.ws + WS_WR))[i] = GIN(I_WROUTER)[((size_t)l * 1024 + k) * NE + e]; }
    for (int i = gt; i < N_ODD * 2 * 32 * 64; i += NGT) { const int p = i & 63, g = (i >> 6) & 31, d = (i >> 11) & 1, o = i >> 12;
        const int idx = ((o * 2 + d) * 32 + g) * 64 + p;
        const float lr = fminf(GIN(I_ODLRE)[idx], -1e-4f), li_ = GIN(I_ODLIM)[idx], dt = expf(GIN(I_ODLDT)[(o * 2 + d) * 32 + g]);
        const float mag = expf(lr * dt); float sn, cs; sincosf(li_ * dt, &sn, &cs); const float are = mag * cs, aim = mag * sn;
        float* A = (float*)(F.ws + WS_S5A) + (size_t)((o * 2 + d) * 32 + g) * 128; A[p] = are; A[64 + p] = aim;
        const float xr = are - 1.0f, xi = aim, den = lr * lr + li_ * li_; const float fre = (xr * lr + xi * li_) / den, fim = (xi * lr - xr * li_) / den;
        bf16_t* Bb = (bf16_t*)(F.ws + WS_S5B) + (size_t)((o * 2 + d) * 32 + g) * 128 * 16;
        for (int h = 0; h < 16; ++h) { const float br = GIN(I_ODBRE)[((size_t)(o * 32 + g) * 64 + p) * 16 + h], bi = GIN(I_ODBIM)[((size_t)(o * 32 + g) * 64 + p) * 16 + h];
            Bb[p * 16 + h] = (bf16_t)f2bf(fre * br - fim * bi); Bb[(64 + p) * 16 + h] = (bf16_t)f2bf(fre * bi + fim * br); } }
    for (int i = gt; i < N_ODD * 32 * 16 * 64; i += NGT) { const int p = i & 63, c = (i >> 6) & 15, g = (i >> 10) & 31, o = i >> 15;
        bf16_t* Cm = (bf16_t*)(F.ws + WS_S5C) + (size_t)((o * 32 + g) * 16 + c) * 128;
        Cm[2 * p] = (bf16_t)f2bf(GIN(I_ODCRE)[i]); Cm[2 * p + 1] = (bf16_t)f2bf(-GIN(I_ODCIM)[i]); }
    ROW_LOOP(r, MPAD) {
        f32x4* dst = (f32x4*)((float*)(F.ws + WS_H) + (size_t)r * 1024) + F.lane;
        if (r < MROWS) { }
        else {
#pragma unroll
            for (int j = 0; j < 4; ++j) dst[64 * j] = (f32x4){0.f, 0.f, 0.f, 0.f};
            u32x4* xz = (u32x4*)((bf16_t*)(F.ws + WS_XIN) + (size_t)r * 1024) + F.lane; xz[0] = (u32x4){0u, 0u, 0u, 0u}; xz[64] = (u32x4){0u, 0u, 0u, 0u};
            u32x4* mz = (u32x4*)((bf16_t*)(F.ws + WS_MERGED) + (size_t)r * 1024) + F.lane; mz[0] = (u32x4){0u, 0u, 0u, 0u}; mz[64] = (u32x4){0u, 0u, 0u, 0u};
            u32x4* yz = (u32x4*)((bf16_t*)(F.ws + WS_YS) + (size_t)r * 512) + F.lane; yz[0] = (u32x4){0u, 0u, 0u, 0u};
        }
    }
    __syncthreads();
    LAS float* sv = (LAS float*)F.lds;
    LAS float* part = (LAS float*)(F.lds + 32768);
    for (int i = F.tid; i < NR * 1024; i += NTHREADS) { const int r = i >> 10, k = i & 1023; const float c = r < B_ ? GIN(I_C)[r * 1024 + k] : GIN(I_CCTX)[k]; sv[i] = silu_f(c); }
    __syncthreads();
    for (int it = F.bid; it < DEPTH * 96; it += F.G) {
        const int l = it / 96, j = (it % 96) * 64 + F.lane;
        const float* w = GIN(I_WMOD) + (size_t)l * 1024 * 6144 + j;
        float acc[NR];
#pragma unroll
        for (int r = 0; r < NR; ++r) acc[r] = 0.f;
        const int k0 = F.wave * 128;
#pragma unroll 8
        for (int k = 0; k < 128; ++k) { const float wv = w[(size_t)(k0 + k) * 6144];
#pragma unroll
            for (int r = 0; r < NR; ++r) acc[r] += sv[r * 1024 + k0 + k] * wv; }
#pragma unroll
        for (int r = 0; r < NR; ++r) part[(F.wave * NR + r) * 64 + F.lane] = acc[r];
        __syncthreads();
        for (int i = F.tid; i < NR * 64; i += NTHREADS) { const int r = i >> 6, jj = i & 63; float s = 0.f;
#pragma unroll
            for (int w8 = 0; w8 < 8; ++w8) s += part[(w8 * NR + r) * 64 + jj];
            const int col = (it % 96) * 64 + jj;
            ((float*)(F.ws + WS_MOD))[((size_t)l * NR + r) * 6144 + col] = s + GIN(I_BMOD)[l * 6144 + col]; }
        __syncthreads();
    }
}

static_assert(TOK % 4 == 0 && CTX % 4 == 0 && MROWS % 4 == 0, "row groups");
#define ROW_GROUPS(nrows, CALL4, CALL2) do { const int _r4 = ((nrows) / (4 * F.NGW)) * (4 * F.NGW); \
    for (int r = 4 * F.gw; r < _r4; r += 4 * F.NGW) { CALL4; } for (int r = _r4 + 2 * F.gw; r < (nrows); r += 2 * F.NGW) { CALL2; } } while (0)
template <int RG> DEV void xg_rows(const Frame& F, int l, int row0, f32x4 (&v)[RG][4]) {
    int b, s; row_bs(row0, b, s); const int mr = s < CTX ? B_ : b;
    const float* mod = (const float*)(F.ws + WS_MOD) + ((size_t)l * NR + mr) * 6144;
#pragma unroll
    for (int j = 0; j < 4; ++j) { const f32x4 sh = *((const f32x4*)mod + F.lane + 64 * j), sc = *((const f32x4*)(mod + 1024) + F.lane + 64 * j);
#pragma unroll
        for (int q = 0; q < RG; ++q) v[q][j] = v[q][j] * (1.0f + sc) + sh; }
#pragma unroll
    for (int q = 0; q < RG; ++q) { u32x2* xo = (u32x2*)((bf16_t*)(F.ws + WS_XIN) + (size_t)(row0 + q) * 1024) + F.lane;
#pragma unroll
        for (int j = 0; j < 4; ++j) xo[64 * j] = (u32x2){pk2(v[q][j].x, v[q][j].y), pk2(v[q][j].z, v[q][j].w)}; }
    const float* wg = (const float*)(F.ws + WS_WG) + (size_t)l * 16 * 1024;
    float mine[RG]; const int gi = F.lane & 15;
#pragma unroll
    for (int q = 0; q < RG; ++q) mine[q] = 0.f;
    f32x4 wc[4];
#pragma unroll
    for (int j = 0; j < 4; ++j) wc[j] = *((const f32x4*)wg + F.lane + 64 * j);
#pragma unroll 1
    for (int g = 0; g < 16; ++g) { f32x4 wn[4]; const int gn = g + 1 < 16 ? g + 1 : g;
#pragma unroll
        for (int j = 0; j < 4; ++j) wn[j] = *((const f32x4*)(wg + gn * 1024) + F.lane + 64 * j);
#pragma unroll
        for (int q = 0; q < RG; ++q) { float p = 0.f;
#pragma unroll
            for (int j = 0; j < 4; ++j) p += v[q][j].x * wc[j].x + v[q][j].y * wc[j].y + v[q][j].z * wc[j].z + v[q][j].w * wc[j].w;
            const float t = wave_sum(p); mine[q] = (gi == g) ? t : mine[q]; }
#pragma unroll
        for (int j = 0; j < 4; ++j) wc[j] = wn[j]; }
    const int ty = gi >> 2, hh = gi & 3, li = l >> 1;
#pragma unroll
    for (int q = 0; q < RG; ++q) { float o;
        if (!(l & 1)) {
            if (ty < 2) o = -expf(GIN(I_EVALOG)[(li * 2 + ty) * 4 + hh]) * softplus_f(mine[q] + GIN(I_EVDTB)[(li * 2 + ty) * 4 + hh]);
            else o = sigmoid_f(mine[q]);
        } else {
            const int d = ty & 1, k = ty >> 1; const float gb = GIN(I_ODGB)[((li * 2 + d) * 2 + k) * 4 + hh];
            o = k ? -softplus_f(-(mine[q] + gb)) : mine[q] + gb;
        }
        if (F.lane < 16) ((float*)(F.ws + WS_GATES))[(size_t)(row0 + q) * 16 + gi] = o; }
}

template <int RG> DEV void xg0_group(const Frame& F, int r) {
        f32x4 v[RG][4];
#pragma unroll
        for (int q = 0; q < RG; ++q) { const f32x4* hr = (const f32x4*)HROW(F, 0, r + q) + F.lane;
#pragma unroll
            for (int j = 0; j < 4; ++j) v[q][j] = hr[64 * j]; }
        xg_rows<RG>(F, 0, r, v);
    }
DEV void phase_xg0(const Frame& F0) {
    const Frame F = refresh(F0);
    ROW_GROUPS(MROWS, xg0_group<4>(F, r), xg0_group<2>(F, r));
}

template <int RG> DEV void prep_group(const Frame& F, int l, int r) {

    const int odd = l & 1, li = l >> 1; const int nin = odd ? NIN_O : NIN_E, nseg = odd ? 2 : 3, qld = odd ? 1024 : 1536;
    const bf16_t* P = (const bf16_t*)(F.ws + WS_P); bf16_t* Q = (bf16_t*)(F.ws + WS_QKV);
    const float* cw = odd ? GIN(I_ODCONV) + (size_t)li * 9 * 1024 : GIN(I_EVCONV) + (size_t)li * 9 * 1536; const int cch = odd ? 1024 : 1536;
    {
        int b, s; row_bs(r, b, s); const bool lat = s >= CTX; const int rr = lat ? (s - CTX) >> 6 : 0, cc = lat ? (s - CTX) & 63 : s;
        const int ncol = lat ? 64 : CTX;
        for (int seg = 0; seg < nseg; ++seg) {
            const int ch0 = seg * 512 + F.lane * 8; float a[RG][8];
#pragma unroll
            for (int q = 0; q < RG; ++q)
#pragma unroll
                for (int i = 0; i < 8; ++i) a[q][i] = 0.f;
#pragma unroll
            for (int kh = 0; kh < 3; ++kh) {
                const int r2 = rr + kh - 1; const bool rok = lat ? (r2 >= 0 && r2 < SEQ / 64) : (kh == 1); const int r2c = rok ? r2 : rr;
                f32x4 w0[3], w1[3];
#pragma unroll
                for (int kw = 0; kw < 3; ++kw) { w0[kw] = *(const f32x4*)(cw + (kh * 3 + kw) * cch + ch0); w1[kw] = *(const f32x4*)(cw + (kh * 3 + kw) * cch + ch0 + 4); }
                const int rowbase = lat ? b * SEQ + r2c * 64 : LATR + b * CTX;
                u32x4 pv[RG + 2];
#pragma unroll
                for (int dc = 0; dc < RG + 2; ++dc) { const int c2 = cc - 1 + dc; const bool ok = rok && c2 >= 0 && c2 < ncol; const int c2c = ok ? c2 : cc;
                    const u32x4 t4 = *(const u32x4*)(P + (size_t)(rowbase + c2c) * nin + ch0); pv[dc] = ok ? t4 : (u32x4){0u, 0u, 0u, 0u}; }
#pragma unroll
                for (int dc = 0; dc < RG + 2; ++dc) {
                    const float x0 = bflo(pv[dc].x), x1 = bfhi(pv[dc].x), x2 = bflo(pv[dc].y), x3 = bfhi(pv[dc].y), x4 = bflo(pv[dc].z), x5 = bfhi(pv[dc].z), x6 = bflo(pv[dc].w), x7 = bfhi(pv[dc].w);
#pragma unroll
                    for (int q = 0; q < RG; ++q) { const int kw = dc - q;
                        if (kw >= 0 && kw <= 2) { a[q][0] += x0 * w0[kw].x; a[q][1] += x1 * w0[kw].y; a[q][2] += x2 * w0[kw].z; a[q][3] += x3 * w0[kw].w;
                            a[q][4] += x4 * w1[kw].x; a[q][5] += x5 * w1[kw].y; a[q][6] += x6 * w1[kw].z; a[q][7] += x7 * w1[kw].w; } } }
            }
#pragma unroll
            for (int q = 0; q < RG; ++q) {
                float ss = 0.f;
#pragma unroll
                for (int i = 0; i < 8; ++i) { a[q][i] = fast_silu(a[q][i]); ss += a[q][i] * a[q][i]; }
                float sc = 1.0f;
                if (!odd) { if (seg < 2) { ss = group_sum<16>(ss); sc = 1.0f / sqrtf(ss + 1e-6f); if (seg == 0) sc *= HD_SCALE; } }
                else if (seg == 1) sc = HD_SCALE;
                u32x4 o; o.x = pk2(a[q][0] * sc, a[q][1] * sc); o.y = pk2(a[q][2] * sc, a[q][3] * sc); o.z = pk2(a[q][4] * sc, a[q][5] * sc); o.w = pk2(a[q][6] * sc, a[q][7] * sc);
                *(u32x4*)(Q + (size_t)(r + q) * qld + ch0) = o;
            }
        }
    }
}
DEV void phase_prep(const Frame& F0, int l) {
    const Frame F = refresh(F0);
    const int odd = l & 1;
    ROW_GROUPS(MROWS, prep_group<4>(F, l, r), prep_group<2>(F, l, r));

    if (odd) {
        const float* GT = (const float*)(F.ws + WS_GATES); float* MC = (float*)(F.ws + WS_MCH);
        for (int c = F.gw; c < B_ * 4 * 2; c += F.NGW) { const int d = c & 1, hh = (c >> 1) & 3, b = c >> 3; float m = 0.f;
            for (int n = 0; n < NCH; ++n) { const int row = tok_row(b, d, n * 64 + F.lane);
                const float lin = GT[(size_t)row * 16 + d * 4 + hh], lf = GT[(size_t)row * 16 + 8 + d * 4 + hh];
                const float bc = wave_scan_add(lf);
                const float bend = bcast_lane_f(bc, 63); const float amax = wave_max(bend - bc + lin);
                if (F.lane == 0) MC[(size_t)c * NCH + n] = m;
                m = fmaxf(bend + m, amax); }
        }
    }
}

DEV int swz256(int r, int k) { return r * 256 + 16 * (k ^ (r & 15)); }
DEV int swz128(int r, int k) { return r * 128 + 16 * (k ^ ((r >> 1) & 7)); }
constexpr int CL_IMG = 90112;
struct ClProb { int n, d, hh, b, kind, qld, vld; const bf16_t *qsrc, *ksrc, *vsrc; float kscale; };
DEV ClProb cl_decode(const Frame& F, int p, int odd, int nhh) {
    ClProb c; c.n = p % NCH; c.d = (p / NCH) & 1; c.hh = (p / (2 * NCH)) % nhh; c.b = p / (2 * NCH * nhh); c.kind = odd ? 2 : (c.hh < 4 ? 0 : 1); c.kscale = 1.0f;
    const bf16_t* P = (const bf16_t*)(F.ws + WS_P); const bf16_t* Q = (const bf16_t*)(F.ws + WS_QKV);
    if (c.kind == 0) { c.qsrc = Q + c.hh * 128; c.ksrc = Q + 512 + c.hh * 128; c.vsrc = Q + 1024 + c.hh * 128; c.qld = 1536; c.vld = 1536; }
    else if (c.kind == 1) { c.qsrc = P + 2048 + (c.hh - 4) * 128; c.ksrc = P + 2560 + (c.hh - 4) * 128; c.vsrc = P + 3072 + (c.hh - 4) * 128; c.qld = NIN_E; c.vld = NIN_E; c.kscale = HD_SCALE; }
    else { c.qsrc = Q + c.hh * 128; c.ksrc = Q + 512 + c.hh * 128; c.vsrc = P + 1024 + c.hh * 128; c.qld = 1024; c.vld = NIN_O; }
    return c;
}
DEV void cl_dma(const Frame& F, const ClProb c) {
    int ln = F.lane; LAUNDER(ln);
    const int r0 = tok_row(c.b, c.d, c.n * 64), sg = c.d ? -1 : 1; const int per = c.kind == 0 ? 6 : 4;
#pragma unroll
    for (int i = 0; i < 6; ++i) if (i < per) { const int ch = F.wave * per + i, reg = ch >> 4, cc = ch & 15, r = 4 * cc + (ln >> 4), kk = (ln & 15) ^ (r & 15);
        const bf16_t* src = reg == 0 ? c.qsrc : (reg == 1 ? c.ksrc : c.vsrc); const int ld = reg == 2 ? c.vld : c.qld;
        glds16((const GAS char*)(src + (size_t)(r0 + sg * r) * ld + 8 * kk), F.lds + CL_IMG + reg * 16384 + 1024 * cc); }
}
DEV void seq_s5_item(const Frame& F, int l, int item, int which);
DEV void phase_cl(const Frame& F0, int l) {
    const Frame F = refresh(F0);
    const int odd = l & 1; const int nhh = odd ? 4 : 8; const int nprob = B_ * nhh * 2 * NCH;
    if (odd) {
        for (int it = F.bid; it < B_ * 2 * 32; it += F.G) { seq_s5_item(F, l, it, 0); __syncthreads(); }
    }
    LAS float* gc = (LAS float*)(F.lds);
    LAS float* bt = (LAS float*)(F.lds + 256);
    LAS float* qs = (LAS float*)(F.lds + 768);
    LAS float* ks = (LAS float*)(F.lds + 1024);
    LAS float* mt = (LAS float*)(F.lds + 1280);
    LAS float* rsp = (LAS float*)(F.lds + 2048);
    LAS float* Am = (LAS float*)(F.lds + 4096);
    LAS bf16_t* An = (LAS bf16_t*)(F.lds + 20480);
    LAS bf16_t* XT = (LAS bf16_t*)(F.lds + 30720);
    LAS float* Rb = (LAS float*)(F.lds + 69632 + F.wave * 2048);
    LAS float* ksp = (LAS float*)(F.lds + 86016);
    LAS unsigned char* IQ = F.lds + CL_IMG; LAS unsigned char* IK = IQ + 16384; LAS unsigned char* IV = IQ + 32768;
    const float* GT = (const float*)(F.ws + WS_GATES);
    float gq = 0.f, bq = 0.f, mq = 0.f;
#define CL_GATES(pp) do { const ClProb cn = cl_decode(F, (pp), odd, nhh); const int rown = tok_row(cn.b, cn.d, cn.n * 64 + F.lane); \
        if (cn.kind == 0) { gq = GT[(size_t)rown * 16 + cn.d * 4 + cn.hh]; bq = GT[(size_t)rown * 16 + 8 + cn.d * 4 + cn.hh]; } \
        else if (cn.kind == 2) { bq = GT[(size_t)rown * 16 + cn.d * 4 + cn.hh]; gq = GT[(size_t)rown * 16 + 8 + cn.d * 4 + cn.hh]; \
            mq = ((const float*)(F.ws + WS_MCH))[(size_t)((cn.b * 4 + cn.hh) * 2 + cn.d) * NCH + cn.n]; } } while (0)
    if (F.bid < nprob) { cl_dma(F, cl_decode(F, F.bid, odd, nhh)); if (F.wave == 0) CL_GATES(F.bid); }
    for (int p = F.bid; p < nprob; p += F.G) {
        int lz = F.lane; LAUNDER(lz); const int h = lz >> 5, l31 = lz & 31;
        const ClProb c = cl_decode(F, p, odd, nhh); const int n = c.n, d = c.d, hh = c.hh, b = c.b, kind = c.kind; const float kscale = c.kscale;
        float* CS = (float*)(F.ws + WS_CLS) + (size_t)p * 512;
        if (F.wave == 0) {
            const int i = F.lane;
            float g = gq, be = bq;
            if (kind == 1) { g = log1pf(-exp2f(-(5.0f + 2.0f * (float)(hh - 4) + (float)d))); be = 0.f; }
            const float cum = wave_scan_add(g);
            const float gend = bcast_lane_f(cum, 63);
            gc[i] = cum; bt[i] = be;
            if (kind < 2) { qs[i] = expf(cum); ks[i] = expf(gend - cum) * kscale; if (i == 0) CS[0] = expf(gend); }
            else {
                const float mprev = mq;
                const float a = gend - cum + be; const float amax = wave_max(a); const float mnew = fmaxf(gend + mprev, amax);
                ks[i] = expf(a - mnew);
                const float pm = wave_scan_max(be - cum);
                const float mti = cum + fmaxf(mprev, pm); mt[i] = mti; qs[i] = expf(cum + mprev - mti);
                CS[128 + i] = expf(-mti);
                if (i == 0) CS[0] = expf(gend + mprev - mnew);
            }
        }
        WAIT_VM(0);
        __syncthreads();
        {
            const int w4 = F.wave & 3, mt_ = w4 >> 1, nt_ = w4 & 1; const bool doY = F.wave >= 4;
            if (!doY || kind == 0) {
                const int rj = 32 * mt_ + l31, ri = 32 * nt_ + l31; LAS unsigned char* IB = doY ? IK : IQ;
                f32x16 acc;
#pragma unroll
                for (int r = 0; r < 16; ++r) acc[r] = 0.f;
                bf16x8 af[8], bfr[8];
#pragma unroll
                for (int s = 0; s < 8; ++s) { af[s] = *(const LAS bf16x8*)(IK + swz256(rj, 2 * s + h)); bfr[s] = *(const LAS bf16x8*)(IB + swz256(ri, 2 * s + h)); }
#pragma unroll
                for (int s = 0; s < 8; ++s) acc = mfma32(af[s], bfr[s], acc);
                const int i = ri; const float gi = gc[i];
                if (!doY) {
                    bf16_t* AQ = (bf16_t*)(F.ws + WS_CLA) + (size_t)p * 4096 + (size_t)i * 64; float rsum = 0.f; const float mti = kind == 2 ? mt[i] : 0.f;
#pragma unroll
                    for (int g4 = 0; g4 < 4; ++g4) { float v[4];
#pragma unroll
                        for (int r = 0; r < 4; ++r) { const int j = 32 * mt_ + 8 * g4 + 4 * h + r; float e;
                            if (kind < 2) e = fast_exp(fminf(gi - gc[j], 0.f)); else e = fast_exp(gi - gc[j] + bt[j] - mti);
                            v[r] = (i >= j) ? acc[4 * g4 + r] * kscale * e : 0.f; rsum += v[r]; }
                        *(u32x2*)(AQ + 32 * mt_ + 8 * g4 + 4 * h) = (u32x2){pk2_sw(v[0], v[1]), pk2_sw(v[2], v[3])}; }
                    if (kind == 2) rsp[i * 4 + mt_ * 2 + h] = rsum;
                } else {
                    const float bi = bt[i];
#pragma unroll
                    for (int r = 0; r < 16; ++r) { const int j = 32 * mt_ + 8 * (r >> 2) + 4 * h + (r & 3);
                        const float av = (i > j) ? bi * acc[r] * fast_exp(fminf(gi - gc[j], 0.f)) : 0.f;
                        Am[i * 64 + j] = av; An[i * 72 + j] = (bf16_t)f2bf_sw(-av); }
                }
            }
        }
        __syncthreads();
        int lz2 = F.lane; LAUNDER(lz2); const int l15 = lz2 & 15, kg = lz2 >> 4; const bool isw = F.wave >= 4;
        float rhsv[4][2][4];
        {
            const int tz = F.wave * 64 + lz2; const int cq = tz & 127, q4 = tz >> 7; bf16_t* QD = (bf16_t*)(F.ws + WS_CLQ) + (size_t)p * 8192 + cq;
            for (int i = 16 * q4; i < 16 * q4 + 16; ++i) QD[i * 128] = (bf16_t)f2bf_sw(bf2f(*(const LAS bf16_t*)(IQ + swz256(i, cq >> 3) + 2 * (cq & 7))) * qs[i]);
            bf16_t* KT = (bf16_t*)(F.ws + WS_CLK) + (size_t)p * 8192 + (size_t)cq * 64;
            float ksum = 0.f;
            for (int j8 = 2 * q4; j8 < 2 * q4 + 2; ++j8) { float v[8];
#pragma unroll
                for (int r = 0; r < 8; ++r) { const int j = 8 * j8 + r; v[r] = bf2f(*(const LAS bf16_t*)(IK + swz256(j, cq >> 3) + 2 * (cq & 7))) * ks[j]; ksum += v[r]; }
                *(u32x4*)(KT + 8 * j8) = (u32x4){pk2_sw(v[0], v[1]), pk2_sw(v[2], v[3]), pk2_sw(v[4], v[5]), pk2_sw(v[6], v[7])}; }
            ksp[cq * 4 + q4] = ksum;
            if (kind == 2 && tz < 64) CS[64 + tz] = (rsp[tz * 4] + rsp[tz * 4 + 1]) + (rsp[tz * 4 + 2] + rsp[tz * 4 + 3]);
            if (kind == 0) { LAS unsigned char* IS = isw ? IK : IV;
#pragma unroll
                for (int bb = 0; bb < 4; ++bb)
#pragma unroll
                    for (int nt2 = 0; nt2 < 2; ++nt2)
#pragma unroll
                        for (int r = 0; r < 4; ++r) { const int i = 16 * bb + 4 * kg + r, cc = (32 * F.wave + 16 * nt2 + l15) & 127;
                            rhsv[bb][nt2][r] = bt[i] * bf2f(*(const LAS bf16_t*)(IS + swz256(i, cc >> 3) + 2 * (cc & 7))) * (isw ? qs[i] : 1.0f); } }
        }
        __syncthreads();
        if (p + F.G < nprob) { cl_dma(F, cl_decode(F, p + F.G, odd, nhh)); if (F.wave == 0) CL_GATES(p + F.G); }
        if (kind == 2 && F.tid < 128) CS[256 + F.tid] = (ksp[F.tid * 4] + ksp[F.tid * 4 + 1]) + (ksp[F.tid * 4 + 2] + ksp[F.tid * 4 + 3]);
        if (kind == 0) {
            const int pg = ((b * 4 + hh) * 2 + d) * NCH + n;
            float* U = (float*)(F.ws + WS_CLU) + (size_t)pg * 8192; bf16_t* W = (bf16_t*)(F.ws + WS_CLW) + (size_t)p * 8192;
#pragma unroll
            for (int bb = 0; bb < 4; ++bb) {
#pragma unroll
                for (int nt2 = 0; nt2 < 2; ++nt2) {
                    const int cidx = 32 * F.wave + 16 * nt2 + l15; f32x4 acc;
#pragma unroll
                    for (int r = 0; r < 4; ++r) acc[r] = rhsv[bb][nt2][r];
                    for (int k2 = 0; k2 < 2; ++k2) if (32 * k2 < 16 * bb) {
                        const bool in = 32 * k2 + 8 * kg + 8 <= 16 * bb;
                        bf16x8 a = *(const LAS bf16x8*)(An + (16 * bb + l15) * 72 + 32 * k2 + 8 * kg); if (!in) a = (bf16x8){0, 0, 0, 0, 0, 0, 0, 0};
                        const bf16x8 xb = *(const LAS bf16x8*)(XT + cidx * 72 + 32 * k2 + 8 * kg);
                        acc = mfma16(a, in ? xb : (bf16x8){0, 0, 0, 0, 0, 0, 0, 0}, acc); }
#pragma unroll
                    for (int r = 0; r < 4; ++r) Rb[(4 * kg + r) * 32 + 16 * nt2 + l15] = acc[r];
                }
                WAVE_LDS_SYNC();
                if (F.lane < 32) {
                    const int cidx = 32 * F.wave + F.lane; float x[16];
#pragma unroll
                    for (int i = 0; i < 16; ++i) { float r = Rb[i * 32 + F.lane];
#pragma unroll
                        for (int j = 0; j < i; ++j) r -= Am[(16 * bb + i) * 64 + 16 * bb + j] * x[j];
                        x[i] = r; }
                    if (!isw) {
#pragma unroll
                        for (int i = 0; i < 16; ++i) U[(16 * bb + i) * 128 + cidx] = x[i]; }
                    else {
#pragma unroll
                        for (int i = 0; i < 16; ++i) W[(16 * bb + i) * 128 + (cidx - 128)] = (bf16_t)f2bf_sw(-x[i]); }
                    *(LAS u32x4*)(XT + cidx * 72 + 16 * bb) = (u32x4){pk2_sw(x[0], x[1]), pk2_sw(x[2], x[3]), pk2_sw(x[4], x[5]), pk2_sw(x[6], x[7])};
                    *(LAS u32x4*)(XT + cidx * 72 + 16 * bb + 8) = (u32x4){pk2_sw(x[8], x[9]), pk2_sw(x[10], x[11]), pk2_sw(x[12], x[13]), pk2_sw(x[14], x[15])};
                }
                WAVE_LDS_SYNC();
            }
        }
    }
    WAIT_VM(0);
    __syncthreads();
}

#define LDS_BARRIER() do { WAIT_LGKM(0); S_BARRIER(); COMPILER_FENCE(); } while (0)
constexpr int SQ_W = 0, SQ_Q = 16384, SQ_K = 32768, SQ_A = 49152, SQ_U = 57344, SQ_C = 65536, SQ_STAGE = 67584;
constexpr int SQ_SB = 2 * SQ_STAGE, SQ_VN = SQ_SB + 8704, SQ_NV = SQ_VN + 4608, SQ_DEN = SQ_NV + 512;
static_assert(SQ_DEN + 256 <= LDS_MISC, "SEQ LDS map");
struct SeqCtx { int kind, b, hh, d, sl, chain, vld; const GAS bf16_t* vsrc; int probe; };
template <int KIND>
DEV void seq_dma(const Frame& F, const SeqCtx& C, int n, LAS unsigned char* img) {
    const int p = C.chain * NCH + n, w = F.wave; int ln = F.lane; LAUNDER(ln);
    if (w < 2) {
        if (KIND == 0) { const GAS char* g = (const GAS char*)(F.ws + WS_CLW) + (size_t)p * 16384; LAUNDER_S(g);
#pragma unroll
            for (int i = 0; i < 8; ++i) { const int r = 4 * (8 * w + i) + (ln >> 4), pp = ln & 15; glds16(g + r * 256 + 16 * (pp ^ (r & 15)), img + SQ_W + 1024 * (8 * w + i)); } }
    } else if (w < 4) {
        const GAS char* g = (const GAS char*)(F.ws + WS_CLQ) + (size_t)p * 16384; LAUNDER_S(g);
#pragma unroll
        for (int i = 0; i < 8; ++i) { const int c = 8 * (w - 2) + i, r = 4 * c + (ln >> 4), pp = ln & 15; glds16(g + r * 256 + 16 * (pp ^ (r & 15)), img + SQ_Q + 1024 * c); }
    } else if (w < 6) {
        const GAS char* g = (const GAS char*)(F.ws + WS_CLK) + (size_t)p * 16384; LAUNDER_S(g);
#pragma unroll
        for (int i = 0; i < 8; ++i) { const int c = 8 * (w - 4) + i, r = 8 * c + (ln >> 3), pp = ln & 7; glds16(g + r * 128 + 16 * (pp ^ ((r >> 1) & 7)), img + SQ_K + 1024 * c); }
    } else if (w == 6) {
        const GAS char* g = (const GAS char*)(F.ws + WS_CLA) + (size_t)p * 8192; LAUNDER_S(g);
#pragma unroll
        for (int i = 0; i < 8; ++i) { const int r = 8 * i + (ln >> 3), pp = ln & 7; glds16(g + r * 128 + 16 * (pp ^ ((r >> 1) & 7)), img + SQ_A + 1024 * i); }
    } else {
        if (KIND == 0) { const int pg = ((C.b * 4 + C.hh) * 2 + C.d) * NCH + n; const GAS char* g = (const GAS char*)(F.ws + WS_CLU) + (size_t)pg * 32768 + 128 * C.sl; LAUNDER_S(g);
#pragma unroll
            for (int i = 0; i < 8; ++i) { const int r = 8 * i + (ln >> 3); glds16(g + r * 512 + 16 * (ln & 7), img + SQ_U + 1024 * i); }
        } else { const int r0 = tok_row(C.b, C.d, n * 64); const long st = C.d ? -(long)C.vld * 2 : (long)C.vld * 2;
            const GAS char* g = (const GAS char*)C.vsrc + (long)r0 * C.vld * 2 + 64 * C.sl; LAUNDER_S(g);
#pragma unroll
            for (int i = 0; i < 4; ++i) { const int r = 16 * i + (ln >> 2); glds16(g + (long)r * st + 16 * (ln & 3), img + SQ_U + 1024 * i); }
        }
        const GAS char* cs = (const GAS char*)(F.ws + WS_CLS) + (size_t)p * 2048; LAUNDER_S(cs);
        glds16(cs + 16 * ln, img + SQ_C);
        if (KIND == 2) glds16(cs + 1024 + 16 * ln, img + SQ_C + 1024);
    }
}
#define SEQ_WAIT_DMA(younger) do { if ((younger) == 16) WAIT_VM(16); else WAIT_VM(0); } while (0)
template <int KIND>
DEV void seq_step(const Frame& F, const SeqCtx& C, int n, f32x16& acc, LAS unsigned char* lds) {
    int lz = F.lane; LAUNDER(lz); const int h = lz >> 5, l31 = lz & 31;
    LAS unsigned char* img = lds + (n & 1) * SQ_STAGE; LAS unsigned char* nimg = lds + ((n + 1) & 1) * SQ_STAGE;
    LAS bf16_t* Sb = (LAS bf16_t*)(lds + SQ_SB); LAS bf16_t* Vn = (LAS bf16_t*)(lds + SQ_VN); LAS float* nvec = (LAS float*)(lds + SQ_NV); LAS float* den = (LAS float*)(lds + SQ_DEN);
    const LAS float* CS = (const LAS float*)(img + SQ_C);
    if (C.probe != 3) seq_dma<KIND>(F, C, C.probe == 2 ? 0 : (n + 1 < NCH ? n + 1 : NCH - 1), nimg);
    if (F.wave < 2) {
        const int mt_ = F.wave;
        if (KIND == 0) {
#pragma unroll
            for (int r = 0; r < 16; ++r) acc[r] = *(const LAS float*)(img + SQ_U + (32 * mt_ + 8 * (r >> 2) + 4 * h + (r & 3)) * 128 + 4 * l31);
            bf16x8 sb[8], wf[8]; const int rr = 32 * mt_ + l31;
#pragma unroll
            for (int s = 0; s < 8; ++s) { sb[s] = *(const LAS bf16x8*)(Sb + l31 * 136 + 16 * s + 8 * h); wf[s] = *(const LAS bf16x8*)(img + SQ_W + swz256(rr, 2 * s + h)); }
#pragma unroll
            for (int s = 0; s < 8; ++s) acc = mfma32(wf[s], sb[s], acc);
        } else {
#pragma unroll
            for (int r = 0; r < 16; ++r) acc[r] = bf2f(*(const LAS bf16_t*)(img + SQ_U + (32 * mt_ + 8 * (r >> 2) + 4 * h + (r & 3)) * 64 + 2 * l31));
        }
#pragma unroll
        for (int g4 = 0; g4 < 4; ++g4) *(LAS u32x2*)(Vn + l31 * 72 + 32 * mt_ + 8 * g4 + 4 * h) = (u32x2){pk2(acc[4 * g4], acc[4 * g4 + 1]), pk2(acc[4 * g4 + 2], acc[4 * g4 + 3])};
    } else if (F.wave < 4) {
        const int rr = 32 * (F.wave - 2) + l31;
#pragma unroll
        for (int r = 0; r < 16; ++r) acc[r] = 0.f;
        bf16x8 sb[8], qf[8];
#pragma unroll
        for (int s = 0; s < 8; ++s) { sb[s] = *(const LAS bf16x8*)(Sb + l31 * 136 + 16 * s + 8 * h); qf[s] = *(const LAS bf16x8*)(img + SQ_Q + swz256(rr, 2 * s + h)); }
#pragma unroll
        for (int s = 0; s < 8; ++s) acc = mfma32(qf[s], sb[s], acc);
    } else if (KIND == 2) {
        const int t = F.tid - 256, i = t >> 2, q = t & 3; float s = 0.f;
#pragma unroll
        for (int c8 = 0; c8 < 4; ++c8) { const u32x4 w = *(const LAS u32x4*)(img + SQ_Q + swz256(i, 4 * q + c8)); const LAS float* nv = nvec + 32 * q + 8 * c8;
            s += bflo(w.x) * nv[0] + bfhi(w.x) * nv[1] + bflo(w.y) * nv[2] + bfhi(w.y) * nv[3] + bflo(w.z) * nv[4] + bfhi(w.z) * nv[5] + bflo(w.w) * nv[6] + bfhi(w.w) * nv[7]; }
        s = group_sum<4>(s);
        if (q == 0) den[i] = fmaxf(fabsf(CS[64 + i] + s), CS[128 + i]);
    }
    LDS_BARRIER();
    if (F.wave >= 2 && F.wave < 4) {
        const int mt_ = F.wave - 2, rr = 32 * mt_ + l31;
        bf16x8 vb[4], af[4];
#pragma unroll
        for (int s = 0; s < 4; ++s) { vb[s] = *(const LAS bf16x8*)(Vn + l31 * 72 + 16 * s + 8 * h); af[s] = *(const LAS bf16x8*)(img + SQ_A + swz128(rr, 2 * s + h)); }
#pragma unroll
        for (int s = 0; s < 4; ++s) acc = mfma32(af[s], vb[s], acc);
        const int r0 = tok_row(C.b, C.d, n * 64); const long st = C.d ? -2048l : 2048l;
        GAS char* Ob = (GAS char*)(F.ws + WS_O) + ((size_t)C.d * MROWS + r0) * 2048 + (long)(32 * mt_) * st; LAUNDER_S(Ob); const long lo = (long)(4 * h) * st + (long)((C.hh * 128 + 32 * C.sl + l31) * 2);
#pragma unroll
        for (int r = 0; r < 16; ++r) { const int i = 32 * mt_ + 8 * (r >> 2) + 4 * h + (r & 3); float v = acc[r];
            if (KIND == 2) v = v / den[i];
            if (!C.probe) *(GAS bf16_t*)(Ob + (long)(8 * (r >> 2) + (r & 3)) * st + lo) = (bf16_t)f2bf(v); }
        SEQ_WAIT_DMA(16);
    } else if (F.wave >= 4) {
        const int kb = F.wave - 4, rr = 32 * kb + l31; const float ge = CS[0];
        bf16x8 vb[4], kf[4];
#pragma unroll
        for (int s = 0; s < 4; ++s) { vb[s] = *(const LAS bf16x8*)(Vn + l31 * 72 + 16 * s + 8 * h); kf[s] = *(const LAS bf16x8*)(img + SQ_K + swz128(rr, 2 * s + h)); }
#pragma unroll
        for (int r = 0; r < 16; ++r) acc[r] *= ge;
#pragma unroll
        for (int s = 0; s < 4; ++s) acc = mfma32(kf[s], vb[s], acc);
#pragma unroll
        for (int g4 = 0; g4 < 4; ++g4) *(LAS u32x2*)(Sb + l31 * 136 + 32 * kb + 8 * g4 + 4 * h) = (u32x2){pk2(acc[4 * g4], acc[4 * g4 + 1]), pk2(acc[4 * g4 + 2], acc[4 * g4 + 3])};
        if (KIND == 2 && F.tid < 256 + 128) { const int dd = F.tid - 256; nvec[dd] = ge * nvec[dd] + CS[256 + dd]; }
        SEQ_WAIT_DMA(0);
    } else SEQ_WAIT_DMA(0);
    LDS_BARRIER();
}
template <int KIND>
DEV void seq_kind_loop(const Frame& F, const SeqCtx& C, LAS unsigned char* lds) {
    f32x16 acc;
#pragma unroll
    for (int r = 0; r < 16; ++r) acc[r] = 0.f;
    seq_dma<KIND>(F, C, 0, lds);
    WAIT_VM(0);
    LDS_BARRIER();
    for (int n = 0; n < NCH; ++n) seq_step<KIND>(F, C, n, acc, lds);
}
DEV void seq_linear_item(const Frame& F, int l, int item, int probe = 0) {
    const int odd = l & 1, nhh = odd ? 4 : 8;
    SeqCtx C; C.probe = probe; C.sl = item & 3; C.chain = item >> 2; C.d = C.chain & 1; C.hh = (C.chain >> 1) % nhh; C.b = C.chain / (2 * nhh);
    C.kind = odd ? 2 : (C.hh < 4 ? 0 : 1);
    const GAS bf16_t* P = (const GAS bf16_t*)(F.ws + WS_P); const GAS bf16_t* Q = (const GAS bf16_t*)(F.ws + WS_QKV);
    if (C.kind == 0) { C.vsrc = Q + 1024 + C.hh * 128; C.vld = 1536; } else if (C.kind == 1) { C.vsrc = P + 3072 + (C.hh - 4) * 128; C.vld = NIN_E; } else { C.vsrc = P + 1024 + C.hh * 128; C.vld = NIN_O; }
    for (int i = F.tid; i < 32 * 136 / 2; i += NTHREADS) ((LAS unsigned*)(F.lds + SQ_SB))[i] = 0u;
    if (F.tid < 128) ((LAS float*)(F.lds + SQ_NV))[F.tid] = 0.f;
    __syncthreads();
    if (C.kind == 0) seq_kind_loop<0>(F, C, F.lds); else if (C.kind == 1) seq_kind_loop<1>(F, C, F.lds); else seq_kind_loop<2>(F, C, F.lds);
    WAIT_VM(0);
}

DEV void seq_s5_item(const Frame& F, int l, int item, int which) {
    const int o = l >> 1; const int g = item & 31, d = (item >> 5) & 1, b = item >> 6;
    LAS float* El = (LAS float*)(F.lds);
    LAS unsigned char* wl = F.lds + 36864 + F.wave * 14336;
    LAS float* scr = (LAS float*)wl; LAS bf16_t* hb = (LAS bf16_t*)(wl + 10240);
    const bf16_t* P = (const bf16_t*)(F.ws + WS_P);
    const float* Ab = (const float*)(F.ws + WS_S5A) + (size_t)((o * 2 + d) * 32 + g) * 128;
    const bf16_t* Bb = (const bf16_t*)(F.ws + WS_S5B) + (size_t)((o * 2 + d) * 32 + g) * 128 * 16;
    const bf16_t* Cm = (const bf16_t*)(F.ws + WS_S5C) + (size_t)(o * 32 + g) * 16 * 128;
    const int l15 = F.lane & 15, kg = F.lane >> 4;
    const float ar = Ab[F.lane], ai = Ab[64 + F.lane];
    bf16x8 bB[8], cB[4]; const bf16x8 zero8 = (bf16x8){0, 0, 0, 0, 0, 0, 0, 0};
#pragma unroll
    for (int ct = 0; ct < 8; ++ct) bB[ct] = kg < 2 ? *(const bf16x8*)(Bb + (size_t)(16 * ct + l15) * 16 + 8 * kg) : zero8;
#pragma unroll
    for (int s = 0; s < 4; ++s) cB[s] = *(const bf16x8*)(Cm + (size_t)l15 * 128 + 32 * s + 8 * kg);
    bf16_t* Obase = (bf16_t*)(F.ws + WS_O) + (size_t)d * MROWS * 1024 + 512 + 16 * g;
    float* SE = (float*)(F.ws + WS_S5E) + (size_t)item * NCH * 128;
    if (which == 1) { for (int i = F.tid; i < NCH * 128; i += NTHREADS) El[i] = SE[i]; __syncthreads(); }
    for (int pass = which; pass < which + 1; ++pass) {
        bf16x8 an[4];
#pragma unroll
        for (int st = 0; st < 4; ++st) an[st] = kg < 2 ? *(const bf16x8*)(P + (size_t)tok_row(b, d, F.wave * 64 + 16 * st + l15) * NIN_O + 2048 + 16 * g + 8 * kg) : zero8;
        for (int n = F.wave; n < NCH; n += NWAVES) {
            float hr = 0.f, hi = 0.f;
            if (pass) { hr = El[n * 128 + F.lane]; hi = El[n * 128 + 64 + F.lane]; }
            bf16x8 ac[4];
#pragma unroll
            for (int st = 0; st < 4; ++st) ac[st] = an[st];
            { const int nn = n + NWAVES < NCH ? n + NWAVES : n;
#pragma unroll
              for (int st = 0; st < 4; ++st) an[st] = kg < 2 ? *(const bf16x8*)(P + (size_t)tok_row(b, d, nn * 64 + 16 * st + l15) * NIN_O + 2048 + 16 * g + 8 * kg) : zero8; }
            const int r0 = tok_row(b, d, n * 64); const int sg = d ? -1 : 1;
#pragma unroll
            for (int st = 0; st < 4; ++st) {
#pragma unroll
                for (int ct = 0; ct < 8; ++ct) { f32x4 acc = (f32x4){0.f, 0.f, 0.f, 0.f}; acc = mfma16(ac[st], bB[ct], acc);
                    *(LAS f32x4*)(scr + (ct >> 2) * 1280 + (16 * (ct & 3) + l15) * 20 + 4 * kg) = acc; }
                WAVE_LDS_SYNC();
                f32x4 br[4], bi[4];
#pragma unroll
                for (int q = 0; q < 4; ++q) { br[q] = *(const LAS f32x4*)(scr + F.lane * 20 + 4 * q); bi[q] = *(const LAS f32x4*)(scr + 1280 + F.lane * 20 + 4 * q); }
#pragma unroll
                for (int t = 0; t < 16; ++t) { const float nr = ar * hr - ai * hi + br[t >> 2][t & 3], ni = ar * hi + ai * hr + bi[t >> 2][t & 3]; hr = nr; hi = ni;
                    if (pass) *(LAS unsigned*)(hb + t * 128 + 2 * F.lane) = pk2(hr, hi); }
                WAVE_LDS_SYNC();
                if (pass) { f32x4 acc = (f32x4){0.f, 0.f, 0.f, 0.f};
#pragma unroll
                    for (int s = 0; s < 4; ++s) { const bf16x8 ha = *(const LAS bf16x8*)(hb + l15 * 128 + 32 * s + 8 * kg); acc = mfma16(ha, cB[s], acc); }
#pragma unroll
                    for (int r = 0; r < 4; ++r) Obase[(size_t)(r0 + sg * (16 * st + 4 * kg + r)) * 1024 + l15] = (bf16_t)f2bf(acc[r]);
                    WAVE_LDS_SYNC(); }
            }
            if (!pass) { El[n * 128 + F.lane] = hr; El[n * 128 + 64 + F.lane] = hi; }
        }
        __syncthreads();
        if (!pass) {
            if (F.wave == 0) { float pr = ar, pi = ai;
#pragma unroll
                for (int q = 0; q < 6; ++q) { const float nr = pr * pr - pi * pi, ni = 2.0f * pr * pi; pr = nr; pi = ni; }
                float hr = 0.f, hi = 0.f;
                for (int n = 0; n < NCH; ++n) { const float er = El[n * 128 + F.lane], ei = El[n * 128 + 64 + F.lane];
                    El[n * 128 + F.lane] = hr; El[n * 128 + 64 + F.lane] = hi;
                    const float nr = pr * hr - pi * hi + er, ni = pr * hi + pi * hr + ei; hr = nr; hi = ni; } }
            __syncthreads();
            for (int i = F.tid; i < NCH * 128; i += NTHREADS) SE[i] = El[i];
        }
    }
}

DEV void phase_seq(const Frame& F0, int l, int mode = 0) {
    const Frame F = refresh(F0);
    const int odd = l & 1; const int nlin = B_ * (odd ? 4 : 8) * 2 * 4; const int ns5 = odd ? B_ * 2 * 32 : 0;
    const int vcu = (F.G % 8 == 0) ? (F.bid % 8) * (F.G / 8) + F.bid / 8 : F.bid;
    if (!odd || F.G <= nlin) {
        for (int it = vcu; it < nlin + ns5; it += F.G) {
            if (it < nlin) { if (mode != 2) seq_linear_item(F, l, it, mode >= 10 ? mode - 10 : 0); } else if (mode != 1 && mode < 10) seq_s5_item(F, l, it - nlin, 1);
            __syncthreads();
        }
    } else if (vcu < nlin) { if (mode != 2) seq_linear_item(F, l, vcu, mode >= 10 ? mode - 10 : 0); }
    else { for (int it = vcu - nlin; it < ns5; it += F.G - nlin) { if (mode != 1 && mode < 10) seq_s5_item(F, l, it, 1); __syncthreads(); } }
}

DEV void phase_merge(const Frame& F0, int l) {
    const Frame F = refresh(F0);
    const int odd = l & 1, li = l >> 1; const bf16_t* P = (const bf16_t*)(F.ws + WS_P);
    const bf16_t* O0 = (const bf16_t*)(F.ws + WS_O); const bf16_t* O1 = O0 + (size_t)MROWS * 1024;
    bf16_t* MG = (bf16_t*)(F.ws + WS_MERGED);
    const int nrows = (l == DEPTH - 1) ? LATR : MROWS;
    ROW_LOOP(r, nrows) {
        if (!odd) {
            const int c0 = 16 * F.lane; float v[16];
#pragma unroll
            for (int q = 0; q < 4; ++q) { const u32x2 a = *(const u32x2*)(O0 + (size_t)r * 1024 + c0 + 4 * q), bq = *(const u32x2*)(O1 + (size_t)r * 1024 + c0 + 4 * q);
                v[4 * q] = bflo(a.x) + bflo(bq.x); v[4 * q + 1] = bfhi(a.x) + bfhi(bq.x); v[4 * q + 2] = bflo(a.y) + bflo(bq.y); v[4 * q + 3] = bfhi(a.y) + bfhi(bq.y); }
            float s = 0.f;
#pragma unroll
            for (int i = 0; i < 16; ++i) s += v[i];
            s = group_sum<8>(s);
            const bool ret = F.lane >= 32; const float mu = ret ? s * (1.0f / 128.0f) : 0.f; float q2 = 0.f;
#pragma unroll
            for (int i = 0; i < 16; ++i) { v[i] -= mu; q2 += v[i] * v[i]; }
            q2 = group_sum<8>(q2);
            const float rstd = 1.0f / sqrtf(q2 * (1.0f / 128.0f) + LN_EPS);
            const bf16_t* zp = P + (size_t)r * NIN_E + (ret ? 3584 + (c0 - 512) : 1536 + c0);
            const float* gp = ret ? GIN(I_EVRETN) + li * 512 + (c0 - 512) : GIN(I_EVGDNN) + li * 128 + (c0 & 127);
            unsigned ow[8]; const u32x4 zq0 = *(const u32x4*)zp, zq1 = *(const u32x4*)(zp + 8); const unsigned zw[8] = {zq0.x, zq0.y, zq0.z, zq0.w, zq1.x, zq1.y, zq1.z, zq1.w};
            f32x4 gq[4];
#pragma unroll
            for (int i = 0; i < 4; ++i) gq[i] = *(const f32x4*)(gp + 4 * i);
#pragma unroll
            for (int i = 0; i < 16; i += 2) { const float z0 = bflo(zw[i >> 1]), z1 = bfhi(zw[i >> 1]); ow[i >> 1] = pk2(v[i] * rstd * gq[i >> 2][i & 3] * fast_silu(z0), v[i + 1] * rstd * gq[i >> 2][(i & 3) + 1] * fast_silu(z1)); }
            u32x4* op = (u32x4*)(MG + (size_t)r * 1024 + c0); op[0] = (u32x4){ow[0], ow[1], ow[2], ow[3]}; op[1] = (u32x4){ow[4], ow[5], ow[6], ow[7]};
        } else {
            const int c0 = 8 * F.lane; float v[8];
#pragma unroll
            for (int q = 0; q < 2; ++q) { const u32x2 a = *(const u32x2*)(O0 + (size_t)r * 1024 + c0 + 4 * q), bq = *(const u32x2*)(O1 + (size_t)r * 1024 + c0 + 4 * q);
                v[4 * q] = bflo(a.x) + bflo(bq.x); v[4 * q + 1] = bfhi(a.x) + bfhi(bq.x); v[4 * q + 2] = bflo(a.y) + bflo(bq.y); v[4 * q + 3] = bfhi(a.y) + bfhi(bq.y); }
            float s = 0.f;
#pragma unroll
            for (int i = 0; i < 8; ++i) s += v[i];
            s = group_sum<16>(s);
            const float mu = s * (1.0f / 128.0f); float q2 = 0.f;
#pragma unroll
            for (int i = 0; i < 8; ++i) { v[i] -= mu; q2 += v[i] * v[i]; }
            q2 = group_sum<16>(q2);
            const float rstd = 1.0f / sqrtf(q2 * (1.0f / 128.0f) + LN_EPS);
            const bf16_t* zp = P + (size_t)r * NIN_O + 1536 + c0; const float* gp = GIN(I_ODMN) + li * 512 + c0;
            unsigned ow[4]; const u32x4 zq = *(const u32x4*)zp; const unsigned zw[4] = {zq.x, zq.y, zq.z, zq.w}; const f32x4 gq0 = *(const f32x4*)gp, gq1 = *(const f32x4*)(gp + 4);
#pragma unroll
            for (int i = 0; i < 8; i += 2) { const f32x4 gq = i < 4 ? gq0 : gq1; ow[i >> 1] = pk2(v[i] * rstd * gq[i & 3] * fast_sigmoid(bflo(zw[i >> 1])), v[i + 1] * rstd * gq[(i & 3) + 1] * fast_sigmoid(bfhi(zw[i >> 1]))); }
            *(u32x4*)(MG + (size_t)r * 1024 + c0) = (u32x4){ow[0], ow[1], ow[2], ow[3]};
            const bf16_t* up = P + (size_t)r * NIN_O + 2048 + c0; const float* dsk = GIN(I_ODDSKIP) + li * 512 + c0;
#pragma unroll
            for (int q = 0; q < 2; ++q) { const u32x2 a = *(const u32x2*)(O0 + (size_t)r * 1024 + 512 + c0 + 4 * q), bq = *(const u32x2*)(O1 + (size_t)r * 1024 + 512 + c0 + 4 * q);
                v[4 * q] = bflo(a.x) + bflo(bq.x); v[4 * q + 1] = bfhi(a.x) + bfhi(bq.x); v[4 * q + 2] = bflo(a.y) + bflo(bq.y); v[4 * q + 3] = bfhi(a.y) + bfhi(bq.y); }
            { const u32x4 uq = *(const u32x4*)up; const unsigned uw[4] = {uq.x, uq.y, uq.z, uq.w}; const f32x4 d0 = *(const f32x4*)dsk, d1 = *(const f32x4*)(dsk + 4);
#pragma unroll
              for (int i = 0; i < 8; i += 2) { const f32x4 dq = i < 4 ? d0 : d1; ow[i >> 1] = pk2(gelu_tanh_f(v[i] + dq[i & 3] * bflo(uw[i >> 1])), gelu_tanh_f(v[i + 1] + dq[(i & 3) + 1] * bfhi(uw[i >> 1]))); } }
            *(u32x4*)((bf16_t*)(F.ws + WS_YS) + (size_t)r * 512 + c0) = (u32x4){ow[0], ow[1], ow[2], ow[3]};
        }
    }
}

template <int RG> DEV void ln_rows(const Frame& F, f32x4 (&t)[RG][4], const float* lg, const float* lb) {
    float mean[RG], rstd[RG];
#pragma unroll
    for (int q = 0; q < RG; ++q) { float sum = 0.f;
#pragma unroll
        for (int j = 0; j < 4; ++j) sum += (t[q][j].x + t[q][j].y) + (t[q][j].z + t[q][j].w);
        mean[q] = wave_sum(sum) * (1.0f / 1024.0f); }
#pragma unroll
    for (int q = 0; q < RG; ++q) { float s2 = 0.f;
#pragma unroll
        for (int j = 0; j < 4; ++j) { t[q][j] = t[q][j] - mean[q]; s2 += (t[q][j].x * t[q][j].x + t[q][j].y * t[q][j].y) + (t[q][j].z * t[q][j].z + t[q][j].w * t[q][j].w); }
        rstd[q] = 1.0f / sqrtf(wave_sum(s2) * (1.0f / 1024.0f) + LN_EPS); }
#pragma unroll
    for (int j = 0; j < 4; ++j) { const f32x4 gg = *((const f32x4*)lg + F.lane + 64 * j), bb = *((const f32x4*)lb + F.lane + 64 * j);
#pragma unroll
        for (int q = 0; q < RG; ++q) t[q][j] = t[q][j] * rstd[q] * gg + bb; }
}
template <int RG> DEV void ln1_group(const Frame& F, int l, int r) {

    const float* Y = (const float*)(F.ws + WS_Y); float* H = (float*)(F.ws + WS_H);
    const float* lg = GIN(I_LN1G) + l * 1024; const float* lb = GIN(I_LN1B) + l * 1024; const float* wr = (const float*)(F.ws + WS_WR) + (size_t)l * NE * 1024;
    {
        int b, s; row_bs(r, b, s); const int mr = s < CTX ? B_ : b; const float* mod = (const float*)(F.ws + WS_MOD) + ((size_t)l * NR + mr) * 6144;
        f32x4 t[RG][4];
#pragma unroll
        for (int j = 0; j < 4; ++j) { const f32x4 g1 = *((const f32x4*)(mod + 2048) + F.lane + 64 * j);
#pragma unroll
            for (int q = 0; q < RG; ++q) { const f32x4 hv = *((const f32x4*)HROW(F, l, r + q) + F.lane + 64 * j), yv = *((const f32x4*)(Y + (size_t)(r + q) * 1024) + F.lane + 64 * j); t[q][j] = ALPHA * hv + g1 * yv; }
            if (j & 1) COMPILER_FENCE(); }
        ln_rows<RG>(F, t, lg, lb);
        COMPILER_FENCE();
#pragma unroll
        for (int j = 0; j < 4; ++j) { const f32x4 sh = *((const f32x4*)(mod + 3072) + F.lane + 64 * j), scv = *((const f32x4*)(mod + 4096) + F.lane + 64 * j);
#pragma unroll
            for (int q = 0; q < RG; ++q) { *((f32x4*)(H + (size_t)(r + q) * 1024) + F.lane + 64 * j) = t[q][j]; t[q][j] = t[q][j] * (1.0f + scv) + sh; } }
        COMPILER_FENCE();
#pragma unroll
        for (int q = 0; q < RG; ++q) { u32x2* xo = (u32x2*)((bf16_t*)(F.ws + WS_XIN) + (size_t)(r + q) * 1024) + F.lane;
#pragma unroll
            for (int j = 0; j < 4; ++j) xo[64 * j] = (u32x2){pk2(t[q][j].x, t[q][j].y), pk2(t[q][j].z, t[q][j].w)}; }
        float mine[RG]; const int ei = F.lane % NE;
#pragma unroll
        for (int q = 0; q < RG; ++q) mine[q] = 0.f;
        f32x4 wc[4];
#pragma unroll
        for (int j = 0; j < 4; ++j) wc[j] = *((const f32x4*)wr + F.lane + 64 * j);
#pragma unroll 1
        for (int e = 0; e < NE; ++e) { f32x4 wn[4]; const int en = e + 1 < NE ? e + 1 : e;
#pragma unroll
            for (int j = 0; j < 4; ++j) wn[j] = *((const f32x4*)(wr + en * 1024) + F.lane + 64 * j);
#pragma unroll
            for (int q = 0; q < RG; ++q) { float p = 0.f;
#pragma unroll
                for (int j = 0; j < 4; ++j) p += t[q][j].x * wc[j].x + t[q][j].y * wc[j].y + t[q][j].z * wc[j].z + t[q][j].w * wc[j].w;
                const float ws_ = wave_sum(p); mine[q] = (ei == e) ? ws_ : mine[q]; }
#pragma unroll
            for (int j = 0; j < 4; ++j) wc[j] = wn[j]; }
#pragma unroll
        for (int q = 0; q < RG; ++q) { const float mx = group_max<NE>(mine[q]); const float ex = expf(mine[q] - mx); const float se = group_sum<NE>(ex);
            if (F.lane < NE) ((float*)(F.ws + WS_AFF))[(size_t)(r + q) * 16 + F.lane] = ex / se; }
    }
}
DEV void phase_ln1(const Frame& F0, int l) {
    const Frame F = refresh(F0);
    const int nrows = (l == DEPTH - 1) ? LATR : MROWS;
    ROW_GROUPS(nrows, ln1_group<4>(F, l, r), ln1_group<2>(F, l, r));
}

DEV void phase_topk(const Frame& F0, int l) {
    const Frame F = refresh(F0);
    const int nitems = (l == DEPTH - 1) ? B_ * NE : 2 * B_ * NE;
    LAS unsigned* hist = (LAS unsigned*)(F.lds);
    LAS unsigned* selw = (LAS unsigned*)(F.lds + 1024);
    LAS unsigned* cnt = (LAS unsigned*)(F.lds + 2048);
    LAS int* selrow = (LAS int*)(F.lds + 8192);
    const float* AFF = (const float*)(F.ws + WS_AFF); int* SLOT = (int*)(F.ws + WS_SLOT); float* EG = (float*)(F.ws + WS_EGATE);
    for (int it = F.bid; it < nitems; it += F.G) {
        const int e = it % NE, set = it / NE, kind = set / B_, b = set % B_;
        const int n = kind ? CTX : SEQ, cap = kind ? CAPC : CAPL; const int row0 = kind ? LATR + b * CTX : b * SEQ;
        const int sbase = kind ? B_ * CAPL + b * CAPC : b * CAPL;
        const int per = n >= NTHREADS ? n / NTHREADS : 1; const bool act = F.tid * per < n;
        unsigned key[8];
#pragma unroll
        for (int k = 0; k < 8; ++k) key[k] = (act && k < per) ? __builtin_bit_cast(unsigned, AFF[(size_t)(row0 + F.tid * per + k) * 16 + e]) : 0u;
        unsigned prefix = 0u, remaining = (unsigned)cap;
        for (int pass = 0; pass < 4; ++pass) {
            const int shift = 24 - 8 * pass; const unsigned mask = pass == 0 ? 0u : (0xFFFFFFFFu << (shift + 8));
            if (F.tid < 256) hist[F.tid] = 0u;
            __syncthreads();
#pragma unroll
            for (int k = 0; k < 8; ++k) if (act && k < per && ((key[k] & mask) == (prefix & mask))) lds_atomic_add(&hist[(key[k] >> shift) & 255u], 1u);
            __syncthreads();
            if (F.wave == 0) {
                const unsigned h0 = hist[4 * F.lane], h1 = hist[4 * F.lane + 1], h2 = hist[4 * F.lane + 2], h3 = hist[4 * F.lane + 3];
                unsigned suf = h0 + h1 + h2 + h3;
#pragma unroll
                for (int o = 1; o < 64; o <<= 1) { const unsigned tv = shfl_t(suf, F.lane + o); if (F.lane + o < 64) suf += tv; }
                unsigned cum = suf - (h0 + h1 + h2 + h3);
                int dsel = -1; unsigned above = 0u;
                if (cum < remaining) {
                    if (cum + h3 >= remaining) { dsel = 4 * F.lane + 3; above = cum; }
                    else if (cum + h3 + h2 >= remaining) { dsel = 4 * F.lane + 2; above = cum + h3; }
                    else if (cum + h3 + h2 + h1 >= remaining) { dsel = 4 * F.lane + 1; above = cum + h3 + h2; }
                    else if (cum + h3 + h2 + h1 + h0 >= remaining) { dsel = 4 * F.lane; above = cum + h3 + h2 + h1; }
                }
                if (dsel >= 0) { selw[0] = prefix | ((unsigned)dsel << shift); selw[1] = remaining - above; }
            }
            __syncthreads();
            prefix = selw[0]; remaining = selw[1];
            __syncthreads();
        }
        const unsigned T = prefix, need_eq = remaining;
        unsigned ngt = 0u, neq = 0u;
#pragma unroll
        for (int k = 0; k < 8; ++k) if (act && k < per) { ngt += key[k] > T ? 1u : 0u; neq += key[k] == T ? 1u : 0u; }
        unsigned pk = (ngt << 16) | neq;
#pragma unroll
        for (int o = 1; o < 64; o <<= 1) { const unsigned tv = shfl_t(pk, F.lane - o); if (F.lane >= o) pk += tv; }
        if (F.lane == 63) cnt[F.wave] = pk;
        __syncthreads();
        unsigned base = 0u;
#pragma unroll
        for (int w8 = 0; w8 < NWAVES; ++w8) base += (w8 < F.wave) ? cnt[w8] : 0u;
        const unsigned excl = base + pk - ((ngt << 16) | neq);
        unsigned gtb = excl >> 16, eqb = excl & 0xffffu;
#pragma unroll
        for (int k = 0; k < 8; ++k) if (act && k < per) {
            const int row = row0 + F.tid * per + k; int slot = -1;
            const bool isgt = key[k] > T, iseq = key[k] == T;
            if (isgt || (iseq && eqb < need_eq)) { slot = (int)(gtb + (eqb < need_eq ? eqb : need_eq)); selrow[slot] = row; EG[(size_t)e * EPAD + sbase + slot] = __builtin_bit_cast(float, key[k]); }
            SLOT[(size_t)row * 16 + e] = slot >= 0 ? sbase + slot : -1;
            gtb += isgt ? 1u : 0u; eqb += iseq ? 1u : 0u;
        }
        __syncthreads();
        for (int sl = F.tid; sl < cap; sl += NTHREADS) ((int*)(F.ws + WS_EIDX))[(size_t)e * EPAD + sbase + sl] = selrow[sl];
        if (it < NE) for (int pr = EROWS + F.tid; pr < EPAD; pr += NTHREADS) EG[(size_t)e * EPAD + pr] = 0.f;
        __syncthreads();
    }
}

DEV void phase_gather(const Frame& F0, int l) {
    const Frame F = refresh(F0);
    const int erows = (l == DEPTH - 1) ? B_ * CAPL : EROWS;
    const int* EI = (const int*)(F.ws + WS_EIDX);
    for (int r0 = 4 * F.gw; r0 < NE * EPAD; r0 += 4 * F.NGW) {
        u32x4 v[4][2];
#pragma unroll
        for (int q = 0; q < 4; ++q) { const int r = r0 + q, sl = r % EPAD; v[q][0] = (u32x4){0u, 0u, 0u, 0u}; v[q][1] = v[q][0];
            if (sl < erows) { const u32x4* src = (const u32x4*)((const bf16_t*)(F.ws + WS_XIN) + (size_t)EI[r] * 1024) + F.lane; v[q][0] = src[0]; v[q][1] = src[64]; } }
#pragma unroll
        for (int q = 0; q < 4; ++q) { u32x4* dst = (u32x4*)((bf16_t*)(F.ws + WS_XS) + (size_t)(r0 + q) * 1024) + F.lane; dst[0] = v[q][0]; dst[64] = v[q][1]; }
    }
}

template <int RG> DEV void ln2_group(const Frame& F, int l, int r) {

    float* H = (float*)(F.ws + WS_H); const int* SLOT = (const int*)(F.ws + WS_SLOT); const bf16_t* YSE = (const bf16_t*)(F.ws + WS_YSE);
    const float* lg = GIN(I_LN2G) + l * 1024; const float* lb = GIN(I_LN2B) + l * 1024;
    {
        int b, s; row_bs(r, b, s); const int mr = s < CTX ? B_ : b; const float* mod = (const float*)(F.ws + WS_MOD) + ((size_t)l * NR + mr) * 6144;
        f32x4 t[RG][4];
#pragma unroll
        for (int q = 0; q < RG; ++q) {
#pragma unroll
            for (int j = 0; j < 4; ++j) t[q][j] = (f32x4){0.f, 0.f, 0.f, 0.f}; }
        const int myslot = F.lane < RG * 16 ? SLOT[(size_t)r * 16 + F.lane] : -1;
#pragma unroll
        for (int q = 0; q < RG; ++q)
#pragma unroll
            for (int e = 0; e < NE; ++e) { const int sl = bcast_lane(myslot, 16 * q + e);
                if (sl >= 0) { const u32x2* yp = (const u32x2*)(YSE + ((size_t)e * EPAD + sl) * 1024) + F.lane;
#pragma unroll
                    for (int j = 0; j < 4; ++j) { const u32x2 w = yp[64 * j]; t[q][j] += (f32x4){bflo(w.x), bfhi(w.x), bflo(w.y), bfhi(w.y)}; } } }
#pragma unroll
        for (int j = 0; j < 4; ++j) { const f32x4 g2 = *((const f32x4*)(mod + 5120) + F.lane + 64 * j);
#pragma unroll
            for (int q = 0; q < RG; ++q) { const f32x4 hv = *((const f32x4*)(H + (size_t)(r + q) * 1024) + F.lane + 64 * j); t[q][j] = ALPHA * hv + g2 * t[q][j]; } }
        ln_rows<RG>(F, t, lg, lb);
        if (l == DEPTH - 1) {
            {
#pragma unroll
                for (int q = 0; q < RG; ++q) { GAS f32x4* op = (GAS f32x4*)(F.out + (size_t)(r + q) * 1024) + F.lane;
#pragma unroll
                    for (int j = 0; j < 4; ++j) op[64 * j] = t[q][j]; } }
        } else {
#pragma unroll
            for (int q = 0; q < RG; ++q)
#pragma unroll
                for (int j = 0; j < 4; ++j) *((f32x4*)(H + (size_t)(r + q) * 1024) + F.lane + 64 * j) = t[q][j];
            xg_rows<RG>(F, l + 1, r, t);
        }
    }
}
DEV void phase_ln2(const Frame& F0, int l) {
    const Frame F = refresh(F0);
    const int nrows = (l == DEPTH - 1) ? LATR : MROWS;
    ROW_GROUPS(nrows, ln2_group<4>(F, l, r), ln2_group<2>(F, l, r));
}

struct EpiP {
    static constexpr bool PERM = true;
    bf16_t* O; int ldc;
    DEV void operator()(const f32x4 (&acc)[2][2][4][2], const pg8::Unit& u, int wr, int wc, int fr, int fq) const {
        const int row0 = u.pm * 256 + wr * 64 + fr, col0 = u.pn * 256 + wc * 32 + 8 * fq;
#pragma unroll
        for (int ai = 0; ai < 2; ++ai)
#pragma unroll
            for (int m = 0; m < 4; ++m) { bf16_t* rowp = O + (size_t)(row0 + ai * 128 + m * 16) * ldc + col0;
#pragma unroll
                for (int bj = 0; bj < 2; ++bj) { const f32x4 v0 = acc[ai][bj][m][0], v1 = acc[ai][bj][m][1];
                    u32x4 w; w.x = pg8::cvt_pk_bf16(v0[0], v0[1]); w.y = pg8::cvt_pk_bf16(v0[2], v0[3]); w.z = pg8::cvt_pk_bf16(v1[0], v1[1]); w.w = pg8::cvt_pk_bf16(v1[2], v1[3]);
                    *(u32x4*)(rowp + bj * 128) = w; } }
    }
};
struct EpiGlu {
    static constexpr bool PERM = true;
    bf16_t* MG; const bf16_t* YS; const float* bias;
    DEV void operator()(const f32x4 (&acc)[2][2][4][2], const pg8::Unit& u, int wr, int wc, int fr, int fq) const {
        const int row0 = u.pm * 256 + wr * 64 + fr, col0 = u.pn * 256 + wc * 32 + 8 * fq;
#pragma unroll
        for (int ai = 0; ai < 2; ++ai)
#pragma unroll
            for (int m = 0; m < 4; ++m) { const int row = row0 + ai * 128 + m * 16;
#pragma unroll
                for (int bj = 0; bj < 2; ++bj) { const int c = col0 + bj * 128; const f32x4 v0 = acc[ai][bj][m][0], v1 = acc[ai][bj][m][1];
                    const u32x4 yv = *(const u32x4*)(YS + (size_t)row * 512 + c); const f32x4 b0 = *(const f32x4*)(bias + c), b1 = *(const f32x4*)(bias + c + 4);
                    u32x4 w; w.x = pk2(bflo(yv.x) * fast_sigmoid(v0[0] + b0[0]), bfhi(yv.x) * fast_sigmoid(v0[1] + b0[1])); w.y = pk2(bflo(yv.y) * fast_sigmoid(v0[2] + b0[2]), bfhi(yv.y) * fast_sigmoid(v0[3] + b0[3]));
                    w.z = pk2(bflo(yv.z) * fast_sigmoid(v1[0] + b1[0]), bfhi(yv.z) * fast_sigmoid(v1[1] + b1[1])); w.w = pk2(bflo(yv.w) * fast_sigmoid(v1[2] + b1[2]), bfhi(yv.w) * fast_sigmoid(v1[3] + b1[3]));
                    *(u32x4*)(MG + (size_t)row * 1024 + 512 + c) = w; } }
    }
};
struct EpiF32 {
    static constexpr bool PERM = false;
    float* C; int ldc; const float* rowscale;
    DEV void operator()(const f32x4 (&acc)[2][2][4][2], const pg8::Unit& u, int wr, int wc, int fr, int fq) const {
        const int row0 = u.pm * 256 + wr * 64 + fr, col0 = u.pn * 256 + wc * 32 + 4 * fq;
        const size_t ebase = rowscale ? (size_t)u.e * EPAD : 0;
#pragma unroll
        for (int ai = 0; ai < 2; ++ai)
#pragma unroll
            for (int m = 0; m < 4; ++m) { const size_t row = ebase + row0 + ai * 128 + m * 16; const float sc = rowscale ? rowscale[row] : 1.0f; float* rowp = C + row * ldc + col0;
#pragma unroll
                for (int bj = 0; bj < 2; ++bj)
#pragma unroll
                    for (int n = 0; n < 2; ++n) *(f32x4*)(rowp + bj * 128 + n * 16) = acc[ai][bj][m][n] * sc; }
    }
};
struct EpiYse {
    static constexpr bool PERM = true;
    bf16_t* O; const float* rowscale;
    DEV void operator()(const f32x4 (&acc)[2][2][4][2], const pg8::Unit& u, int wr, int wc, int fr, int fq) const {
        const int row0 = u.pm * 256 + wr * 64 + fr, col0 = u.pn * 256 + wc * 32 + 8 * fq; const size_t ebase = (size_t)u.e * EPAD;
#pragma unroll
        for (int ai = 0; ai < 2; ++ai)
#pragma unroll
            for (int m = 0; m < 4; ++m) { const size_t row = ebase + row0 + ai * 128 + m * 16; const float sc = rowscale[row]; bf16_t* rowp = O + row * 1024 + col0;
#pragma unroll
                for (int bj = 0; bj < 2; ++bj) { const f32x4 v0 = acc[ai][bj][m][0] * sc, v1 = acc[ai][bj][m][1] * sc;
                    u32x4 w; w.x = pg8::cvt_pk_bf16(v0[0], v0[1]); w.y = pg8::cvt_pk_bf16(v0[2], v0[3]); w.z = pg8::cvt_pk_bf16(v1[0], v1[1]); w.w = pg8::cvt_pk_bf16(v1[2], v1[3]);
                    *(u32x4*)(rowp + bj * 128) = w; } }
    }
};
struct EpiSwiglu {
    static constexpr bool PERM = true;
    bf16_t* HID;
    DEV void operator()(const f32x4 (&acc)[2][2][4][2], const pg8::Unit& u, int wr, int wc, int fr, int fq) const {
        const int row0 = u.pm * 256 + wr * 64 + fr, col0 = u.pn * 128 + wc * 32 + 8 * fq;
#pragma unroll
        for (int ai = 0; ai < 2; ++ai)
#pragma unroll
            for (int m = 0; m < 4; ++m) { bf16_t* rowp = HID + ((size_t)u.e * EPAD + row0 + ai * 128 + m * 16) * FF + col0;
                const f32x4 g0 = acc[ai][0][m][0], g1 = acc[ai][0][m][1], u0 = acc[ai][1][m][0], u1 = acc[ai][1][m][1];
                u32x4 w; w.x = pk2(fast_silu(g0[0]) * u0[0], fast_silu(g0[1]) * u0[1]); w.y = pk2(fast_silu(g0[2]) * u0[2], fast_silu(g0[3]) * u0[3]);
                w.z = pk2(fast_silu(g1[0]) * u1[0], fast_silu(g1[1]) * u1[1]); w.w = pk2(fast_silu(g1[2]) * u1[2], fast_silu(g1[3]) * u1[3]);
                *(u32x4*)rowp = w; }
    }
};

DEV void gemm_g1(const Frame& F0, int l, int vcu) {
    const Frame F = refresh(F0);
    const int nin = (l & 1) ? NIN_O : NIN_E;
    pg8::PlainOrder S; S.init((const void*)(F.ws + WS_XIN), (const bf16_t*)(F.ws + WS_WIN) + (size_t)l * NINMAX * 1024, 1024, MPAD, nin, F.G, vcu);
    EpiP E; E.O = (bf16_t*)(F.ws + WS_P); E.ldc = nin;
    pg8::gemm_phase(F.lds, 1024, S, E, F.wave, F.lane);
}
DEV void gemm_glu(const Frame& F0, int l, int vcu) {
    const Frame F = refresh(F0);
    const int li = l >> 1;
    pg8::PlainOrder S; S.init((const void*)(F.ws + WS_YS), (const bf16_t*)(F.ws + WS_WGLU) + (size_t)li * 512 * 512, 512, (l == DEPTH - 1) ? LATPAD : MPAD, 512, F.G, vcu);
    EpiGlu E; E.MG = (bf16_t*)(F.ws + WS_MERGED); E.YS = (const bf16_t*)(F.ws + WS_YS); E.bias = GIN(I_ODBGLU) + li * 512;
    pg8::gemm_phase(F.lds, 512, S, E, F.wave, F.lane);
}
DEV void gemm_g3(const Frame& F0, int l, int vcu) {
    const Frame F = refresh(F0);
    pg8::PlainOrder S; S.init((const void*)(F.ws + WS_MERGED), (const bf16_t*)(F.ws + WS_WOUT) + (size_t)l * 1024 * 1024, 1024, (l == DEPTH - 1) ? LATPAD : MPAD, 1024, F.G, vcu);
    EpiF32 E; E.C = (float*)(F.ws + WS_Y); E.ldc = 1024; E.rowscale = nullptr;
    pg8::gemm_phase(F.lds, 1024, S, E, F.wave, F.lane);
}
DEV void gemm_g4(const Frame& F0, int l, int vcu) {
    const Frame F = refresh(F0);
    pg8::GroupedOrder S; S.init((const void*)(F.ws + WS_XS), (const bf16_t*)(F.ws + WS_WGU) + (size_t)l * NE * 2 * FF * 1024, 1024, 2 * FF, F.G, vcu, (l == DEPTH - 1) ? B_ * CAPL : EROWS);
    EpiSwiglu E; E.HID = (bf16_t*)(F.ws + WS_HID);
    pg8::gemm_phase(F.lds, 1024, S, E, F.wave, F.lane);
}
DEV void gemm_g5(const Frame& F0, int l, int vcu) {
    const Frame F = refresh(F0);
    pg8::GroupedOrder S; S.init((const void*)(F.ws + WS_HID), (const bf16_t*)(F.ws + WS_WD) + (size_t)l * NE * 1024 * FF, FF, 1024, F.G, vcu, (l == DEPTH - 1) ? B_ * CAPL : EROWS);
    EpiYse E; E.O = (bf16_t*)(F.ws + WS_YSE); E.rowscale = (const float*)(F.ws + WS_EGATE);
    pg8::gemm_phase(F.lds, FF, S, E, F.wave, F.lane);
}

__global__ void __launch_bounds__(NTHREADS, 2) mega_fwd(Args args) {
#ifdef EMU
    LAS unsigned char* lds = emu::lds();
#else
    extern __shared__ __attribute__((aligned(16))) unsigned char lds_raw[];
    LAS unsigned char* lds = (LAS unsigned char*)lds_raw;
#endif
    Frame F;
    F.in = args.in; F.out = (GAS float*)args.out; F.ws = (GAS unsigned char*)args.ws; F.lds = lds;
    F.tid = threadIdx.x; F.lane = F.tid & 63; F.wave = readfirstlane_i(F.tid >> 6); F.G = gridDim.x; F.bid = blockIdx.x;
    F.gw = F.bid * NWAVES + F.wave; F.NGW = F.G * NWAVES;
    for (int u = F.tid; u < (LDS_BYTES - LDS_MISC) / 4; u += NTHREADS) ((LAS unsigned*)(lds + LDS_MISC))[u] = 0u;
    __syncthreads();
    XcdBarrier bar = xcd_barrier_post((unsigned*)(F.ws + WS_CTL), (volatile LAS unsigned*)(lds + LDS_MISC), F.wave);
#define GRID_BAR() xcd_barrier(bar)
    const int vcu = (F.G % 8 == 0) ? (F.bid % 8) * (F.G / 8) + F.bid / 8 : F.bid;

#ifndef PHASE_MASK
#define PHASE_MASK 0xFFFFF
#endif
#ifndef REPEAT_MASK
#define REPEAT_MASK 0x0
#endif
#ifndef TIMING_PROBE
#define TIMING_PROBE -1
#endif
    unsigned long long pt_acc = 0ull, pt_t0 = 0ull;
#define PT(k) do { if (TIMING_PROBE == (k)) pt_t0 = rt_now(); } while (0)
#define PTE(k) do { if (TIMING_PROBE == (k)) pt_acc += rt_now() - pt_t0; } while (0)
#define PH(k) if ((PHASE_MASK >> (k)) & 1)
#define RP(k) if ((REPEAT_MASK >> (k)) & 1)
    PT(0); PH(0) phase_prologue_a(F);
    RP(0) { GRID_BAR(); phase_prologue_a(F); }
    GRID_BAR(); PTE(0);
    PT(1); PH(1) phase_xg0(F);
    GRID_BAR(); PTE(1);
    for (int l = 0; l < DEPTH; ++l) {
        const int odd = l & 1;
        PT(2); PH(2) gemm_g1(F, l, F.bid);
        RP(2) { GRID_BAR(); gemm_g1(F, l, F.bid); }
        GRID_BAR(); PTE(2);
        PT(3); PH(3) phase_prep(F, l);
        RP(3) { GRID_BAR(); phase_prep(F, l); }
        GRID_BAR(); PTE(3);
        PT(4); PH(4) phase_cl(F, l);
        RP(4) { GRID_BAR(); phase_cl(F, l); }
        GRID_BAR(); PTE(4);
        PT(5); PH(5) phase_seq(F, l);
        RP(5) { GRID_BAR(); phase_seq(F, l); }
        GRID_BAR(); PTE(5);
#ifdef SEQ_XPROBE
        if ((l & 1) == SEQ_XPARITY) { PT(20); phase_seq(F, l, 10 + SEQ_XPROBE); GRID_BAR(); PTE(20); }
#endif
        PT(6); PH(6) phase_merge(F, l);
        RP(6) { GRID_BAR(); phase_merge(F, l); }
        GRID_BAR(); PTE(6);
        if (odd) { PT(7); PH(7) gemm_glu(F, l, F.bid); RP(7) { GRID_BAR(); gemm_glu(F, l, F.bid); } GRID_BAR(); PTE(7); }
        PT(8); PH(8) gemm_g3(F, l, F.bid);
        RP(8) { GRID_BAR(); gemm_g3(F, l, F.bid); }
        GRID_BAR(); PTE(8);
        PT(9); PH(9) phase_ln1(F, l);
        GRID_BAR(); PTE(9);
        PT(10); PH(10) phase_topk(F, l);
        RP(10) { GRID_BAR(); phase_topk(F, l); }
        GRID_BAR(); PTE(10);
        PT(14); PH(10) phase_gather(F, l);
        GRID_BAR(); PTE(14);
        PT(11); PH(11) gemm_g4(F, l, F.bid);
        RP(11) { GRID_BAR(); gemm_g4(F, l, F.bid); }
        GRID_BAR(); PTE(11);
        PT(12); PH(12) gemm_g5(F, l, F.bid);
        RP(12) { GRID_BAR(); gemm_g5(F, l, F.bid); }
        GRID_BAR(); PTE(12);
        PT(13); PH(13) phase_ln2(F, l);
        if (l + 1 < DEPTH || TIMING_PROBE >= 0) GRID_BAR();
        PTE(13);
    }
    if (TIMING_PROBE >= 0 && F.bid == 0) { const unsigned long long t1 = rt_now() + pt_acc; while (rt_now() < t1) s_sleep1(); }
}

#ifndef EMU
extern "C" void kernel_launch(void* const* d_in, const int* in_sizes, int n_in, void* d_out, int out_size, void* d_ws, size_t ws_size, hipStream_t stream) {
    static int grid = 0;
    if (grid == 0) {
        if (n_in != N_IN || ws_size < WS_END) { fprintf(stderr, "kernel_launch: need %d inputs and %zu bytes of workspace; got %d, %zu\n", (int)N_IN, (size_t)WS_END, n_in, ws_size); grid = -1; return; }
        int dev = 0, cus = 0, per_cu = 0;
        if (hipGetDevice(&dev) != hipSuccess || hipDeviceGetAttribute(&cus, hipDeviceAttributeMultiprocessorCount, dev) != hipSuccess) { grid = -1; return; }
        if (hipFuncSetAttribute((const void*)mega_fwd, hipFuncAttributeMaxDynamicSharedMemorySize, LDS_BYTES) != hipSuccess) { fprintf(stderr, "kernel_launch: hipFuncSetAttribute failed\n"); grid = -1; return; }
        if (hipOccupancyMaxActiveBlocksPerMultiprocessor(&per_cu, (const void*)mega_fwd, NTHREADS, LDS_BYTES) != hipSuccess || per_cu < 1) { fprintf(stderr, "kernel_launch: occupancy query says %d\n", per_cu); }
        (void)hipGetLastError();
        grid = cus;
    }
    if (grid < 0) return;
    (void)hipMemsetAsync((char*)d_ws + WS_CTL, 0, CTL_BYTES, stream);
    Args a{};
    for (int i = 0; i < N_IN; ++i) a.in[i] = (const float*)d_in[i];
    a.out = (float*)d_out; a.ws = (unsigned char*)d_ws;
    hipLaunchKernelGGL(mega_fwd, dim3(grid), dim3(NTHREADS), LDS_BYTES, stream, a);
}
#endif
```

```cpp
#ifdef EMU
#include "emu.h"
#else
#include <hip/hip_runtime.h>
#endif
#include <cstdio>
#include <cstdint>
#include <cstddef>

#ifndef CFG_BATCH
#define CFG_BATCH 4
#define CFG_SEQ 4096
#define CFG_CTX 256
#define CFG_DEPTH 4
#define CFG_NEXP 16
#define CFG_FF 2048
#endif
constexpr int B_ = CFG_BATCH, SEQ = CFG_SEQ, CTX = CFG_CTX, DEPTH = CFG_DEPTH, NE = CFG_NEXP, FF = CFG_FF;
constexpr int D = 1024, TOK = CTX + SEQ, MROWS = B_ * TOK, MPAD = (MROWS + 255) / 256 * 256;
constexpr int NCH = TOK / 64;
constexpr int LATR = B_ * SEQ;
constexpr int LATPAD = (LATR + 255) / 256 * 256;
constexpr int CAPL = 2 * SEQ / NE, CAPC = 2 * CTX / NE, EROWS = B_ * (CAPL + CAPC), EPAD = (EROWS + 255) / 256 * 256;
constexpr int NIN_E = 4096, NIN_O = 2560, NINMAX = 4096;
constexpr int N_EVEN = (DEPTH + 1) / 2, N_ODD = DEPTH / 2, N_ODDA = N_ODD > 0 ? N_ODD : 1;
constexpr int NR = B_ + 1;
constexpr float ALPHA = 1.681792830507429f;
constexpr float LN_EPS = 1e-5f;
constexpr float HD_SCALE = 0.08838834764831845f;
constexpr int NWAVES = 8, NTHREADS = 512;

enum { I_X = 0, I_C, I_CTX, I_CCTX, I_WMOD, I_BMOD, I_LN1G, I_LN1B, I_LN2G, I_LN2B, I_WROUTER, I_WGATE, I_WUP, I_WDOWN,
       I_EVWIN, I_EVWOUT, I_EVCONV, I_EVALOG, I_EVDTB, I_EVGDNN, I_EVRETN,
       I_ODWIN, I_ODWOUT, I_ODCONV, I_ODGB, I_ODMN, I_ODLRE, I_ODLIM, I_ODLDT, I_ODBRE, I_ODBIM, I_ODCRE, I_ODCIM, I_ODDSKIP, I_ODWGLU, I_ODBGLU, N_IN };

constexpr size_t al256(size_t x) { return (x + 255) & ~(size_t)255; }
constexpr size_t WS_CTL = 0, CTL_BYTES = 65536;
constexpr size_t WS_MOD = WS_CTL + CTL_BYTES;
constexpr size_t WS_WG = al256(WS_MOD + (size_t)DEPTH * NR * 6144 * 4);
constexpr size_t WS_WIN = al256(WS_WG + (size_t)DEPTH * 16 * 1024 * 4);
constexpr size_t WS_WOUT = al256(WS_WIN + (size_t)DEPTH * NINMAX * 1024 * 2);
constexpr size_t WS_WGLU = al256(WS_WOUT + (size_t)DEPTH * 1024 * 1024 * 2);
constexpr size_t WS_WGU = al256(WS_WGLU + (size_t)N_ODDA * 512 * 512 * 2);
constexpr size_t WS_WD = al256(WS_WGU + (size_t)DEPTH * NE * 2 * FF * 1024 * 2);
constexpr size_t WS_S5A = al256(WS_WD + (size_t)DEPTH * NE * 1024 * FF * 2);
constexpr size_t WS_S5B = al256(WS_S5A + (size_t)N_ODDA * 2 * 32 * 128 * 4);
constexpr size_t WS_S5C = al256(WS_S5B + (size_t)N_ODDA * 2 * 32 * 128 * 16 * 2);
constexpr size_t WS_H = al256(WS_S5C + (size_t)N_ODDA * 32 * 16 * 128 * 2);
constexpr size_t WS_XIN = al256(WS_H + (size_t)MPAD * 1024 * 4);
constexpr size_t WS_GATES = al256(WS_XIN + (size_t)MPAD * 1024 * 2);
constexpr size_t WS_MERGED = al256(WS_GATES + (size_t)MROWS * 16 * 4);
constexpr size_t WS_YS = al256(WS_MERGED + (size_t)MPAD * 1024 * 2);
constexpr size_t WS_Y = al256(WS_YS + (size_t)MPAD * 512 * 2);
constexpr size_t WS_AFF = al256(WS_Y + (size_t)MPAD * 1024 * 4);
constexpr size_t WS_SLOT = al256(WS_AFF + (size_t)MROWS * 16 * 4);
constexpr size_t WS_EGATE = al256(WS_SLOT + (size_t)MROWS * 16 * 4);
constexpr size_t WS_MCH = al256(WS_EGATE + (size_t)NE * EPAD * 4);
constexpr size_t WS_WR = al256(WS_MCH + (size_t)B_ * 4 * 2 * NCH * 4);
constexpr size_t WS_EIDX = al256(WS_WR + (size_t)DEPTH * NE * 1024 * 4);
constexpr size_t WS_S5E = al256(WS_EIDX + (size_t)NE * EPAD * 4);
constexpr size_t WS_R = al256(WS_S5E + (size_t)B_ * 2 * 32 * NCH * 128 * 4);
constexpr int NCP = B_ * 8 * 2 * NCH, NCPG = B_ * 4 * 2 * NCH;
constexpr size_t WS_P = WS_R;
constexpr size_t WS_QKV = al256(WS_P + (size_t)MPAD * NINMAX * 2);
constexpr size_t WS_CLW = al256(WS_QKV + (size_t)MROWS * 1536 * 2);
constexpr size_t WS_CLQ = al256(WS_CLW + (size_t)NCP * 64 * 128 * 2);
constexpr size_t WS_CLK = al256(WS_CLQ + (size_t)NCP * 64 * 128 * 2);
constexpr size_t WS_CLA = al256(WS_CLK + (size_t)NCP * 64 * 128 * 2);
constexpr size_t WS_CLU = al256(WS_CLA + (size_t)NCP * 64 * 64 * 2);
constexpr size_t WS_CLS = al256(WS_CLU + (size_t)NCPG * 64 * 128 * 4);
constexpr size_t WS_O = al256(WS_CLS + (size_t)NCP * 512 * 4);
constexpr size_t WS_R_END1 = al256(WS_O + (size_t)2 * MROWS * 1024 * 4);
constexpr size_t WS_XS = WS_R;
constexpr size_t WS_HID = al256(WS_XS + (size_t)NE * EPAD * 1024 * 2);
constexpr size_t WS_YSE = al256(WS_HID + (size_t)NE * EPAD * FF * 2);
constexpr size_t WS_R_END2 = al256(WS_YSE + (size_t)NE * EPAD * 1024 * 4);
constexpr size_t WS_END = WS_R_END1 > WS_R_END2 ? WS_R_END1 : WS_R_END2;

constexpr int LDS_BYTES = 163840;
constexpr int LDS_MISC = 163328;

typedef unsigned short bf16_t;
typedef short bf16x8 __attribute__((ext_vector_type(8)));
typedef float f32x2 __attribute__((ext_vector_type(2)));
typedef float f32x4 __attribute__((ext_vector_type(4)));
typedef float f32x16 __attribute__((ext_vector_type(16)));
typedef unsigned u32x2 __attribute__((ext_vector_type(2)));
typedef unsigned u32x4 __attribute__((ext_vector_type(4)));
#define DEV __device__ __forceinline__

#ifdef EMU
#define LAS
#define GAS
static inline float bf2f_h(bf16_t b) { unsigned u = (unsigned)b << 16; float f; memcpy(&f, &u, 4); return f; }
static inline f32x4 mfma16(bf16x8 a, bf16x8 b, f32x4 c) {
    struct In { bf16x8 a, b; } in{a, b};
    auto s = emu::wave_xchg(&in, sizeof(in)); const int l = emu::cur->lane, col = l & 15, rg = l >> 4;
    for (int r = 0; r < 4; ++r) { const int row = 4 * rg + r; double acc = c[r];
        for (int kg = 0; kg < 4; ++kg) { const In* pa = (const In*)s[row + 16 * kg]; const In* pb = (const In*)s[col + 16 * kg];
            for (int j = 0; j < 8; ++j) acc += (double)bf2f_h((bf16_t)pa->a[j]) * (double)bf2f_h((bf16_t)pb->b[j]); }
        c[r] = (float)acc; }
    return c;
}
static inline f32x16 mfma32(bf16x8 a, bf16x8 b, f32x16 c) {
    struct In { bf16x8 a, b; } in{a, b};
    auto s = emu::wave_xchg(&in, sizeof(in)); const int l = emu::cur->lane, col = l & 31, h = l >> 5;
    for (int r = 0; r < 16; ++r) { const int row = (r & 3) + 8 * (r >> 2) + 4 * h; double acc = c[r];
        for (int kh = 0; kh < 2; ++kh) { const In* pa = (const In*)s[row + 32 * kh]; const In* pb = (const In*)s[col + 32 * kh];
            for (int j = 0; j < 8; ++j) acc += (double)bf2f_h((bf16_t)pa->a[j]) * (double)bf2f_h((bf16_t)pb->b[j]); }
        c[r] = (float)acc; }
    return c;
}
static inline void glds16(const void* g, void* l) { memcpy((char*)l + 16 * emu::cur->lane, g, 16); }
#define S_BARRIER() emu::block_barrier()
#define WAIT_VM(n) do {} while (0)
#define WAIT_LGKM(n) do {} while (0)
#define WAIT_ALL() do {} while (0)
#define SETPRIO(n) do {} while (0)
#define SCHED_BARRIER() do {} while (0)
#define COMPILER_FENCE() do {} while (0)
#define WAVE_LDS_SYNC() do { int _z = 0; (void)emu::wave_xchg(&_z, 4); } while (0)
#define LAUNDER(x) do {} while (0)
#define CODE_ALIGN() do {} while (0)
#define LAUNDER_S(x) do {} while (0)
static inline int lane_id() { return emu::cur->lane; }
template <class T> static inline T shfl_xor_t(T v, int m) { auto s = emu::wave_xchg(&v, sizeof(T)); T r; memcpy(&r, s[emu::cur->lane ^ m], sizeof(T)); return r; }
template <class T> static inline T shfl_t(T v, int src) { auto s = emu::wave_xchg(&v, sizeof(T)); T r; memcpy(&r, s[src & 63], sizeof(T)); return r; }
static inline float wave_sum(float v) { for (int o = 1; o < 64; o <<= 1) v += shfl_xor_t(v, o); return v; }
static inline float wave_max(float v) { for (int o = 1; o < 64; o <<= 1) v = fmaxf(v, shfl_xor_t(v, o)); return v; }
template <int W> static inline float group_sum(float v) { for (int o = 1; o < W; o <<= 1) v += shfl_xor_t(v, o); return v; }
template <int W> static inline float group_max(float v) { for (int o = 1; o < W; o <<= 1) v = fmaxf(v, shfl_xor_t(v, o)); return v; }
static inline int bcast_lane(int v, int src) { return shfl_t(v, src); }
static inline float bcast_lane_f(float v, int src) { return shfl_t(v, src); }
static inline float wave_scan_add(float v) { const int ln = emu::cur->lane; for (int o = 1; o < 64; o <<= 1) { const float t = shfl_t(v, ln - o); if (ln >= o) v += t; } return v; }
static inline float wave_scan_max(float v) { const int ln = emu::cur->lane; for (int o = 1; o < 64; o <<= 1) { const float t = shfl_t(v, ln - o); if (ln >= o) v = fmaxf(v, t); } return v; }
static inline int readfirstlane_i(int v) { return v; }
static inline unsigned xb_ld(unsigned* p) { return *(volatile unsigned*)p; }
static inline unsigned xb_add(unsigned* p, unsigned v) { unsigned o = *p; *p = o + v; return o; }
static inline unsigned xb_xcc_id() { return (unsigned)emu::cur->bid & 7u; }
static inline void s_sleep1() { emu::yield(); }
static inline void fence_acquire() {}
static inline void fence_release() {}
static inline unsigned lds_atomic_add(unsigned* p, unsigned v) { unsigned o = *p; *p = o + v; return o; }
static inline unsigned long long rt_now() { return 0ull; }
static inline float fast_exp2(float x) { return exp2f(x); }
static inline float fast_rcp(float x) { return 1.0f / x; }
#else
#define LAS __attribute__((address_space(3)))
#define GAS __attribute__((address_space(1)))
DEV f32x4 mfma16(bf16x8 a, bf16x8 b, f32x4 c) { return __builtin_amdgcn_mfma_f32_16x16x32_bf16(a, b, c, 0, 0, 0); }
DEV f32x16 mfma32(bf16x8 a, bf16x8 b, f32x16 c) { return __builtin_amdgcn_mfma_f32_32x32x16_bf16(a, b, c, 0, 0, 0); }
#define glds16(g, l) __builtin_amdgcn_global_load_lds((const unsigned*)(g), (LAS unsigned*)(l), 16, 0, 0)
#define S_BARRIER() __builtin_amdgcn_s_barrier()
#define WAIT_VM(n) asm volatile("s_waitcnt vmcnt(" #n ")" ::: "memory")
#define WAIT_LGKM(n) asm volatile("s_waitcnt lgkmcnt(" #n ")" ::: "memory")
#define WAIT_ALL() asm volatile("s_waitcnt vmcnt(0) lgkmcnt(0)" ::: "memory")
#define SETPRIO(n) __builtin_amdgcn_s_setprio(n)
#define SCHED_BARRIER() __builtin_amdgcn_sched_barrier(0)
#define COMPILER_FENCE() asm volatile("" ::: "memory")
#define WAVE_LDS_SYNC() asm volatile("s_waitcnt lgkmcnt(0)" ::: "memory")
#define LAUNDER(x) asm volatile("" : "+v"(x))
#define CODE_ALIGN() asm volatile(".p2align 8")
#define LAUNDER_S(x) asm volatile("" : "+s"(x))
DEV int lane_id() { return (int)__builtin_amdgcn_mbcnt_hi(~0u, __builtin_amdgcn_mbcnt_lo(~0u, 0u)); }
template <class T> DEV T shfl_xor_t(T v, int m) { return __shfl_xor(v, m); }
template <class T> DEV T shfl_t(T v, int src) { return __shfl(v, src); }
template <int CTRL, int ROWMASK> DEV float dpp_mov(float v) { return __builtin_bit_cast(float, __builtin_amdgcn_update_dpp(0, __builtin_bit_cast(int, v), CTRL, ROWMASK, 0xf, false)); }
template <int CTRL, int ROWMASK> DEV float dpp_mov_keep(float oldv, float v) { return __builtin_bit_cast(float, __builtin_amdgcn_update_dpp(__builtin_bit_cast(int, oldv), __builtin_bit_cast(int, v), CTRL, ROWMASK, 0xf, false)); }
template <int W> DEV float group_sum(float v) {
    v += dpp_mov<0xB1, 0xf>(v); v += dpp_mov<0x4E, 0xf>(v);
    if (W >= 8) v += dpp_mov<0x141, 0xf>(v);
    if (W >= 16) v += dpp_mov<0x140, 0xf>(v);
    return v;
}
DEV float wave_sum(float v) {
    v = group_sum<16>(v);
    v += dpp_mov<0x142, 0xa>(v);
    v += dpp_mov<0x143, 0xc>(v);
    return __builtin_bit_cast(float, __builtin_amdgcn_readlane(__builtin_bit_cast(int, v), 63));
}
DEV float wave_max(float v) {
    v = fmaxf(v, dpp_mov_keep<0xB1, 0xf>(v, v)); v = fmaxf(v, dpp_mov_keep<0x4E, 0xf>(v, v)); v = fmaxf(v, dpp_mov_keep<0x141, 0xf>(v, v)); v = fmaxf(v, dpp_mov_keep<0x140, 0xf>(v, v));
    v = fmaxf(v, dpp_mov_keep<0x142, 0xa>(v, v)); v = fmaxf(v, dpp_mov_keep<0x143, 0xc>(v, v));
    return __builtin_bit_cast(float, __builtin_amdgcn_readlane(__builtin_bit_cast(int, v), 63));
}
template <int W> DEV float group_max(float v) {
    v = fmaxf(v, dpp_mov_keep<0xB1, 0xf>(v, v)); v = fmaxf(v, dpp_mov_keep<0x4E, 0xf>(v, v));
    if (W >= 8) v = fmaxf(v, dpp_mov_keep<0x141, 0xf>(v, v));
    if (W >= 16) v = fmaxf(v, dpp_mov_keep<0x140, 0xf>(v, v));
    return v;
}
DEV int bcast_lane(int v, int src) { return __builtin_amdgcn_readlane(v, src); }
DEV float bcast_lane_f(float v, int src) { return __builtin_bit_cast(float, __builtin_amdgcn_readlane(__builtin_bit_cast(int, v), src)); }
DEV float wave_scan_add(float v) {
    v += dpp_mov<0x111, 0xf>(v); v += dpp_mov<0x112, 0xf>(v); v += dpp_mov<0x114, 0xf>(v); v += dpp_mov<0x118, 0xf>(v);
    v += dpp_mov<0x142, 0xa>(v); v += dpp_mov<0x143, 0xc>(v); return v;
}
DEV float wave_scan_max(float v) {
    v = fmaxf(v, dpp_mov_keep<0x111, 0xf>(v, v)); v = fmaxf(v, dpp_mov_keep<0x112, 0xf>(v, v)); v = fmaxf(v, dpp_mov_keep<0x114, 0xf>(v, v)); v = fmaxf(v, dpp_mov_keep<0x118, 0xf>(v, v));
    v = fmaxf(v, dpp_mov_keep<0x142, 0xa>(v, v)); v = fmaxf(v, dpp_mov_keep<0x143, 0xc>(v, v)); return v;
}
DEV int readfirstlane_i(int v) { return __builtin_amdgcn_readfirstlane(v); }
DEV unsigned xb_ld(unsigned* p) { return __hip_atomic_load(p, __ATOMIC_RELAXED, __HIP_MEMORY_SCOPE_AGENT); }
DEV unsigned xb_add(unsigned* p, unsigned v) { return __hip_atomic_fetch_add(p, v, __ATOMIC_RELAXED, __HIP_MEMORY_SCOPE_AGENT); }
DEV unsigned xb_xcc_id() { return (unsigned)__builtin_amdgcn_s_getreg((3 << 11) | 20) & 0xFu; }
DEV void s_sleep1() { __builtin_amdgcn_s_sleep(1); }
DEV void fence_acquire() { __builtin_amdgcn_fence(__ATOMIC_ACQUIRE, "agent"); }
DEV void fence_release() { __builtin_amdgcn_fence(__ATOMIC_RELEASE, "agent"); }
DEV unsigned lds_atomic_add(LAS unsigned* p, unsigned v) { return __hip_atomic_fetch_add(p, v, __ATOMIC_RELAXED, __HIP_MEMORY_SCOPE_WORKGROUP); }
DEV unsigned long long rt_now() { return __builtin_amdgcn_s_memrealtime(); }
DEV float fast_exp2(float x) { return __builtin_amdgcn_exp2f(x); }
DEV float fast_rcp(float x) { return __builtin_amdgcn_rcpf(x); }
#endif

#ifdef EMU
DEV unsigned f2bf(float f) { unsigned u = __builtin_bit_cast(unsigned, f); return (u + 0x7fffu + ((u >> 16) & 1u)) >> 16; }
DEV unsigned pk2(float lo, float hi) { return f2bf(lo) | (f2bf(hi) << 16); }
DEV unsigned f2bf_sw(float f) { return f2bf(f); }
DEV unsigned pk2_sw(float lo, float hi) { return pk2(lo, hi); }
#else
typedef float f32x2n_t __attribute__((ext_vector_type(2)));
typedef __bf16 bf16x2n_t __attribute__((ext_vector_type(2)));
DEV unsigned pk2(float lo, float hi) { const f32x2n_t v = {lo, hi}; return __builtin_bit_cast(unsigned, __builtin_convertvector(v, bf16x2n_t)); }
DEV unsigned f2bf(float f) { return (unsigned)__builtin_bit_cast(unsigned short, (__bf16)f); }
DEV unsigned f2bf_sw(float f) { unsigned u = __builtin_bit_cast(unsigned, f); return (u + 0x7fffu + ((u >> 16) & 1u)) >> 16; }
DEV unsigned pk2_sw(float lo, float hi) { return f2bf_sw(lo) | (f2bf_sw(hi) << 16); }
#endif
DEV float bf2f(unsigned b) { return __builtin_bit_cast(float, b << 16); }
DEV float bflo(unsigned w) { return __builtin_bit_cast(float, w << 16); }
DEV float bfhi(unsigned w) { return __builtin_bit_cast(float, w & 0xffff0000u); }
DEV float sigmoid_f(float x) { return 1.0f / (1.0f + expf(-x)); }
DEV float silu_f(float x) { return x / (1.0f + expf(-x)); }
DEV float softplus_f(float x) { return fmaxf(x, 0.0f) + log1pf(expf(-fabsf(x))); }
DEV float fast_sigmoid(float x) { return fast_rcp(1.0f + fast_exp2(-1.4426950408889634f * x)); }
DEV float fast_silu(float x) { return x * fast_sigmoid(x); }
DEV float gelu_tanh_f(float x) { const float u = 0.7978845608028654f * (x + 0.044715f * x * x * x); return x * fast_sigmoid(2.0f * u); }
DEV float fast_exp(float x) { return fast_exp2(1.4426950408889634f * x); }

#define XB_TMO      128
#define XB_XCNT(j)  (256  + 64 * (j))
#define XB_XSUB(j)  (1280 + 64 * (j))
#define XB_XGEN(j)  (2304 + 64 * (j))
#define XB_TOP      3328
#define XB_TOPGEN   3392
#define XCD_BAR_WORDS 3456
#define XB_SPIN_CAP (1u << 20)
#define XB_SPIN(cond, bar) do { unsigned _sp = 0; while (cond) { s_sleep1(); \
    if ((++_sp & 255u) == 0u) { if (xb_ld(&(bar)[XB_TMO])) break; if (_sp > XB_SPIN_CAP) { xb_add(&(bar)[XB_TMO], 1u); break; } } } } while (0)
struct XcdBarrier { unsigned* bar; unsigned x; volatile LAS unsigned* st; int wave; };
DEV XcdBarrier xcd_barrier_post(unsigned* bar, volatile LAS unsigned* st, int wave) {
    XcdBarrier b; b.wave = wave; b.bar = bar; b.x = (unsigned)readfirstlane_i((int)xb_xcc_id()); b.st = st;
    if (wave == 0 && lane_id() == 0) (void)xb_add(&bar[XB_XCNT(b.x)], 1u);
    return b;
}
DEV void xcd_barrier_complete(unsigned* bar, unsigned x, unsigned& nloc, unsigned& nx) {
    const unsigned G = gridDim.x;
    unsigned sum, cnt, mine, sp = 0u;
    for (;;) {
        sum = 0u; cnt = 0u; mine = 0u;
#pragma unroll
        for (unsigned j = 0; j < 16; ++j) { const unsigned c = xb_ld(&bar[XB_XCNT(j)]); sum += c; cnt += (c > 0u) ? 1u : 0u; mine = (j == x) ? c : mine; }
        if (sum == G) break;
        s_sleep1();
        if ((++sp & 255u) == 0u) { if (xb_ld(&bar[XB_TMO])) break; if (sp > XB_SPIN_CAP) { xb_add(&bar[XB_TMO], 1u); break; } }
    }
    nloc = mine > 0u ? mine : 1u; nx = cnt > 0u ? cnt : 1u;
}
DEV void xcd_barrier(const XcdBarrier& b) {
    WAIT_VM(0);
    __syncthreads();
    int bw = b.wave; LAUNDER_S(bw);
    if (bw == 0 && lane_id() == 0) {
        unsigned* bar = b.bar; LAUNDER_S(bar);
        unsigned bx = b.x; LAUNDER_S(bx);
        WAIT_ALL();
        unsigned nloc = b.st[0], nx = b.st[1];
        if (nloc == 0u) { xcd_barrier_complete(bar, bx, nloc, nx); b.st[0] = nloc; b.st[1] = nx; }
        const unsigned old = xb_add(&bar[XB_XSUB(bx)], 1u);
        const unsigned gen = old / nloc;
        if (old + 1u == (gen + 1u) * nloc) {
            fence_release();
            WAIT_VM(0);
            const unsigned og = xb_add(&bar[XB_TOP], 1u);
            const unsigned tg = og / nx;
            if (og + 1u == (tg + 1u) * nx) xb_add(&bar[XB_TOPGEN], 1u);
            else XB_SPIN(xb_ld(&bar[XB_TOPGEN]) == tg, bar);
            fence_acquire();
            xb_add(&bar[XB_XGEN(bx)], 1u);
            WAIT_VM(0);
        } else {
            XB_SPIN(xb_ld(&bar[XB_XGEN(bx)]) == gen, bar);
            fence_acquire();
            WAIT_VM(0);
        }
    }
    __syncthreads();
}

namespace pg8 {
constexpr int BM = 256, BK = 64, HALF = 128, HTB = HALF * BK * 2, STAGE_BYTES = 8 * HTB;
DEV int lds_byte(int r, int c) { const int st = (r >> 4) * 2 + (c >> 5), rr = r & 15, cc = c & 31, ob = rr * 64 + cc * 2; return st * 1024 + (ob ^ (((ob >> 9) & 1) << 5)); }
DEV void stage_rc(int b, int& R, int& C) { const int st = b / 1024, sb = b % 1024, swz = sb ^ (((sb >> 9) & 1) << 5); R = (st >> 1) * 16 + swz / 64; C = (st & 1) * 32 + (swz % 64) / 2; }
DEV int perm32(int rho) { const int n = rho >> 4, i = rho & 15; return 8 * (i >> 2) + 4 * n + (i & 3); }
struct Unit { const char* A; const char* B; int pm, pn, e; };
#ifdef EMU
static inline unsigned cvt_pk_bf16(float lo, float hi) { return pk2(lo, hi); }
#else
DEV unsigned cvt_pk_bf16(float lo, float hi) { return pk2(lo, hi); }
#endif
template <class Epi, class Sched>
DEV void gemm_phase(LAS unsigned char* lds, const int K, const Sched& S, const Epi& E, const int wid, const int lane) {
    const int tid = wid * 64 + lane; const int wr = wid >> 2, wc = wid & 3, fr = lane & 15, fq = lane >> 4;
    const int nt = K / BK;
    unsigned voffA[2], voffB[2];
#pragma unroll
    for (int i = 0; i < 2; ++i) { int R, C; stage_rc(tid * 16 + i * 8192, R, C); const int Rb = Epi::PERM ? ((R & ~31) + perm32(R & 31)) : R;
        voffA[i] = (unsigned)(R * K + C) * 2u; voffB[i] = (unsigned)(Rb * K + C) * 2u; }
    const size_t kstep = (size_t)(BK * 2);
    const size_t hstep = (size_t)HALF * K * 2;
    const unsigned ldsw = (unsigned)wid * 1024u;
    const int aoff = lds_byte(wr * 64 + fr, fq * 8), boff = lds_byte(wc * 32 + fr, fq * 8);
#define PG8_SA(b, h) (((b) * 2 + (h)) * HTB)
#define PG8_SB(b, h) ((4 + (b) * 2 + (h)) * HTB)
#define PG8_STAGE(bufoff, gbase, voff) do { _Pragma("unroll") for (int _i = 0; _i < 2; ++_i) \
        glds16(((const char*)(gbase) + (voff)[_i]), (lds + (bufoff) + ldsw + _i * 8192)); } while (0)
#define PG8_LDA(dst, b, h) do { _Pragma("unroll") for (int m = 0; m < 4; ++m) _Pragma("unroll") for (int k = 0; k < 2; ++k) dst[m][k] = *(const LAS bf16x8*)(lds + PG8_SA(b, h) + aoff + m * 2048 + k * 1024); } while (0)
#define PG8_LDB(dst, b, h) do { _Pragma("unroll") for (int n = 0; n < 2; ++n) _Pragma("unroll") for (int k = 0; k < 2; ++k) dst[n][k] = *(const LAS bf16x8*)(lds + PG8_SB(b, h) + boff + n * 2048 + k * 1024); } while (0)
#define PG8_MMA(ai, bj, At, Bt) do { SETPRIO(1); _Pragma("unroll") for (int m = 0; m < 4; ++m) _Pragma("unroll") for (int n = 0; n < 2; ++n) _Pragma("unroll") for (int k = 0; k < 2; ++k) \
        acc[ai][bj][m][n] = mfma16(Bt[n][k], At[m][k], acc[ai][bj][m][n]); SETPRIO(0); } while (0)
    Unit cur, nxt; int ui = 0;
    if (!S.next(0, cur)) return;
    f32x4 acc[2][2][4][2];
#pragma unroll
    for (int a = 0; a < 2; ++a)
#pragma unroll
        for (int b = 0; b < 2; ++b)
#pragma unroll
            for (int m = 0; m < 4; ++m)
#pragma unroll
                for (int n = 0; n < 2; ++n) acc[a][b][m][n] = (f32x4){0.f, 0.f, 0.f, 0.f};
    bf16x8 At[4][2], B0[2][2], B1[2][2];
    const char* cA = cur.A; const char* cB = cur.B;
    PG8_STAGE(PG8_SB(0, 0), cB, voffB); PG8_STAGE(PG8_SB(0, 1), cB + hstep, voffB); PG8_STAGE(PG8_SA(0, 0), cA, voffA); PG8_STAGE(PG8_SA(0, 1), cA + hstep, voffA);
    if (wr == 1) S_BARRIER();
    WAIT_VM(2); S_BARRIER();
    PG8_STAGE(PG8_SB(1, 0), cB + kstep, voffB); PG8_STAGE(PG8_SA(1, 0), cA + kstep, voffA); PG8_STAGE(PG8_SB(1, 1), cB + hstep + kstep, voffB);
    WAIT_VM(6); S_BARRIER();
    CODE_ALIGN();
    for (;;) {
        const bool has_next = S.next(ui + 1, nxt);
        const char* nA = has_next ? nxt.A : cA; const char* nB = has_next ? nxt.B : cB;
        for (int t = 0; t < nt; t += 2) {
            const bool last = (t == nt - 2);
            const char* a1 = cA + (size_t)(t + 1) * kstep;
            const char* a2 = last ? nA : cA + (size_t)(t + 2) * kstep; const char* b2 = last ? nB : cB + (size_t)(t + 2) * kstep;
            const char* a3 = a2 + kstep; const char* b3 = b2 + kstep;
            PG8_LDB(B0, 0, 0); PG8_LDB(B1, 0, 1); SCHED_BARRIER(); PG8_LDA(At, 0, 0); PG8_STAGE(PG8_SA(1, 1), a1 + hstep, voffA);
            WAIT_VM(8); WAIT_LGKM(0); S_BARRIER(); PG8_MMA(0, 0, At, B0); PG8_MMA(0, 1, At, B1); S_BARRIER(); SCHED_BARRIER();
            PG8_LDA(At, 0, 1); PG8_STAGE(PG8_SB(0, 0), b2, voffB); PG8_STAGE(PG8_SB(0, 1), b2 + hstep, voffB); PG8_STAGE(PG8_SA(0, 0), a2, voffA);
            WAIT_VM(8); WAIT_LGKM(0); S_BARRIER(); PG8_MMA(1, 0, At, B0); PG8_MMA(1, 1, At, B1); S_BARRIER(); SCHED_BARRIER();
            PG8_LDB(B0, 1, 0); PG8_LDB(B1, 1, 1); SCHED_BARRIER(); PG8_LDA(At, 1, 0); PG8_STAGE(PG8_SA(0, 1), a2 + hstep, voffA);
            WAIT_VM(8); WAIT_LGKM(0); S_BARRIER(); PG8_MMA(0, 0, At, B0); PG8_MMA(0, 1, At, B1); S_BARRIER(); SCHED_BARRIER();
            PG8_LDA(At, 1, 1); PG8_STAGE(PG8_SB(1, 0), b3, voffB); PG8_STAGE(PG8_SB(1, 1), b3 + hstep, voffB); PG8_STAGE(PG8_SA(1, 0), a3, voffA);
            WAIT_VM(8); WAIT_LGKM(0); S_BARRIER(); PG8_MMA(1, 0, At, B0); PG8_MMA(1, 1, At, B1); S_BARRIER(); SCHED_BARRIER();
        }
        if (wr == 0) S_BARRIER();
        E(acc, cur, wr, wc, fr, fq);
        if (!has_next) break;
#pragma unroll
        for (int a = 0; a < 2; ++a)
#pragma unroll
            for (int b = 0; b < 2; ++b)
#pragma unroll
                for (int m = 0; m < 4; ++m)
#pragma unroll
                    for (int n = 0; n < 2; ++n) acc[a][b][m][n] = (f32x4){0.f, 0.f, 0.f, 0.f};
        cur = nxt; cA = nA; cB = nB; ++ui;
        if (wr == 1) S_BARRIER();
    }
    WAIT_VM(0);
    S_BARRIER();
#undef PG8_SA
#undef PG8_SB
#undef PG8_STAGE
#undef PG8_LDA
#undef PG8_LDB
#undef PG8_MMA
}

struct PlainOrder {
    const char* A; const char* Bt; int K, nM, nN, nwg, G, c;
    DEV void init(const void* A_, const void* Bt_, int K_, int M, int N, int G_, int c_) { A = (const char*)A_; Bt = (const char*)Bt_; K = K_; nM = M / BM; nN = N / BM; nwg = nM * nN; G = G_; c = c_; }
    DEV bool next(int i, Unit& u) const {
        const long L = (long)i * G + c; if (L >= nwg) return false;
        int wgid = (int)L; { const int q = nwg / 8, r = nwg % 8, xcd = wgid % 8, off = wgid / 8; wgid = (xcd < r ? xcd * (q + 1) : r * (q + 1) + (xcd - r) * q) + off; }
        const int nig = 8 * nN, gid = wgid / nig, fm = gid * 8, gsz = (nM - fm) < 8 ? (nM - fm) : 8;
        u.pm = fm + ((wgid % nig) % gsz); u.pn = (wgid % nig) / gsz; u.e = 0;
        u.A = A + (size_t)u.pm * BM * K * 2; u.B = Bt + (size_t)u.pn * BM * K * 2; return true;
    }
};
struct GroupedOrder {
    const char* A; const char* Bt; int K, nMe, nN, nwg, G, c; size_t bstride;
    DEV void init(const void* A_, const void* Bt_, int K_, int N, int G_, int c_, int erows) { A = (const char*)A_; Bt = (const char*)Bt_; K = K_; nMe = (erows + BM - 1) / BM; nN = N / BM; nwg = NE * nMe * nN; G = G_; c = c_; bstride = (size_t)N * K * 2; }
    DEV bool next(int i, Unit& u) const {
        const long L = (long)i * G + c; if (L >= nwg) return false;
        int wgid = (int)L; { const int q = nwg / 8, r = nwg % 8, xcd = wgid % 8, off = wgid / 8; wgid = (xcd < r ? xcd * (q + 1) : r * (q + 1) + (xcd - r) * q) + off; }
        const int per_e = nMe * nN; const int e = wgid / per_e, w = wgid % per_e;
        u.e = e; u.pm = w % nMe; u.pn = w / nMe;
        u.A = A + ((size_t)e * EPAD + (size_t)u.pm * BM) * K * 2; u.B = Bt + (size_t)e * bstride + (size_t)u.pn * BM * K * 2; return true;
    }
};
}

struct Args { const float* in[N_IN]; float* out; unsigned char* ws; };

struct Frame {
    const float* const* in; GAS float* out; GAS unsigned char* ws; LAS unsigned char* lds;
    int tid, lane, wave, G, bid, gw, NGW;
};

#define HROW(F, l, r) ((l) == 0 ? ((r) < LATR ? GIN(I_X) + (size_t)(r) * 1024 : GIN(I_CTX) + (size_t)((r) - LATR) * 1024) : (const float*)((F).ws + WS_H) + (size_t)(r) * 1024)

DEV Frame refresh(const Frame& F0) {
    Frame F = F0; int w = F0.wave; LAUNDER_S(w); int ln = lane_id(); LAUNDER(ln);
    F.wave = w; F.lane = ln; F.tid = w * 64 + ln; F.gw = F.bid * NWAVES + w;
    GAS unsigned char* ws = F0.ws; LAUNDER_S(ws); F.ws = ws;
    return F;
}

#define GIN(k) ((const float*)(GAS const float*)F.in[k])

#define ROW_LOOP(r, NROWS) for (int r = F.gw; r < (NROWS); r += F.NGW)

DEV int tok_row(int b, int d, int sp) {
    if (sp < CTX) return LATR + b * CTX + (d ? (CTX - 1 - sp) : sp);
    const int j = sp - CTX; return b * SEQ + (d ? (SEQ - 1 - j) : j);
}
DEV void row_bs(int r, int& b, int& s) { if (r < LATR) { b = r / SEQ; s = CTX + r % SEQ; } else { const int q = r - LATR; b = q / CTX; s = q % CTX; } }

DEV void tr_item(const float* W, int ldw, int col0, int k0, bf16_t* WT, int K, int row0, LAS float* scr, int lane) {
#pragma unroll 8
    for (int i = 0; i < 32; ++i) { const int kk = 2 * i + (lane >> 5); scr[kk * 33 + (lane & 31)] = W[(size_t)(k0 + kk) * ldw + col0 + (lane & 31)]; }
    WAVE_LDS_SYNC();
    const int c = lane & 7;
#pragma unroll
    for (int j = 0; j < 4; ++j) { const int n = (lane >> 3) + 8 * j; const LAS float* s = scr + (8 * c) * 33 + n;
        u32x4 o; o.x = pk2(s[0 * 33], s[1 * 33]); o.y = pk2(s[2 * 33], s[3 * 33]); o.z = pk2(s[4 * 33], s[5 * 33]); o.w = pk2(s[6 * 33], s[7 * 33]);
        *(u32x4*)(WT + (size_t)(row0 + n) * K + k0 + 8 * c) = o; }
    WAVE_LDS_SYNC();
}

DEV void phase_prologue_a(const Frame& F0) {
    const Frame F = refresh(F0);
    LAS float* scr = (LAS float*)(F.lds + F.wave * 16384);
    for (int l = 0; l < DEPTH; ++l) {
        const int odd = l & 1, li = l >> 1;
        const float* win = odd ? GIN(I_ODWIN) + (size_t)li * 1024 * 2576 : GIN(I_EVWIN) + (size_t)li * 1024 * 4112;
        const int ldw = odd ? 2576 : 4112, nin = odd ? NIN_O : NIN_E;
        bf16_t* wint = (bf16_t*)(F.ws + WS_WIN) + (size_t)l * NINMAX * 1024;
        for (int it = F.gw; it < 16 * (nin / 32); it += F.NGW) { const int kb = it / (nin / 32), nb = it % (nin / 32); const int d0 = 32 * nb;
            tr_item(win, ldw, d0 < 2048 ? d0 : d0 + 16, 64 * kb, wint, 1024, d0, scr, F.lane); }
        const float* wout = odd ? GIN(I_ODWOUT) + (size_t)li * 1024 * 1024 : GIN(I_EVWOUT) + (size_t)li * 1024 * 1024;
        bf16_t* woutt = (bf16_t*)(F.ws + WS_WOUT) + (size_t)l * 1024 * 1024;
        for (int it = F.gw; it < 16 * 32; it += F.NGW) { const int kb = it / 32, nb = it % 32; tr_item(wout, 1024, 32 * nb, 64 * kb, woutt, 1024, 32 * nb, scr, F.lane); }
        if (odd) {
            const float* wglu = GIN(I_ODWGLU) + (size_t)li * 512 * 512; bf16_t* wglut = (bf16_t*)(F.ws + WS_WGLU) + (size_t)li * 512 * 512;
            for (int it = F.gw; it < 8 * 16; it += F.NGW) { const int kb = it / 16, nb = it % 16; tr_item(wglu, 512, 32 * nb, 64 * kb, wglut, 512, 32 * nb, scr, F.lane); }
        }
        constexpr int GU_NB = 2 * FF / 32, GU_ITEMS = 16 * GU_NB;
        for (int it = F.gw; it < NE * GU_ITEMS; it += F.NGW) { const int e = it / GU_ITEMS, r = it % GU_ITEMS, kb = r / GU_NB, nb = r % GU_NB; const int d0 = 32 * nb, j = d0 >> 8, w = d0 & 255;
            const float* src = (w < 128 ? GIN(I_WGATE) : GIN(I_WUP)) + ((size_t)l * NE + e) * 1024 * FF;
            tr_item(src, FF, 128 * j + (w & 127), 64 * kb, (bf16_t*)(F.ws + WS_WGU) + ((size_t)l * NE + e) * 2 * FF * 1024, 1024, d0, scr, F.lane); }
        constexpr int D_ITEMS = (FF / 64) * 32;
        for (int it = F.gw; it < NE * D_ITEMS; it += F.NGW) { const int e = it / D_ITEMS, r = it % D_ITEMS, kb = r / 32, nb = r % 32;
            tr_item(GIN(I_WDOWN) + ((size_t)l * NE + e) * FF * 1024, 1024, 32 * nb, 64 * kb, (bf16_t*)(F.ws + WS_WD) + ((size_t)l * NE + e) * 1024 * FF, FF, 32 * nb, scr, F.lane); }
    }
    const int gt = F.bid * NTHREADS + F.tid, NGT = F.G * NTHREADS;
    for (int i = gt; i < DEPTH * 16 * 1024; i += NGT) { const int l = i / 16384, g = (i >> 10) & 15, k = i & 1023; const int odd = l & 1, li = l >> 1;
        ((float*)(F.ws + WS_WG))[i] = odd ? GIN(I_ODWIN)[((size_t)li * 1024 + k) * 2576 + 2048 + g] : GIN(I_EVWIN)[((size_t)li * 1024 + k) * 4112 + 2048 + g]; }
    for (int i = gt; i < DEPTH * NE * 1024; i += NGT) { const int k = i & 1023, e = (i >> 10) % NE, l = i / (NE * 1024); ((float*)(F.ws + WS_WR))[i] = GIN(I_WROUTER)[((size_t)l * 1024 + k) * NE + e]; }
    for (int i = gt; i < N_ODD * 2 * 32 * 64; i += NGT) { const int p = i & 63, g = (i >> 6) & 31, d = (i >> 11) & 1, o = i >> 12;
        const int idx = ((o * 2 + d) * 32 + g) * 64 + p;
        const float lr = fminf(GIN(I_ODLRE)[idx], -1e-4f), li_ = GIN(I_ODLIM)[idx], dt = expf(GIN(I_ODLDT)[(o * 2 + d) * 32 + g]);
        const float mag = expf(lr * dt); float sn, cs; sincosf(li_ * dt, &sn, &cs); const float are = mag * cs, aim = mag * sn;
        float* A = (float*)(F.ws + WS_S5A) + (size_t)((o * 2 + d) * 32 + g) * 128; A[p] = are; A[64 + p] = aim;
        const float xr = are - 1.0f, xi = aim, den = lr * lr + li_ * li_; const float fre = (xr * lr + xi * li_) / den, fim = (xi * lr - xr * li_) / den;
        bf16_t* Bb = (bf16_t*)(F.ws + WS_S5B) + (size_t)((o * 2 + d) * 32 + g) * 128 * 16;
        for (int h = 0; h < 16; ++h) { const float br = GIN(I_ODBRE)[((size_t)(o * 32 + g) * 64 + p) * 16 + h], bi = GIN(I_ODBIM)[((size_t)(o * 32 + g) * 64 + p) * 16 + h];
            Bb[p * 16 + h] = (bf16_t)f2bf(fre * br - fim * bi); Bb[(64 + p) * 16 + h] = (bf16_t)f2bf(fre * bi + fim * br); } }
    for (int i = gt; i < N_ODD * 32 * 16 * 64; i += NGT) { const int p = i & 63, c = (i >> 6) & 15, g = (i >> 10) & 31, o = i >> 15;
        bf16_t* Cm = (bf16_t*)(F.ws + WS_S5C) + (size_t)((o * 32 + g) * 16 + c) * 128;
        Cm[2 * p] = (bf16_t)f2bf(GIN(I_ODCRE)[i]); Cm[2 * p + 1] = (bf16_t)f2bf(-GIN(I_ODCIM)[i]); }
    ROW_LOOP(r, MPAD) {
        f32x4* dst = (f32x4*)((float*)(F.ws + WS_H) + (size_t)r * 1024) + F.lane;
        if (r < MROWS) { }
        else {
#pragma unroll
            for (int j = 0; j < 4; ++j) dst[64 * j] = (f32x4){0.f, 0.f, 0.f, 0.f};
            u32x4* xz = (u32x4*)((bf16_t*)(F.ws + WS_XIN) + (size_t)r * 1024) + F.lane; xz[0] = (u32x4){0u, 0u, 0u, 0u}; xz[64] = (u32x4){0u, 0u, 0u, 0u};
            u32x4* mz = (u32x4*)((bf16_t*)(F.ws + WS_MERGED) + (size_t)r * 1024) + F.lane; mz[0] = (u32x4){0u, 0u, 0u, 0u}; mz[64] = (u32x4){0u, 0u, 0u, 0u};
            u32x4* yz = (u32x4*)((bf16_t*)(F.ws + WS_YS) + (size_t)r * 512) + F.lane; yz[0] = (u32x4){0u, 0u, 0u, 0u};
        }
    }
    __syncthreads();
    LAS float* sv = (LAS float*)F.lds;
    LAS float* part = (LAS float*)(F.lds + 32768);
    for (int i = F.tid; i < NR * 1024; i += NTHREADS) { const int r = i >> 10, k = i & 1023; const float c = r < B_ ? GIN(I_C)[r * 1024 + k] : GIN(I_CCTX)[k]; sv[i] = silu_f(c); }
    __syncthreads();
    for (int it = F.bid; it < DEPTH * 96; it += F.G) {
        const int l = it / 96, j = (it % 96) * 64 + F.lane;
        const float* w = GIN(I_WMOD) + (size_t)l * 1024 * 6144 + j;
        float acc[NR];
#pragma unroll
        for (int r = 0; r < NR; ++r) acc[r] = 0.f;
        const int k0 = F.wave * 128;
#pragma unroll 8
        for (int k = 0; k < 128; ++k) { const float wv = w[(size_t)(k0 + k) * 6144];
#pragma unroll
            for (int r = 0; r < NR; ++r) acc[r] += sv[r * 1024 + k0 + k] * wv; }
#pragma unroll
        for (int r = 0; r < NR; ++r) part[(F.wave * NR + r) * 64 + F.lane] = acc[r];
        __syncthreads();
        for (int i = F.tid; i < NR * 64; i += NTHREADS) { const int r = i >> 6, jj = i & 63; float s = 0.f;
#pragma unroll
            for (int w8 = 0; w8 < 8; ++w8) s += part[(w8 * NR + r) * 64 + jj];
            const int col = (it % 96) * 64 + jj;
            ((float*)(F.ws + WS_MOD))[((size_t)l * NR + r) * 6144 + col] = s + GIN(I_BMOD)[l * 6144 + col]; }
        __syncthreads();
    }
}

static_assert(TOK % 4 == 0 && CTX % 4 == 0 && MROWS % 4 == 0, "row groups");
#define ROW_GROUPS(nrows, CALL4, CALL2) do { const int _r4 = ((nrows) / (4 * F.NGW)) * (4 * F.NGW); \
    for (int r = 4 * F.gw; r < _r4; r += 4 * F.NGW) { CALL4; } for (int r = _r4 + 2 * F.gw; r < (nrows); r += 2 * F.NGW) { CALL2; } } while (0)
template <int RG> DEV void xg_rows(const Frame& F, int l, int row0, f32x4 (&v)[RG][4]) {
    int b, s; row_bs(row0, b, s); const int mr = s < CTX ? B_ : b;
    const float* mod = (const float*)(F.ws + WS_MOD) + ((size_t)l * NR + mr) * 6144;
#pragma unroll
    for (int j = 0; j < 4; ++j) { const f32x4 sh = *((const f32x4*)mod + F.lane + 64 * j), sc = *((const f32x4*)(mod + 1024) + F.lane + 64 * j);
#pragma unroll
        for (int q = 0; q < RG; ++q) v[q][j] = v[q][j] * (1.0f + sc) + sh; }
#pragma unroll
    for (int q = 0; q < RG; ++q) { u32x2* xo = (u32x2*)((bf16_t*)(F.ws + WS_XIN) + (size_t)(row0 + q) * 1024) + F.lane;
#pragma unroll
        for (int j = 0; j < 4; ++j) xo[64 * j] = (u32x2){pk2(v[q][j].x, v[q][j].y), pk2(v[q][j].z, v[q][j].w)}; }
    const float* wg = (const float*)(F.ws + WS_WG) + (size_t)l * 16 * 1024;
    float mine[RG]; const int gi = F.lane & 15;
#pragma unroll
    for (int q = 0; q < RG; ++q) mine[q] = 0.f;
    f32x4 wc[4];
#pragma unroll
    for (int j = 0; j < 4; ++j) wc[j] = *((const f32x4*)wg + F.lane + 64 * j);
#pragma unroll 1
    for (int g = 0; g < 16; ++g) { f32x4 wn[4]; const int gn = g + 1 < 16 ? g + 1 : g;
#pragma unroll
        for (int j = 0; j < 4; ++j) wn[j] = *((const f32x4*)(wg + gn * 1024) + F.lane + 64 * j);
#pragma unroll
        for (int q = 0; q < RG; ++q) { float p = 0.f;
#pragma unroll
            for (int j = 0; j < 4; ++j) p += v[q][j].x * wc[j].x + v[q][j].y * wc[j].y + v[q][j].z * wc[j].z + v[q][j].w * wc[j].w;
            const float t = wave_sum(p); mine[q] = (gi == g) ? t : mine[q]; }
#pragma unroll
        for (int j = 0; j < 4; ++j) wc[j] = wn[j]; }
    const int ty = gi >> 2, hh = gi & 3, li = l >> 1;
#pragma unroll
    for (int q = 0; q < RG; ++q) { float o;
        if (!(l & 1)) {
            if (ty < 2) o = -expf(GIN(I_EVALOG)[(li * 2 + ty) * 4 + hh]) * softplus_f(mine[q] + GIN(I_EVDTB)[(li * 2 + ty) * 4 + hh]);
            else o = sigmoid_f(mine[q]);
        } else {
            const int d = ty & 1, k = ty >> 1; const float gb = GIN(I_ODGB)[((li * 2 + d) * 2 + k) * 4 + hh];
            o = k ? -softplus_f(-(mine[q] + gb)) : mine[q] + gb;
        }
        if (F.lane < 16) ((float*)(F.ws + WS_GATES))[(size_t)(row0 + q) * 16 + gi] = o; }
}

template <int RG> DEV void xg0_group(const Frame& F, int r) {
        f32x4 v[RG][4];
#pragma unroll
        for (int q = 0; q < RG; ++q) { const f32x4* hr = (const f32x4*)HROW(F, 0, r + q) + F.lane;
#pragma unroll
            for (int j = 0; j < 4; ++j) v[q][j] = hr[64 * j]; }
        xg_rows<RG>(F, 0, r, v);
    }
DEV void phase_xg0(const Frame& F0) {
    const Frame F = refresh(F0);
    ROW_GROUPS(MROWS, xg0_group<4>(F, r), xg0_group<2>(F, r));
}

template <int RG> DEV void prep_group(const Frame& F, int l, int r) {

    const int odd = l & 1, li = l >> 1; const int nin = odd ? NIN_O : NIN_E, nseg = odd ? 2 : 3, qld = odd ? 1024 : 1536;
    const bf16_t* P = (const bf16_t*)(F.ws + WS_P); bf16_t* Q = (bf16_t*)(F.ws + WS_QKV);
    const float* cw = odd ? GIN(I_ODCONV) + (size_t)li * 9 * 1024 : GIN(I_EVCONV) + (size_t)li * 9 * 1536; const int cch = odd ? 1024 : 1536;
    {
        int b, s; row_bs(r, b, s); const bool lat = s >= CTX; const int rr = lat ? (s - CTX) >> 6 : 0, cc = lat ? (s - CTX) & 63 : s;
        const int ncol = lat ? 64 : CTX;
        for (int seg = 0; seg < nseg; ++seg) {
            const int ch0 = seg * 512 + F.lane * 8; float a[RG][8];
#pragma unroll
            for (int q = 0; q < RG; ++q)
#pragma unroll
                for (int i = 0; i < 8; ++i) a[q][i] = 0.f;
#pragma unroll
            for (int kh = 0; kh < 3; ++kh) {
                const int r2 = rr + kh - 1; const bool rok = lat ? (r2 >= 0 && r2 < SEQ / 64) : (kh == 1); const int r2c = rok ? r2 : rr;
                f32x4 w0[3], w1[3];
#pragma unroll
                for (int kw = 0; kw < 3; ++kw) { w0[kw] = *(const f32x4*)(cw + (kh * 3 + kw) * cch + ch0); w1[kw] = *(const f32x4*)(cw + (kh * 3 + kw) * cch + ch0 + 4); }
                const int rowbase = lat ? b * SEQ + r2c * 64 : LATR + b * CTX;
                u32x4 pv[RG + 2];
#pragma unroll
                for (int dc = 0; dc < RG + 2; ++dc) { const int c2 = cc - 1 + dc; const bool ok = rok && c2 >= 0 && c2 < ncol; const int c2c = ok ? c2 : cc;
                    const u32x4 t4 = *(const u32x4*)(P + (size_t)(rowbase + c2c) * nin + ch0); pv[dc] = ok ? t4 : (u32x4){0u, 0u, 0u, 0u}; }
#pragma unroll
                for (int dc = 0; dc < RG + 2; ++dc) {
                    const float x0 = bflo(pv[dc].x), x1 = bfhi(pv[dc].x), x2 = bflo(pv[dc].y), x3 = bfhi(pv[dc].y), x4 = bflo(pv[dc].z), x5 = bfhi(pv[dc].z), x6 = bflo(pv[dc].w), x7 = bfhi(pv[dc].w);
#pragma unroll
                    for (int q = 0; q < RG; ++q) { const int kw = dc - q;
                        if (kw >= 0 && kw <= 2) { a[q][0] += x0 * w0[kw].x; a[q][1] += x1 * w0[kw].y; a[q][2] += x2 * w0[kw].z; a[q][3] += x3 * w0[kw].w;
                            a[q][4] += x4 * w1[kw].x; a[q][5] += x5 * w1[kw].y; a[q][6] += x6 * w1[kw].z; a[q][7] += x7 * w1[kw].w; } } }
            }
#pragma unroll
            for (int q = 0; q < RG; ++q) {
                float ss = 0.f;
#pragma unroll
                for (int i = 0; i < 8; ++i) { a[q][i] = fast_silu(a[q][i]); ss += a[q][i] * a[q][i]; }
                float sc = 1.0f;
                if (!odd) { if (seg < 2) { ss = group_sum<16>(ss); sc = 1.0f / sqrtf(ss + 1e-6f); if (seg == 0) sc *= HD_SCALE; } }
                else if (seg == 1) sc = HD_SCALE;
                u32x4 o; o.x = pk2(a[q][0] * sc, a[q][1] * sc); o.y = pk2(a[q][2] * sc, a[q][3] * sc); o.z = pk2(a[q][4] * sc, a[q][5] * sc); o.w = pk2(a[q][6] * sc, a[q][7] * sc);
                *(u32x4*)(Q + (size_t)(r + q) * qld + ch0) = o;
            }
        }
    }
}
DEV void phase_prep(const Frame& F0, int l) {
    const Frame F = refresh(F0);
    const int odd = l & 1;
    ROW_GROUPS(MROWS, prep_group<4>(F, l, r), prep_group<2>(F, l, r));

    if (odd) {
        const float* GT = (const float*)(F.ws + WS_GATES); float* MC = (float*)(F.ws + WS_MCH);
        for (int c = F.gw; c < B_ * 4 * 2; c += F.NGW) { const int d = c & 1, hh = (c >> 1) & 3, b = c >> 3; float m = 0.f;
            for (int n = 0; n < NCH; ++n) { const int row = tok_row(b, d, n * 64 + F.lane);
                const float lin = GT[(size_t)row * 16 + d * 4 + hh], lf = GT[(size_t)row * 16 + 8 + d * 4 + hh];
                const float bc = wave_scan_add(lf);
                const float bend = bcast_lane_f(bc, 63); const float amax = wave_max(bend - bc + lin);
                if (F.lane == 0) MC[(size_t)c * NCH + n] = m;
                m = fmaxf(bend + m, amax); }
        }
    }
}

DEV int swz256(int r, int k) { return r * 256 + 16 * (k ^ (r & 15)); }
DEV int swz128(int r, int k) { return r * 128 + 16 * (k ^ ((r >> 1) & 7)); }
constexpr int CL_IMG = 90112;
struct ClProb { int n, d, hh, b, kind, qld, vld; const bf16_t *qsrc, *ksrc, *vsrc; float kscale; };
DEV ClProb cl_decode(const Frame& F, int p, int odd, int nhh) {
    ClProb c; c.n = p % NCH; c.d = (p / NCH) & 1; c.hh = (p / (2 * NCH)) % nhh; c.b = p / (2 * NCH * nhh); c.kind = odd ? 2 : (c.hh < 4 ? 0 : 1); c.kscale = 1.0f;
    const bf16_t* P = (const bf16_t*)(F.ws + WS_P); const bf16_t* Q = (const bf16_t*)(F.ws + WS_QKV);
    if (c.kind == 0) { c.qsrc = Q + c.hh * 128; c.ksrc = Q + 512 + c.hh * 128; c.vsrc = Q + 1024 + c.hh * 128; c.qld = 1536; c.vld = 1536; }
    else if (c.kind == 1) { c.qsrc = P + 2048 + (c.hh - 4) * 128; c.ksrc = P + 2560 + (c.hh - 4) * 128; c.vsrc = P + 3072 + (c.hh - 4) * 128; c.qld = NIN_E; c.vld = NIN_E; c.kscale = HD_SCALE; }
    else { c.qsrc = Q + c.hh * 128; c.ksrc = Q + 512 + c.hh * 128; c.vsrc = P + 1024 + c.hh * 128; c.qld = 1024; c.vld = NIN_O; }
    return c;
}
DEV void cl_dma(const Frame& F, const ClProb c) {
    int ln = F.lane; LAUNDER(ln);
    const int r0 = tok_row(c.b, c.d, c.n * 64), sg = c.d ? -1 : 1; const int per = c.kind == 0 ? 6 : 4;
#pragma unroll
    for (int i = 0; i < 6; ++i) if (i < per) { const int ch = F.wave * per + i, reg = ch >> 4, cc = ch & 15, r = 4 * cc + (ln >> 4), kk = (ln & 15) ^ (r & 15);
        const bf16_t* src = reg == 0 ? c.qsrc : (reg == 1 ? c.ksrc : c.vsrc); const int ld = reg == 2 ? c.vld : c.qld;
        glds16((const GAS char*)(src + (size_t)(r0 + sg * r) * ld + 8 * kk), F.lds + CL_IMG + reg * 16384 + 1024 * cc); }
}
DEV void seq_s5_item(const Frame& F, int l, int item, int which);
DEV void phase_cl(const Frame& F0, int l) {
    const Frame F = refresh(F0);
    const int odd = l & 1; const int nhh = odd ? 4 : 8; const int nprob = B_ * nhh * 2 * NCH;
    if (odd) {
        for (int it = F.bid; it < B_ * 2 * 32; it += F.G) { seq_s5_item(F, l, it, 0); __syncthreads(); }
    }
    LAS float* gc = (LAS float*)(F.lds);
    LAS float* bt = (LAS float*)(F.lds + 256);
    LAS float* qs = (LAS float*)(F.lds + 768);
    LAS float* ks = (LAS float*)(F.lds + 1024);
    LAS float* mt = (LAS float*)(F.lds + 1280);
    LAS float* rsp = (LAS float*)(F.lds + 2048);
    LAS float* Am = (LAS float*)(F.lds + 4096);
    LAS bf16_t* An = (LAS bf16_t*)(F.lds + 20480);
    LAS bf16_t* XT = (LAS bf16_t*)(F.lds + 30720);
    LAS float* Rb = (LAS float*)(F.lds + 69632 + F.wave * 2048);
    LAS float* ksp = (LAS float*)(F.lds + 86016);
    LAS unsigned char* IQ = F.lds + CL_IMG; LAS unsigned char* IK = IQ + 16384; LAS unsigned char* IV = IQ + 32768;
    const float* GT = (const float*)(F.ws + WS_GATES);
    float gq = 0.f, bq = 0.f, mq = 0.f;
#define CL_GATES(pp) do { const ClProb cn = cl_decode(F, (pp), odd, nhh); const int rown = tok_row(cn.b, cn.d, cn.n * 64 + F.lane); \
        if (cn.kind == 0) { gq = GT[(size_t)rown * 16 + cn.d * 4 + cn.hh]; bq = GT[(size_t)rown * 16 + 8 + cn.d * 4 + cn.hh]; } \
        else if (cn.kind == 2) { bq = GT[(size_t)rown * 16 + cn.d * 4 + cn.hh]; gq = GT[(size_t)rown * 16 + 8 + cn.d * 4 + cn.hh]; \
            mq = ((const float*)(F.ws + WS_MCH))[(size_t)((cn.b * 4 + cn.hh) * 2 + cn.d) * NCH + cn.n]; } } while (0)
    if (F.bid < nprob) { cl_dma(F, cl_decode(F, F.bid, odd, nhh)); if (F.wave == 0) CL_GATES(F.bid); }
    for (int p = F.bid; p < nprob; p += F.G) {
        int lz = F.lane; LAUNDER(lz); const int h = lz >> 5, l31 = lz & 31;
        const ClProb c = cl_decode(F, p, odd, nhh); const int n = c.n, d = c.d, hh = c.hh, b = c.b, kind = c.kind; const float kscale = c.kscale;
        float* CS = (float*)(F.ws + WS_CLS) + (size_t)p * 512;
        if (F.wave == 0) {
            const int i = F.lane;
            float g = gq, be = bq;
            if (kind == 1) { g = log1pf(-exp2f(-(5.0f + 2.0f * (float)(hh - 4) + (float)d))); be = 0.f; }
            const float cum = wave_scan_add(g);
            const float gend = bcast_lane_f(cum, 63);
            gc[i] = cum; bt[i] = be;
            if (kind < 2) { qs[i] = expf(cum); ks[i] = expf(gend - cum) * kscale; if (i == 0) CS[0] = expf(gend); }
            else {
                const float mprev = mq;
                const float a = gend - cum + be; const float amax = wave_max(a); const float mnew = fmaxf(gend + mprev, amax);
                ks[i] = expf(a - mnew);
                const float pm = wave_scan_max(be - cum);
                const float mti = cum + fmaxf(mprev, pm); mt[i] = mti; qs[i] = expf(cum + mprev - mti);
                CS[128 + i] = expf(-mti);
                if (i == 0) CS[0] = expf(gend + mprev - mnew);
            }
        }
        WAIT_VM(0);
        __syncthreads();
        {
            const int w4 = F.wave & 3, mt_ = w4 >> 1, nt_ = w4 & 1; const bool doY = F.wave >= 4;
            if (!doY || kind == 0) {
                const int rj = 32 * mt_ + l31, ri = 32 * nt_ + l31; LAS unsigned char* IB = doY ? IK : IQ;
                f32x16 acc;
#pragma unroll
                for (int r = 0; r < 16; ++r) acc[r] = 0.f;
                bf16x8 af[8], bfr[8];
#pragma unroll
                for (int s = 0; s < 8; ++s) { af[s] = *(const LAS bf16x8*)(IK + swz256(rj, 2 * s + h)); bfr[s] = *(const LAS bf16x8*)(IB + swz256(ri, 2 * s + h)); }
#pragma unroll
                for (int s = 0; s < 8; ++s) acc = mfma32(af[s], bfr[s], acc);
                const int i = ri; const float gi = gc[i];
                if (!doY) {
                    bf16_t* AQ = (bf16_t*)(F.ws + WS_CLA) + (size_t)p * 4096 + (size_t)i * 64; float rsum = 0.f; const float mti = kind == 2 ? mt[i] : 0.f;
#pragma unroll
                    for (int g4 = 0; g4 < 4; ++g4) { float v[4];
#pragma unroll
                        for (int r = 0; r < 4; ++r) { const int j = 32 * mt_ + 8 * g4 + 4 * h + r; float e;
                            if (kind < 2) e = fast_exp(fminf(gi - gc[j], 0.f)); else e = fast_exp(gi - gc[j] + bt[j] - mti);
                            v[r] = (i >= j) ? acc[4 * g4 + r] * kscale * e : 0.f; rsum += v[r]; }
                        *(u32x2*)(AQ + 32 * mt_ + 8 * g4 + 4 * h) = (u32x2){pk2_sw(v[0], v[1]), pk2_sw(v[2], v[3])}; }
                    if (kind == 2) rsp[i * 4 + mt_ * 2 + h] = rsum;
                } else {
                    const float bi = bt[i];
#pragma unroll
                    for (int r = 0; r < 16; ++r) { const int j = 32 * mt_ + 8 * (r >> 2) + 4 * h + (r & 3);
                        const float av = (i > j) ? bi * acc[r] * fast_exp(fminf(gi - gc[j], 0.f)) : 0.f;
                        Am[i * 64 + j] = av; An[i * 72 + j] = (bf16_t)f2bf_sw(-av); }
                }
            }
        }
        __syncthreads();
        int lz2 = F.lane; LAUNDER(lz2); const int l15 = lz2 & 15, kg = lz2 >> 4; const bool isw = F.wave >= 4;
        float rhsv[4][2][4];
        {
            const int tz = F.wave * 64 + lz2; const int cq = tz & 127, q4 = tz >> 7; bf16_t* QD = (bf16_t*)(F.ws + WS_CLQ) + (size_t)p * 8192 + cq;
            for (int i = 16 * q4; i < 16 * q4 + 16; ++i) QD[i * 128] = (bf16_t)f2bf_sw(bf2f(*(const LAS bf16_t*)(IQ + swz256(i, cq >> 3) + 2 * (cq & 7))) * qs[i]);
            bf16_t* KT = (bf16_t*)(F.ws + WS_CLK) + (size_t)p * 8192 + (size_t)cq * 64;
            float ksum = 0.f;
            for (int j8 = 2 * q4; j8 < 2 * q4 + 2; ++j8) { float v[8];
#pragma unroll
                for (int r = 0; r < 8; ++r) { const int j = 8 * j8 + r; v[r] = bf2f(*(const LAS bf16_t*)(IK + swz256(j, cq >> 3) + 2 * (cq & 7))) * ks[j]; ksum += v[r]; }
                *(u32x4*)(KT + 8 * j8) = (u32x4){pk2_sw(v[0], v[1]), pk2_sw(v[2], v[3]), pk2_sw(v[4], v[5]), pk2_sw(v[6], v[7])}; }
            ksp[cq * 4 + q4] = ksum;
            if (kind == 2 && tz < 64) CS[64 + tz] = (rsp[tz * 4] + rsp[tz * 4 + 1]) + (rsp[tz * 4 + 2] + rsp[tz * 4 + 3]);
            if (kind == 0) { LAS unsigned char* IS = isw ? IK : IV;
#pragma unroll
                for (int bb = 0; bb < 4; ++bb)
#pragma unroll
                    for (int nt2 = 0; nt2 < 2; ++nt2)
#pragma unroll
                        for (int r = 0; r < 4; ++r) { const int i = 16 * bb + 4 * kg + r, cc = (32 * F.wave + 16 * nt2 + l15) & 127;
                            rhsv[bb][nt2][r] = bt[i] * bf2f(*(const LAS bf16_t*)(IS + swz256(i, cc >> 3) + 2 * (cc & 7))) * (isw ? qs[i] : 1.0f); } }
        }
        __syncthreads();
        if (p + F.G < nprob) { cl_dma(F, cl_decode(F, p + F.G, odd, nhh)); if (F.wave == 0) CL_GATES(p + F.G); }
        if (kind == 2 && F.tid < 128) CS[256 + F.tid] = (ksp[F.tid * 4] + ksp[F.tid * 4 + 1]) + (ksp[F.tid * 4 + 2] + ksp[F.tid * 4 + 3]);
        if (kind == 0) {
            const int pg = ((b * 4 + hh) * 2 + d) * NCH + n;
            float* U = (float*)(F.ws + WS_CLU) + (size_t)pg * 8192; bf16_t* W = (bf16_t*)(F.ws + WS_CLW) + (size_t)p * 8192;
#pragma unroll
            for (int bb = 0; bb < 4; ++bb) {
#pragma unroll
                for (int nt2 = 0; nt2 < 2; ++nt2) {
                    const int cidx = 32 * F.wave + 16 * nt2 + l15; f32x4 acc;
#pragma unroll
                    for (int r = 0; r < 4; ++r) acc[r] = rhsv[bb][nt2][r];
                    for (int k2 = 0; k2 < 2; ++k2) if (32 * k2 < 16 * bb) {
                        const bool in = 32 * k2 + 8 * kg + 8 <= 16 * bb;
                        bf16x8 a = *(const LAS bf16x8*)(An + (16 * bb + l15) * 72 + 32 * k2 + 8 * kg); if (!in) a = (bf16x8){0, 0, 0, 0, 0, 0, 0, 0};
                        const bf16x8 xb = *(const LAS bf16x8*)(XT + cidx * 72 + 32 * k2 + 8 * kg);
                        acc = mfma16(a, in ? xb : (bf16x8){0, 0, 0, 0, 0, 0, 0, 0}, acc); }
#pragma unroll
                    for (int r = 0; r < 4; ++r) Rb[(4 * kg + r) * 32 + 16 * nt2 + l15] = acc[r];
                }
                WAVE_LDS_SYNC();
                if (F.lane < 32) {
                    const int cidx = 32 * F.wave + F.lane; float x[16];
#pragma unroll
                    for (int i = 0; i < 16; ++i) { float r = Rb[i * 32 + F.lane];
#pragma unroll
                        for (int j = 0; j < i; ++j) r -= Am[(16 * bb + i) * 64 + 16 * bb + j] * x[j];
                        x[i] = r; }
                    if (!isw) {
#pragma unroll
                        for (int i = 0; i < 16; ++i) U[(16 * bb + i) * 128 + cidx] = x[i]; }
                    else {
#pragma unroll
                        for (int i = 0; i < 16; ++i) W[(16 * bb + i) * 128 + (cidx - 128)] = (bf16_t)f2bf_sw(-x[i]); }
                    *(LAS u32x4*)(XT + cidx * 72 + 16 * bb) = (u32x4){pk2_sw(x[0], x[1]), pk2_sw(x[2], x[3]), pk2_sw(x[4], x[5]), pk2_sw(x[6], x[7])};
                    *(LAS u32x4*)(XT + cidx * 72 + 16 * bb + 8) = (u32x4){pk2_sw(x[8], x[9]), pk2_sw(x[10], x[11]), pk2_sw(x[12], x[13]), pk2_sw(x[14], x[15])};
                }
                WAVE_LDS_SYNC();
            }
        }
    }
    WAIT_VM(0);
    __syncthreads();
}

#define LDS_BARRIER() do { WAIT_LGKM(0); S_BARRIER(); COMPILER_FENCE(); } while (0)
constexpr int SQ_W = 0, SQ_Q = 16384, SQ_K = 32768, SQ_A = 49152, SQ_U = 57344, SQ_C = 65536, SQ_STAGE = 67584;
constexpr int SQ_SB = 2 * SQ_STAGE, SQ_VN = SQ_SB + 8704, SQ_NV = SQ_VN + 4608, SQ_DEN = SQ_NV + 512;
static_assert(SQ_DEN + 256 <= LDS_MISC, "SEQ LDS map");
struct SeqCtx { int kind, b, hh, d, sl, chain, vld; const GAS bf16_t* vsrc; int probe; };
template <int KIND>
DEV void seq_dma(const Frame& F, const SeqCtx& C, int n, LAS unsigned char* img) {
    const int p = C.chain * NCH + n, w = F.wave; int ln = F.lane; LAUNDER(ln);
    if (w < 2) {
        if (KIND == 0) { const GAS char* g = (const GAS char*)(F.ws + WS_CLW) + (size_t)p * 16384; LAUNDER_S(g);
#pragma unroll
            for (int i = 0; i < 8; ++i) { const int r = 4 * (8 * w + i) + (ln >> 4), pp = ln & 15; glds16(g + r * 256 + 16 * (pp ^ (r & 15)), img + SQ_W + 1024 * (8 * w + i)); } }
    } else if (w < 4) {
        const GAS char* g = (const GAS char*)(F.ws + WS_CLQ) + (size_t)p * 16384; LAUNDER_S(g);
#pragma unroll
        for (int i = 0; i < 8; ++i) { const int c = 8 * (w - 2) + i, r = 4 * c + (ln >> 4), pp = ln & 15; glds16(g + r * 256 + 16 * (pp ^ (r & 15)), img + SQ_Q + 1024 * c); }
    } else if (w < 6) {
        const GAS char* g = (const GAS char*)(F.ws + WS_CLK) + (size_t)p * 16384; LAUNDER_S(g);
#pragma unroll
        for (int i = 0; i < 8; ++i) { const int c = 8 * (w - 4) + i, r = 8 * c + (ln >> 3), pp = ln & 7; glds16(g + r * 128 + 16 * (pp ^ ((r >> 1) & 7)), img + SQ_K + 1024 * c); }
    } else if (w == 6) {
        const GAS char* g = (const GAS char*)(F.ws + WS_CLA) + (size_t)p * 8192; LAUNDER_S(g);
#pragma unroll
        for (int i = 0; i < 8; ++i) { const int r = 8 * i + (ln >> 3), pp = ln & 7; glds16(g + r * 128 + 16 * (pp ^ ((r >> 1) & 7)), img + SQ_A + 1024 * i); }
    } else {
        if (KIND == 0) { const int pg = ((C.b * 4 + C.hh) * 2 + C.d) * NCH + n; const GAS char* g = (const GAS char*)(F.ws + WS_CLU) + (size_t)pg * 32768 + 128 * C.sl; LAUNDER_S(g);
#pragma unroll
            for (int i = 0; i < 8; ++i) { const int r = 8 * i + (ln >> 3); glds16(g + r * 512 + 16 * (ln & 7), img + SQ_U + 1024 * i); }
        } else { const int r0 = tok_row(C.b, C.d, n * 64); const long st = C.d ? -(long)C.vld * 2 : (long)C.vld * 2;
            const GAS char* g = (const GAS char*)C.vsrc + (long)r0 * C.vld * 2 + 64 * C.sl; LAUNDER_S(g);
#pragma unroll
            for (int i = 0; i < 4; ++i) { const int r = 16 * i + (ln >> 2); glds16(g + (long)r * st + 16 * (ln & 3), img + SQ_U + 1024 * i); }
        }
        const GAS char* cs = (const GAS char*)(F.ws + WS_CLS) + (size_t)p * 2048; LAUNDER_S(cs);
        glds16(cs + 16 * ln, img + SQ_C);
        if (KIND == 2) glds16(cs + 1024 + 16 * ln, img + SQ_C + 1024);
    }
}
#define SEQ_WAIT_DMA(younger) do { if ((younger) == 16) WAIT_VM(16); else WAIT_VM(0); } while (0)
template <int KIND>
DEV void seq_step(const Frame& F, const SeqCtx& C, int n, f32x16& acc, LAS unsigned char* lds) {
    int lz = F.lane; LAUNDER(lz); const int h = lz >> 5, l31 = lz & 31;
    LAS unsigned char* img = lds + (n & 1) * SQ_STAGE; LAS unsigned char* nimg = lds + ((n + 1) & 1) * SQ_STAGE;
    LAS bf16_t* Sb = (LAS bf16_t*)(lds + SQ_SB); LAS bf16_t* Vn = (LAS bf16_t*)(lds + SQ_VN); LAS float* nvec = (LAS float*)(lds + SQ_NV); LAS float* den = (LAS float*)(lds + SQ_DEN);
    const LAS float* CS = (const LAS float*)(img + SQ_C);
    if (C.probe != 3) seq_dma<KIND>(F, C, C.probe == 2 ? 0 : (n + 1 < NCH ? n + 1 : NCH - 1), nimg);
    if (F.wave < 2) {
        const int mt_ = F.wave;
        if (KIND == 0) {
#pragma unroll
            for (int r = 0; r < 16; ++r) acc[r] = *(const LAS float*)(img + SQ_U + (32 * mt_ + 8 * (r >> 2) + 4 * h + (r & 3)) * 128 + 4 * l31);
            bf16x8 sb[8], wf[8]; const int rr = 32 * mt_ + l31;
#pragma unroll
            for (int s = 0; s < 8; ++s) { sb[s] = *(const LAS bf16x8*)(Sb + l31 * 136 + 16 * s + 8 * h); wf[s] = *(const LAS bf16x8*)(img + SQ_W + swz256(rr, 2 * s + h)); }
#pragma unroll
            for (int s = 0; s < 8; ++s) acc = mfma32(wf[s], sb[s], acc);
        } else {
#pragma unroll
            for (int r = 0; r < 16; ++r) acc[r] = bf2f(*(const LAS bf16_t*)(img + SQ_U + (32 * mt_ + 8 * (r >> 2) + 4 * h + (r & 3)) * 64 + 2 * l31));
        }
#pragma unroll
        for (int g4 = 0; g4 < 4; ++g4) *(LAS u32x2*)(Vn + l31 * 72 + 32 * mt_ + 8 * g4 + 4 * h) = (u32x2){pk2(acc[4 * g4], acc[4 * g4 + 1]), pk2(acc[4 * g4 + 2], acc[4 * g4 + 3])};
    } else if (F.wave < 4) {
        const int rr = 32 * (F.wave - 2) + l31;
#pragma unroll
        for (int r = 0; r < 16; ++r) acc[r] = 0.f;
        bf16x8 sb[8], qf[8];
#pragma unroll
        for (int s = 0; s < 8; ++s) { sb[s] = *(const LAS bf16x8*)(Sb + l31 * 136 + 16 * s + 8 * h); qf[s] = *(const LAS bf16x8*)(img + SQ_Q + swz256(rr, 2 * s + h)); }
#pragma unroll
        for (int s = 0; s < 8; ++s) acc = mfma32(qf[s], sb[s], acc);
    } else if (KIND == 2) {
        const int t = F.tid - 256, i = t >> 2, q = t & 3; float s = 0.f;
#pragma unroll
        for (int c8 = 0; c8 < 4; ++c8) { const u32x4 w = *(const LAS u32x4*)(img + SQ_Q + swz256(i, 4 * q + c8)); const LAS float* nv = nvec + 32 * q + 8 * c8;
            s += bflo(w.x) * nv[0] + bfhi(w.x) * nv[1] + bflo(w.y) * nv[2] + bfhi(w.y) * nv[3] + bflo(w.z) * nv[4] + bfhi(w.z) * nv[5] + bflo(w.w) * nv[6] + bfhi(w.w) * nv[7]; }
        s = group_sum<4>(s);
        if (q == 0) den[i] = fmaxf(fabsf(CS[64 + i] + s), CS[128 + i]);
    }
    LDS_BARRIER();
    if (F.wave >= 2 && F.wave < 4) {
        const int mt_ = F.wave - 2, rr = 32 * mt_ + l31;
        bf16x8 vb[4], af[4];
#pragma unroll
        for (int s = 0; s < 4; ++s) { vb[s] = *(const LAS bf16x8*)(Vn + l31 * 72 + 16 * s + 8 * h); af[s] = *(const LAS bf16x8*)(img + SQ_A + swz128(rr, 2 * s + h)); }
#pragma unroll
        for (int s = 0; s < 4; ++s) acc = mfma32(af[s], vb[s], acc);
        const int r0 = tok_row(C.b, C.d, n * 64); const long st = C.d ? -2048l : 2048l;
        GAS char* Ob = (GAS char*)(F.ws + WS_O) + ((size_t)C.d * MROWS + r0) * 2048 + (long)(32 * mt_) * st; LAUNDER_S(Ob); const long lo = (long)(4 * h) * st + (long)((C.hh * 128 + 32 * C.sl + l31) * 2);
#pragma unroll
        for (int r = 0; r < 16; ++r) { const int i = 32 * mt_ + 8 * (r >> 2) + 4 * h + (r & 3); float v = acc[r];
            if (KIND == 2) v = v / den[i];
            if (!C.probe) *(GAS bf16_t*)(Ob + (long)(8 * (r >> 2) + (r & 3)) * st + lo) = (bf16_t)f2bf(v); }
        SEQ_WAIT_DMA(16);
    } else if (F.wave >= 4) {
        const int kb = F.wave - 4, rr = 32 * kb + l31; const float ge = CS[0];
        bf16x8 vb[4], kf[4];
#pragma unroll
        for (int s = 0; s < 4; ++s) { vb[s] = *(const LAS bf16x8*)(Vn + l31 * 72 + 16 * s + 8 * h); kf[s] = *(const LAS bf16x8*)(img + SQ_K + swz128(rr, 2 * s + h)); }
#pragma unroll
        for (int r = 0; r < 16; ++r) acc[r] *= ge;
#pragma unroll
        for (int s = 0; s < 4; ++s) acc = mfma32(kf[s], vb[s], acc);
#pragma unroll
        for (int g4 = 0; g4 < 4; ++g4) *(LAS u32x2*)(Sb + l31 * 136 + 32 * kb + 8 * g4 + 4 * h) = (u32x2){pk2(acc[4 * g4], acc[4 * g4 + 1]), pk2(acc[4 * g4 + 2], acc[4 * g4 + 3])};
        if (KIND == 2 && F.tid < 256 + 128) { const int dd = F.tid - 256; nvec[dd] = ge * nvec[dd] + CS[256 + dd]; }
        SEQ_WAIT_DMA(0);
    } else SEQ_WAIT_DMA(0);
    LDS_BARRIER();
}
template <int KIND>
DEV void seq_kind_loop(const Frame& F, const SeqCtx& C, LAS unsigned char* lds) {
    f32x16 acc;
#pragma unroll
    for (int r = 0; r < 16; ++r) acc[r] = 0.f;
    seq_dma<KIND>(F, C, 0, lds);
    WAIT_VM(0);
    LDS_BARRIER();
    for (int n = 0; n < NCH; ++n) seq_step<KIND>(F, C, n, acc, lds);
}
DEV void seq_linear_item(const Frame& F, int l, int item, int probe = 0) {
    const int odd = l & 1, nhh = odd ? 4 : 8;
    SeqCtx C; C.probe = probe; C.sl = item & 3; C.chain = item >> 2; C.d = C.chain & 1; C.hh = (C.chain >> 1) % nhh; C.b = C.chain / (2 * nhh);
    C.kind = odd ? 2 : (C.hh < 4 ? 0 : 1);
    const GAS bf16_t* P = (const GAS bf16_t*)(F.ws + WS_P); const GAS bf16_t* Q = (const GAS bf16_t*)(F.ws + WS_QKV);
    if (C.kind == 0) { C.vsrc = Q + 1024 + C.hh * 128; C.vld = 1536; } else if (C.kind == 1) { C.vsrc = P + 3072 + (C.hh - 4) * 128; C.vld = NIN_E; } else { C.vsrc = P + 1024 + C.hh * 128; C.vld = NIN_O; }
    for (int i = F.tid; i < 32 * 136 / 2; i += NTHREADS) ((LAS unsigned*)(F.lds + SQ_SB))[i] = 0u;
    if (F.tid < 128) ((LAS float*)(F.lds + SQ_NV))[F.tid] = 0.f;
    __syncthreads();
    if (C.kind == 0) seq_kind_loop<0>(F, C, F.lds); else if (C.kind == 1) seq_kind_loop<1>(F, C, F.lds); else seq_kind_loop<2>(F, C, F.lds);
    WAIT_VM(0);
}

DEV void seq_s5_item(const Frame& F, int l, int item, int which) {
    const int o = l >> 1; const int g = item & 31, d = (item >> 5) & 1, b = item >> 6;
    LAS float* El = (LAS float*)(F.lds);
    LAS unsigned char* wl = F.lds + 36864 + F.wave * 14336;
    LAS float* scr = (LAS float*)wl; LAS bf16_t* hb = (LAS bf16_t*)(wl + 10240);
    const bf16_t* P = (const bf16_t*)(F.ws + WS_P);
    const float* Ab = (const float*)(F.ws + WS_S5A) + (size_t)((o * 2 + d) * 32 + g) * 128;
    const bf16_t* Bb = (const bf16_t*)(F.ws + WS_S5B) + (size_t)((o * 2 + d) * 32 + g) * 128 * 16;
    const bf16_t* Cm = (const bf16_t*)(F.ws + WS_S5C) + (size_t)(o * 32 + g) * 16 * 128;
    const int l15 = F.lane & 15, kg = F.lane >> 4;
    const float ar = Ab[F.lane], ai = Ab[64 + F.lane];
    bf16x8 bB[8], cB[4]; const bf16x8 zero8 = (bf16x8){0, 0, 0, 0, 0, 0, 0, 0};
#pragma unroll
    for (int ct = 0; ct < 8; ++ct) bB[ct] = kg < 2 ? *(const bf16x8*)(Bb + (size_t)(16 * ct + l15) * 16 + 8 * kg) : zero8;
#pragma unroll
    for (int s = 0; s < 4; ++s) cB[s] = *(const bf16x8*)(Cm + (size_t)l15 * 128 + 32 * s + 8 * kg);
    bf16_t* Obase = (bf16_t*)(F.ws + WS_O) + (size_t)d * MROWS * 1024 + 512 + 16 * g;
    float* SE = (float*)(F.ws + WS_S5E) + (size_t)item * NCH * 128;
    if (which == 1) { for (int i = F.tid; i < NCH * 128; i += NTHREADS) El[i] = SE[i]; __syncthreads(); }
    for (int pass = which; pass < which + 1; ++pass) {
        bf16x8 an[4];
#pragma unroll
        for (int st = 0; st < 4; ++st) an[st] = kg < 2 ? *(const bf16x8*)(P + (size_t)tok_row(b, d, F.wave * 64 + 16 * st + l15) * NIN_O + 2048 + 16 * g + 8 * kg) : zero8;
        for (int n = F.wave; n < NCH; n += NWAVES) {
            float hr = 0.f, hi = 0.f;
            if (pass) { hr = El[n * 128 + F.lane]; hi = El[n * 128 + 64 + F.lane]; }
            bf16x8 ac[4];
#pragma unroll
            for (int st = 0; st < 4; ++st) ac[st] = an[st];
            { const int nn = n + NWAVES < NCH ? n + NWAVES : n;
#pragma unroll
              for (int st = 0; st < 4; ++st) an[st] = kg < 2 ? *(const bf16x8*)(P + (size_t)tok_row(b, d, nn * 64 + 16 * st + l15) * NIN_O + 2048 + 16 * g + 8 * kg) : zero8; }
            const int r0 = tok_row(b, d, n * 64); const int sg = d ? -1 : 1;
#pragma unroll
            for (int st = 0; st < 4; ++st) {
#pragma unroll
                for (int ct = 0; ct < 8; ++ct) { f32x4 acc = (f32x4){0.f, 0.f, 0.f, 0.f}; acc = mfma16(ac[st], bB[ct], acc);
                    *(LAS f32x4*)(scr + (ct >> 2) * 1280 + (16 * (ct & 3) + l15) * 20 + 4 * kg) = acc; }
                WAVE_LDS_SYNC();
                f32x4 br[4], bi[4];
#pragma unroll
                for (int q = 0; q < 4; ++q) { br[q] = *(const LAS f32x4*)(scr + F.lane * 20 + 4 * q); bi[q] = *(const LAS f32x4*)(scr + 1280 + F.lane * 20 + 4 * q); }
#pragma unroll
                for (int t = 0; t < 16; ++t) { const float nr = ar * hr - ai * hi + br[t >> 2][t & 3], ni = ar * hi + ai * hr + bi[t >> 2][t & 3]; hr = nr; hi = ni;
                    if (pass) *(LAS unsigned*)(hb + t * 128 + 2 * F.lane) = pk2(hr, hi); }
                WAVE_LDS_SYNC();
                if (pass) { f32x4 acc = (f32x4){0.f, 0.f, 0.f, 0.f};
#pragma unroll
                    for (int s = 0; s < 4; ++s) { const bf16x8 ha = *(const LAS bf16x8*)(hb + l15 * 128 + 32 * s + 8 * kg); acc = mfma16(ha, cB[s], acc); }
#pragma unroll
                    for (int r = 0; r < 4; ++r) Obase[(size_t)(r0 + sg * (16 * st + 4 * kg + r)) * 1024 + l15] = (bf16_t)f2bf(acc[r]);
                    WAVE_LDS_SYNC(); }
            }
            if (!pass) { El[n * 128 + F.lane] = hr; El[n * 128 + 64 + F.lane] = hi; }
        }
        __syncthreads();
        if (!pass) {
            if (F.wave == 0) { float pr = ar, pi = ai;
#pragma unroll
                for (int q = 0; q < 6; ++q) { const float nr = pr * pr - pi * pi, ni = 2.0f * pr * pi; pr = nr; pi = ni; }
                float hr = 0.f, hi = 0.f;
                for (int n = 0; n < NCH; ++n) { const float er = El[n * 128 + F.lane], ei = El[n * 128 + 64 + F.lane];
                    El[n * 128 + F.lane] = hr; El[n * 128 + 64 + F.lane] = hi;
                    const float nr = pr * hr - pi * hi + er, ni = pr * hi + pi * hr + ei; hr = nr; hi = ni; } }
            __syncthreads();
            for (int i = F.tid; i < NCH * 128; i += NTHREADS) SE[i] = El[i];
        }
    }
}

DEV void phase_seq(const Frame& F0, int l, int mode = 0) {
    const Frame F = refresh(F0);
    const int odd = l & 1; const int nlin = B_ * (odd ? 4 : 8) * 2 * 4; const int ns5 = odd ? B_ * 2 * 32 : 0;
    const int vcu = (F.G % 8 == 0) ? (F.bid % 8) * (F.G / 8) + F.bid / 8 : F.bid;
    if (!odd || F.G <= nlin) {
        for (int it = vcu; it < nlin + ns5; it += F.G) {
            if (it < nlin) { if (mode != 2) seq_linear_item(F, l, it, mode >= 10 ? mode - 10 : 0); } else if (mode != 1 && mode < 10) seq_s5_item(F, l, it - nlin, 1);
            __syncthreads();
        }
    } else if (vcu < nlin) { if (mode != 2) seq_linear_item(F, l, vcu, mode >= 10 ? mode - 10 : 0); }
    else { for (int it = vcu - nlin; it < ns5; it += F.G - nlin) { if (mode != 1 && mode < 10) seq_s5_item(F, l, it, 1); __syncthreads(); } }
}

DEV void phase_merge(const Frame& F0, int l) {
    const Frame F = refresh(F0);
    const int odd = l & 1, li = l >> 1; const bf16_t* P = (const bf16_t*)(F.ws + WS_P);
    const bf16_t* O0 = (const bf16_t*)(F.ws + WS_O); const bf16_t* O1 = O0 + (size_t)MROWS * 1024;
    bf16_t* MG = (bf16_t*)(F.ws + WS_MERGED);
    const int nrows = (l == DEPTH - 1) ? LATR : MROWS;
    ROW_LOOP(r, nrows) {
        if (!odd) {
            const int c0 = 16 * F.lane; float v[16];
#pragma unroll
            for (int q = 0; q < 4; ++q) { const u32x2 a = *(const u32x2*)(O0 + (size_t)r * 1024 + c0 + 4 * q), bq = *(const u32x2*)(O1 + (size_t)r * 1024 + c0 + 4 * q);
                v[4 * q] = bflo(a.x) + bflo(bq.x); v[4 * q + 1] = bfhi(a.x) + bfhi(bq.x); v[4 * q + 2] = bflo(a.y) + bflo(bq.y); v[4 * q + 3] = bfhi(a.y) + bfhi(bq.y); }
            float s = 0.f;
#pragma unroll
            for (int i = 0; i < 16; ++i) s += v[i];
            s = group_sum<8>(s);
            const bool ret = F.lane >= 32; const float mu = ret ? s * (1.0f / 128.0f) : 0.f; float q2 = 0.f;
#pragma unroll
            for (int i = 0; i < 16; ++i) { v[i] -= mu; q2 += v[i] * v[i]; }
            q2 = group_sum<8>(q2);
            const float rstd = 1.0f / sqrtf(q2 * (1.0f / 128.0f) + LN_EPS);
            const bf16_t* zp = P + (size_t)r * NIN_E + (ret ? 3584 + (c0 - 512) : 1536 + c0);
            const float* gp = ret ? GIN(I_EVRETN) + li * 512 + (c0 - 512) : GIN(I_EVGDNN) + li * 128 + (c0 & 127);
            unsigned ow[8]; const u32x4 zq0 = *(const u32x4*)zp, zq1 = *(const u32x4*)(zp + 8); const unsigned zw[8] = {zq0.x, zq0.y, zq0.z, zq0.w, zq1.x, zq1.y, zq1.z, zq1.w};
            f32x4 gq[4];
#pragma unroll
            for (int i = 0; i < 4; ++i) gq[i] = *(const f32x4*)(gp + 4 * i);
#pragma unroll
            for (int i = 0; i < 16; i += 2) { const float z0 = bflo(zw[i >> 1]), z1 = bfhi(zw[i >> 1]); ow[i >> 1] = pk2(v[i] * rstd * gq[i >> 2][i & 3] * fast_silu(z0), v[i + 1] * rstd * gq[i >> 2][(i & 3) + 1] * fast_silu(z1)); }
            u32x4* op = (u32x4*)(MG + (size_t)r * 1024 + c0); op[0] = (u32x4){ow[0], ow[1], ow[2], ow[3]}; op[1] = (u32x4){ow[4], ow[5], ow[6], ow[7]};
        } else {
            const int c0 = 8 * F.lane; float v[8];
#pragma unroll
            for (int q = 0; q < 2; ++q) { const u32x2 a = *(const u32x2*)(O0 + (size_t)r * 1024 + c0 + 4 * q), bq = *(const u32x2*)(O1 + (size_t)r * 1024 + c0 + 4 * q);
                v[4 * q] = bflo(a.x) + bflo(bq.x); v[4 * q + 1] = bfhi(a.x) + bfhi(bq.x); v[4 * q + 2] = bflo(a.y) + bflo(bq.y); v[4 * q + 3] = bfhi(a.y) + bfhi(bq.y); }
            float s = 0.f;
#pragma unroll
            for (int i = 0; i < 8; ++i) s += v[i];
            s = group_sum<16>(s);
            const float mu = s * (1.0f / 128.0f); float q2 = 0.f;
#pragma unroll
            for (int i = 0; i < 8; ++i) { v[i] -= mu; q2 += v[i] * v[i]; }
            q2 = group_sum<16>(q2);
            const float rstd = 1.0f / sqrtf(q2 * (1.0f / 128.0f) + LN_EPS);
            const bf16_t* zp = P + (size_t)r * NIN_O + 1536 + c0; const float* gp = GIN(I_ODMN) + li * 512 + c0;
            unsigned ow[4]; const u32x4 zq = *(const u32x4*)zp; const unsigned zw[4] = {zq.x, zq.y, zq.z, zq.w}; const f32x4 gq0 = *(const f32x4*)gp, gq1 = *(const f32x4*)(gp + 4);
#pragma unroll
            for (int i = 0; i < 8; i += 2) { const f32x4 gq = i < 4 ? gq0 : gq1; ow[i >> 1] = pk2(v[i] * rstd * gq[i & 3] * fast_sigmoid(bflo(zw[i >> 1])), v[i + 1] * rstd * gq[(i & 3) + 1] * fast_sigmoid(bfhi(zw[i >> 1]))); }
            *(u32x4*)(MG + (size_t)r * 1024 + c0) = (u32x4){ow[0], ow[1], ow[2], ow[3]};
            const bf16_t* up = P + (size_t)r * NIN_O + 2048 + c0; const float* dsk = GIN(I_ODDSKIP) + li * 512 + c0;
#pragma unroll
            for (int q = 0; q < 2; ++q) { const u32x2 a = *(const u32x2*)(O0 + (size_t)r * 1024 + 512 + c0 + 4 * q), bq = *(const u32x2*)(O1 + (size_t)r * 1024 + 512 + c0 + 4 * q);
                v[4 * q] = bflo(a.x) + bflo(bq.x); v[4 * q + 1] = bfhi(a.x) + bfhi(bq.x); v[4 * q + 2] = bflo(a.y) + bflo(bq.y); v[4 * q + 3] = bfhi(a.y) + bfhi(bq.y); }
            { const u32x4 uq = *(const u32x4*)up; const unsigned uw[4] = {uq.x, uq.y, uq.z, uq.w}; const f32x4 d0 = *(const f32x4*)dsk, d1 = *(const f32x4*)(dsk + 4);
#pragma unroll
              for (int i = 0; i < 8; i += 2) { const f32x4 dq = i < 4 ? d0 : d1; ow[i >> 1] = pk2(gelu_tanh_f(v[i] + dq[i & 3] * bflo(uw[i >> 1])), gelu_tanh_f(v[i + 1] + dq[(i & 3) + 1] * bfhi(uw[i >> 1]))); } }
            *(u32x4*)((bf16_t*)(F.ws + WS_YS) + (size_t)r * 512 + c0) = (u32x4){ow[0], ow[1], ow[2], ow[3]};
        }
    }
}

template <int RG> DEV void ln_rows(const Frame& F, f32x4 (&t)[RG][4], const float* lg, const float* lb) {
    float mean[RG], rstd[RG];
#pragma unroll
    for (int q = 0; q < RG; ++q) { float sum = 0.f;
#pragma unroll
        for (int j = 0; j < 4; ++j) sum += (t[q][j].x + t[q][j].y) + (t[q][j].z + t[q][j].w);
        mean[q] = wave_sum(sum) * (1.0f / 1024.0f); }
#pragma unroll
    for (int q = 0; q < RG; ++q) { float s2 = 0.f;
#pragma unroll
        for (int j = 0; j < 4; ++j) { t[q][j] = t[q][j] - mean[q]; s2 += (t[q][j].x * t[q][j].x + t[q][j].y * t[q][j].y) + (t[q][j].z * t[q][j].z + t[q][j].w * t[q][j].w); }
        rstd[q] = 1.0f / sqrtf(wave_sum(s2) * (1.0f / 1024.0f) + LN_EPS); }
#pragma unroll
    for (int j = 0; j < 4; ++j) { const f32x4 gg = *((const f32x4*)lg + F.lane + 64 * j), bb = *((const f32x4*)lb + F.lane + 64 * j);
#pragma unroll
        for (int q = 0; q < RG; ++q) t[q][j] = t[q][j] * rstd[q] * gg + bb; }
}
template <int RG> DEV void ln1_group(const Frame& F, int l, int r) {

    const bf16_t* Y = (const bf16_t*)(F.ws + WS_Y); float* H = (float*)(F.ws + WS_H);
    const float* lg = GIN(I_LN1G) + l * 1024; const float* lb = GIN(I_LN1B) + l * 1024; const float* wr = (const float*)(F.ws + WS_WR) + (size_t)l * NE * 1024;
    {
        int b, s; row_bs(r, b, s); const int mr = s < CTX ? B_ : b; const float* mod = (const float*)(F.ws + WS_MOD) + ((size_t)l * NR + mr) * 6144;
        f32x4 t[RG][4];
#pragma unroll
        for (int j = 0; j < 4; ++j) { const f32x4 g1 = *((const f32x4*)(mod + 2048) + F.lane + 64 * j);
#pragma unroll
            for (int q = 0; q < RG; ++q) { const f32x4 hv = *((const f32x4*)HROW(F, l, r + q) + F.lane + 64 * j); const u32x2 yw = *((const u32x2*)(Y + (size_t)(r + q) * 1024) + F.lane + 64 * j); const f32x4 yv = (f32x4){bflo(yw.x), bfhi(yw.x), bflo(yw.y), bfhi(yw.y)}; t[q][j] = ALPHA * hv + g1 * yv; }
            if (j & 1) COMPILER_FENCE(); }
        ln_rows<RG>(F, t, lg, lb);
        COMPILER_FENCE();
#pragma unroll
        for (int j = 0; j < 4; ++j) { const f32x4 sh = *((const f32x4*)(mod + 3072) + F.lane + 64 * j), scv = *((const f32x4*)(mod + 4096) + F.lane + 64 * j);
#pragma unroll
            for (int q = 0; q < RG; ++q) { *((f32x4*)(H + (size_t)(r + q) * 1024) + F.lane + 64 * j) = t[q][j]; t[q][j] = t[q][j] * (1.0f + scv) + sh; } }
        COMPILER_FENCE();
#pragma unroll
        for (int q = 0; q < RG; ++q) { u32x2* xo = (u32x2*)((bf16_t*)(F.ws + WS_XIN) + (size_t)(r + q) * 1024) + F.lane;
#pragma unroll
            for (int j = 0; j < 4; ++j) xo[64 * j] = (u32x2){pk2(t[q][j].x, t[q][j].y), pk2(t[q][j].z, t[q][j].w)}; }
        float mine[RG]; const int ei = F.lane % NE;
#pragma unroll
        for (int q = 0; q < RG; ++q) mine[q] = 0.f;
        f32x4 wc[4];
#pragma unroll
        for (int j = 0; j < 4; ++j) wc[j] = *((const f32x4*)wr + F.lane + 64 * j);
#pragma unroll 1
        for (int e = 0; e < NE; ++e) { f32x4 wn[4]; const int en = e + 1 < NE ? e + 1 : e;
#pragma unroll
            for (int j = 0; j < 4; ++j) wn[j] = *((const f32x4*)(wr + en * 1024) + F.lane + 64 * j);
#pragma unroll
            for (int q = 0; q < RG; ++q) { float p = 0.f;
#pragma unroll
                for (int j = 0; j < 4; ++j) p += t[q][j].x * wc[j].x + t[q][j].y * wc[j].y + t[q][j].z * wc[j].z + t[q][j].w * wc[j].w;
                const float ws_ = wave_sum(p); mine[q] = (ei == e) ? ws_ : mine[q]; }
#pragma unroll
            for (int j = 0; j < 4; ++j) wc[j] = wn[j]; }
#pragma unroll
        for (int q = 0; q < RG; ++q) { const float mx = group_max<NE>(mine[q]); const float ex = expf(mine[q] - mx); const float se = group_sum<NE>(ex);
            if (F.lane < NE) ((float*)(F.ws + WS_AFF))[(size_t)(r + q) * 16 + F.lane] = ex / se; }
    }
}
DEV void phase_ln1(const Frame& F0, int l) {
    const Frame F = refresh(F0);
    const int nrows = (l == DEPTH - 1) ? LATR : MROWS;
    ROW_GROUPS(nrows, ln1_group<4>(F, l, r), ln1_group<2>(F, l, r));
}

DEV void phase_topk(const Frame& F0, int l) {
    const Frame F = refresh(F0);
    const int nitems = (l == DEPTH - 1) ? B_ * NE : 2 * B_ * NE;
    LAS unsigned* hist = (LAS unsigned*)(F.lds);
    LAS unsigned* selw = (LAS unsigned*)(F.lds + 1024);
    LAS unsigned* cnt = (LAS unsigned*)(F.lds + 2048);
    LAS int* selrow = (LAS int*)(F.lds + 8192);
    const float* AFF = (const float*)(F.ws + WS_AFF); int* SLOT = (int*)(F.ws + WS_SLOT); float* EG = (float*)(F.ws + WS_EGATE);
    for (int it = F.bid; it < nitems; it += F.G) {
        const int e = it % NE, set = it / NE, kind = set / B_, b = set % B_;
        const int n = kind ? CTX : SEQ, cap = kind ? CAPC : CAPL; const int row0 = kind ? LATR + b * CTX : b * SEQ;
        const int sbase = kind ? B_ * CAPL + b * CAPC : b * CAPL;
        const int per = n >= NTHREADS ? n / NTHREADS : 1; const bool act = F.tid * per < n;
        unsigned key[8];
#pragma unroll
        for (int k = 0; k < 8; ++k) key[k] = (act && k < per) ? __builtin_bit_cast(unsigned, AFF[(size_t)(row0 + F.tid * per + k) * 16 + e]) : 0u;
        unsigned prefix = 0u, remaining = (unsigned)cap;
        for (int pass = 0; pass < 4; ++pass) {
            const int shift = 24 - 8 * pass; const unsigned mask = pass == 0 ? 0u : (0xFFFFFFFFu << (shift + 8));
            if (F.tid < 256) hist[F.tid] = 0u;
            __syncthreads();
#pragma unroll
            for (int k = 0; k < 8; ++k) if (act && k < per && ((key[k] & mask) == (prefix & mask))) lds_atomic_add(&hist[(key[k] >> shift) & 255u], 1u);
            __syncthreads();
            if (F.wave == 0) {
                const unsigned h0 = hist[4 * F.lane], h1 = hist[4 * F.lane + 1], h2 = hist[4 * F.lane + 2], h3 = hist[4 * F.lane + 3];
                unsigned suf = h0 + h1 + h2 + h3;
#pragma unroll
                for (int o = 1; o < 64; o <<= 1) { const unsigned tv = shfl_t(suf, F.lane + o); if (F.lane + o < 64) suf += tv; }
                unsigned cum = suf - (h0 + h1 + h2 + h3);
                int dsel = -1; unsigned above = 0u;
                if (cum < remaining) {
                    if (cum + h3 >= remaining) { dsel = 4 * F.lane + 3; above = cum; }
                    else if (cum + h3 + h2 >= remaining) { dsel = 4 * F.lane + 2; above = cum + h3; }
                    else if (cum + h3 + h2 + h1 >= remaining) { dsel = 4 * F.lane + 1; above = cum + h3 + h2; }
                    else if (cum + h3 + h2 + h1 + h0 >= remaining) { dsel = 4 * F.lane; above = cum + h3 + h2 + h1; }
                }
                if (dsel >= 0) { selw[0] = prefix | ((unsigned)dsel << shift); selw[1] = remaining - above; }
            }
            __syncthreads();
            prefix = selw[0]; remaining = selw[1];
            __syncthreads();
        }
        const unsigned T = prefix, need_eq = remaining;
        unsigned ngt = 0u, neq = 0u;
#pragma unroll
        for (int k = 0; k < 8; ++k) if (act && k < per) { ngt += key[k] > T ? 1u : 0u; neq += key[k] == T ? 1u : 0u; }
        unsigned pk = (ngt << 16) | neq;
#pragma unroll
        for (int o = 1; o < 64; o <<= 1) { const unsigned tv = shfl_t(pk, F.lane - o); if (F.lane >= o) pk += tv; }
        if (F.lane == 63) cnt[F.wave] = pk;
        __syncthreads();
        unsigned base = 0u;
#pragma unroll
        for (int w8 = 0; w8 < NWAVES; ++w8) base += (w8 < F.wave) ? cnt[w8] : 0u;
        const unsigned excl = base + pk - ((ngt << 16) | neq);
        unsigned gtb = excl >> 16, eqb = excl & 0xffffu;
#pragma unroll
        for (int k = 0; k < 8; ++k) if (act && k < per) {
            const int row = row0 + F.tid * per + k; int slot = -1;
            const bool isgt = key[k] > T, iseq = key[k] == T;
            if (isgt || (iseq && eqb < need_eq)) { slot = (int)(gtb + (eqb < need_eq ? eqb : need_eq)); selrow[slot] = row; EG[(size_t)e * EPAD + sbase + slot] = __builtin_bit_cast(float, key[k]); }
            SLOT[(size_t)row * 16 + e] = slot >= 0 ? sbase + slot : -1;
            gtb += isgt ? 1u : 0u; eqb += iseq ? 1u : 0u;
        }
        __syncthreads();
        for (int sl = F.tid; sl < cap; sl += NTHREADS) ((int*)(F.ws + WS_EIDX))[(size_t)e * EPAD + sbase + sl] = selrow[sl];
        if (it < NE) for (int pr = EROWS + F.tid; pr < EPAD; pr += NTHREADS) EG[(size_t)e * EPAD + pr] = 0.f;
        __syncthreads();
    }
}

DEV void phase_gather(const Frame& F0, int l) {
    const Frame F = refresh(F0);
    const int erows = (l == DEPTH - 1) ? B_ * CAPL : EROWS;
    const int* EI = (const int*)(F.ws + WS_EIDX);
    for (int r0 = 4 * F.gw; r0 < NE * EPAD; r0 += 4 * F.NGW) {
        u32x4 v[4][2];
#pragma unroll
        for (int q = 0; q < 4; ++q) { const int r = r0 + q, sl = r % EPAD; v[q][0] = (u32x4){0u, 0u, 0u, 0u}; v[q][1] = v[q][0];
            if (sl < erows) { const u32x4* src = (const u32x4*)((const bf16_t*)(F.ws + WS_XIN) + (size_t)EI[r] * 1024) + F.lane; v[q][0] = src[0]; v[q][1] = src[64]; } }
#pragma unroll
        for (int q = 0; q < 4; ++q) { u32x4* dst = (u32x4*)((bf16_t*)(F.ws + WS_XS) + (size_t)(r0 + q) * 1024) + F.lane; dst[0] = v[q][0]; dst[64] = v[q][1]; }
    }
}

template <int RG> DEV void ln2_group(const Frame& F, int l, int r) {

    float* H = (float*)(F.ws + WS_H); const int* SLOT = (const int*)(F.ws + WS_SLOT); const bf16_t* YSE = (const bf16_t*)(F.ws + WS_YSE);
    const float* lg = GIN(I_LN2G) + l * 1024; const float* lb = GIN(I_LN2B) + l * 1024;
    {
        int b, s; row_bs(r, b, s); const int mr = s < CTX ? B_ : b; const float* mod = (const float*)(F.ws + WS_MOD) + ((size_t)l * NR + mr) * 6144;
        f32x4 t[RG][4];
#pragma unroll
        for (int q = 0; q < RG; ++q) {
#pragma unroll
            for (int j = 0; j < 4; ++j) t[q][j] = (f32x4){0.f, 0.f, 0.f, 0.f}; }
        const int myslot = F.lane < RG * 16 ? SLOT[(size_t)r * 16 + F.lane] : -1;
#pragma unroll
        for (int q = 0; q < RG; ++q)
#pragma unroll
            for (int e = 0; e < NE; ++e) { const int sl = bcast_lane(myslot, 16 * q + e);
                if (sl >= 0) { const u32x2* yp = (const u32x2*)(YSE + ((size_t)e * EPAD + sl) * 1024) + F.lane;
#pragma unroll
                    for (int j = 0; j < 4; ++j) { const u32x2 w = yp[64 * j]; t[q][j] += (f32x4){bflo(w.x), bfhi(w.x), bflo(w.y), bfhi(w.y)}; } } }
#pragma unroll
        for (int j = 0; j < 4; ++j) { const f32x4 g2 = *((const f32x4*)(mod + 5120) + F.lane + 64 * j);
#pragma unroll
            for (int q = 0; q < RG; ++q) { const f32x4 hv = *((const f32x4*)(H + (size_t)(r + q) * 1024) + F.lane + 64 * j); t[q][j] = ALPHA * hv + g2 * t[q][j]; } }
        ln_rows<RG>(F, t, lg, lb);
        if (l == DEPTH - 1) {
            {
#pragma unroll
                for (int q = 0; q < RG; ++q) { GAS f32x4* op = (GAS f32x4*)(F.out + (size_t)(r + q) * 1024) + F.lane;
#pragma unroll
                    for (int j = 0; j < 4; ++j) op[64 * j] = t[q][j]; } }
        } else {
#pragma unroll
            for (int q = 0; q < RG; ++q)
#pragma unroll
                for (int j = 0; j < 4; ++j) *((f32x4*)(H + (size_t)(r + q) * 1024) + F.lane + 64 * j) = t[q][j];
            xg_rows<RG>(F, l + 1, r, t);
        }
    }
}
DEV void phase_ln2(const Frame& F0, int l) {
    const Frame F = refresh(F0);
    const int nrows = (l == DEPTH - 1) ? LATR : MROWS;
    ROW_GROUPS(nrows, ln2_group<4>(F, l, r), ln2_group<2>(F, l, r));
}

struct EpiP {
    static constexpr bool PERM = true;
    bf16_t* O; int ldc;
    DEV void operator()(const f32x4 (&acc)[2][2][4][2], const pg8::Unit& u, int wr, int wc, int fr, int fq) const {
        const int row0 = u.pm * 256 + wr * 64 + fr, col0 = u.pn * 256 + wc * 32 + 8 * fq;
#pragma unroll
        for (int ai = 0; ai < 2; ++ai)
#pragma unroll
            for (int m = 0; m < 4; ++m) { bf16_t* rowp = O + (size_t)(row0 + ai * 128 + m * 16) * ldc + col0;
#pragma unroll
                for (int bj = 0; bj < 2; ++bj) { const f32x4 v0 = acc[ai][bj][m][0], v1 = acc[ai][bj][m][1];
                    u32x4 w; w.x = pg8::cvt_pk_bf16(v0[0], v0[1]); w.y = pg8::cvt_pk_bf16(v0[2], v0[3]); w.z = pg8::cvt_pk_bf16(v1[0], v1[1]); w.w = pg8::cvt_pk_bf16(v1[2], v1[3]);
                    *(u32x4*)(rowp + bj * 128) = w; } }
    }
};
struct EpiGlu {
    static constexpr bool PERM = true;
    bf16_t* MG; const bf16_t* YS; const float* bias;
    DEV void operator()(const f32x4 (&acc)[2][2][4][2], const pg8::Unit& u, int wr, int wc, int fr, int fq) const {
        const int row0 = u.pm * 256 + wr * 64 + fr, col0 = u.pn * 256 + wc * 32 + 8 * fq;
#pragma unroll
        for (int ai = 0; ai < 2; ++ai)
#pragma unroll
            for (int m = 0; m < 4; ++m) { const int row = row0 + ai * 128 + m * 16;
#pragma unroll
                for (int bj = 0; bj < 2; ++bj) { const int c = col0 + bj * 128; const f32x4 v0 = acc[ai][bj][m][0], v1 = acc[ai][bj][m][1];
                    const u32x4 yv = *(const u32x4*)(YS + (size_t)row * 512 + c); const f32x4 b0 = *(const f32x4*)(bias + c), b1 = *(const f32x4*)(bias + c + 4);
                    u32x4 w; w.x = pk2(bflo(yv.x) * fast_sigmoid(v0[0] + b0[0]), bfhi(yv.x) * fast_sigmoid(v0[1] + b0[1])); w.y = pk2(bflo(yv.y) * fast_sigmoid(v0[2] + b0[2]), bfhi(yv.y) * fast_sigmoid(v0[3] + b0[3]));
                    w.z = pk2(bflo(yv.z) * fast_sigmoid(v1[0] + b1[0]), bfhi(yv.z) * fast_sigmoid(v1[1] + b1[1])); w.w = pk2(bflo(yv.w) * fast_sigmoid(v1[2] + b1[2]), bfhi(yv.w) * fast_sigmoid(v1[3] + b1[3]));
                    *(u32x4*)(MG + (size_t)row * 1024 + 512 + c) = w; } }
    }
};
struct EpiF32 {
    static constexpr bool PERM = false;
    float* C; int ldc; const float* rowscale;
    DEV void operator()(const f32x4 (&acc)[2][2][4][2], const pg8::Unit& u, int wr, int wc, int fr, int fq) const {
        const int row0 = u.pm * 256 + wr * 64 + fr, col0 = u.pn * 256 + wc * 32 + 4 * fq;
        const size_t ebase = rowscale ? (size_t)u.e * EPAD : 0;
#pragma unroll
        for (int ai = 0; ai < 2; ++ai)
#pragma unroll
            for (int m = 0; m < 4; ++m) { const size_t row = ebase + row0 + ai * 128 + m * 16; const float sc = rowscale ? rowscale[row] : 1.0f; float* rowp = C + row * ldc + col0;
#pragma unroll
                for (int bj = 0; bj < 2; ++bj)
#pragma unroll
                    for (int n = 0; n < 2; ++n) *(f32x4*)(rowp + bj * 128 + n * 16) = acc[ai][bj][m][n] * sc; }
    }
};
struct EpiYse {
    static constexpr bool PERM = true;
    bf16_t* O; const float* rowscale;
    DEV void operator()(const f32x4 (&acc)[2][2][4][2], const pg8::Unit& u, int wr, int wc, int fr, int fq) const {
        const int row0 = u.pm * 256 + wr * 64 + fr, col0 = u.pn * 256 + wc * 32 + 8 * fq; const size_t ebase = (size_t)u.e * EPAD;
#pragma unroll
        for (int ai = 0; ai < 2; ++ai)
#pragma unroll
            for (int m = 0; m < 4; ++m) { const size_t row = ebase + row0 + ai * 128 + m * 16; const float sc = rowscale[row]; bf16_t* rowp = O + row * 1024 + col0;
#pragma unroll
                for (int bj = 0; bj < 2; ++bj) { const f32x4 v0 = acc[ai][bj][m][0] * sc, v1 = acc[ai][bj][m][1] * sc;
                    u32x4 w; w.x = pg8::cvt_pk_bf16(v0[0], v0[1]); w.y = pg8::cvt_pk_bf16(v0[2], v0[3]); w.z = pg8::cvt_pk_bf16(v1[0], v1[1]); w.w = pg8::cvt_pk_bf16(v1[2], v1[3]);
                    *(u32x4*)(rowp + bj * 128) = w; } }
    }
};
struct EpiSwiglu {
    static constexpr bool PERM = true;
    bf16_t* HID;
    DEV void operator()(const f32x4 (&acc)[2][2][4][2], const pg8::Unit& u, int wr, int wc, int fr, int fq) const {
        const int row0 = u.pm * 256 + wr * 64 + fr, col0 = u.pn * 128 + wc * 32 + 8 * fq;
#pragma unroll
        for (int ai = 0; ai < 2; ++ai)
#pragma unroll
            for (int m = 0; m < 4; ++m) { bf16_t* rowp = HID + ((size_t)u.e * EPAD + row0 + ai * 128 + m * 16) * FF + col0;
                const f32x4 g0 = acc[ai][0][m][0], g1 = acc[ai][0][m][1], u0 = acc[ai][1][m][0], u1 = acc[ai][1][m][1];
                u32x4 w; w.x = pk2(fast_silu(g0[0]) * u0[0], fast_silu(g0[1]) * u0[1]); w.y = pk2(fast_silu(g0[2]) * u0[2], fast_silu(g0[3]) * u0[3]);
                w.z = pk2(fast_silu(g1[0]) * u1[0], fast_silu(g1[1]) * u1[1]); w.w = pk2(fast_silu(g1[2]) * u1[2], fast_silu(g1[3]) * u1[3]);
                *(u32x4*)rowp = w; }
    }
};

DEV void gemm_g1(const Frame& F0, int l, int vcu) {
    const Frame F = refresh(F0);
    const int nin = (l & 1) ? NIN_O : NIN_E;
    pg8::PlainOrder S; S.init((const void*)(F.ws + WS_XIN), (const bf16_t*)(F.ws + WS_WIN) + (size_t)l * NINMAX * 1024, 1024, MPAD, nin, F.G, vcu);
    EpiP E; E.O = (bf16_t*)(F.ws + WS_P); E.ldc = nin;
    pg8::gemm_phase(F.lds, 1024, S, E, F.wave, F.lane);
}
DEV void gemm_glu(const Frame& F0, int l, int vcu) {
    const Frame F = refresh(F0);
    const int li = l >> 1;
    pg8::PlainOrder S; S.init((const void*)(F.ws + WS_YS), (const bf16_t*)(F.ws + WS_WGLU) + (size_t)li * 512 * 512, 512, (l == DEPTH - 1) ? LATPAD : MPAD, 512, F.G, vcu);
    EpiGlu E; E.MG = (bf16_t*)(F.ws + WS_MERGED); E.YS = (const bf16_t*)(F.ws + WS_YS); E.bias = GIN(I_ODBGLU) + li * 512;
    pg8::gemm_phase(F.lds, 512, S, E, F.wave, F.lane);
}
DEV void gemm_g3(const Frame& F0, int l, int vcu) {
    const Frame F = refresh(F0);
    pg8::PlainOrder S; S.init((const void*)(F.ws + WS_MERGED), (const bf16_t*)(F.ws + WS_WOUT) + (size_t)l * 1024 * 1024, 1024, (l == DEPTH - 1) ? LATPAD : MPAD, 1024, F.G, vcu);
    EpiP E; E.O = (bf16_t*)(F.ws + WS_Y); E.ldc = 1024;
    pg8::gemm_phase(F.lds, 1024, S, E, F.wave, F.lane);
}
DEV void gemm_g4(const Frame& F0, int l, int vcu) {
    const Frame F = refresh(F0);
    pg8::GroupedOrder S; S.init((const void*)(F.ws + WS_XS), (const bf16_t*)(F.ws + WS_WGU) + (size_t)l * NE * 2 * FF * 1024, 1024, 2 * FF, F.G, vcu, (l == DEPTH - 1) ? B_ * CAPL : EROWS);
    EpiSwiglu E; E.HID = (bf16_t*)(F.ws + WS_HID);
    pg8::gemm_phase(F.lds, 1024, S, E, F.wave, F.lane);
}
DEV void gemm_g5(const Frame& F0, int l, int vcu) {
    const Frame F = refresh(F0);
    pg8::GroupedOrder S; S.init((const void*)(F.ws + WS_HID), (const bf16_t*)(F.ws + WS_WD) + (size_t)l * NE * 1024 * FF, FF, 1024, F.G, vcu, (l == DEPTH - 1) ? B_ * CAPL : EROWS);
    EpiYse E; E.O = (bf16_t*)(F.ws + WS_YSE); E.rowscale = (const float*)(F.ws + WS_EGATE);
    pg8::gemm_phase(F.lds, FF, S, E, F.wave, F.lane);
}

__global__ void __launch_bounds__(NTHREADS, 2) mega_fwd(Args args) {
#ifdef EMU
    LAS unsigned char* lds = emu::lds();
#else
    extern __shared__ __attribute__((aligned(16))) unsigned char lds_raw[];
    LAS unsigned char* lds = (LAS unsigned char*)lds_raw;
#endif
    Frame F;
    F.in = args.in; F.out = (GAS float*)args.out; F.ws = (GAS unsigned char*)args.ws; F.lds = lds;
    F.tid = threadIdx.x; F.lane = F.tid & 63; F.wave = readfirstlane_i(F.tid >> 6); F.G = gridDim.x; F.bid = blockIdx.x;
    F.gw = F.bid * NWAVES + F.wave; F.NGW = F.G * NWAVES;
    for (int u = F.tid; u < (LDS_BYTES - LDS_MISC) / 4; u += NTHREADS) ((LAS unsigned*)(lds + LDS_MISC))[u] = 0u;
    __syncthreads();
    XcdBarrier bar = xcd_barrier_post((unsigned*)(F.ws + WS_CTL), (volatile LAS unsigned*)(lds + LDS_MISC), F.wave);
#define GRID_BAR() xcd_barrier(bar)
    const int vcu = (F.G % 8 == 0) ? (F.bid % 8) * (F.G / 8) + F.bid / 8 : F.bid;

#ifndef PHASE_MASK
#define PHASE_MASK 0xFFFFF
#endif
#ifndef REPEAT_MASK
#define REPEAT_MASK 0x0
#endif
#ifndef TIMING_PROBE
#define TIMING_PROBE -1
#endif
    unsigned long long pt_acc = 0ull, pt_t0 = 0ull;
#define PT(k) do { if (TIMING_PROBE == (k)) pt_t0 = rt_now(); } while (0)
#define PTE(k) do { if (TIMING_PROBE == (k)) pt_acc += rt_now() - pt_t0; } while (0)
#define PH(k) if ((PHASE_MASK >> (k)) & 1)
#define RP(k) if ((REPEAT_MASK >> (k)) & 1)
    PT(0); PH(0) phase_prologue_a(F);
    RP(0) { GRID_BAR(); phase_prologue_a(F); }
    GRID_BAR(); PTE(0);
    PT(1); PH(1) phase_xg0(F);
    GRID_BAR(); PTE(1);
    for (int l = 0; l < DEPTH; ++l) {
        const int odd = l & 1;
        PT(2); PH(2) gemm_g1(F, l, F.bid);
        RP(2) { GRID_BAR(); gemm_g1(F, l, F.bid); }
        GRID_BAR(); PTE(2);
        PT(3); PH(3) phase_prep(F, l);
        RP(3) { GRID_BAR(); phase_prep(F, l); }
        GRID_BAR(); PTE(3);
        PT(4); PH(4) phase_cl(F, l);
        RP(4) { GRID_BAR(); phase_cl(F, l); }
        GRID_BAR(); PTE(4);
        PT(5); PH(5) phase_seq(F, l);
        RP(5) { GRID_BAR(); phase_seq(F, l); }
        GRID_BAR(); PTE(5);
#ifdef SEQ_XPROBE
        if ((l & 1) == SEQ_XPARITY) { PT(20); phase_seq(F, l, 10 + SEQ_XPROBE); GRID_BAR(); PTE(20); }
#endif
        PT(6); PH(6) phase_merge(F, l);
        RP(6) { GRID_BAR(); phase_merge(F, l); }
        GRID_BAR(); PTE(6);
        if (odd) { PT(7); PH(7) gemm_glu(F, l, F.bid); RP(7) { GRID_BAR(); gemm_glu(F, l, F.bid); } GRID_BAR(); PTE(7); }
        PT(8); PH(8) gemm_g3(F, l, F.bid);
        RP(8) { GRID_BAR(); gemm_g3(F, l, F.bid); }
        GRID_BAR(); PTE(8);
        PT(9); PH(9) phase_ln1(F, l);
        GRID_BAR(); PTE(9);
        PT(10); PH(10) phase_topk(F, l);
        RP(10) { GRID_BAR(); phase_topk(F, l); }
        GRID_BAR(); PTE(10);
        PT(14); PH(10) phase_gather(F, l);
        GRID_BAR(); PTE(14);
        PT(11); PH(11) gemm_g4(F, l, F.bid);
        RP(11) { GRID_BAR(); gemm_g4(F, l, F.bid); }
        GRID_BAR(); PTE(11);
        PT(12); PH(12) gemm_g5(F, l, F.bid);
        RP(12) { GRID_BAR(); gemm_g5(F, l, F.bid); }
        GRID_BAR(); PTE(12);
        PT(13); PH(13) phase_ln2(F, l);
        if (l + 1 < DEPTH || TIMING_PROBE >= 0) GRID_BAR();
        PTE(13);
    }
    if (TIMING_PROBE >= 0 && F.bid == 0) { const unsigned long long t1 = rt_now() + pt_acc; while (rt_now() < t1) s_sleep1(); }
}

#ifndef EMU
extern "C" void kernel_launch(void* const* d_in, const int* in_sizes, int n_in, void* d_out, int out_size, void* d_ws, size_t ws_size, hipStream_t stream) {
    static int grid = 0;
    if (grid == 0) {
        if (n_in != N_IN || ws_size < WS_END) { fprintf(stderr, "kernel_launch: need %d inputs and %zu bytes of workspace; got %d, %zu\n", (int)N_IN, (size_t)WS_END, n_in, ws_size); grid = -1; return; }
        int dev = 0, cus = 0, per_cu = 0;
        if (hipGetDevice(&dev) != hipSuccess || hipDeviceGetAttribute(&cus, hipDeviceAttributeMultiprocessorCount, dev) != hipSuccess) { grid = -1; return; }
        if (hipFuncSetAttribute((const void*)mega_fwd, hipFuncAttributeMaxDynamicSharedMemorySize, LDS_BYTES) != hipSuccess) { fprintf(stderr, "kernel_launch: hipFuncSetAttribute failed\n"); grid = -1; return; }
        if (hipOccupancyMaxActiveBlocksPerMultiprocessor(&per_cu, (const void*)mega_fwd, NTHREADS, LDS_BYTES) != hipSuccess || per_cu < 1) { fprintf(stderr, "kernel_launch: occupancy query says %d\n", per_cu); }
        (void)hipGetLastError();
        grid = cus;
    }
    if (grid < 0) return;
    (void)hipMemsetAsync((char*)d_ws + WS_CTL, 0, CTL_BYTES, stream);
    Args a{};
    for (int i = 0; i < N_IN; ++i) a.in[i] = (const float*)d_in[i];
    a.out = (float*)d_out; a.ws = (unsigned char*)d_ws;
    hipLaunchKernelGGL(mega_fwd, dim3(grid), dim3(NTHREADS), LDS_BYTES, stream, a);
}
#endif
```

```cpp
#ifdef EMU
#include "emu.h"
#else
#include <hip/hip_runtime.h>
#endif
#include <cstdio>
#include <cstdint>
#include <cstddef>

#ifndef CFG_BATCH
#define CFG_BATCH 4
#define CFG_SEQ 4096
#define CFG_CTX 256
#define CFG_DEPTH 4
#define CFG_NEXP 16
#define CFG_FF 2048
#endif
constexpr int B_ = CFG_BATCH, SEQ = CFG_SEQ, CTX = CFG_CTX, DEPTH = CFG_DEPTH, NE = CFG_NEXP, FF = CFG_FF;
constexpr int D = 1024, TOK = CTX + SEQ, MROWS = B_ * TOK, MPAD = (MROWS + 255) / 256 * 256;
constexpr int NCH = TOK / 64;
constexpr int LATR = B_ * SEQ;
constexpr int LATPAD = (LATR + 255) / 256 * 256;
constexpr int CAPL = 2 * SEQ / NE, CAPC = 2 * CTX / NE, EROWS = B_ * (CAPL + CAPC), EPAD = (EROWS + 255) / 256 * 256;
constexpr int NIN_E = 4096, NIN_O = 2560, NINMAX = 4096;
constexpr int N_EVEN = (DEPTH + 1) / 2, N_ODD = DEPTH / 2, N_ODDA = N_ODD > 0 ? N_ODD : 1;
constexpr int NR = B_ + 1;
constexpr float ALPHA = 1.681792830507429f;
constexpr float LN_EPS = 1e-5f;
constexpr float HD_SCALE = 0.08838834764831845f;
constexpr int NWAVES = 8, NTHREADS = 512;

enum { I_X = 0, I_C, I_CTX, I_CCTX, I_WMOD, I_BMOD, I_LN1G, I_LN1B, I_LN2G, I_LN2B, I_WROUTER, I_WGATE, I_WUP, I_WDOWN,
       I_EVWIN, I_EVWOUT, I_EVCONV, I_EVALOG, I_EVDTB, I_EVGDNN, I_EVRETN,
       I_ODWIN, I_ODWOUT, I_ODCONV, I_ODGB, I_ODMN, I_ODLRE, I_ODLIM, I_ODLDT, I_ODBRE, I_ODBIM, I_ODCRE, I_ODCIM, I_ODDSKIP, I_ODWGLU, I_ODBGLU, N_IN };

constexpr size_t al256(size_t x) { return (x + 255) & ~(size_t)255; }
constexpr size_t WS_CTL = 0, CTL_BYTES = 65536;
constexpr size_t WS_MOD = WS_CTL + CTL_BYTES;
constexpr size_t WS_WG = al256(WS_MOD + (size_t)DEPTH * NR * 6144 * 4);
constexpr size_t WS_WIN = al256(WS_WG + (size_t)DEPTH * 16 * 1024 * 4);
constexpr size_t WS_WOUT = al256(WS_WIN + (size_t)DEPTH * NINMAX * 1024 * 2);
constexpr size_t WS_WGLU = al256(WS_WOUT + (size_t)DEPTH * 1024 * 1024 * 2);
constexpr size_t WS_WGU = al256(WS_WGLU + (size_t)N_ODDA * 512 * 512 * 2);
constexpr size_t WS_WD = al256(WS_WGU + (size_t)DEPTH * NE * 2 * FF * 1024 * 2);
constexpr size_t WS_S5A = al256(WS_WD + (size_t)DEPTH * NE * 1024 * FF * 2);
constexpr size_t WS_S5B = al256(WS_S5A + (size_t)N_ODDA * 2 * 32 * 128 * 4);
constexpr size_t WS_S5C = al256(WS_S5B + (size_t)N_ODDA * 2 * 32 * 128 * 16 * 2);
constexpr size_t WS_H = al256(WS_S5C + (size_t)N_ODDA * 32 * 16 * 128 * 2);
constexpr size_t WS_XIN = al256(WS_H + (size_t)MPAD * 1024 * 4);
constexpr size_t WS_GATES = al256(WS_XIN + (size_t)MPAD * 1024 * 2);
constexpr size_t WS_MERGED = al256(WS_GATES + (size_t)MROWS * 16 * 4);
constexpr size_t WS_YS = al256(WS_MERGED + (size_t)MPAD * 1024 * 2);
constexpr size_t WS_Y = al256(WS_YS + (size_t)MPAD * 512 * 2);
constexpr size_t WS_AFF = al256(WS_Y + (size_t)MPAD * 1024 * 4);
constexpr size_t WS_SLOT = al256(WS_AFF + (size_t)MROWS * 16 * 4);
constexpr size_t WS_EGATE = al256(WS_SLOT + (size_t)MROWS * 16 * 4);
constexpr size_t WS_MCH = al256(WS_EGATE + (size_t)NE * EPAD * 4);
constexpr size_t WS_WR = al256(WS_MCH + (size_t)B_ * 4 * 2 * NCH * 4);
constexpr size_t WS_EIDX = al256(WS_WR + (size_t)DEPTH * NE * 1024 * 4);
constexpr size_t WS_S5E = al256(WS_EIDX + (size_t)NE * EPAD * 4);
constexpr size_t WS_R = al256(WS_S5E + (size_t)B_ * 2 * 32 * NCH * 128 * 4);
constexpr int NCP = B_ * 8 * 2 * NCH, NCPG = B_ * 4 * 2 * NCH;
constexpr size_t WS_P = WS_R;
constexpr size_t WS_QKV = al256(WS_P + (size_t)MPAD * NINMAX * 2);
constexpr size_t WS_CLW = al256(WS_QKV + (size_t)MROWS * 1536 * 2);
constexpr size_t WS_CLQ = al256(WS_CLW + (size_t)NCP * 64 * 128 * 2);
constexpr size_t WS_CLK = al256(WS_CLQ + (size_t)NCP * 64 * 128 * 2);
constexpr size_t WS_CLA = al256(WS_CLK + (size_t)NCP * 64 * 128 * 2);
constexpr size_t WS_CLU = al256(WS_CLA + (size_t)NCP * 64 * 64 * 2);
constexpr size_t WS_CLS = al256(WS_CLU + (size_t)NCPG * 64 * 128 * 4);
constexpr size_t WS_O = al256(WS_CLS + (size_t)NCP * 512 * 4);
constexpr size_t WS_R_END1 = al256(WS_O + (size_t)2 * MROWS * 1024 * 4);
constexpr size_t WS_XS = WS_R;
constexpr size_t WS_HID = al256(WS_XS + (size_t)NE * EPAD * 1024 * 2);
constexpr size_t WS_YSE = al256(WS_HID + (size_t)NE * EPAD * FF * 2);
constexpr size_t WS_R_END2 = al256(WS_YSE + (size_t)NE * EPAD * 1024 * 4);
constexpr size_t WS_END = WS_R_END1 > WS_R_END2 ? WS_R_END1 : WS_R_END2;

constexpr int LDS_BYTES = 163840;
constexpr int LDS_MISC = 163328;

typedef unsigned short bf16_t;
typedef short bf16x8 __attribute__((ext_vector_type(8)));
typedef float f32x2 __attribute__((ext_vector_type(2)));
typedef float f32x4 __attribute__((ext_vector_type(4)));
typedef float f32x16 __attribute__((ext_vector_type(16)));
typedef unsigned u32x2 __attribute__((ext_vector_type(2)));
typedef unsigned u32x4 __attribute__((ext_vector_type(4)));
#define DEV __device__ __forceinline__

#ifdef EMU
#define LAS
#define GAS
static inline float bf2f_h(bf16_t b) { unsigned u = (unsigned)b << 16; float f; memcpy(&f, &u, 4); return f; }
static inline f32x4 mfma16(bf16x8 a, bf16x8 b, f32x4 c) {
    struct In { bf16x8 a, b; } in{a, b};
    auto s = emu::wave_xchg(&in, sizeof(in)); const int l = emu::cur->lane, col = l & 15, rg = l >> 4;
    for (int r = 0; r < 4; ++r) { const int row = 4 * rg + r; double acc = c[r];
        for (int kg = 0; kg < 4; ++kg) { const In* pa = (const In*)s[row + 16 * kg]; const In* pb = (const In*)s[col + 16 * kg];
            for (int j = 0; j < 8; ++j) acc += (double)bf2f_h((bf16_t)pa->a[j]) * (double)bf2f_h((bf16_t)pb->b[j]); }
        c[r] = (float)acc; }
    return c;
}
static inline f32x16 mfma32(bf16x8 a, bf16x8 b, f32x16 c) {
    struct In { bf16x8 a, b; } in{a, b};
    auto s = emu::wave_xchg(&in, sizeof(in)); const int l = emu::cur->lane, col = l & 31, h = l >> 5;
    for (int r = 0; r < 16; ++r) { const int row = (r & 3) + 8 * (r >> 2) + 4 * h; double acc = c[r];
        for (int kh = 0; kh < 2; ++kh) { const In* pa = (const In*)s[row + 32 * kh]; const In* pb = (const In*)s[col + 32 * kh];
            for (int j = 0; j < 8; ++j) acc += (double)bf2f_h((bf16_t)pa->a[j]) * (double)bf2f_h((bf16_t)pb->b[j]); }
        c[r] = (float)acc; }
    return c;
}
static inline void glds16(const void* g, void* l) { memcpy((char*)l + 16 * emu::cur->lane, g, 16); }
#define S_BARRIER() emu::block_barrier()
#define WAIT_VM(n) do {} while (0)
#define WAIT_LGKM(n) do {} while (0)
#define WAIT_ALL() do {} while (0)
#define SETPRIO(n) do {} while (0)
#define SCHED_BARRIER() do {} while (0)
#define COMPILER_FENCE() do {} while (0)
#define WAVE_LDS_SYNC() do { int _z = 0; (void)emu::wave_xchg(&_z, 4); } while (0)
#define LAUNDER(x) do {} while (0)
#define CODE_ALIGN() do {} while (0)
#define LAUNDER_S(x) do {} while (0)
static inline int lane_id() { return emu::cur->lane; }
template <class T> static inline T shfl_xor_t(T v, int m) { auto s = emu::wave_xchg(&v, sizeof(T)); T r; memcpy(&r, s[emu::cur->lane ^ m], sizeof(T)); return r; }
template <class T> static inline T shfl_t(T v, int src) { auto s = emu::wave_xchg(&v, sizeof(T)); T r; memcpy(&r, s[src & 63], sizeof(T)); return r; }
static inline float wave_sum(float v) { for (int o = 1; o < 64; o <<= 1) v += shfl_xor_t(v, o); return v; }
static inline float wave_max(float v) { for (int o = 1; o < 64; o <<= 1) v = fmaxf(v, shfl_xor_t(v, o)); return v; }
template <int W> static inline float group_sum(float v) { for (int o = 1; o < W; o <<= 1) v += shfl_xor_t(v, o); return v; }
template <int W> static inline float group_max(float v) { for (int o = 1; o < W; o <<= 1) v = fmaxf(v, shfl_xor_t(v, o)); return v; }
static inline int bcast_lane(int v, int src) { return shfl_t(v, src); }
static inline float bcast_lane_f(float v, int src) { return shfl_t(v, src); }
static inline float wave_scan_add(float v) { const int ln = emu::cur->lane; for (int o = 1; o < 64; o <<= 1) { const float t = shfl_t(v, ln - o); if (ln >= o) v += t; } return v; }
static inline float wave_scan_max(float v) { const int ln = emu::cur->lane; for (int o = 1; o < 64; o <<= 1) { const float t = shfl_t(v, ln - o); if (ln >= o) v = fmaxf(v, t); } return v; }
static inline int readfirstlane_i(int v) { return v; }
static inline unsigned xb_ld(unsigned* p) { return *(volatile unsigned*)p; }
static inline unsigned xb_add(unsigned* p, unsigned v) { unsigned o = *p; *p = o + v; return o; }
static inline unsigned xb_xcc_id() { return (unsigned)emu::cur->bid & 7u; }
static inline void s_sleep1() { emu::yield(); }
static inline void fence_acquire() {}
static inline void fence_release() {}
static inline unsigned lds_atomic_add(unsigned* p, unsigned v) { unsigned o = *p; *p = o + v; return o; }
static inline unsigned long long rt_now() { return 0ull; }
static inline float fast_exp2(float x) { return exp2f(x); }
static inline float fast_rcp(float x) { return 1.0f / x; }
#else
#define LAS __attribute__((address_space(3)))
#define GAS __attribute__((address_space(1)))
DEV f32x4 mfma16(bf16x8 a, bf16x8 b, f32x4 c) { return __builtin_amdgcn_mfma_f32_16x16x32_bf16(a, b, c, 0, 0, 0); }
DEV f32x16 mfma32(bf16x8 a, bf16x8 b, f32x16 c) { return __builtin_amdgcn_mfma_f32_32x32x16_bf16(a, b, c, 0, 0, 0); }
#define glds16(g, l) __builtin_amdgcn_global_load_lds((const unsigned*)(g), (LAS unsigned*)(l), 16, 0, 0)
#define S_BARRIER() __builtin_amdgcn_s_barrier()
#define WAIT_VM(n) asm volatile("s_waitcnt vmcnt(" #n ")" ::: "memory")
#define WAIT_LGKM(n) asm volatile("s_waitcnt lgkmcnt(" #n ")" ::: "memory")
#define WAIT_ALL() asm volatile("s_waitcnt vmcnt(0) lgkmcnt(0)" ::: "memory")
#define SETPRIO(n) __builtin_amdgcn_s_setprio(n)
#define SCHED_BARRIER() __builtin_amdgcn_sched_barrier(0)
#define COMPILER_FENCE() asm volatile("" ::: "memory")
#define WAVE_LDS_SYNC() asm volatile("s_waitcnt lgkmcnt(0)" ::: "memory")
#define LAUNDER(x) asm volatile("" : "+v"(x))
#define CODE_ALIGN() asm volatile(".p2align 8")
#define LAUNDER_S(x) asm volatile("" : "+s"(x))
DEV int lane_id() { return (int)__builtin_amdgcn_mbcnt_hi(~0u, __builtin_amdgcn_mbcnt_lo(~0u, 0u)); }
template <class T> DEV T shfl_xor_t(T v, int m) { return __shfl_xor(v, m); }
template <class T> DEV T shfl_t(T v, int src) { return __shfl(v, src); }
template <int CTRL, int ROWMASK> DEV float dpp_mov(float v) { return __builtin_bit_cast(float, __builtin_amdgcn_update_dpp(0, __builtin_bit_cast(int, v), CTRL, ROWMASK, 0xf, false)); }
template <int CTRL, int ROWMASK> DEV float dpp_mov_keep(float oldv, float v) { return __builtin_bit_cast(float, __builtin_amdgcn_update_dpp(__builtin_bit_cast(int, oldv), __builtin_bit_cast(int, v), CTRL, ROWMASK, 0xf, false)); }
template <int W> DEV float group_sum(float v) {
    v += dpp_mov<0xB1, 0xf>(v); v += dpp_mov<0x4E, 0xf>(v);
    if (W >= 8) v += dpp_mov<0x141, 0xf>(v);
    if (W >= 16) v += dpp_mov<0x140, 0xf>(v);
    return v;
}
DEV float wave_sum(float v) {
    v = group_sum<16>(v);
    v += dpp_mov<0x142, 0xa>(v);
    v += dpp_mov<0x143, 0xc>(v);
    return __builtin_bit_cast(float, __builtin_amdgcn_readlane(__builtin_bit_cast(int, v), 63));
}
DEV float wave_max(float v) {
    v = fmaxf(v, dpp_mov_keep<0xB1, 0xf>(v, v)); v = fmaxf(v, dpp_mov_keep<0x4E, 0xf>(v, v)); v = fmaxf(v, dpp_mov_keep<0x141, 0xf>(v, v)); v = fmaxf(v, dpp_mov_keep<0x140, 0xf>(v, v));
    v = fmaxf(v, dpp_mov_keep<0x142, 0xa>(v, v)); v = fmaxf(v, dpp_mov_keep<0x143, 0xc>(v, v));
    return __builtin_bit_cast(float, __builtin_amdgcn_readlane(__builtin_bit_cast(int, v), 63));
}
template <int W> DEV float group_max(float v) {
    v = fmaxf(v, dpp_mov_keep<0xB1, 0xf>(v, v)); v = fmaxf(v, dpp_mov_keep<0x4E, 0xf>(v, v));
    if (W >= 8) v = fmaxf(v, dpp_mov_keep<0x141, 0xf>(v, v));
    if (W >= 16) v = fmaxf(v, dpp_mov_keep<0x140, 0xf>(v, v));
    return v;
}
DEV int bcast_lane(int v, int src) { return __builtin_amdgcn_readlane(v, src); }
DEV float bcast_lane_f(float v, int src) { return __builtin_bit_cast(float, __builtin_amdgcn_readlane(__builtin_bit_cast(int, v), src)); }
DEV float wave_scan_add(float v) {
    v += dpp_mov<0x111, 0xf>(v); v += dpp_mov<0x112, 0xf>(v); v += dpp_mov<0x114, 0xf>(v); v += dpp_mov<0x118, 0xf>(v);
    v += dpp_mov<0x142, 0xa>(v); v += dpp_mov<0x143, 0xc>(v); return v;
}
DEV float wave_scan_max(float v) {
    v = fmaxf(v, dpp_mov_keep<0x111, 0xf>(v, v)); v = fmaxf(v, dpp_mov_keep<0x112, 0xf>(v, v)); v = fmaxf(v, dpp_mov_keep<0x114, 0xf>(v, v)); v = fmaxf(v, dpp_mov_keep<0x118, 0xf>(v, v));
    v = fmaxf(v, dpp_mov_keep<0x142, 0xa>(v, v)); v = fmaxf(v, dpp_mov_keep<0x143, 0xc>(v, v)); return v;
}
DEV int readfirstlane_i(int v) { return __builtin_amdgcn_readfirstlane(v); }
DEV unsigned xb_ld(unsigned* p) { return __hip_atomic_load(p, __ATOMIC_RELAXED, __HIP_MEMORY_SCOPE_AGENT); }
DEV unsigned xb_add(unsigned* p, unsigned v) { return __hip_atomic_fetch_add(p, v, __ATOMIC_RELAXED, __HIP_MEMORY_SCOPE_AGENT); }
DEV unsigned xb_xcc_id() { return (unsigned)__builtin_amdgcn_s_getreg((3 << 11) | 20) & 0xFu; }
DEV void s_sleep1() { __builtin_amdgcn_s_sleep(1); }
DEV void fence_acquire() { __builtin_amdgcn_fence(__ATOMIC_ACQUIRE, "agent"); }
DEV void fence_release() { __builtin_amdgcn_fence(__ATOMIC_RELEASE, "agent"); }
DEV unsigned lds_atomic_add(LAS unsigned* p, unsigned v) { return __hip_atomic_fetch_add(p, v, __ATOMIC_RELAXED, __HIP_MEMORY_SCOPE_WORKGROUP); }
DEV unsigned long long rt_now() { return __builtin_amdgcn_s_memrealtime(); }
DEV float fast_exp2(float x) { return __builtin_amdgcn_exp2f(x); }
DEV float fast_rcp(float x) { return __builtin_amdgcn_rcpf(x); }
#endif

#ifdef EMU
DEV unsigned f2bf(float f) { unsigned u = __builtin_bit_cast(unsigned, f); return (u + 0x7fffu + ((u >> 16) & 1u)) >> 16; }
DEV unsigned pk2(float lo, float hi) { return f2bf(lo) | (f2bf(hi) << 16); }
DEV unsigned f2bf_sw(float f) { return f2bf(f); }
DEV unsigned pk2_sw(float lo, float hi) { return pk2(lo, hi); }
#else
typedef float f32x2n_t __attribute__((ext_vector_type(2)));
typedef __bf16 bf16x2n_t __attribute__((ext_vector_type(2)));
DEV unsigned pk2(float lo, float hi) { const f32x2n_t v = {lo, hi}; return __builtin_bit_cast(unsigned, __builtin_convertvector(v, bf16x2n_t)); }
DEV unsigned f2bf(float f) { return (unsigned)__builtin_bit_cast(unsigned short, (__bf16)f); }
DEV unsigned f2bf_sw(float f) { unsigned u = __builtin_bit_cast(unsigned, f); return (u + 0x7fffu + ((u >> 16) & 1u)) >> 16; }
DEV unsigned pk2_sw(float lo, float hi) { return f2bf_sw(lo) | (f2bf_sw(hi) << 16); }
#endif
DEV float bf2f(unsigned b) { return __builtin_bit_cast(float, b << 16); }
DEV float bflo(unsigned w) { return __builtin_bit_cast(float, w << 16); }
DEV float bfhi(unsigned w) { return __builtin_bit_cast(float, w & 0xffff0000u); }
DEV float sigmoid_f(float x) { return 1.0f / (1.0f + expf(-x)); }
DEV float silu_f(float x) { return x / (1.0f + expf(-x)); }
DEV float softplus_f(float x) { return fmaxf(x, 0.0f) + log1pf(expf(-fabsf(x))); }
DEV float fast_sigmoid(float x) { return fast_rcp(1.0f + fast_exp2(-1.4426950408889634f * x)); }
DEV float fast_silu(float x) { return x * fast_sigmoid(x); }
DEV float gelu_tanh_f(float x) { const float u = 0.7978845608028654f * (x + 0.044715f * x * x * x); return x * fast_sigmoid(2.0f * u); }
DEV float fast_exp(float x) { return fast_exp2(1.4426950408889634f * x); }

#define XB_TMO      128
#define XB_XCNT(j)  (256  + 64 * (j))
#define XB_XSUB(j)  (1280 + 64 * (j))
#define XB_XGEN(j)  (2304 + 64 * (j))
#define XB_TOP      3328
#define XB_TOPGEN   3392
#define XCD_BAR_WORDS 3456
#define XB_SPIN_CAP (1u << 20)
#define XB_SPIN(cond, bar) do { unsigned _sp = 0; while (cond) { s_sleep1(); \
    if ((++_sp & 255u) == 0u) { if (xb_ld(&(bar)[XB_TMO])) break; if (_sp > XB_SPIN_CAP) { xb_add(&(bar)[XB_TMO], 1u); break; } } } } while (0)
struct XcdBarrier { unsigned* bar; unsigned x; volatile LAS unsigned* st; int wave; };
DEV XcdBarrier xcd_barrier_post(unsigned* bar, volatile LAS unsigned* st, int wave) {
    XcdBarrier b; b.wave = wave; b.bar = bar; b.x = (unsigned)readfirstlane_i((int)xb_xcc_id()); b.st = st;
    if (wave == 0 && lane_id() == 0) (void)xb_add(&bar[XB_XCNT(b.x)], 1u);
    return b;
}
DEV void xcd_barrier_complete(unsigned* bar, unsigned x, unsigned& nloc, unsigned& nx) {
    const unsigned G = gridDim.x;
    unsigned sum, cnt, mine, sp = 0u;
    for (;;) {
        sum = 0u; cnt = 0u; mine = 0u;
#pragma unroll
        for (unsigned j = 0; j < 16; ++j) { const unsigned c = xb_ld(&bar[XB_XCNT(j)]); sum += c; cnt += (c > 0u) ? 1u : 0u; mine = (j == x) ? c : mine; }
        if (sum == G) break;
        s_sleep1();
        if ((++sp & 255u) == 0u) { if (xb_ld(&bar[XB_TMO])) break; if (sp > XB_SPIN_CAP) { xb_add(&bar[XB_TMO], 1u); break; } }
    }
    nloc = mine > 0u ? mine : 1u; nx = cnt > 0u ? cnt : 1u;
}
DEV void xcd_barrier(const XcdBarrier& b) {
    WAIT_VM(0);
    __syncthreads();
    int bw = b.wave; LAUNDER_S(bw);
    if (bw == 0 && lane_id() == 0) {
        unsigned* bar = b.bar; LAUNDER_S(bar);
        unsigned bx = b.x; LAUNDER_S(bx);
        WAIT_ALL();
        unsigned nloc = b.st[0], nx = b.st[1];
        if (nloc == 0u) { xcd_barrier_complete(bar, bx, nloc, nx); b.st[0] = nloc; b.st[1] = nx; }
        const unsigned old = xb_add(&bar[XB_XSUB(bx)], 1u);
        const unsigned gen = old / nloc;
        if (old + 1u == (gen + 1u) * nloc) {
            fence_release();
            WAIT_VM(0);
            const unsigned og = xb_add(&bar[XB_TOP], 1u);
            const unsigned tg = og / nx;
            if (og + 1u == (tg + 1u) * nx) xb_add(&bar[XB_TOPGEN], 1u);
            else XB_SPIN(xb_ld(&bar[XB_TOPGEN]) == tg, bar);
            fence_acquire();
            xb_add(&bar[XB_XGEN(bx)], 1u);
            WAIT_VM(0);
        } else {
            XB_SPIN(xb_ld(&bar[XB_XGEN(bx)]) == gen, bar);
            fence_acquire();
            WAIT_VM(0);
        }
    }
    __syncthreads();
}

namespace pg8 {
constexpr int BM = 256, BK = 64, HALF = 128, HTB = HALF * BK * 2, STAGE_BYTES = 8 * HTB;
DEV int lds_byte(int r, int c) { const int st = (r >> 4) * 2 + (c >> 5), rr = r & 15, cc = c & 31, ob = rr * 64 + cc * 2; return st * 1024 + (ob ^ (((ob >> 9) & 1) << 5)); }
DEV void stage_rc(int b, int& R, int& C) { const int st = b / 1024, sb = b % 1024, swz = sb ^ (((sb >> 9) & 1) << 5); R = (st >> 1) * 16 + swz / 64; C = (st & 1) * 32 + (swz % 64) / 2; }
DEV int perm32(int rho) { const int n = rho >> 4, i = rho & 15; return 8 * (i >> 2) + 4 * n + (i & 3); }
struct Unit { const char* A; const char* B; int pm, pn, e; };
#ifdef EMU
static inline unsigned cvt_pk_bf16(float lo, float hi) { return pk2(lo, hi); }
#else
DEV unsigned cvt_pk_bf16(float lo, float hi) { return pk2(lo, hi); }
#endif
template <class Epi, class Sched>
DEV void gemm_phase(LAS unsigned char* lds, const int K, const Sched& S, const Epi& E, const int wid, const int lane) {
    const int tid = wid * 64 + lane; const int wr = wid >> 2, wc = wid & 3, fr = lane & 15, fq = lane >> 4;
    const int nt = K / BK;
    unsigned voffA[2], voffB[2];
#pragma unroll
    for (int i = 0; i < 2; ++i) { int R, C; stage_rc(tid * 16 + i * 8192, R, C); const int Rb = Epi::PERM ? ((R & ~31) + perm32(R & 31)) : R;
        voffA[i] = (unsigned)(R * K + C) * 2u; voffB[i] = (unsigned)(Rb * K + C) * 2u; }
    const size_t kstep = (size_t)(BK * 2);
    const size_t hstep = (size_t)HALF * K * 2;
    const unsigned ldsw = (unsigned)wid * 1024u;
    const int aoff = lds_byte(wr * 64 + fr, fq * 8), boff = lds_byte(wc * 32 + fr, fq * 8);
#define PG8_SA(b, h) (((b) * 2 + (h)) * HTB)
#define PG8_SB(b, h) ((4 + (b) * 2 + (h)) * HTB)
#define PG8_STAGE(bufoff, gbase, voff) do { _Pragma("unroll") for (int _i = 0; _i < 2; ++_i) \
        glds16(((const char*)(gbase) + (voff)[_i]), (lds + (bufoff) + ldsw + _i * 8192)); } while (0)
#define PG8_LDA(dst, b, h) do { _Pragma("unroll") for (int m = 0; m < 4; ++m) _Pragma("unroll") for (int k = 0; k < 2; ++k) dst[m][k] = *(const LAS bf16x8*)(lds + PG8_SA(b, h) + aoff + m * 2048 + k * 1024); } while (0)
#define PG8_LDB(dst, b, h) do { _Pragma("unroll") for (int n = 0; n < 2; ++n) _Pragma("unroll") for (int k = 0; k < 2; ++k) dst[n][k] = *(const LAS bf16x8*)(lds + PG8_SB(b, h) + boff + n * 2048 + k * 1024); } while (0)
#define PG8_MMA(ai, bj, At, Bt) do { SETPRIO(1); _Pragma("unroll") for (int m = 0; m < 4; ++m) _Pragma("unroll") for (int n = 0; n < 2; ++n) _Pragma("unroll") for (int k = 0; k < 2; ++k) \
        acc[ai][bj][m][n] = mfma16(Bt[n][k], At[m][k], acc[ai][bj][m][n]); SETPRIO(0); } while (0)
    Unit cur, nxt; int ui = 0;
    if (!S.next(0, cur)) return;
    f32x4 acc[2][2][4][2];
#pragma unroll
    for (int a = 0; a < 2; ++a)
#pragma unroll
        for (int b = 0; b < 2; ++b)
#pragma unroll
            for (int m = 0; m < 4; ++m)
#pragma unroll
                for (int n = 0; n < 2; ++n) acc[a][b][m][n] = (f32x4){0.f, 0.f, 0.f, 0.f};
    bf16x8 At[4][2], B0[2][2], B1[2][2];
    const char* cA = cur.A; const char* cB = cur.B;
    PG8_STAGE(PG8_SB(0, 0), cB, voffB); PG8_STAGE(PG8_SB(0, 1), cB + hstep, voffB); PG8_STAGE(PG8_SA(0, 0), cA, voffA); PG8_STAGE(PG8_SA(0, 1), cA + hstep, voffA);
    if (wr == 1) S_BARRIER();
    WAIT_VM(2); S_BARRIER();
    PG8_STAGE(PG8_SB(1, 0), cB + kstep, voffB); PG8_STAGE(PG8_SA(1, 0), cA + kstep, voffA); PG8_STAGE(PG8_SB(1, 1), cB + hstep + kstep, voffB);
    WAIT_VM(6); S_BARRIER();
    CODE_ALIGN();
    for (;;) {
        const bool has_next = S.next(ui + 1, nxt);
        const char* nA = has_next ? nxt.A : cA; const char* nB = has_next ? nxt.B : cB;
        for (int t = 0; t < nt; t += 2) {
            const bool last = (t == nt - 2);
            const char* a1 = cA + (size_t)(t + 1) * kstep;
            const char* a2 = last ? nA : cA + (size_t)(t + 2) * kstep; const char* b2 = last ? nB : cB + (size_t)(t + 2) * kstep;
            const char* a3 = a2 + kstep; const char* b3 = b2 + kstep;
            PG8_LDB(B0, 0, 0); PG8_LDB(B1, 0, 1); SCHED_BARRIER(); PG8_LDA(At, 0, 0); PG8_STAGE(PG8_SA(1, 1), a1 + hstep, voffA);
            WAIT_VM(8); WAIT_LGKM(0); S_BARRIER(); PG8_MMA(0, 0, At, B0); PG8_MMA(0, 1, At, B1); S_BARRIER(); SCHED_BARRIER();
            PG8_LDA(At, 0, 1); PG8_STAGE(PG8_SB(0, 0), b2, voffB); PG8_STAGE(PG8_SB(0, 1), b2 + hstep, voffB); PG8_STAGE(PG8_SA(0, 0), a2, voffA);
            WAIT_VM(8); WAIT_LGKM(0); S_BARRIER(); PG8_MMA(1, 0, At, B0); PG8_MMA(1, 1, At, B1); S_BARRIER(); SCHED_BARRIER();
            PG8_LDB(B0, 1, 0); PG8_LDB(B1, 1, 1); SCHED_BARRIER(); PG8_LDA(At, 1, 0); PG8_STAGE(PG8_SA(0, 1), a2 + hstep, voffA);
            WAIT_VM(8); WAIT_LGKM(0); S_BARRIER(); PG8_MMA(0, 0, At, B0); PG8_MMA(0, 1, At, B1); S_BARRIER(); SCHED_BARRIER();
            PG8_LDA(At, 1, 1); PG8_STAGE(PG8_SB(1, 0), b3, voffB); PG8_STAGE(PG8_SB(1, 1), b3 + hstep, voffB); PG8_STAGE(PG8_SA(1, 0), a3, voffA);
            WAIT_VM(8); WAIT_LGKM(0); S_BARRIER(); PG8_MMA(1, 0, At, B0); PG8_MMA(1, 1, At, B1); S_BARRIER(); SCHED_BARRIER();
        }
        if (wr == 0) S_BARRIER();
        E(acc, cur, wr, wc, fr, fq);
        if (!has_next) break;
#pragma unroll
        for (int a = 0; a < 2; ++a)
#pragma unroll
            for (int b = 0; b < 2; ++b)
#pragma unroll
                for (int m = 0; m < 4; ++m)
#pragma unroll
                    for (int n = 0; n < 2; ++n) acc[a][b][m][n] = (f32x4){0.f, 0.f, 0.f, 0.f};
        cur = nxt; cA = nA; cB = nB; ++ui;
        if (wr == 1) S_BARRIER();
    }
    WAIT_VM(0);
    S_BARRIER();
#undef PG8_SA
#undef PG8_SB
#undef PG8_STAGE
#undef PG8_LDA
#undef PG8_LDB
#undef PG8_MMA
}

struct PlainOrder {
    const char* A; const char* Bt; int K, nM, nN, nwg, G, c;
    DEV void init(const void* A_, const void* Bt_, int K_, int M, int N, int G_, int c_) { A = (const char*)A_; Bt = (const char*)Bt_; K = K_; nM = M / BM; nN = N / BM; nwg = nM * nN; G = G_; c = c_; }
    DEV bool next(int i, Unit& u) const {
        const long L = (long)i * G + c; if (L >= nwg) return false;
        int wgid = (int)L; { const int q = nwg / 8, r = nwg % 8, xcd = wgid % 8, off = wgid / 8; wgid = (xcd < r ? xcd * (q + 1) : r * (q + 1) + (xcd - r) * q) + off; }
        const int nig = 8 * nN, gid = wgid / nig, fm = gid * 8, gsz = (nM - fm) < 8 ? (nM - fm) : 8;
        u.pm = fm + ((wgid % nig) % gsz); u.pn = (wgid % nig) / gsz; u.e = 0;
        u.A = A + (size_t)u.pm * BM * K * 2; u.B = Bt + (size_t)u.pn * BM * K * 2; return true;
    }
};
struct GroupedOrder {
    const char* A; const char* Bt; int K, nMe, nN, nwg, G, c; size_t bstride;
    DEV void init(const void* A_, const void* Bt_, int K_, int N, int G_, int c_, int erows) { A = (const char*)A_; Bt = (const char*)Bt_; K = K_; nMe = (erows + BM - 1) / BM; nN = N / BM; nwg = NE * nMe * nN; G = G_; c = c_; bstride = (size_t)N * K * 2; }
    DEV bool next(int i, Unit& u) const {
        const long L = (long)i * G + c; if (L >= nwg) return false;
        int wgid = (int)L; { const int q = nwg / 8, r = nwg % 8, xcd = wgid % 8, off = wgid / 8; wgid = (xcd < r ? xcd * (q + 1) : r * (q + 1) + (xcd - r) * q) + off; }
        const int per_e = nMe * nN; const int e = wgid / per_e, w = wgid % per_e;
        u.e = e; u.pm = w % nMe; u.pn = w / nMe;
        u.A = A + ((size_t)e * EPAD + (size_t)u.pm * BM) * K * 2; u.B = Bt + (size_t)e * bstride + (size_t)u.pn * BM * K * 2; return true;
    }
};
}

struct Args { const float* in[N_IN]; float* out; unsigned char* ws; };

struct Frame {
    const float* const* in; GAS float* out; GAS unsigned char* ws; LAS unsigned char* lds;
    int tid, lane, wave, G, bid, gw, NGW;
};

#define HROW(F, l, r) ((l) == 0 ? ((r) < LATR ? GIN(I_X) + (size_t)(r) * 1024 : GIN(I_CTX) + (size_t)((r) - LATR) * 1024) : (const float*)((F).ws + WS_H) + (size_t)(r) * 1024)

DEV Frame refresh(const Frame& F0) {
    Frame F = F0; int w = F0.wave; LAUNDER_S(w); int ln = lane_id(); LAUNDER(ln);
    F.wave = w; F.lane = ln; F.tid = w * 64 + ln; F.gw = F.bid * NWAVES + w;
    GAS unsigned char* ws = F0.ws; LAUNDER_S(ws); F.ws = ws;
    return F;
}

#define GIN(k) ((const float*)(GAS const float*)F.in[k])

#define ROW_LOOP(r, NROWS) for (int r = F.gw; r < (NROWS); r += F.NGW)

DEV int tok_row(int b, int d, int sp) {
    if (sp < CTX) return LATR + b * CTX + (d ? (CTX - 1 - sp) : sp);
    const int j = sp - CTX; return b * SEQ + (d ? (SEQ - 1 - j) : j);
}
DEV void row_bs(int r, int& b, int& s) { if (r < LATR) { b = r / SEQ; s = CTX + r % SEQ; } else { const int q = r - LATR; b = q / CTX; s = q % CTX; } }

DEV void tr_item(const float* W, int ldw, int col0, int k0, bf16_t* WT, int K, int row0, LAS float* scr, int lane) {
#pragma unroll 8
    for (int i = 0; i < 32; ++i) { const int kk = 2 * i + (lane >> 5); scr[kk * 33 + (lane & 31)] = W[(size_t)(k0 + kk) * ldw + col0 + (lane & 31)]; }
    WAVE_LDS_SYNC();
    const int c = lane & 7;
#pragma unroll
    for (int j = 0; j < 4; ++j) { const int n = (lane >> 3) + 8 * j; const LAS float* s = scr + (8 * c) * 33 + n;
        u32x4 o; o.x = pk2(s[0 * 33], s[1 * 33]); o.y = pk2(s[2 * 33], s[3 * 33]); o.z = pk2(s[4 * 33], s[5 * 33]); o.w = pk2(s[6 * 33], s[7 * 33]);
        *(u32x4*)(WT + (size_t)(row0 + n) * K + k0 + 8 * c) = o; }
    WAVE_LDS_SYNC();
}

DEV void phase_prologue_a(const Frame& F0) {
    const Frame F = refresh(F0);
    LAS float* scr = (LAS float*)(F.lds + F.wave * 16384);
    for (int l = 0; l < DEPTH; ++l) {
        const int odd = l & 1, li = l >> 1;
        const float* win = odd ? GIN(I_ODWIN) + (size_t)li * 1024 * 2576 : GIN(I_EVWIN) + (size_t)li * 1024 * 4112;
        const int ldw = odd ? 2576 : 4112, nin = odd ? NIN_O : NIN_E;
        bf16_t* wint = (bf16_t*)(F.ws + WS_WIN) + (size_t)l * NINMAX * 1024;
        for (int it = F.gw; it < 16 * (nin / 32); it += F.NGW) { const int kb = it / (nin / 32), nb = it % (nin / 32); const int d0 = 32 * nb;
            tr_item(win, ldw, d0 < 2048 ? d0 : d0 + 16, 64 * kb, wint, 1024, d0, scr, F.lane); }
        const float* wout = odd ? GIN(I_ODWOUT) + (size_t)li * 1024 * 1024 : GIN(I_EVWOUT) + (size_t)li * 1024 * 1024;
        bf16_t* woutt = (bf16_t*)(F.ws + WS_WOUT) + (size_t)l * 1024 * 1024;
        for (int it = F.gw; it < 16 * 32; it += F.NGW) { const int kb = it / 32, nb = it % 32; tr_item(wout, 1024, 32 * nb, 64 * kb, woutt, 1024, 32 * nb, scr, F.lane); }
        if (odd) {
            const float* wglu = GIN(I_ODWGLU) + (size_t)li * 512 * 512; bf16_t* wglut = (bf16_t*)(F.ws + WS_WGLU) + (size_t)li * 512 * 512;
            for (int it = F.gw; it < 8 * 16; it += F.NGW) { const int kb = it / 16, nb = it % 16; tr_item(wglu, 512, 32 * nb, 64 * kb, wglut, 512, 32 * nb, scr, F.lane); }
        }
        constexpr int GU_NB = 2 * FF / 32, GU_ITEMS = 16 * GU_NB;
        for (int it = F.gw; it < NE * GU_ITEMS; it += F.NGW) { const int e = it / GU_ITEMS, r = it % GU_ITEMS, kb = r / GU_NB, nb = r % GU_NB; const int d0 = 32 * nb, j = d0 >> 8, w = d0 & 255;
            const float* src = (w < 128 ? GIN(I_WGATE) : GIN(I_WUP)) + ((size_t)l * NE + e) * 1024 * FF;
            tr_item(src, FF, 128 * j + (w & 127), 64 * kb, (bf16_t*)(F.ws + WS_WGU) + ((size_t)l * NE + e) * 2 * FF * 1024, 1024, d0, scr, F.lane); }
        constexpr int D_ITEMS = (FF / 64) * 32;
        for (int it = F.gw; it < NE * D_ITEMS; it += F.NGW) { const int e = it / D_ITEMS, r = it % D_ITEMS, kb = r / 32, nb = r % 32;
            tr_item(GIN(I_WDOWN) + ((size_t)l * NE + e) * FF * 1024, 1024, 32 * nb, 64 * kb, (bf16_t*)(F.ws + WS_WD) + ((size_t)l * NE + e) * 1024 * FF, FF, 32 * nb, scr, F.lane); }
    }
    const int gt = F.bid * NTHREADS + F.tid, NGT = F.G * NTHREADS;
    for (int i = gt; i < DEPTH * 16 * 1024; i += NGT) { const int l = i / 16384, g = (i >> 10) & 15, k = i & 1023; const int odd = l & 1, li = l >> 1;
        ((float*)(F.ws + WS_WG))[i] = odd ? GIN(I_ODWIN)[((size_t)li * 1024 + k) * 2576 + 2048 + g] : GIN(I_EVWIN)[((size_t)li * 1024 + k) * 4112 + 2048 + g]; }
    for (int i = gt; i < DEPTH * NE * 1024; i += NGT) { const int k = i & 1023, e = (i >> 10) % NE, l = i / (NE * 1024); ((float*)(F.ws + WS_WR))[i] = GIN(I_WROUTER)[((size_t)l * 1024 + k) * NE + e]; }
    for (int i = gt; i < N_ODD * 2 * 32 * 64; i += NGT) { const int p = i & 63, g = (i >> 6) & 31, d = (i >> 11) & 1, o = i >> 12;
        const int idx = ((o * 2 + d) * 32 + g) * 64 + p;
        const float lr = fminf(GIN(I_ODLRE)[idx], -1e-4f), li_ = GIN(I_ODLIM)[idx], dt = expf(GIN(I_ODLDT)[(o * 2 + d) * 32 + g]);
        const float mag = expf(lr * dt); float sn, cs; sincosf(li_ * dt, &sn, &cs); const float are = mag * cs, aim = mag * sn;
        float* A = (float*)(F.ws + WS_S5A) + (size_t)((o * 2 + d) * 32 + g) * 128; A[p] = are; A[64 + p] = aim;
        const float xr = are - 1.0f, xi = aim, den = lr * lr + li_ * li_; const float fre = (xr * lr + xi * li_) / den, fim = (xi * lr - xr * li_) / den;
        bf16_t* Bb = (bf16_t*)(F.ws + WS_S5B) + (size_t)((o * 2 + d) * 32 + g) * 128 * 16;
        for (int h = 0; h < 16; ++h) { const float br = GIN(I_ODBRE)[((size_t)(o * 32 + g) * 64 + p) * 16 + h], bi = GIN(I_ODBIM)[((size_t)(o * 32 + g) * 64 + p) * 16 + h];
            Bb[p * 16 + h] = (bf16_t)f2bf(fre * br - fim * bi); Bb[(64 + p) * 16 + h] = (bf16_t)f2bf(fre * bi + fim * br); } }
    for (int i = gt; i < N_ODD * 32 * 16 * 64; i += NGT) { const int p = i & 63, c = (i >> 6) & 15, g = (i >> 10) & 31, o = i >> 15;
        bf16_t* Cm = (bf16_t*)(F.ws + WS_S5C) + (size_t)((o * 32 + g) * 16 + c) * 128;
        Cm[2 * p] = (bf16_t)f2bf(GIN(I_ODCRE)[i]); Cm[2 * p + 1] = (bf16_t)f2bf(-GIN(I_ODCIM)[i]); }
    ROW_LOOP(r, MPAD) {
        f32x4* dst = (f32x4*)((float*)(F.ws + WS_H) + (size_t)r * 1024) + F.lane;
        if (r < MROWS) { }
        else {
#pragma unroll
            for (int j = 0; j < 4; ++j) dst[64 * j] = (f32x4){0.f, 0.f, 0.f, 0.f};
            u32x4* xz = (u32x4*)((bf16_t*)(F.ws + WS_XIN) + (size_t)r * 1024) + F.lane; xz[0] = (u32x4){0u, 0u, 0u, 0u}; xz[64] = (u32x4){0u, 0u, 0u, 0u};
            u32x4* mz = (u32x4*)((bf16_t*)(F.ws + WS_MERGED) + (size_t)r * 1024) + F.lane; mz[0] = (u32x4){0u, 0u, 0u, 0u}; mz[64] = (u32x4){0u, 0u, 0u, 0u};
            u32x4* yz = (u32x4*)((bf16_t*)(F.ws + WS_YS) + (size_t)r * 512) + F.lane; yz[0] = (u32x4){0u, 0u, 0u, 0u};
        }
    }
    __syncthreads();
    LAS float* sv = (LAS float*)F.lds;
    LAS float* part = (LAS float*)(F.lds + 32768);
    for (int i = F.tid; i < NR * 1024; i += NTHREADS) { const int r = i >> 10, k = i & 1023; const float c = r < B_ ? GIN(I_C)[r * 1024 + k] : GIN(I_CCTX)[k]; sv[i] = silu_f(c); }
    __syncthreads();
    for (int it = F.bid; it < DEPTH * 96; it += F.G) {
        const int l = it / 96, j = (it % 96) * 64 + F.lane;
        const float* w = GIN(I_WMOD) + (size_t)l * 1024 * 6144 + j;
        float acc[NR];
#pragma unroll
        for (int r = 0; r < NR; ++r) acc[r] = 0.f;
        const int k0 = F.wave * 128;
#pragma unroll 8
        for (int k = 0; k < 128; ++k) { const float wv = w[(size_t)(k0 + k) * 6144];
#pragma unroll
            for (int r = 0; r < NR; ++r) acc[r] += sv[r * 1024 + k0 + k] * wv; }
#pragma unroll
        for (int r = 0; r < NR; ++r) part[(F.wave * NR + r) * 64 + F.lane] = acc[r];
        __syncthreads();
        for (int i = F.tid; i < NR * 64; i += NTHREADS) { const int r = i >> 6, jj = i & 63; float s = 0.f;
#pragma unroll
            for (int w8 = 0; w8 < 8; ++w8) s += part[(w8 * NR + r) * 64 + jj];
            const int col = (it % 96) * 64 + jj;
            ((float*)(F.ws + WS_MOD))[((size_t)l * NR + r) * 6144 + col] = s + GIN(I_BMOD)[l * 6144 + col]; }
        __syncthreads();
    }
}

static_assert(TOK % 4 == 0 && CTX % 4 == 0 && MROWS % 4 == 0, "row groups");
#define ROW_GROUPS(nrows, CALL4, CALL2) do { const int _r4 = ((nrows) / (4 * F.NGW)) * (4 * F.NGW); \
    for (int r = 4 * F.gw; r < _r4; r += 4 * F.NGW) { CALL4; } for (int r = _r4 + 2 * F.gw; r < (nrows); r += 2 * F.NGW) { CALL2; } } while (0)
template <int RG> DEV void xg_rows(const Frame& F, int l, int row0, f32x4 (&v)[RG][4]) {
    int b, s; row_bs(row0, b, s); const int mr = s < CTX ? B_ : b;
    const float* mod = (const float*)(F.ws + WS_MOD) + ((size_t)l * NR + mr) * 6144;
#pragma unroll
    for (int j = 0; j < 4; ++j) { const f32x4 sh = *((const f32x4*)mod + F.lane + 64 * j), sc = *((const f32x4*)(mod + 1024) + F.lane + 64 * j);
#pragma unroll
        for (int q = 0; q < RG; ++q) v[q][j] = v[q][j] * (1.0f + sc) + sh; }
#pragma unroll
    for (int q = 0; q < RG; ++q) { u32x2* xo = (u32x2*)((bf16_t*)(F.ws + WS_XIN) + (size_t)(row0 + q) * 1024) + F.lane;
#pragma unroll
        for (int j = 0; j < 4; ++j) xo[64 * j] = (u32x2){pk2(v[q][j].x, v[q][j].y), pk2(v[q][j].z, v[q][j].w)}; }
    const float* wg = (const float*)(F.ws + WS_WG) + (size_t)l * 16 * 1024;
    float mine[RG]; const int gi = F.lane & 15;
#pragma unroll
    for (int q = 0; q < RG; ++q) mine[q] = 0.f;
    f32x4 wc[4];
#pragma unroll
    for (int j = 0; j < 4; ++j) wc[j] = *((const f32x4*)wg + F.lane + 64 * j);
#pragma unroll 1
    for (int g = 0; g < 16; ++g) { f32x4 wn[4]; const int gn = g + 1 < 16 ? g + 1 : g;
#pragma unroll
        for (int j = 0; j < 4; ++j) wn[j] = *((const f32x4*)(wg + gn * 1024) + F.lane + 64 * j);
#pragma unroll
        for (int q = 0; q < RG; ++q) { float p = 0.f;
#pragma unroll
            for (int j = 0; j < 4; ++j) p += v[q][j].x * wc[j].x + v[q][j].y * wc[j].y + v[q][j].z * wc[j].z + v[q][j].w * wc[j].w;
            const float t = wave_sum(p); mine[q] = (gi == g) ? t : mine[q]; }
#pragma unroll
        for (int j = 0; j < 4; ++j) wc[j] = wn[j]; }
    const int ty = gi >> 2, hh = gi & 3, li = l >> 1;
#pragma unroll
    for (int q = 0; q < RG; ++q) { float o;
        if (!(l & 1)) {
            if (ty < 2) o = -expf(GIN(I_EVALOG)[(li * 2 + ty) * 4 + hh]) * softplus_f(mine[q] + GIN(I_EVDTB)[(li * 2 + ty) * 4 + hh]);
            else o = sigmoid_f(mine[q]);
        } else {
            const int d = ty & 1, k = ty >> 1; const float gb = GIN(I_ODGB)[((li * 2 + d) * 2 + k) * 4 + hh];
            o = k ? -softplus_f(-(mine[q] + gb)) : mine[q] + gb;
        }
        if (F.lane < 16) ((float*)(F.ws + WS_GATES))[(size_t)(row0 + q) * 16 + gi] = o; }
}

template <int RG> DEV void xg0_group(const Frame& F, int r) {
        f32x4 v[RG][4];
#pragma unroll
        for (int q = 0; q < RG; ++q) { const f32x4* hr = (const f32x4*)HROW(F, 0, r + q) + F.lane;
#pragma unroll
            for (int j = 0; j < 4; ++j) v[q][j] = hr[64 * j]; }
        xg_rows<RG>(F, 0, r, v);
    }
DEV void phase_xg0(const Frame& F0) {
    const Frame F = refresh(F0);
    ROW_GROUPS(MROWS, xg0_group<4>(F, r), xg0_group<2>(F, r));
}

template <int RG> DEV void prep_group(const Frame& F, int l, int r) {

    const int odd = l & 1, li = l >> 1; const int nin = odd ? NIN_O : NIN_E, nseg = odd ? 2 : 3, qld = odd ? 1024 : 1536;
    const bf16_t* P = (const bf16_t*)(F.ws + WS_P); bf16_t* Q = (bf16_t*)(F.ws + WS_QKV);
    const float* cw = odd ? GIN(I_ODCONV) + (size_t)li * 9 * 1024 : GIN(I_EVCONV) + (size_t)li * 9 * 1536; const int cch = odd ? 1024 : 1536;
    {
        int b, s; row_bs(r, b, s); const bool lat = s >= CTX; const int rr = lat ? (s - CTX) >> 6 : 0, cc = lat ? (s - CTX) & 63 : s;
        const int ncol = lat ? 64 : CTX;
        for (int seg = 0; seg < nseg; ++seg) {
            const int ch0 = seg * 512 + F.lane * 8; float a[RG][8];
#pragma unroll
            for (int q = 0; q < RG; ++q)
#pragma unroll
                for (int i = 0; i < 8; ++i) a[q][i] = 0.f;
#pragma unroll
            for (int kh = 0; kh < 3; ++kh) {
                const int r2 = rr + kh - 1; const bool rok = lat ? (r2 >= 0 && r2 < SEQ / 64) : (kh == 1); const int r2c = rok ? r2 : rr;
                f32x4 w0[3], w1[3];
#pragma unroll
                for (int kw = 0; kw < 3; ++kw) { w0[kw] = *(const f32x4*)(cw + (kh * 3 + kw) * cch + ch0); w1[kw] = *(const f32x4*)(cw + (kh * 3 + kw) * cch + ch0 + 4); }
                const int rowbase = lat ? b * SEQ + r2c * 64 : LATR + b * CTX;
                u32x4 pv[RG + 2];
#pragma unroll
                for (int dc = 0; dc < RG + 2; ++dc) { const int c2 = cc - 1 + dc; const bool ok = rok && c2 >= 0 && c2 < ncol; const int c2c = ok ? c2 : cc;
                    const u32x4 t4 = *(const u32x4*)(P + (size_t)(rowbase + c2c) * nin + ch0); pv[dc] = ok ? t4 : (u32x4){0u, 0u, 0u, 0u}; }
#pragma unroll
                for (int dc = 0; dc < RG + 2; ++dc) {
                    const float x0 = bflo(pv[dc].x), x1 = bfhi(pv[dc].x), x2 = bflo(pv[dc].y), x3 = bfhi(pv[dc].y), x4 = bflo(pv[dc].z), x5 = bfhi(pv[dc].z), x6 = bflo(pv[dc].w), x7 = bfhi(pv[dc].w);
#pragma unroll
                    for (int q = 0; q < RG; ++q) { const int kw = dc - q;
                        if (kw >= 0 && kw <= 2) { a[q][0] += x0 * w0[kw].x; a[q][1] += x1 * w0[kw].y; a[q][2] += x2 * w0[kw].z; a[q][3] += x3 * w0[kw].w;
                            a[q][4] += x4 * w1[kw].x; a[q][5] += x5 * w1[kw].y; a[q][6] += x6 * w1[kw].z; a[q][7] += x7 * w1[kw].w; } } }
            }
#pragma unroll
            for (int q = 0; q < RG; ++q) {
                float ss = 0.f;
#pragma unroll
                for (int i = 0; i < 8; ++i) { a[q][i] = fast_silu(a[q][i]); ss += a[q][i] * a[q][i]; }
                float sc = 1.0f;
                if (!odd) { if (seg < 2) { ss = group_sum<16>(ss); sc = 1.0f / sqrtf(ss + 1e-6f); if (seg == 0) sc *= HD_SCALE; } }
                else if (seg == 1) sc = HD_SCALE;
                u32x4 o; o.x = pk2(a[q][0] * sc, a[q][1] * sc); o.y = pk2(a[q][2] * sc, a[q][3] * sc); o.z = pk2(a[q][4] * sc, a[q][5] * sc); o.w = pk2(a[q][6] * sc, a[q][7] * sc);
                *(u32x4*)(Q + (size_t)(r + q) * qld + ch0) = o;
            }
        }
    }
}
DEV void phase_prep(const Frame& F0, int l) {
    const Frame F = refresh(F0);
    const int odd = l & 1;
    ROW_GROUPS(MROWS, prep_group<4>(F, l, r), prep_group<2>(F, l, r));

    if (odd) {
        const float* GT = (const float*)(F.ws + WS_GATES); float* MC = (float*)(F.ws + WS_MCH);
        for (int c = F.gw; c < B_ * 4 * 2; c += F.NGW) { const int d = c & 1, hh = (c >> 1) & 3, b = c >> 3; float m = 0.f;
            for (int n = 0; n < NCH; ++n) { const int row = tok_row(b, d, n * 64 + F.lane);
                const float lin = GT[(size_t)row * 16 + d * 4 + hh], lf = GT[(size_t)row * 16 + 8 + d * 4 + hh];
                const float bc = wave_scan_add(lf);
                const float bend = bcast_lane_f(bc, 63); const float amax = wave_max(bend - bc + lin);
                if (F.lane == 0) MC[(size_t)c * NCH + n] = m;
                m = fmaxf(bend + m, amax); }
        }
    }
}

DEV int swz256(int r, int k) { return r * 256 + 16 * (k ^ (r & 15)); }
DEV int swz128(int r, int k) { return r * 128 + 16 * (k ^ ((r >> 1) & 7)); }
constexpr int CL_IMG = 90112;
struct ClProb { int n, d, hh, b, kind, qld, vld; const bf16_t *qsrc, *ksrc, *vsrc; float kscale; };
DEV ClProb cl_decode(const Frame& F, int p, int odd, int nhh) {
    ClProb c; c.n = p % NCH; c.d = (p / NCH) & 1; c.hh = (p / (2 * NCH)) % nhh; c.b = p / (2 * NCH * nhh); c.kind = odd ? 2 : (c.hh < 4 ? 0 : 1); c.kscale = 1.0f;
    const bf16_t* P = (const bf16_t*)(F.ws + WS_P); const bf16_t* Q = (const bf16_t*)(F.ws + WS_QKV);
    if (c.kind == 0) { c.qsrc = Q + c.hh * 128; c.ksrc = Q + 512 + c.hh * 128; c.vsrc = Q + 1024 + c.hh * 128; c.qld = 1536; c.vld = 1536; }
    else if (c.kind == 1) { c.qsrc = P + 2048 + (c.hh - 4) * 128; c.ksrc = P + 2560 + (c.hh - 4) * 128; c.vsrc = P + 3072 + (c.hh - 4) * 128; c.qld = NIN_E; c.vld = NIN_E; c.kscale = HD_SCALE; }
    else { c.qsrc = Q + c.hh * 128; c.ksrc = Q + 512 + c.hh * 128; c.vsrc = P + 1024 + c.hh * 128; c.qld = 1024; c.vld = NIN_O; }
    return c;
}
DEV void cl_dma(const Frame& F, const ClProb c) {
    int ln = F.lane; LAUNDER(ln);
    const int r0 = tok_row(c.b, c.d, c.n * 64), sg = c.d ? -1 : 1; const int per = c.kind == 0 ? 6 : 4;
#pragma unroll
    for (int i = 0; i < 6; ++i) if (i < per) { const int ch = F.wave * per + i, reg = ch >> 4, cc = ch & 15, r = 4 * cc + (ln >> 4), kk = (ln & 15) ^ (r & 15);
        const bf16_t* src = reg == 0 ? c.qsrc : (reg == 1 ? c.ksrc : c.vsrc); const int ld = reg == 2 ? c.vld : c.qld;
        glds16((const GAS char*)(src + (size_t)(r0 + sg * r) * ld + 8 * kk), F.lds + CL_IMG + reg * 16384 + 1024 * cc); }
}
DEV void seq_s5_item(const Frame& F, int l, int item, int which);
DEV void phase_cl(const Frame& F0, int l) {
    const Frame F = refresh(F0);
    const int odd = l & 1; const int nhh = odd ? 4 : 8; const int nprob = B_ * nhh * 2 * NCH;
    if (odd) {
        for (int it = F.bid; it < B_ * 2 * 32; it += F.G) { seq_s5_item(F, l, it, 0); __syncthreads(); }
    }
    LAS float* gc = (LAS float*)(F.lds);
    LAS float* bt = (LAS float*)(F.lds + 256);
    LAS float* qs = (LAS float*)(F.lds + 768);
    LAS float* ks = (LAS float*)(F.lds + 1024);
    LAS float* mt = (LAS float*)(F.lds + 1280);
    LAS float* rsp = (LAS float*)(F.lds + 2048);
    LAS float* Am = (LAS float*)(F.lds + 4096);
    LAS bf16_t* An = (LAS bf16_t*)(F.lds + 20480);
    LAS bf16_t* XT = (LAS bf16_t*)(F.lds + 30720);
    LAS float* Rb = (LAS float*)(F.lds + 69632 + F.wave * 2048);
    LAS float* ksp = (LAS float*)(F.lds + 86016);
    LAS unsigned char* IQ = F.lds + CL_IMG; LAS unsigned char* IK = IQ + 16384; LAS unsigned char* IV = IQ + 32768;
    const float* GT = (const float*)(F.ws + WS_GATES);
    float gq = 0.f, bq = 0.f, mq = 0.f;
#define CL_GATES(pp) do { const ClProb cn = cl_decode(F, (pp), odd, nhh); const int rown = tok_row(cn.b, cn.d, cn.n * 64 + F.lane); \
        if (cn.kind == 0) { gq = GT[(size_t)rown * 16 + cn.d * 4 + cn.hh]; bq = GT[(size_t)rown * 16 + 8 + cn.d * 4 + cn.hh]; } \
        else if (cn.kind == 2) { bq = GT[(size_t)rown * 16 + cn.d * 4 + cn.hh]; gq = GT[(size_t)rown * 16 + 8 + cn.d * 4 + cn.hh]; \
            mq = ((const float*)(F.ws + WS_MCH))[(size_t)((cn.b * 4 + cn.hh) * 2 + cn.d) * NCH + cn.n]; } } while (0)
    if (F.bid < nprob) { cl_dma(F, cl_decode(F, F.bid, odd, nhh)); if (F.wave == 0) CL_GATES(F.bid); }
    for (int p = F.bid; p < nprob; p += F.G) {
        int lz = F.lane; LAUNDER(lz); const int h = lz >> 5, l31 = lz & 31;
        const ClProb c = cl_decode(F, p, odd, nhh); const int n = c.n, d = c.d, hh = c.hh, b = c.b, kind = c.kind; const float kscale = c.kscale;
        float* CS = (float*)(F.ws + WS_CLS) + (size_t)p * 512;
        if (F.wave == 0) {
            const int i = F.lane;
            float g = gq, be = bq;
            if (kind == 1) { g = log1pf(-exp2f(-(5.0f + 2.0f * (float)(hh - 4) + (float)d))); be = 0.f; }
            const float cum = wave_scan_add(g);
            const float gend = bcast_lane_f(cum, 63);
            gc[i] = cum; bt[i] = be;
            if (kind < 2) { qs[i] = expf(cum); ks[i] = expf(gend - cum) * kscale; if (i == 0) CS[0] = expf(gend); }
            else {
                const float mprev = mq;
                const float a = gend - cum + be; const float amax = wave_max(a); const float mnew = fmaxf(gend + mprev, amax);
                ks[i] = expf(a - mnew);
                const float pm = wave_scan_max(be - cum);
                const float mti = cum + fmaxf(mprev, pm); mt[i] = mti; qs[i] = expf(cum + mprev - mti);
                CS[128 + i] = expf(-mti);
                if (i == 0) CS[0] = expf(gend + mprev - mnew);
            }
        }
        WAIT_VM(0);
        __syncthreads();
        {
            const int w4 = F.wave & 3, mt_ = w4 >> 1, nt_ = w4 & 1; const bool doY = F.wave >= 4;
            if (!doY || kind == 0) {
                const int rj = 32 * mt_ + l31, ri = 32 * nt_ + l31; LAS unsigned char* IB = doY ? IK : IQ;
                f32x16 acc;
#pragma unroll
                for (int r = 0; r < 16; ++r) acc[r] = 0.f;
                bf16x8 af[8], bfr[8];
#pragma unroll
                for (int s = 0; s < 8; ++s) { af[s] = *(const LAS bf16x8*)(IK + swz256(rj, 2 * s + h)); bfr[s] = *(const LAS bf16x8*)(IB + swz256(ri, 2 * s + h)); }
#pragma unroll
                for (int s = 0; s < 8; ++s) acc = mfma32(af[s], bfr[s], acc);
                const int i = ri; const float gi = gc[i];
                if (!doY) {
                    bf16_t* AQ = (bf16_t*)(F.ws + WS_CLA) + (size_t)p * 4096 + (size_t)i * 64; float rsum = 0.f; const float mti = kind == 2 ? mt[i] : 0.f;
#pragma unroll
                    for (int g4 = 0; g4 < 4; ++g4) { float v[4];
#pragma unroll
                        for (int r = 0; r < 4; ++r) { const int j = 32 * mt_ + 8 * g4 + 4 * h + r; float e;
                            if (kind < 2) e = fast_exp(fminf(gi - gc[j], 0.f)); else e = fast_exp(gi - gc[j] + bt[j] - mti);
                            v[r] = (i >= j) ? acc[4 * g4 + r] * kscale * e : 0.f; rsum += v[r]; }
                        *(u32x2*)(AQ + 32 * mt_ + 8 * g4 + 4 * h) = (u32x2){pk2_sw(v[0], v[1]), pk2_sw(v[2], v[3])}; }
                    if (kind == 2) rsp[i * 4 + mt_ * 2 + h] = rsum;
                } else {
                    const float bi = bt[i];
#pragma unroll
                    for (int r = 0; r < 16; ++r) { const int j = 32 * mt_ + 8 * (r >> 2) + 4 * h + (r & 3);
                        const float av = (i > j) ? bi * acc[r] * fast_exp(fminf(gi - gc[j], 0.f)) : 0.f;
                        Am[i * 64 + j] = av; An[i * 72 + j] = (bf16_t)f2bf_sw(-av); }
                }
            }
        }
        __syncthreads();
        int lz2 = F.lane; LAUNDER(lz2); const int l15 = lz2 & 15, kg = lz2 >> 4; const bool isw = F.wave >= 4;
        float rhsv[4][2][4];
        {
            const int tz = F.wave * 64 + lz2; const int cq = tz & 127, q4 = tz >> 7; bf16_t* QD = (bf16_t*)(F.ws + WS_CLQ) + (size_t)p * 8192 + cq;
            for (int i = 16 * q4; i < 16 * q4 + 16; ++i) QD[i * 128] = (bf16_t)f2bf_sw(bf2f(*(const LAS bf16_t*)(IQ + swz256(i, cq >> 3) + 2 * (cq & 7))) * qs[i]);
            bf16_t* KT = (bf16_t*)(F.ws + WS_CLK) + (size_t)p * 8192 + (size_t)cq * 64;
            float ksum = 0.f;
            for (int j8 = 2 * q4; j8 < 2 * q4 + 2; ++j8) { float v[8];
#pragma unroll
                for (int r = 0; r < 8; ++r) { const int j = 8 * j8 + r; v[r] = bf2f(*(const LAS bf16_t*)(IK + swz256(j, cq >> 3) + 2 * (cq & 7))) * ks[j]; ksum += v[r]; }
                *(u32x4*)(KT + 8 * j8) = (u32x4){pk2_sw(v[0], v[1]), pk2_sw(v[2], v[3]), pk2_sw(v[4], v[5]), pk2_sw(v[6], v[7])}; }
            ksp[cq * 4 + q4] = ksum;
            if (kind == 2 && tz < 64) CS[64 + tz] = (rsp[tz * 4] + rsp[tz * 4 + 1]) + (rsp[tz * 4 + 2] + rsp[tz * 4 + 3]);
            if (kind == 0) { LAS unsigned char* IS = isw ? IK : IV;
#pragma unroll
                for (int bb = 0; bb < 4; ++bb)
#pragma unroll
                    for (int nt2 = 0; nt2 < 2; ++nt2)
#pragma unroll
                        for (int r = 0; r < 4; ++r) { const int i = 16 * bb + 4 * kg + r, cc = (32 * F.wave + 16 * nt2 + l15) & 127;
                            rhsv[bb][nt2][r] = bt[i] * bf2f(*(const LAS bf16_t*)(IS + swz256(i, cc >> 3) + 2 * (cc & 7))) * (isw ? qs[i] : 1.0f); } }
        }
        __syncthreads();
        if (p + F.G < nprob) { cl_dma(F, cl_decode(F, p + F.G, odd, nhh)); if (F.wave == 0) CL_GATES(p + F.G); }
        if (kind == 2 && F.tid < 128) CS[256 + F.tid] = (ksp[F.tid * 4] + ksp[F.tid * 4 + 1]) + (ksp[F.tid * 4 + 2] + ksp[F.tid * 4 + 3]);
        if (kind == 0) {
            const int pg = ((b * 4 + hh) * 2 + d) * NCH + n;
            bf16_t* U = (bf16_t*)(F.ws + WS_CLU) + (size_t)pg * 8192; bf16_t* W = (bf16_t*)(F.ws + WS_CLW) + (size_t)p * 8192;
#pragma unroll
            for (int bb = 0; bb < 4; ++bb) {
#pragma unroll
                for (int nt2 = 0; nt2 < 2; ++nt2) {
                    const int cidx = 32 * F.wave + 16 * nt2 + l15; f32x4 acc;
#pragma unroll
                    for (int r = 0; r < 4; ++r) acc[r] = rhsv[bb][nt2][r];
                    for (int k2 = 0; k2 < 2; ++k2) if (32 * k2 < 16 * bb) {
                        const bool in = 32 * k2 + 8 * kg + 8 <= 16 * bb;
                        bf16x8 a = *(const LAS bf16x8*)(An + (16 * bb + l15) * 72 + 32 * k2 + 8 * kg); if (!in) a = (bf16x8){0, 0, 0, 0, 0, 0, 0, 0};
                        const bf16x8 xb = *(const LAS bf16x8*)(XT + cidx * 72 + 32 * k2 + 8 * kg);
                        acc = mfma16(a, in ? xb : (bf16x8){0, 0, 0, 0, 0, 0, 0, 0}, acc); }
#pragma unroll
                    for (int r = 0; r < 4; ++r) Rb[(4 * kg + r) * 32 + 16 * nt2 + l15] = acc[r];
                }
                WAVE_LDS_SYNC();
                if (F.lane < 32) {
                    const int cidx = 32 * F.wave + F.lane; float x[16];
#pragma unroll
                    for (int i = 0; i < 16; ++i) { float r = Rb[i * 32 + F.lane];
#pragma unroll
                        for (int j = 0; j < i; ++j) r -= Am[(16 * bb + i) * 64 + 16 * bb + j] * x[j];
                        x[i] = r; }
                    if (!isw) {
#pragma unroll
                        for (int i = 0; i < 16; ++i) U[(16 * bb + i) * 128 + cidx] = (bf16_t)f2bf_sw(x[i]); }
                    else {
#pragma unroll
                        for (int i = 0; i < 16; ++i) W[(16 * bb + i) * 128 + (cidx - 128)] = (bf16_t)f2bf_sw(-x[i]); }
                    *(LAS u32x4*)(XT + cidx * 72 + 16 * bb) = (u32x4){pk2_sw(x[0], x[1]), pk2_sw(x[2], x[3]), pk2_sw(x[4], x[5]), pk2_sw(x[6], x[7])};
                    *(LAS u32x4*)(XT + cidx * 72 + 16 * bb + 8) = (u32x4){pk2_sw(x[8], x[9]), pk2_sw(x[10], x[11]), pk2_sw(x[12], x[13]), pk2_sw(x[14], x[15])};
                }
                WAVE_LDS_SYNC();
            }
        }
    }
    WAIT_VM(0);
    __syncthreads();
}

#define LDS_BARRIER() do { WAIT_LGKM(0); S_BARRIER(); COMPILER_FENCE(); } while (0)
constexpr int SQ_W = 0, SQ_Q = 16384, SQ_K = 32768, SQ_A = 49152, SQ_U = 57344, SQ_C = 65536, SQ_STAGE = 67584;
constexpr int SQ_SB = 2 * SQ_STAGE, SQ_VN = SQ_SB + 8704, SQ_NV = SQ_VN + 4608, SQ_DEN = SQ_NV + 512;
static_assert(SQ_DEN + 256 <= LDS_MISC, "SEQ LDS map");
struct SeqCtx { int kind, b, hh, d, sl, chain, vld; const GAS bf16_t* vsrc; int probe; };
template <int KIND>
DEV void seq_dma(const Frame& F, const SeqCtx& C, int n, LAS unsigned char* img) {
    const int p = C.chain * NCH + n, w = F.wave; int ln = F.lane; LAUNDER(ln);
    if (w < 2) {
        if (KIND == 0) { const GAS char* g = (const GAS char*)(F.ws + WS_CLW) + (size_t)p * 16384; LAUNDER_S(g);
#pragma unroll
            for (int i = 0; i < 8; ++i) { const int r = 4 * (8 * w + i) + (ln >> 4), pp = ln & 15; glds16(g + r * 256 + 16 * (pp ^ (r & 15)), img + SQ_W + 1024 * (8 * w + i)); } }
    } else if (w < 4) {
        const GAS char* g = (const GAS char*)(F.ws + WS_CLQ) + (size_t)p * 16384; LAUNDER_S(g);
#pragma unroll
        for (int i = 0; i < 8; ++i) { const int c = 8 * (w - 2) + i, r = 4 * c + (ln >> 4), pp = ln & 15; glds16(g + r * 256 + 16 * (pp ^ (r & 15)), img + SQ_Q + 1024 * c); }
    } else if (w < 6) {
        const GAS char* g = (const GAS char*)(F.ws + WS_CLK) + (size_t)p * 16384; LAUNDER_S(g);
#pragma unroll
        for (int i = 0; i < 8; ++i) { const int c = 8 * (w - 4) + i, r = 8 * c + (ln >> 3), pp = ln & 7; glds16(g + r * 128 + 16 * (pp ^ ((r >> 1) & 7)), img + SQ_K + 1024 * c); }
    } else if (w == 6) {
        const GAS char* g = (const GAS char*)(F.ws + WS_CLA) + (size_t)p * 8192; LAUNDER_S(g);
#pragma unroll
        for (int i = 0; i < 8; ++i) { const int r = 8 * i + (ln >> 3), pp = ln & 7; glds16(g + r * 128 + 16 * (pp ^ ((r >> 1) & 7)), img + SQ_A + 1024 * i); }
    } else {
        if (KIND == 0) { const int pg = ((C.b * 4 + C.hh) * 2 + C.d) * NCH + n; const GAS char* g = (const GAS char*)(F.ws + WS_CLU) + (size_t)pg * 16384 + 64 * C.sl; LAUNDER_S(g);
#pragma unroll
            for (int i = 0; i < 4; ++i) { const int r = 16 * i + (ln >> 2); glds16(g + r * 256 + 16 * (ln & 3), img + SQ_U + 1024 * i); }
        } else { const int r0 = tok_row(C.b, C.d, n * 64); const long st = C.d ? -(long)C.vld * 2 : (long)C.vld * 2;
            const GAS char* g = (const GAS char*)C.vsrc + (long)r0 * C.vld * 2 + 64 * C.sl; LAUNDER_S(g);
#pragma unroll
            for (int i = 0; i < 4; ++i) { const int r = 16 * i + (ln >> 2); glds16(g + (long)r * st + 16 * (ln & 3), img + SQ_U + 1024 * i); }
        }
        const GAS char* cs = (const GAS char*)(F.ws + WS_CLS) + (size_t)p * 2048; LAUNDER_S(cs);
        glds16(cs + 16 * ln, img + SQ_C);
        if (KIND == 2) glds16(cs + 1024 + 16 * ln, img + SQ_C + 1024);
    }
}
#define SEQ_WAIT_DMA(younger) do { if ((younger) == 16) WAIT_VM(16); else WAIT_VM(0); } while (0)
template <int KIND>
DEV void seq_step(const Frame& F, const SeqCtx& C, int n, f32x16& acc, LAS unsigned char* lds) {
    int lz = F.lane; LAUNDER(lz); const int h = lz >> 5, l31 = lz & 31;
    LAS unsigned char* img = lds + (n & 1) * SQ_STAGE; LAS unsigned char* nimg = lds + ((n + 1) & 1) * SQ_STAGE;
    LAS bf16_t* Sb = (LAS bf16_t*)(lds + SQ_SB); LAS bf16_t* Vn = (LAS bf16_t*)(lds + SQ_VN); LAS float* nvec = (LAS float*)(lds + SQ_NV); LAS float* den = (LAS float*)(lds + SQ_DEN);
    const LAS float* CS = (const LAS float*)(img + SQ_C);
    if (C.probe != 3) seq_dma<KIND>(F, C, C.probe == 2 ? 0 : (n + 1 < NCH ? n + 1 : NCH - 1), nimg);
    if (F.wave < 2) {
        const int mt_ = F.wave;
#pragma unroll
        for (int r = 0; r < 16; ++r) acc[r] = bf2f(*(const LAS bf16_t*)(img + SQ_U + (32 * mt_ + 8 * (r >> 2) + 4 * h + (r & 3)) * 64 + 2 * l31));
        if (KIND == 0) {
            bf16x8 sb[8], wf[8]; const int rr = 32 * mt_ + l31;
#pragma unroll
            for (int s = 0; s < 8; ++s) { sb[s] = *(const LAS bf16x8*)(Sb + l31 * 136 + 16 * s + 8 * h); wf[s] = *(const LAS bf16x8*)(img + SQ_W + swz256(rr, 2 * s + h)); }
#pragma unroll
            for (int s = 0; s < 8; ++s) acc = mfma32(wf[s], sb[s], acc);
        }
#pragma unroll
        for (int g4 = 0; g4 < 4; ++g4) *(LAS u32x2*)(Vn + l31 * 72 + 32 * mt_ + 8 * g4 + 4 * h) = (u32x2){pk2(acc[4 * g4], acc[4 * g4 + 1]), pk2(acc[4 * g4 + 2], acc[4 * g4 + 3])};
    } else if (F.wave < 4) {
        const int rr = 32 * (F.wave - 2) + l31;
#pragma unroll
        for (int r = 0; r < 16; ++r) acc[r] = 0.f;
        bf16x8 sb[8], qf[8];
#pragma unroll
        for (int s = 0; s < 8; ++s) { sb[s] = *(const LAS bf16x8*)(Sb + l31 * 136 + 16 * s + 8 * h); qf[s] = *(const LAS bf16x8*)(img + SQ_Q + swz256(rr, 2 * s + h)); }
#pragma unroll
        for (int s = 0; s < 8; ++s) acc = mfma32(qf[s], sb[s], acc);
    } else if (KIND == 2) {
        const int t = F.tid - 256, i = t >> 2, q = t & 3; float s = 0.f;
#pragma unroll
        for (int c8 = 0; c8 < 4; ++c8) { const u32x4 w = *(const LAS u32x4*)(img + SQ_Q + swz256(i, 4 * q + c8)); const LAS float* nv = nvec + 32 * q + 8 * c8;
            s += bflo(w.x) * nv[0] + bfhi(w.x) * nv[1] + bflo(w.y) * nv[2] + bfhi(w.y) * nv[3] + bflo(w.z) * nv[4] + bfhi(w.z) * nv[5] + bflo(w.w) * nv[6] + bfhi(w.w) * nv[7]; }
        s = group_sum<4>(s);
        if (q == 0) den[i] = fmaxf(fabsf(CS[64 + i] + s), CS[128 + i]);
    }
    LDS_BARRIER();
    if (F.wave >= 2 && F.wave < 4) {
        const int mt_ = F.wave - 2, rr = 32 * mt_ + l31;
        bf16x8 vb[4], af[4];
#pragma unroll
        for (int s = 0; s < 4; ++s) { vb[s] = *(const LAS bf16x8*)(Vn + l31 * 72 + 16 * s + 8 * h); af[s] = *(const LAS bf16x8*)(img + SQ_A + swz128(rr, 2 * s + h)); }
#pragma unroll
        for (int s = 0; s < 4; ++s) acc = mfma32(af[s], vb[s], acc);
        const int r0 = tok_row(C.b, C.d, n * 64); const long st = C.d ? -2048l : 2048l;
        GAS char* Ob = (GAS char*)(F.ws + WS_O) + ((size_t)C.d * MROWS + r0) * 2048 + (long)(32 * mt_) * st; LAUNDER_S(Ob); const long lo = (long)(4 * h) * st + (long)((C.hh * 128 + 32 * C.sl + l31) * 2);
#pragma unroll
        for (int r = 0; r < 16; ++r) { const int i = 32 * mt_ + 8 * (r >> 2) + 4 * h + (r & 3); float v = acc[r];
            if (KIND == 2) v = v / den[i];
            if (!C.probe) *(GAS bf16_t*)(Ob + (long)(8 * (r >> 2) + (r & 3)) * st + lo) = (bf16_t)f2bf(v); }
        SEQ_WAIT_DMA(16);
    } else if (F.wave >= 4) {
        const int kb = F.wave - 4, rr = 32 * kb + l31; const float ge = CS[0];
        bf16x8 vb[4], kf[4];
#pragma unroll
        for (int s = 0; s < 4; ++s) { vb[s] = *(const LAS bf16x8*)(Vn + l31 * 72 + 16 * s + 8 * h); kf[s] = *(const LAS bf16x8*)(img + SQ_K + swz128(rr, 2 * s + h)); }
#pragma unroll
        for (int r = 0; r < 16; ++r) acc[r] *= ge;
#pragma unroll
        for (int s = 0; s < 4; ++s) acc = mfma32(kf[s], vb[s], acc);
#pragma unroll
        for (int g4 = 0; g4 < 4; ++g4) *(LAS u32x2*)(Sb + l31 * 136 + 32 * kb + 8 * g4 + 4 * h) = (u32x2){pk2(acc[4 * g4], acc[4 * g4 + 1]), pk2(acc[4 * g4 + 2], acc[4 * g4 + 3])};
        if (KIND == 2 && F.tid < 256 + 128) { const int dd = F.tid - 256; nvec[dd] = ge * nvec[dd] + CS[256 + dd]; }
        SEQ_WAIT_DMA(0);
    } else SEQ_WAIT_DMA(0);
    LDS_BARRIER();
}
template <int KIND>
DEV void seq_kind_loop(const Frame& F, const SeqCtx& C, LAS unsigned char* lds) {
    f32x16 acc;
#pragma unroll
    for (int r = 0; r < 16; ++r) acc[r] = 0.f;
    seq_dma<KIND>(F, C, 0, lds);
    WAIT_VM(0);
    LDS_BARRIER();
    for (int n = 0; n < NCH; ++n) seq_step<KIND>(F, C, n, acc, lds);
}
DEV void seq_linear_item(const Frame& F, int l, int item, int probe = 0) {
    const int odd = l & 1, nhh = odd ? 4 : 8;
    SeqCtx C; C.probe = probe; C.sl = item & 3; C.chain = item >> 2; C.d = C.chain & 1; C.hh = (C.chain >> 1) % nhh; C.b = C.chain / (2 * nhh);
    C.kind = odd ? 2 : (C.hh < 4 ? 0 : 1);
    const GAS bf16_t* P = (const GAS bf16_t*)(F.ws + WS_P); const GAS bf16_t* Q = (const GAS bf16_t*)(F.ws + WS_QKV);
    if (C.kind == 0) { C.vsrc = Q + 1024 + C.hh * 128; C.vld = 1536; } else if (C.kind == 1) { C.vsrc = P + 3072 + (C.hh - 4) * 128; C.vld = NIN_E; } else { C.vsrc = P + 1024 + C.hh * 128; C.vld = NIN_O; }
    for (int i = F.tid; i < 32 * 136 / 2; i += NTHREADS) ((LAS unsigned*)(F.lds + SQ_SB))[i] = 0u;
    if (F.tid < 128) ((LAS float*)(F.lds + SQ_NV))[F.tid] = 0.f;
    __syncthreads();
    if (C.kind == 0) seq_kind_loop<0>(F, C, F.lds); else if (C.kind == 1) seq_kind_loop<1>(F, C, F.lds); else seq_kind_loop<2>(F, C, F.lds);
    WAIT_VM(0);
}

DEV void seq_s5_item(const Frame& F, int l, int item, int which) {
    const int o = l >> 1; const int g = item & 31, d = (item >> 5) & 1, b = item >> 6;
    LAS float* El = (LAS float*)(F.lds);
    LAS unsigned char* wl = F.lds + 36864 + F.wave * 14336;
    LAS float* scr = (LAS float*)wl; LAS bf16_t* hb = (LAS bf16_t*)(wl + 10240);
    const bf16_t* P = (const bf16_t*)(F.ws + WS_P);
    const float* Ab = (const float*)(F.ws + WS_S5A) + (size_t)((o * 2 + d) * 32 + g) * 128;
    const bf16_t* Bb = (const bf16_t*)(F.ws + WS_S5B) + (size_t)((o * 2 + d) * 32 + g) * 128 * 16;
    const bf16_t* Cm = (const bf16_t*)(F.ws + WS_S5C) + (size_t)(o * 32 + g) * 16 * 128;
    const int l15 = F.lane & 15, kg = F.lane >> 4;
    const float ar = Ab[F.lane], ai = Ab[64 + F.lane];
    bf16x8 bB[8], cB[4]; const bf16x8 zero8 = (bf16x8){0, 0, 0, 0, 0, 0, 0, 0};
#pragma unroll
    for (int ct = 0; ct < 8; ++ct) bB[ct] = kg < 2 ? *(const bf16x8*)(Bb + (size_t)(16 * ct + l15) * 16 + 8 * kg) : zero8;
#pragma unroll
    for (int s = 0; s < 4; ++s) cB[s] = *(const bf16x8*)(Cm + (size_t)l15 * 128 + 32 * s + 8 * kg);
    bf16_t* Obase = (bf16_t*)(F.ws + WS_O) + (size_t)d * MROWS * 1024 + 512 + 16 * g;
    float* SE = (float*)(F.ws + WS_S5E) + (size_t)item * NCH * 128;
    if (which == 1) { for (int i = F.tid; i < NCH * 128; i += NTHREADS) El[i] = SE[i]; __syncthreads(); }
    for (int pass = which; pass < which + 1; ++pass) {
        bf16x8 an[4];
#pragma unroll
        for (int st = 0; st < 4; ++st) an[st] = kg < 2 ? *(const bf16x8*)(P + (size_t)tok_row(b, d, F.wave * 64 + 16 * st + l15) * NIN_O + 2048 + 16 * g + 8 * kg) : zero8;
        for (int n = F.wave; n < NCH; n += NWAVES) {
            float hr = 0.f, hi = 0.f;
            if (pass) { hr = El[n * 128 + F.lane]; hi = El[n * 128 + 64 + F.lane]; }
            bf16x8 ac[4];
#pragma unroll
            for (int st = 0; st < 4; ++st) ac[st] = an[st];
            { const int nn = n + NWAVES < NCH ? n + NWAVES : n;
#pragma unroll
              for (int st = 0; st < 4; ++st) an[st] = kg < 2 ? *(const bf16x8*)(P + (size_t)tok_row(b, d, nn * 64 + 16 * st + l15) * NIN_O + 2048 + 16 * g + 8 * kg) : zero8; }
            const int r0 = tok_row(b, d, n * 64); const int sg = d ? -1 : 1;
#pragma unroll
            for (int st = 0; st < 4; ++st) {
#pragma unroll
                for (int ct = 0; ct < 8; ++ct) { f32x4 acc = (f32x4){0.f, 0.f, 0.f, 0.f}; acc = mfma16(ac[st], bB[ct], acc);
                    *(LAS f32x4*)(scr + (ct >> 2) * 1280 + (16 * (ct & 3) + l15) * 20 + 4 * kg) = acc; }
                WAVE_LDS_SYNC();
                f32x4 br[4], bi[4];
#pragma unroll
                for (int q = 0; q < 4; ++q) { br[q] = *(const LAS f32x4*)(scr + F.lane * 20 + 4 * q); bi[q] = *(const LAS f32x4*)(scr + 1280 + F.lane * 20 + 4 * q); }
#pragma unroll
                for (int t = 0; t < 16; ++t) { const float nr = ar * hr - ai * hi + br[t >> 2][t & 3], ni = ar * hi + ai * hr + bi[t >> 2][t & 3]; hr = nr; hi = ni;
                    if (pass) *(LAS unsigned*)(hb + t * 128 + 2 * F.lane) = pk2(hr, hi); }
                WAVE_LDS_SYNC();
                if (pass) { f32x4 acc = (f32x4){0.f, 0.f, 0.f, 0.f};
#pragma unroll
                    for (int s = 0; s < 4; ++s) { const bf16x8 ha = *(const LAS bf16x8*)(hb + l15 * 128 + 32 * s + 8 * kg); acc = mfma16(ha, cB[s], acc); }
#pragma unroll
                    for (int r = 0; r < 4; ++r) Obase[(size_t)(r0 + sg * (16 * st + 4 * kg + r)) * 1024 + l15] = (bf16_t)f2bf(acc[r]);
                    WAVE_LDS_SYNC(); }
            }
            if (!pass) { El[n * 128 + F.lane] = hr; El[n * 128 + 64 + F.lane] = hi; }
        }
        __syncthreads();
        if (!pass) {
            if (F.wave == 0) { float pr = ar, pi = ai;
#pragma unroll
                for (int q = 0; q < 6; ++q) { const float nr = pr * pr - pi * pi, ni = 2.0f * pr * pi; pr = nr; pi = ni; }
                float hr = 0.f, hi = 0.f;
                for (int n = 0; n < NCH; ++n) { const float er = El[n * 128 + F.lane], ei = El[n * 128 + 64 + F.lane];
                    El[n * 128 + F.lane] = hr; El[n * 128 + 64 + F.lane] = hi;
                    const float nr = pr * hr - pi * hi + er, ni = pr * hi + pi * hr + ei; hr = nr; hi = ni; } }
            __syncthreads();
            for (int i = F.tid; i < NCH * 128; i += NTHREADS) SE[i] = El[i];
        }
    }
}

DEV void phase_seq(const Frame& F0, int l, int mode = 0) {
    const Frame F = refresh(F0);
    const int odd = l & 1; const int nlin = B_ * (odd ? 4 : 8) * 2 * 4; const int ns5 = odd ? B_ * 2 * 32 : 0;
    const int vcu = (F.G % 8 == 0) ? (F.bid % 8) * (F.G / 8) + F.bid / 8 : F.bid;
    if (!odd || F.G <= nlin) {
        for (int it = vcu; it < nlin + ns5; it += F.G) {
            if (it < nlin) { if (mode != 2) seq_linear_item(F, l, it, mode >= 10 ? mode - 10 : 0); } else if (mode != 1 && mode < 10) seq_s5_item(F, l, it - nlin, 1);
            __syncthreads();
        }
    } else if (vcu < nlin) { if (mode != 2) seq_linear_item(F, l, vcu, mode >= 10 ? mode - 10 : 0); }
    else { for (int it = vcu - nlin; it < ns5; it += F.G - nlin) { if (mode != 1 && mode < 10) seq_s5_item(F, l, it, 1); __syncthreads(); } }
}

DEV void phase_merge(const Frame& F0, int l) {
    const Frame F = refresh(F0);
    const int odd = l & 1, li = l >> 1; const bf16_t* P = (const bf16_t*)(F.ws + WS_P);
    const bf16_t* O0 = (const bf16_t*)(F.ws + WS_O); const bf16_t* O1 = O0 + (size_t)MROWS * 1024;
    bf16_t* MG = (bf16_t*)(F.ws + WS_MERGED);
    const int nrows = (l == DEPTH - 1) ? LATR : MROWS;
    ROW_LOOP(r, nrows) {
        if (!odd) {
            const int c0 = 16 * F.lane; float v[16];
#pragma unroll
            for (int q = 0; q < 4; ++q) { const u32x2 a = *(const u32x2*)(O0 + (size_t)r * 1024 + c0 + 4 * q), bq = *(const u32x2*)(O1 + (size_t)r * 1024 + c0 + 4 * q);
                v[4 * q] = bflo(a.x) + bflo(bq.x); v[4 * q + 1] = bfhi(a.x) + bfhi(bq.x); v[4 * q + 2] = bflo(a.y) + bflo(bq.y); v[4 * q + 3] = bfhi(a.y) + bfhi(bq.y); }
            float s = 0.f;
#pragma unroll
            for (int i = 0; i < 16; ++i) s += v[i];
            s = group_sum<8>(s);
            const bool ret = F.lane >= 32; const float mu = ret ? s * (1.0f / 128.0f) : 0.f; float q2 = 0.f;
#pragma unroll
            for (int i = 0; i < 16; ++i) { v[i] -= mu; q2 += v[i] * v[i]; }
            q2 = group_sum<8>(q2);
            const float rstd = 1.0f / sqrtf(q2 * (1.0f / 128.0f) + LN_EPS);
            const bf16_t* zp = P + (size_t)r * NIN_E + (ret ? 3584 + (c0 - 512) : 1536 + c0);
            const float* gp = ret ? GIN(I_EVRETN) + li * 512 + (c0 - 512) : GIN(I_EVGDNN) + li * 128 + (c0 & 127);
            unsigned ow[8]; const u32x4 zq0 = *(const u32x4*)zp, zq1 = *(const u32x4*)(zp + 8); const unsigned zw[8] = {zq0.x, zq0.y, zq0.z, zq0.w, zq1.x, zq1.y, zq1.z, zq1.w};
            f32x4 gq[4];
#pragma unroll
            for (int i = 0; i < 4; ++i) gq[i] = *(const f32x4*)(gp + 4 * i);
#pragma unroll
            for (int i = 0; i < 16; i += 2) { const float z0 = bflo(zw[i >> 1]), z1 = bfhi(zw[i >> 1]); ow[i >> 1] = pk2(v[i] * rstd * gq[i >> 2][i & 3] * fast_silu(z0), v[i + 1] * rstd * gq[i >> 2][(i & 3) + 1] * fast_silu(z1)); }
            u32x4* op = (u32x4*)(MG + (size_t)r * 1024 + c0); op[0] = (u32x4){ow[0], ow[1], ow[2], ow[3]}; op[1] = (u32x4){ow[4], ow[5], ow[6], ow[7]};
        } else {
            const int c0 = 8 * F.lane; float v[8];
#pragma unroll
            for (int q = 0; q < 2; ++q) { const u32x2 a = *(const u32x2*)(O0 + (size_t)r * 1024 + c0 + 4 * q), bq = *(const u32x2*)(O1 + (size_t)r * 1024 + c0 + 4 * q);
                v[4 * q] = bflo(a.x) + bflo(bq.x); v[4 * q + 1] = bfhi(a.x) + bfhi(bq.x); v[4 * q + 2] = bflo(a.y) + bflo(bq.y); v[4 * q + 3] = bfhi(a.y) + bfhi(bq.y); }
            float s = 0.f;
#pragma unroll
            for (int i = 0; i < 8; ++i) s += v[i];
            s = group_sum<16>(s);
            const float mu = s * (1.0f / 128.0f); float q2 = 0.f;
#pragma unroll
            for (int i = 0; i < 8; ++i) { v[i] -= mu; q2 += v[i] * v[i]; }
            q2 = group_sum<16>(q2);
            const float rstd = 1.0f / sqrtf(q2 * (1.0f / 128.0f) + LN_EPS);
            const bf16_t* zp = P + (size_t)r * NIN_O + 1536 + c0; const float* gp = GIN(I_ODMN) + li * 512 + c0;
            unsigned ow[4]; const u32x4 zq = *(const u32x4*)zp; const unsigned zw[4] = {zq.x, zq.y, zq.z, zq.w}; const f32x4 gq0 = *(const f32x4*)gp, gq1 = *(const f32x4*)(gp + 4);
#pragma unroll
            for (int i = 0; i < 8; i += 2) { const f32x4 gq = i < 4 ? gq0 : gq1; ow[i >> 1] = pk2(v[i] * rstd * gq[i & 3] * fast_sigmoid(bflo(zw[i >> 1])), v[i + 1] * rstd * gq[(i & 3) + 1] * fast_sigmoid(bfhi(zw[i >> 1]))); }
            *(u32x4*)(MG + (size_t)r * 1024 + c0) = (u32x4){ow[0], ow[1], ow[2], ow[3]};
            const bf16_t* up = P + (size_t)r * NIN_O + 2048 + c0; const float* dsk = GIN(I_ODDSKIP) + li * 512 + c0;
#pragma unroll
            for (int q = 0; q < 2; ++q) { const u32x2 a = *(const u32x2*)(O0 + (size_t)r * 1024 + 512 + c0 + 4 * q), bq = *(const u32x2*)(O1 + (size_t)r * 1024 + 512 + c0 + 4 * q);
                v[4 * q] = bflo(a.x) + bflo(bq.x); v[4 * q + 1] = bfhi(a.x) + bfhi(bq.x); v[4 * q + 2] = bflo(a.y) + bflo(bq.y); v[4 * q + 3] = bfhi(a.y) + bfhi(bq.y); }
            { const u32x4 uq = *(const u32x4*)up; const unsigned uw[4] = {uq.x, uq.y, uq.z, uq.w}; const f32x4 d0 = *(const f32x4*)dsk, d1 = *(const f32x4*)(dsk + 4);
#pragma unroll
              for (int i = 0; i < 8; i += 2) { const f32x4 dq = i < 4 ? d0 : d1; ow[i >> 1] = pk2(gelu_tanh_f(v[i] + dq[i & 3] * bflo(uw[i >> 1])), gelu_tanh_f(v[i + 1] + dq[(i & 3) + 1] * bfhi(uw[i >> 1]))); } }
            *(u32x4*)((bf16_t*)(F.ws + WS_YS) + (size_t)r * 512 + c0) = (u32x4){ow[0], ow[1], ow[2], ow[3]};
        }
    }
}

template <int RG> DEV void ln_rows(const Frame& F, f32x4 (&t)[RG][4], const float* lg, const float* lb) {
    float mean[RG], rstd[RG];
#pragma unroll
    for (int q = 0; q < RG; ++q) { float sum = 0.f;
#pragma unroll
        for (int j = 0; j < 4; ++j) sum += (t[q][j].x + t[q][j].y) + (t[q][j].z + t[q][j].w);
        mean[q] = wave_sum(sum) * (1.0f / 1024.0f); }
#pragma unroll
    for (int q = 0; q < RG; ++q) { float s2 = 0.f;
#pragma unroll
        for (int j = 0; j < 4; ++j) { t[q][j] = t[q][j] - mean[q]; s2 += (t[q][j].x * t[q][j].x + t[q][j].y * t[q][j].y) + (t[q][j].z * t[q][j].z + t[q][j].w * t[q][j].w); }
        rstd[q] = 1.0f / sqrtf(wave_sum(s2) * (1.0f / 1024.0f) + LN_EPS); }
#pragma unroll
    for (int j = 0; j < 4; ++j) { const f32x4 gg = *((const f32x4*)lg + F.lane + 64 * j), bb = *((const f32x4*)lb + F.lane + 64 * j);
#pragma unroll
        for (int q = 0; q < RG; ++q) t[q][j] = t[q][j] * rstd[q] * gg + bb; }
}
template <int RG> DEV void ln1_group(const Frame& F, int l, int r) {

    const bf16_t* Y = (const bf16_t*)(F.ws + WS_Y); float* H = (float*)(F.ws + WS_H);
    const float* lg = GIN(I_LN1G) + l * 1024; const float* lb = GIN(I_LN1B) + l * 1024; const float* wr = (const float*)(F.ws + WS_WR) + (size_t)l * NE * 1024;
    {
        int b, s; row_bs(r, b, s); const int mr = s < CTX ? B_ : b; const float* mod = (const float*)(F.ws + WS_MOD) + ((size_t)l * NR + mr) * 6144;
        f32x4 t[RG][4];
#pragma unroll
        for (int j = 0; j < 4; ++j) { const f32x4 g1 = *((const f32x4*)(mod + 2048) + F.lane + 64 * j);
#pragma unroll
            for (int q = 0; q < RG; ++q) { const f32x4 hv = *((const f32x4*)HROW(F, l, r + q) + F.lane + 64 * j); const u32x2 yw = *((const u32x2*)(Y + (size_t)(r + q) * 1024) + F.lane + 64 * j); const f32x4 yv = (f32x4){bflo(yw.x), bfhi(yw.x), bflo(yw.y), bfhi(yw.y)}; t[q][j] = ALPHA * hv + g1 * yv; }
            if (j & 1) COMPILER_FENCE(); }
        ln_rows<RG>(F, t, lg, lb);
        COMPILER_FENCE();
#pragma unroll
        for (int j = 0; j < 4; ++j) { const f32x4 sh = *((const f32x4*)(mod + 3072) + F.lane + 64 * j), scv = *((const f32x4*)(mod + 4096) + F.lane + 64 * j);
#pragma unroll
            for (int q = 0; q < RG; ++q) { *((f32x4*)(H + (size_t)(r + q) * 1024) + F.lane + 64 * j) = t[q][j]; t[q][j] = t[q][j] * (1.0f + scv) + sh; } }
        COMPILER_FENCE();
#pragma unroll
        for (int q = 0; q < RG; ++q) { u32x2* xo = (u32x2*)((bf16_t*)(F.ws + WS_XIN) + (size_t)(r + q) * 1024) + F.lane;
#pragma unroll
            for (int j = 0; j < 4; ++j) xo[64 * j] = (u32x2){pk2(t[q][j].x, t[q][j].y), pk2(t[q][j].z, t[q][j].w)}; }
        float mine[RG]; const int ei = F.lane % NE;
#pragma unroll
        for (int q = 0; q < RG; ++q) mine[q] = 0.f;
        f32x4 wc[4];
#pragma unroll
        for (int j = 0; j < 4; ++j) wc[j] = *((const f32x4*)wr + F.lane + 64 * j);
#pragma unroll 1
        for (int e = 0; e < NE; ++e) { f32x4 wn[4]; const int en = e + 1 < NE ? e + 1 : e;
#pragma unroll
            for (int j = 0; j < 4; ++j) wn[j] = *((const f32x4*)(wr + en * 1024) + F.lane + 64 * j);
#pragma unroll
            for (int q = 0; q < RG; ++q) { float p = 0.f;
#pragma unroll
                for (int j = 0; j < 4; ++j) p += t[q][j].x * wc[j].x + t[q][j].y * wc[j].y + t[q][j].z * wc[j].z + t[q][j].w * wc[j].w;
                const float ws_ = wave_sum(p); mine[q] = (ei == e) ? ws_ : mine[q]; }
#pragma unroll
            for (int j = 0; j < 4; ++j) wc[j] = wn[j]; }
#pragma unroll
        for (int q = 0; q < RG; ++q) { const float mx = group_max<NE>(mine[q]); const float ex = expf(mine[q] - mx); const float se = group_sum<NE>(ex);
            if (F.lane < NE) ((float*)(F.ws + WS_AFF))[(size_t)(r + q) * 16 + F.lane] = ex / se; }
    }
}
DEV void phase_ln1(const Frame& F0, int l) {
    const Frame F = refresh(F0);
    const int nrows = (l == DEPTH - 1) ? LATR : MROWS;
    ROW_GROUPS(nrows, ln1_group<4>(F, l, r), ln1_group<2>(F, l, r));
}

DEV void phase_topk(const Frame& F0, int l) {
    const Frame F = refresh(F0);
    const int nitems = (l == DEPTH - 1) ? B_ * NE : 2 * B_ * NE;
    LAS unsigned* hist = (LAS unsigned*)(F.lds);
    LAS unsigned* selw = (LAS unsigned*)(F.lds + 1024);
    LAS unsigned* cnt = (LAS unsigned*)(F.lds + 2048);
    LAS int* selrow = (LAS int*)(F.lds + 8192);
    const float* AFF = (const float*)(F.ws + WS_AFF); int* SLOT = (int*)(F.ws + WS_SLOT); float* EG = (float*)(F.ws + WS_EGATE);
    for (int it = F.bid; it < nitems; it += F.G) {
        const int e = it % NE, set = it / NE, kind = set / B_, b = set % B_;
        const int n = kind ? CTX : SEQ, cap = kind ? CAPC : CAPL; const int row0 = kind ? LATR + b * CTX : b * SEQ;
        const int sbase = kind ? B_ * CAPL + b * CAPC : b * CAPL;
        const int per = n >= NTHREADS ? n / NTHREADS : 1; const bool act = F.tid * per < n;
        unsigned key[8];
#pragma unroll
        for (int k = 0; k < 8; ++k) key[k] = (act && k < per) ? __builtin_bit_cast(unsigned, AFF[(size_t)(row0 + F.tid * per + k) * 16 + e]) : 0u;
        unsigned prefix = 0u, remaining = (unsigned)cap;
        for (int pass = 0; pass < 4; ++pass) {
            const int shift = 24 - 8 * pass; const unsigned mask = pass == 0 ? 0u : (0xFFFFFFFFu << (shift + 8));
            if (F.tid < 256) hist[F.tid] = 0u;
            __syncthreads();
#pragma unroll
            for (int k = 0; k < 8; ++k) if (act && k < per && ((key[k] & mask) == (prefix & mask))) lds_atomic_add(&hist[(key[k] >> shift) & 255u], 1u);
            __syncthreads();
            if (F.wave == 0) {
                const unsigned h0 = hist[4 * F.lane], h1 = hist[4 * F.lane + 1], h2 = hist[4 * F.lane + 2], h3 = hist[4 * F.lane + 3];
                unsigned suf = h0 + h1 + h2 + h3;
#pragma unroll
                for (int o = 1; o < 64; o <<= 1) { const unsigned tv = shfl_t(suf, F.lane + o); if (F.lane + o < 64) suf += tv; }
                unsigned cum = suf - (h0 + h1 + h2 + h3);
                int dsel = -1; unsigned above = 0u;
                if (cum < remaining) {
                    if (cum + h3 >= remaining) { dsel = 4 * F.lane + 3; above = cum; }
                    else if (cum + h3 + h2 >= remaining) { dsel = 4 * F.lane + 2; above = cum + h3; }
                    else if (cum + h3 + h2 + h1 >= remaining) { dsel = 4 * F.lane + 1; above = cum + h3 + h2; }
                    else if (cum + h3 + h2 + h1 + h0 >= remaining) { dsel = 4 * F.lane; above = cum + h3 + h2 + h1; }
                }
                if (dsel >= 0) { selw[0] = prefix | ((unsigned)dsel << shift); selw[1] = remaining - above; }
            }
            __syncthreads();
            prefix = selw[0]; remaining = selw[1];
            __syncthreads();
        }
        const unsigned T = prefix, need_eq = remaining;
        unsigned ngt = 0u, neq = 0u;
#pragma unroll
        for (int k = 0; k < 8; ++k) if (act && k < per) { ngt += key[k] > T ? 1u : 0u; neq += key[k] == T ? 1u : 0u; }
        unsigned pk = (ngt << 16) | neq;
#pragma unroll
        for (int o = 1; o < 64; o <<= 1) { const unsigned tv = shfl_t(pk, F.lane - o); if (F.lane >= o) pk += tv; }
        if (F.lane == 63) cnt[F.wave] = pk;
        __syncthreads();
        unsigned base = 0u;
#pragma unroll
        for (int w8 = 0; w8 < NWAVES; ++w8) base += (w8 < F.wave) ? cnt[w8] : 0u;
        const unsigned excl = base + pk - ((ngt << 16) | neq);
        unsigned gtb = excl >> 16, eqb = excl & 0xffffu;
#pragma unroll
        for (int k = 0; k < 8; ++k) if (act && k < per) {
            const int row = row0 + F.tid * per + k; int slot = -1;
            const bool isgt = key[k] > T, iseq = key[k] == T;
            if (isgt || (iseq && eqb < need_eq)) { slot = (int)(gtb + (eqb < need_eq ? eqb : need_eq)); selrow[slot] = row; EG[(size_t)e * EPAD + sbase + slot] = __builtin_bit_cast(float, key[k]); }
            SLOT[(size_t)row * 16 + e] = slot >= 0 ? sbase + slot : -1;
            gtb += isgt ? 1u : 0u; eqb += iseq ? 1u : 0u;
        }
        __syncthreads();
        for (int sl = F.tid; sl < cap; sl += NTHREADS) ((int*)(F.ws + WS_EIDX))[(size_t)e * EPAD + sbase + sl] = selrow[sl];
        if (it < NE) for (int pr = EROWS + F.tid; pr < EPAD; pr += NTHREADS) EG[(size_t)e * EPAD + pr] = 0.f;
        __syncthreads();
    }
}

DEV void phase_gather(const Frame& F0, int l) {
    const Frame F = refresh(F0);
    const int erows = (l == DEPTH - 1) ? B_ * CAPL : EROWS;
    const int* EI = (const int*)(F.ws + WS_EIDX);
    for (int r0 = 4 * F.gw; r0 < NE * EPAD; r0 += 4 * F.NGW) {
        u32x4 v[4][2];
#pragma unroll
        for (int q = 0; q < 4; ++q) { const int r = r0 + q, sl = r % EPAD; v[q][0] = (u32x4){0u, 0u, 0u, 0u}; v[q][1] = v[q][0];
            if (sl < erows) { const u32x4* src = (const u32x4*)((const bf16_t*)(F.ws + WS_XIN) + (size_t)EI[r] * 1024) + F.lane; v[q][0] = src[0]; v[q][1] = src[64]; } }
#pragma unroll
        for (int q = 0; q < 4; ++q) { u32x4* dst = (u32x4*)((bf16_t*)(F.ws + WS_XS) + (size_t)(r0 + q) * 1024) + F.lane; dst[0] = v[q][0]; dst[64] = v[q][1]; }
    }
}

template <int RG> DEV void ln2_group(const Frame& F, int l, int r) {

    float* H = (float*)(F.ws + WS_H); const int* SLOT = (const int*)(F.ws + WS_SLOT); const bf16_t* YSE = (const bf16_t*)(F.ws + WS_YSE);
    const float* lg = GIN(I_LN2G) + l * 1024; const float* lb = GIN(I_LN2B) + l * 1024;
    {
        int b, s; row_bs(r, b, s); const int mr = s < CTX ? B_ : b; const float* mod = (const float*)(F.ws + WS_MOD) + ((size_t)l * NR + mr) * 6144;
        f32x4 t[RG][4];
#pragma unroll
        for (int q = 0; q < RG; ++q) {
#pragma unroll
            for (int j = 0; j < 4; ++j) t[q][j] = (f32x4){0.f, 0.f, 0.f, 0.f}; }
        const int myslot = F.lane < RG * 16 ? SLOT[(size_t)r * 16 + F.lane] : -1;
#pragma unroll
        for (int q = 0; q < RG; ++q)
#pragma unroll
            for (int e = 0; e < NE; ++e) { const int sl = bcast_lane(myslot, 16 * q + e);
                if (sl >= 0) { const u32x2* yp = (const u32x2*)(YSE + ((size_t)e * EPAD + sl) * 1024) + F.lane;
#pragma unroll
                    for (int j = 0; j < 4; ++j) { const u32x2 w = yp[64 * j]; t[q][j] += (f32x4){bflo(w.x), bfhi(w.x), bflo(w.y), bfhi(w.y)}; } } }
#pragma unroll
        for (int j = 0; j < 4; ++j) { const f32x4 g2 = *((const f32x4*)(mod + 5120) + F.lane + 64 * j);
#pragma unroll
            for (int q = 0; q < RG; ++q) { const f32x4 hv = *((const f32x4*)(H + (size_t)(r + q) * 1024) + F.lane + 64 * j); t[q][j] = ALPHA * hv + g2 * t[q][j]; } }
        ln_rows<RG>(F, t, lg, lb);
        if (l == DEPTH - 1) {
            {
#pragma unroll
                for (int q = 0; q < RG; ++q) { GAS f32x4* op = (GAS f32x4*)(F.out + (size_t)(r + q) * 1024) + F.lane;
#pragma unroll
                    for (int j = 0; j < 4; ++j) op[64 * j] = t[q][j]; } }
        } else {
#pragma unroll
            for (int q = 0; q < RG; ++q)
#pragma unroll
                for (int j = 0; j < 4; ++j) *((f32x4*)(H + (size_t)(r + q) * 1024) + F.lane + 64 * j) = t[q][j];
            xg_rows<RG>(F, l + 1, r, t);
        }
    }
}
DEV void phase_ln2(const Frame& F0, int l) {
    const Frame F = refresh(F0);
    const int nrows = (l == DEPTH - 1) ? LATR : MROWS;
    ROW_GROUPS(nrows, ln2_group<4>(F, l, r), ln2_group<2>(F, l, r));
}

struct EpiP {
    static constexpr bool PERM = true;
    bf16_t* O; int ldc;
    DEV void operator()(const f32x4 (&acc)[2][2][4][2], const pg8::Unit& u, int wr, int wc, int fr, int fq) const {
        const int row0 = u.pm * 256 + wr * 64 + fr, col0 = u.pn * 256 + wc * 32 + 8 * fq;
#pragma unroll
        for (int ai = 0; ai < 2; ++ai)
#pragma unroll
            for (int m = 0; m < 4; ++m) { bf16_t* rowp = O + (size_t)(row0 + ai * 128 + m * 16) * ldc + col0;
#pragma unroll
                for (int bj = 0; bj < 2; ++bj) { const f32x4 v0 = acc[ai][bj][m][0], v1 = acc[ai][bj][m][1];
                    u32x4 w; w.x = pg8::cvt_pk_bf16(v0[0], v0[1]); w.y = pg8::cvt_pk_bf16(v0[2], v0[3]); w.z = pg8::cvt_pk_bf16(v1[0], v1[1]); w.w = pg8::cvt_pk_bf16(v1[2], v1[3]);
                    *(u32x4*)(rowp + bj * 128) = w; } }
    }
};
struct EpiGlu {
    static constexpr bool PERM = true;
    bf16_t* MG; const bf16_t* YS; const float* bias;
    DEV void operator()(const f32x4 (&acc)[2][2][4][2], const pg8::Unit& u, int wr, int wc, int fr, int fq) const {
        const int row0 = u.pm * 256 + wr * 64 + fr, col0 = u.pn * 256 + wc * 32 + 8 * fq;
#pragma unroll
        for (int ai = 0; ai < 2; ++ai)
#pragma unroll
            for (int m = 0; m < 4; ++m) { const int row = row0 + ai * 128 + m * 16;
#pragma unroll
                for (int bj = 0; bj < 2; ++bj) { const int c = col0 + bj * 128; const f32x4 v0 = acc[ai][bj][m][0], v1 = acc[ai][bj][m][1];
                    const u32x4 yv = *(const u32x4*)(YS + (size_t)row * 512 + c); const f32x4 b0 = *(const f32x4*)(bias + c), b1 = *(const f32x4*)(bias + c + 4);
                    u32x4 w; w.x = pk2(bflo(yv.x) * fast_sigmoid(v0[0] + b0[0]), bfhi(yv.x) * fast_sigmoid(v0[1] + b0[1])); w.y = pk2(bflo(yv.y) * fast_sigmoid(v0[2] + b0[2]), bfhi(yv.y) * fast_sigmoid(v0[3] + b0[3]));
                    w.z = pk2(bflo(yv.z) * fast_sigmoid(v1[0] + b1[0]), bfhi(yv.z) * fast_sigmoid(v1[1] + b1[1])); w.w = pk2(bflo(yv.w) * fast_sigmoid(v1[2] + b1[2]), bfhi(yv.w) * fast_sigmoid(v1[3] + b1[3]));
                    *(u32x4*)(MG + (size_t)row * 1024 + 512 + c) = w; } }
    }
};
struct EpiF32 {
    static constexpr bool PERM = false;
    float* C; int ldc; const float* rowscale;
    DEV void operator()(const f32x4 (&acc)[2][2][4][2], const pg8::Unit& u, int wr, int wc, int fr, int fq) const {
        const int row0 = u.pm * 256 + wr * 64 + fr, col0 = u.pn * 256 + wc * 32 + 4 * fq;
        const size_t ebase = rowscale ? (size_t)u.e * EPAD : 0;
#pragma unroll
        for (int ai = 0; ai < 2; ++ai)
#pragma unroll
            for (int m = 0; m < 4; ++m) { const size_t row = ebase + row0 + ai * 128 + m * 16; const float sc = rowscale ? rowscale[row] : 1.0f; float* rowp = C + row * ldc + col0;
#pragma unroll
                for (int bj = 0; bj < 2; ++bj)
#pragma unroll
                    for (int n = 0; n < 2; ++n) *(f32x4*)(rowp + bj * 128 + n * 16) = acc[ai][bj][m][n] * sc; }
    }
};
struct EpiYse {
    static constexpr bool PERM = true;
    bf16_t* O; const float* rowscale;
    DEV void operator()(const f32x4 (&acc)[2][2][4][2], const pg8::Unit& u, int wr, int wc, int fr, int fq) const {
        const int row0 = u.pm * 256 + wr * 64 + fr, col0 = u.pn * 256 + wc * 32 + 8 * fq; const size_t ebase = (size_t)u.e * EPAD;
#pragma unroll
        for (int ai = 0; ai < 2; ++ai)
#pragma unroll
            for (int m = 0; m < 4; ++m) { const size_t row = ebase + row0 + ai * 128 + m * 16; const float sc = rowscale[row]; bf16_t* rowp = O + row * 1024 + col0;
#pragma unroll
                for (int bj = 0; bj < 2; ++bj) { const f32x4 v0 = acc[ai][bj][m][0] * sc, v1 = acc[ai][bj][m][1] * sc;
                    u32x4 w; w.x = pg8::cvt_pk_bf16(v0[0], v0[1]); w.y = pg8::cvt_pk_bf16(v0[2], v0[3]); w.z = pg8::cvt_pk_bf16(v1[0], v1[1]); w.w = pg8::cvt_pk_bf16(v1[2], v1[3]);
                    *(u32x4*)(rowp + bj * 128) = w; } }
    }
};
struct EpiSwiglu {
    static constexpr bool PERM = true;
    bf16_t* HID;
    DEV void operator()(const f32x4 (&acc)[2][2][4][2], const pg8::Unit& u, int wr, int wc, int fr, int fq) const {
        const int row0 = u.pm * 256 + wr * 64 + fr, col0 = u.pn * 128 + wc * 32 + 8 * fq;
#pragma unroll
        for (int ai = 0; ai < 2; ++ai)
#pragma unroll
            for (int m = 0; m < 4; ++m) { bf16_t* rowp = HID + ((size_t)u.e * EPAD + row0 + ai * 128 + m * 16) * FF + col0;
                const f32x4 g0 = acc[ai][0][m][0], g1 = acc[ai][0][m][1], u0 = acc[ai][1][m][0], u1 = acc[ai][1][m][1];
                u32x4 w; w.x = pk2(fast_silu(g0[0]) * u0[0], fast_silu(g0[1]) * u0[1]); w.y = pk2(fast_silu(g0[2]) * u0[2], fast_silu(g0[3]) * u0[3]);
                w.z = pk2(fast_silu(g1[0]) * u1[0], fast_silu(g1[1]) * u1[1]); w.w = pk2(fast_silu(g1[2]) * u1[2], fast_silu(g1[3]) * u1[3]);
                *(u32x4*)rowp = w; }
    }
};

DEV void gemm_g1(const Frame& F0, int l, int vcu) {
    const Frame F = refresh(F0);
    const int nin = (l & 1) ? NIN_O : NIN_E;
    pg8::PlainOrder S; S.init((const void*)(F.ws + WS_XIN), (const bf16_t*)(F.ws + WS_WIN) + (size_t)l * NINMAX * 1024, 1024, MPAD, nin, F.G, vcu);
    EpiP E; E.O = (bf16_t*)(F.ws + WS_P); E.ldc = nin;
    pg8::gemm_phase(F.lds, 1024, S, E, F.wave, F.lane);
}
DEV void gemm_glu(const Frame& F0, int l, int vcu) {
    const Frame F = refresh(F0);
    const int li = l >> 1;
    pg8::PlainOrder S; S.init((const void*)(F.ws + WS_YS), (const bf16_t*)(F.ws + WS_WGLU) + (size_t)li * 512 * 512, 512, (l == DEPTH - 1) ? LATPAD : MPAD, 512, F.G, vcu);
    EpiGlu E; E.MG = (bf16_t*)(F.ws + WS_MERGED); E.YS = (const bf16_t*)(F.ws + WS_YS); E.bias = GIN(I_ODBGLU) + li * 512;
    pg8::gemm_phase(F.lds, 512, S, E, F.wave, F.lane);
}
DEV void gemm_g3(const Frame& F0, int l, int vcu) {
    const Frame F = refresh(F0);
    pg8::PlainOrder S; S.init((const void*)(F.ws + WS_MERGED), (const bf16_t*)(F.ws + WS_WOUT) + (size_t)l * 1024 * 1024, 1024, (l == DEPTH - 1) ? LATPAD : MPAD, 1024, F.G, vcu);
    EpiP E; E.O = (bf16_t*)(F.ws + WS_Y); E.ldc = 1024;
    pg8::gemm_phase(F.lds, 1024, S, E, F.wave, F.lane);
}
DEV void gemm_g4(const Frame& F0, int l, int vcu) {
    const Frame F = refresh(F0);
    pg8::GroupedOrder S; S.init((const void*)(F.ws + WS_XS), (const bf16_t*)(F.ws + WS_WGU) + (size_t)l * NE * 2 * FF * 1024, 1024, 2 * FF, F.G, vcu, (l == DEPTH - 1) ? B_ * CAPL : EROWS);
    EpiSwiglu E; E.HID = (bf16_t*)(F.ws + WS_HID);
    pg8::gemm_phase(F.lds, 1024, S, E, F.wave, F.lane);
}
DEV void gemm_g5(const Frame& F0, int l, int vcu) {
    const Frame F = refresh(F0);
    pg8::GroupedOrder S; S.init((const void*)(F.ws + WS_HID), (const bf16_t*)(F.ws + WS_WD) + (size_t)l * NE * 1024 * FF, FF, 1024, F.G, vcu, (l == DEPTH - 1) ? B_ * CAPL : EROWS);
    EpiYse E; E.O = (bf16_t*)(F.ws + WS_YSE); E.rowscale = (const float*)(F.ws + WS_EGATE);
    pg8::gemm_phase(F.lds, FF, S, E, F.wave, F.lane);
}

__global__ void __launch_bounds__(NTHREADS, 2) mega_fwd(Args args) {
#ifdef EMU
    LAS unsigned char* lds = emu::lds();
#else
    extern __shared__ __attribute__((aligned(16))) unsigned char lds_raw[];
    LAS unsigned char* lds = (LAS unsigned char*)lds_raw;
#endif
    Frame F;
    F.in = args.in; F.out = (GAS float*)args.out; F.ws = (GAS unsigned char*)args.ws; F.lds = lds;
    F.tid = threadIdx.x; F.lane = F.tid & 63; F.wave = readfirstlane_i(F.tid >> 6); F.G = gridDim.x; F.bid = blockIdx.x;
    F.gw = F.bid * NWAVES + F.wave; F.NGW = F.G * NWAVES;
    for (int u = F.tid; u < (LDS_BYTES - LDS_MISC) / 4; u += NTHREADS) ((LAS unsigned*)(lds + LDS_MISC))[u] = 0u;
    __syncthreads();
    XcdBarrier bar = xcd_barrier_post((unsigned*)(F.ws + WS_CTL), (volatile LAS unsigned*)(lds + LDS_MISC), F.wave);
#define GRID_BAR() xcd_barrier(bar)
    const int vcu = (F.G % 8 == 0) ? (F.bid % 8) * (F.G / 8) + F.bid / 8 : F.bid;

#ifndef PHASE_MASK
#define PHASE_MASK 0xFFFFF
#endif
#ifndef REPEAT_MASK
#define REPEAT_MASK 0x0
#endif
#ifndef TIMING_PROBE
#define TIMING_PROBE -1
#endif
    unsigned long long pt_acc = 0ull, pt_t0 = 0ull;
#define PT(k) do { if (TIMING_PROBE == (k)) pt_t0 = rt_now(); } while (0)
#define PTE(k) do { if (TIMING_PROBE == (k)) pt_acc += rt_now() - pt_t0; } while (0)
#define PH(k) if ((PHASE_MASK >> (k)) & 1)
#define RP(k) if ((REPEAT_MASK >> (k)) & 1)
    PT(0); PH(0) phase_prologue_a(F);
    RP(0) { GRID_BAR(); phase_prologue_a(F); }
    GRID_BAR(); PTE(0);
    PT(1); PH(1) phase_xg0(F);
    GRID_BAR(); PTE(1);
    for (int l = 0; l < DEPTH; ++l) {
        const int odd = l & 1;
        PT(2); PH(2) gemm_g1(F, l, F.bid);
        RP(2) { GRID_BAR(); gemm_g1(F, l, F.bid); }
        GRID_BAR(); PTE(2);
        PT(3); PH(3) phase_prep(F, l);
        RP(3) { GRID_BAR(); phase_prep(F, l); }
        GRID_BAR(); PTE(3);
        PT(4); PH(4) phase_cl(F, l);
        RP(4) { GRID_BAR(); phase_cl(F, l); }
        GRID_BAR(); PTE(4);
        PT(5); PH(5) phase_seq(F, l);
        RP(5) { GRID_BAR(); phase_seq(F, l); }
        GRID_BAR(); PTE(5);
#ifdef SEQ_XPROBE
        if ((l & 1) == SEQ_XPARITY) { PT(20); phase_seq(F, l, 10 + SEQ_XPROBE); GRID_BAR(); PTE(20); }
#endif
        PT(6); PH(6) phase_merge(F, l);
        RP(6) { GRID_BAR(); phase_merge(F, l); }
        GRID_BAR(); PTE(6);
        if (odd) { PT(7); PH(7) gemm_glu(F, l, F.bid); RP(7) { GRID_BAR(); gemm_glu(F, l, F.bid); } GRID_BAR(); PTE(7); }
        PT(8); PH(8) gemm_g3(F, l, F.bid);
        RP(8) { GRID_BAR(); gemm_g3(F, l, F.bid); }
        GRID_BAR(); PTE(8);
        PT(9); PH(9) phase_ln1(F, l);
        GRID_BAR(); PTE(9);
        PT(10); PH(10) phase_topk(F, l);
        RP(10) { GRID_BAR(); phase_topk(F, l); }
        GRID_BAR(); PTE(10);
        PT(14); PH(10) phase_gather(F, l);
        GRID_BAR(); PTE(14);
        PT(11); PH(11) gemm_g4(F, l, F.bid);
        RP(11) { GRID_BAR(); gemm_g4(F, l, F.bid); }
        GRID_BAR(); PTE(11);
        PT(12); PH(12) gemm_g5(F, l, F.bid);
        RP(12) { GRID_BAR(); gemm_g5(F, l, F.bid); }
        GRID_BAR(); PTE(12);
        PT(13); PH(13) phase_ln2(F, l);
        if (l + 1 < DEPTH || TIMING_PROBE >= 0) GRID_BAR();
        PTE(13);
    }
    if (TIMING_PROBE >= 0 && F.bid == 0) { const unsigned long long t1 = rt_now() + pt_acc; while (rt_now() < t1) s_sleep1(); }
}

#ifndef EMU
extern "C" void kernel_launch(void* const* d_in, const int* in_sizes, int n_in, void* d_out, int out_size, void* d_ws, size_t ws_size, hipStream_t stream) {
    static int grid = 0;
    if (grid == 0) {
        if (n_in != N_IN || ws_size < WS_END) { fprintf(stderr, "kernel_launch: need %d inputs and %zu bytes of workspace; got %d, %zu\n", (int)N_IN, (size_t)WS_END, n_in, ws_size); grid = -1; return; }
        int dev = 0, cus = 0, per_cu = 0;
        if (hipGetDevice(&dev) != hipSuccess || hipDeviceGetAttribute(&cus, hipDeviceAttributeMultiprocessorCount, dev) != hipSuccess) { grid = -1; return; }
        if (hipFuncSetAttribute((const void*)mega_fwd, hipFuncAttributeMaxDynamicSharedMemorySize, LDS_BYTES) != hipSuccess) { fprintf(stderr, "kernel_launch: hipFuncSetAttribute failed\n"); grid = -1; return; }
        if (hipOccupancyMaxActiveBlocksPerMultiprocessor(&per_cu, (const void*)mega_fwd, NTHREADS, LDS_BYTES) != hipSuccess || per_cu < 1) { fprintf(stderr, "kernel_launch: occupancy query says %d\n", per_cu); }
        (void)hipGetLastError();
        grid = cus;
    }
    if (grid < 0) return;
    (void)hipMemsetAsync((char*)d_ws + WS_CTL, 0, CTL_BYTES, stream);
    Args a{};
    for (int i = 0; i < N_IN; ++i) a.in[i] = (const float*)d_in[i];
    a.out = (float*)d_out; a.ws = (unsigned char*)d_ws;
    hipLaunchKernelGGL(mega_fwd, dim3(grid), dim3(NTHREADS), LDS_BYTES, stream, a);
}
#endif
```

```cpp
#ifdef EMU
#include "emu.h"
#else
#include <hip/hip_runtime.h>
#endif
#include <cstdio>
#include <cstdint>
#include <cstddef>

#ifndef CFG_BATCH
#define CFG_BATCH 4
#define CFG_SEQ 4096
#define CFG_CTX 256
#define CFG_DEPTH 4
#define CFG_NEXP 16
#define CFG_FF 2048
#endif
constexpr int B_ = CFG_BATCH, SEQ = CFG_SEQ, CTX = CFG_CTX, DEPTH = CFG_DEPTH, NE = CFG_NEXP, FF = CFG_FF;
constexpr int D = 1024, TOK = CTX + SEQ, MROWS = B_ * TOK, MPAD = (MROWS + 255) / 256 * 256;
constexpr int NCH = TOK / 64;
constexpr int LATR = B_ * SEQ;
constexpr int LATPAD = (LATR + 255) / 256 * 256;
constexpr int CAPL = 2 * SEQ / NE, CAPC = 2 * CTX / NE, EROWS = B_ * (CAPL + CAPC), EPAD = (EROWS + 255) / 256 * 256;
constexpr int NIN_E = 4096, NIN_O = 2560, NINMAX = 4096;
constexpr int N_EVEN = (DEPTH + 1) / 2, N_ODD = DEPTH / 2, N_ODDA = N_ODD > 0 ? N_ODD : 1;
constexpr int NR = B_ + 1;
constexpr float ALPHA = 1.681792830507429f;
constexpr float LN_EPS = 1e-5f;
constexpr float HD_SCALE = 0.08838834764831845f;
constexpr int NWAVES = 8, NTHREADS = 512;

enum { I_X = 0, I_C, I_CTX, I_CCTX, I_WMOD, I_BMOD, I_LN1G, I_LN1B, I_LN2G, I_LN2B, I_WROUTER, I_WGATE, I_WUP, I_WDOWN,
       I_EVWIN, I_EVWOUT, I_EVCONV, I_EVALOG, I_EVDTB, I_EVGDNN, I_EVRETN,
       I_ODWIN, I_ODWOUT, I_ODCONV, I_ODGB, I_ODMN, I_ODLRE, I_ODLIM, I_ODLDT, I_ODBRE, I_ODBIM, I_ODCRE, I_ODCIM, I_ODDSKIP, I_ODWGLU, I_ODBGLU, N_IN };

constexpr size_t al256(size_t x) { return (x + 255) & ~(size_t)255; }
constexpr size_t WS_CTL = 0, CTL_BYTES = 65536;
constexpr size_t WS_MOD = WS_CTL + CTL_BYTES;
constexpr size_t WS_WG = al256(WS_MOD + (size_t)DEPTH * NR * 6144 * 4);
constexpr size_t WS_WIN = al256(WS_WG + (size_t)DEPTH * 16 * 1024 * 4);
constexpr size_t WS_WOUT = al256(WS_WIN + (size_t)DEPTH * NINMAX * 1024 * 2);
constexpr size_t WS_WGLU = al256(WS_WOUT + (size_t)DEPTH * 1024 * 1024 * 2);
constexpr size_t WS_WGU = al256(WS_WGLU + (size_t)N_ODDA * 512 * 512 * 2);
constexpr size_t WS_WD = al256(WS_WGU + (size_t)DEPTH * NE * 2 * FF * 1024 * 2);
constexpr size_t WS_S5A = al256(WS_WD + (size_t)DEPTH * NE * 1024 * FF * 2);
constexpr size_t WS_S5B = al256(WS_S5A + (size_t)N_ODDA * 2 * 32 * 128 * 4);
constexpr size_t WS_S5C = al256(WS_S5B + (size_t)N_ODDA * 2 * 32 * 128 * 16 * 2);
constexpr size_t WS_H = al256(WS_S5C + (size_t)N_ODDA * 32 * 16 * 128 * 2);
constexpr size_t WS_XIN = al256(WS_H + (size_t)MPAD * 1024 * 4);
constexpr size_t WS_GATES = al256(WS_XIN + (size_t)MPAD * 1024 * 2);
constexpr size_t WS_MERGED = al256(WS_GATES + (size_t)MROWS * 16 * 4);
constexpr size_t WS_YS = al256(WS_MERGED + (size_t)MPAD * 1024 * 2);
constexpr size_t WS_Y = al256(WS_YS + (size_t)MPAD * 512 * 2);
constexpr size_t WS_AFF = al256(WS_Y + (size_t)MPAD * 1024 * 4);
constexpr size_t WS_SLOT = al256(WS_AFF + (size_t)MROWS * 16 * 4);
constexpr size_t WS_EGATE = al256(WS_SLOT + (size_t)MROWS * 16 * 4);
constexpr size_t WS_MCH = al256(WS_EGATE + (size_t)NE * EPAD * 4);
constexpr size_t WS_WR = al256(WS_MCH + (size_t)B_ * 4 * 2 * NCH * 4);
constexpr size_t WS_EIDX = al256(WS_WR + (size_t)DEPTH * NE * 1024 * 4);
constexpr size_t WS_S5E = al256(WS_EIDX + (size_t)NE * EPAD * 4);
constexpr size_t WS_R = al256(WS_S5E + (size_t)B_ * 2 * 32 * NCH * 128 * 4);
constexpr int NCP = B_ * 8 * 2 * NCH, NCPG = B_ * 4 * 2 * NCH;
constexpr size_t WS_P = WS_R;
constexpr size_t WS_QKV = al256(WS_P + (size_t)MPAD * NINMAX * 2);
constexpr size_t WS_CLW = al256(WS_QKV + (size_t)MROWS * 1536 * 2);
constexpr size_t WS_CLQ = al256(WS_CLW + (size_t)NCP * 64 * 128 * 2);
constexpr size_t WS_CLK = al256(WS_CLQ + (size_t)NCP * 64 * 128 * 2);
constexpr size_t WS_CLA = al256(WS_CLK + (size_t)NCP * 64 * 128 * 2);
constexpr size_t WS_CLU = al256(WS_CLA + (size_t)NCP * 64 * 64 * 2);
constexpr size_t WS_CLS = al256(WS_CLU + (size_t)NCPG * 64 * 128 * 4);
constexpr size_t WS_O = al256(WS_CLS + (size_t)NCP * 512 * 4);
constexpr size_t WS_R_END1 = al256(WS_O + (size_t)2 * MROWS * 1024 * 4);
constexpr size_t WS_XS = WS_R;
constexpr size_t WS_HID = al256(WS_XS + (size_t)NE * EPAD * 1024 * 2);
constexpr size_t WS_YSE = al256(WS_HID + (size_t)NE * EPAD * FF * 2);
constexpr size_t WS_R_END2 = al256(WS_YSE + (size_t)NE * EPAD * 1024 * 4);
constexpr size_t WS_END = WS_R_END1 > WS_R_END2 ? WS_R_END1 : WS_R_END2;

constexpr int LDS_BYTES = 163840;
constexpr int LDS_MISC = 163328;

typedef unsigned short bf16_t;
typedef short bf16x8 __attribute__((ext_vector_type(8)));
typedef float f32x2 __attribute__((ext_vector_type(2)));
typedef float f32x4 __attribute__((ext_vector_type(4)));
typedef float f32x16 __attribute__((ext_vector_type(16)));
typedef unsigned u32x2 __attribute__((ext_vector_type(2)));
typedef unsigned u32x4 __attribute__((ext_vector_type(4)));
#define DEV __device__ __forceinline__

#ifdef EMU
#define LAS
#define GAS
static inline float bf2f_h(bf16_t b) { unsigned u = (unsigned)b << 16; float f; memcpy(&f, &u, 4); return f; }
static inline f32x4 mfma16(bf16x8 a, bf16x8 b, f32x4 c) {
    struct In { bf16x8 a, b; } in{a, b};
    auto s = emu::wave_xchg(&in, sizeof(in)); const int l = emu::cur->lane, col = l & 15, rg = l >> 4;
    for (int r = 0; r < 4; ++r) { const int row = 4 * rg + r; double acc = c[r];
        for (int kg = 0; kg < 4; ++kg) { const In* pa = (const In*)s[row + 16 * kg]; const In* pb = (const In*)s[col + 16 * kg];
            for (int j = 0; j < 8; ++j) acc += (double)bf2f_h((bf16_t)pa->a[j]) * (double)bf2f_h((bf16_t)pb->b[j]); }
        c[r] = (float)acc; }
    return c;
}
static inline f32x16 mfma32(bf16x8 a, bf16x8 b, f32x16 c) {
    struct In { bf16x8 a, b; } in{a, b};
    auto s = emu::wave_xchg(&in, sizeof(in)); const int l = emu::cur->lane, col = l & 31, h = l >> 5;
    for (int r = 0; r < 16; ++r) { const int row = (r & 3) + 8 * (r >> 2) + 4 * h; double acc = c[r];
        for (int kh = 0; kh < 2; ++kh) { const In* pa = (const In*)s[row + 32 * kh]; const In* pb = (const In*)s[col + 32 * kh];
            for (int j = 0; j < 8; ++j) acc += (double)bf2f_h((bf16_t)pa->a[j]) * (double)bf2f_h((bf16_t)pb->b[j]); }
        c[r] = (float)acc; }
    return c;
}
static inline void glds16(const void* g, void* l) { memcpy((char*)l + 16 * emu::cur->lane, g, 16); }
#define S_BARRIER() emu::block_barrier()
#define WAIT_VM(n) do {} while (0)
#define WAIT_LGKM(n) do {} while (0)
#define WAIT_ALL() do {} while (0)
#define SETPRIO(n) do {} while (0)
#define SCHED_BARRIER() do {} while (0)
#define COMPILER_FENCE() do {} while (0)
#define WAVE_LDS_SYNC() do { int _z = 0; (void)emu::wave_xchg(&_z, 4); } while (0)
#define LAUNDER(x) do {} while (0)
#define NT_LOAD(p) (*(p))
#define NT_STORE(v, p) (*(p) = (v))
#define CODE_ALIGN() do {} while (0)
#define LAUNDER_S(x) do {} while (0)
static inline int lane_id() { return emu::cur->lane; }
template <class T> static inline T shfl_xor_t(T v, int m) { auto s = emu::wave_xchg(&v, sizeof(T)); T r; memcpy(&r, s[emu::cur->lane ^ m], sizeof(T)); return r; }
template <class T> static inline T shfl_t(T v, int src) { auto s = emu::wave_xchg(&v, sizeof(T)); T r; memcpy(&r, s[src & 63], sizeof(T)); return r; }
static inline float wave_sum(float v) { for (int o = 1; o < 64; o <<= 1) v += shfl_xor_t(v, o); return v; }
static inline float wave_max(float v) { for (int o = 1; o < 64; o <<= 1) v = fmaxf(v, shfl_xor_t(v, o)); return v; }
template <int W> static inline float group_sum(float v) { for (int o = 1; o < W; o <<= 1) v += shfl_xor_t(v, o); return v; }
template <int W> static inline float group_max(float v) { for (int o = 1; o < W; o <<= 1) v = fmaxf(v, shfl_xor_t(v, o)); return v; }
static inline int bcast_lane(int v, int src) { return shfl_t(v, src); }
static inline float bcast_lane_f(float v, int src) { return shfl_t(v, src); }
static inline float wave_scan_add(float v) { const int ln = emu::cur->lane; for (int o = 1; o < 64; o <<= 1) { const float t = shfl_t(v, ln - o); if (ln >= o) v += t; } return v; }
static inline float wave_scan_max(float v) { const int ln = emu::cur->lane; for (int o = 1; o < 64; o <<= 1) { const float t = shfl_t(v, ln - o); if (ln >= o) v = fmaxf(v, t); } return v; }
static inline int readfirstlane_i(int v) { return v; }
static inline unsigned xb_ld(unsigned* p) { return *(volatile unsigned*)p; }
static inline unsigned xb_add(unsigned* p, unsigned v) { unsigned o = *p; *p = o + v; return o; }
static inline unsigned xb_xcc_id() { return (unsigned)emu::cur->bid & 7u; }
static inline void s_sleep1() { emu::yield(); }
static inline void fence_acquire() {}
static inline void fence_release() {}
static inline unsigned lds_atomic_add(unsigned* p, unsigned v) { unsigned o = *p; *p = o + v; return o; }
static inline unsigned long long rt_now() { return 0ull; }
static inline float fast_exp2(float x) { return exp2f(x); }
static inline float fast_rcp(float x) { return 1.0f / x; }
#else
#define LAS __attribute__((address_space(3)))
#define GAS __attribute__((address_space(1)))
DEV f32x4 mfma16(bf16x8 a, bf16x8 b, f32x4 c) { return __builtin_amdgcn_mfma_f32_16x16x32_bf16(a, b, c, 0, 0, 0); }
DEV f32x16 mfma32(bf16x8 a, bf16x8 b, f32x16 c) { return __builtin_amdgcn_mfma_f32_32x32x16_bf16(a, b, c, 0, 0, 0); }
#define glds16(g, l) __builtin_amdgcn_global_load_lds((const unsigned*)(g), (LAS unsigned*)(l), 16, 0, 0)
#define S_BARRIER() __builtin_amdgcn_s_barrier()
#define WAIT_VM(n) asm volatile("s_waitcnt vmcnt(" #n ")" ::: "memory")
#define WAIT_LGKM(n) asm volatile("s_waitcnt lgkmcnt(" #n ")" ::: "memory")
#define WAIT_ALL() asm volatile("s_waitcnt vmcnt(0) lgkmcnt(0)" ::: "memory")
#define SETPRIO(n) __builtin_amdgcn_s_setprio(n)
#define SCHED_BARRIER() __builtin_amdgcn_sched_barrier(0)
#define COMPILER_FENCE() asm volatile("" ::: "memory")
#define WAVE_LDS_SYNC() asm volatile("s_waitcnt lgkmcnt(0)" ::: "memory")
#define LAUNDER(x) asm volatile("" : "+v"(x))
#define NT_LOAD(p) __builtin_nontemporal_load(p)
#define NT_STORE(v, p) __builtin_nontemporal_store((v), (p))
#define CODE_ALIGN() asm volatile(".p2align 8")
#define LAUNDER_S(x) asm volatile("" : "+s"(x))
DEV int lane_id() { return (int)__builtin_amdgcn_mbcnt_hi(~0u, __builtin_amdgcn_mbcnt_lo(~0u, 0u)); }
template <class T> DEV T shfl_xor_t(T v, int m) { return __shfl_xor(v, m); }
template <class T> DEV T shfl_t(T v, int src) { return __shfl(v, src); }
template <int CTRL, int ROWMASK> DEV float dpp_mov(float v) { return __builtin_bit_cast(float, __builtin_amdgcn_update_dpp(0, __builtin_bit_cast(int, v), CTRL, ROWMASK, 0xf, false)); }
template <int CTRL, int ROWMASK> DEV float dpp_mov_keep(float oldv, float v) { return __builtin_bit_cast(float, __builtin_amdgcn_update_dpp(__builtin_bit_cast(int, oldv), __builtin_bit_cast(int, v), CTRL, ROWMASK, 0xf, false)); }
template <int W> DEV float group_sum(float v) {
    v += dpp_mov<0xB1, 0xf>(v); v += dpp_mov<0x4E, 0xf>(v);
    if (W >= 8) v += dpp_mov<0x141, 0xf>(v);
    if (W >= 16) v += dpp_mov<0x140, 0xf>(v);
    return v;
}
DEV float wave_sum(float v) {
    v = group_sum<16>(v);
    v += dpp_mov<0x142, 0xa>(v);
    v += dpp_mov<0x143, 0xc>(v);
    return __builtin_bit_cast(float, __builtin_amdgcn_readlane(__builtin_bit_cast(int, v), 63));
}
DEV float wave_max(float v) {
    v = fmaxf(v, dpp_mov_keep<0xB1, 0xf>(v, v)); v = fmaxf(v, dpp_mov_keep<0x4E, 0xf>(v, v)); v = fmaxf(v, dpp_mov_keep<0x141, 0xf>(v, v)); v = fmaxf(v, dpp_mov_keep<0x140, 0xf>(v, v));
    v = fmaxf(v, dpp_mov_keep<0x142, 0xa>(v, v)); v = fmaxf(v, dpp_mov_keep<0x143, 0xc>(v, v));
    return __builtin_bit_cast(float, __builtin_amdgcn_readlane(__builtin_bit_cast(int, v), 63));
}
template <int W> DEV float group_max(float v) {
    v = fmaxf(v, dpp_mov_keep<0xB1, 0xf>(v, v)); v = fmaxf(v, dpp_mov_keep<0x4E, 0xf>(v, v));
    if (W >= 8) v = fmaxf(v, dpp_mov_keep<0x141, 0xf>(v, v));
    if (W >= 16) v = fmaxf(v, dpp_mov_keep<0x140, 0xf>(v, v));
    return v;
}
DEV int bcast_lane(int v, int src) { return __builtin_amdgcn_readlane(v, src); }
DEV float bcast_lane_f(float v, int src) { return __builtin_bit_cast(float, __builtin_amdgcn_readlane(__builtin_bit_cast(int, v), src)); }
DEV float wave_scan_add(float v) {
    v += dpp_mov<0x111, 0xf>(v); v += dpp_mov<0x112, 0xf>(v); v += dpp_mov<0x114, 0xf>(v); v += dpp_mov<0x118, 0xf>(v);
    v += dpp_mov<0x142, 0xa>(v); v += dpp_mov<0x143, 0xc>(v); return v;
}
DEV float wave_scan_max(float v) {
    v = fmaxf(v, dpp_mov_keep<0x111, 0xf>(v, v)); v = fmaxf(v, dpp_mov_keep<0x112, 0xf>(v, v)); v = fmaxf(v, dpp_mov_keep<0x114, 0xf>(v, v)); v = fmaxf(v, dpp_mov_keep<0x118, 0xf>(v, v));
    v = fmaxf(v, dpp_mov_keep<0x142, 0xa>(v, v)); v = fmaxf(v, dpp_mov_keep<0x143, 0xc>(v, v)); return v;
}
DEV int readfirstlane_i(int v) { return __builtin_amdgcn_readfirstlane(v); }
DEV unsigned xb_ld(unsigned* p) { return __hip_atomic_load(p, __ATOMIC_RELAXED, __HIP_MEMORY_SCOPE_AGENT); }
DEV unsigned xb_add(unsigned* p, unsigned v) { return __hip_atomic_fetch_add(p, v, __ATOMIC_RELAXED, __HIP_MEMORY_SCOPE_AGENT); }
DEV unsigned xb_xcc_id() { return (unsigned)__builtin_amdgcn_s_getreg((3 << 11) | 20) & 0xFu; }
DEV void s_sleep1() { __builtin_amdgcn_s_sleep(1); }
DEV void fence_acquire() { __builtin_amdgcn_fence(__ATOMIC_ACQUIRE, "agent"); }
DEV void fence_release() { __builtin_amdgcn_fence(__ATOMIC_RELEASE, "agent"); }
DEV unsigned lds_atomic_add(LAS unsigned* p, unsigned v) { return __hip_atomic_fetch_add(p, v, __ATOMIC_RELAXED, __HIP_MEMORY_SCOPE_WORKGROUP); }
DEV unsigned long long rt_now() { return __builtin_amdgcn_s_memrealtime(); }
DEV float fast_exp2(float x) { return __builtin_amdgcn_exp2f(x); }
DEV float fast_rcp(float x) { return __builtin_amdgcn_rcpf(x); }
#endif

#ifdef EMU
DEV unsigned f2bf(float f) { unsigned u = __builtin_bit_cast(unsigned, f); return (u + 0x7fffu + ((u >> 16) & 1u)) >> 16; }
DEV unsigned pk2(float lo, float hi) { return f2bf(lo) | (f2bf(hi) << 16); }
DEV unsigned f2bf_sw(float f) { return f2bf(f); }
DEV unsigned pk2_sw(float lo, float hi) { return pk2(lo, hi); }
#else
typedef float f32x2n_t __attribute__((ext_vector_type(2)));
typedef __bf16 bf16x2n_t __attribute__((ext_vector_type(2)));
DEV unsigned pk2(float lo, float hi) { const f32x2n_t v = {lo, hi}; return __builtin_bit_cast(unsigned, __builtin_convertvector(v, bf16x2n_t)); }
DEV unsigned f2bf(float f) { return (unsigned)__builtin_bit_cast(unsigned short, (__bf16)f); }
DEV unsigned f2bf_sw(float f) { unsigned u = __builtin_bit_cast(unsigned, f); return (u + 0x7fffu + ((u >> 16) & 1u)) >> 16; }
DEV unsigned pk2_sw(float lo, float hi) { return f2bf_sw(lo) | (f2bf_sw(hi) << 16); }
#endif
DEV float bf2f(unsigned b) { return __builtin_bit_cast(float, b << 16); }
DEV float bflo(unsigned w) { return __builtin_bit_cast(float, w << 16); }
DEV float bfhi(unsigned w) { return __builtin_bit_cast(float, w & 0xffff0000u); }
DEV float sigmoid_f(float x) { return 1.0f / (1.0f + expf(-x)); }
DEV float silu_f(float x) { return x / (1.0f + expf(-x)); }
DEV float softplus_f(float x) { return fmaxf(x, 0.0f) + log1pf(expf(-fabsf(x))); }
DEV float fast_sigmoid(float x) { return fast_rcp(1.0f + fast_exp2(-1.4426950408889634f * x)); }
DEV float fast_silu(float x) { return x * fast_sigmoid(x); }
DEV float gelu_tanh_f(float x) { const float u = 0.7978845608028654f * (x + 0.044715f * x * x * x); return x * fast_sigmoid(2.0f * u); }
DEV float fast_exp(float x) { return fast_exp2(1.4426950408889634f * x); }

#define XB_TMO      128
#define XB_XCNT(j)  (256  + 64 * (j))
#define XB_XSUB(j)  (1280 + 64 * (j))
#define XB_XGEN(j)  (2304 + 64 * (j))
#define XB_TOP      3328
#define XB_TOPGEN   3392
#define XCD_BAR_WORDS 3456
#define XB_SPIN_CAP (1u << 20)
#define XB_SPIN(cond, bar) do { unsigned _sp = 0; while (cond) { s_sleep1(); \
    if ((++_sp & 255u) == 0u) { if (xb_ld(&(bar)[XB_TMO])) break; if (_sp > XB_SPIN_CAP) { xb_add(&(bar)[XB_TMO], 1u); break; } } } } while (0)
struct XcdBarrier { unsigned* bar; unsigned x; volatile LAS unsigned* st; int wave; };
DEV XcdBarrier xcd_barrier_post(unsigned* bar, volatile LAS unsigned* st, int wave) {
    XcdBarrier b; b.wave = wave; b.bar = bar; b.x = (unsigned)readfirstlane_i((int)xb_xcc_id()); b.st = st;
    if (wave == 0 && lane_id() == 0) (void)xb_add(&bar[XB_XCNT(b.x)], 1u);
    return b;
}
DEV void xcd_barrier_complete(unsigned* bar, unsigned x, unsigned& nloc, unsigned& nx) {
    const unsigned G = gridDim.x;
    unsigned sum, cnt, mine, sp = 0u;
    for (;;) {
        sum = 0u; cnt = 0u; mine = 0u;
#pragma unroll
        for (unsigned j = 0; j < 16; ++j) { const unsigned c = xb_ld(&bar[XB_XCNT(j)]); sum += c; cnt += (c > 0u) ? 1u : 0u; mine = (j == x) ? c : mine; }
        if (sum == G) break;
        s_sleep1();
        if ((++sp & 255u) == 0u) { if (xb_ld(&bar[XB_TMO])) break; if (sp > XB_SPIN_CAP) { xb_add(&bar[XB_TMO], 1u); break; } }
    }
    nloc = mine > 0u ? mine : 1u; nx = cnt > 0u ? cnt : 1u;
}
DEV void xcd_barrier(const XcdBarrier& b) {
    WAIT_VM(0);
    __syncthreads();
    int bw = b.wave; LAUNDER_S(bw);
    if (bw == 0 && lane_id() == 0) {
        unsigned* bar = b.bar; LAUNDER_S(bar);
        unsigned bx = b.x; LAUNDER_S(bx);
        WAIT_ALL();
        unsigned nloc = b.st[0], nx = b.st[1];
        if (nloc == 0u) { xcd_barrier_complete(bar, bx, nloc, nx); b.st[0] = nloc; b.st[1] = nx; }
        const unsigned old = xb_add(&bar[XB_XSUB(bx)], 1u);
        const unsigned gen = old / nloc;
        if (old + 1u == (gen + 1u) * nloc) {
            fence_release();
            WAIT_VM(0);
            const unsigned og = xb_add(&bar[XB_TOP], 1u);
            const unsigned tg = og / nx;
            if (og + 1u == (tg + 1u) * nx) xb_add(&bar[XB_TOPGEN], 1u);
            else XB_SPIN(xb_ld(&bar[XB_TOPGEN]) == tg, bar);
            fence_acquire();
            xb_add(&bar[XB_XGEN(bx)], 1u);
            WAIT_VM(0);
        } else {
            XB_SPIN(xb_ld(&bar[XB_XGEN(bx)]) == gen, bar);
            fence_acquire();
            WAIT_VM(0);
        }
    }
    __syncthreads();
}

namespace pg8 {
constexpr int BM = 256, BK = 64, HALF = 128, HTB = HALF * BK * 2, STAGE_BYTES = 8 * HTB;
DEV int lds_byte(int r, int c) { const int st = (r >> 4) * 2 + (c >> 5), rr = r & 15, cc = c & 31, ob = rr * 64 + cc * 2; return st * 1024 + (ob ^ (((ob >> 9) & 1) << 5)); }
DEV void stage_rc(int b, int& R, int& C) { const int st = b / 1024, sb = b % 1024, swz = sb ^ (((sb >> 9) & 1) << 5); R = (st >> 1) * 16 + swz / 64; C = (st & 1) * 32 + (swz % 64) / 2; }
DEV int perm32(int rho) { const int n = rho >> 4, i = rho & 15; return 8 * (i >> 2) + 4 * n + (i & 3); }
struct Unit { const char* A; const char* B; int pm, pn, e; };
#ifdef EMU
static inline unsigned cvt_pk_bf16(float lo, float hi) { return pk2(lo, hi); }
#else
DEV unsigned cvt_pk_bf16(float lo, float hi) { return pk2(lo, hi); }
#endif
template <class Epi, class Sched>
DEV void gemm_phase(LAS unsigned char* lds, const int K, const Sched& S, const Epi& E, const int wid, const int lane) {
    const int tid = wid * 64 + lane; const int wr = wid >> 2, wc = wid & 3, fr = lane & 15, fq = lane >> 4;
    const int nt = K / BK;
    unsigned voffA[2], voffB[2];
#pragma unroll
    for (int i = 0; i < 2; ++i) { int R, C; stage_rc(tid * 16 + i * 8192, R, C); const int Rb = Epi::PERM ? ((R & ~31) + perm32(R & 31)) : R;
        voffA[i] = (unsigned)(R * K + C) * 2u; voffB[i] = (unsigned)(Rb * K + C) * 2u; }
    const size_t kstep = (size_t)(BK * 2);
    const size_t hstep = (size_t)HALF * K * 2;
    const unsigned ldsw = (unsigned)wid * 1024u;
    const int aoff = lds_byte(wr * 64 + fr, fq * 8), boff = lds_byte(wc * 32 + fr, fq * 8);
#define PG8_SA(b, h) (((b) * 2 + (h)) * HTB)
#define PG8_SB(b, h) ((4 + (b) * 2 + (h)) * HTB)
#define PG8_STAGE(bufoff, gbase, voff) do { _Pragma("unroll") for (int _i = 0; _i < 2; ++_i) \
        glds16(((const char*)(gbase) + (voff)[_i]), (lds + (bufoff) + ldsw + _i * 8192)); } while (0)
#define PG8_LDA(dst, b, h) do { _Pragma("unroll") for (int m = 0; m < 4; ++m) _Pragma("unroll") for (int k = 0; k < 2; ++k) dst[m][k] = *(const LAS bf16x8*)(lds + PG8_SA(b, h) + aoff + m * 2048 + k * 1024); } while (0)
#define PG8_LDB(dst, b, h) do { _Pragma("unroll") for (int n = 0; n < 2; ++n) _Pragma("unroll") for (int k = 0; k < 2; ++k) dst[n][k] = *(const LAS bf16x8*)(lds + PG8_SB(b, h) + boff + n * 2048 + k * 1024); } while (0)
#define PG8_MMA(ai, bj, At, Bt) do { SETPRIO(1); _Pragma("unroll") for (int m = 0; m < 4; ++m) _Pragma("unroll") for (int n = 0; n < 2; ++n) _Pragma("unroll") for (int k = 0; k < 2; ++k) \
        acc[ai][bj][m][n] = mfma16(Bt[n][k], At[m][k], acc[ai][bj][m][n]); SETPRIO(0); } while (0)
    Unit cur, nxt; int ui = 0;
    if (!S.next(0, cur)) return;
    f32x4 acc[2][2][4][2];
#pragma unroll
    for (int a = 0; a < 2; ++a)
#pragma unroll
        for (int b = 0; b < 2; ++b)
#pragma unroll
            for (int m = 0; m < 4; ++m)
#pragma unroll
                for (int n = 0; n < 2; ++n) acc[a][b][m][n] = (f32x4){0.f, 0.f, 0.f, 0.f};
    bf16x8 At[4][2], B0[2][2], B1[2][2];
    const char* cA = cur.A; const char* cB = cur.B;
    PG8_STAGE(PG8_SB(0, 0), cB, voffB); PG8_STAGE(PG8_SB(0, 1), cB + hstep, voffB); PG8_STAGE(PG8_SA(0, 0), cA, voffA); PG8_STAGE(PG8_SA(0, 1), cA + hstep, voffA);
    if (wr == 1) S_BARRIER();
    WAIT_VM(2); S_BARRIER();
    PG8_STAGE(PG8_SB(1, 0), cB + kstep, voffB); PG8_STAGE(PG8_SA(1, 0), cA + kstep, voffA); PG8_STAGE(PG8_SB(1, 1), cB + hstep + kstep, voffB);
    WAIT_VM(6); S_BARRIER();
    CODE_ALIGN();
    for (;;) {
        const bool has_next = S.next(ui + 1, nxt);
        const char* nA = has_next ? nxt.A : cA; const char* nB = has_next ? nxt.B : cB;
        for (int t = 0; t < nt; t += 2) {
            const bool last = (t == nt - 2);
            const char* a1 = cA + (size_t)(t + 1) * kstep;
            const char* a2 = last ? nA : cA + (size_t)(t + 2) * kstep; const char* b2 = last ? nB : cB + (size_t)(t + 2) * kstep;
            const char* a3 = a2 + kstep; const char* b3 = b2 + kstep;
            PG8_LDB(B0, 0, 0); PG8_LDB(B1, 0, 1); SCHED_BARRIER(); PG8_LDA(At, 0, 0); PG8_STAGE(PG8_SA(1, 1), a1 + hstep, voffA);
            WAIT_VM(8); WAIT_LGKM(0); S_BARRIER(); PG8_MMA(0, 0, At, B0); PG8_MMA(0, 1, At, B1); S_BARRIER(); SCHED_BARRIER();
            PG8_LDA(At, 0, 1); PG8_STAGE(PG8_SB(0, 0), b2, voffB); PG8_STAGE(PG8_SB(0, 1), b2 + hstep, voffB); PG8_STAGE(PG8_SA(0, 0), a2, voffA);
            WAIT_VM(8); WAIT_LGKM(0); S_BARRIER(); PG8_MMA(1, 0, At, B0); PG8_MMA(1, 1, At, B1); S_BARRIER(); SCHED_BARRIER();
            PG8_LDB(B0, 1, 0); PG8_LDB(B1, 1, 1); SCHED_BARRIER(); PG8_LDA(At, 1, 0); PG8_STAGE(PG8_SA(0, 1), a2 + hstep, voffA);
            WAIT_VM(8); WAIT_LGKM(0); S_BARRIER(); PG8_MMA(0, 0, At, B0); PG8_MMA(0, 1, At, B1); S_BARRIER(); SCHED_BARRIER();
            PG8_LDA(At, 1, 1); PG8_STAGE(PG8_SB(1, 0), b3, voffB); PG8_STAGE(PG8_SB(1, 1), b3 + hstep, voffB); PG8_STAGE(PG8_SA(1, 0), a3, voffA);
            WAIT_VM(8); WAIT_LGKM(0); S_BARRIER(); PG8_MMA(1, 0, At, B0); PG8_MMA(1, 1, At, B1); S_BARRIER(); SCHED_BARRIER();
        }
        if (wr == 0) S_BARRIER();
        E(acc, cur, wr, wc, fr, fq);
        if (!has_next) break;
#pragma unroll
        for (int a = 0; a < 2; ++a)
#pragma unroll
            for (int b = 0; b < 2; ++b)
#pragma unroll
                for (int m = 0; m < 4; ++m)
#pragma unroll
                    for (int n = 0; n < 2; ++n) acc[a][b][m][n] = (f32x4){0.f, 0.f, 0.f, 0.f};
        cur = nxt; cA = nA; cB = nB; ++ui;
        if (wr == 1) S_BARRIER();
    }
    WAIT_VM(0);
    S_BARRIER();
#undef PG8_SA
#undef PG8_SB
#undef PG8_STAGE
#undef PG8_LDA
#undef PG8_LDB
#undef PG8_MMA
}

struct PlainOrder {
    const char* A; const char* Bt; int K, nM, nN, nwg, G, c;
    DEV void init(const void* A_, const void* Bt_, int K_, int M, int N, int G_, int c_) { A = (const char*)A_; Bt = (const char*)Bt_; K = K_; nM = M / BM; nN = N / BM; nwg = nM * nN; G = G_; c = c_; }
    DEV bool next(int i, Unit& u) const {
        const long L = (long)i * G + c; if (L >= nwg) return false;
        int wgid = (int)L; { const int q = nwg / 8, r = nwg % 8, xcd = wgid % 8, off = wgid / 8; wgid = (xcd < r ? xcd * (q + 1) : r * (q + 1) + (xcd - r) * q) + off; }
        const int nig = 8 * nN, gid = wgid / nig, fm = gid * 8, gsz = (nM - fm) < 8 ? (nM - fm) : 8;
        u.pm = fm + ((wgid % nig) % gsz); u.pn = (wgid % nig) / gsz; u.e = 0;
        u.A = A + (size_t)u.pm * BM * K * 2; u.B = Bt + (size_t)u.pn * BM * K * 2; return true;
    }
};
struct GroupedOrder {
    const char* A; const char* Bt; int K, nMe, nN, nwg, G, c; size_t bstride;
    DEV void init(const void* A_, const void* Bt_, int K_, int N, int G_, int c_, int erows) { A = (const char*)A_; Bt = (const char*)Bt_; K = K_; nMe = (erows + BM - 1) / BM; nN = N / BM; nwg = NE * nMe * nN; G = G_; c = c_; bstride = (size_t)N * K * 2; }
    DEV bool next(int i, Unit& u) const {
        const long L = (long)i * G + c; if (L >= nwg) return false;
        int wgid = (int)L; { const int q = nwg / 8, r = nwg % 8, xcd = wgid % 8, off = wgid / 8; wgid = (xcd < r ? xcd * (q + 1) : r * (q + 1) + (xcd - r) * q) + off; }
        const int per_e = nMe * nN; const int e = wgid / per_e, w = wgid % per_e;
        u.e = e; u.pm = w % nMe; u.pn = w / nMe;
        u.A = A + ((size_t)e * EPAD + (size_t)u.pm * BM) * K * 2; u.B = Bt + (size_t)e * bstride + (size_t)u.pn * BM * K * 2; return true;
    }
};
}

struct Args { const float* in[N_IN]; float* out; unsigned char* ws; };

struct Frame {
    const float* const* in; GAS float* out; GAS unsigned char* ws; LAS unsigned char* lds;
    int tid, lane, wave, G, bid, gw, NGW;
};

#define HROW(F, l, r) ((l) == 0 ? ((r) < LATR ? GIN(I_X) + (size_t)(r) * 1024 : GIN(I_CTX) + (size_t)((r) - LATR) * 1024) : (const float*)((F).ws + WS_H) + (size_t)(r) * 1024)

DEV Frame refresh(const Frame& F0) {
    Frame F = F0; int w = F0.wave; LAUNDER_S(w); int ln = lane_id(); LAUNDER(ln);
    F.wave = w; F.lane = ln; F.tid = w * 64 + ln; F.gw = F.bid * NWAVES + w;
    GAS unsigned char* ws = F0.ws; LAUNDER_S(ws); F.ws = ws;
    return F;
}

#define GIN(k) ((const float*)(GAS const float*)F.in[k])

#define ROW_LOOP(r, NROWS) for (int r = F.gw; r < (NROWS); r += F.NGW)

DEV int tok_row(int b, int d, int sp) {
    if (sp < CTX) return LATR + b * CTX + (d ? (CTX - 1 - sp) : sp);
    const int j = sp - CTX; return b * SEQ + (d ? (SEQ - 1 - j) : j);
}
DEV void row_bs(int r, int& b, int& s) { if (r < LATR) { b = r / SEQ; s = CTX + r % SEQ; } else { const int q = r - LATR; b = q / CTX; s = q % CTX; } }

DEV void tr_item(const float* W, int ldw, int col0, int k0, bf16_t* WT, int K, int row0, LAS float* scr, int lane) {
#pragma unroll 8
    for (int i = 0; i < 32; ++i) { const int kk = 2 * i + (lane >> 5); scr[kk * 33 + (lane & 31)] = NT_LOAD(&W[(size_t)(k0 + kk) * ldw + col0 + (lane & 31)]); }
    WAVE_LDS_SYNC();
    const int c = lane & 7;
#pragma unroll
    for (int j = 0; j < 4; ++j) { const int n = (lane >> 3) + 8 * j; const LAS float* s = scr + (8 * c) * 33 + n;
        u32x4 o; o.x = pk2(s[0 * 33], s[1 * 33]); o.y = pk2(s[2 * 33], s[3 * 33]); o.z = pk2(s[4 * 33], s[5 * 33]); o.w = pk2(s[6 * 33], s[7 * 33]);
        NT_STORE(o, (u32x4*)(WT + (size_t)(row0 + n) * K + k0 + 8 * c)); }
    WAVE_LDS_SYNC();
}

DEV void phase_prologue_a(const Frame& F0) {
    const Frame F = refresh(F0);
    LAS float* scr = (LAS float*)(F.lds + F.wave * 16384);
    for (int l = 0; l < DEPTH; ++l) {
        const int odd = l & 1, li = l >> 1;
        const float* win = odd ? GIN(I_ODWIN) + (size_t)li * 1024 * 2576 : GIN(I_EVWIN) + (size_t)li * 1024 * 4112;
        const int ldw = odd ? 2576 : 4112, nin = odd ? NIN_O : NIN_E;
        bf16_t* wint = (bf16_t*)(F.ws + WS_WIN) + (size_t)l * NINMAX * 1024;
        for (int it = F.gw; it < 16 * (nin / 32); it += F.NGW) { const int kb = it / (nin / 32), nb = it % (nin / 32); const int d0 = 32 * nb;
            tr_item(win, ldw, d0 < 2048 ? d0 : d0 + 16, 64 * kb, wint, 1024, d0, scr, F.lane); }
        const float* wout = odd ? GIN(I_ODWOUT) + (size_t)li * 1024 * 1024 : GIN(I_EVWOUT) + (size_t)li * 1024 * 1024;
        bf16_t* woutt = (bf16_t*)(F.ws + WS_WOUT) + (size_t)l * 1024 * 1024;
        for (int it = F.gw; it < 16 * 32; it += F.NGW) { const int kb = it / 32, nb = it % 32; tr_item(wout, 1024, 32 * nb, 64 * kb, woutt, 1024, 32 * nb, scr, F.lane); }
        if (odd) {
            const float* wglu = GIN(I_ODWGLU) + (size_t)li * 512 * 512; bf16_t* wglut = (bf16_t*)(F.ws + WS_WGLU) + (size_t)li * 512 * 512;
            for (int it = F.gw; it < 8 * 16; it += F.NGW) { const int kb = it / 16, nb = it % 16; tr_item(wglu, 512, 32 * nb, 64 * kb, wglut, 512, 32 * nb, scr, F.lane); }
        }
        constexpr int GU_NB = 2 * FF / 32, GU_ITEMS = 16 * GU_NB;
        for (int it = F.gw; it < NE * GU_ITEMS; it += F.NGW) { const int e = it / GU_ITEMS, r = it % GU_ITEMS, kb = r / GU_NB, nb = r % GU_NB; const int d0 = 32 * nb, j = d0 >> 8, w = d0 & 255;
            const float* src = (w < 128 ? GIN(I_WGATE) : GIN(I_WUP)) + ((size_t)l * NE + e) * 1024 * FF;
            tr_item(src, FF, 128 * j + (w & 127), 64 * kb, (bf16_t*)(F.ws + WS_WGU) + ((size_t)l * NE + e) * 2 * FF * 1024, 1024, d0, scr, F.lane); }
        constexpr int D_ITEMS = (FF / 64) * 32;
        for (int it = F.gw; it < NE * D_ITEMS; it += F.NGW) { const int e = it / D_ITEMS, r = it % D_ITEMS, kb = r / 32, nb = r % 32;
            tr_item(GIN(I_WDOWN) + ((size_t)l * NE + e) * FF * 1024, 1024, 32 * nb, 64 * kb, (bf16_t*)(F.ws + WS_WD) + ((size_t)l * NE + e) * 1024 * FF, FF, 32 * nb, scr, F.lane); }
    }
    const int gt = F.bid * NTHREADS + F.tid, NGT = F.G * NTHREADS;
    for (int i = gt; i < DEPTH * 16 * 1024; i += NGT) { const int l = i / 16384, g = (i >> 10) & 15, k = i & 1023; const int odd = l & 1, li = l >> 1;
        ((float*)(F.ws + WS_WG))[i] = odd ? GIN(I_ODWIN)[((size_t)li * 1024 + k) * 2576 + 2048 + g] : GIN(I_EVWIN)[((size_t)li * 1024 + k) * 4112 + 2048 + g]; }
    for (int i = gt; i < DEPTH * NE * 1024; i += NGT) { const int k = i & 1023, e = (i >> 10) % NE, l = i / (NE * 1024); ((float*)(F.ws + WS_WR))[i] = GIN(I_WROUTER)[((size_t)l * 1024 + k) * NE + e]; }
    for (int i = gt; i < N_ODD * 2 * 32 * 64; i += NGT) { const int p = i & 63, g = (i >> 6) & 31, d = (i >> 11) & 1, o = i >> 12;
        const int idx = ((o * 2 + d) * 32 + g) * 64 + p;
        const float lr = fminf(GIN(I_ODLRE)[idx], -1e-4f), li_ = GIN(I_ODLIM)[idx], dt = expf(GIN(I_ODLDT)[(o * 2 + d) * 32 + g]);
        const float mag = expf(lr * dt); float sn, cs; sincosf(li_ * dt, &sn, &cs); const float are = mag * cs, aim = mag * sn;
        float* A = (float*)(F.ws + WS_S5A) + (size_t)((o * 2 + d) * 32 + g) * 128; A[p] = are; A[64 + p] = aim;
        const float xr = are - 1.0f, xi = aim, den = lr * lr + li_ * li_; const float fre = (xr * lr + xi * li_) / den, fim = (xi * lr - xr * li_) / den;
        bf16_t* Bb = (bf16_t*)(F.ws + WS_S5B) + (size_t)((o * 2 + d) * 32 + g) * 128 * 16;
        for (int h = 0; h < 16; ++h) { const float br = GIN(I_ODBRE)[((size_t)(o * 32 + g) * 64 + p) * 16 + h], bi = GIN(I_ODBIM)[((size_t)(o * 32 + g) * 64 + p) * 16 + h];
            Bb[p * 16 + h] = (bf16_t)f2bf(fre * br - fim * bi); Bb[(64 + p) * 16 + h] = (bf16_t)f2bf(fre * bi + fim * br); } }
    for (int i = gt; i < N_ODD * 32 * 16 * 64; i += NGT) { const int p = i & 63, c = (i >> 6) & 15, g = (i >> 10) & 31, o = i >> 15;
        bf16_t* Cm = (bf16_t*)(F.ws + WS_S5C) + (size_t)((o * 32 + g) * 16 + c) * 128;
        Cm[2 * p] = (bf16_t)f2bf(GIN(I_ODCRE)[i]); Cm[2 * p + 1] = (bf16_t)f2bf(-GIN(I_ODCIM)[i]); }
    ROW_LOOP(r, MPAD) {
        f32x4* dst = (f32x4*)((float*)(F.ws + WS_H) + (size_t)r * 1024) + F.lane;
        if (r < MROWS) { }
        else {
#pragma unroll
            for (int j = 0; j < 4; ++j) dst[64 * j] = (f32x4){0.f, 0.f, 0.f, 0.f};
            u32x4* xz = (u32x4*)((bf16_t*)(F.ws + WS_XIN) + (size_t)r * 1024) + F.lane; xz[0] = (u32x4){0u, 0u, 0u, 0u}; xz[64] = (u32x4){0u, 0u, 0u, 0u};
            u32x4* mz = (u32x4*)((bf16_t*)(F.ws + WS_MERGED) + (size_t)r * 1024) + F.lane; mz[0] = (u32x4){0u, 0u, 0u, 0u}; mz[64] = (u32x4){0u, 0u, 0u, 0u};
            u32x4* yz = (u32x4*)((bf16_t*)(F.ws + WS_YS) + (size_t)r * 512) + F.lane; yz[0] = (u32x4){0u, 0u, 0u, 0u};
        }
    }
    __syncthreads();
    LAS float* sv = (LAS float*)F.lds;
    LAS float* part = (LAS float*)(F.lds + 32768);
    for (int i = F.tid; i < NR * 1024; i += NTHREADS) { const int r = i >> 10, k = i & 1023; const float c = r < B_ ? GIN(I_C)[r * 1024 + k] : GIN(I_CCTX)[k]; sv[i] = silu_f(c); }
    __syncthreads();
    for (int it = F.bid; it < DEPTH * 96; it += F.G) {
        const int l = it / 96, j = (it % 96) * 64 + F.lane;
        const float* w = GIN(I_WMOD) + (size_t)l * 1024 * 6144 + j;
        float acc[NR];
#pragma unroll
        for (int r = 0; r < NR; ++r) acc[r] = 0.f;
        const int k0 = F.wave * 128;
#pragma unroll 8
        for (int k = 0; k < 128; ++k) { const float wv = w[(size_t)(k0 + k) * 6144];
#pragma unroll
            for (int r = 0; r < NR; ++r) acc[r] += sv[r * 1024 + k0 + k] * wv; }
#pragma unroll
        for (int r = 0; r < NR; ++r) part[(F.wave * NR + r) * 64 + F.lane] = acc[r];
        __syncthreads();
        for (int i = F.tid; i < NR * 64; i += NTHREADS) { const int r = i >> 6, jj = i & 63; float s = 0.f;
#pragma unroll
            for (int w8 = 0; w8 < 8; ++w8) s += part[(w8 * NR + r) * 64 + jj];
            const int col = (it % 96) * 64 + jj;
            ((float*)(F.ws + WS_MOD))[((size_t)l * NR + r) * 6144 + col] = s + GIN(I_BMOD)[l * 6144 + col]; }
        __syncthreads();
    }
}

static_assert(TOK % 4 == 0 && CTX % 4 == 0 && MROWS % 4 == 0, "row groups");
#define ROW_GROUPS(nrows, CALL4, CALL2) do { const int _r4 = ((nrows) / (4 * F.NGW)) * (4 * F.NGW); \
    for (int r = 4 * F.gw; r < _r4; r += 4 * F.NGW) { CALL4; } for (int r = _r4 + 2 * F.gw; r < (nrows); r += 2 * F.NGW) { CALL2; } } while (0)
template <int RG> DEV void xg_rows(const Frame& F, int l, int row0, f32x4 (&v)[RG][4]) {
    int b, s; row_bs(row0, b, s); const int mr = s < CTX ? B_ : b;
    const float* mod = (const float*)(F.ws + WS_MOD) + ((size_t)l * NR + mr) * 6144;
#pragma unroll
    for (int j = 0; j < 4; ++j) { const f32x4 sh = *((const f32x4*)mod + F.lane + 64 * j), sc = *((const f32x4*)(mod + 1024) + F.lane + 64 * j);
#pragma unroll
        for (int q = 0; q < RG; ++q) v[q][j] = v[q][j] * (1.0f + sc) + sh; }
#pragma unroll
    for (int q = 0; q < RG; ++q) { u32x2* xo = (u32x2*)((bf16_t*)(F.ws + WS_XIN) + (size_t)(row0 + q) * 1024) + F.lane;
#pragma unroll
        for (int j = 0; j < 4; ++j) xo[64 * j] = (u32x2){pk2(v[q][j].x, v[q][j].y), pk2(v[q][j].z, v[q][j].w)}; }
    const float* wg = (const float*)(F.ws + WS_WG) + (size_t)l * 16 * 1024;
    float mine[RG]; const int gi = F.lane & 15;
#pragma unroll
    for (int q = 0; q < RG; ++q) mine[q] = 0.f;
    f32x4 wc[4];
#pragma unroll
    for (int j = 0; j < 4; ++j) wc[j] = *((const f32x4*)wg + F.lane + 64 * j);
#pragma unroll 1
    for (int g = 0; g < 16; ++g) { f32x4 wn[4]; const int gn = g + 1 < 16 ? g + 1 : g;
#pragma unroll
        for (int j = 0; j < 4; ++j) wn[j] = *((const f32x4*)(wg + gn * 1024) + F.lane + 64 * j);
#pragma unroll
        for (int q = 0; q < RG; ++q) { float p = 0.f;
#pragma unroll
            for (int j = 0; j < 4; ++j) p += v[q][j].x * wc[j].x + v[q][j].y * wc[j].y + v[q][j].z * wc[j].z + v[q][j].w * wc[j].w;
            const float t = wave_sum(p); mine[q] = (gi == g) ? t : mine[q]; }
#pragma unroll
        for (int j = 0; j < 4; ++j) wc[j] = wn[j]; }
    const int ty = gi >> 2, hh = gi & 3, li = l >> 1;
#pragma unroll
    for (int q = 0; q < RG; ++q) { float o;
        if (!(l & 1)) {
            if (ty < 2) o = -expf(GIN(I_EVALOG)[(li * 2 + ty) * 4 + hh]) * softplus_f(mine[q] + GIN(I_EVDTB)[(li * 2 + ty) * 4 + hh]);
            else o = sigmoid_f(mine[q]);
        } else {
            const int d = ty & 1, k = ty >> 1; const float gb = GIN(I_ODGB)[((li * 2 + d) * 2 + k) * 4 + hh];
            o = k ? -softplus_f(-(mine[q] + gb)) : mine[q] + gb;
        }
        if (F.lane < 16) ((float*)(F.ws + WS_GATES))[(size_t)(row0 + q) * 16 + gi] = o; }
}

template <int RG> DEV void xg0_group(const Frame& F, int r) {
        f32x4 v[RG][4];
#pragma unroll
        for (int q = 0; q < RG; ++q) { const f32x4* hr = (const f32x4*)HROW(F, 0, r + q) + F.lane;
#pragma unroll
            for (int j = 0; j < 4; ++j) v[q][j] = hr[64 * j]; }
        xg_rows<RG>(F, 0, r, v);
    }
DEV void phase_xg0(const Frame& F0) {
    const Frame F = refresh(F0);
    ROW_GROUPS(MROWS, xg0_group<4>(F, r), xg0_group<2>(F, r));
}

template <int RG> DEV void prep_group(const Frame& F, int l, int r) {

    const int odd = l & 1, li = l >> 1; const int nin = odd ? NIN_O : NIN_E, nseg = odd ? 2 : 3, qld = odd ? 1024 : 1536;
    const bf16_t* P = (const bf16_t*)(F.ws + WS_P); bf16_t* Q = (bf16_t*)(F.ws + WS_QKV);
    const float* cw = odd ? GIN(I_ODCONV) + (size_t)li * 9 * 1024 : GIN(I_EVCONV) + (size_t)li * 9 * 1536; const int cch = odd ? 1024 : 1536;
    {
        int b, s; row_bs(r, b, s); const bool lat = s >= CTX; const int rr = lat ? (s - CTX) >> 6 : 0, cc = lat ? (s - CTX) & 63 : s;
        const int ncol = lat ? 64 : CTX;
        for (int seg = 0; seg < nseg; ++seg) {
            const int ch0 = seg * 512 + F.lane * 8; float a[RG][8];
#pragma unroll
            for (int q = 0; q < RG; ++q)
#pragma unroll
                for (int i = 0; i < 8; ++i) a[q][i] = 0.f;
#pragma unroll
            for (int kh = 0; kh < 3; ++kh) {
                const int r2 = rr + kh - 1; const bool rok = lat ? (r2 >= 0 && r2 < SEQ / 64) : (kh == 1); const int r2c = rok ? r2 : rr;
                f32x4 w0[3], w1[3];
#pragma unroll
                for (int kw = 0; kw < 3; ++kw) { w0[kw] = *(const f32x4*)(cw + (kh * 3 + kw) * cch + ch0); w1[kw] = *(const f32x4*)(cw + (kh * 3 + kw) * cch + ch0 + 4); }
                const int rowbase = lat ? b * SEQ + r2c * 64 : LATR + b * CTX;
                u32x4 pv[RG + 2];
#pragma unroll
                for (int dc = 0; dc < RG + 2; ++dc) { const int c2 = cc - 1 + dc; const bool ok = rok && c2 >= 0 && c2 < ncol; const int c2c = ok ? c2 : cc;
                    const u32x4 t4 = *(const u32x4*)(P + (size_t)(rowbase + c2c) * nin + ch0); pv[dc] = ok ? t4 : (u32x4){0u, 0u, 0u, 0u}; }
#pragma unroll
                for (int dc = 0; dc < RG + 2; ++dc) {
                    const float x0 = bflo(pv[dc].x), x1 = bfhi(pv[dc].x), x2 = bflo(pv[dc].y), x3 = bfhi(pv[dc].y), x4 = bflo(pv[dc].z), x5 = bfhi(pv[dc].z), x6 = bflo(pv[dc].w), x7 = bfhi(pv[dc].w);
#pragma unroll
                    for (int q = 0; q < RG; ++q) { const int kw = dc - q;
                        if (kw >= 0 && kw <= 2) { a[q][0] += x0 * w0[kw].x; a[q][1] += x1 * w0[kw].y; a[q][2] += x2 * w0[kw].z; a[q][3] += x3 * w0[kw].w;
                            a[q][4] += x4 * w1[kw].x; a[q][5] += x5 * w1[kw].y; a[q][6] += x6 * w1[kw].z; a[q][7] += x7 * w1[kw].w; } } }
            }
#pragma unroll
            for (int q = 0; q < RG; ++q) {
                float ss = 0.f;
#pragma unroll
                for (int i = 0; i < 8; ++i) { a[q][i] = fast_silu(a[q][i]); ss += a[q][i] * a[q][i]; }
                float sc = 1.0f;
                if (!odd) { if (seg < 2) { ss = group_sum<16>(ss); sc = 1.0f / sqrtf(ss + 1e-6f); if (seg == 0) sc *= HD_SCALE; } }
                else if (seg == 1) sc = HD_SCALE;
                u32x4 o; o.x = pk2(a[q][0] * sc, a[q][1] * sc); o.y = pk2(a[q][2] * sc, a[q][3] * sc); o.z = pk2(a[q][4] * sc, a[q][5] * sc); o.w = pk2(a[q][6] * sc, a[q][7] * sc);
                *(u32x4*)(Q + (size_t)(r + q) * qld + ch0) = o;
            }
        }
    }
}
DEV void phase_prep(const Frame& F0, int l) {
    const Frame F = refresh(F0);
    const int odd = l & 1;
    ROW_GROUPS(MROWS, prep_group<4>(F, l, r), prep_group<2>(F, l, r));

    if (odd) {
        const float* GT = (const float*)(F.ws + WS_GATES); float* MC = (float*)(F.ws + WS_MCH);
        for (int c = F.gw; c < B_ * 4 * 2; c += F.NGW) { const int d = c & 1, hh = (c >> 1) & 3, b = c >> 3; float m = 0.f;
            for (int n = 0; n < NCH; ++n) { const int row = tok_row(b, d, n * 64 + F.lane);
                const float lin = GT[(size_t)row * 16 + d * 4 + hh], lf = GT[(size_t)row * 16 + 8 + d * 4 + hh];
                const float bc = wave_scan_add(lf);
                const float bend = bcast_lane_f(bc, 63); const float amax = wave_max(bend - bc + lin);
                if (F.lane == 0) MC[(size_t)c * NCH + n] = m;
                m = fmaxf(bend + m, amax); }
        }
    }
}

DEV int swz256(int r, int k) { return r * 256 + 16 * (k ^ (r & 15)); }
DEV int swz128(int r, int k) { return r * 128 + 16 * (k ^ ((r >> 1) & 7)); }
constexpr int CL_IMG = 90112;
struct ClProb { int n, d, hh, b, kind, qld, vld; const bf16_t *qsrc, *ksrc, *vsrc; float kscale; };
DEV ClProb cl_decode(const Frame& F, int p, int odd, int nhh) {
    ClProb c; c.n = p % NCH; c.d = (p / NCH) & 1; c.hh = (p / (2 * NCH)) % nhh; c.b = p / (2 * NCH * nhh); c.kind = odd ? 2 : (c.hh < 4 ? 0 : 1); c.kscale = 1.0f;
    const bf16_t* P = (const bf16_t*)(F.ws + WS_P); const bf16_t* Q = (const bf16_t*)(F.ws + WS_QKV);
    if (c.kind == 0) { c.qsrc = Q + c.hh * 128; c.ksrc = Q + 512 + c.hh * 128; c.vsrc = Q + 1024 + c.hh * 128; c.qld = 1536; c.vld = 1536; }
    else if (c.kind == 1) { c.qsrc = P + 2048 + (c.hh - 4) * 128; c.ksrc = P + 2560 + (c.hh - 4) * 128; c.vsrc = P + 3072 + (c.hh - 4) * 128; c.qld = NIN_E; c.vld = NIN_E; c.kscale = HD_SCALE; }
    else { c.qsrc = Q + c.hh * 128; c.ksrc = Q + 512 + c.hh * 128; c.vsrc = P + 1024 + c.hh * 128; c.qld = 1024; c.vld = NIN_O; }
    return c;
}
DEV void cl_dma(const Frame& F, const ClProb c) {
    int ln = F.lane; LAUNDER(ln);
    const int r0 = tok_row(c.b, c.d, c.n * 64), sg = c.d ? -1 : 1; const int per = c.kind == 0 ? 6 : 4;
#pragma unroll
    for (int i = 0; i < 6; ++i) if (i < per) { const int ch = F.wave * per + i, reg = ch >> 4, cc = ch & 15, r = 4 * cc + (ln >> 4), kk = (ln & 15) ^ (r & 15);
        const bf16_t* src = reg == 0 ? c.qsrc : (reg == 1 ? c.ksrc : c.vsrc); const int ld = reg == 2 ? c.vld : c.qld;
        glds16((const GAS char*)(src + (size_t)(r0 + sg * r) * ld + 8 * kk), F.lds + CL_IMG + reg * 16384 + 1024 * cc); }
}
DEV void seq_s5_item(const Frame& F, int l, int item, int which);
DEV void phase_cl(const Frame& F0, int l) {
    const Frame F = refresh(F0);
    const int odd = l & 1; const int nhh = odd ? 4 : 8; const int nprob = B_ * nhh * 2 * NCH;
    if (odd) {
        for (int it = F.bid; it < B_ * 2 * 32; it += F.G) { seq_s5_item(F, l, it, 0); __syncthreads(); }
    }
    LAS float* gc = (LAS float*)(F.lds);
    LAS float* bt = (LAS float*)(F.lds + 256);
    LAS float* qs = (LAS float*)(F.lds + 768);
    LAS float* ks = (LAS float*)(F.lds + 1024);
    LAS float* mt = (LAS float*)(F.lds + 1280);
    LAS float* rsp = (LAS float*)(F.lds + 2048);
    LAS float* Am = (LAS float*)(F.lds + 4096);
    LAS bf16_t* An = (LAS bf16_t*)(F.lds + 20480);
    LAS bf16_t* XT = (LAS bf16_t*)(F.lds + 30720);
    LAS float* Rb = (LAS float*)(F.lds + 69632 + F.wave * 2048);
    LAS float* ksp = (LAS float*)(F.lds + 86016);
    LAS unsigned char* IQ = F.lds + CL_IMG; LAS unsigned char* IK = IQ + 16384; LAS unsigned char* IV = IQ + 32768;
    const float* GT = (const float*)(F.ws + WS_GATES);
    float gq = 0.f, bq = 0.f, mq = 0.f;
#define CL_GATES(pp) do { const ClProb cn = cl_decode(F, (pp), odd, nhh); const int rown = tok_row(cn.b, cn.d, cn.n * 64 + F.lane); \
        if (cn.kind == 0) { gq = GT[(size_t)rown * 16 + cn.d * 4 + cn.hh]; bq = GT[(size_t)rown * 16 + 8 + cn.d * 4 + cn.hh]; } \
        else if (cn.kind == 2) { bq = GT[(size_t)rown * 16 + cn.d * 4 + cn.hh]; gq = GT[(size_t)rown * 16 + 8 + cn.d * 4 + cn.hh]; \
            mq = ((const float*)(F.ws + WS_MCH))[(size_t)((cn.b * 4 + cn.hh) * 2 + cn.d) * NCH + cn.n]; } } while (0)
    if (F.bid < nprob) { cl_dma(F, cl_decode(F, F.bid, odd, nhh)); if (F.wave == 0) CL_GATES(F.bid); }
    for (int p = F.bid; p < nprob; p += F.G) {
        int lz = F.lane; LAUNDER(lz); const int h = lz >> 5, l31 = lz & 31;
        const ClProb c = cl_decode(F, p, odd, nhh); const int n = c.n, d = c.d, hh = c.hh, b = c.b, kind = c.kind; const float kscale = c.kscale;
        float* CS = (float*)(F.ws + WS_CLS) + (size_t)p * 512;
        if (F.wave == 0) {
            const int i = F.lane;
            float g = gq, be = bq;
            if (kind == 1) { g = log1pf(-exp2f(-(5.0f + 2.0f * (float)(hh - 4) + (float)d))); be = 0.f; }
            const float cum = wave_scan_add(g);
            const float gend = bcast_lane_f(cum, 63);
            gc[i] = cum; bt[i] = be;
            if (kind < 2) { qs[i] = expf(cum); ks[i] = expf(gend - cum) * kscale; if (i == 0) CS[0] = expf(gend); }
            else {
                const float mprev = mq;
                const float a = gend - cum + be; const float amax = wave_max(a); const float mnew = fmaxf(gend + mprev, amax);
                ks[i] = expf(a - mnew);
                const float pm = wave_scan_max(be - cum);
                const float mti = cum + fmaxf(mprev, pm); mt[i] = mti; qs[i] = expf(cum + mprev - mti);
                CS[128 + i] = expf(-mti);
                if (i == 0) CS[0] = expf(gend + mprev - mnew);
            }
        }
        WAIT_VM(0);
        __syncthreads();
        {
            const int w4 = F.wave & 3, mt_ = w4 >> 1, nt_ = w4 & 1; const bool doY = F.wave >= 4;
            if (!doY || kind == 0) {
                const int rj = 32 * mt_ + l31, ri = 32 * nt_ + l31; LAS unsigned char* IB = doY ? IK : IQ;
                f32x16 acc;
#pragma unroll
                for (int r = 0; r < 16; ++r) acc[r] = 0.f;
                bf16x8 af[8], bfr[8];
#pragma unroll
                for (int s = 0; s < 8; ++s) { af[s] = *(const LAS bf16x8*)(IK + swz256(rj, 2 * s + h)); bfr[s] = *(const LAS bf16x8*)(IB + swz256(ri, 2 * s + h)); }
#pragma unroll
                for (int s = 0; s < 8; ++s) acc = mfma32(af[s], bfr[s], acc);
                const int i = ri; const float gi = gc[i];
                if (!doY) {
                    bf16_t* AQ = (bf16_t*)(F.ws + WS_CLA) + (size_t)p * 4096 + (size_t)i * 64; float rsum = 0.f; const float mti = kind == 2 ? mt[i] : 0.f;
#pragma unroll
                    for (int g4 = 0; g4 < 4; ++g4) { float v[4];
#pragma unroll
                        for (int r = 0; r < 4; ++r) { const int j = 32 * mt_ + 8 * g4 + 4 * h + r; float e;
                            if (kind < 2) e = fast_exp(fminf(gi - gc[j], 0.f)); else e = fast_exp(gi - gc[j] + bt[j] - mti);
                            v[r] = (i >= j) ? acc[4 * g4 + r] * kscale * e : 0.f; rsum += v[r]; }
                        *(u32x2*)(AQ + 32 * mt_ + 8 * g4 + 4 * h) = (u32x2){pk2_sw(v[0], v[1]), pk2_sw(v[2], v[3])}; }
                    if (kind == 2) rsp[i * 4 + mt_ * 2 + h] = rsum;
                } else {
                    const float bi = bt[i];
#pragma unroll
                    for (int r = 0; r < 16; ++r) { const int j = 32 * mt_ + 8 * (r >> 2) + 4 * h + (r & 3);
                        const float av = (i > j) ? bi * acc[r] * fast_exp(fminf(gi - gc[j], 0.f)) : 0.f;
                        Am[i * 64 + j] = av; An[i * 72 + j] = (bf16_t)f2bf_sw(-av); }
                }
            }
        }
        __syncthreads();
        int lz2 = F.lane; LAUNDER(lz2); const int l15 = lz2 & 15, kg = lz2 >> 4; const bool isw = F.wave >= 4;
        float rhsv[4][2][4];
        {
            const int tz = F.wave * 64 + lz2; const int cq = tz & 127, q4 = tz >> 7; bf16_t* QD = (bf16_t*)(F.ws + WS_CLQ) + (size_t)p * 8192 + cq;
            for (int i = 16 * q4; i < 16 * q4 + 16; ++i) QD[i * 128] = (bf16_t)f2bf_sw(bf2f(*(const LAS bf16_t*)(IQ + swz256(i, cq >> 3) + 2 * (cq & 7))) * qs[i]);
            bf16_t* KT = (bf16_t*)(F.ws + WS_CLK) + (size_t)p * 8192 + (size_t)cq * 64;
            float ksum = 0.f;
            for (int j8 = 2 * q4; j8 < 2 * q4 + 2; ++j8) { float v[8];
#pragma unroll
                for (int r = 0; r < 8; ++r) { const int j = 8 * j8 + r; v[r] = bf2f(*(const LAS bf16_t*)(IK + swz256(j, cq >> 3) + 2 * (cq & 7))) * ks[j]; ksum += v[r]; }
                *(u32x4*)(KT + 8 * j8) = (u32x4){pk2_sw(v[0], v[1]), pk2_sw(v[2], v[3]), pk2_sw(v[4], v[5]), pk2_sw(v[6], v[7])}; }
            ksp[cq * 4 + q4] = ksum;
            if (kind == 2 && tz < 64) CS[64 + tz] = (rsp[tz * 4] + rsp[tz * 4 + 1]) + (rsp[tz * 4 + 2] + rsp[tz * 4 + 3]);
            if (kind == 0) { LAS unsigned char* IS = isw ? IK : IV;
#pragma unroll
                for (int bb = 0; bb < 4; ++bb)
#pragma unroll
                    for (int nt2 = 0; nt2 < 2; ++nt2)
#pragma unroll
                        for (int r = 0; r < 4; ++r) { const int i = 16 * bb + 4 * kg + r, cc = (32 * F.wave + 16 * nt2 + l15) & 127;
                            rhsv[bb][nt2][r] = bt[i] * bf2f(*(const LAS bf16_t*)(IS + swz256(i, cc >> 3) + 2 * (cc & 7))) * (isw ? qs[i] : 1.0f); } }
        }
        __syncthreads();
        if (p + F.G < nprob) { cl_dma(F, cl_decode(F, p + F.G, odd, nhh)); if (F.wave == 0) CL_GATES(p + F.G); }
        if (kind == 2 && F.tid < 128) CS[256 + F.tid] = (ksp[F.tid * 4] + ksp[F.tid * 4 + 1]) + (ksp[F.tid * 4 + 2] + ksp[F.tid * 4 + 3]);
        if (kind == 0) {
            const int pg = ((b * 4 + hh) * 2 + d) * NCH + n;
            bf16_t* U = (bf16_t*)(F.ws + WS_CLU) + (size_t)pg * 8192; bf16_t* W = (bf16_t*)(F.ws + WS_CLW) + (size_t)p * 8192;
#pragma unroll
            for (int bb = 0; bb < 4; ++bb) {
#pragma unroll
                for (int nt2 = 0; nt2 < 2; ++nt2) {
                    const int cidx = 32 * F.wave + 16 * nt2 + l15; f32x4 acc;
#pragma unroll
                    for (int r = 0; r < 4; ++r) acc[r] = rhsv[bb][nt2][r];
                    for (int k2 = 0; k2 < 2; ++k2) if (32 * k2 < 16 * bb) {
                        const bool in = 32 * k2 + 8 * kg + 8 <= 16 * bb;
                        bf16x8 a = *(const LAS bf16x8*)(An + (16 * bb + l15) * 72 + 32 * k2 + 8 * kg); if (!in) a = (bf16x8){0, 0, 0, 0, 0, 0, 0, 0};
                        const bf16x8 xb = *(const LAS bf16x8*)(XT + cidx * 72 + 32 * k2 + 8 * kg);
                        acc = mfma16(a, in ? xb : (bf16x8){0, 0, 0, 0, 0, 0, 0, 0}, acc); }
#pragma unroll
                    for (int r = 0; r < 4; ++r) Rb[(4 * kg + r) * 32 + 16 * nt2 + l15] = acc[r];
                }
                WAVE_LDS_SYNC();
                if (F.lane < 32) {
                    const int cidx = 32 * F.wave + F.lane; float x[16];
#pragma unroll
                    for (int i = 0; i < 16; ++i) { float r = Rb[i * 32 + F.lane];
#pragma unroll
                        for (int j = 0; j < i; ++j) r -= Am[(16 * bb + i) * 64 + 16 * bb + j] * x[j];
                        x[i] = r; }
                    if (!isw) {
#pragma unroll
                        for (int i = 0; i < 16; ++i) U[(16 * bb + i) * 128 + cidx] = (bf16_t)f2bf_sw(x[i]); }
                    else {
#pragma unroll
                        for (int i = 0; i < 16; ++i) W[(16 * bb + i) * 128 + (cidx - 128)] = (bf16_t)f2bf_sw(-x[i]); }
                    *(LAS u32x4*)(XT + cidx * 72 + 16 * bb) = (u32x4){pk2_sw(x[0], x[1]), pk2_sw(x[2], x[3]), pk2_sw(x[4], x[5]), pk2_sw(x[6], x[7])};
                    *(LAS u32x4*)(XT + cidx * 72 + 16 * bb + 8) = (u32x4){pk2_sw(x[8], x[9]), pk2_sw(x[10], x[11]), pk2_sw(x[12], x[13]), pk2_sw(x[14], x[15])};
                }
                WAVE_LDS_SYNC();
            }
        }
    }
    WAIT_VM(0);
    __syncthreads();
}

#define LDS_BARRIER() do { WAIT_LGKM(0); S_BARRIER(); COMPILER_FENCE(); } while (0)
constexpr int SQ_W = 0, SQ_Q = 16384, SQ_K = 32768, SQ_A = 49152, SQ_U = 57344, SQ_C = 65536, SQ_STAGE = 67584;
constexpr int SQ_SB = 2 * SQ_STAGE, SQ_VN = SQ_SB + 8704, SQ_NV = SQ_VN + 4608, SQ_DEN = SQ_NV + 512;
static_assert(SQ_DEN + 256 <= LDS_MISC, "SEQ LDS map");
struct SeqCtx { int kind, b, hh, d, sl, chain, vld; const GAS bf16_t* vsrc; int probe; };
template <int KIND>
DEV void seq_dma(const Frame& F, const SeqCtx& C, int n, LAS unsigned char* img) {
    const int p = C.chain * NCH + n, w = F.wave; int ln = F.lane; LAUNDER(ln);
    if (w < 2) {
        if (KIND == 0) { const GAS char* g = (const GAS char*)(F.ws + WS_CLW) + (size_t)p * 16384; LAUNDER_S(g);
#pragma unroll
            for (int i = 0; i < 8; ++i) { const int r = 4 * (8 * w + i) + (ln >> 4), pp = ln & 15; glds16(g + r * 256 + 16 * (pp ^ (r & 15)), img + SQ_W + 1024 * (8 * w + i)); } }
    } else if (w < 4) {
        const GAS char* g = (const GAS char*)(F.ws + WS_CLQ) + (size_t)p * 16384; LAUNDER_S(g);
#pragma unroll
        for (int i = 0; i < 8; ++i) { const int c = 8 * (w - 2) + i, r = 4 * c + (ln >> 4), pp = ln & 15; glds16(g + r * 256 + 16 * (pp ^ (r & 15)), img + SQ_Q + 1024 * c); }
    } else if (w < 6) {
        const GAS char* g = (const GAS char*)(F.ws + WS_CLK) + (size_t)p * 16384; LAUNDER_S(g);
#pragma unroll
        for (int i = 0; i < 8; ++i) { const int c = 8 * (w - 4) + i, r = 8 * c + (ln >> 3), pp = ln & 7; glds16(g + r * 128 + 16 * (pp ^ ((r >> 1) & 7)), img + SQ_K + 1024 * c); }
    } else if (w == 6) {
        const GAS char* g = (const GAS char*)(F.ws + WS_CLA) + (size_t)p * 8192; LAUNDER_S(g);
#pragma unroll
        for (int i = 0; i < 8; ++i) { const int r = 8 * i + (ln >> 3), pp = ln & 7; glds16(g + r * 128 + 16 * (pp ^ ((r >> 1) & 7)), img + SQ_A + 1024 * i); }
    } else {
        if (KIND == 0) { const int pg = ((C.b * 4 + C.hh) * 2 + C.d) * NCH + n; const GAS char* g = (const GAS char*)(F.ws + WS_CLU) + (size_t)pg * 16384 + 64 * C.sl; LAUNDER_S(g);
#pragma unroll
            for (int i = 0; i < 4; ++i) { const int r = 16 * i + (ln >> 2); glds16(g + r * 256 + 16 * (ln & 3), img + SQ_U + 1024 * i); }
        } else { const int r0 = tok_row(C.b, C.d, n * 64); const long st = C.d ? -(long)C.vld * 2 : (long)C.vld * 2;
            const GAS char* g = (const GAS char*)C.vsrc + (long)r0 * C.vld * 2 + 64 * C.sl; LAUNDER_S(g);
#pragma unroll
            for (int i = 0; i < 4; ++i) { const int r = 16 * i + (ln >> 2); glds16(g + (long)r * st + 16 * (ln & 3), img + SQ_U + 1024 * i); }
        }
        const GAS char* cs = (const GAS char*)(F.ws + WS_CLS) + (size_t)p * 2048; LAUNDER_S(cs);
        glds16(cs + 16 * ln, img + SQ_C);
        if (KIND == 2) glds16(cs + 1024 + 16 * ln, img + SQ_C + 1024);
    }
}
#define SEQ_WAIT_DMA(younger) do { if ((younger) == 16) WAIT_VM(16); else WAIT_VM(0); } while (0)
template <int KIND>
DEV void seq_step(const Frame& F, const SeqCtx& C, int n, f32x16& acc, LAS unsigned char* lds) {
    int lz = F.lane; LAUNDER(lz); const int h = lz >> 5, l31 = lz & 31;
    LAS unsigned char* img = lds + (n & 1) * SQ_STAGE; LAS unsigned char* nimg = lds + ((n + 1) & 1) * SQ_STAGE;
    LAS bf16_t* Sb = (LAS bf16_t*)(lds + SQ_SB); LAS bf16_t* Vn = (LAS bf16_t*)(lds + SQ_VN); LAS float* nvec = (LAS float*)(lds + SQ_NV); LAS float* den = (LAS float*)(lds + SQ_DEN);
    const LAS float* CS = (const LAS float*)(img + SQ_C);
    if (C.probe != 3) seq_dma<KIND>(F, C, C.probe == 2 ? 0 : (n + 1 < NCH ? n + 1 : NCH - 1), nimg);
    if (F.wave < 2) {
        const int mt_ = F.wave;
#pragma unroll
        for (int r = 0; r < 16; ++r) acc[r] = bf2f(*(const LAS bf16_t*)(img + SQ_U + (32 * mt_ + 8 * (r >> 2) + 4 * h + (r & 3)) * 64 + 2 * l31));
        if (KIND == 0) {
            bf16x8 sb[8], wf[8]; const int rr = 32 * mt_ + l31;
#pragma unroll
            for (int s = 0; s < 8; ++s) { sb[s] = *(const LAS bf16x8*)(Sb + l31 * 136 + 16 * s + 8 * h); wf[s] = *(const LAS bf16x8*)(img + SQ_W + swz256(rr, 2 * s + h)); }
#pragma unroll
            for (int s = 0; s < 8; ++s) acc = mfma32(wf[s], sb[s], acc);
        }
#pragma unroll
        for (int g4 = 0; g4 < 4; ++g4) *(LAS u32x2*)(Vn + l31 * 72 + 32 * mt_ + 8 * g4 + 4 * h) = (u32x2){pk2(acc[4 * g4], acc[4 * g4 + 1]), pk2(acc[4 * g4 + 2], acc[4 * g4 + 3])};
    } else if (F.wave < 4) {
        const int rr = 32 * (F.wave - 2) + l31;
#pragma unroll
        for (int r = 0; r < 16; ++r) acc[r] = 0.f;
        bf16x8 sb[8], qf[8];
#pragma unroll
        for (int s = 0; s < 8; ++s) { sb[s] = *(const LAS bf16x8*)(Sb + l31 * 136 + 16 * s + 8 * h); qf[s] = *(const LAS bf16x8*)(img + SQ_Q + swz256(rr, 2 * s + h)); }
#pragma unroll
        for (int s = 0; s < 8; ++s) acc = mfma32(qf[s], sb[s], acc);
    } else if (KIND == 2) {
        const int t = F.tid - 256, i = t >> 2, q = t & 3; float s = 0.f;
#pragma unroll
        for (int c8 = 0; c8 < 4; ++c8) { const u32x4 w = *(const LAS u32x4*)(img + SQ_Q + swz256(i, 4 * q + c8)); const LAS float* nv = nvec + 32 * q + 8 * c8;
            s += bflo(w.x) * nv[0] + bfhi(w.x) * nv[1] + bflo(w.y) * nv[2] + bfhi(w.y) * nv[3] + bflo(w.z) * nv[4] + bfhi(w.z) * nv[5] + bflo(w.w) * nv[6] + bfhi(w.w) * nv[7]; }
        s = group_sum<4>(s);
        if (q == 0) den[i] = fmaxf(fabsf(CS[64 + i] + s), CS[128 + i]);
    }
    LDS_BARRIER();
    if (F.wave >= 2 && F.wave < 4) {
        const int mt_ = F.wave - 2, rr = 32 * mt_ + l31;
        bf16x8 vb[4], af[4];
#pragma unroll
        for (int s = 0; s < 4; ++s) { vb[s] = *(const LAS bf16x8*)(Vn + l31 * 72 + 16 * s + 8 * h); af[s] = *(const LAS bf16x8*)(img + SQ_A + swz128(rr, 2 * s + h)); }
#pragma unroll
        for (int s = 0; s < 4; ++s) acc = mfma32(af[s], vb[s], acc);
        const int r0 = tok_row(C.b, C.d, n * 64); const long st = C.d ? -2048l : 2048l;
        GAS char* Ob = (GAS char*)(F.ws + WS_O) + ((size_t)C.d * MROWS + r0) * 2048 + (long)(32 * mt_) * st; LAUNDER_S(Ob); const long lo = (long)(4 * h) * st + (long)((C.hh * 128 + 32 * C.sl + l31) * 2);
#pragma unroll
        for (int r = 0; r < 16; ++r) { const int i = 32 * mt_ + 8 * (r >> 2) + 4 * h + (r & 3); float v = acc[r];
            if (KIND == 2) v = v / den[i];
            if (!C.probe) *(GAS bf16_t*)(Ob + (long)(8 * (r >> 2) + (r & 3)) * st + lo) = (bf16_t)f2bf(v); }
        SEQ_WAIT_DMA(16);
    } else if (F.wave >= 4) {
        const int kb = F.wave - 4, rr = 32 * kb + l31; const float ge = CS[0];
        bf16x8 vb[4], kf[4];
#pragma unroll
        for (int s = 0; s < 4; ++s) { vb[s] = *(const LAS bf16x8*)(Vn + l31 * 72 + 16 * s + 8 * h); kf[s] = *(const LAS bf16x8*)(img + SQ_K + swz128(rr, 2 * s + h)); }
#pragma unroll
        for (int r = 0; r < 16; ++r) acc[r] *= ge;
#pragma unroll
        for (int s = 0; s < 4; ++s) acc = mfma32(kf[s], vb[s], acc);
#pragma unroll
        for (int g4 = 0; g4 < 4; ++g4) *(LAS u32x2*)(Sb + l31 * 136 + 32 * kb + 8 * g4 + 4 * h) = (u32x2){pk2(acc[4 * g4], acc[4 * g4 + 1]), pk2(acc[4 * g4 + 2], acc[4 * g4 + 3])};
        if (KIND == 2 && F.tid < 256 + 128) { const int dd = F.tid - 256; nvec[dd] = ge * nvec[dd] + CS[256 + dd]; }
        SEQ_WAIT_DMA(0);
    } else SEQ_WAIT_DMA(0);
    LDS_BARRIER();
}
template <int KIND>
DEV void seq_kind_loop(const Frame& F, const SeqCtx& C, LAS unsigned char* lds) {
    f32x16 acc;
#pragma unroll
    for (int r = 0; r < 16; ++r) acc[r] = 0.f;
    seq_dma<KIND>(F, C, 0, lds);
    WAIT_VM(0);
    LDS_BARRIER();
    for (int n = 0; n < NCH; ++n) seq_step<KIND>(F, C, n, acc, lds);
}
DEV void seq_linear_item(const Frame& F, int l, int item, int probe = 0) {
    const int odd = l & 1, nhh = odd ? 4 : 8;
    SeqCtx C; C.probe = probe; C.sl = item & 3; C.chain = item >> 2; C.d = C.chain & 1; C.hh = (C.chain >> 1) % nhh; C.b = C.chain / (2 * nhh);
    C.kind = odd ? 2 : (C.hh < 4 ? 0 : 1);
    const GAS bf16_t* P = (const GAS bf16_t*)(F.ws + WS_P); const GAS bf16_t* Q = (const GAS bf16_t*)(F.ws + WS_QKV);
    if (C.kind == 0) { C.vsrc = Q + 1024 + C.hh * 128; C.vld = 1536; } else if (C.kind == 1) { C.vsrc = P + 3072 + (C.hh - 4) * 128; C.vld = NIN_E; } else { C.vsrc = P + 1024 + C.hh * 128; C.vld = NIN_O; }
    for (int i = F.tid; i < 32 * 136 / 2; i += NTHREADS) ((LAS unsigned*)(F.lds + SQ_SB))[i] = 0u;
    if (F.tid < 128) ((LAS float*)(F.lds + SQ_NV))[F.tid] = 0.f;
    __syncthreads();
    if (C.kind == 0) seq_kind_loop<0>(F, C, F.lds); else if (C.kind == 1) seq_kind_loop<1>(F, C, F.lds); else seq_kind_loop<2>(F, C, F.lds);
    WAIT_VM(0);
}

DEV void seq_s5_item(const Frame& F, int l, int item, int which) {
    const int o = l >> 1; const int g = item & 31, d = (item >> 5) & 1, b = item >> 6;
    LAS float* El = (LAS float*)(F.lds);
    LAS unsigned char* wl = F.lds + 36864 + F.wave * 14336;
    LAS float* scr = (LAS float*)wl; LAS bf16_t* hb = (LAS bf16_t*)(wl + 10240);
    const bf16_t* P = (const bf16_t*)(F.ws + WS_P);
    const float* Ab = (const float*)(F.ws + WS_S5A) + (size_t)((o * 2 + d) * 32 + g) * 128;
    const bf16_t* Bb = (const bf16_t*)(F.ws + WS_S5B) + (size_t)((o * 2 + d) * 32 + g) * 128 * 16;
    const bf16_t* Cm = (const bf16_t*)(F.ws + WS_S5C) + (size_t)(o * 32 + g) * 16 * 128;
    const int l15 = F.lane & 15, kg = F.lane >> 4;
    const float ar = Ab[F.lane], ai = Ab[64 + F.lane];
    bf16x8 bB[8], cB[4]; const bf16x8 zero8 = (bf16x8){0, 0, 0, 0, 0, 0, 0, 0};
#pragma unroll
    for (int ct = 0; ct < 8; ++ct) bB[ct] = kg < 2 ? *(const bf16x8*)(Bb + (size_t)(16 * ct + l15) * 16 + 8 * kg) : zero8;
#pragma unroll
    for (int s = 0; s < 4; ++s) cB[s] = *(const bf16x8*)(Cm + (size_t)l15 * 128 + 32 * s + 8 * kg);
    bf16_t* Obase = (bf16_t*)(F.ws + WS_O) + (size_t)d * MROWS * 1024 + 512 + 16 * g;
    float* SE = (float*)(F.ws + WS_S5E) + (size_t)item * NCH * 128;
    if (which == 1) { for (int i = F.tid; i < NCH * 128; i += NTHREADS) El[i] = SE[i]; __syncthreads(); }
    for (int pass = which; pass < which + 1; ++pass) {
        bf16x8 an[4];
#pragma unroll
        for (int st = 0; st < 4; ++st) an[st] = kg < 2 ? *(const bf16x8*)(P + (size_t)tok_row(b, d, F.wave * 64 + 16 * st + l15) * NIN_O + 2048 + 16 * g + 8 * kg) : zero8;
        for (int n = F.wave; n < NCH; n += NWAVES) {
            float hr = 0.f, hi = 0.f;
            if (pass) { hr = El[n * 128 + F.lane]; hi = El[n * 128 + 64 + F.lane]; }
            bf16x8 ac[4];
#pragma unroll
            for (int st = 0; st < 4; ++st) ac[st] = an[st];
            { const int nn = n + NWAVES < NCH ? n + NWAVES : n;
#pragma unroll
              for (int st = 0; st < 4; ++st) an[st] = kg < 2 ? *(const bf16x8*)(P + (size_t)tok_row(b, d, nn * 64 + 16 * st + l15) * NIN_O + 2048 + 16 * g + 8 * kg) : zero8; }
            const int r0 = tok_row(b, d, n * 64); const int sg = d ? -1 : 1;
#pragma unroll
            for (int st = 0; st < 4; ++st) {
#pragma unroll
                for (int ct = 0; ct < 8; ++ct) { f32x4 acc = (f32x4){0.f, 0.f, 0.f, 0.f}; acc = mfma16(ac[st], bB[ct], acc);
                    *(LAS f32x4*)(scr + (ct >> 2) * 1280 + (16 * (ct & 3) + l15) * 20 + 4 * kg) = acc; }
                WAVE_LDS_SYNC();
                f32x4 br[4], bi[4];
#pragma unroll
                for (int q = 0; q < 4; ++q) { br[q] = *(const LAS f32x4*)(scr + F.lane * 20 + 4 * q); bi[q] = *(const LAS f32x4*)(scr + 1280 + F.lane * 20 + 4 * q); }
#pragma unroll
                for (int t = 0; t < 16; ++t) { const float nr = ar * hr - ai * hi + br[t >> 2][t & 3], ni = ar * hi + ai * hr + bi[t >> 2][t & 3]; hr = nr; hi = ni;
                    if (pass) *(LAS unsigned*)(hb + t * 128 + 2 * F.lane) = pk2(hr, hi); }
                WAVE_LDS_SYNC();
                if (pass) { f32x4 acc = (f32x4){0.f, 0.f, 0.f, 0.f};
#pragma unroll
                    for (int s = 0; s < 4; ++s) { const bf16x8 ha = *(const LAS bf16x8*)(hb + l15 * 128 + 32 * s + 8 * kg); acc = mfma16(ha, cB[s], acc); }
#pragma unroll
                    for (int r = 0; r < 4; ++r) Obase[(size_t)(r0 + sg * (16 * st + 4 * kg + r)) * 1024 + l15] = (bf16_t)f2bf(acc[r]);
                    WAVE_LDS_SYNC(); }
            }
            if (!pass) { El[n * 128 + F.lane] = hr; El[n * 128 + 64 + F.lane] = hi; }
        }
        __syncthreads();
        if (!pass) {
            if (F.wave == 0) { float pr = ar, pi = ai;
#pragma unroll
                for (int q = 0; q < 6; ++q) { const float nr = pr * pr - pi * pi, ni = 2.0f * pr * pi; pr = nr; pi = ni; }
                float hr = 0.f, hi = 0.f;
                for (int n = 0; n < NCH; ++n) { const float er = El[n * 128 + F.lane], ei = El[n * 128 + 64 + F.lane];
                    El[n * 128 + F.lane] = hr; El[n * 128 + 64 + F.lane] = hi;
                    const float nr = pr * hr - pi * hi + er, ni = pr * hi + pi * hr + ei; hr = nr; hi = ni; } }
            __syncthreads();
            for (int i = F.tid; i < NCH * 128; i += NTHREADS) SE[i] = El[i];
        }
    }
}

DEV void phase_seq(const Frame& F0, int l, int mode = 0) {
    const Frame F = refresh(F0);
    const int odd = l & 1; const int nlin = B_ * (odd ? 4 : 8) * 2 * 4; const int ns5 = odd ? B_ * 2 * 32 : 0;
    const int vcu = (F.G % 8 == 0) ? (F.bid % 8) * (F.G / 8) + F.bid / 8 : F.bid;
    if (!odd || F.G <= nlin) {
        for (int it = vcu; it < nlin + ns5; it += F.G) {
            if (it < nlin) { if (mode != 2) seq_linear_item(F, l, it, mode >= 10 ? mode - 10 : 0); } else if (mode != 1 && mode < 10) seq_s5_item(F, l, it - nlin, 1);
            __syncthreads();
        }
    } else if (vcu < nlin) { if (mode != 2) seq_linear_item(F, l, vcu, mode >= 10 ? mode - 10 : 0); }
    else { for (int it = vcu - nlin; it < ns5; it += F.G - nlin) { if (mode != 1 && mode < 10) seq_s5_item(F, l, it, 1); __syncthreads(); } }
}

DEV void phase_merge(const Frame& F0, int l) {
    const Frame F = refresh(F0);
    const int odd = l & 1, li = l >> 1; const bf16_t* P = (const bf16_t*)(F.ws + WS_P);
    const bf16_t* O0 = (const bf16_t*)(F.ws + WS_O); const bf16_t* O1 = O0 + (size_t)MROWS * 1024;
    bf16_t* MG = (bf16_t*)(F.ws + WS_MERGED);
    const int nrows = (l == DEPTH - 1) ? LATR : MROWS;
    ROW_LOOP(r, nrows) {
        if (!odd) {
            const int c0 = 16 * F.lane; float v[16];
#pragma unroll
            for (int q = 0; q < 4; ++q) { const u32x2 a = *(const u32x2*)(O0 + (size_t)r * 1024 + c0 + 4 * q), bq = *(const u32x2*)(O1 + (size_t)r * 1024 + c0 + 4 * q);
                v[4 * q] = bflo(a.x) + bflo(bq.x); v[4 * q + 1] = bfhi(a.x) + bfhi(bq.x); v[4 * q + 2] = bflo(a.y) + bflo(bq.y); v[4 * q + 3] = bfhi(a.y) + bfhi(bq.y); }
            float s = 0.f;
#pragma unroll
            for (int i = 0; i < 16; ++i) s += v[i];
            s = group_sum<8>(s);
            const bool ret = F.lane >= 32; const float mu = ret ? s * (1.0f / 128.0f) : 0.f; float q2 = 0.f;
#pragma unroll
            for (int i = 0; i < 16; ++i) { v[i] -= mu; q2 += v[i] * v[i]; }
            q2 = group_sum<8>(q2);
            const float rstd = 1.0f / sqrtf(q2 * (1.0f / 128.0f) + LN_EPS);
            const bf16_t* zp = P + (size_t)r * NIN_E + (ret ? 3584 + (c0 - 512) : 1536 + c0);
            const float* gp = ret ? GIN(I_EVRETN) + li * 512 + (c0 - 512) : GIN(I_EVGDNN) + li * 128 + (c0 & 127);
            unsigned ow[8]; const u32x4 zq0 = *(const u32x4*)zp, zq1 = *(const u32x4*)(zp + 8); const unsigned zw[8] = {zq0.x, zq0.y, zq0.z, zq0.w, zq1.x, zq1.y, zq1.z, zq1.w};
            f32x4 gq[4];
#pragma unroll
            for (int i = 0; i < 4; ++i) gq[i] = *(const f32x4*)(gp + 4 * i);
#pragma unroll
            for (int i = 0; i < 16; i += 2) { const float z0 = bflo(zw[i >> 1]), z1 = bfhi(zw[i >> 1]); ow[i >> 1] = pk2(v[i] * rstd * gq[i >> 2][i & 3] * fast_silu(z0), v[i + 1] * rstd * gq[i >> 2][(i & 3) + 1] * fast_silu(z1)); }
            u32x4* op = (u32x4*)(MG + (size_t)r * 1024 + c0); op[0] = (u32x4){ow[0], ow[1], ow[2], ow[3]}; op[1] = (u32x4){ow[4], ow[5], ow[6], ow[7]};
        } else {
            const int c0 = 8 * F.lane; float v[8];
#pragma unroll
            for (int q = 0; q < 2; ++q) { const u32x2 a = *(const u32x2*)(O0 + (size_t)r * 1024 + c0 + 4 * q), bq = *(const u32x2*)(O1 + (size_t)r * 1024 + c0 + 4 * q);
                v[4 * q] = bflo(a.x) + bflo(bq.x); v[4 * q + 1] = bfhi(a.x) + bfhi(bq.x); v[4 * q + 2] = bflo(a.y) + bflo(bq.y); v[4 * q + 3] = bfhi(a.y) + bfhi(bq.y); }
            float s = 0.f;
#pragma unroll
            for (int i = 0; i < 8; ++i) s += v[i];
            s = group_sum<16>(s);
            const float mu = s * (1.0f / 128.0f); float q2 = 0.f;
#pragma unroll
            for (int i = 0; i < 8; ++i) { v[i] -= mu; q2 += v[i] * v[i]; }
            q2 = group_sum<16>(q2);
            const float rstd = 1.0f / sqrtf(q2 * (1.0f / 128.0f) + LN_EPS);
            const bf16_t* zp = P + (size_t)r * NIN_O + 1536 + c0; const float* gp = GIN(I_ODMN) + li * 512 + c0;
            unsigned ow[4]; const u32x4 zq = *(const u32x4*)zp; const unsigned zw[4] = {zq.x, zq.y, zq.z, zq.w}; const f32x4 gq0 = *(const f32x4*)gp, gq1 = *(const f32x4*)(gp + 4);
#pragma unroll
            for (int i = 0; i < 8; i += 2) { const f32x4 gq = i < 4 ? gq0 : gq1; ow[i >> 1] = pk2(v[i] * rstd * gq[i & 3] * fast_sigmoid(bflo(zw[i >> 1])), v[i + 1] * rstd * gq[(i & 3) + 1] * fast_sigmoid(bfhi(zw[i >> 1]))); }
            *(u32x4*)(MG + (size_t)r * 1024 + c0) = (u32x4){ow[0], ow[1], ow[2], ow[3]};
            const bf16_t* up = P + (size_t)r * NIN_O + 2048 + c0; const float* dsk = GIN(I_ODDSKIP) + li * 512 + c0;
#pragma unroll
            for (int q = 0; q < 2; ++q) { const u32x2 a = *(const u32x2*)(O0 + (size_t)r * 1024 + 512 + c0 + 4 * q), bq = *(const u32x2*)(O1 + (size_t)r * 1024 + 512 + c0 + 4 * q);
                v[4 * q] = bflo(a.x) + bflo(bq.x); v[4 * q + 1] = bfhi(a.x) + bfhi(bq.x); v[4 * q + 2] = bflo(a.y) + bflo(bq.y); v[4 * q + 3] = bfhi(a.y) + bfhi(bq.y); }
            { const u32x4 uq = *(const u32x4*)up; const unsigned uw[4] = {uq.x, uq.y, uq.z, uq.w}; const f32x4 d0 = *(const f32x4*)dsk, d1 = *(const f32x4*)(dsk + 4);
#pragma unroll
              for (int i = 0; i < 8; i += 2) { const f32x4 dq = i < 4 ? d0 : d1; ow[i >> 1] = pk2(gelu_tanh_f(v[i] + dq[i & 3] * bflo(uw[i >> 1])), gelu_tanh_f(v[i + 1] + dq[(i & 3) + 1] * bfhi(uw[i >> 1]))); } }
            *(u32x4*)((bf16_t*)(F.ws + WS_YS) + (size_t)r * 512 + c0) = (u32x4){ow[0], ow[1], ow[2], ow[3]};
        }
    }
}

template <int RG> DEV void ln_rows(const Frame& F, f32x4 (&t)[RG][4], const float* lg, const float* lb) {
    float mean[RG], rstd[RG];
#pragma unroll
    for (int q = 0; q < RG; ++q) { float sum = 0.f;
#pragma unroll
        for (int j = 0; j < 4; ++j) sum += (t[q][j].x + t[q][j].y) + (t[q][j].z + t[q][j].w);
        mean[q] = wave_sum(sum) * (1.0f / 1024.0f); }
#pragma unroll
    for (int q = 0; q < RG; ++q) { float s2 = 0.f;
#pragma unroll
        for (int j = 0; j < 4; ++j) { t[q][j] = t[q][j] - mean[q]; s2 += (t[q][j].x * t[q][j].x + t[q][j].y * t[q][j].y) + (t[q][j].z * t[q][j].z + t[q][j].w * t[q][j].w); }
        rstd[q] = 1.0f / sqrtf(wave_sum(s2) * (1.0f / 1024.0f) + LN_EPS); }
#pragma unroll
    for (int j = 0; j < 4; ++j) { const f32x4 gg = *((const f32x4*)lg + F.lane + 64 * j), bb = *((const f32x4*)lb + F.lane + 64 * j);
#pragma unroll
        for (int q = 0; q < RG; ++q) t[q][j] = t[q][j] * rstd[q] * gg + bb; }
}
template <int RG> DEV void ln1_group(const Frame& F, int l, int r) {

    const bf16_t* Y = (const bf16_t*)(F.ws + WS_Y); float* H = (float*)(F.ws + WS_H);
    const float* lg = GIN(I_LN1G) + l * 1024; const float* lb = GIN(I_LN1B) + l * 1024; const float* wr = (const float*)(F.ws + WS_WR) + (size_t)l * NE * 1024;
    {
        int b, s; row_bs(r, b, s); const int mr = s < CTX ? B_ : b; const float* mod = (const float*)(F.ws + WS_MOD) + ((size_t)l * NR + mr) * 6144;
        f32x4 t[RG][4];
#pragma unroll
        for (int j = 0; j < 4; ++j) { const f32x4 g1 = *((const f32x4*)(mod + 2048) + F.lane + 64 * j);
#pragma unroll
            for (int q = 0; q < RG; ++q) { const f32x4 hv = *((const f32x4*)HROW(F, l, r + q) + F.lane + 64 * j); const u32x2 yw = *((const u32x2*)(Y + (size_t)(r + q) * 1024) + F.lane + 64 * j); const f32x4 yv = (f32x4){bflo(yw.x), bfhi(yw.x), bflo(yw.y), bfhi(yw.y)}; t[q][j] = ALPHA * hv + g1 * yv; }
            if (j & 1) COMPILER_FENCE(); }
        ln_rows<RG>(F, t, lg, lb);
        COMPILER_FENCE();
#pragma unroll
        for (int j = 0; j < 4; ++j) { const f32x4 sh = *((const f32x4*)(mod + 3072) + F.lane + 64 * j), scv = *((const f32x4*)(mod + 4096) + F.lane + 64 * j);
#pragma unroll
            for (int q = 0; q < RG; ++q) { *((f32x4*)(H + (size_t)(r + q) * 1024) + F.lane + 64 * j) = t[q][j]; t[q][j] = t[q][j] * (1.0f + scv) + sh; } }
        COMPILER_FENCE();
#pragma unroll
        for (int q = 0; q < RG; ++q) { u32x2* xo = (u32x2*)((bf16_t*)(F.ws + WS_XIN) + (size_t)(r + q) * 1024) + F.lane;
#pragma unroll
            for (int j = 0; j < 4; ++j) xo[64 * j] = (u32x2){pk2(t[q][j].x, t[q][j].y), pk2(t[q][j].z, t[q][j].w)}; }
        float mine[RG]; const int ei = F.lane % NE;
#pragma unroll
        for (int q = 0; q < RG; ++q) mine[q] = 0.f;
        f32x4 wc[4];
#pragma unroll
        for (int j = 0; j < 4; ++j) wc[j] = *((const f32x4*)wr + F.lane + 64 * j);
#pragma unroll 1
        for (int e = 0; e < NE; ++e) { f32x4 wn[4]; const int en = e + 1 < NE ? e + 1 : e;
#pragma unroll
            for (int j = 0; j < 4; ++j) wn[j] = *((const f32x4*)(wr + en * 1024) + F.lane + 64 * j);
#pragma unroll
            for (int q = 0; q < RG; ++q) { float p = 0.f;
#pragma unroll
                for (int j = 0; j < 4; ++j) p += t[q][j].x * wc[j].x + t[q][j].y * wc[j].y + t[q][j].z * wc[j].z + t[q][j].w * wc[j].w;
                const float ws_ = wave_sum(p); mine[q] = (ei == e) ? ws_ : mine[q]; }
#pragma unroll
            for (int j = 0; j < 4; ++j) wc[j] = wn[j]; }
#pragma unroll
        for (int q = 0; q < RG; ++q) { const float mx = group_max<NE>(mine[q]); const float ex = expf(mine[q] - mx); const float se = group_sum<NE>(ex);
            if (F.lane < NE) ((float*)(F.ws + WS_AFF))[(size_t)(r + q) * 16 + F.lane] = ex / se; }
    }
}
DEV void phase_ln1(const Frame& F0, int l) {
    const Frame F = refresh(F0);
    const int nrows = (l == DEPTH - 1) ? LATR : MROWS;
    ROW_GROUPS(nrows, ln1_group<4>(F, l, r), ln1_group<2>(F, l, r));
}

DEV void phase_topk(const Frame& F0, int l) {
    const Frame F = refresh(F0);
    const int nitems = (l == DEPTH - 1) ? B_ * NE : 2 * B_ * NE;
    LAS unsigned* hist = (LAS unsigned*)(F.lds);
    LAS unsigned* selw = (LAS unsigned*)(F.lds + 1024);
    LAS unsigned* cnt = (LAS unsigned*)(F.lds + 2048);
    LAS int* selrow = (LAS int*)(F.lds + 8192);
    const float* AFF = (const float*)(F.ws + WS_AFF); int* SLOT = (int*)(F.ws + WS_SLOT); float* EG = (float*)(F.ws + WS_EGATE);
    for (int it = F.bid; it < nitems; it += F.G) {
        const int e = it % NE, set = it / NE, kind = set / B_, b = set % B_;
        const int n = kind ? CTX : SEQ, cap = kind ? CAPC : CAPL; const int row0 = kind ? LATR + b * CTX : b * SEQ;
        const int sbase = kind ? B_ * CAPL + b * CAPC : b * CAPL;
        const int per = n >= NTHREADS ? n / NTHREADS : 1; const bool act = F.tid * per < n;
        unsigned key[8];
#pragma unroll
        for (int k = 0; k < 8; ++k) key[k] = (act && k < per) ? __builtin_bit_cast(unsigned, AFF[(size_t)(row0 + F.tid * per + k) * 16 + e]) : 0u;
        unsigned prefix = 0u, remaining = (unsigned)cap;
        for (int pass = 0; pass < 4; ++pass) {
            const int shift = 24 - 8 * pass; const unsigned mask = pass == 0 ? 0u : (0xFFFFFFFFu << (shift + 8));
            if (F.tid < 256) hist[F.tid] = 0u;
            __syncthreads();
#pragma unroll
            for (int k = 0; k < 8; ++k) if (act && k < per && ((key[k] & mask) == (prefix & mask))) lds_atomic_add(&hist[(key[k] >> shift) & 255u], 1u);
            __syncthreads();
            if (F.wave == 0) {
                const unsigned h0 = hist[4 * F.lane], h1 = hist[4 * F.lane + 1], h2 = hist[4 * F.lane + 2], h3 = hist[4 * F.lane + 3];
                unsigned suf = h0 + h1 + h2 + h3;
#pragma unroll
                for (int o = 1; o < 64; o <<= 1) { const unsigned tv = shfl_t(suf, F.lane + o); if (F.lane + o < 64) suf += tv; }
                unsigned cum = suf - (h0 + h1 + h2 + h3);
                int dsel = -1; unsigned above = 0u;
                if (cum < remaining) {
                    if (cum + h3 >= remaining) { dsel = 4 * F.lane + 3; above = cum; }
                    else if (cum + h3 + h2 >= remaining) { dsel = 4 * F.lane + 2; above = cum + h3; }
                    else if (cum + h3 + h2 + h1 >= remaining) { dsel = 4 * F.lane + 1; above = cum + h3 + h2; }
                    else if (cum + h3 + h2 + h1 + h0 >= remaining) { dsel = 4 * F.lane; above = cum + h3 + h2 + h1; }
                }
                if (dsel >= 0) { selw[0] = prefix | ((unsigned)dsel << shift); selw[1] = remaining - above; }
            }
            __syncthreads();
            prefix = selw[0]; remaining = selw[1];
            __syncthreads();
        }
        const unsigned T = prefix, need_eq = remaining;
        unsigned ngt = 0u, neq = 0u;
#pragma unroll
        for (int k = 0; k < 8; ++k) if (act && k < per) { ngt += key[k] > T ? 1u : 0u; neq += key[k] == T ? 1u : 0u; }
        unsigned pk = (ngt << 16) | neq;
#pragma unroll
        for (int o = 1; o < 64; o <<= 1) { const unsigned tv = shfl_t(pk, F.lane - o); if (F.lane >= o) pk += tv; }
        if (F.lane == 63) cnt[F.wave] = pk;
        __syncthreads();
        unsigned base = 0u;
#pragma unroll
        for (int w8 = 0; w8 < NWAVES; ++w8) base += (w8 < F.wave) ? cnt[w8] : 0u;
        const unsigned excl = base + pk - ((ngt << 16) | neq);
        unsigned gtb = excl >> 16, eqb = excl & 0xffffu;
#pragma unroll
        for (int k = 0; k < 8; ++k) if (act && k < per) {
            const int row = row0 + F.tid * per + k; int slot = -1;
            const bool isgt = key[k] > T, iseq = key[k] == T;
            if (isgt || (iseq && eqb < need_eq)) { slot = (int)(gtb + (eqb < need_eq ? eqb : need_eq)); selrow[slot] = row; EG[(size_t)e * EPAD + sbase + slot] = __builtin_bit_cast(float, key[k]); }
            SLOT[(size_t)row * 16 + e] = slot >= 0 ? sbase + slot : -1;
            gtb += isgt ? 1u : 0u; eqb += iseq ? 1u : 0u;
        }
        __syncthreads();
        for (int sl = F.tid; sl < cap; sl += NTHREADS) ((int*)(F.ws + WS_EIDX))[(size_t)e * EPAD + sbase + sl] = selrow[sl];
        if (it < NE) for (int pr = EROWS + F.tid; pr < EPAD; pr += NTHREADS) EG[(size_t)e * EPAD + pr] = 0.f;
        __syncthreads();
    }
}

DEV void phase_gather(const Frame& F0, int l) {
    const Frame F = refresh(F0);
    const int erows = (l == DEPTH - 1) ? B_ * CAPL : EROWS;
    const int* EI = (const int*)(F.ws + WS_EIDX);
    for (int r0 = 4 * F.gw; r0 < NE * EPAD; r0 += 4 * F.NGW) {
        u32x4 v[4][2];
#pragma unroll
        for (int q = 0; q < 4; ++q) { const int r = r0 + q, sl = r % EPAD; v[q][0] = (u32x4){0u, 0u, 0u, 0u}; v[q][1] = v[q][0];
            if (sl < erows) { const u32x4* src = (const u32x4*)((const bf16_t*)(F.ws + WS_XIN) + (size_t)EI[r] * 1024) + F.lane; v[q][0] = src[0]; v[q][1] = src[64]; } }
#pragma unroll
        for (int q = 0; q < 4; ++q) { u32x4* dst = (u32x4*)((bf16_t*)(F.ws + WS_XS) + (size_t)(r0 + q) * 1024) + F.lane; dst[0] = v[q][0]; dst[64] = v[q][1]; }
    }
}

template <int RG> DEV void ln2_group(const Frame& F, int l, int r) {

    float* H = (float*)(F.ws + WS_H); const int* SLOT = (const int*)(F.ws + WS_SLOT); const bf16_t* YSE = (const bf16_t*)(F.ws + WS_YSE);
    const float* lg = GIN(I_LN2G) + l * 1024; const float* lb = GIN(I_LN2B) + l * 1024;
    {
        int b, s; row_bs(r, b, s); const int mr = s < CTX ? B_ : b; const float* mod = (const float*)(F.ws + WS_MOD) + ((size_t)l * NR + mr) * 6144;
        f32x4 t[RG][4];
#pragma unroll
        for (int q = 0; q < RG; ++q) {
#pragma unroll
            for (int j = 0; j < 4; ++j) t[q][j] = (f32x4){0.f, 0.f, 0.f, 0.f}; }
        const int myslot = F.lane < RG * 16 ? SLOT[(size_t)r * 16 + F.lane] : -1;
#pragma unroll
        for (int q = 0; q < RG; ++q)
#pragma unroll
            for (int e = 0; e < NE; ++e) { const int sl = bcast_lane(myslot, 16 * q + e);
                if (sl >= 0) { const u32x2* yp = (const u32x2*)(YSE + ((size_t)e * EPAD + sl) * 1024) + F.lane;
#pragma unroll
                    for (int j = 0; j < 4; ++j) { const u32x2 w = yp[64 * j]; t[q][j] += (f32x4){bflo(w.x), bfhi(w.x), bflo(w.y), bfhi(w.y)}; } } }
#pragma unroll
        for (int j = 0; j < 4; ++j) { const f32x4 g2 = *((const f32x4*)(mod + 5120) + F.lane + 64 * j);
#pragma unroll
            for (int q = 0; q < RG; ++q) { const f32x4 hv = *((const f32x4*)(H + (size_t)(r + q) * 1024) + F.lane + 64 * j); t[q][j] = ALPHA * hv + g2 * t[q][j]; } }
        ln_rows<RG>(F, t, lg, lb);
        if (l == DEPTH - 1) {
            {
#pragma unroll
                for (int q = 0; q < RG; ++q) { GAS f32x4* op = (GAS f32x4*)(F.out + (size_t)(r + q) * 1024) + F.lane;
#pragma unroll
                    for (int j = 0; j < 4; ++j) op[64 * j] = t[q][j]; } }
        } else {
#pragma unroll
            for (int q = 0; q < RG; ++q)
#pragma unroll
                for (int j = 0; j < 4; ++j) *((f32x4*)(H + (size_t)(r + q) * 1024) + F.lane + 64 * j) = t[q][j];
            xg_rows<RG>(F, l + 1, r, t);
        }
    }
}
DEV void phase_ln2(const Frame& F0, int l) {
    const Frame F = refresh(F0);
    const int nrows = (l == DEPTH - 1) ? LATR : MROWS;
    ROW_GROUPS(nrows, ln2_group<4>(F, l, r), ln2_group<2>(F, l, r));
}

struct EpiP {
    static constexpr bool PERM = true;
    bf16_t* O; int ldc;
    DEV void operator()(const f32x4 (&acc)[2][2][4][2], const pg8::Unit& u, int wr, int wc, int fr, int fq) const {
        const int row0 = u.pm * 256 + wr * 64 + fr, col0 = u.pn * 256 + wc * 32 + 8 * fq;
#pragma unroll
        for (int ai = 0; ai < 2; ++ai)
#pragma unroll
            for (int m = 0; m < 4; ++m) { bf16_t* rowp = O + (size_t)(row0 + ai * 128 + m * 16) * ldc + col0;
#pragma unroll
                for (int bj = 0; bj < 2; ++bj) { const f32x4 v0 = acc[ai][bj][m][0], v1 = acc[ai][bj][m][1];
                    u32x4 w; w.x = pg8::cvt_pk_bf16(v0[0], v0[1]); w.y = pg8::cvt_pk_bf16(v0[2], v0[3]); w.z = pg8::cvt_pk_bf16(v1[0], v1[1]); w.w = pg8::cvt_pk_bf16(v1[2], v1[3]);
                    *(u32x4*)(rowp + bj * 128) = w; } }
    }
};
struct EpiGlu {
    static constexpr bool PERM = true;
    bf16_t* MG; const bf16_t* YS; const float* bias;
    DEV void operator()(const f32x4 (&acc)[2][2][4][2], const pg8::Unit& u, int wr, int wc, int fr, int fq) const {
        const int row0 = u.pm * 256 + wr * 64 + fr, col0 = u.pn * 256 + wc * 32 + 8 * fq;
#pragma unroll
        for (int ai = 0; ai < 2; ++ai)
#pragma unroll
            for (int m = 0; m < 4; ++m) { const int row = row0 + ai * 128 + m * 16;
#pragma unroll
                for (int bj = 0; bj < 2; ++bj) { const int c = col0 + bj * 128; const f32x4 v0 = acc[ai][bj][m][0], v1 = acc[ai][bj][m][1];
                    const u32x4 yv = *(const u32x4*)(YS + (size_t)row * 512 + c); const f32x4 b0 = *(const f32x4*)(bias + c), b1 = *(const f32x4*)(bias + c + 4);
                    u32x4 w; w.x = pk2(bflo(yv.x) * fast_sigmoid(v0[0] + b0[0]), bfhi(yv.x) * fast_sigmoid(v0[1] + b0[1])); w.y = pk2(bflo(yv.y) * fast_sigmoid(v0[2] + b0[2]), bfhi(yv.y) * fast_sigmoid(v0[3] + b0[3]));
                    w.z = pk2(bflo(yv.z) * fast_sigmoid(v1[0] + b1[0]), bfhi(yv.z) * fast_sigmoid(v1[1] + b1[1])); w.w = pk2(bflo(yv.w) * fast_sigmoid(v1[2] + b1[2]), bfhi(yv.w) * fast_sigmoid(v1[3] + b1[3]));
                    *(u32x4*)(MG + (size_t)row * 1024 + 512 + c) = w; } }
    }
};
struct EpiF32 {
    static constexpr bool PERM = false;
    float* C; int ldc; const float* rowscale;
    DEV void operator()(const f32x4 (&acc)[2][2][4][2], const pg8::Unit& u, int wr, int wc, int fr, int fq) const {
        const int row0 = u.pm * 256 + wr * 64 + fr, col0 = u.pn * 256 + wc * 32 + 4 * fq;
        const size_t ebase = rowscale ? (size_t)u.e * EPAD : 0;
#pragma unroll
        for (int ai = 0; ai < 2; ++ai)
#pragma unroll
            for (int m = 0; m < 4; ++m) { const size_t row = ebase + row0 + ai * 128 + m * 16; const float sc = rowscale ? rowscale[row] : 1.0f; float* rowp = C + row * ldc + col0;
#pragma unroll
                for (int bj = 0; bj < 2; ++bj)
#pragma unroll
                    for (int n = 0; n < 2; ++n) *(f32x4*)(rowp + bj * 128 + n * 16) = acc[ai][bj][m][n] * sc; }
    }
};
struct EpiYse {
    static constexpr bool PERM = true;
    bf16_t* O; const float* rowscale;
    DEV void operator()(const f32x4 (&acc)[2][2][4][2], const pg8::Unit& u, int wr, int wc, int fr, int fq) const {
        const int row0 = u.pm * 256 + wr * 64 + fr, col0 = u.pn * 256 + wc * 32 + 8 * fq; const size_t ebase = (size_t)u.e * EPAD;
#pragma unroll
        for (int ai = 0; ai < 2; ++ai)
#pragma unroll
            for (int m = 0; m < 4; ++m) { const size_t row = ebase + row0 + ai * 128 + m * 16; const float sc = rowscale[row]; bf16_t* rowp = O + row * 1024 + col0;
#pragma unroll
                for (int bj = 0; bj < 2; ++bj) { const f32x4 v0 = acc[ai][bj][m][0] * sc, v1 = acc[ai][bj][m][1] * sc;
                    u32x4 w; w.x = pg8::cvt_pk_bf16(v0[0], v0[1]); w.y = pg8::cvt_pk_bf16(v0[2], v0[3]); w.z = pg8::cvt_pk_bf16(v1[0], v1[1]); w.w = pg8::cvt_pk_bf16(v1[2], v1[3]);
                    *(u32x4*)(rowp + bj * 128) = w; } }
    }
};
struct EpiSwiglu {
    static constexpr bool PERM = true;
    bf16_t* HID;
    DEV void operator()(const f32x4 (&acc)[2][2][4][2], const pg8::Unit& u, int wr, int wc, int fr, int fq) const {
        const int row0 = u.pm * 256 + wr * 64 + fr, col0 = u.pn * 128 + wc * 32 + 8 * fq;
#pragma unroll
        for (int ai = 0; ai < 2; ++ai)
#pragma unroll
            for (int m = 0; m < 4; ++m) { bf16_t* rowp = HID + ((size_t)u.e * EPAD + row0 + ai * 128 + m * 16) * FF + col0;
                const f32x4 g0 = acc[ai][0][m][0], g1 = acc[ai][0][m][1], u0 = acc[ai][1][m][0], u1 = acc[ai][1][m][1];
                u32x4 w; w.x = pk2(fast_silu(g0[0]) * u0[0], fast_silu(g0[1]) * u0[1]); w.y = pk2(fast_silu(g0[2]) * u0[2], fast_silu(g0[3]) * u0[3]);
                w.z = pk2(fast_silu(g1[0]) * u1[0], fast_silu(g1[1]) * u1[1]); w.w = pk2(fast_silu(g1[2]) * u1[2], fast_silu(g1[3]) * u1[3]);
                *(u32x4*)rowp = w; }
    }
};

DEV void gemm_g1(const Frame& F0, int l, int vcu) {
    const Frame F = refresh(F0);
    const int nin = (l & 1) ? NIN_O : NIN_E;
    pg8::PlainOrder S; S.init((const void*)(F.ws + WS_XIN), (const bf16_t*)(F.ws + WS_WIN) + (size_t)l * NINMAX * 1024, 1024, MPAD, nin, F.G, vcu);
    EpiP E; E.O = (bf16_t*)(F.ws + WS_P); E.ldc = nin;
    pg8::gemm_phase(F.lds, 1024, S, E, F.wave, F.lane);
}
DEV void gemm_glu(const Frame& F0, int l, int vcu) {
    const Frame F = refresh(F0);
    const int li = l >> 1;
    pg8::PlainOrder S; S.init((const void*)(F.ws + WS_YS), (const bf16_t*)(F.ws + WS_WGLU) + (size_t)li * 512 * 512, 512, (l == DEPTH - 1) ? LATPAD : MPAD, 512, F.G, vcu);
    EpiGlu E; E.MG = (bf16_t*)(F.ws + WS_MERGED); E.YS = (const bf16_t*)(F.ws + WS_YS); E.bias = GIN(I_ODBGLU) + li * 512;
    pg8::gemm_phase(F.lds, 512, S, E, F.wave, F.lane);
}
DEV void gemm_g3(const Frame& F0, int l, int vcu) {
    const Frame F = refresh(F0);
    pg8::PlainOrder S; S.init((const void*)(F.ws + WS_MERGED), (const bf16_t*)(F.ws + WS_WOUT) + (size_t)l * 1024 * 1024, 1024, (l == DEPTH - 1) ? LATPAD : MPAD, 1024, F.G, vcu);
    EpiP E; E.O = (bf16_t*)(F.ws + WS_Y); E.ldc = 1024;
    pg8::gemm_phase(F.lds, 1024, S, E, F.wave, F.lane);
}
DEV void gemm_g4(const Frame& F0, int l, int vcu) {
    const Frame F = refresh(F0);
    pg8::GroupedOrder S; S.init((const void*)(F.ws + WS_XS), (const bf16_t*)(F.ws + WS_WGU) + (size_t)l * NE * 2 * FF * 1024, 1024, 2 * FF, F.G, vcu, (l == DEPTH - 1) ? B_ * CAPL : EROWS);
    EpiSwiglu E; E.HID = (bf16_t*)(F.ws + WS_HID);
    pg8::gemm_phase(F.lds, 1024, S, E, F.wave, F.lane);
}
DEV void gemm_g5(const Frame& F0, int l, int vcu) {
    const Frame F = refresh(F0);
    pg8::GroupedOrder S; S.init((const void*)(F.ws + WS_HID), (const bf16_t*)(F.ws + WS_WD) + (size_t)l * NE * 1024 * FF, FF, 1024, F.G, vcu, (l == DEPTH - 1) ? B_ * CAPL : EROWS);
    EpiYse E; E.O = (bf16_t*)(F.ws + WS_YSE); E.rowscale = (const float*)(F.ws + WS_EGATE);
    pg8::gemm_phase(F.lds, FF, S, E, F.wave, F.lane);
}

__global__ void __launch_bounds__(NTHREADS, 2) mega_fwd(Args args) {
#ifdef EMU
    LAS unsigned char* lds = emu::lds();
#else
    extern __shared__ __attribute__((aligned(16))) unsigned char lds_raw[];
    LAS unsigned char* lds = (LAS unsigned char*)lds_raw;
#endif
    Frame F;
    F.in = args.in; F.out = (GAS float*)args.out; F.ws = (GAS unsigned char*)args.ws; F.lds = lds;
    F.tid = threadIdx.x; F.lane = F.tid & 63; F.wave = readfirstlane_i(F.tid >> 6); F.G = gridDim.x; F.bid = blockIdx.x;
    F.gw = F.bid * NWAVES + F.wave; F.NGW = F.G * NWAVES;
    for (int u = F.tid; u < (LDS_BYTES - LDS_MISC) / 4; u += NTHREADS) ((LAS unsigned*)(lds + LDS_MISC))[u] = 0u;
    __syncthreads();
    XcdBarrier bar = xcd_barrier_post((unsigned*)(F.ws + WS_CTL), (volatile LAS unsigned*)(lds + LDS_MISC), F.wave);
#define GRID_BAR() xcd_barrier(bar)
    const int vcu = (F.G % 8 == 0) ? (F.bid % 8) * (F.G / 8) + F.bid / 8 : F.bid;

#ifndef PHASE_MASK
#define PHASE_MASK 0xFFFFF
#endif
#ifndef REPEAT_MASK
#define REPEAT_MASK 0x0
#endif
#ifndef TIMING_PROBE
#define TIMING_PROBE -1
#endif
    unsigned long long pt_acc = 0ull, pt_t0 = 0ull;
#define PT(k) do { if (TIMING_PROBE == (k)) pt_t0 = rt_now(); } while (0)
#define PTE(k) do { if (TIMING_PROBE == (k)) pt_acc += rt_now() - pt_t0; } while (0)
#define PH(k) if ((PHASE_MASK >> (k)) & 1)
#define RP(k) if ((REPEAT_MASK >> (k)) & 1)
    PT(0); PH(0) phase_prologue_a(F);
    RP(0) { GRID_BAR(); phase_prologue_a(F); }
    GRID_BAR(); PTE(0);
    PT(1); PH(1) phase_xg0(F);
    GRID_BAR(); PTE(1);
    for (int l = 0; l < DEPTH; ++l) {
        const int odd = l & 1;
        PT(2); PH(2) gemm_g1(F, l, F.bid);
        RP(2) { GRID_BAR(); gemm_g1(F, l, F.bid); }
        GRID_BAR(); PTE(2);
        PT(3); PH(3) phase_prep(F, l);
        RP(3) { GRID_BAR(); phase_prep(F, l); }
        GRID_BAR(); PTE(3);
        PT(4); PH(4) phase_cl(F, l);
        RP(4) { GRID_BAR(); phase_cl(F, l); }
        GRID_BAR(); PTE(4);
        PT(5); PH(5) phase_seq(F, l);
        RP(5) { GRID_BAR(); phase_seq(F, l); }
        GRID_BAR(); PTE(5);
#ifdef SEQ_XPROBE
        if ((l & 1) == SEQ_XPARITY) { PT(20); phase_seq(F, l, 10 + SEQ_XPROBE); GRID_BAR(); PTE(20); }
#endif
        PT(6); PH(6) phase_merge(F, l);
        RP(6) { GRID_BAR(); phase_merge(F, l); }
        GRID_BAR(); PTE(6);
        if (odd) { PT(7); PH(7) gemm_glu(F, l, F.bid); RP(7) { GRID_BAR(); gemm_glu(F, l, F.bid); } GRID_BAR(); PTE(7); }
        PT(8); PH(8) gemm_g3(F, l, F.bid);
        RP(8) { GRID_BAR(); gemm_g3(F, l, F.bid); }
        GRID_BAR(); PTE(8);
        PT(9); PH(9) phase_ln1(F, l);
        GRID_BAR(); PTE(9);
        PT(10); PH(10) phase_topk(F, l);
        RP(10) { GRID_BAR(); phase_topk(F, l); }
        GRID_BAR(); PTE(10);
        PT(14); PH(10) phase_gather(F, l);
        GRID_BAR(); PTE(14);
        PT(11); PH(11) gemm_g4(F, l, F.bid);
        RP(11) { GRID_BAR(); gemm_g4(F, l, F.bid); }
        GRID_BAR(); PTE(11);
        PT(12); PH(12) gemm_g5(F, l, F.bid);
        RP(12) { GRID_BAR(); gemm_g5(F, l, F.bid); }
        GRID_BAR(); PTE(12);
        PT(13); PH(13) phase_ln2(F, l);
        if (l + 1 < DEPTH || TIMING_PROBE >= 0) GRID_BAR();
        PTE(13);
    }
    if (TIMING_PROBE >= 0 && F.bid == 0) { const unsigned long long t1 = rt_now() + pt_acc; while (rt_now() < t1) s_sleep1(); }
}

#ifndef EMU
extern "C" void kernel_launch(void* const* d_in, const int* in_sizes, int n_in, void* d_out, int out_size, void* d_ws, size_t ws_size, hipStream_t stream) {
    static int grid = 0;
    if (grid == 0) {
        if (n_in != N_IN || ws_size < WS_END) { fprintf(stderr, "kernel_launch: need %d inputs and %zu bytes of workspace; got %d, %zu\n", (int)N_IN, (size_t)WS_END, n_in, ws_size); grid = -1; return; }
        int dev = 0, cus = 0, per_cu = 0;
        if (hipGetDevice(&dev) != hipSuccess || hipDeviceGetAttribute(&cus, hipDeviceAttributeMultiprocessorCount, dev) != hipSuccess) { grid = -1; return; }
        if (hipFuncSetAttribute((const void*)mega_fwd, hipFuncAttributeMaxDynamicSharedMemorySize, LDS_BYTES) != hipSuccess) { fprintf(stderr, "kernel_launch: hipFuncSetAttribute failed\n"); grid = -1; return; }
        if (hipOccupancyMaxActiveBlocksPerMultiprocessor(&per_cu, (const void*)mega_fwd, NTHREADS, LDS_BYTES) != hipSuccess || per_cu < 1) { fprintf(stderr, "kernel_launch: occupancy query says %d\n", per_cu); }
        (void)hipGetLastError();
        grid = cus;
    }
    if (grid < 0) return;
    (void)hipMemsetAsync((char*)d_ws + WS_CTL, 0, CTL_BYTES, stream);
    Args a{};
    for (int i = 0; i < N_IN; ++i) a.in[i] = (const float*)d_in[i];
    a.out = (float*)d_out; a.ws = (unsigned char*)d_ws;
    hipLaunchKernelGGL(mega_fwd, dim3(grid), dim3(NTHREADS), LDS_BYTES, stream, a);
}
#endif
```

```cpp
#ifdef EMU
#include "emu.h"
#else
#include <hip/hip_runtime.h>
#endif
#include <cstdio>
#include <cstdint>
#include <cstddef>

#ifndef CFG_BATCH
#define CFG_BATCH 4
#define CFG_SEQ 4096
#define CFG_CTX 256
#define CFG_DEPTH 4
#define CFG_NEXP 16
#define CFG_FF 2048
#endif
constexpr int B_ = CFG_BATCH, SEQ = CFG_SEQ, CTX = CFG_CTX, DEPTH = CFG_DEPTH, NE = CFG_NEXP, FF = CFG_FF;
constexpr int D = 1024, TOK = CTX + SEQ, MROWS = B_ * TOK, MPAD = (MROWS + 255) / 256 * 256;
constexpr int NCH = TOK / 64;
constexpr int LATR = B_ * SEQ;
constexpr int LATPAD = (LATR + 255) / 256 * 256;
constexpr int CAPL = 2 * SEQ / NE, CAPC = 2 * CTX / NE, EROWS = B_ * (CAPL + CAPC), EPAD = (EROWS + 255) / 256 * 256;
constexpr int NIN_E = 4096, NIN_O = 2560, NINMAX = 4096;
constexpr int N_EVEN = (DEPTH + 1) / 2, N_ODD = DEPTH / 2, N_ODDA = N_ODD > 0 ? N_ODD : 1;
constexpr int NR = B_ + 1;
constexpr float ALPHA = 1.681792830507429f;
constexpr float LN_EPS = 1e-5f;
constexpr float HD_SCALE = 0.08838834764831845f;
constexpr int NWAVES = 8, NTHREADS = 512;

enum { I_X = 0, I_C, I_CTX, I_CCTX, I_WMOD, I_BMOD, I_LN1G, I_LN1B, I_LN2G, I_LN2B, I_WROUTER, I_WGATE, I_WUP, I_WDOWN,
       I_EVWIN, I_EVWOUT, I_EVCONV, I_EVALOG, I_EVDTB, I_EVGDNN, I_EVRETN,
       I_ODWIN, I_ODWOUT, I_ODCONV, I_ODGB, I_ODMN, I_ODLRE, I_ODLIM, I_ODLDT, I_ODBRE, I_ODBIM, I_ODCRE, I_ODCIM, I_ODDSKIP, I_ODWGLU, I_ODBGLU, N_IN };

constexpr size_t al256(size_t x) { return (x + 255) & ~(size_t)255; }
constexpr size_t WS_CTL = 0, CTL_BYTES = 65536;
constexpr size_t WS_MOD = WS_CTL + CTL_BYTES;
constexpr size_t WS_WG = al256(WS_MOD + (size_t)DEPTH * NR * 6144 * 4);
constexpr size_t WS_WIN = al256(WS_WG + (size_t)DEPTH * 16 * 1024 * 4);
constexpr size_t WS_WOUT = al256(WS_WIN + (size_t)DEPTH * NINMAX * 1024 * 2);
constexpr size_t WS_WGLU = al256(WS_WOUT + (size_t)DEPTH * 1024 * 1024 * 2);
constexpr size_t WS_WGU = al256(WS_WGLU + (size_t)N_ODDA * 512 * 512 * 2);
constexpr size_t WS_WD = al256(WS_WGU + (size_t)DEPTH * NE * 2 * FF * 1024 * 2);
constexpr size_t WS_S5A = al256(WS_WD + (size_t)DEPTH * NE * 1024 * FF * 2);
constexpr size_t WS_S5B = al256(WS_S5A + (size_t)N_ODDA * 2 * 32 * 128 * 4);
constexpr size_t WS_S5C = al256(WS_S5B + (size_t)N_ODDA * 2 * 32 * 128 * 16 * 2);
constexpr size_t WS_H = al256(WS_S5C + (size_t)N_ODDA * 32 * 16 * 128 * 2);
constexpr size_t WS_XIN = al256(WS_H + (size_t)MPAD * 1024 * 4);
constexpr int ZROW = MPAD;
constexpr size_t WS_GATES = al256(WS_XIN + (size_t)(MPAD + 1) * 1024 * 2);
constexpr size_t WS_MERGED = al256(WS_GATES + (size_t)MROWS * 16 * 4);
constexpr size_t WS_YS = al256(WS_MERGED + (size_t)MPAD * 1024 * 2);
constexpr size_t WS_Y = al256(WS_YS + (size_t)MPAD * 512 * 2);
constexpr size_t WS_AFF = al256(WS_Y + (size_t)MPAD * 1024 * 4);
constexpr size_t WS_SLOT = al256(WS_AFF + (size_t)MROWS * 16 * 4);
constexpr size_t WS_EGATE = al256(WS_SLOT + (size_t)MROWS * 16 * 4);
constexpr size_t WS_MCH = al256(WS_EGATE + (size_t)NE * EPAD * 4);
constexpr size_t WS_WR = al256(WS_MCH + (size_t)B_ * 4 * 2 * NCH * 4);
constexpr size_t WS_EIDX = al256(WS_WR + (size_t)DEPTH * NE * 1024 * 4);
constexpr size_t WS_S5E = al256(WS_EIDX + (size_t)NE * EPAD * 4);
constexpr size_t WS_R = al256(WS_S5E + (size_t)B_ * 2 * 32 * NCH * 128 * 4);
constexpr int NCP = B_ * 8 * 2 * NCH, NCPG = B_ * 4 * 2 * NCH;
constexpr size_t WS_P = WS_R;
constexpr size_t WS_QKV = al256(WS_P + (size_t)MPAD * NINMAX * 2);
constexpr size_t WS_CLW = al256(WS_QKV + (size_t)MROWS * 1536 * 2);
constexpr size_t WS_CLQ = al256(WS_CLW + (size_t)NCP * 64 * 128 * 2);
constexpr size_t WS_CLK = al256(WS_CLQ + (size_t)NCP * 64 * 128 * 2);
constexpr size_t WS_CLA = al256(WS_CLK + (size_t)NCP * 64 * 128 * 2);
constexpr size_t WS_CLU = al256(WS_CLA + (size_t)NCP * 64 * 64 * 2);
constexpr size_t WS_CLS = al256(WS_CLU + (size_t)NCPG * 64 * 128 * 4);
constexpr size_t WS_O = al256(WS_CLS + (size_t)NCP * 512 * 4);
constexpr size_t WS_R_END1 = al256(WS_O + (size_t)2 * MROWS * 1024 * 4);
constexpr size_t WS_XS = WS_R;
constexpr size_t WS_HID = al256(WS_XS + (size_t)NE * EPAD * 1024 * 2);
constexpr size_t WS_YSE = al256(WS_HID + (size_t)NE * EPAD * FF * 2);
constexpr size_t WS_R_END2 = al256(WS_YSE + (size_t)NE * EPAD * 1024 * 4);
constexpr size_t WS_END = WS_R_END1 > WS_R_END2 ? WS_R_END1 : WS_R_END2;

constexpr int LDS_BYTES = 163840;
constexpr int LDS_MISC = 163328;

typedef unsigned short bf16_t;
typedef short bf16x8 __attribute__((ext_vector_type(8)));
typedef float f32x2 __attribute__((ext_vector_type(2)));
typedef float f32x4 __attribute__((ext_vector_type(4)));
typedef float f32x16 __attribute__((ext_vector_type(16)));
typedef unsigned u32x2 __attribute__((ext_vector_type(2)));
typedef unsigned u32x4 __attribute__((ext_vector_type(4)));
#define DEV __device__ __forceinline__

#ifdef EMU
#define LAS
#define GAS
static inline float bf2f_h(bf16_t b) { unsigned u = (unsigned)b << 16; float f; memcpy(&f, &u, 4); return f; }
static inline f32x4 mfma16(bf16x8 a, bf16x8 b, f32x4 c) {
    struct In { bf16x8 a, b; } in{a, b};
    auto s = emu::wave_xchg(&in, sizeof(in)); const int l = emu::cur->lane, col = l & 15, rg = l >> 4;
    for (int r = 0; r < 4; ++r) { const int row = 4 * rg + r; double acc = c[r];
        for (int kg = 0; kg < 4; ++kg) { const In* pa = (const In*)s[row + 16 * kg]; const In* pb = (const In*)s[col + 16 * kg];
            for (int j = 0; j < 8; ++j) acc += (double)bf2f_h((bf16_t)pa->a[j]) * (double)bf2f_h((bf16_t)pb->b[j]); }
        c[r] = (float)acc; }
    return c;
}
static inline f32x16 mfma32(bf16x8 a, bf16x8 b, f32x16 c) {
    struct In { bf16x8 a, b; } in{a, b};
    auto s = emu::wave_xchg(&in, sizeof(in)); const int l = emu::cur->lane, col = l & 31, h = l >> 5;
    for (int r = 0; r < 16; ++r) { const int row = (r & 3) + 8 * (r >> 2) + 4 * h; double acc = c[r];
        for (int kh = 0; kh < 2; ++kh) { const In* pa = (const In*)s[row + 32 * kh]; const In* pb = (const In*)s[col + 32 * kh];
            for (int j = 0; j < 8; ++j) acc += (double)bf2f_h((bf16_t)pa->a[j]) * (double)bf2f_h((bf16_t)pb->b[j]); }
        c[r] = (float)acc; }
    return c;
}
static inline void glds16(const void* g, void* l) { memcpy((char*)l + 16 * emu::cur->lane, g, 16); }
#define S_BARRIER() emu::block_barrier()
#define WAIT_VM(n) do {} while (0)
#define WAIT_LGKM(n) do {} while (0)
#define WAIT_ALL() do {} while (0)
#define SETPRIO(n) do {} while (0)
#define SCHED_BARRIER() do {} while (0)
#define COMPILER_FENCE() do {} while (0)
#define WAVE_LDS_SYNC() do { int _z = 0; (void)emu::wave_xchg(&_z, 4); } while (0)
#define LAUNDER(x) do {} while (0)
#define NT_LOAD(p) (*(p))
#define NT_STORE(v, p) (*(p) = (v))
#define CODE_ALIGN() do {} while (0)
#define LAUNDER_S(x) do {} while (0)
static inline int lane_id() { return emu::cur->lane; }
template <class T> static inline T shfl_xor_t(T v, int m) { auto s = emu::wave_xchg(&v, sizeof(T)); T r; memcpy(&r, s[emu::cur->lane ^ m], sizeof(T)); return r; }
template <class T> static inline T shfl_t(T v, int src) { auto s = emu::wave_xchg(&v, sizeof(T)); T r; memcpy(&r, s[src & 63], sizeof(T)); return r; }
static inline float wave_sum(float v) { for (int o = 1; o < 64; o <<= 1) v += shfl_xor_t(v, o); return v; }
static inline float wave_max(float v) { for (int o = 1; o < 64; o <<= 1) v = fmaxf(v, shfl_xor_t(v, o)); return v; }
template <int W> static inline float group_sum(float v) { for (int o = 1; o < W; o <<= 1) v += shfl_xor_t(v, o); return v; }
template <int W> static inline float group_max(float v) { for (int o = 1; o < W; o <<= 1) v = fmaxf(v, shfl_xor_t(v, o)); return v; }
static inline int bcast_lane(int v, int src) { return shfl_t(v, src); }
static inline float bcast_lane_f(float v, int src) { return shfl_t(v, src); }
static inline float wave_scan_add(float v) { const int ln = emu::cur->lane; for (int o = 1; o < 64; o <<= 1) { const float t = shfl_t(v, ln - o); if (ln >= o) v += t; } return v; }
static inline float wave_scan_max(float v) { const int ln = emu::cur->lane; for (int o = 1; o < 64; o <<= 1) { const float t = shfl_t(v, ln - o); if (ln >= o) v = fmaxf(v, t); } return v; }
static inline int readfirstlane_i(int v) { return v; }
static inline unsigned xb_ld(unsigned* p) { return *(volatile unsigned*)p; }
static inline unsigned xb_add(unsigned* p, unsigned v) { unsigned o = *p; *p = o + v; return o; }
static inline unsigned xb_xcc_id() { return (unsigned)emu::cur->bid & 7u; }
static inline void s_sleep1() { emu::yield(); }
static inline void fence_acquire() {}
static inline void fence_release() {}
static inline unsigned lds_atomic_add(unsigned* p, unsigned v) { unsigned o = *p; *p = o + v; return o; }
static inline unsigned long long rt_now() { return 0ull; }
static inline float fast_exp2(float x) { return exp2f(x); }
static inline float fast_rcp(float x) { return 1.0f / x; }
#else
#define LAS __attribute__((address_space(3)))
#define GAS __attribute__((address_space(1)))
DEV f32x4 mfma16(bf16x8 a, bf16x8 b, f32x4 c) { return __builtin_amdgcn_mfma_f32_16x16x32_bf16(a, b, c, 0, 0, 0); }
DEV f32x16 mfma32(bf16x8 a, bf16x8 b, f32x16 c) { return __builtin_amdgcn_mfma_f32_32x32x16_bf16(a, b, c, 0, 0, 0); }
#define glds16(g, l) __builtin_amdgcn_global_load_lds((const unsigned*)(g), (LAS unsigned*)(l), 16, 0, 0)
#define S_BARRIER() __builtin_amdgcn_s_barrier()
#define WAIT_VM(n) asm volatile("s_waitcnt vmcnt(" #n ")" ::: "memory")
#define WAIT_LGKM(n) asm volatile("s_waitcnt lgkmcnt(" #n ")" ::: "memory")
#define WAIT_ALL() asm volatile("s_waitcnt vmcnt(0) lgkmcnt(0)" ::: "memory")
#define SETPRIO(n) __builtin_amdgcn_s_setprio(n)
#define SCHED_BARRIER() __builtin_amdgcn_sched_barrier(0)
#define COMPILER_FENCE() asm volatile("" ::: "memory")
#define WAVE_LDS_SYNC() asm volatile("s_waitcnt lgkmcnt(0)" ::: "memory")
#define LAUNDER(x) asm volatile("" : "+v"(x))
#define NT_LOAD(p) __builtin_nontemporal_load(p)
#define NT_STORE(v, p) __builtin_nontemporal_store((v), (p))
#define CODE_ALIGN() asm volatile(".p2align 8")
#define LAUNDER_S(x) asm volatile("" : "+s"(x))
DEV int lane_id() { return (int)__builtin_amdgcn_mbcnt_hi(~0u, __builtin_amdgcn_mbcnt_lo(~0u, 0u)); }
template <class T> DEV T shfl_xor_t(T v, int m) { return __shfl_xor(v, m); }
template <class T> DEV T shfl_t(T v, int src) { return __shfl(v, src); }
template <int CTRL, int ROWMASK> DEV float dpp_mov(float v) { return __builtin_bit_cast(float, __builtin_amdgcn_update_dpp(0, __builtin_bit_cast(int, v), CTRL, ROWMASK, 0xf, false)); }
template <int CTRL, int ROWMASK> DEV float dpp_mov_keep(float oldv, float v) { return __builtin_bit_cast(float, __builtin_amdgcn_update_dpp(__builtin_bit_cast(int, oldv), __builtin_bit_cast(int, v), CTRL, ROWMASK, 0xf, false)); }
template <int W> DEV float group_sum(float v) {
    v += dpp_mov<0xB1, 0xf>(v); v += dpp_mov<0x4E, 0xf>(v);
    if (W >= 8) v += dpp_mov<0x141, 0xf>(v);
    if (W >= 16) v += dpp_mov<0x140, 0xf>(v);
    return v;
}
DEV float wave_sum(float v) {
    v = group_sum<16>(v);
    v += dpp_mov<0x142, 0xa>(v);
    v += dpp_mov<0x143, 0xc>(v);
    return __builtin_bit_cast(float, __builtin_amdgcn_readlane(__builtin_bit_cast(int, v), 63));
}
DEV float wave_max(float v) {
    v = fmaxf(v, dpp_mov_keep<0xB1, 0xf>(v, v)); v = fmaxf(v, dpp_mov_keep<0x4E, 0xf>(v, v)); v = fmaxf(v, dpp_mov_keep<0x141, 0xf>(v, v)); v = fmaxf(v, dpp_mov_keep<0x140, 0xf>(v, v));
    v = fmaxf(v, dpp_mov_keep<0x142, 0xa>(v, v)); v = fmaxf(v, dpp_mov_keep<0x143, 0xc>(v, v));
    return __builtin_bit_cast(float, __builtin_amdgcn_readlane(__builtin_bit_cast(int, v), 63));
}
template <int W> DEV float group_max(float v) {
    v = fmaxf(v, dpp_mov_keep<0xB1, 0xf>(v, v)); v = fmaxf(v, dpp_mov_keep<0x4E, 0xf>(v, v));
    if (W >= 8) v = fmaxf(v, dpp_mov_keep<0x141, 0xf>(v, v));
    if (W >= 16) v = fmaxf(v, dpp_mov_keep<0x140, 0xf>(v, v));
    return v;
}
DEV int bcast_lane(int v, int src) { return __builtin_amdgcn_readlane(v, src); }
DEV float bcast_lane_f(float v, int src) { return __builtin_bit_cast(float, __builtin_amdgcn_readlane(__builtin_bit_cast(int, v), src)); }
DEV float wave_scan_add(float v) {
    v += dpp_mov<0x111, 0xf>(v); v += dpp_mov<0x112, 0xf>(v); v += dpp_mov<0x114, 0xf>(v); v += dpp_mov<0x118, 0xf>(v);
    v += dpp_mov<0x142, 0xa>(v); v += dpp_mov<0x143, 0xc>(v); return v;
}
DEV float wave_scan_max(float v) {
    v = fmaxf(v, dpp_mov_keep<0x111, 0xf>(v, v)); v = fmaxf(v, dpp_mov_keep<0x112, 0xf>(v, v)); v = fmaxf(v, dpp_mov_keep<0x114, 0xf>(v, v)); v = fmaxf(v, dpp_mov_keep<0x118, 0xf>(v, v));
    v = fmaxf(v, dpp_mov_keep<0x142, 0xa>(v, v)); v = fmaxf(v, dpp_mov_keep<0x143, 0xc>(v, v)); return v;
}
DEV int readfirstlane_i(int v) { return __builtin_amdgcn_readfirstlane(v); }
DEV unsigned xb_ld(unsigned* p) { return __hip_atomic_load(p, __ATOMIC_RELAXED, __HIP_MEMORY_SCOPE_AGENT); }
DEV unsigned xb_add(unsigned* p, unsigned v) { return __hip_atomic_fetch_add(p, v, __ATOMIC_RELAXED, __HIP_MEMORY_SCOPE_AGENT); }
DEV unsigned xb_xcc_id() { return (unsigned)__builtin_amdgcn_s_getreg((3 << 11) | 20) & 0xFu; }
DEV void s_sleep1() { __builtin_amdgcn_s_sleep(1); }
DEV void fence_acquire() { __builtin_amdgcn_fence(__ATOMIC_ACQUIRE, "agent"); }
DEV void fence_release() { __builtin_amdgcn_fence(__ATOMIC_RELEASE, "agent"); }
DEV unsigned lds_atomic_add(LAS unsigned* p, unsigned v) { return __hip_atomic_fetch_add(p, v, __ATOMIC_RELAXED, __HIP_MEMORY_SCOPE_WORKGROUP); }
DEV unsigned long long rt_now() { return __builtin_amdgcn_s_memrealtime(); }
DEV float fast_exp2(float x) { return __builtin_amdgcn_exp2f(x); }
DEV float fast_rcp(float x) { return __builtin_amdgcn_rcpf(x); }
#endif

#ifdef EMU
DEV unsigned f2bf(float f) { unsigned u = __builtin_bit_cast(unsigned, f); return (u + 0x7fffu + ((u >> 16) & 1u)) >> 16; }
DEV unsigned pk2(float lo, float hi) { return f2bf(lo) | (f2bf(hi) << 16); }
DEV unsigned f2bf_sw(float f) { return f2bf(f); }
DEV unsigned pk2_sw(float lo, float hi) { return pk2(lo, hi); }
#else
typedef float f32x2n_t __attribute__((ext_vector_type(2)));
typedef __bf16 bf16x2n_t __attribute__((ext_vector_type(2)));
DEV unsigned pk2(float lo, float hi) { const f32x2n_t v = {lo, hi}; return __builtin_bit_cast(unsigned, __builtin_convertvector(v, bf16x2n_t)); }
DEV unsigned f2bf(float f) { return (unsigned)__builtin_bit_cast(unsigned short, (__bf16)f); }
DEV unsigned f2bf_sw(float f) { unsigned u = __builtin_bit_cast(unsigned, f); return (u + 0x7fffu + ((u >> 16) & 1u)) >> 16; }
DEV unsigned pk2_sw(float lo, float hi) { return f2bf_sw(lo) | (f2bf_sw(hi) << 16); }
#endif
DEV float bf2f(unsigned b) { return __builtin_bit_cast(float, b << 16); }
DEV float bflo(unsigned w) { return __builtin_bit_cast(float, w << 16); }
DEV float bfhi(unsigned w) { return __builtin_bit_cast(float, w & 0xffff0000u); }
DEV float sigmoid_f(float x) { return 1.0f / (1.0f + expf(-x)); }
DEV float silu_f(float x) { return x / (1.0f + expf(-x)); }
DEV float softplus_f(float x) { return fmaxf(x, 0.0f) + log1pf(expf(-fabsf(x))); }
DEV float fast_sigmoid(float x) { return fast_rcp(1.0f + fast_exp2(-1.4426950408889634f * x)); }
DEV float fast_silu(float x) { return x * fast_sigmoid(x); }
DEV float gelu_tanh_f(float x) { const float u = 0.7978845608028654f * (x + 0.044715f * x * x * x); return x * fast_sigmoid(2.0f * u); }
DEV float fast_exp(float x) { return fast_exp2(1.4426950408889634f * x); }

#define XB_TMO      128
#define XB_XCNT(j)  (256  + 64 * (j))
#define XB_XSUB(j)  (1280 + 64 * (j))
#define XB_XGEN(j)  (2304 + 64 * (j))
#define XB_TOP      3328
#define XB_TOPGEN   3392
#define XCD_BAR_WORDS 3456
#define XB_SPIN_CAP (1u << 20)
#define XB_SPIN(cond, bar) do { unsigned _sp = 0; while (cond) { s_sleep1(); \
    if ((++_sp & 255u) == 0u) { if (xb_ld(&(bar)[XB_TMO])) break; if (_sp > XB_SPIN_CAP) { xb_add(&(bar)[XB_TMO], 1u); break; } } } } while (0)
struct XcdBarrier { unsigned* bar; unsigned x; volatile LAS unsigned* st; int wave; };
DEV XcdBarrier xcd_barrier_post(unsigned* bar, volatile LAS unsigned* st, int wave) {
    XcdBarrier b; b.wave = wave; b.bar = bar; b.x = (unsigned)readfirstlane_i((int)xb_xcc_id()); b.st = st;
    if (wave == 0 && lane_id() == 0) (void)xb_add(&bar[XB_XCNT(b.x)], 1u);
    return b;
}
DEV void xcd_barrier_complete(unsigned* bar, unsigned x, unsigned& nloc, unsigned& nx) {
    const unsigned G = gridDim.x;
    unsigned sum, cnt, mine, sp = 0u;
    for (;;) {
        sum = 0u; cnt = 0u; mine = 0u;
#pragma unroll
        for (unsigned j = 0; j < 16; ++j) { const unsigned c = xb_ld(&bar[XB_XCNT(j)]); sum += c; cnt += (c > 0u) ? 1u : 0u; mine = (j == x) ? c : mine; }
        if (sum == G) break;
        s_sleep1();
        if ((++sp & 255u) == 0u) { if (xb_ld(&bar[XB_TMO])) break; if (sp > XB_SPIN_CAP) { xb_add(&bar[XB_TMO], 1u); break; } }
    }
    nloc = mine > 0u ? mine : 1u; nx = cnt > 0u ? cnt : 1u;
}
DEV void xcd_barrier(const XcdBarrier& b) {
    WAIT_VM(0);
    __syncthreads();
    int bw = b.wave; LAUNDER_S(bw);
    if (bw == 0 && lane_id() == 0) {
        unsigned* bar = b.bar; LAUNDER_S(bar);
        unsigned bx = b.x; LAUNDER_S(bx);
        WAIT_ALL();
        unsigned nloc = b.st[0], nx = b.st[1];
        if (nloc == 0u) { xcd_barrier_complete(bar, bx, nloc, nx); b.st[0] = nloc; b.st[1] = nx; }
        const unsigned old = xb_add(&bar[XB_XSUB(bx)], 1u);
        const unsigned gen = old / nloc;
        if (old + 1u == (gen + 1u) * nloc) {
            fence_release();
            WAIT_VM(0);
            const unsigned og = xb_add(&bar[XB_TOP], 1u);
            const unsigned tg = og / nx;
            if (og + 1u == (tg + 1u) * nx) xb_add(&bar[XB_TOPGEN], 1u);
            else XB_SPIN(xb_ld(&bar[XB_TOPGEN]) == tg, bar);
            fence_acquire();
            xb_add(&bar[XB_XGEN(bx)], 1u);
            WAIT_VM(0);
        } else {
            XB_SPIN(xb_ld(&bar[XB_XGEN(bx)]) == gen, bar);
            fence_acquire();
            WAIT_VM(0);
        }
    }
    __syncthreads();
}

namespace pg8 {
constexpr int BM = 256, BK = 64, HALF = 128, HTB = HALF * BK * 2, STAGE_BYTES = 8 * HTB;
DEV int lds_byte(int r, int c) { const int st = (r >> 4) * 2 + (c >> 5), rr = r & 15, cc = c & 31, ob = rr * 64 + cc * 2; return st * 1024 + (ob ^ (((ob >> 9) & 1) << 5)); }
DEV void stage_rc(int b, int& R, int& C) { const int st = b / 1024, sb = b % 1024, swz = sb ^ (((sb >> 9) & 1) << 5); R = (st >> 1) * 16 + swz / 64; C = (st & 1) * 32 + (swz % 64) / 2; }
DEV int perm32(int rho) { const int n = rho >> 4, i = rho & 15; return 8 * (i >> 2) + 4 * n + (i & 3); }
struct Unit { const char* A; const char* B; int pm, pn, e; };
#ifdef EMU
static inline unsigned cvt_pk_bf16(float lo, float hi) { return pk2(lo, hi); }
#else
DEV unsigned cvt_pk_bf16(float lo, float hi) { return pk2(lo, hi); }
#endif
template <class Epi, class Sched>
DEV void gemm_phase(LAS unsigned char* lds, const int K, const Sched& S, const Epi& E, const int wid, const int lane) {
    const int tid = wid * 64 + lane; const int wr = wid >> 2, wc = wid & 3, fr = lane & 15, fq = lane >> 4;
    const int nt = K / BK;
    unsigned voffA[2], voffB[2]; int Ri[2], Ci[2];
#pragma unroll
    for (int i = 0; i < 2; ++i) { int R, C; stage_rc(tid * 16 + i * 8192, R, C); const int Rb = Epi::PERM ? ((R & ~31) + perm32(R & 31)) : R; Ri[i] = R; Ci[i] = C;
        voffA[i] = (unsigned)(R * K + C) * 2u; voffB[i] = (unsigned)(Rb * K + C) * 2u; }
    unsigned goffC[2][2] = {{0u, 0u}, {0u, 0u}}, goffN[2][2] = {{0u, 0u}, {0u, 0u}};
    constexpr int GIDX_OFF = STAGE_BYTES;
    const size_t kstep = (size_t)(BK * 2);
    const size_t hstep = (size_t)HALF * K * 2;
    const unsigned ldsw = (unsigned)wid * 1024u;
    const int aoff = lds_byte(wr * 64 + fr, fq * 8), boff = lds_byte(wc * 32 + fr, fq * 8);
#define PG8_SA(b, h) (((b) * 2 + (h)) * HTB)
#define PG8_SB(b, h) ((4 + (b) * 2 + (h)) * HTB)
#define PG8_STAGE(bufoff, gbase, voff) do { _Pragma("unroll") for (int _i = 0; _i < 2; ++_i) \
        glds16(((const char*)(gbase) + (voff)[_i]), (lds + (bufoff) + ldsw + _i * 8192)); } while (0)
#define PG8_STAGEA(bufoff, gptr, h, nx) do { _Pragma("unroll") for (int _i = 0; _i < 2; ++_i) { \
        const unsigned _o = Sched::GATHER_A ? ((nx) ? goffN[h][_i] : goffC[h][_i]) : voffA[_i] + (unsigned)((h) * hstep); \
        glds16(((const char*)(gptr) + _o), (lds + (bufoff) + ldsw + _i * 8192)); } } while (0)
#define PG8_LDA(dst, b, h) do { _Pragma("unroll") for (int m = 0; m < 4; ++m) _Pragma("unroll") for (int k = 0; k < 2; ++k) dst[m][k] = *(const LAS bf16x8*)(lds + PG8_SA(b, h) + aoff + m * 2048 + k * 1024); } while (0)
#define PG8_LDB(dst, b, h) do { _Pragma("unroll") for (int n = 0; n < 2; ++n) _Pragma("unroll") for (int k = 0; k < 2; ++k) dst[n][k] = *(const LAS bf16x8*)(lds + PG8_SB(b, h) + boff + n * 2048 + k * 1024); } while (0)
#define PG8_MMA(ai, bj, At, Bt) do { SETPRIO(1); _Pragma("unroll") for (int m = 0; m < 4; ++m) _Pragma("unroll") for (int n = 0; n < 2; ++n) _Pragma("unroll") for (int k = 0; k < 2; ++k) \
        acc[ai][bj][m][n] = mfma16(Bt[n][k], At[m][k], acc[ai][bj][m][n]); SETPRIO(0); } while (0)
    Unit cur, nxt; int ui = 0;
    if (!S.next(0, cur)) return;
    f32x4 acc[2][2][4][2];
#pragma unroll
    for (int a = 0; a < 2; ++a)
#pragma unroll
        for (int b = 0; b < 2; ++b)
#pragma unroll
            for (int m = 0; m < 4; ++m)
#pragma unroll
                for (int n = 0; n < 2; ++n) acc[a][b][m][n] = (f32x4){0.f, 0.f, 0.f, 0.f};
    bf16x8 At[4][2], B0[2][2], B1[2][2];
    const char* cA = cur.A; const char* cB = cur.B;
    if constexpr (Sched::GATHER_A) {
#pragma unroll
        for (int hh = 0; hh < 2; ++hh)
#pragma unroll
            for (int i = 0; i < 2; ++i) { goffC[hh][i] = (unsigned)S.gidx[S.idx_base(cur) + hh * HALF + Ri[i]] * (unsigned)(K * 2) + (unsigned)(Ci[i] * 2); goffN[hh][i] = goffC[hh][i]; }
    }
    PG8_STAGE(PG8_SB(0, 0), cB, voffB); PG8_STAGE(PG8_SB(0, 1), cB + hstep, voffB); PG8_STAGEA(PG8_SA(0, 0), cA, 0, false); PG8_STAGEA(PG8_SA(0, 1), cA, 1, false);
    if (wr == 1) S_BARRIER();
    WAIT_VM(2); S_BARRIER();
    PG8_STAGE(PG8_SB(1, 0), cB + kstep, voffB); PG8_STAGEA(PG8_SA(1, 0), cA + kstep, 0, false); PG8_STAGE(PG8_SB(1, 1), cB + hstep + kstep, voffB);
    WAIT_VM(6); S_BARRIER();
    CODE_ALIGN();
    for (;;) {
        const bool has_next = S.next(ui + 1, nxt);
        const char* nA = has_next ? nxt.A : cA; const char* nB = has_next ? nxt.B : cB;
        if constexpr (Sched::GATHER_A) { if (has_next && wid == 0) glds16((const char*)(S.gidx + S.idx_base(nxt)) + 16 * lane, lds + GIDX_OFF); }
        for (int t = 0; t < nt; t += 2) {
            const bool last = (t == nt - 2);
            const char* a1 = cA + (size_t)(t + 1) * kstep;
            const char* a2 = last ? nA : cA + (size_t)(t + 2) * kstep; const char* b2 = last ? nB : cB + (size_t)(t + 2) * kstep;
            const char* a3 = a2 + kstep; const char* b3 = b2 + kstep;
            if constexpr (Sched::GATHER_A) { if (last && has_next) { COMPILER_FENCE();
#pragma unroll
                for (int hh = 0; hh < 2; ++hh)
#pragma unroll
                    for (int i = 0; i < 2; ++i) goffN[hh][i] = (unsigned)(*(const LAS int*)(lds + GIDX_OFF + 4 * (hh * HALF + Ri[i]))) * (unsigned)(K * 2) + (unsigned)(Ci[i] * 2); } }
            PG8_LDB(B0, 0, 0); PG8_LDB(B1, 0, 1); SCHED_BARRIER(); PG8_LDA(At, 0, 0); PG8_STAGEA(PG8_SA(1, 1), a1, 1, false);
            WAIT_VM(8); WAIT_LGKM(0); S_BARRIER(); PG8_MMA(0, 0, At, B0); PG8_MMA(0, 1, At, B1); S_BARRIER(); SCHED_BARRIER();
            PG8_LDA(At, 0, 1); PG8_STAGE(PG8_SB(0, 0), b2, voffB); PG8_STAGE(PG8_SB(0, 1), b2 + hstep, voffB); PG8_STAGEA(PG8_SA(0, 0), a2, 0, last);
            WAIT_VM(8); WAIT_LGKM(0); S_BARRIER(); PG8_MMA(1, 0, At, B0); PG8_MMA(1, 1, At, B1); S_BARRIER(); SCHED_BARRIER();
            PG8_LDB(B0, 1, 0); PG8_LDB(B1, 1, 1); SCHED_BARRIER(); PG8_LDA(At, 1, 0); PG8_STAGEA(PG8_SA(0, 1), a2, 1, last);
            WAIT_VM(8); WAIT_LGKM(0); S_BARRIER(); PG8_MMA(0, 0, At, B0); PG8_MMA(0, 1, At, B1); S_BARRIER(); SCHED_BARRIER();
            PG8_LDA(At, 1, 1); PG8_STAGE(PG8_SB(1, 0), b3, voffB); PG8_STAGE(PG8_SB(1, 1), b3 + hstep, voffB); PG8_STAGEA(PG8_SA(1, 0), a3, 0, last);
            WAIT_VM(8); WAIT_LGKM(0); S_BARRIER(); PG8_MMA(1, 0, At, B0); PG8_MMA(1, 1, At, B1); S_BARRIER(); SCHED_BARRIER();
        }
        if (wr == 0) S_BARRIER();
        E(acc, cur, wr, wc, fr, fq);
        if (!has_next) break;
#pragma unroll
        for (int a = 0; a < 2; ++a)
#pragma unroll
            for (int b = 0; b < 2; ++b)
#pragma unroll
                for (int m = 0; m < 4; ++m)
#pragma unroll
                    for (int n = 0; n < 2; ++n) acc[a][b][m][n] = (f32x4){0.f, 0.f, 0.f, 0.f};
        cur = nxt; cA = nA; cB = nB; ++ui;
        if constexpr (Sched::GATHER_A) {
#pragma unroll
            for (int hh = 0; hh < 2; ++hh)
#pragma unroll
                for (int i = 0; i < 2; ++i) goffC[hh][i] = goffN[hh][i]; }
        if (wr == 1) S_BARRIER();
    }
    WAIT_VM(0);
    S_BARRIER();
#undef PG8_SA
#undef PG8_SB
#undef PG8_STAGE
#undef PG8_STAGEA
#undef PG8_LDA
#undef PG8_LDB
#undef PG8_MMA
}

struct PlainOrder {
    static constexpr bool GATHER_A = false;
    const char* A; const char* Bt; int K, nM, nN, nwg, G, c;
    DEV void init(const void* A_, const void* Bt_, int K_, int M, int N, int G_, int c_) { A = (const char*)A_; Bt = (const char*)Bt_; K = K_; nM = M / BM; nN = N / BM; nwg = nM * nN; G = G_; c = c_; }
    DEV bool next(int i, Unit& u) const {
        const long L = (long)i * G + c; if (L >= nwg) return false;
        int wgid = (int)L; { const int q = nwg / 8, r = nwg % 8, xcd = wgid % 8, off = wgid / 8; wgid = (xcd < r ? xcd * (q + 1) : r * (q + 1) + (xcd - r) * q) + off; }
        const int nig = 8 * nN, gid = wgid / nig, fm = gid * 8, gsz = (nM - fm) < 8 ? (nM - fm) : 8;
        u.pm = fm + ((wgid % nig) % gsz); u.pn = (wgid % nig) / gsz; u.e = 0;
        u.A = A + (size_t)u.pm * BM * K * 2; u.B = Bt + (size_t)u.pn * BM * K * 2; return true;
    }
};
struct GroupedOrder {
    static constexpr bool GATHER_A = false;
    const char* A; const char* Bt; int K, nMe, nN, nwg, G, c; size_t bstride;
    DEV void init(const void* A_, const void* Bt_, int K_, int N, int G_, int c_, int erows) { A = (const char*)A_; Bt = (const char*)Bt_; K = K_; nMe = (erows + BM - 1) / BM; nN = N / BM; nwg = NE * nMe * nN; G = G_; c = c_; bstride = (size_t)N * K * 2; }
    DEV bool next(int i, Unit& u) const {
        const long L = (long)i * G + c; if (L >= nwg) return false;
        int wgid = (int)L; { const int q = nwg / 8, r = nwg % 8, xcd = wgid % 8, off = wgid / 8; wgid = (xcd < r ? xcd * (q + 1) : r * (q + 1) + (xcd - r) * q) + off; }
        const int per_e = nMe * nN; const int e = wgid / per_e, w = wgid % per_e;
        u.e = e; u.pm = w % nMe; u.pn = w / nMe;
        u.A = A + ((size_t)e * EPAD + (size_t)u.pm * BM) * K * 2; u.B = Bt + (size_t)e * bstride + (size_t)u.pn * BM * K * 2; return true;
    }
};
struct GatherOrder : GroupedOrder {
    static constexpr bool GATHER_A = true;
    const int* gidx;
    DEV bool next(int i, Unit& u) const { if (!GroupedOrder::next(i, u)) return false; u.A = A; return true; }
    DEV size_t idx_base(const Unit& u) const { return (size_t)u.e * EPAD + (size_t)u.pm * BM; }
};
}

struct Args { const float* in[N_IN]; float* out; unsigned char* ws; };

struct Frame {
    const float* const* in; GAS float* out; GAS unsigned char* ws; LAS unsigned char* lds;
    int tid, lane, wave, G, bid, gw, NGW;
};

#define HROW(F, l, r) ((l) == 0 ? ((r) < LATR ? GIN(I_X) + (size_t)(r) * 1024 : GIN(I_CTX) + (size_t)((r) - LATR) * 1024) : (const float*)((F).ws + WS_H) + (size_t)(r) * 1024)

DEV Frame refresh(const Frame& F0) {
    Frame F = F0; int w = F0.wave; LAUNDER_S(w); int ln = lane_id(); LAUNDER(ln);
    F.wave = w; F.lane = ln; F.tid = w * 64 + ln; F.gw = F.bid * NWAVES + w;
    GAS unsigned char* ws = F0.ws; LAUNDER_S(ws); F.ws = ws;
    return F;
}

#define GIN(k) ((const float*)(GAS const float*)F.in[k])

#define ROW_LOOP(r, NROWS) for (int r = F.gw; r < (NROWS); r += F.NGW)

DEV int tok_row(int b, int d, int sp) {
    if (sp < CTX) return LATR + b * CTX + (d ? (CTX - 1 - sp) : sp);
    const int j = sp - CTX; return b * SEQ + (d ? (SEQ - 1 - j) : j);
}
DEV void row_bs(int r, int& b, int& s) { if (r < LATR) { b = r / SEQ; s = CTX + r % SEQ; } else { const int q = r - LATR; b = q / CTX; s = q % CTX; } }

DEV void tr_item(const float* W, int ldw, int col0, int k0, bf16_t* WT, int K, int row0, LAS float* scr, int lane) {
#pragma unroll 8
    for (int i = 0; i < 32; ++i) { const int kk = 2 * i + (lane >> 5); scr[kk * 33 + (lane & 31)] = NT_LOAD(&W[(size_t)(k0 + kk) * ldw + col0 + (lane & 31)]); }
    WAVE_LDS_SYNC();
    const int c = lane & 7;
#pragma unroll
    for (int j = 0; j < 4; ++j) { const int n = (lane >> 3) + 8 * j; const LAS float* s = scr + (8 * c) * 33 + n;
        u32x4 o; o.x = pk2(s[0 * 33], s[1 * 33]); o.y = pk2(s[2 * 33], s[3 * 33]); o.z = pk2(s[4 * 33], s[5 * 33]); o.w = pk2(s[6 * 33], s[7 * 33]);
        NT_STORE(o, (u32x4*)(WT + (size_t)(row0 + n) * K + k0 + 8 * c)); }
    WAVE_LDS_SYNC();
}

DEV void phase_prologue_a(const Frame& F0) {
    const Frame F = refresh(F0);
    LAS float* scr = (LAS float*)(F.lds + F.wave * 16384);
    for (int l = 0; l < DEPTH; ++l) {
        const int odd = l & 1, li = l >> 1;
        const float* win = odd ? GIN(I_ODWIN) + (size_t)li * 1024 * 2576 : GIN(I_EVWIN) + (size_t)li * 1024 * 4112;
        const int ldw = odd ? 2576 : 4112, nin = odd ? NIN_O : NIN_E;
        bf16_t* wint = (bf16_t*)(F.ws + WS_WIN) + (size_t)l * NINMAX * 1024;
        for (int it = F.gw; it < 16 * (nin / 32); it += F.NGW) { const int kb = it / (nin / 32), nb = it % (nin / 32); const int d0 = 32 * nb;
            tr_item(win, ldw, d0 < 2048 ? d0 : d0 + 16, 64 * kb, wint, 1024, d0, scr, F.lane); }
        const float* wout = odd ? GIN(I_ODWOUT) + (size_t)li * 1024 * 1024 : GIN(I_EVWOUT) + (size_t)li * 1024 * 1024;
        bf16_t* woutt = (bf16_t*)(F.ws + WS_WOUT) + (size_t)l * 1024 * 1024;
        for (int it = F.gw; it < 16 * 32; it += F.NGW) { const int kb = it / 32, nb = it % 32; tr_item(wout, 1024, 32 * nb, 64 * kb, woutt, 1024, 32 * nb, scr, F.lane); }
        if (odd) {
            const float* wglu = GIN(I_ODWGLU) + (size_t)li * 512 * 512; bf16_t* wglut = (bf16_t*)(F.ws + WS_WGLU) + (size_t)li * 512 * 512;
            for (int it = F.gw; it < 8 * 16; it += F.NGW) { const int kb = it / 16, nb = it % 16; tr_item(wglu, 512, 32 * nb, 64 * kb, wglut, 512, 32 * nb, scr, F.lane); }
        }
        constexpr int GU_NB = 2 * FF / 32, GU_ITEMS = 16 * GU_NB;
        for (int it = F.gw; it < NE * GU_ITEMS; it += F.NGW) { const int e = it / GU_ITEMS, r = it % GU_ITEMS, kb = r / GU_NB, nb = r % GU_NB; const int d0 = 32 * nb, j = d0 >> 8, w = d0 & 255;
            const float* src = (w < 128 ? GIN(I_WGATE) : GIN(I_WUP)) + ((size_t)l * NE + e) * 1024 * FF;
            tr_item(src, FF, 128 * j + (w & 127), 64 * kb, (bf16_t*)(F.ws + WS_WGU) + ((size_t)l * NE + e) * 2 * FF * 1024, 1024, d0, scr, F.lane); }
        constexpr int D_ITEMS = (FF / 64) * 32;
        for (int it = F.gw; it < NE * D_ITEMS; it += F.NGW) { const int e = it / D_ITEMS, r = it % D_ITEMS, kb = r / 32, nb = r % 32;
            tr_item(GIN(I_WDOWN) + ((size_t)l * NE + e) * FF * 1024, 1024, 32 * nb, 64 * kb, (bf16_t*)(F.ws + WS_WD) + ((size_t)l * NE + e) * 1024 * FF, FF, 32 * nb, scr, F.lane); }
    }
    const int gt = F.bid * NTHREADS + F.tid, NGT = F.G * NTHREADS;
    for (int i = gt; i < DEPTH * 16 * 1024; i += NGT) { const int l = i / 16384, g = (i >> 10) & 15, k = i & 1023; const int odd = l & 1, li = l >> 1;
        ((float*)(F.ws + WS_WG))[i] = odd ? GIN(I_ODWIN)[((size_t)li * 1024 + k) * 2576 + 2048 + g] : GIN(I_EVWIN)[((size_t)li * 1024 + k) * 4112 + 2048 + g]; }
    for (int i = gt; i < DEPTH * NE * 1024; i += NGT) { const int k = i & 1023, e = (i >> 10) % NE, l = i / (NE * 1024); ((float*)(F.ws + WS_WR))[i] = GIN(I_WROUTER)[((size_t)l * 1024 + k) * NE + e]; }
    for (int i = gt; i < N_ODD * 2 * 32 * 64; i += NGT) { const int p = i & 63, g = (i >> 6) & 31, d = (i >> 11) & 1, o = i >> 12;
        const int idx = ((o * 2 + d) * 32 + g) * 64 + p;
        const float lr = fminf(GIN(I_ODLRE)[idx], -1e-4f), li_ = GIN(I_ODLIM)[idx], dt = expf(GIN(I_ODLDT)[(o * 2 + d) * 32 + g]);
        const float mag = expf(lr * dt); float sn, cs; sincosf(li_ * dt, &sn, &cs); const float are = mag * cs, aim = mag * sn;
        float* A = (float*)(F.ws + WS_S5A) + (size_t)((o * 2 + d) * 32 + g) * 128; A[p] = are; A[64 + p] = aim;
        const float xr = are - 1.0f, xi = aim, den = lr * lr + li_ * li_; const float fre = (xr * lr + xi * li_) / den, fim = (xi * lr - xr * li_) / den;
        bf16_t* Bb = (bf16_t*)(F.ws + WS_S5B) + (size_t)((o * 2 + d) * 32 + g) * 128 * 16;
        for (int h = 0; h < 16; ++h) { const float br = GIN(I_ODBRE)[((size_t)(o * 32 + g) * 64 + p) * 16 + h], bi = GIN(I_ODBIM)[((size_t)(o * 32 + g) * 64 + p) * 16 + h];
            Bb[p * 16 + h] = (bf16_t)f2bf(fre * br - fim * bi); Bb[(64 + p) * 16 + h] = (bf16_t)f2bf(fre * bi + fim * br); } }
    for (int i = gt; i < N_ODD * 32 * 16 * 64; i += NGT) { const int p = i & 63, c = (i >> 6) & 15, g = (i >> 10) & 31, o = i >> 15;
        bf16_t* Cm = (bf16_t*)(F.ws + WS_S5C) + (size_t)((o * 32 + g) * 16 + c) * 128;
        Cm[2 * p] = (bf16_t)f2bf(GIN(I_ODCRE)[i]); Cm[2 * p + 1] = (bf16_t)f2bf(-GIN(I_ODCIM)[i]); }
    ROW_LOOP(r, MPAD) {
        f32x4* dst = (f32x4*)((float*)(F.ws + WS_H) + (size_t)r * 1024) + F.lane;
        if (r < MROWS) { }
        else {
#pragma unroll
            for (int j = 0; j < 4; ++j) dst[64 * j] = (f32x4){0.f, 0.f, 0.f, 0.f};
            u32x4* xz = (u32x4*)((bf16_t*)(F.ws + WS_XIN) + (size_t)r * 1024) + F.lane; xz[0] = (u32x4){0u, 0u, 0u, 0u}; xz[64] = (u32x4){0u, 0u, 0u, 0u};
            u32x4* mz = (u32x4*)((bf16_t*)(F.ws + WS_MERGED) + (size_t)r * 1024) + F.lane; mz[0] = (u32x4){0u, 0u, 0u, 0u}; mz[64] = (u32x4){0u, 0u, 0u, 0u};
            u32x4* yz = (u32x4*)((bf16_t*)(F.ws + WS_YS) + (size_t)r * 512) + F.lane; yz[0] = (u32x4){0u, 0u, 0u, 0u};
        }
    }
    if (F.gw == 0) { u32x4* zr = (u32x4*)((bf16_t*)(F.ws + WS_XIN) + (size_t)ZROW * 1024) + F.lane; zr[0] = (u32x4){0u, 0u, 0u, 0u}; zr[64] = (u32x4){0u, 0u, 0u, 0u}; }
    __syncthreads();
    LAS float* sv = (LAS float*)F.lds;
    LAS float* part = (LAS float*)(F.lds + 32768);
    for (int i = F.tid; i < NR * 1024; i += NTHREADS) { const int r = i >> 10, k = i & 1023; const float c = r < B_ ? GIN(I_C)[r * 1024 + k] : GIN(I_CCTX)[k]; sv[i] = silu_f(c); }
    __syncthreads();
    for (int it = F.bid; it < DEPTH * 96; it += F.G) {
        const int l = it / 96, j = (it % 96) * 64 + F.lane;
        const float* w = GIN(I_WMOD) + (size_t)l * 1024 * 6144 + j;
        float acc[NR];
#pragma unroll
        for (int r = 0; r < NR; ++r) acc[r] = 0.f;
        const int k0 = F.wave * 128;
#pragma unroll 8
        for (int k = 0; k < 128; ++k) { const float wv = w[(size_t)(k0 + k) * 6144];
#pragma unroll
            for (int r = 0; r < NR; ++r) acc[r] += sv[r * 1024 + k0 + k] * wv; }
#pragma unroll
        for (int r = 0; r < NR; ++r) part[(F.wave * NR + r) * 64 + F.lane] = acc[r];
        __syncthreads();
        for (int i = F.tid; i < NR * 64; i += NTHREADS) { const int r = i >> 6, jj = i & 63; float s = 0.f;
#pragma unroll
            for (int w8 = 0; w8 < 8; ++w8) s += part[(w8 * NR + r) * 64 + jj];
            const int col = (it % 96) * 64 + jj;
            ((float*)(F.ws + WS_MOD))[((size_t)l * NR + r) * 6144 + col] = s + GIN(I_BMOD)[l * 6144 + col]; }
        __syncthreads();
    }
}

static_assert(TOK % 4 == 0 && CTX % 4 == 0 && MROWS % 4 == 0, "row groups");
#define ROW_GROUPS(nrows, CALL4, CALL2) do { const int _r4 = ((nrows) / (4 * F.NGW)) * (4 * F.NGW); \
    for (int r = 4 * F.gw; r < _r4; r += 4 * F.NGW) { CALL4; } for (int r = _r4 + 2 * F.gw; r < (nrows); r += 2 * F.NGW) { CALL2; } } while (0)
template <int RG> DEV void xg_rows(const Frame& F, int l, int row0, f32x4 (&v)[RG][4]) {
    int b, s; row_bs(row0, b, s); const int mr = s < CTX ? B_ : b;
    const float* mod = (const float*)(F.ws + WS_MOD) + ((size_t)l * NR + mr) * 6144;
#pragma unroll
    for (int j = 0; j < 4; ++j) { const f32x4 sh = *((const f32x4*)mod + F.lane + 64 * j), sc = *((const f32x4*)(mod + 1024) + F.lane + 64 * j);
#pragma unroll
        for (int q = 0; q < RG; ++q) v[q][j] = v[q][j] * (1.0f + sc) + sh; }
#pragma unroll
    for (int q = 0; q < RG; ++q) { u32x2* xo = (u32x2*)((bf16_t*)(F.ws + WS_XIN) + (size_t)(row0 + q) * 1024) + F.lane;
#pragma unroll
        for (int j = 0; j < 4; ++j) xo[64 * j] = (u32x2){pk2(v[q][j].x, v[q][j].y), pk2(v[q][j].z, v[q][j].w)}; }
    const float* wg = (const float*)(F.ws + WS_WG) + (size_t)l * 16 * 1024;
    float mine[RG]; const int gi = F.lane & 15;
#pragma unroll
    for (int q = 0; q < RG; ++q) mine[q] = 0.f;
    f32x4 wc[4];
#pragma unroll
    for (int j = 0; j < 4; ++j) wc[j] = *((const f32x4*)wg + F.lane + 64 * j);
#pragma unroll 1
    for (int g = 0; g < 16; ++g) { f32x4 wn[4]; const int gn = g + 1 < 16 ? g + 1 : g;
#pragma unroll
        for (int j = 0; j < 4; ++j) wn[j] = *((const f32x4*)(wg + gn * 1024) + F.lane + 64 * j);
#pragma unroll
        for (int q = 0; q < RG; ++q) { float p = 0.f;
#pragma unroll
            for (int j = 0; j < 4; ++j) p += v[q][j].x * wc[j].x + v[q][j].y * wc[j].y + v[q][j].z * wc[j].z + v[q][j].w * wc[j].w;
            const float t = wave_sum(p); mine[q] = (gi == g) ? t : mine[q]; }
#pragma unroll
        for (int j = 0; j < 4; ++j) wc[j] = wn[j]; }
    const int ty = gi >> 2, hh = gi & 3, li = l >> 1;
#pragma unroll
    for (int q = 0; q < RG; ++q) { float o;
        if (!(l & 1)) {
            if (ty < 2) o = -expf(GIN(I_EVALOG)[(li * 2 + ty) * 4 + hh]) * softplus_f(mine[q] + GIN(I_EVDTB)[(li * 2 + ty) * 4 + hh]);
            else o = sigmoid_f(mine[q]);
        } else {
            const int d = ty & 1, k = ty >> 1; const float gb = GIN(I_ODGB)[((li * 2 + d) * 2 + k) * 4 + hh];
            o = k ? -softplus_f(-(mine[q] + gb)) : mine[q] + gb;
        }
        if (F.lane < 16) ((float*)(F.ws + WS_GATES))[(size_t)(row0 + q) * 16 + gi] = o; }
}

template <int RG> DEV void xg0_group(const Frame& F, int r) {
        f32x4 v[RG][4];
#pragma unroll
        for (int q = 0; q < RG; ++q) { const f32x4* hr = (const f32x4*)HROW(F, 0, r + q) + F.lane;
#pragma unroll
            for (int j = 0; j < 4; ++j) v[q][j] = hr[64 * j]; }
        xg_rows<RG>(F, 0, r, v);
    }
DEV void phase_xg0(const Frame& F0) {
    const Frame F = refresh(F0);
    ROW_GROUPS(MROWS, xg0_group<4>(F, r), xg0_group<2>(F, r));
}

template <int RG> DEV void prep_group(const Frame& F, int l, int r) {

    const int odd = l & 1, li = l >> 1; const int nin = odd ? NIN_O : NIN_E, nseg = odd ? 2 : 3, qld = odd ? 1024 : 1536;
    const bf16_t* P = (const bf16_t*)(F.ws + WS_P); bf16_t* Q = (bf16_t*)(F.ws + WS_QKV);
    const float* cw = odd ? GIN(I_ODCONV) + (size_t)li * 9 * 1024 : GIN(I_EVCONV) + (size_t)li * 9 * 1536; const int cch = odd ? 1024 : 1536;
    {
        int b, s; row_bs(r, b, s); const bool lat = s >= CTX; const int rr = lat ? (s - CTX) >> 6 : 0, cc = lat ? (s - CTX) & 63 : s;
        const int ncol = lat ? 64 : CTX;
        for (int seg = 0; seg < nseg; ++seg) {
            const int ch0 = seg * 512 + F.lane * 8; float a[RG][8];
#pragma unroll
            for (int q = 0; q < RG; ++q)
#pragma unroll
                for (int i = 0; i < 8; ++i) a[q][i] = 0.f;
#pragma unroll
            for (int kh = 0; kh < 3; ++kh) {
                const int r2 = rr + kh - 1; const bool rok = lat ? (r2 >= 0 && r2 < SEQ / 64) : (kh == 1); const int r2c = rok ? r2 : rr;
                f32x4 w0[3], w1[3];
#pragma unroll
                for (int kw = 0; kw < 3; ++kw) { w0[kw] = *(const f32x4*)(cw + (kh * 3 + kw) * cch + ch0); w1[kw] = *(const f32x4*)(cw + (kh * 3 + kw) * cch + ch0 + 4); }
                const int rowbase = lat ? b * SEQ + r2c * 64 : LATR + b * CTX;
                u32x4 pv[RG + 2];
#pragma unroll
                for (int dc = 0; dc < RG + 2; ++dc) { const int c2 = cc - 1 + dc; const bool ok = rok && c2 >= 0 && c2 < ncol; const int c2c = ok ? c2 : cc;
                    const u32x4 t4 = *(const u32x4*)(P + (size_t)(rowbase + c2c) * nin + ch0); pv[dc] = ok ? t4 : (u32x4){0u, 0u, 0u, 0u}; }
#pragma unroll
                for (int dc = 0; dc < RG + 2; ++dc) {
                    const float x0 = bflo(pv[dc].x), x1 = bfhi(pv[dc].x), x2 = bflo(pv[dc].y), x3 = bfhi(pv[dc].y), x4 = bflo(pv[dc].z), x5 = bfhi(pv[dc].z), x6 = bflo(pv[dc].w), x7 = bfhi(pv[dc].w);
#pragma unroll
                    for (int q = 0; q < RG; ++q) { const int kw = dc - q;
                        if (kw >= 0 && kw <= 2) { a[q][0] += x0 * w0[kw].x; a[q][1] += x1 * w0[kw].y; a[q][2] += x2 * w0[kw].z; a[q][3] += x3 * w0[kw].w;
                            a[q][4] += x4 * w1[kw].x; a[q][5] += x5 * w1[kw].y; a[q][6] += x6 * w1[kw].z; a[q][7] += x7 * w1[kw].w; } } }
            }
#pragma unroll
            for (int q = 0; q < RG; ++q) {
                float ss = 0.f;
#pragma unroll
                for (int i = 0; i < 8; ++i) { a[q][i] = fast_silu(a[q][i]); ss += a[q][i] * a[q][i]; }
                float sc = 1.0f;
                if (!odd) { if (seg < 2) { ss = group_sum<16>(ss); sc = 1.0f / sqrtf(ss + 1e-6f); if (seg == 0) sc *= HD_SCALE; } }
                else if (seg == 1) sc = HD_SCALE;
                u32x4 o; o.x = pk2(a[q][0] * sc, a[q][1] * sc); o.y = pk2(a[q][2] * sc, a[q][3] * sc); o.z = pk2(a[q][4] * sc, a[q][5] * sc); o.w = pk2(a[q][6] * sc, a[q][7] * sc);
                *(u32x4*)(Q + (size_t)(r + q) * qld + ch0) = o;
            }
        }
    }
}
DEV void phase_prep(const Frame& F0, int l) {
    const Frame F = refresh(F0);
    const int odd = l & 1;
    ROW_GROUPS(MROWS, prep_group<4>(F, l, r), prep_group<2>(F, l, r));

    if (odd) {
        const float* GT = (const float*)(F.ws + WS_GATES); float* MC = (float*)(F.ws + WS_MCH);
        for (int c = F.gw; c < B_ * 4 * 2; c += F.NGW) { const int d = c & 1, hh = (c >> 1) & 3, b = c >> 3; float m = 0.f;
            for (int n = 0; n < NCH; ++n) { const int row = tok_row(b, d, n * 64 + F.lane);
                const float lin = GT[(size_t)row * 16 + d * 4 + hh], lf = GT[(size_t)row * 16 + 8 + d * 4 + hh];
                const float bc = wave_scan_add(lf);
                const float bend = bcast_lane_f(bc, 63); const float amax = wave_max(bend - bc + lin);
                if (F.lane == 0) MC[(size_t)c * NCH + n] = m;
                m = fmaxf(bend + m, amax); }
        }
    }
}

DEV int swz256(int r, int k) { return r * 256 + 16 * (k ^ (r & 15)); }
DEV int swz128(int r, int k) { return r * 128 + 16 * (k ^ ((r >> 1) & 7)); }
constexpr int CL_IMG = 90112;
struct ClProb { int n, d, hh, b, kind, qld, vld; const bf16_t *qsrc, *ksrc, *vsrc; float kscale; };
DEV ClProb cl_decode(const Frame& F, int p, int odd, int nhh) {
    ClProb c; c.n = p % NCH; c.d = (p / NCH) & 1; c.hh = (p / (2 * NCH)) % nhh; c.b = p / (2 * NCH * nhh); c.kind = odd ? 2 : (c.hh < 4 ? 0 : 1); c.kscale = 1.0f;
    const bf16_t* P = (const bf16_t*)(F.ws + WS_P); const bf16_t* Q = (const bf16_t*)(F.ws + WS_QKV);
    if (c.kind == 0) { c.qsrc = Q + c.hh * 128; c.ksrc = Q + 512 + c.hh * 128; c.vsrc = Q + 1024 + c.hh * 128; c.qld = 1536; c.vld = 1536; }
    else if (c.kind == 1) { c.qsrc = P + 2048 + (c.hh - 4) * 128; c.ksrc = P + 2560 + (c.hh - 4) * 128; c.vsrc = P + 3072 + (c.hh - 4) * 128; c.qld = NIN_E; c.vld = NIN_E; c.kscale = HD_SCALE; }
    else { c.qsrc = Q + c.hh * 128; c.ksrc = Q + 512 + c.hh * 128; c.vsrc = P + 1024 + c.hh * 128; c.qld = 1024; c.vld = NIN_O; }
    return c;
}
DEV void cl_dma(const Frame& F, const ClProb c) {
    int ln = F.lane; LAUNDER(ln);
    const int r0 = tok_row(c.b, c.d, c.n * 64), sg = c.d ? -1 : 1; const int per = c.kind == 0 ? 6 : 4;
#pragma unroll
    for (int i = 0; i < 6; ++i) if (i < per) { const int ch = F.wave * per + i, reg = ch >> 4, cc = ch & 15, r = 4 * cc + (ln >> 4), kk = (ln & 15) ^ (r & 15);
        const bf16_t* src = reg == 0 ? c.qsrc : (reg == 1 ? c.ksrc : c.vsrc); const int ld = reg == 2 ? c.vld : c.qld;
        glds16((const GAS char*)(src + (size_t)(r0 + sg * r) * ld + 8 * kk), F.lds + CL_IMG + reg * 16384 + 1024 * cc); }
}
DEV void seq_s5_item(const Frame& F, int l, int item, int which);
DEV void phase_cl(const Frame& F0, int l) {
    const Frame F = refresh(F0);
    const int odd = l & 1; const int nhh = odd ? 4 : 8; const int nprob = B_ * nhh * 2 * NCH;
    if (odd) {
        for (int it = F.bid; it < B_ * 2 * 32; it += F.G) { seq_s5_item(F, l, it, 0); __syncthreads(); }
    }
    LAS float* gc = (LAS float*)(F.lds);
    LAS float* bt = (LAS float*)(F.lds + 256);
    LAS float* qs = (LAS float*)(F.lds + 768);
    LAS float* ks = (LAS float*)(F.lds + 1024);
    LAS float* mt = (LAS float*)(F.lds + 1280);
    LAS float* rsp = (LAS float*)(F.lds + 2048);
    LAS float* Am = (LAS float*)(F.lds + 4096);
    LAS bf16_t* An = (LAS bf16_t*)(F.lds + 20480);
    LAS bf16_t* XT = (LAS bf16_t*)(F.lds + 30720);
    LAS float* Rb = (LAS float*)(F.lds + 69632 + F.wave * 2048);
    LAS float* ksp = (LAS float*)(F.lds + 86016);
    LAS unsigned char* IQ = F.lds + CL_IMG; LAS unsigned char* IK = IQ + 16384; LAS unsigned char* IV = IQ + 32768;
    const float* GT = (const float*)(F.ws + WS_GATES);
    float gq = 0.f, bq = 0.f, mq = 0.f;
#define CL_GATES(pp) do { const ClProb cn = cl_decode(F, (pp), odd, nhh); const int rown = tok_row(cn.b, cn.d, cn.n * 64 + F.lane); \
        if (cn.kind == 0) { gq = GT[(size_t)rown * 16 + cn.d * 4 + cn.hh]; bq = GT[(size_t)rown * 16 + 8 + cn.d * 4 + cn.hh]; } \
        else if (cn.kind == 2) { bq = GT[(size_t)rown * 16 + cn.d * 4 + cn.hh]; gq = GT[(size_t)rown * 16 + 8 + cn.d * 4 + cn.hh]; \
            mq = ((const float*)(F.ws + WS_MCH))[(size_t)((cn.b * 4 + cn.hh) * 2 + cn.d) * NCH + cn.n]; } } while (0)
    if (F.bid < nprob) { cl_dma(F, cl_decode(F, F.bid, odd, nhh)); if (F.wave == 0) CL_GATES(F.bid); }
    for (int p = F.bid; p < nprob; p += F.G) {
        int lz = F.lane; LAUNDER(lz); const int h = lz >> 5, l31 = lz & 31;
        const ClProb c = cl_decode(F, p, odd, nhh); const int n = c.n, d = c.d, hh = c.hh, b = c.b, kind = c.kind; const float kscale = c.kscale;
        float* CS = (float*)(F.ws + WS_CLS) + (size_t)p * 512;
        if (F.wave == 0) {
            const int i = F.lane;
            float g = gq, be = bq;
            if (kind == 1) { g = log1pf(-exp2f(-(5.0f + 2.0f * (float)(hh - 4) + (float)d))); be = 0.f; }
            const float cum = wave_scan_add(g);
            const float gend = bcast_lane_f(cum, 63);
            gc[i] = cum; bt[i] = be;
            if (kind < 2) { qs[i] = expf(cum); ks[i] = expf(gend - cum) * kscale; if (i == 0) CS[0] = expf(gend); }
            else {
                const float mprev = mq;
                const float a = gend - cum + be; const float amax = wave_max(a); const float mnew = fmaxf(gend + mprev, amax);
                ks[i] = expf(a - mnew);
                const float pm = wave_scan_max(be - cum);
                const float mti = cum + fmaxf(mprev, pm); mt[i] = mti; qs[i] = expf(cum + mprev - mti);
                CS[128 + i] = expf(-mti);
                if (i == 0) CS[0] = expf(gend + mprev - mnew);
            }
        }
        WAIT_VM(0);
        __syncthreads();
        {
            const int w4 = F.wave & 3, mt_ = w4 >> 1, nt_ = w4 & 1; const bool doY = F.wave >= 4;
            if (!doY || kind == 0) {
                const int rj = 32 * mt_ + l31, ri = 32 * nt_ + l31; LAS unsigned char* IB = doY ? IK : IQ;
                f32x16 acc;
#pragma unroll
                for (int r = 0; r < 16; ++r) acc[r] = 0.f;
                bf16x8 af[8], bfr[8];
#pragma unroll
                for (int s = 0; s < 8; ++s) { af[s] = *(const LAS bf16x8*)(IK + swz256(rj, 2 * s + h)); bfr[s] = *(const LAS bf16x8*)(IB + swz256(ri, 2 * s + h)); }
#pragma unroll
                for (int s = 0; s < 8; ++s) acc = mfma32(af[s], bfr[s], acc);
                const int i = ri; const float gi = gc[i];
                if (!doY) {
                    bf16_t* AQ = (bf16_t*)(F.ws + WS_CLA) + (size_t)p * 4096 + (size_t)i * 64; float rsum = 0.f; const float mti = kind == 2 ? mt[i] : 0.f;
#pragma unroll
                    for (int g4 = 0; g4 < 4; ++g4) { float v[4];
#pragma unroll
                        for (int r = 0; r < 4; ++r) { const int j = 32 * mt_ + 8 * g4 + 4 * h + r; float e;
                            if (kind < 2) e = fast_exp(fminf(gi - gc[j], 0.f)); else e = fast_exp(gi - gc[j] + bt[j] - mti);
                            v[r] = (i >= j) ? acc[4 * g4 + r] * kscale * e : 0.f; rsum += v[r]; }
                        *(u32x2*)(AQ + 32 * mt_ + 8 * g4 + 4 * h) = (u32x2){pk2_sw(v[0], v[1]), pk2_sw(v[2], v[3])}; }
                    if (kind == 2) rsp[i * 4 + mt_ * 2 + h] = rsum;
                } else {
                    const float bi = bt[i];
#pragma unroll
                    for (int r = 0; r < 16; ++r) { const int j = 32 * mt_ + 8 * (r >> 2) + 4 * h + (r & 3);
                        const float av = (i > j) ? bi * acc[r] * fast_exp(fminf(gi - gc[j], 0.f)) : 0.f;
                        Am[i * 64 + j] = av; An[i * 72 + j] = (bf16_t)f2bf_sw(-av); }
                }
            }
        }
        __syncthreads();
        int lz2 = F.lane; LAUNDER(lz2); const int l15 = lz2 & 15, kg = lz2 >> 4; const bool isw = F.wave >= 4;
        float rhsv[4][2][4];
        {
            const int tz = F.wave * 64 + lz2; const int cq = tz & 127, q4 = tz >> 7; bf16_t* QD = (bf16_t*)(F.ws + WS_CLQ) + (size_t)p * 8192 + cq;
            for (int i = 16 * q4; i < 16 * q4 + 16; ++i) QD[i * 128] = (bf16_t)f2bf_sw(bf2f(*(const LAS bf16_t*)(IQ + swz256(i, cq >> 3) + 2 * (cq & 7))) * qs[i]);
            bf16_t* KT = (bf16_t*)(F.ws + WS_CLK) + (size_t)p * 8192 + (size_t)cq * 64;
            float ksum = 0.f;
            for (int j8 = 2 * q4; j8 < 2 * q4 + 2; ++j8) { float v[8];
#pragma unroll
                for (int r = 0; r < 8; ++r) { const int j = 8 * j8 + r; v[r] = bf2f(*(const LAS bf16_t*)(IK + swz256(j, cq >> 3) + 2 * (cq & 7))) * ks[j]; ksum += v[r]; }
                *(u32x4*)(KT + 8 * j8) = (u32x4){pk2_sw(v[0], v[1]), pk2_sw(v[2], v[3]), pk2_sw(v[4], v[5]), pk2_sw(v[6], v[7])}; }
            ksp[cq * 4 + q4] = ksum;
            if (kind == 2 && tz < 64) CS[64 + tz] = (rsp[tz * 4] + rsp[tz * 4 + 1]) + (rsp[tz * 4 + 2] + rsp[tz * 4 + 3]);
            if (kind == 0) { LAS unsigned char* IS = isw ? IK : IV;
#pragma unroll
                for (int bb = 0; bb < 4; ++bb)
#pragma unroll
                    for (int nt2 = 0; nt2 < 2; ++nt2)
#pragma unroll
                        for (int r = 0; r < 4; ++r) { const int i = 16 * bb + 4 * kg + r, cc = (32 * F.wave + 16 * nt2 + l15) & 127;
                            rhsv[bb][nt2][r] = bt[i] * bf2f(*(const LAS bf16_t*)(IS + swz256(i, cc >> 3) + 2 * (cc & 7))) * (isw ? qs[i] : 1.0f); } }
        }
        __syncthreads();
        if (p + F.G < nprob) { cl_dma(F, cl_decode(F, p + F.G, odd, nhh)); if (F.wave == 0) CL_GATES(p + F.G); }
        if (kind == 2 && F.tid < 128) CS[256 + F.tid] = (ksp[F.tid * 4] + ksp[F.tid * 4 + 1]) + (ksp[F.tid * 4 + 2] + ksp[F.tid * 4 + 3]);
        if (kind == 0) {
            const int pg = ((b * 4 + hh) * 2 + d) * NCH + n;
            bf16_t* U = (bf16_t*)(F.ws + WS_CLU) + (size_t)pg * 8192; bf16_t* W = (bf16_t*)(F.ws + WS_CLW) + (size_t)p * 8192;
#pragma unroll
            for (int bb = 0; bb < 4; ++bb) {
#pragma unroll
                for (int nt2 = 0; nt2 < 2; ++nt2) {
                    const int cidx = 32 * F.wave + 16 * nt2 + l15; f32x4 acc;
#pragma unroll
                    for (int r = 0; r < 4; ++r) acc[r] = rhsv[bb][nt2][r];
                    for (int k2 = 0; k2 < 2; ++k2) if (32 * k2 < 16 * bb) {
                        const bool in = 32 * k2 + 8 * kg + 8 <= 16 * bb;
                        bf16x8 a = *(const LAS bf16x8*)(An + (16 * bb + l15) * 72 + 32 * k2 + 8 * kg); if (!in) a = (bf16x8){0, 0, 0, 0, 0, 0, 0, 0};
                        const bf16x8 xb = *(const LAS bf16x8*)(XT + cidx * 72 + 32 * k2 + 8 * kg);
                        acc = mfma16(a, in ? xb : (bf16x8){0, 0, 0, 0, 0, 0, 0, 0}, acc); }
#pragma unroll
                    for (int r = 0; r < 4; ++r) Rb[(4 * kg + r) * 32 + 16 * nt2 + l15] = acc[r];
                }
                WAVE_LDS_SYNC();
                if (F.lane < 32) {
                    const int cidx = 32 * F.wave + F.lane; float x[16];
#pragma unroll
                    for (int i = 0; i < 16; ++i) { float r = Rb[i * 32 + F.lane];
#pragma unroll
                        for (int j = 0; j < i; ++j) r -= Am[(16 * bb + i) * 64 + 16 * bb + j] * x[j];
                        x[i] = r; }
                    if (!isw) {
#pragma unroll
                        for (int i = 0; i < 16; ++i) U[(16 * bb + i) * 128 + cidx] = (bf16_t)f2bf_sw(x[i]); }
                    else {
#pragma unroll
                        for (int i = 0; i < 16; ++i) W[(16 * bb + i) * 128 + (cidx - 128)] = (bf16_t)f2bf_sw(-x[i]); }
                    *(LAS u32x4*)(XT + cidx * 72 + 16 * bb) = (u32x4){pk2_sw(x[0], x[1]), pk2_sw(x[2], x[3]), pk2_sw(x[4], x[5]), pk2_sw(x[6], x[7])};
                    *(LAS u32x4*)(XT + cidx * 72 + 16 * bb + 8) = (u32x4){pk2_sw(x[8], x[9]), pk2_sw(x[10], x[11]), pk2_sw(x[12], x[13]), pk2_sw(x[14], x[15])};
                }
                WAVE_LDS_SYNC();
            }
        }
    }
    WAIT_VM(0);
    __syncthreads();
}

#define LDS_BARRIER() do { WAIT_LGKM(0); S_BARRIER(); COMPILER_FENCE(); } while (0)
constexpr int SQ_W = 0, SQ_Q = 16384, SQ_K = 32768, SQ_A = 49152, SQ_U = 57344, SQ_C = 65536, SQ_STAGE = 67584;
constexpr int SQ_SB = 2 * SQ_STAGE, SQ_VN = SQ_SB + 8704, SQ_NV = SQ_VN + 4608, SQ_DEN = SQ_NV + 512;
static_assert(SQ_DEN + 256 <= LDS_MISC, "SEQ LDS map");
struct SeqCtx { int kind, b, hh, d, sl, chain, vld; const GAS bf16_t* vsrc; int probe; };
template <int KIND>
DEV void seq_dma(const Frame& F, const SeqCtx& C, int n, LAS unsigned char* img) {
    const int p = C.chain * NCH + n, w = F.wave; int ln = F.lane; LAUNDER(ln);
    if (w < 2) {
        if (KIND == 0) { const GAS char* g = (const GAS char*)(F.ws + WS_CLW) + (size_t)p * 16384; LAUNDER_S(g);
#pragma unroll
            for (int i = 0; i < 8; ++i) { const int r = 4 * (8 * w + i) + (ln >> 4), pp = ln & 15; glds16(g + r * 256 + 16 * (pp ^ (r & 15)), img + SQ_W + 1024 * (8 * w + i)); } }
    } else if (w < 4) {
        const GAS char* g = (const GAS char*)(F.ws + WS_CLQ) + (size_t)p * 16384; LAUNDER_S(g);
#pragma unroll
        for (int i = 0; i < 8; ++i) { const int c = 8 * (w - 2) + i, r = 4 * c + (ln >> 4), pp = ln & 15; glds16(g + r * 256 + 16 * (pp ^ (r & 15)), img + SQ_Q + 1024 * c); }
    } else if (w < 6) {
        const GAS char* g = (const GAS char*)(F.ws + WS_CLK) + (size_t)p * 16384; LAUNDER_S(g);
#pragma unroll
        for (int i = 0; i < 8; ++i) { const int c = 8 * (w - 4) + i, r = 8 * c + (ln >> 3), pp = ln & 7; glds16(g + r * 128 + 16 * (pp ^ ((r >> 1) & 7)), img + SQ_K + 1024 * c); }
    } else if (w == 6) {
        const GAS char* g = (const GAS char*)(F.ws + WS_CLA) + (size_t)p * 8192; LAUNDER_S(g);
#pragma unroll
        for (int i = 0; i < 8; ++i) { const int r = 8 * i + (ln >> 3), pp = ln & 7; glds16(g + r * 128 + 16 * (pp ^ ((r >> 1) & 7)), img + SQ_A + 1024 * i); }
    } else {
        if (KIND == 0) { const int pg = ((C.b * 4 + C.hh) * 2 + C.d) * NCH + n; const GAS char* g = (const GAS char*)(F.ws + WS_CLU) + (size_t)pg * 16384 + 64 * C.sl; LAUNDER_S(g);
#pragma unroll
            for (int i = 0; i < 4; ++i) { const int r = 16 * i + (ln >> 2); glds16(g + r * 256 + 16 * (ln & 3), img + SQ_U + 1024 * i); }
        } else { const int r0 = tok_row(C.b, C.d, n * 64); const long st = C.d ? -(long)C.vld * 2 : (long)C.vld * 2;
            const GAS char* g = (const GAS char*)C.vsrc + (long)r0 * C.vld * 2 + 64 * C.sl; LAUNDER_S(g);
#pragma unroll
            for (int i = 0; i < 4; ++i) { const int r = 16 * i + (ln >> 2); glds16(g + (long)r * st + 16 * (ln & 3), img + SQ_U + 1024 * i); }
        }
        const GAS char* cs = (const GAS char*)(F.ws + WS_CLS) + (size_t)p * 2048; LAUNDER_S(cs);
        glds16(cs + 16 * ln, img + SQ_C);
        if (KIND == 2) glds16(cs + 1024 + 16 * ln, img + SQ_C + 1024);
    }
}
#define SEQ_WAIT_DMA(younger) do { if ((younger) == 16) WAIT_VM(16); else WAIT_VM(0); } while (0)
template <int KIND>
DEV void seq_step(const Frame& F, const SeqCtx& C, int n, f32x16& acc, LAS unsigned char* lds) {
    int lz = F.lane; LAUNDER(lz); const int h = lz >> 5, l31 = lz & 31;
    LAS unsigned char* img = lds + (n & 1) * SQ_STAGE; LAS unsigned char* nimg = lds + ((n + 1) & 1) * SQ_STAGE;
    LAS bf16_t* Sb = (LAS bf16_t*)(lds + SQ_SB); LAS bf16_t* Vn = (LAS bf16_t*)(lds + SQ_VN); LAS float* nvec = (LAS float*)(lds + SQ_NV); LAS float* den = (LAS float*)(lds + SQ_DEN);
    const LAS float* CS = (const LAS float*)(img + SQ_C);
    if (C.probe != 3) seq_dma<KIND>(F, C, C.probe == 2 ? 0 : (n + 1 < NCH ? n + 1 : NCH - 1), nimg);
    if (F.wave < 2) {
        const int mt_ = F.wave;
#pragma unroll
        for (int r = 0; r < 16; ++r) acc[r] = bf2f(*(const LAS bf16_t*)(img + SQ_U + (32 * mt_ + 8 * (r >> 2) + 4 * h + (r & 3)) * 64 + 2 * l31));
        if (KIND == 0) {
            bf16x8 sb[8], wf[8]; const int rr = 32 * mt_ + l31;
#pragma unroll
            for (int s = 0; s < 8; ++s) { sb[s] = *(const LAS bf16x8*)(Sb + l31 * 136 + 16 * s + 8 * h); wf[s] = *(const LAS bf16x8*)(img + SQ_W + swz256(rr, 2 * s + h)); }
#pragma unroll
            for (int s = 0; s < 8; ++s) acc = mfma32(wf[s], sb[s], acc);
        }
#pragma unroll
        for (int g4 = 0; g4 < 4; ++g4) *(LAS u32x2*)(Vn + l31 * 72 + 32 * mt_ + 8 * g4 + 4 * h) = (u32x2){pk2(acc[4 * g4], acc[4 * g4 + 1]), pk2(acc[4 * g4 + 2], acc[4 * g4 + 3])};
    } else if (F.wave < 4) {
        const int rr = 32 * (F.wave - 2) + l31;
#pragma unroll
        for (int r = 0; r < 16; ++r) acc[r] = 0.f;
        bf16x8 sb[8], qf[8];
#pragma unroll
        for (int s = 0; s < 8; ++s) { sb[s] = *(const LAS bf16x8*)(Sb + l31 * 136 + 16 * s + 8 * h); qf[s] = *(const LAS bf16x8*)(img + SQ_Q + swz256(rr, 2 * s + h)); }
#pragma unroll
        for (int s = 0; s < 8; ++s) acc = mfma32(qf[s], sb[s], acc);
    } else if (KIND == 2) {
        const int t = F.tid - 256, i = t >> 2, q = t & 3; float s = 0.f;
#pragma unroll
        for (int c8 = 0; c8 < 4; ++c8) { const u32x4 w = *(const LAS u32x4*)(img + SQ_Q + swz256(i, 4 * q + c8)); const LAS float* nv = nvec + 32 * q + 8 * c8;
            s += bflo(w.x) * nv[0] + bfhi(w.x) * nv[1] + bflo(w.y) * nv[2] + bfhi(w.y) * nv[3] + bflo(w.z) * nv[4] + bfhi(w.z) * nv[5] + bflo(w.w) * nv[6] + bfhi(w.w) * nv[7]; }
        s = group_sum<4>(s);
        if (q == 0) den[i] = fmaxf(fabsf(CS[64 + i] + s), CS[128 + i]);
    }
    LDS_BARRIER();
    if (F.wave >= 2 && F.wave < 4) {
        const int mt_ = F.wave - 2, rr = 32 * mt_ + l31;
        bf16x8 vb[4], af[4];
#pragma unroll
        for (int s = 0; s < 4; ++s) { vb[s] = *(const LAS bf16x8*)(Vn + l31 * 72 + 16 * s + 8 * h); af[s] = *(const LAS bf16x8*)(img + SQ_A + swz128(rr, 2 * s + h)); }
#pragma unroll
        for (int s = 0; s < 4; ++s) acc = mfma32(af[s], vb[s], acc);
        const int r0 = tok_row(C.b, C.d, n * 64); const long st = C.d ? -2048l : 2048l;
        GAS char* Ob = (GAS char*)(F.ws + WS_O) + ((size_t)C.d * MROWS + r0) * 2048 + (long)(32 * mt_) * st; LAUNDER_S(Ob); const long lo = (long)(4 * h) * st + (long)((C.hh * 128 + 32 * C.sl + l31) * 2);
#pragma unroll
        for (int r = 0; r < 16; ++r) { const int i = 32 * mt_ + 8 * (r >> 2) + 4 * h + (r & 3); float v = acc[r];
            if (KIND == 2) v = v / den[i];
            if (!C.probe) *(GAS bf16_t*)(Ob + (long)(8 * (r >> 2) + (r & 3)) * st + lo) = (bf16_t)f2bf(v); }
        SEQ_WAIT_DMA(16);
    } else if (F.wave >= 4) {
        const int kb = F.wave - 4, rr = 32 * kb + l31; const float ge = CS[0];
        bf16x8 vb[4], kf[4];
#pragma unroll
        for (int s = 0; s < 4; ++s) { vb[s] = *(const LAS bf16x8*)(Vn + l31 * 72 + 16 * s + 8 * h); kf[s] = *(const LAS bf16x8*)(img + SQ_K + swz128(rr, 2 * s + h)); }
#pragma unroll
        for (int r = 0; r < 16; ++r) acc[r] *= ge;
#pragma unroll
        for (int s = 0; s < 4; ++s) acc = mfma32(kf[s], vb[s], acc);
#pragma unroll
        for (int g4 = 0; g4 < 4; ++g4) *(LAS u32x2*)(Sb + l31 * 136 + 32 * kb + 8 * g4 + 4 * h) = (u32x2){pk2(acc[4 * g4], acc[4 * g4 + 1]), pk2(acc[4 * g4 + 2], acc[4 * g4 + 3])};
        if (KIND == 2 && F.tid < 256 + 128) { const int dd = F.tid - 256; nvec[dd] = ge * nvec[dd] + CS[256 + dd]; }
        SEQ_WAIT_DMA(0);
    } else SEQ_WAIT_DMA(0);
    LDS_BARRIER();
}
template <int KIND>
DEV void seq_kind_loop(const Frame& F, const SeqCtx& C, LAS unsigned char* lds) {
    f32x16 acc;
#pragma unroll
    for (int r = 0; r < 16; ++r) acc[r] = 0.f;
    seq_dma<KIND>(F, C, 0, lds);
    WAIT_VM(0);
    LDS_BARRIER();
    for (int n = 0; n < NCH; ++n) seq_step<KIND>(F, C, n, acc, lds);
}
DEV void seq_linear_item(const Frame& F, int l, int item, int probe = 0) {
    const int odd = l & 1, nhh = odd ? 4 : 8;
    SeqCtx C; C.probe = probe; C.sl = item & 3; C.chain = item >> 2; C.d = C.chain & 1; C.hh = (C.chain >> 1) % nhh; C.b = C.chain / (2 * nhh);
    C.kind = odd ? 2 : (C.hh < 4 ? 0 : 1);
    const GAS bf16_t* P = (const GAS bf16_t*)(F.ws + WS_P); const GAS bf16_t* Q = (const GAS bf16_t*)(F.ws + WS_QKV);
    if (C.kind == 0) { C.vsrc = Q + 1024 + C.hh * 128; C.vld = 1536; } else if (C.kind == 1) { C.vsrc = P + 3072 + (C.hh - 4) * 128; C.vld = NIN_E; } else { C.vsrc = P + 1024 + C.hh * 128; C.vld = NIN_O; }
    for (int i = F.tid; i < 32 * 136 / 2; i += NTHREADS) ((LAS unsigned*)(F.lds + SQ_SB))[i] = 0u;
    if (F.tid < 128) ((LAS float*)(F.lds + SQ_NV))[F.tid] = 0.f;
    __syncthreads();
    if (C.kind == 0) seq_kind_loop<0>(F, C, F.lds); else if (C.kind == 1) seq_kind_loop<1>(F, C, F.lds); else seq_kind_loop<2>(F, C, F.lds);
    WAIT_VM(0);
}

DEV void seq_s5_item(const Frame& F, int l, int item, int which) {
    const int o = l >> 1; const int g = item & 31, d = (item >> 5) & 1, b = item >> 6;
    LAS float* El = (LAS float*)(F.lds);
    LAS unsigned char* wl = F.lds + 36864 + F.wave * 14336;
    LAS float* scr = (LAS float*)wl; LAS bf16_t* hb = (LAS bf16_t*)(wl + 10240);
    const bf16_t* P = (const bf16_t*)(F.ws + WS_P);
    const float* Ab = (const float*)(F.ws + WS_S5A) + (size_t)((o * 2 + d) * 32 + g) * 128;
    const bf16_t* Bb = (const bf16_t*)(F.ws + WS_S5B) + (size_t)((o * 2 + d) * 32 + g) * 128 * 16;
    const bf16_t* Cm = (const bf16_t*)(F.ws + WS_S5C) + (size_t)(o * 32 + g) * 16 * 128;
    const int l15 = F.lane & 15, kg = F.lane >> 4;
    const float ar = Ab[F.lane], ai = Ab[64 + F.lane];
    bf16x8 bB[8], cB[4]; const bf16x8 zero8 = (bf16x8){0, 0, 0, 0, 0, 0, 0, 0};
#pragma unroll
    for (int ct = 0; ct < 8; ++ct) bB[ct] = kg < 2 ? *(const bf16x8*)(Bb + (size_t)(16 * ct + l15) * 16 + 8 * kg) : zero8;
#pragma unroll
    for (int s = 0; s < 4; ++s) cB[s] = *(const bf16x8*)(Cm + (size_t)l15 * 128 + 32 * s + 8 * kg);
    bf16_t* Obase = (bf16_t*)(F.ws + WS_O) + (size_t)d * MROWS * 1024 + 512 + 16 * g;
    float* SE = (float*)(F.ws + WS_S5E) + (size_t)item * NCH * 128;
    if (which == 1) { for (int i = F.tid; i < NCH * 128; i += NTHREADS) El[i] = SE[i]; __syncthreads(); }
    for (int pass = which; pass < which + 1; ++pass) {
        bf16x8 an[4];
#pragma unroll
        for (int st = 0; st < 4; ++st) an[st] = kg < 2 ? *(const bf16x8*)(P + (size_t)tok_row(b, d, F.wave * 64 + 16 * st + l15) * NIN_O + 2048 + 16 * g + 8 * kg) : zero8;
        for (int n = F.wave; n < NCH; n += NWAVES) {
            float hr = 0.f, hi = 0.f;
            if (pass) { hr = El[n * 128 + F.lane]; hi = El[n * 128 + 64 + F.lane]; }
            bf16x8 ac[4];
#pragma unroll
            for (int st = 0; st < 4; ++st) ac[st] = an[st];
            { const int nn = n + NWAVES < NCH ? n + NWAVES : n;
#pragma unroll
              for (int st = 0; st < 4; ++st) an[st] = kg < 2 ? *(const bf16x8*)(P + (size_t)tok_row(b, d, nn * 64 + 16 * st + l15) * NIN_O + 2048 + 16 * g + 8 * kg) : zero8; }
            const int r0 = tok_row(b, d, n * 64); const int sg = d ? -1 : 1;
#pragma unroll
            for (int st = 0; st < 4; ++st) {
#pragma unroll
                for (int ct = 0; ct < 8; ++ct) { f32x4 acc = (f32x4){0.f, 0.f, 0.f, 0.f}; acc = mfma16(ac[st], bB[ct], acc);
                    *(LAS f32x4*)(scr + (ct >> 2) * 1280 + (16 * (ct & 3) + l15) * 20 + 4 * kg) = acc; }
                WAVE_LDS_SYNC();
                f32x4 br[4], bi[4];
#pragma unroll
                for (int q = 0; q < 4; ++q) { br[q] = *(const LAS f32x4*)(scr + F.lane * 20 + 4 * q); bi[q] = *(const LAS f32x4*)(scr + 1280 + F.lane * 20 + 4 * q); }
#pragma unroll
                for (int t = 0; t < 16; ++t) { const float nr = ar * hr - ai * hi + br[t >> 2][t & 3], ni = ar * hi + ai * hr + bi[t >> 2][t & 3]; hr = nr; hi = ni;
                    if (pass) *(LAS unsigned*)(hb + t * 128 + 2 * F.lane) = pk2(hr, hi); }
                WAVE_LDS_SYNC();
                if (pass) { f32x4 acc = (f32x4){0.f, 0.f, 0.f, 0.f};
#pragma unroll
                    for (int s = 0; s < 4; ++s) { const bf16x8 ha = *(const LAS bf16x8*)(hb + l15 * 128 + 32 * s + 8 * kg); acc = mfma16(ha, cB[s], acc); }
#pragma unroll
                    for (int r = 0; r < 4; ++r) Obase[(size_t)(r0 + sg * (16 * st + 4 * kg + r)) * 1024 + l15] = (bf16_t)f2bf(acc[r]);
                    WAVE_LDS_SYNC(); }
            }
            if (!pass) { El[n * 128 + F.lane] = hr; El[n * 128 + 64 + F.lane] = hi; }
        }
        __syncthreads();
        if (!pass) {
            if (F.wave == 0) { float pr = ar, pi = ai;
#pragma unroll
                for (int q = 0; q < 6; ++q) { const float nr = pr * pr - pi * pi, ni = 2.0f * pr * pi; pr = nr; pi = ni; }
                float hr = 0.f, hi = 0.f;
                for (int n = 0; n < NCH; ++n) { const float er = El[n * 128 + F.lane], ei = El[n * 128 + 64 + F.lane];
                    El[n * 128 + F.lane] = hr; El[n * 128 + 64 + F.lane] = hi;
                    const float nr = pr * hr - pi * hi + er, ni = pr * hi + pi * hr + ei; hr = nr; hi = ni; } }
            __syncthreads();
            for (int i = F.tid; i < NCH * 128; i += NTHREADS) SE[i] = El[i];
        }
    }
}

DEV void phase_seq(const Frame& F0, int l, int mode = 0) {
    const Frame F = refresh(F0);
    const int odd = l & 1; const int nlin = B_ * (odd ? 4 : 8) * 2 * 4; const int ns5 = odd ? B_ * 2 * 32 : 0;
    const int vcu = (F.G % 8 == 0) ? (F.bid % 8) * (F.G / 8) + F.bid / 8 : F.bid;
    if (!odd || F.G <= nlin) {
        for (int it = vcu; it < nlin + ns5; it += F.G) {
            if (it < nlin) { if (mode != 2) seq_linear_item(F, l, it, mode >= 10 ? mode - 10 : 0); } else if (mode != 1 && mode < 10) seq_s5_item(F, l, it - nlin, 1);
            __syncthreads();
        }
    } else if (vcu < nlin) { if (mode != 2) seq_linear_item(F, l, vcu, mode >= 10 ? mode - 10 : 0); }
    else { for (int it = vcu - nlin; it < ns5; it += F.G - nlin) { if (mode != 1 && mode < 10) seq_s5_item(F, l, it, 1); __syncthreads(); } }
}

DEV void phase_merge(const Frame& F0, int l) {
    const Frame F = refresh(F0);
    const int odd = l & 1, li = l >> 1; const bf16_t* P = (const bf16_t*)(F.ws + WS_P);
    const bf16_t* O0 = (const bf16_t*)(F.ws + WS_O); const bf16_t* O1 = O0 + (size_t)MROWS * 1024;
    bf16_t* MG = (bf16_t*)(F.ws + WS_MERGED);
    const int nrows = (l == DEPTH - 1) ? LATR : MROWS;
    ROW_LOOP(r, nrows) {
        if (!odd) {
            const int c0 = 16 * F.lane; float v[16];
#pragma unroll
            for (int q = 0; q < 4; ++q) { const u32x2 a = *(const u32x2*)(O0 + (size_t)r * 1024 + c0 + 4 * q), bq = *(const u32x2*)(O1 + (size_t)r * 1024 + c0 + 4 * q);
                v[4 * q] = bflo(a.x) + bflo(bq.x); v[4 * q + 1] = bfhi(a.x) + bfhi(bq.x); v[4 * q + 2] = bflo(a.y) + bflo(bq.y); v[4 * q + 3] = bfhi(a.y) + bfhi(bq.y); }
            float s = 0.f;
#pragma unroll
            for (int i = 0; i < 16; ++i) s += v[i];
            s = group_sum<8>(s);
            const bool ret = F.lane >= 32; const float mu = ret ? s * (1.0f / 128.0f) : 0.f; float q2 = 0.f;
#pragma unroll
            for (int i = 0; i < 16; ++i) { v[i] -= mu; q2 += v[i] * v[i]; }
            q2 = group_sum<8>(q2);
            const float rstd = 1.0f / sqrtf(q2 * (1.0f / 128.0f) + LN_EPS);
            const bf16_t* zp = P + (size_t)r * NIN_E + (ret ? 3584 + (c0 - 512) : 1536 + c0);
            const float* gp = ret ? GIN(I_EVRETN) + li * 512 + (c0 - 512) : GIN(I_EVGDNN) + li * 128 + (c0 & 127);
            unsigned ow[8]; const u32x4 zq0 = *(const u32x4*)zp, zq1 = *(const u32x4*)(zp + 8); const unsigned zw[8] = {zq0.x, zq0.y, zq0.z, zq0.w, zq1.x, zq1.y, zq1.z, zq1.w};
            f32x4 gq[4];
#pragma unroll
            for (int i = 0; i < 4; ++i) gq[i] = *(const f32x4*)(gp + 4 * i);
#pragma unroll
            for (int i = 0; i < 16; i += 2) { const float z0 = bflo(zw[i >> 1]), z1 = bfhi(zw[i >> 1]); ow[i >> 1] = pk2(v[i] * rstd * gq[i >> 2][i & 3] * fast_silu(z0), v[i + 1] * rstd * gq[i >> 2][(i & 3) + 1] * fast_silu(z1)); }
            u32x4* op = (u32x4*)(MG + (size_t)r * 1024 + c0); op[0] = (u32x4){ow[0], ow[1], ow[2], ow[3]}; op[1] = (u32x4){ow[4], ow[5], ow[6], ow[7]};
        } else {
            const int c0 = 8 * F.lane; float v[8];
#pragma unroll
            for (int q = 0; q < 2; ++q) { const u32x2 a = *(const u32x2*)(O0 + (size_t)r * 1024 + c0 + 4 * q), bq = *(const u32x2*)(O1 + (size_t)r * 1024 + c0 + 4 * q);
                v[4 * q] = bflo(a.x) + bflo(bq.x); v[4 * q + 1] = bfhi(a.x) + bfhi(bq.x); v[4 * q + 2] = bflo(a.y) + bflo(bq.y); v[4 * q + 3] = bfhi(a.y) + bfhi(bq.y); }
            float s = 0.f;
#pragma unroll
            for (int i = 0; i < 8; ++i) s += v[i];
            s = group_sum<16>(s);
            const float mu = s * (1.0f / 128.0f); float q2 = 0.f;
#pragma unroll
            for (int i = 0; i < 8; ++i) { v[i] -= mu; q2 += v[i] * v[i]; }
            q2 = group_sum<16>(q2);
            const float rstd = 1.0f / sqrtf(q2 * (1.0f / 128.0f) + LN_EPS);
            const bf16_t* zp = P + (size_t)r * NIN_O + 1536 + c0; const float* gp = GIN(I_ODMN) + li * 512 + c0;
            unsigned ow[4]; const u32x4 zq = *(const u32x4*)zp; const unsigned zw[4] = {zq.x, zq.y, zq.z, zq.w}; const f32x4 gq0 = *(const f32x4*)gp, gq1 = *(const f32x4*)(gp + 4);
#pragma unroll
            for (int i = 0; i < 8; i += 2) { const f32x4 gq = i < 4 ? gq0 : gq1; ow[i >> 1] = pk2(v[i] * rstd * gq[i & 3] * fast_sigmoid(bflo(zw[i >> 1])), v[i + 1] * rstd * gq[(i & 3) + 1] * fast_sigmoid(bfhi(zw[i >> 1]))); }
            *(u32x4*)(MG + (size_t)r * 1024 + c0) = (u32x4){ow[0], ow[1], ow[2], ow[3]};
            const bf16_t* up = P + (size_t)r * NIN_O + 2048 + c0; const float* dsk = GIN(I_ODDSKIP) + li * 512 + c0;
#pragma unroll
            for (int q = 0; q < 2; ++q) { const u32x2 a = *(const u32x2*)(O0 + (size_t)r * 1024 + 512 + c0 + 4 * q), bq = *(const u32x2*)(O1 + (size_t)r * 1024 + 512 + c0 + 4 * q);
                v[4 * q] = bflo(a.x) + bflo(bq.x); v[4 * q + 1] = bfhi(a.x) + bfhi(bq.x); v[4 * q + 2] = bflo(a.y) + bflo(bq.y); v[4 * q + 3] = bfhi(a.y) + bfhi(bq.y); }
            { const u32x4 uq = *(const u32x4*)up; const unsigned uw[4] = {uq.x, uq.y, uq.z, uq.w}; const f32x4 d0 = *(const f32x4*)dsk, d1 = *(const f32x4*)(dsk + 4);
#pragma unroll
              for (int i = 0; i < 8; i += 2) { const f32x4 dq = i < 4 ? d0 : d1; ow[i >> 1] = pk2(gelu_tanh_f(v[i] + dq[i & 3] * bflo(uw[i >> 1])), gelu_tanh_f(v[i + 1] + dq[(i & 3) + 1] * bfhi(uw[i >> 1]))); } }
            *(u32x4*)((bf16_t*)(F.ws + WS_YS) + (size_t)r * 512 + c0) = (u32x4){ow[0], ow[1], ow[2], ow[3]};
        }
    }
}

template <int RG> DEV void ln_rows(const Frame& F, f32x4 (&t)[RG][4], const float* lg, const float* lb) {
    float mean[RG], rstd[RG];
#pragma unroll
    for (int q = 0; q < RG; ++q) { float sum = 0.f;
#pragma unroll
        for (int j = 0; j < 4; ++j) sum += (t[q][j].x + t[q][j].y) + (t[q][j].z + t[q][j].w);
        mean[q] = wave_sum(sum) * (1.0f / 1024.0f); }
#pragma unroll
    for (int q = 0; q < RG; ++q) { float s2 = 0.f;
#pragma unroll
        for (int j = 0; j < 4; ++j) { t[q][j] = t[q][j] - mean[q]; s2 += (t[q][j].x * t[q][j].x + t[q][j].y * t[q][j].y) + (t[q][j].z * t[q][j].z + t[q][j].w * t[q][j].w); }
        rstd[q] = 1.0f / sqrtf(wave_sum(s2) * (1.0f / 1024.0f) + LN_EPS); }
#pragma unroll
    for (int j = 0; j < 4; ++j) { const f32x4 gg = *((const f32x4*)lg + F.lane + 64 * j), bb = *((const f32x4*)lb + F.lane + 64 * j);
#pragma unroll
        for (int q = 0; q < RG; ++q) t[q][j] = t[q][j] * rstd[q] * gg + bb; }
}
template <int RG> DEV void ln1_group(const Frame& F, int l, int r) {

    const bf16_t* Y = (const bf16_t*)(F.ws + WS_Y); float* H = (float*)(F.ws + WS_H);
    const float* lg = GIN(I_LN1G) + l * 1024; const float* lb = GIN(I_LN1B) + l * 1024; const float* wr = (const float*)(F.ws + WS_WR) + (size_t)l * NE * 1024;
    {
        int b, s; row_bs(r, b, s); const int mr = s < CTX ? B_ : b; const float* mod = (const float*)(F.ws + WS_MOD) + ((size_t)l * NR + mr) * 6144;
        f32x4 t[RG][4];
#pragma unroll
        for (int j = 0; j < 4; ++j) { const f32x4 g1 = *((const f32x4*)(mod + 2048) + F.lane + 64 * j);
#pragma unroll
            for (int q = 0; q < RG; ++q) { const f32x4 hv = *((const f32x4*)HROW(F, l, r + q) + F.lane + 64 * j); const u32x2 yw = *((const u32x2*)(Y + (size_t)(r + q) * 1024) + F.lane + 64 * j); const f32x4 yv = (f32x4){bflo(yw.x), bfhi(yw.x), bflo(yw.y), bfhi(yw.y)}; t[q][j] = ALPHA * hv + g1 * yv; }
            if (j & 1) COMPILER_FENCE(); }
        ln_rows<RG>(F, t, lg, lb);
        COMPILER_FENCE();
#pragma unroll
        for (int j = 0; j < 4; ++j) { const f32x4 sh = *((const f32x4*)(mod + 3072) + F.lane + 64 * j), scv = *((const f32x4*)(mod + 4096) + F.lane + 64 * j);
#pragma unroll
            for (int q = 0; q < RG; ++q) { *((f32x4*)(H + (size_t)(r + q) * 1024) + F.lane + 64 * j) = t[q][j]; t[q][j] = t[q][j] * (1.0f + scv) + sh; } }
        COMPILER_FENCE();
#pragma unroll
        for (int q = 0; q < RG; ++q) { u32x2* xo = (u32x2*)((bf16_t*)(F.ws + WS_XIN) + (size_t)(r + q) * 1024) + F.lane;
#pragma unroll
            for (int j = 0; j < 4; ++j) xo[64 * j] = (u32x2){pk2(t[q][j].x, t[q][j].y), pk2(t[q][j].z, t[q][j].w)}; }
        float mine[RG]; const int ei = F.lane % NE;
#pragma unroll
        for (int q = 0; q < RG; ++q) mine[q] = 0.f;
        f32x4 wc[4];
#pragma unroll
        for (int j = 0; j < 4; ++j) wc[j] = *((const f32x4*)wr + F.lane + 64 * j);
#pragma unroll 1
        for (int e = 0; e < NE; ++e) { f32x4 wn[4]; const int en = e + 1 < NE ? e + 1 : e;
#pragma unroll
            for (int j = 0; j < 4; ++j) wn[j] = *((const f32x4*)(wr + en * 1024) + F.lane + 64 * j);
#pragma unroll
            for (int q = 0; q < RG; ++q) { float p = 0.f;
#pragma unroll
                for (int j = 0; j < 4; ++j) p += t[q][j].x * wc[j].x + t[q][j].y * wc[j].y + t[q][j].z * wc[j].z + t[q][j].w * wc[j].w;
                const float ws_ = wave_sum(p); mine[q] = (ei == e) ? ws_ : mine[q]; }
#pragma unroll
            for (int j = 0; j < 4; ++j) wc[j] = wn[j]; }
#pragma unroll
        for (int q = 0; q < RG; ++q) { const float mx = group_max<NE>(mine[q]); const float ex = expf(mine[q] - mx); const float se = group_sum<NE>(ex);
            if (F.lane < NE) ((float*)(F.ws + WS_AFF))[(size_t)(r + q) * 16 + F.lane] = ex / se; }
    }
}
DEV void phase_ln1(const Frame& F0, int l) {
    const Frame F = refresh(F0);
    const int nrows = (l == DEPTH - 1) ? LATR : MROWS;
    ROW_GROUPS(nrows, ln1_group<4>(F, l, r), ln1_group<2>(F, l, r));
}

DEV void phase_topk(const Frame& F0, int l) {
    const Frame F = refresh(F0);
    const int nitems = (l == DEPTH - 1) ? B_ * NE : 2 * B_ * NE;
    LAS unsigned* hist = (LAS unsigned*)(F.lds);
    LAS unsigned* selw = (LAS unsigned*)(F.lds + 1024);
    LAS unsigned* cnt = (LAS unsigned*)(F.lds + 2048);
    LAS int* selrow = (LAS int*)(F.lds + 8192);
    const float* AFF = (const float*)(F.ws + WS_AFF); int* SLOT = (int*)(F.ws + WS_SLOT); float* EG = (float*)(F.ws + WS_EGATE);
    for (int it = F.bid; it < nitems; it += F.G) {
        const int e = it % NE, set = it / NE, kind = set / B_, b = set % B_;
        const int n = kind ? CTX : SEQ, cap = kind ? CAPC : CAPL; const int row0 = kind ? LATR + b * CTX : b * SEQ;
        const int sbase = kind ? B_ * CAPL + b * CAPC : b * CAPL;
        const int per = n >= NTHREADS ? n / NTHREADS : 1; const bool act = F.tid * per < n;
        unsigned key[8];
#pragma unroll
        for (int k = 0; k < 8; ++k) key[k] = (act && k < per) ? __builtin_bit_cast(unsigned, AFF[(size_t)(row0 + F.tid * per + k) * 16 + e]) : 0u;
        unsigned prefix = 0u, remaining = (unsigned)cap;
        for (int pass = 0; pass < 4; ++pass) {
            const int shift = 24 - 8 * pass; const unsigned mask = pass == 0 ? 0u : (0xFFFFFFFFu << (shift + 8));
            if (F.tid < 256) hist[F.tid] = 0u;
            __syncthreads();
#pragma unroll
            for (int k = 0; k < 8; ++k) if (act && k < per && ((key[k] & mask) == (prefix & mask))) lds_atomic_add(&hist[(key[k] >> shift) & 255u], 1u);
            __syncthreads();
            if (F.wave == 0) {
                const unsigned h0 = hist[4 * F.lane], h1 = hist[4 * F.lane + 1], h2 = hist[4 * F.lane + 2], h3 = hist[4 * F.lane + 3];
                unsigned suf = h0 + h1 + h2 + h3;
#pragma unroll
                for (int o = 1; o < 64; o <<= 1) { const unsigned tv = shfl_t(suf, F.lane + o); if (F.lane + o < 64) suf += tv; }
                unsigned cum = suf - (h0 + h1 + h2 + h3);
                int dsel = -1; unsigned above = 0u;
                if (cum < remaining) {
                    if (cum + h3 >= remaining) { dsel = 4 * F.lane + 3; above = cum; }
                    else if (cum + h3 + h2 >= remaining) { dsel = 4 * F.lane + 2; above = cum + h3; }
                    else if (cum + h3 + h2 + h1 >= remaining) { dsel = 4 * F.lane + 1; above = cum + h3 + h2; }
                    else if (cum + h3 + h2 + h1 + h0 >= remaining) { dsel = 4 * F.lane; above = cum + h3 + h2 + h1; }
                }
                if (dsel >= 0) { selw[0] = prefix | ((unsigned)dsel << shift); selw[1] = remaining - above; }
            }
            __syncthreads();
            prefix = selw[0]; remaining = selw[1];
            __syncthreads();
        }
        const unsigned T = prefix, need_eq = remaining;
        unsigned ngt = 0u, neq = 0u;
#pragma unroll
        for (int k = 0; k < 8; ++k) if (act && k < per) { ngt += key[k] > T ? 1u : 0u; neq += key[k] == T ? 1u : 0u; }
        unsigned pk = (ngt << 16) | neq;
#pragma unroll
        for (int o = 1; o < 64; o <<= 1) { const unsigned tv = shfl_t(pk, F.lane - o); if (F.lane >= o) pk += tv; }
        if (F.lane == 63) cnt[F.wave] = pk;
        __syncthreads();
        unsigned base = 0u;
#pragma unroll
        for (int w8 = 0; w8 < NWAVES; ++w8) base += (w8 < F.wave) ? cnt[w8] : 0u;
        const unsigned excl = base + pk - ((ngt << 16) | neq);
        unsigned gtb = excl >> 16, eqb = excl & 0xffffu;
#pragma unroll
        for (int k = 0; k < 8; ++k) if (act && k < per) {
            const int row = row0 + F.tid * per + k; int slot = -1;
            const bool isgt = key[k] > T, iseq = key[k] == T;
            if (isgt || (iseq && eqb < need_eq)) { slot = (int)(gtb + (eqb < need_eq ? eqb : need_eq)); selrow[slot] = row; EG[(size_t)e * EPAD + sbase + slot] = __builtin_bit_cast(float, key[k]); }
            SLOT[(size_t)row * 16 + e] = slot >= 0 ? sbase + slot : -1;
            gtb += isgt ? 1u : 0u; eqb += iseq ? 1u : 0u;
        }
        __syncthreads();
        for (int sl = F.tid; sl < cap; sl += NTHREADS) ((int*)(F.ws + WS_EIDX))[(size_t)e * EPAD + sbase + sl] = selrow[sl];
        if (it < NE) for (int pr = EROWS + F.tid; pr < EPAD; pr += NTHREADS) { EG[(size_t)e * EPAD + pr] = 0.f; ((int*)(F.ws + WS_EIDX))[(size_t)e * EPAD + pr] = ZROW; }
        __syncthreads();
    }
}

DEV void phase_gather(const Frame& F0, int l) {
    const Frame F = refresh(F0);
    const int erows = (l == DEPTH - 1) ? B_ * CAPL : EROWS;
    const int* EI = (const int*)(F.ws + WS_EIDX);
    for (int r0 = 4 * F.gw; r0 < NE * EPAD; r0 += 4 * F.NGW) {
        u32x4 v[4][2];
#pragma unroll
        for (int q = 0; q < 4; ++q) { const int r = r0 + q, sl = r % EPAD; v[q][0] = (u32x4){0u, 0u, 0u, 0u}; v[q][1] = v[q][0];
            if (sl < erows) { const u32x4* src = (const u32x4*)((const bf16_t*)(F.ws + WS_XIN) + (size_t)EI[r] * 1024) + F.lane; v[q][0] = src[0]; v[q][1] = src[64]; } }
#pragma unroll
        for (int q = 0; q < 4; ++q) { u32x4* dst = (u32x4*)((bf16_t*)(F.ws + WS_XS) + (size_t)(r0 + q) * 1024) + F.lane; dst[0] = v[q][0]; dst[64] = v[q][1]; }
    }
}

template <int RG> DEV void ln2_group(const Frame& F, int l, int r) {

    float* H = (float*)(F.ws + WS_H); const int* SLOT = (const int*)(F.ws + WS_SLOT); const bf16_t* YSE = (const bf16_t*)(F.ws + WS_YSE);
    const float* lg = GIN(I_LN2G) + l * 1024; const float* lb = GIN(I_LN2B) + l * 1024;
    {
        int b, s; row_bs(r, b, s); const int mr = s < CTX ? B_ : b; const float* mod = (const float*)(F.ws + WS_MOD) + ((size_t)l * NR + mr) * 6144;
        f32x4 t[RG][4];
#pragma unroll
        for (int q = 0; q < RG; ++q) {
#pragma unroll
            for (int j = 0; j < 4; ++j) t[q][j] = (f32x4){0.f, 0.f, 0.f, 0.f}; }
        const int myslot = F.lane < RG * 16 ? SLOT[(size_t)r * 16 + F.lane] : -1;
#pragma unroll
        for (int q = 0; q < RG; ++q)
#pragma unroll
            for (int e = 0; e < NE; ++e) { const int sl = bcast_lane(myslot, 16 * q + e);
                if (sl >= 0) { const u32x2* yp = (const u32x2*)(YSE + ((size_t)e * EPAD + sl) * 1024) + F.lane;
#pragma unroll
                    for (int j = 0; j < 4; ++j) { const u32x2 w = yp[64 * j]; t[q][j] += (f32x4){bflo(w.x), bfhi(w.x), bflo(w.y), bfhi(w.y)}; } } }
#pragma unroll
        for (int j = 0; j < 4; ++j) { const f32x4 g2 = *((const f32x4*)(mod + 5120) + F.lane + 64 * j);
#pragma unroll
            for (int q = 0; q < RG; ++q) { const f32x4 hv = *((const f32x4*)(H + (size_t)(r + q) * 1024) + F.lane + 64 * j); t[q][j] = ALPHA * hv + g2 * t[q][j]; } }
        ln_rows<RG>(F, t, lg, lb);
        if (l == DEPTH - 1) {
            {
#pragma unroll
                for (int q = 0; q < RG; ++q) { GAS f32x4* op = (GAS f32x4*)(F.out + (size_t)(r + q) * 1024) + F.lane;
#pragma unroll
                    for (int j = 0; j < 4; ++j) op[64 * j] = t[q][j]; } }
        } else {
#pragma unroll
            for (int q = 0; q < RG; ++q)
#pragma unroll
                for (int j = 0; j < 4; ++j) *((f32x4*)(H + (size_t)(r + q) * 1024) + F.lane + 64 * j) = t[q][j];
            xg_rows<RG>(F, l + 1, r, t);
        }
    }
}
DEV void phase_ln2(const Frame& F0, int l) {
    const Frame F = refresh(F0);
    const int nrows = (l == DEPTH - 1) ? LATR : MROWS;
    ROW_GROUPS(nrows, ln2_group<4>(F, l, r), ln2_group<2>(F, l, r));
}

struct EpiP {
    static constexpr bool PERM = true;
    bf16_t* O; int ldc;
    DEV void operator()(const f32x4 (&acc)[2][2][4][2], const pg8::Unit& u, int wr, int wc, int fr, int fq) const {
        const int row0 = u.pm * 256 + wr * 64 + fr, col0 = u.pn * 256 + wc * 32 + 8 * fq;
#pragma unroll
        for (int ai = 0; ai < 2; ++ai)
#pragma unroll
            for (int m = 0; m < 4; ++m) { bf16_t* rowp = O + (size_t)(row0 + ai * 128 + m * 16) * ldc + col0;
#pragma unroll
                for (int bj = 0; bj < 2; ++bj) { const f32x4 v0 = acc[ai][bj][m][0], v1 = acc[ai][bj][m][1];
                    u32x4 w; w.x = pg8::cvt_pk_bf16(v0[0], v0[1]); w.y = pg8::cvt_pk_bf16(v0[2], v0[3]); w.z = pg8::cvt_pk_bf16(v1[0], v1[1]); w.w = pg8::cvt_pk_bf16(v1[2], v1[3]);
                    *(u32x4*)(rowp + bj * 128) = w; } }
    }
};
struct EpiGlu {
    static constexpr bool PERM = true;
    bf16_t* MG; const bf16_t* YS; const float* bias;
    DEV void operator()(const f32x4 (&acc)[2][2][4][2], const pg8::Unit& u, int wr, int wc, int fr, int fq) const {
        const int row0 = u.pm * 256 + wr * 64 + fr, col0 = u.pn * 256 + wc * 32 + 8 * fq;
#pragma unroll
        for (int ai = 0; ai < 2; ++ai)
#pragma unroll
            for (int m = 0; m < 4; ++m) { const int row = row0 + ai * 128 + m * 16;
#pragma unroll
                for (int bj = 0; bj < 2; ++bj) { const int c = col0 + bj * 128; const f32x4 v0 = acc[ai][bj][m][0], v1 = acc[ai][bj][m][1];
                    const u32x4 yv = *(const u32x4*)(YS + (size_t)row * 512 + c); const f32x4 b0 = *(const f32x4*)(bias + c), b1 = *(const f32x4*)(bias + c + 4);
                    u32x4 w; w.x = pk2(bflo(yv.x) * fast_sigmoid(v0[0] + b0[0]), bfhi(yv.x) * fast_sigmoid(v0[1] + b0[1])); w.y = pk2(bflo(yv.y) * fast_sigmoid(v0[2] + b0[2]), bfhi(yv.y) * fast_sigmoid(v0[3] + b0[3]));
                    w.z = pk2(bflo(yv.z) * fast_sigmoid(v1[0] + b1[0]), bfhi(yv.z) * fast_sigmoid(v1[1] + b1[1])); w.w = pk2(bflo(yv.w) * fast_sigmoid(v1[2] + b1[2]), bfhi(yv.w) * fast_sigmoid(v1[3] + b1[3]));
                    *(u32x4*)(MG + (size_t)row * 1024 + 512 + c) = w; } }
    }
};
struct EpiF32 {
    static constexpr bool PERM = false;
    float* C; int ldc; const float* rowscale;
    DEV void operator()(const f32x4 (&acc)[2][2][4][2], const pg8::Unit& u, int wr, int wc, int fr, int fq) const {
        const int row0 = u.pm * 256 + wr * 64 + fr, col0 = u.pn * 256 + wc * 32 + 4 * fq;
        const size_t ebase = rowscale ? (size_t)u.e * EPAD : 0;
#pragma unroll
        for (int ai = 0; ai < 2; ++ai)
#pragma unroll
            for (int m = 0; m < 4; ++m) { const size_t row = ebase + row0 + ai * 128 + m * 16; const float sc = rowscale ? rowscale[row] : 1.0f; float* rowp = C + row * ldc + col0;
#pragma unroll
                for (int bj = 0; bj < 2; ++bj)
#pragma unroll
                    for (int n = 0; n < 2; ++n) *(f32x4*)(rowp + bj * 128 + n * 16) = acc[ai][bj][m][n] * sc; }
    }
};
struct EpiYse {
    static constexpr bool PERM = true;
    bf16_t* O; const float* rowscale;
    DEV void operator()(const f32x4 (&acc)[2][2][4][2], const pg8::Unit& u, int wr, int wc, int fr, int fq) const {
        const int row0 = u.pm * 256 + wr * 64 + fr, col0 = u.pn * 256 + wc * 32 + 8 * fq; const size_t ebase = (size_t)u.e * EPAD;
#pragma unroll
        for (int ai = 0; ai < 2; ++ai)
#pragma unroll
            for (int m = 0; m < 4; ++m) { const size_t row = ebase + row0 + ai * 128 + m * 16; const float sc = rowscale[row]; bf16_t* rowp = O + row * 1024 + col0;
#pragma unroll
                for (int bj = 0; bj < 2; ++bj) { const f32x4 v0 = acc[ai][bj][m][0] * sc, v1 = acc[ai][bj][m][1] * sc;
                    u32x4 w; w.x = pg8::cvt_pk_bf16(v0[0], v0[1]); w.y = pg8::cvt_pk_bf16(v0[2], v0[3]); w.z = pg8::cvt_pk_bf16(v1[0], v1[1]); w.w = pg8::cvt_pk_bf16(v1[2], v1[3]);
                    *(u32x4*)(rowp + bj * 128) = w; } }
    }
};
struct EpiSwiglu {
    static constexpr bool PERM = true;
    bf16_t* HID;
    DEV void operator()(const f32x4 (&acc)[2][2][4][2], const pg8::Unit& u, int wr, int wc, int fr, int fq) const {
        const int row0 = u.pm * 256 + wr * 64 + fr, col0 = u.pn * 128 + wc * 32 + 8 * fq;
#pragma unroll
        for (int ai = 0; ai < 2; ++ai)
#pragma unroll
            for (int m = 0; m < 4; ++m) { bf16_t* rowp = HID + ((size_t)u.e * EPAD + row0 + ai * 128 + m * 16) * FF + col0;
                const f32x4 g0 = acc[ai][0][m][0], g1 = acc[ai][0][m][1], u0 = acc[ai][1][m][0], u1 = acc[ai][1][m][1];
                u32x4 w; w.x = pk2(fast_silu(g0[0]) * u0[0], fast_silu(g0[1]) * u0[1]); w.y = pk2(fast_silu(g0[2]) * u0[2], fast_silu(g0[3]) * u0[3]);
                w.z = pk2(fast_silu(g1[0]) * u1[0], fast_silu(g1[1]) * u1[1]); w.w = pk2(fast_silu(g1[2]) * u1[2], fast_silu(g1[3]) * u1[3]);
                *(u32x4*)rowp = w; }
    }
};

DEV void gemm_g1(const Frame& F0, int l, int vcu) {
    const Frame F = refresh(F0);
    const int nin = (l & 1) ? NIN_O : NIN_E;
    pg8::PlainOrder S; S.init((const void*)(F.ws + WS_XIN), (const bf16_t*)(F.ws + WS_WIN) + (size_t)l * NINMAX * 1024, 1024, MPAD, nin, F.G, vcu);
    EpiP E; E.O = (bf16_t*)(F.ws + WS_P); E.ldc = nin;
    pg8::gemm_phase(F.lds, 1024, S, E, F.wave, F.lane);
}
DEV void gemm_glu(const Frame& F0, int l, int vcu) {
    const Frame F = refresh(F0);
    const int li = l >> 1;
    pg8::PlainOrder S; S.init((const void*)(F.ws + WS_YS), (const bf16_t*)(F.ws + WS_WGLU) + (size_t)li * 512 * 512, 512, (l == DEPTH - 1) ? LATPAD : MPAD, 512, F.G, vcu);
    EpiGlu E; E.MG = (bf16_t*)(F.ws + WS_MERGED); E.YS = (const bf16_t*)(F.ws + WS_YS); E.bias = GIN(I_ODBGLU) + li * 512;
    pg8::gemm_phase(F.lds, 512, S, E, F.wave, F.lane);
}
DEV void gemm_g3(const Frame& F0, int l, int vcu) {
    const Frame F = refresh(F0);
    pg8::PlainOrder S; S.init((const void*)(F.ws + WS_MERGED), (const bf16_t*)(F.ws + WS_WOUT) + (size_t)l * 1024 * 1024, 1024, (l == DEPTH - 1) ? LATPAD : MPAD, 1024, F.G, vcu);
    EpiP E; E.O = (bf16_t*)(F.ws + WS_Y); E.ldc = 1024;
    pg8::gemm_phase(F.lds, 1024, S, E, F.wave, F.lane);
}
DEV void gemm_g4(const Frame& F0, int l, int vcu) {
    const Frame F = refresh(F0);
    pg8::GatherOrder S; S.init((const void*)(F.ws + WS_XIN), (const bf16_t*)(F.ws + WS_WGU) + (size_t)l * NE * 2 * FF * 1024, 1024, 2 * FF, F.G, vcu, (l == DEPTH - 1) ? B_ * CAPL : EROWS); S.gidx = (const int*)(F.ws + WS_EIDX);
    EpiSwiglu E; E.HID = (bf16_t*)(F.ws + WS_HID);
    pg8::gemm_phase(F.lds, 1024, S, E, F.wave, F.lane);
}
DEV void gemm_g5(const Frame& F0, int l, int vcu) {
    const Frame F = refresh(F0);
    pg8::GroupedOrder S; S.init((const void*)(F.ws + WS_HID), (const bf16_t*)(F.ws + WS_WD) + (size_t)l * NE * 1024 * FF, FF, 1024, F.G, vcu, (l == DEPTH - 1) ? B_ * CAPL : EROWS);
    EpiYse E; E.O = (bf16_t*)(F.ws + WS_YSE); E.rowscale = (const float*)(F.ws + WS_EGATE);
    pg8::gemm_phase(F.lds, FF, S, E, F.wave, F.lane);
}

__global__ void __launch_bounds__(NTHREADS, 2) mega_fwd(Args args) {
#ifdef EMU
    LAS unsigned char* lds = emu::lds();
#else
    extern __shared__ __attribute__((aligned(16))) unsigned char lds_raw[];
    LAS unsigned char* lds = (LAS unsigned char*)lds_raw;
#endif
    Frame F;
    F.in = args.in; F.out = (GAS float*)args.out; F.ws = (GAS unsigned char*)args.ws; F.lds = lds;
    F.tid = threadIdx.x; F.lane = F.tid & 63; F.wave = readfirstlane_i(F.tid >> 6); F.G = gridDim.x; F.bid = blockIdx.x;
    F.gw = F.bid * NWAVES + F.wave; F.NGW = F.G * NWAVES;
    for (int u = F.tid; u < (LDS_BYTES - LDS_MISC) / 4; u += NTHREADS) ((LAS unsigned*)(lds + LDS_MISC))[u] = 0u;
    __syncthreads();
    XcdBarrier bar = xcd_barrier_post((unsigned*)(F.ws + WS_CTL), (volatile LAS unsigned*)(lds + LDS_MISC), F.wave);
#define GRID_BAR() xcd_barrier(bar)
    const int vcu = (F.G % 8 == 0) ? (F.bid % 8) * (F.G / 8) + F.bid / 8 : F.bid;

#ifndef PHASE_MASK
#define PHASE_MASK 0xFFFFF
#endif
#ifndef REPEAT_MASK
#define REPEAT_MASK 0x0
#endif
#ifndef TIMING_PROBE
#define TIMING_PROBE -1
#endif
    unsigned long long pt_acc = 0ull, pt_t0 = 0ull;
#define PT(k) do { if (TIMING_PROBE == (k)) pt_t0 = rt_now(); } while (0)
#define PTE(k) do { if (TIMING_PROBE == (k)) pt_acc += rt_now() - pt_t0; } while (0)
#define PH(k) if ((PHASE_MASK >> (k)) & 1)
#define RP(k) if ((REPEAT_MASK >> (k)) & 1)
    PT(0); PH(0) phase_prologue_a(F);
    RP(0) { GRID_BAR(); phase_prologue_a(F); }
    GRID_BAR(); PTE(0);
    PT(1); PH(1) phase_xg0(F);
    GRID_BAR(); PTE(1);
    for (int l = 0; l < DEPTH; ++l) {
        const int odd = l & 1;
        PT(2); PH(2) gemm_g1(F, l, F.bid);
        RP(2) { GRID_BAR(); gemm_g1(F, l, F.bid); }
        GRID_BAR(); PTE(2);
        PT(3); PH(3) phase_prep(F, l);
        RP(3) { GRID_BAR(); phase_prep(F, l); }
        GRID_BAR(); PTE(3);
        PT(4); PH(4) phase_cl(F, l);
        RP(4) { GRID_BAR(); phase_cl(F, l); }
        GRID_BAR(); PTE(4);
        PT(5); PH(5) phase_seq(F, l);
        RP(5) { GRID_BAR(); phase_seq(F, l); }
        GRID_BAR(); PTE(5);
#ifdef SEQ_XPROBE
        if ((l & 1) == SEQ_XPARITY) { PT(20); phase_seq(F, l, 10 + SEQ_XPROBE); GRID_BAR(); PTE(20); }
#endif
        PT(6); PH(6) phase_merge(F, l);
        RP(6) { GRID_BAR(); phase_merge(F, l); }
        GRID_BAR(); PTE(6);
        if (odd) { PT(7); PH(7) gemm_glu(F, l, F.bid); RP(7) { GRID_BAR(); gemm_glu(F, l, F.bid); } GRID_BAR(); PTE(7); }
        PT(8); PH(8) gemm_g3(F, l, F.bid);
        RP(8) { GRID_BAR(); gemm_g3(F, l, F.bid); }
        GRID_BAR(); PTE(8);
        PT(9); PH(9) phase_ln1(F, l);
        GRID_BAR(); PTE(9);
        PT(10); PH(10) phase_topk(F, l);
        RP(10) { GRID_BAR(); phase_topk(F, l); }
        GRID_BAR(); PTE(10);
        PT(11); PH(11) gemm_g4(F, l, F.bid);
        RP(11) { GRID_BAR(); gemm_g4(F, l, F.bid); }
        GRID_BAR(); PTE(11);
        PT(12); PH(12) gemm_g5(F, l, F.bid);
        RP(12) { GRID_BAR(); gemm_g5(F, l, F.bid); }
        GRID_BAR(); PTE(12);
        PT(13); PH(13) phase_ln2(F, l);
        if (l + 1 < DEPTH || TIMING_PROBE >= 0) GRID_BAR();
        PTE(13);
    }
    if (TIMING_PROBE >= 0 && F.bid == 0) { const unsigned long long t1 = rt_now() + pt_acc; while (rt_now() < t1) s_sleep1(); }
}

#ifndef EMU
extern "C" void kernel_launch(void* const* d_in, const int* in_sizes, int n_in, void* d_out, int out_size, void* d_ws, size_t ws_size, hipStream_t stream) {
    static int grid = 0;
    if (grid == 0) {
        if (n_in != N_IN || ws_size < WS_END) { fprintf(stderr, "kernel_launch: need %d inputs and %zu bytes of workspace; got %d, %zu\n", (int)N_IN, (size_t)WS_END, n_in, ws_size); grid = -1; return; }
        int dev = 0, cus = 0, per_cu = 0;
        if (hipGetDevice(&dev) != hipSuccess || hipDeviceGetAttribute(&cus, hipDeviceAttributeMultiprocessorCount, dev) != hipSuccess) { grid = -1; return; }
        if (hipFuncSetAttribute((const void*)mega_fwd, hipFuncAttributeMaxDynamicSharedMemorySize, LDS_BYTES) != hipSuccess) { fprintf(stderr, "kernel_launch: hipFuncSetAttribute failed\n"); grid = -1; return; }
        if (hipOccupancyMaxActiveBlocksPerMultiprocessor(&per_cu, (const void*)mega_fwd, NTHREADS, LDS_BYTES) != hipSuccess || per_cu < 1) { fprintf(stderr, "kernel_launch: occupancy query says %d\n", per_cu); }
        (void)hipGetLastError();
        grid = cus;
    }
    if (grid < 0) return;
    (void)hipMemsetAsync((char*)d_ws + WS_CTL, 0, CTL_BYTES, stream);
    Args a{};
    for (int i = 0; i < N_IN; ++i) a.in[i] = (const float*)d_in[i];
    a.out = (float*)d_out; a.ws = (unsigned char*)d_ws;
    hipLaunchKernelGGL(mega_fwd, dim3(grid), dim3(NTHREADS), LDS_BYTES, stream, a);
}
#endif
```

```cpp
#ifdef EMU
#include "emu.h"
#else
#include <hip/hip_runtime.h>
#endif
#include <cstdio>
#include <cstdint>
#include <cstddef>

#ifndef CFG_BATCH
#define CFG_BATCH 4
#define CFG_SEQ 4096
#define CFG_CTX 256
#define CFG_DEPTH 4
#define CFG_NEXP 16
#define CFG_FF 2048
#endif
constexpr int B_ = CFG_BATCH, SEQ = CFG_SEQ, CTX = CFG_CTX, DEPTH = CFG_DEPTH, NE = CFG_NEXP, FF = CFG_FF;
constexpr int D = 1024, TOK = CTX + SEQ, MROWS = B_ * TOK, MPAD = (MROWS + 255) / 256 * 256;
constexpr int NCH = TOK / 64;
constexpr int LATR = B_ * SEQ;
constexpr int LATPAD = (LATR + 255) / 256 * 256;
constexpr int CAPL = 2 * SEQ / NE, CAPC = 2 * CTX / NE, EROWS = B_ * (CAPL + CAPC), EPAD = (EROWS + 255) / 256 * 256;
constexpr int NIN_E = 4096, NIN_O = 2560, NINMAX = 4096;
constexpr int N_EVEN = (DEPTH + 1) / 2, N_ODD = DEPTH / 2, N_ODDA = N_ODD > 0 ? N_ODD : 1;
constexpr int NR = B_ + 1;
constexpr float ALPHA = 1.681792830507429f;
constexpr float LN_EPS = 1e-5f;
constexpr float HD_SCALE = 0.08838834764831845f;
constexpr int NWAVES = 8, NTHREADS = 512;

enum { I_X = 0, I_C, I_CTX, I_CCTX, I_WMOD, I_BMOD, I_LN1G, I_LN1B, I_LN2G, I_LN2B, I_WROUTER, I_WGATE, I_WUP, I_WDOWN,
       I_EVWIN, I_EVWOUT, I_EVCONV, I_EVALOG, I_EVDTB, I_EVGDNN, I_EVRETN,
       I_ODWIN, I_ODWOUT, I_ODCONV, I_ODGB, I_ODMN, I_ODLRE, I_ODLIM, I_ODLDT, I_ODBRE, I_ODBIM, I_ODCRE, I_ODCIM, I_ODDSKIP, I_ODWGLU, I_ODBGLU, N_IN };

constexpr size_t al256(size_t x) { return (x + 255) & ~(size_t)255; }
constexpr size_t WS_CTL = 0, CTL_BYTES = 65536;
constexpr size_t WS_MOD = WS_CTL + CTL_BYTES;
constexpr size_t WS_WG = al256(WS_MOD + (size_t)DEPTH * NR * 6144 * 4);
constexpr size_t WS_WIN = al256(WS_WG + (size_t)DEPTH * 16 * 1024 * 4);
constexpr size_t WS_WOUT = al256(WS_WIN + (size_t)DEPTH * NINMAX * 1024 * 2);
constexpr size_t WS_WGLU = al256(WS_WOUT + (size_t)DEPTH * 1024 * 1024 * 2);
constexpr size_t WS_WGU = al256(WS_WGLU + (size_t)N_ODDA * 512 * 512 * 2);
constexpr size_t WS_WD = al256(WS_WGU + (size_t)DEPTH * NE * 2 * FF * 1024 * 2);
constexpr size_t WS_S5A = al256(WS_WD + (size_t)DEPTH * NE * 1024 * FF * 2);
constexpr size_t WS_S5B = al256(WS_S5A + (size_t)N_ODDA * 2 * 32 * 128 * 4);
constexpr size_t WS_S5C = al256(WS_S5B + (size_t)N_ODDA * 2 * 32 * 128 * 16 * 2);
constexpr size_t WS_H = al256(WS_S5C + (size_t)N_ODDA * 32 * 16 * 128 * 2);
constexpr size_t WS_XIN = al256(WS_H + (size_t)MPAD * 1024 * 4);
constexpr int ZROW = MPAD;
constexpr size_t WS_GATES = al256(WS_XIN + (size_t)(MPAD + 1) * 1024 * 2);
constexpr size_t WS_MERGED = al256(WS_GATES + (size_t)MROWS * 16 * 4);
constexpr size_t WS_YS = al256(WS_MERGED + (size_t)MPAD * 1024 * 2);
constexpr size_t WS_Y = al256(WS_YS + (size_t)MPAD * 512 * 2);
constexpr size_t WS_AFF = al256(WS_Y + (size_t)MPAD * 1024 * 4);
constexpr size_t WS_SLOT = al256(WS_AFF + (size_t)MROWS * 16 * 4);
constexpr size_t WS_EGATE = al256(WS_SLOT + (size_t)MROWS * 16 * 4);
constexpr size_t WS_MCH = al256(WS_EGATE + (size_t)NE * EPAD * 4);
constexpr size_t WS_WR = al256(WS_MCH + (size_t)B_ * 4 * 2 * NCH * 4);
constexpr size_t WS_EIDX = al256(WS_WR + (size_t)DEPTH * NE * 1024 * 4);
constexpr size_t WS_S5E = al256(WS_EIDX + (size_t)NE * EPAD * 4);
constexpr size_t WS_R = al256(WS_S5E + (size_t)B_ * 2 * 32 * NCH * 128 * 4);
constexpr int NCP = B_ * 8 * 2 * NCH, NCPG = B_ * 4 * 2 * NCH;
constexpr size_t WS_P = WS_R;
constexpr size_t WS_QKV = al256(WS_P + (size_t)MPAD * NINMAX * 2);
constexpr size_t WS_CLW = al256(WS_QKV + (size_t)MROWS * 1536 * 2);
constexpr size_t WS_CLQ = al256(WS_CLW + (size_t)NCP * 64 * 128 * 2);
constexpr size_t WS_CLK = al256(WS_CLQ + (size_t)NCP * 64 * 128 * 2);
constexpr size_t WS_CLA = al256(WS_CLK + (size_t)NCP * 64 * 128 * 2);
constexpr size_t WS_CLU = al256(WS_CLA + (size_t)NCP * 64 * 64 * 2);
constexpr size_t WS_CLS = al256(WS_CLU + (size_t)NCPG * 64 * 128 * 4);
constexpr size_t WS_O = al256(WS_CLS + (size_t)NCP * 512 * 4);
constexpr size_t WS_R_END1 = al256(WS_O + (size_t)2 * MROWS * 1024 * 4);
constexpr size_t WS_XS = WS_R;
constexpr size_t WS_HID = al256(WS_XS + (size_t)NE * EPAD * 1024 * 2);
constexpr size_t WS_YSE = al256(WS_HID + (size_t)NE * EPAD * FF * 2);
constexpr size_t WS_R_END2 = al256(WS_YSE + (size_t)NE * EPAD * 1024 * 4);
constexpr size_t WS_END = WS_R_END1 > WS_R_END2 ? WS_R_END1 : WS_R_END2;

constexpr int LDS_BYTES = 163840;
constexpr int LDS_MISC = 163328;

typedef unsigned short bf16_t;
typedef short bf16x8 __attribute__((ext_vector_type(8)));
typedef float f32x2 __attribute__((ext_vector_type(2)));
typedef float f32x4 __attribute__((ext_vector_type(4)));
typedef float f32x16 __attribute__((ext_vector_type(16)));
typedef unsigned u32x2 __attribute__((ext_vector_type(2)));
typedef unsigned u32x4 __attribute__((ext_vector_type(4)));
#define DEV __device__ __forceinline__

#ifdef EMU
#define LAS
#define GAS
static inline float bf2f_h(bf16_t b) { unsigned u = (unsigned)b << 16; float f; memcpy(&f, &u, 4); return f; }
static inline f32x4 mfma16(bf16x8 a, bf16x8 b, f32x4 c) {
    struct In { bf16x8 a, b; } in{a, b};
    auto s = emu::wave_xchg(&in, sizeof(in)); const int l = emu::cur->lane, col = l & 15, rg = l >> 4;
    for (int r = 0; r < 4; ++r) { const int row = 4 * rg + r; double acc = c[r];
        for (int kg = 0; kg < 4; ++kg) { const In* pa = (const In*)s[row + 16 * kg]; const In* pb = (const In*)s[col + 16 * kg];
            for (int j = 0; j < 8; ++j) acc += (double)bf2f_h((bf16_t)pa->a[j]) * (double)bf2f_h((bf16_t)pb->b[j]); }
        c[r] = (float)acc; }
    return c;
}
static inline f32x16 mfma32(bf16x8 a, bf16x8 b, f32x16 c) {
    struct In { bf16x8 a, b; } in{a, b};
    auto s = emu::wave_xchg(&in, sizeof(in)); const int l = emu::cur->lane, col = l & 31, h = l >> 5;
    for (int r = 0; r < 16; ++r) { const int row = (r & 3) + 8 * (r >> 2) + 4 * h; double acc = c[r];
        for (int kh = 0; kh < 2; ++kh) { const In* pa = (const In*)s[row + 32 * kh]; const In* pb = (const In*)s[col + 32 * kh];
            for (int j = 0; j < 8; ++j) acc += (double)bf2f_h((bf16_t)pa->a[j]) * (double)bf2f_h((bf16_t)pb->b[j]); }
        c[r] = (float)acc; }
    return c;
}
static inline void glds16(const void* g, void* l) { memcpy((char*)l + 16 * emu::cur->lane, g, 16); }
#define S_BARRIER() emu::block_barrier()
#define WAIT_VM(n) do {} while (0)
#define WAIT_LGKM(n) do {} while (0)
#define WAIT_ALL() do {} while (0)
#define SETPRIO(n) do {} while (0)
#define SCHED_BARRIER() do {} while (0)
#define COMPILER_FENCE() do {} while (0)
#define WAVE_LDS_SYNC() do { int _z = 0; (void)emu::wave_xchg(&_z, 4); } while (0)
#define LAUNDER(x) do {} while (0)
#define NT_LOAD(p) (*(p))
#define NT_STORE(v, p) (*(p) = (v))
#define CODE_ALIGN() do {} while (0)
#define LAUNDER_S(x) do {} while (0)
static inline int lane_id() { return emu::cur->lane; }
template <class T> static inline T shfl_xor_t(T v, int m) { auto s = emu::wave_xchg(&v, sizeof(T)); T r; memcpy(&r, s[emu::cur->lane ^ m], sizeof(T)); return r; }
template <class T> static inline T shfl_t(T v, int src) { auto s = emu::wave_xchg(&v, sizeof(T)); T r; memcpy(&r, s[src & 63], sizeof(T)); return r; }
static inline float wave_sum(float v) { for (int o = 1; o < 64; o <<= 1) v += shfl_xor_t(v, o); return v; }
static inline float wave_max(float v) { for (int o = 1; o < 64; o <<= 1) v = fmaxf(v, shfl_xor_t(v, o)); return v; }
template <int W> static inline float group_sum(float v) { for (int o = 1; o < W; o <<= 1) v += shfl_xor_t(v, o); return v; }
template <int W> static inline float group_max(float v) { for (int o = 1; o < W; o <<= 1) v = fmaxf(v, shfl_xor_t(v, o)); return v; }
static inline int bcast_lane(int v, int src) { return shfl_t(v, src); }
static inline float bcast_lane_f(float v, int src) { return shfl_t(v, src); }
static inline float wave_scan_add(float v) { const int ln = emu::cur->lane; for (int o = 1; o < 64; o <<= 1) { const float t = shfl_t(v, ln - o); if (ln >= o) v += t; } return v; }
static inline float wave_scan_max(float v) { const int ln = emu::cur->lane; for (int o = 1; o < 64; o <<= 1) { const float t = shfl_t(v, ln - o); if (ln >= o) v = fmaxf(v, t); } return v; }
static inline int readfirstlane_i(int v) { return v; }
static inline unsigned xb_ld(unsigned* p) { return *(volatile unsigned*)p; }
static inline unsigned xb_add(unsigned* p, unsigned v) { unsigned o = *p; *p = o + v; return o; }
static inline unsigned xb_xcc_id() { return (unsigned)emu::cur->bid & 7u; }
static inline void s_sleep1() { emu::yield(); }
static inline void fence_acquire() {}
static inline void fence_release() {}
static inline unsigned lds_atomic_add(unsigned* p, unsigned v) { unsigned o = *p; *p = o + v; return o; }
static inline unsigned long long rt_now() { return 0ull; }
static inline float fast_exp2(float x) { return exp2f(x); }
static inline float fast_rcp(float x) { return 1.0f / x; }
#else
#define LAS __attribute__((address_space(3)))
#define GAS __attribute__((address_space(1)))
DEV f32x4 mfma16(bf16x8 a, bf16x8 b, f32x4 c) { return __builtin_amdgcn_mfma_f32_16x16x32_bf16(a, b, c, 0, 0, 0); }
DEV f32x16 mfma32(bf16x8 a, bf16x8 b, f32x16 c) { return __builtin_amdgcn_mfma_f32_32x32x16_bf16(a, b, c, 0, 0, 0); }
#define glds16(g, l) __builtin_amdgcn_global_load_lds((const unsigned*)(g), (LAS unsigned*)(l), 16, 0, 0)
#define S_BARRIER() __builtin_amdgcn_s_barrier()
#define WAIT_VM(n) asm volatile("s_waitcnt vmcnt(" #n ")" ::: "memory")
#define WAIT_LGKM(n) asm volatile("s_waitcnt lgkmcnt(" #n ")" ::: "memory")
#define WAIT_ALL() asm volatile("s_waitcnt vmcnt(0) lgkmcnt(0)" ::: "memory")
#define SETPRIO(n) __builtin_amdgcn_s_setprio(n)
#define SCHED_BARRIER() __builtin_amdgcn_sched_barrier(0)
#define COMPILER_FENCE() asm volatile("" ::: "memory")
#define WAVE_LDS_SYNC() asm volatile("s_waitcnt lgkmcnt(0)" ::: "memory")
#define LAUNDER(x) asm volatile("" : "+v"(x))
#define NT_LOAD(p) __builtin_nontemporal_load(p)
#define NT_STORE(v, p) __builtin_nontemporal_store((v), (p))
#define CODE_ALIGN() asm volatile(".p2align 8")
#define LAUNDER_S(x) asm volatile("" : "+s"(x))
DEV int lane_id() { return (int)__builtin_amdgcn_mbcnt_hi(~0u, __builtin_amdgcn_mbcnt_lo(~0u, 0u)); }
template <class T> DEV T shfl_xor_t(T v, int m) { return __shfl_xor(v, m); }
template <class T> DEV T shfl_t(T v, int src) { return __shfl(v, src); }
template <int CTRL, int ROWMASK> DEV float dpp_mov(float v) { return __builtin_bit_cast(float, __builtin_amdgcn_update_dpp(0, __builtin_bit_cast(int, v), CTRL, ROWMASK, 0xf, false)); }
template <int CTRL, int ROWMASK> DEV float dpp_mov_keep(float oldv, float v) { return __builtin_bit_cast(float, __builtin_amdgcn_update_dpp(__builtin_bit_cast(int, oldv), __builtin_bit_cast(int, v), CTRL, ROWMASK, 0xf, false)); }
template <int W> DEV float group_sum(float v) {
    v += dpp_mov<0xB1, 0xf>(v); v += dpp_mov<0x4E, 0xf>(v);
    if (W >= 8) v += dpp_mov<0x141, 0xf>(v);
    if (W >= 16) v += dpp_mov<0x140, 0xf>(v);
    return v;
}
DEV float wave_sum(float v) {
    v = group_sum<16>(v);
    v += dpp_mov<0x142, 0xa>(v);
    v += dpp_mov<0x143, 0xc>(v);
    return __builtin_bit_cast(float, __builtin_amdgcn_readlane(__builtin_bit_cast(int, v), 63));
}
DEV float wave_max(float v) {
    v = fmaxf(v, dpp_mov_keep<0xB1, 0xf>(v, v)); v = fmaxf(v, dpp_mov_keep<0x4E, 0xf>(v, v)); v = fmaxf(v, dpp_mov_keep<0x141, 0xf>(v, v)); v = fmaxf(v, dpp_mov_keep<0x140, 0xf>(v, v));
    v = fmaxf(v, dpp_mov_keep<0x142, 0xa>(v, v)); v = fmaxf(v, dpp_mov_keep<0x143, 0xc>(v, v));
    return __builtin_bit_cast(float, __builtin_amdgcn_readlane(__builtin_bit_cast(int, v), 63));
}
template <int W> DEV float group_max(float v) {
    v = fmaxf(v, dpp_mov_keep<0xB1, 0xf>(v, v)); v = fmaxf(v, dpp_mov_keep<0x4E, 0xf>(v, v));
    if (W >= 8) v = fmaxf(v, dpp_mov_keep<0x141, 0xf>(v, v));
    if (W >= 16) v = fmaxf(v, dpp_mov_keep<0x140, 0xf>(v, v));
    return v;
}
DEV int bcast_lane(int v, int src) { return __builtin_amdgcn_readlane(v, src); }
DEV float bcast_lane_f(float v, int src) { return __builtin_bit_cast(float, __builtin_amdgcn_readlane(__builtin_bit_cast(int, v), src)); }
DEV float wave_scan_add(float v) {
    v += dpp_mov<0x111, 0xf>(v); v += dpp_mov<0x112, 0xf>(v); v += dpp_mov<0x114, 0xf>(v); v += dpp_mov<0x118, 0xf>(v);
    v += dpp_mov<0x142, 0xa>(v); v += dpp_mov<0x143, 0xc>(v); return v;
}
DEV float wave_scan_max(float v) {
    v = fmaxf(v, dpp_mov_keep<0x111, 0xf>(v, v)); v = fmaxf(v, dpp_mov_keep<0x112, 0xf>(v, v)); v = fmaxf(v, dpp_mov_keep<0x114, 0xf>(v, v)); v = fmaxf(v, dpp_mov_keep<0x118, 0xf>(v, v));
    v = fmaxf(v, dpp_mov_keep<0x142, 0xa>(v, v)); v = fmaxf(v, dpp_mov_keep<0x143, 0xc>(v, v)); return v;
}
DEV int readfirstlane_i(int v) { return __builtin_amdgcn_readfirstlane(v); }
DEV unsigned xb_ld(unsigned* p) { return __hip_atomic_load(p, __ATOMIC_RELAXED, __HIP_MEMORY_SCOPE_AGENT); }
DEV unsigned xb_add(unsigned* p, unsigned v) { return __hip_atomic_fetch_add(p, v, __ATOMIC_RELAXED, __HIP_MEMORY_SCOPE_AGENT); }
DEV unsigned xb_xcc_id() { return (unsigned)__builtin_amdgcn_s_getreg((3 << 11) | 20) & 0xFu; }
DEV void s_sleep1() { __builtin_amdgcn_s_sleep(1); }
DEV void fence_acquire() { __builtin_amdgcn_fence(__ATOMIC_ACQUIRE, "agent"); }
DEV void fence_release() { __builtin_amdgcn_fence(__ATOMIC_RELEASE, "agent"); }
DEV unsigned lds_atomic_add(LAS unsigned* p, unsigned v) { return __hip_atomic_fetch_add(p, v, __ATOMIC_RELAXED, __HIP_MEMORY_SCOPE_WORKGROUP); }
DEV unsigned long long rt_now() { return __builtin_amdgcn_s_memrealtime(); }
DEV float fast_exp2(float x) { return __builtin_amdgcn_exp2f(x); }
DEV float fast_rcp(float x) { return __builtin_amdgcn_rcpf(x); }
#endif

#ifdef EMU
DEV unsigned f2bf(float f) { unsigned u = __builtin_bit_cast(unsigned, f); return (u + 0x7fffu + ((u >> 16) & 1u)) >> 16; }
DEV unsigned pk2(float lo, float hi) { return f2bf(lo) | (f2bf(hi) << 16); }
DEV unsigned f2bf_sw(float f) { return f2bf(f); }
DEV unsigned pk2_sw(float lo, float hi) { return pk2(lo, hi); }
#else
typedef float f32x2n_t __attribute__((ext_vector_type(2)));
typedef __bf16 bf16x2n_t __attribute__((ext_vector_type(2)));
DEV unsigned pk2(float lo, float hi) { const f32x2n_t v = {lo, hi}; return __builtin_bit_cast(unsigned, __builtin_convertvector(v, bf16x2n_t)); }
DEV unsigned f2bf(float f) { return (unsigned)__builtin_bit_cast(unsigned short, (__bf16)f); }
DEV unsigned f2bf_sw(float f) { unsigned u = __builtin_bit_cast(unsigned, f); return (u + 0x7fffu + ((u >> 16) & 1u)) >> 16; }
DEV unsigned pk2_sw(float lo, float hi) { return f2bf_sw(lo) | (f2bf_sw(hi) << 16); }
#endif
DEV float bf2f(unsigned b) { return __builtin_bit_cast(float, b << 16); }
DEV float bflo(unsigned w) { return __builtin_bit_cast(float, w << 16); }
DEV float bfhi(unsigned w) { return __builtin_bit_cast(float, w & 0xffff0000u); }
DEV float sigmoid_f(float x) { return 1.0f / (1.0f + expf(-x)); }
DEV float silu_f(float x) { return x / (1.0f + expf(-x)); }
DEV float softplus_f(float x) { return fmaxf(x, 0.0f) + log1pf(expf(-fabsf(x))); }
DEV float fast_sigmoid(float x) { return fast_rcp(1.0f + fast_exp2(-1.4426950408889634f * x)); }
DEV float fast_silu(float x) { return x * fast_sigmoid(x); }
DEV float gelu_tanh_f(float x) { const float u = 0.7978845608028654f * (x + 0.044715f * x * x * x); return x * fast_sigmoid(2.0f * u); }
DEV float fast_exp(float x) { return fast_exp2(1.4426950408889634f * x); }

#define XB_TMO      128
#define XB_XCNT(j)  (256  + 64 * (j))
#define XB_XSUB(j)  (1280 + 64 * (j))
#define XB_XGEN(j)  (2304 + 64 * (j))
#define XB_TOP      3328
#define XB_TOPGEN   3392
#define XCD_BAR_WORDS 3456
#define XB_SPIN_CAP (1u << 20)
#define XB_SPIN(cond, bar) do { unsigned _sp = 0; while (cond) { s_sleep1(); \
    if ((++_sp & 255u) == 0u) { if (xb_ld(&(bar)[XB_TMO])) break; if (_sp > XB_SPIN_CAP) { xb_add(&(bar)[XB_TMO], 1u); break; } } } } while (0)
struct XcdBarrier { unsigned* bar; unsigned x; volatile LAS unsigned* st; int wave; };
DEV XcdBarrier xcd_barrier_post(unsigned* bar, volatile LAS unsigned* st, int wave) {
    XcdBarrier b; b.wave = wave; b.bar = bar; b.x = (unsigned)readfirstlane_i((int)xb_xcc_id()); b.st = st;
    if (wave == 0 && lane_id() == 0) (void)xb_add(&bar[XB_XCNT(b.x)], 1u);
    return b;
}
DEV void xcd_barrier_complete(unsigned* bar, unsigned x, unsigned& nloc, unsigned& nx) {
    const unsigned G = gridDim.x;
    unsigned sum, cnt, mine, sp = 0u;
    for (;;) {
        sum = 0u; cnt = 0u; mine = 0u;
#pragma unroll
        for (unsigned j = 0; j < 16; ++j) { const unsigned c = xb_ld(&bar[XB_XCNT(j)]); sum += c; cnt += (c > 0u) ? 1u : 0u; mine = (j == x) ? c : mine; }
        if (sum == G) break;
        s_sleep1();
        if ((++sp & 255u) == 0u) { if (xb_ld(&bar[XB_TMO])) break; if (sp > XB_SPIN_CAP) { xb_add(&bar[XB_TMO], 1u); break; } }
    }
    nloc = mine > 0u ? mine : 1u; nx = cnt > 0u ? cnt : 1u;
}
DEV void xcd_barrier(const XcdBarrier& b) {
    WAIT_VM(0);
    __syncthreads();
    int bw = b.wave; LAUNDER_S(bw);
    if (bw == 0 && lane_id() == 0) {
        unsigned* bar = b.bar; LAUNDER_S(bar);
        unsigned bx = b.x; LAUNDER_S(bx);
        WAIT_ALL();
        unsigned nloc = b.st[0], nx = b.st[1];
        if (nloc == 0u) { xcd_barrier_complete(bar, bx, nloc, nx); b.st[0] = nloc; b.st[1] = nx; }
        const unsigned old = xb_add(&bar[XB_XSUB(bx)], 1u);
        const unsigned gen = old / nloc;
        if (old + 1u == (gen + 1u) * nloc) {
            fence_release();
            WAIT_VM(0);
            const unsigned og = xb_add(&bar[XB_TOP], 1u);
            const unsigned tg = og / nx;
            if (og + 1u == (tg + 1u) * nx) xb_add(&bar[XB_TOPGEN], 1u);
            else XB_SPIN(xb_ld(&bar[XB_TOPGEN]) == tg, bar);
            fence_acquire();
            xb_add(&bar[XB_XGEN(bx)], 1u);
            WAIT_VM(0);
        } else {
            XB_SPIN(xb_ld(&bar[XB_XGEN(bx)]) == gen, bar);
            fence_acquire();
            WAIT_VM(0);
        }
    }
    __syncthreads();
}

namespace pg8 {
constexpr int BM = 256, BK = 64, HALF = 128, HTB = HALF * BK * 2, STAGE_BYTES = 8 * HTB;
DEV int lds_byte(int r, int c) { const int st = (r >> 4) * 2 + (c >> 5), rr = r & 15, cc = c & 31, ob = rr * 64 + cc * 2; return st * 1024 + (ob ^ (((ob >> 9) & 1) << 5)); }
DEV void stage_rc(int b, int& R, int& C) { const int st = b / 1024, sb = b % 1024, swz = sb ^ (((sb >> 9) & 1) << 5); R = (st >> 1) * 16 + swz / 64; C = (st & 1) * 32 + (swz % 64) / 2; }
DEV int perm32(int rho) { const int n = rho >> 4, i = rho & 15; return 8 * (i >> 2) + 4 * n + (i & 3); }
struct Unit { const char* A; const char* B; int pm, pn, e; };
#ifdef EMU
static inline unsigned cvt_pk_bf16(float lo, float hi) { return pk2(lo, hi); }
#else
DEV unsigned cvt_pk_bf16(float lo, float hi) { return pk2(lo, hi); }
#endif
template <class Epi, class Sched>
DEV void gemm_phase(LAS unsigned char* lds, const int K, const Sched& S, const Epi& E, const int wid, const int lane) {
    const int tid = wid * 64 + lane; const int wr = wid >> 2, wc = wid & 3, fr = lane & 15, fq = lane >> 4;
    const int nt = K / BK;
    unsigned voffA[2], voffB[2]; int Ri[2], Ci[2];
#pragma unroll
    for (int i = 0; i < 2; ++i) { int R, C; stage_rc(tid * 16 + i * 8192, R, C); const int Rb = Epi::PERM ? ((R & ~31) + perm32(R & 31)) : R; Ri[i] = R; Ci[i] = C;
        voffA[i] = (unsigned)(R * K + C) * 2u; voffB[i] = (unsigned)(Rb * K + C) * 2u; }
    unsigned goffC[2][2] = {{0u, 0u}, {0u, 0u}}, goffN[2][2] = {{0u, 0u}, {0u, 0u}};
    constexpr int GIDX_OFF = STAGE_BYTES;
    const size_t kstep = (size_t)(BK * 2);
    const size_t hstep = (size_t)HALF * K * 2;
    const unsigned ldsw = (unsigned)wid * 1024u;
    const int aoff = lds_byte(wr * 64 + fr, fq * 8), boff = lds_byte(wc * 32 + fr, fq * 8);
#define PG8_SA(b, h) (((b) * 2 + (h)) * HTB)
#define PG8_SB(b, h) ((4 + (b) * 2 + (h)) * HTB)
#define PG8_STAGE(bufoff, gbase, voff) do { _Pragma("unroll") for (int _i = 0; _i < 2; ++_i) \
        glds16(((const char*)(gbase) + (voff)[_i]), (lds + (bufoff) + ldsw + _i * 8192)); } while (0)
#define PG8_STAGEA(bufoff, gptr, h, nx) do { _Pragma("unroll") for (int _i = 0; _i < 2; ++_i) { \
        const unsigned _o = Sched::GATHER_A ? ((nx) ? goffN[h][_i] : goffC[h][_i]) : voffA[_i] + (unsigned)((h) * hstep); \
        glds16(((const char*)(gptr) + _o), (lds + (bufoff) + ldsw + _i * 8192)); } } while (0)
#define PG8_LDA(dst, b, h) do { _Pragma("unroll") for (int m = 0; m < 4; ++m) _Pragma("unroll") for (int k = 0; k < 2; ++k) dst[m][k] = *(const LAS bf16x8*)(lds + PG8_SA(b, h) + aoff + m * 2048 + k * 1024); } while (0)
#define PG8_LDB(dst, b, h) do { _Pragma("unroll") for (int n = 0; n < 2; ++n) _Pragma("unroll") for (int k = 0; k < 2; ++k) dst[n][k] = *(const LAS bf16x8*)(lds + PG8_SB(b, h) + boff + n * 2048 + k * 1024); } while (0)
#define PG8_MMA(ai, bj, At, Bt) do { SETPRIO(1); _Pragma("unroll") for (int m = 0; m < 4; ++m) _Pragma("unroll") for (int n = 0; n < 2; ++n) _Pragma("unroll") for (int k = 0; k < 2; ++k) \
        acc[ai][bj][m][n] = mfma16(Bt[n][k], At[m][k], acc[ai][bj][m][n]); SETPRIO(0); } while (0)
    Unit cur, nxt; int ui = 0;
    if (!S.next(0, cur)) return;
    f32x4 acc[2][2][4][2];
#pragma unroll
    for (int a = 0; a < 2; ++a)
#pragma unroll
        for (int b = 0; b < 2; ++b)
#pragma unroll
            for (int m = 0; m < 4; ++m)
#pragma unroll
                for (int n = 0; n < 2; ++n) acc[a][b][m][n] = (f32x4){0.f, 0.f, 0.f, 0.f};
    bf16x8 At[4][2], B0[2][2], B1[2][2];
    const char* cA = cur.A; const char* cB = cur.B;
    if constexpr (Sched::GATHER_A) {
#pragma unroll
        for (int hh = 0; hh < 2; ++hh)
#pragma unroll
            for (int i = 0; i < 2; ++i) { goffC[hh][i] = (unsigned)S.gidx[S.idx_base(cur) + hh * HALF + Ri[i]] * (unsigned)(K * 2) + (unsigned)(Ci[i] * 2); goffN[hh][i] = goffC[hh][i]; }
    }
    PG8_STAGE(PG8_SB(0, 0), cB, voffB); PG8_STAGE(PG8_SB(0, 1), cB + hstep, voffB); PG8_STAGEA(PG8_SA(0, 0), cA, 0, false); PG8_STAGEA(PG8_SA(0, 1), cA, 1, false);
    if (wr == 1) S_BARRIER();
    WAIT_VM(2); S_BARRIER();
    PG8_STAGE(PG8_SB(1, 0), cB + kstep, voffB); PG8_STAGEA(PG8_SA(1, 0), cA + kstep, 0, false); PG8_STAGE(PG8_SB(1, 1), cB + hstep + kstep, voffB);
    WAIT_VM(6); S_BARRIER();
    CODE_ALIGN();
    for (;;) {
        const bool has_next = S.next(ui + 1, nxt);
        const char* nA = has_next ? nxt.A : cA; const char* nB = has_next ? nxt.B : cB;
        if constexpr (Sched::GATHER_A) { if (has_next && wid == 0) glds16((const char*)(S.gidx + S.idx_base(nxt)) + 16 * lane, lds + GIDX_OFF); }
        for (int t = 0; t < nt; t += 2) {
            const bool last = (t == nt - 2);
            const char* a1 = cA + (size_t)(t + 1) * kstep;
            const char* a2 = last ? nA : cA + (size_t)(t + 2) * kstep; const char* b2 = last ? nB : cB + (size_t)(t + 2) * kstep;
            const char* a3 = a2 + kstep; const char* b3 = b2 + kstep;
            if constexpr (Sched::GATHER_A) { if (last && has_next) { COMPILER_FENCE();
#pragma unroll
                for (int hh = 0; hh < 2; ++hh)
#pragma unroll
                    for (int i = 0; i < 2; ++i) goffN[hh][i] = (unsigned)(*(const LAS int*)(lds + GIDX_OFF + 4 * (hh * HALF + Ri[i]))) * (unsigned)(K * 2) + (unsigned)(Ci[i] * 2); } }
            PG8_LDB(B0, 0, 0); PG8_LDB(B1, 0, 1); SCHED_BARRIER(); PG8_LDA(At, 0, 0); PG8_STAGEA(PG8_SA(1, 1), a1, 1, false);
            WAIT_VM(8); WAIT_LGKM(0); S_BARRIER(); PG8_MMA(0, 0, At, B0); PG8_MMA(0, 1, At, B1); S_BARRIER(); SCHED_BARRIER();
            PG8_LDA(At, 0, 1); PG8_STAGE(PG8_SB(0, 0), b2, voffB); PG8_STAGE(PG8_SB(0, 1), b2 + hstep, voffB); PG8_STAGEA(PG8_SA(0, 0), a2, 0, last);
            WAIT_VM(8); WAIT_LGKM(0); S_BARRIER(); PG8_MMA(1, 0, At, B0); PG8_MMA(1, 1, At, B1); S_BARRIER(); SCHED_BARRIER();
            PG8_LDB(B0, 1, 0); PG8_LDB(B1, 1, 1); SCHED_BARRIER(); PG8_LDA(At, 1, 0); PG8_STAGEA(PG8_SA(0, 1), a2, 1, last);
            WAIT_VM(8); WAIT_LGKM(0); S_BARRIER(); PG8_MMA(0, 0, At, B0); PG8_MMA(0, 1, At, B1); S_BARRIER(); SCHED_BARRIER();
            PG8_LDA(At, 1, 1); PG8_STAGE(PG8_SB(1, 0), b3, voffB); PG8_STAGE(PG8_SB(1, 1), b3 + hstep, voffB); PG8_STAGEA(PG8_SA(1, 0), a3, 0, last);
            WAIT_VM(8); WAIT_LGKM(0); S_BARRIER(); PG8_MMA(1, 0, At, B0); PG8_MMA(1, 1, At, B1); S_BARRIER(); SCHED_BARRIER();
        }
        if (wr == 0) S_BARRIER();
        E(acc, cur, wr, wc, fr, fq);
        if (!has_next) break;
#pragma unroll
        for (int a = 0; a < 2; ++a)
#pragma unroll
            for (int b = 0; b < 2; ++b)
#pragma unroll
                for (int m = 0; m < 4; ++m)
#pragma unroll
                    for (int n = 0; n < 2; ++n) acc[a][b][m][n] = (f32x4){0.f, 0.f, 0.f, 0.f};
        cur = nxt; cA = nA; cB = nB; ++ui;
        if constexpr (Sched::GATHER_A) {
#pragma unroll
            for (int hh = 0; hh < 2; ++hh)
#pragma unroll
                for (int i = 0; i < 2; ++i) goffC[hh][i] = goffN[hh][i]; }
        if (wr == 1) S_BARRIER();
    }
    WAIT_VM(0);
    S_BARRIER();
#undef PG8_SA
#undef PG8_SB
#undef PG8_STAGE
#undef PG8_STAGEA
#undef PG8_LDA
#undef PG8_LDB
#undef PG8_MMA
}

struct PlainOrder {
    static constexpr bool GATHER_A = false;
    const char* A; const char* Bt; int K, nM, nN, nwg, G, c;
    DEV void init(const void* A_, const void* Bt_, int K_, int M, int N, int G_, int c_) { A = (const char*)A_; Bt = (const char*)Bt_; K = K_; nM = M / BM; nN = N / BM; nwg = nM * nN; G = G_; c = c_; }
    DEV bool next(int i, Unit& u) const {
        const long L = (long)i * G + c; if (L >= nwg) return false;
        int wgid = (int)L; { const int q = nwg / 8, r = nwg % 8, xcd = wgid % 8, off = wgid / 8; wgid = (xcd < r ? xcd * (q + 1) : r * (q + 1) + (xcd - r) * q) + off; }
        const int nig = 8 * nN, gid = wgid / nig, fm = gid * 8, gsz = (nM - fm) < 8 ? (nM - fm) : 8;
        u.pm = fm + ((wgid % nig) % gsz); u.pn = (wgid % nig) / gsz; u.e = 0;
        u.A = A + (size_t)u.pm * BM * K * 2; u.B = Bt + (size_t)u.pn * BM * K * 2; return true;
    }
};
struct GroupedOrder {
    static constexpr bool GATHER_A = false;
    const char* A; const char* Bt; int K, nMe, nN, nwg, G, c; size_t bstride;
    DEV void init(const void* A_, const void* Bt_, int K_, int N, int G_, int c_, int erows) { A = (const char*)A_; Bt = (const char*)Bt_; K = K_; nMe = (erows + BM - 1) / BM; nN = N / BM; nwg = NE * nMe * nN; G = G_; c = c_; bstride = (size_t)N * K * 2; }
    DEV bool next(int i, Unit& u) const {
        const long L = (long)i * G + c; if (L >= nwg) return false;
        int wgid = (int)L; { const int q = nwg / 8, r = nwg % 8, xcd = wgid % 8, off = wgid / 8; wgid = (xcd < r ? xcd * (q + 1) : r * (q + 1) + (xcd - r) * q) + off; }
        const int per_e = nMe * nN; const int e = wgid / per_e, w = wgid % per_e;
        u.e = e; u.pm = w % nMe; u.pn = w / nMe;
        u.A = A + ((size_t)e * EPAD + (size_t)u.pm * BM) * K * 2; u.B = Bt + (size_t)e * bstride + (size_t)u.pn * BM * K * 2; return true;
    }
};
struct GatherOrder : GroupedOrder {
    static constexpr bool GATHER_A = true;
    const int* gidx;
    DEV bool next(int i, Unit& u) const { if (!GroupedOrder::next(i, u)) return false; u.A = A; return true; }
    DEV size_t idx_base(const Unit& u) const { return (size_t)u.e * EPAD + (size_t)u.pm * BM; }
};
}

struct Args { const float* in[N_IN]; float* out; unsigned char* ws; };

struct Frame {
    const float* const* in; GAS float* out; GAS unsigned char* ws; LAS unsigned char* lds;
    int tid, lane, wave, G, bid, gw, NGW;
};

#define HROW(F, l, r) ((l) == 0 ? ((r) < LATR ? GIN(I_X) + (size_t)(r) * 1024 : GIN(I_CTX) + (size_t)((r) - LATR) * 1024) : (const float*)((F).ws + WS_H) + (size_t)(r) * 1024)

DEV Frame refresh(const Frame& F0) {
    Frame F = F0; int w = F0.wave; LAUNDER_S(w); int ln = lane_id(); LAUNDER(ln);
    F.wave = w; F.lane = ln; F.tid = w * 64 + ln; F.gw = F.bid * NWAVES + w;
    GAS unsigned char* ws = F0.ws; LAUNDER_S(ws); F.ws = ws;
    return F;
}

#define GIN(k) ((const float*)(GAS const float*)F.in[k])

#define ROW_LOOP(r, NROWS) for (int r = F.gw; r < (NROWS); r += F.NGW)

DEV int tok_row(int b, int d, int sp) {
    if (sp < CTX) return LATR + b * CTX + (d ? (CTX - 1 - sp) : sp);
    const int j = sp - CTX; return b * SEQ + (d ? (SEQ - 1 - j) : j);
}
DEV void row_bs(int r, int& b, int& s) { if (r < LATR) { b = r / SEQ; s = CTX + r % SEQ; } else { const int q = r - LATR; b = q / CTX; s = q % CTX; } }

DEV void tr_item(const float* W, int ldw, int col0, int k0, bf16_t* WT, int K, int row0, LAS float* scr, int lane) {
#pragma unroll 8
    for (int i = 0; i < 32; ++i) { const int kk = 2 * i + (lane >> 5); scr[kk * 33 + (lane & 31)] = NT_LOAD(&W[(size_t)(k0 + kk) * ldw + col0 + (lane & 31)]); }
    WAVE_LDS_SYNC();
    const int c = lane & 7;
#pragma unroll
    for (int j = 0; j < 4; ++j) { const int n = (lane >> 3) + 8 * j; const LAS float* s = scr + (8 * c) * 33 + n;
        u32x4 o; o.x = pk2(s[0 * 33], s[1 * 33]); o.y = pk2(s[2 * 33], s[3 * 33]); o.z = pk2(s[4 * 33], s[5 * 33]); o.w = pk2(s[6 * 33], s[7 * 33]);
        NT_STORE(o, (u32x4*)(WT + (size_t)(row0 + n) * K + k0 + 8 * c)); }
    WAVE_LDS_SYNC();
}

DEV void phase_prologue_a(const Frame& F0) {
    const Frame F = refresh(F0);
    LAS float* scr = (LAS float*)(F.lds + F.wave * 16384);
    for (int l = 0; l < DEPTH; ++l) {
        const int odd = l & 1, li = l >> 1;
        const float* win = odd ? GIN(I_ODWIN) + (size_t)li * 1024 * 2576 : GIN(I_EVWIN) + (size_t)li * 1024 * 4112;
        const int ldw = odd ? 2576 : 4112, nin = odd ? NIN_O : NIN_E;
        bf16_t* wint = (bf16_t*)(F.ws + WS_WIN) + (size_t)l * NINMAX * 1024;
        for (int it = F.gw; it < 16 * (nin / 32); it += F.NGW) { const int kb = it / (nin / 32), nb = it % (nin / 32); const int d0 = 32 * nb;
            tr_item(win, ldw, d0 < 2048 ? d0 : d0 + 16, 64 * kb, wint, 1024, d0, scr, F.lane); }
        const float* wout = odd ? GIN(I_ODWOUT) + (size_t)li * 1024 * 1024 : GIN(I_EVWOUT) + (size_t)li * 1024 * 1024;
        bf16_t* woutt = (bf16_t*)(F.ws + WS_WOUT) + (size_t)l * 1024 * 1024;
        for (int it = F.gw; it < 16 * 32; it += F.NGW) { const int kb = it / 32, nb = it % 32; tr_item(wout, 1024, 32 * nb, 64 * kb, woutt, 1024, 32 * nb, scr, F.lane); }
        if (odd) {
            const float* wglu = GIN(I_ODWGLU) + (size_t)li * 512 * 512; bf16_t* wglut = (bf16_t*)(F.ws + WS_WGLU) + (size_t)li * 512 * 512;
            for (int it = F.gw; it < 8 * 16; it += F.NGW) { const int kb = it / 16, nb = it % 16; tr_item(wglu, 512, 32 * nb, 64 * kb, wglut, 512, 32 * nb, scr, F.lane); }
        }
        constexpr int GU_NB = 2 * FF / 32, GU_ITEMS = 16 * GU_NB;
        for (int it = F.gw; it < NE * GU_ITEMS; it += F.NGW) { const int e = it / GU_ITEMS, r = it % GU_ITEMS, kb = r / GU_NB, nb = r % GU_NB; const int d0 = 32 * nb, j = d0 >> 8, w = d0 & 255;
            const float* src = (w < 128 ? GIN(I_WGATE) : GIN(I_WUP)) + ((size_t)l * NE + e) * 1024 * FF;
            tr_item(src, FF, 128 * j + (w & 127), 64 * kb, (bf16_t*)(F.ws + WS_WGU) + ((size_t)l * NE + e) * 2 * FF * 1024, 1024, d0, scr, F.lane); }
        constexpr int D_ITEMS = (FF / 64) * 32;
        for (int it = F.gw; it < NE * D_ITEMS; it += F.NGW) { const int e = it / D_ITEMS, r = it % D_ITEMS, kb = r / 32, nb = r % 32;
            tr_item(GIN(I_WDOWN) + ((size_t)l * NE + e) * FF * 1024, 1024, 32 * nb, 64 * kb, (bf16_t*)(F.ws + WS_WD) + ((size_t)l * NE + e) * 1024 * FF, FF, 32 * nb, scr, F.lane); }
    }
    const int gt = F.bid * NTHREADS + F.tid, NGT = F.G * NTHREADS;
    for (int i = gt; i < DEPTH * 16 * 1024; i += NGT) { const int l = i / 16384, g = (i >> 10) & 15, k = i & 1023; const int odd = l & 1, li = l >> 1;
        ((float*)(F.ws + WS_WG))[i] = odd ? GIN(I_ODWIN)[((size_t)li * 1024 + k) * 2576 + 2048 + g] : GIN(I_EVWIN)[((size_t)li * 1024 + k) * 4112 + 2048 + g]; }
    for (int i = gt; i < DEPTH * NE * 1024; i += NGT) { const int k = i & 1023, e = (i >> 10) % NE, l = i / (NE * 1024); ((float*)(F.ws + WS_WR))[i] = GIN(I_WROUTER)[((size_t)l * 1024 + k) * NE + e]; }
    for (int i = gt; i < N_ODD * 2 * 32 * 64; i += NGT) { const int p = i & 63, g = (i >> 6) & 31, d = (i >> 11) & 1, o = i >> 12;
        const int idx = ((o * 2 + d) * 32 + g) * 64 + p;
        const float lr = fminf(GIN(I_ODLRE)[idx], -1e-4f), li_ = GIN(I_ODLIM)[idx], dt = expf(GIN(I_ODLDT)[(o * 2 + d) * 32 + g]);
        const float mag = expf(lr * dt); float sn, cs; sincosf(li_ * dt, &sn, &cs); const float are = mag * cs, aim = mag * sn;
        float* A = (float*)(F.ws + WS_S5A) + (size_t)((o * 2 + d) * 32 + g) * 128; A[p] = are; A[64 + p] = aim;
        const float xr = are - 1.0f, xi = aim, den = lr * lr + li_ * li_; const float fre = (xr * lr + xi * li_) / den, fim = (xi * lr - xr * li_) / den;
        bf16_t* Bb = (bf16_t*)(F.ws + WS_S5B) + (size_t)((o * 2 + d) * 32 + g) * 128 * 16;
        for (int h = 0; h < 16; ++h) { const float br = GIN(I_ODBRE)[((size_t)(o * 32 + g) * 64 + p) * 16 + h], bi = GIN(I_ODBIM)[((size_t)(o * 32 + g) * 64 + p) * 16 + h];
            Bb[p * 16 + h] = (bf16_t)f2bf(fre * br - fim * bi); Bb[(64 + p) * 16 + h] = (bf16_t)f2bf(fre * bi + fim * br); } }
    for (int i = gt; i < N_ODD * 32 * 16 * 64; i += NGT) { const int p = i & 63, c = (i >> 6) & 15, g = (i >> 10) & 31, o = i >> 15;
        bf16_t* Cm = (bf16_t*)(F.ws + WS_S5C) + (size_t)((o * 32 + g) * 16 + c) * 128;
        Cm[2 * p] = (bf16_t)f2bf(GIN(I_ODCRE)[i]); Cm[2 * p + 1] = (bf16_t)f2bf(-GIN(I_ODCIM)[i]); }
    ROW_LOOP(r, MPAD) {
        f32x4* dst = (f32x4*)((float*)(F.ws + WS_H) + (size_t)r * 1024) + F.lane;
        if (r < MROWS) { }
        else {
#pragma unroll
            for (int j = 0; j < 4; ++j) dst[64 * j] = (f32x4){0.f, 0.f, 0.f, 0.f};
            u32x4* xz = (u32x4*)((bf16_t*)(F.ws + WS_XIN) + (size_t)r * 1024) + F.lane; xz[0] = (u32x4){0u, 0u, 0u, 0u}; xz[64] = (u32x4){0u, 0u, 0u, 0u};
            u32x4* mz = (u32x4*)((bf16_t*)(F.ws + WS_MERGED) + (size_t)r * 1024) + F.lane; mz[0] = (u32x4){0u, 0u, 0u, 0u}; mz[64] = (u32x4){0u, 0u, 0u, 0u};
            u32x4* yz = (u32x4*)((bf16_t*)(F.ws + WS_YS) + (size_t)r * 512) + F.lane; yz[0] = (u32x4){0u, 0u, 0u, 0u};
        }
    }
    if (F.gw == 0) { u32x4* zr = (u32x4*)((bf16_t*)(F.ws + WS_XIN) + (size_t)ZROW * 1024) + F.lane; zr[0] = (u32x4){0u, 0u, 0u, 0u}; zr[64] = (u32x4){0u, 0u, 0u, 0u}; }
    __syncthreads();
    LAS float* sv = (LAS float*)F.lds;
    LAS float* part = (LAS float*)(F.lds + 32768);
    for (int i = F.tid; i < NR * 1024; i += NTHREADS) { const int r = i >> 10, k = i & 1023; const float c = r < B_ ? GIN(I_C)[r * 1024 + k] : GIN(I_CCTX)[k]; sv[i] = silu_f(c); }
    __syncthreads();
    for (int it = F.bid; it < DEPTH * 96; it += F.G) {
        const int l = it / 96, j = (it % 96) * 64 + F.lane;
        const float* w = GIN(I_WMOD) + (size_t)l * 1024 * 6144 + j;
        float acc[NR];
#pragma unroll
        for (int r = 0; r < NR; ++r) acc[r] = 0.f;
        const int k0 = F.wave * 128;
#pragma unroll 8
        for (int k = 0; k < 128; ++k) { const float wv = w[(size_t)(k0 + k) * 6144];
#pragma unroll
            for (int r = 0; r < NR; ++r) acc[r] += sv[r * 1024 + k0 + k] * wv; }
#pragma unroll
        for (int r = 0; r < NR; ++r) part[(F.wave * NR + r) * 64 + F.lane] = acc[r];
        __syncthreads();
        for (int i = F.tid; i < NR * 64; i += NTHREADS) { const int r = i >> 6, jj = i & 63; float s = 0.f;
#pragma unroll
            for (int w8 = 0; w8 < 8; ++w8) s += part[(w8 * NR + r) * 64 + jj];
            const int col = (it % 96) * 64 + jj;
            ((float*)(F.ws + WS_MOD))[((size_t)l * NR + r) * 6144 + col] = s + GIN(I_BMOD)[l * 6144 + col]; }
        __syncthreads();
    }
}

static_assert(TOK % 4 == 0 && CTX % 4 == 0 && MROWS % 4 == 0, "row groups");
#define ROW_GROUPS(nrows, CALL4, CALL2) do { const int _r4 = ((nrows) / (4 * F.NGW)) * (4 * F.NGW); \
    for (int r = 4 * F.gw; r < _r4; r += 4 * F.NGW) { CALL4; } for (int r = _r4 + 2 * F.gw; r < (nrows); r += 2 * F.NGW) { CALL2; } } while (0)
template <int RG> DEV void xg_rows(const Frame& F, int l, int row0, f32x4 (&v)[RG][4]) {
    int b, s; row_bs(row0, b, s); const int mr = s < CTX ? B_ : b;
    const float* mod = (const float*)(F.ws + WS_MOD) + ((size_t)l * NR + mr) * 6144;
#pragma unroll
    for (int j = 0; j < 4; ++j) { const f32x4 sh = *((const f32x4*)mod + F.lane + 64 * j), sc = *((const f32x4*)(mod + 1024) + F.lane + 64 * j);
#pragma unroll
        for (int q = 0; q < RG; ++q) v[q][j] = v[q][j] * (1.0f + sc) + sh; }
#pragma unroll
    for (int q = 0; q < RG; ++q) { u32x2* xo = (u32x2*)((bf16_t*)(F.ws + WS_XIN) + (size_t)(row0 + q) * 1024) + F.lane;
#pragma unroll
        for (int j = 0; j < 4; ++j) xo[64 * j] = (u32x2){pk2(v[q][j].x, v[q][j].y), pk2(v[q][j].z, v[q][j].w)}; }
    const float* wg = (const float*)(F.ws + WS_WG) + (size_t)l * 16 * 1024;
    float mine[RG]; const int gi = F.lane & 15;
#pragma unroll
    for (int q = 0; q < RG; ++q) mine[q] = 0.f;
    f32x4 wc[4];
#pragma unroll
    for (int j = 0; j < 4; ++j) wc[j] = *((const f32x4*)wg + F.lane + 64 * j);
#pragma unroll 1
    for (int g = 0; g < 16; ++g) { f32x4 wn[4]; const int gn = g + 1 < 16 ? g + 1 : g;
#pragma unroll
        for (int j = 0; j < 4; ++j) wn[j] = *((const f32x4*)(wg + gn * 1024) + F.lane + 64 * j);
#pragma unroll
        for (int q = 0; q < RG; ++q) { float p = 0.f;
#pragma unroll
            for (int j = 0; j < 4; ++j) p += v[q][j].x * wc[j].x + v[q][j].y * wc[j].y + v[q][j].z * wc[j].z + v[q][j].w * wc[j].w;
            const float t = wave_sum(p); mine[q] = (gi == g) ? t : mine[q]; }
#pragma unroll
        for (int j = 0; j < 4; ++j) wc[j] = wn[j]; }
    const int ty = gi >> 2, hh = gi & 3, li = l >> 1;
#pragma unroll
    for (int q = 0; q < RG; ++q) { float o;
        if (!(l & 1)) {
            if (ty < 2) o = -expf(GIN(I_EVALOG)[(li * 2 + ty) * 4 + hh]) * softplus_f(mine[q] + GIN(I_EVDTB)[(li * 2 + ty) * 4 + hh]);
            else o = sigmoid_f(mine[q]);
        } else {
            const int d = ty & 1, k = ty >> 1; const float gb = GIN(I_ODGB)[((li * 2 + d) * 2 + k) * 4 + hh];
            o = k ? -softplus_f(-(mine[q] + gb)) : mine[q] + gb;
        }
        if (F.lane < 16) ((float*)(F.ws + WS_GATES))[(size_t)(row0 + q) * 16 + gi] = o; }
}

template <int RG> DEV void xg0_group(const Frame& F, int r) {
        f32x4 v[RG][4];
#pragma unroll
        for (int q = 0; q < RG; ++q) { const f32x4* hr = (const f32x4*)HROW(F, 0, r + q) + F.lane;
#pragma unroll
            for (int j = 0; j < 4; ++j) v[q][j] = hr[64 * j]; }
        xg_rows<RG>(F, 0, r, v);
    }
DEV void phase_xg0(const Frame& F0) {
    const Frame F = refresh(F0);
    ROW_GROUPS(MROWS, xg0_group<4>(F, r), xg0_group<2>(F, r));
}

template <int RG> DEV void prep_group(const Frame& F, int l, int r) {

    const int odd = l & 1, li = l >> 1; const int nin = odd ? NIN_O : NIN_E, nseg = odd ? 2 : 3, qld = odd ? 1024 : 1536;
    const bf16_t* P = (const bf16_t*)(F.ws + WS_P); bf16_t* Q = (bf16_t*)(F.ws + WS_QKV);
    const float* cw = odd ? GIN(I_ODCONV) + (size_t)li * 9 * 1024 : GIN(I_EVCONV) + (size_t)li * 9 * 1536; const int cch = odd ? 1024 : 1536;
    {
        int b, s; row_bs(r, b, s); const bool lat = s >= CTX; const int rr = lat ? (s - CTX) >> 6 : 0, cc = lat ? (s - CTX) & 63 : s;
        const int ncol = lat ? 64 : CTX;
        for (int seg = 0; seg < nseg; ++seg) {
            const int ch0 = seg * 512 + F.lane * 8; float a[RG][8];
#pragma unroll
            for (int q = 0; q < RG; ++q)
#pragma unroll
                for (int i = 0; i < 8; ++i) a[q][i] = 0.f;
            u32x4 pv[3][RG + 2]; f32x4 w0[3][3], w1[3][3];
#pragma unroll
            for (int kh = 0; kh < 3; ++kh) {
                const int r2 = rr + kh - 1; const bool rok = lat ? (r2 >= 0 && r2 < SEQ / 64) : (kh == 1); const int r2c = rok ? r2 : rr;
                const int rowbase = lat ? b * SEQ + r2c * 64 : LATR + b * CTX;
#pragma unroll
                for (int dc = 0; dc < RG + 2; ++dc) { const int c2 = cc - 1 + dc; const bool ok = rok && c2 >= 0 && c2 < ncol; const int c2c = ok ? c2 : cc;
                    const u32x4 t4 = *(const u32x4*)(P + (size_t)(rowbase + c2c) * nin + ch0); pv[kh][dc] = ok ? t4 : (u32x4){0u, 0u, 0u, 0u}; }
#pragma unroll
                for (int kw = 0; kw < 3; ++kw) { w0[kh][kw] = *(const f32x4*)(cw + (kh * 3 + kw) * cch + ch0); w1[kh][kw] = *(const f32x4*)(cw + (kh * 3 + kw) * cch + ch0 + 4); }
            }
#pragma unroll
            for (int kh = 0; kh < 3; ++kh)
#pragma unroll
                for (int dc = 0; dc < RG + 2; ++dc) {
                    const float x0 = bflo(pv[kh][dc].x), x1 = bfhi(pv[kh][dc].x), x2 = bflo(pv[kh][dc].y), x3 = bfhi(pv[kh][dc].y), x4 = bflo(pv[kh][dc].z), x5 = bfhi(pv[kh][dc].z), x6 = bflo(pv[kh][dc].w), x7 = bfhi(pv[kh][dc].w);
#pragma unroll
                    for (int q = 0; q < RG; ++q) { const int kw = dc - q;
                        if (kw >= 0 && kw <= 2) { a[q][0] += x0 * w0[kh][kw].x; a[q][1] += x1 * w0[kh][kw].y; a[q][2] += x2 * w0[kh][kw].z; a[q][3] += x3 * w0[kh][kw].w;
                            a[q][4] += x4 * w1[kh][kw].x; a[q][5] += x5 * w1[kh][kw].y; a[q][6] += x6 * w1[kh][kw].z; a[q][7] += x7 * w1[kh][kw].w; } } }
#pragma unroll
            for (int q = 0; q < RG; ++q) {
                float ss = 0.f;
#pragma unroll
                for (int i = 0; i < 8; ++i) { a[q][i] = fast_silu(a[q][i]); ss += a[q][i] * a[q][i]; }
                float sc = 1.0f;
                if (!odd) { if (seg < 2) { ss = group_sum<16>(ss); sc = 1.0f / sqrtf(ss + 1e-6f); if (seg == 0) sc *= HD_SCALE; } }
                else if (seg == 1) sc = HD_SCALE;
                u32x4 o; o.x = pk2(a[q][0] * sc, a[q][1] * sc); o.y = pk2(a[q][2] * sc, a[q][3] * sc); o.z = pk2(a[q][4] * sc, a[q][5] * sc); o.w = pk2(a[q][6] * sc, a[q][7] * sc);
                *(u32x4*)(Q + (size_t)(r + q) * qld + ch0) = o;
            }
        }
    }
}
DEV void phase_prep(const Frame& F0, int l) {
    const Frame F = refresh(F0);
    const int odd = l & 1;
    ROW_GROUPS(MROWS, prep_group<4>(F, l, r), prep_group<2>(F, l, r));

    if (odd) {
        const float* GT = (const float*)(F.ws + WS_GATES); float* MC = (float*)(F.ws + WS_MCH);
        for (int c = F.gw; c < B_ * 4 * 2; c += F.NGW) { const int d = c & 1, hh = (c >> 1) & 3, b = c >> 3; float m = 0.f;
            for (int n = 0; n < NCH; ++n) { const int row = tok_row(b, d, n * 64 + F.lane);
                const float lin = GT[(size_t)row * 16 + d * 4 + hh], lf = GT[(size_t)row * 16 + 8 + d * 4 + hh];
                const float bc = wave_scan_add(lf);
                const float bend = bcast_lane_f(bc, 63); const float amax = wave_max(bend - bc + lin);
                if (F.lane == 0) MC[(size_t)c * NCH + n] = m;
                m = fmaxf(bend + m, amax); }
        }
    }
}

DEV int swz256(int r, int k) { return r * 256 + 16 * (k ^ (r & 15)); }
DEV int swz128(int r, int k) { return r * 128 + 16 * (k ^ ((r >> 1) & 7)); }
constexpr int CL_IMG = 90112;
struct ClProb { int n, d, hh, b, kind, qld, vld; const bf16_t *qsrc, *ksrc, *vsrc; float kscale; };
DEV ClProb cl_decode(const Frame& F, int p, int odd, int nhh) {
    ClProb c; c.n = p % NCH; c.d = (p / NCH) & 1; c.hh = (p / (2 * NCH)) % nhh; c.b = p / (2 * NCH * nhh); c.kind = odd ? 2 : (c.hh < 4 ? 0 : 1); c.kscale = 1.0f;
    const bf16_t* P = (const bf16_t*)(F.ws + WS_P); const bf16_t* Q = (const bf16_t*)(F.ws + WS_QKV);
    if (c.kind == 0) { c.qsrc = Q + c.hh * 128; c.ksrc = Q + 512 + c.hh * 128; c.vsrc = Q + 1024 + c.hh * 128; c.qld = 1536; c.vld = 1536; }
    else if (c.kind == 1) { c.qsrc = P + 2048 + (c.hh - 4) * 128; c.ksrc = P + 2560 + (c.hh - 4) * 128; c.vsrc = P + 3072 + (c.hh - 4) * 128; c.qld = NIN_E; c.vld = NIN_E; c.kscale = HD_SCALE; }
    else { c.qsrc = Q + c.hh * 128; c.ksrc = Q + 512 + c.hh * 128; c.vsrc = P + 1024 + c.hh * 128; c.qld = 1024; c.vld = NIN_O; }
    return c;
}
DEV void cl_dma(const Frame& F, const ClProb c) {
    int ln = F.lane; LAUNDER(ln);
    const int r0 = tok_row(c.b, c.d, c.n * 64), sg = c.d ? -1 : 1; const int per = c.kind == 0 ? 6 : 4;
#pragma unroll
    for (int i = 0; i < 6; ++i) if (i < per) { const int ch = F.wave * per + i, reg = ch >> 4, cc = ch & 15, r = 4 * cc + (ln >> 4), kk = (ln & 15) ^ (r & 15);
        const bf16_t* src = reg == 0 ? c.qsrc : (reg == 1 ? c.ksrc : c.vsrc); const int ld = reg == 2 ? c.vld : c.qld;
        glds16((const GAS char*)(src + (size_t)(r0 + sg * r) * ld + 8 * kk), F.lds + CL_IMG + reg * 16384 + 1024 * cc); }
}
DEV void seq_s5_item(const Frame& F, int l, int item, int which);
DEV void phase_cl(const Frame& F0, int l) {
    const Frame F = refresh(F0);
    const int odd = l & 1; const int nhh = odd ? 4 : 8; const int nprob = B_ * nhh * 2 * NCH;
    if (odd) {
        for (int it = F.bid; it < B_ * 2 * 32; it += F.G) { seq_s5_item(F, l, it, 0); __syncthreads(); }
    }
    LAS float* gc = (LAS float*)(F.lds);
    LAS float* bt = (LAS float*)(F.lds + 256);
    LAS float* qs = (LAS float*)(F.lds + 768);
    LAS float* ks = (LAS float*)(F.lds + 1024);
    LAS float* mt = (LAS float*)(F.lds + 1280);
    LAS float* rsp = (LAS float*)(F.lds + 2048);
    LAS float* Am = (LAS float*)(F.lds + 4096);
    LAS bf16_t* An = (LAS bf16_t*)(F.lds + 20480);
    LAS bf16_t* XT = (LAS bf16_t*)(F.lds + 30720);
    LAS float* Rb = (LAS float*)(F.lds + 69632 + F.wave * 2048);
    LAS float* ksp = (LAS float*)(F.lds + 86016);
    LAS unsigned char* IQ = F.lds + CL_IMG; LAS unsigned char* IK = IQ + 16384; LAS unsigned char* IV = IQ + 32768;
    const float* GT = (const float*)(F.ws + WS_GATES);
    float gq = 0.f, bq = 0.f, mq = 0.f;
#define CL_GATES(pp) do { const ClProb cn = cl_decode(F, (pp), odd, nhh); const int rown = tok_row(cn.b, cn.d, cn.n * 64 + F.lane); \
        if (cn.kind == 0) { gq = GT[(size_t)rown * 16 + cn.d * 4 + cn.hh]; bq = GT[(size_t)rown * 16 + 8 + cn.d * 4 + cn.hh]; } \
        else if (cn.kind == 2) { bq = GT[(size_t)rown * 16 + cn.d * 4 + cn.hh]; gq = GT[(size_t)rown * 16 + 8 + cn.d * 4 + cn.hh]; \
            mq = ((const float*)(F.ws + WS_MCH))[(size_t)((cn.b * 4 + cn.hh) * 2 + cn.d) * NCH + cn.n]; } } while (0)
    if (F.bid < nprob) { cl_dma(F, cl_decode(F, F.bid, odd, nhh)); if (F.wave == 0) CL_GATES(F.bid); }
    for (int p = F.bid; p < nprob; p += F.G) {
        int lz = F.lane; LAUNDER(lz); const int h = lz >> 5, l31 = lz & 31;
        const ClProb c = cl_decode(F, p, odd, nhh); const int n = c.n, d = c.d, hh = c.hh, b = c.b, kind = c.kind; const float kscale = c.kscale;
        float* CS = (float*)(F.ws + WS_CLS) + (size_t)p * 512;
        if (F.wave == 0) {
            const int i = F.lane;
            float g = gq, be = bq;
            if (kind == 1) { g = log1pf(-exp2f(-(5.0f + 2.0f * (float)(hh - 4) + (float)d))); be = 0.f; }
            const float cum = wave_scan_add(g);
            const float gend = bcast_lane_f(cum, 63);
            gc[i] = cum; bt[i] = be;
            if (kind < 2) { qs[i] = expf(cum); ks[i] = expf(gend - cum) * kscale; if (i == 0) CS[0] = expf(gend); }
            else {
                const float mprev = mq;
                const float a = gend - cum + be; const float amax = wave_max(a); const float mnew = fmaxf(gend + mprev, amax);
                ks[i] = expf(a - mnew);
                const float pm = wave_scan_max(be - cum);
                const float mti = cum + fmaxf(mprev, pm); mt[i] = mti; qs[i] = expf(cum + mprev - mti);
                CS[128 + i] = expf(-mti);
                if (i == 0) CS[0] = expf(gend + mprev - mnew);
            }
        }
        WAIT_VM(0);
        __syncthreads();
        {
            const int w4 = F.wave & 3, mt_ = w4 >> 1, nt_ = w4 & 1; const bool doY = F.wave >= 4;
            if (!doY || kind == 0) {
                const int rj = 32 * mt_ + l31, ri = 32 * nt_ + l31; LAS unsigned char* IB = doY ? IK : IQ;
                f32x16 acc;
#pragma unroll
                for (int r = 0; r < 16; ++r) acc[r] = 0.f;
                bf16x8 af[8], bfr[8];
#pragma unroll
                for (int s = 0; s < 8; ++s) { af[s] = *(const LAS bf16x8*)(IK + swz256(rj, 2 * s + h)); bfr[s] = *(const LAS bf16x8*)(IB + swz256(ri, 2 * s + h)); }
#pragma unroll
                for (int s = 0; s < 8; ++s) acc = mfma32(af[s], bfr[s], acc);
                const int i = ri; const float gi = gc[i];
                if (!doY) {
                    bf16_t* AQ = (bf16_t*)(F.ws + WS_CLA) + (size_t)p * 4096 + (size_t)i * 64; float rsum = 0.f; const float mti = kind == 2 ? mt[i] : 0.f;
#pragma unroll
                    for (int g4 = 0; g4 < 4; ++g4) { float v[4];
#pragma unroll
                        for (int r = 0; r < 4; ++r) { const int j = 32 * mt_ + 8 * g4 + 4 * h + r; float e;
                            if (kind < 2) e = fast_exp(fminf(gi - gc[j], 0.f)); else e = fast_exp(gi - gc[j] + bt[j] - mti);
                            v[r] = (i >= j) ? acc[4 * g4 + r] * kscale * e : 0.f; rsum += v[r]; }
                        *(u32x2*)(AQ + 32 * mt_ + 8 * g4 + 4 * h) = (u32x2){pk2_sw(v[0], v[1]), pk2_sw(v[2], v[3])}; }
                    if (kind == 2) rsp[i * 4 + mt_ * 2 + h] = rsum;
                } else {
                    const float bi = bt[i];
#pragma unroll
                    for (int r = 0; r < 16; ++r) { const int j = 32 * mt_ + 8 * (r >> 2) + 4 * h + (r & 3);
                        const float av = (i > j) ? bi * acc[r] * fast_exp(fminf(gi - gc[j], 0.f)) : 0.f;
                        Am[i * 64 + j] = av; An[i * 72 + j] = (bf16_t)f2bf_sw(-av); }
                }
            }
        }
        __syncthreads();
        int lz2 = F.lane; LAUNDER(lz2); const int l15 = lz2 & 15, kg = lz2 >> 4; const bool isw = F.wave >= 4;
        float rhsv[4][2][4];
        {
            const int tz = F.wave * 64 + lz2; const int cq = tz & 127, q4 = tz >> 7; bf16_t* QD = (bf16_t*)(F.ws + WS_CLQ) + (size_t)p * 8192 + cq;
            for (int i = 16 * q4; i < 16 * q4 + 16; ++i) QD[i * 128] = (bf16_t)f2bf_sw(bf2f(*(const LAS bf16_t*)(IQ + swz256(i, cq >> 3) + 2 * (cq & 7))) * qs[i]);
            bf16_t* KT = (bf16_t*)(F.ws + WS_CLK) + (size_t)p * 8192 + (size_t)cq * 64;
            float ksum = 0.f;
            for (int j8 = 2 * q4; j8 < 2 * q4 + 2; ++j8) { float v[8];
#pragma unroll
                for (int r = 0; r < 8; ++r) { const int j = 8 * j8 + r; v[r] = bf2f(*(const LAS bf16_t*)(IK + swz256(j, cq >> 3) + 2 * (cq & 7))) * ks[j]; ksum += v[r]; }
                *(u32x4*)(KT + 8 * j8) = (u32x4){pk2_sw(v[0], v[1]), pk2_sw(v[2], v[3]), pk2_sw(v[4], v[5]), pk2_sw(v[6], v[7])}; }
            ksp[cq * 4 + q4] = ksum;
            if (kind == 2 && tz < 64) CS[64 + tz] = (rsp[tz * 4] + rsp[tz * 4 + 1]) + (rsp[tz * 4 + 2] + rsp[tz * 4 + 3]);
            if (kind == 0) { LAS unsigned char* IS = isw ? IK : IV;
#pragma unroll
                for (int bb = 0; bb < 4; ++bb)
#pragma unroll
                    for (int nt2 = 0; nt2 < 2; ++nt2)
#pragma unroll
                        for (int r = 0; r < 4; ++r) { const int i = 16 * bb + 4 * kg + r, cc = (32 * F.wave + 16 * nt2 + l15) & 127;
                            rhsv[bb][nt2][r] = bt[i] * bf2f(*(const LAS bf16_t*)(IS + swz256(i, cc >> 3) + 2 * (cc & 7))) * (isw ? qs[i] : 1.0f); } }
        }
        __syncthreads();
        if (p + F.G < nprob) { cl_dma(F, cl_decode(F, p + F.G, odd, nhh)); if (F.wave == 0) CL_GATES(p + F.G); }
        if (kind == 2 && F.tid < 128) CS[256 + F.tid] = (ksp[F.tid * 4] + ksp[F.tid * 4 + 1]) + (ksp[F.tid * 4 + 2] + ksp[F.tid * 4 + 3]);
        if (kind == 0) {
            const int pg = ((b * 4 + hh) * 2 + d) * NCH + n;
            bf16_t* U = (bf16_t*)(F.ws + WS_CLU) + (size_t)pg * 8192; bf16_t* W = (bf16_t*)(F.ws + WS_CLW) + (size_t)p * 8192;
#pragma unroll
            for (int bb = 0; bb < 4; ++bb) {
#pragma unroll
                for (int nt2 = 0; nt2 < 2; ++nt2) {
                    const int cidx = 32 * F.wave + 16 * nt2 + l15; f32x4 acc;
#pragma unroll
                    for (int r = 0; r < 4; ++r) acc[r] = rhsv[bb][nt2][r];
                    for (int k2 = 0; k2 < 2; ++k2) if (32 * k2 < 16 * bb) {
                        const bool in = 32 * k2 + 8 * kg + 8 <= 16 * bb;
                        bf16x8 a = *(const LAS bf16x8*)(An + (16 * bb + l15) * 72 + 32 * k2 + 8 * kg); if (!in) a = (bf16x8){0, 0, 0, 0, 0, 0, 0, 0};
                        const bf16x8 xb = *(const LAS bf16x8*)(XT + cidx * 72 + 32 * k2 + 8 * kg);
                        acc = mfma16(a, in ? xb : (bf16x8){0, 0, 0, 0, 0, 0, 0, 0}, acc); }
#pragma unroll
                    for (int r = 0; r < 4; ++r) Rb[(4 * kg + r) * 32 + 16 * nt2 + l15] = acc[r];
                }
                WAVE_LDS_SYNC();
                if (F.lane < 32) {
                    const int cidx = 32 * F.wave + F.lane; float x[16];
#pragma unroll
                    for (int i = 0; i < 16; ++i) { float r = Rb[i * 32 + F.lane];
#pragma unroll
                        for (int j = 0; j < i; ++j) r -= Am[(16 * bb + i) * 64 + 16 * bb + j] * x[j];
                        x[i] = r; }
                    if (!isw) {
#pragma unroll
                        for (int i = 0; i < 16; ++i) U[(16 * bb + i) * 128 + cidx] = (bf16_t)f2bf_sw(x[i]); }
                    else {
#pragma unroll
                        for (int i = 0; i < 16; ++i) W[(16 * bb + i) * 128 + (cidx - 128)] = (bf16_t)f2bf_sw(-x[i]); }
                    *(LAS u32x4*)(XT + cidx * 72 + 16 * bb) = (u32x4){pk2_sw(x[0], x[1]), pk2_sw(x[2], x[3]), pk2_sw(x[4], x[5]), pk2_sw(x[6], x[7])};
                    *(LAS u32x4*)(XT + cidx * 72 + 16 * bb + 8) = (u32x4){pk2_sw(x[8], x[9]), pk2_sw(x[10], x[11]), pk2_sw(x[12], x[13]), pk2_sw(x[14], x[15])};
                }
                WAVE_LDS_SYNC();
            }
        }
    }
    WAIT_VM(0);
    __syncthreads();
}

#define LDS_BARRIER() do { WAIT_LGKM(0); S_BARRIER(); COMPILER_FENCE(); } while (0)
constexpr int SQ_W = 0, SQ_Q = 16384, SQ_K = 32768, SQ_A = 49152, SQ_U = 57344, SQ_C = 65536, SQ_STAGE = 67584;
constexpr int SQ_SB = 2 * SQ_STAGE, SQ_VN = SQ_SB + 8704, SQ_NV = SQ_VN + 4608, SQ_DEN = SQ_NV + 512;
static_assert(SQ_DEN + 256 <= LDS_MISC, "SEQ LDS map");
struct SeqCtx { int kind, b, hh, d, sl, chain, vld; const GAS bf16_t* vsrc; int probe; };
template <int KIND>
DEV void seq_dma(const Frame& F, const SeqCtx& C, int n, LAS unsigned char* img) {
    const int p = C.chain * NCH + n, w = F.wave; int ln = F.lane; LAUNDER(ln);
    if (w < 2) {
        if (KIND == 0) { const GAS char* g = (const GAS char*)(F.ws + WS_CLW) + (size_t)p * 16384; LAUNDER_S(g);
#pragma unroll
            for (int i = 0; i < 8; ++i) { const int r = 4 * (8 * w + i) + (ln >> 4), pp = ln & 15; glds16(g + r * 256 + 16 * (pp ^ (r & 15)), img + SQ_W + 1024 * (8 * w + i)); } }
    } else if (w < 4) {
        const GAS char* g = (const GAS char*)(F.ws + WS_CLQ) + (size_t)p * 16384; LAUNDER_S(g);
#pragma unroll
        for (int i = 0; i < 8; ++i) { const int c = 8 * (w - 2) + i, r = 4 * c + (ln >> 4), pp = ln & 15; glds16(g + r * 256 + 16 * (pp ^ (r & 15)), img + SQ_Q + 1024 * c); }
    } else if (w < 6) {
        const GAS char* g = (const GAS char*)(F.ws + WS_CLK) + (size_t)p * 16384; LAUNDER_S(g);
#pragma unroll
        for (int i = 0; i < 8; ++i) { const int c = 8 * (w - 4) + i, r = 8 * c + (ln >> 3), pp = ln & 7; glds16(g + r * 128 + 16 * (pp ^ ((r >> 1) & 7)), img + SQ_K + 1024 * c); }
    } else if (w == 6) {
        const GAS char* g = (const GAS char*)(F.ws + WS_CLA) + (size_t)p * 8192; LAUNDER_S(g);
#pragma unroll
        for (int i = 0; i < 8; ++i) { const int r = 8 * i + (ln >> 3), pp = ln & 7; glds16(g + r * 128 + 16 * (pp ^ ((r >> 1) & 7)), img + SQ_A + 1024 * i); }
    } else {
        if (KIND == 0) { const int pg = ((C.b * 4 + C.hh) * 2 + C.d) * NCH + n; const GAS char* g = (const GAS char*)(F.ws + WS_CLU) + (size_t)pg * 16384 + 64 * C.sl; LAUNDER_S(g);
#pragma unroll
            for (int i = 0; i < 4; ++i) { const int r = 16 * i + (ln >> 2); glds16(g + r * 256 + 16 * (ln & 3), img + SQ_U + 1024 * i); }
        } else { const int r0 = tok_row(C.b, C.d, n * 64); const long st = C.d ? -(long)C.vld * 2 : (long)C.vld * 2;
            const GAS char* g = (const GAS char*)C.vsrc + (long)r0 * C.vld * 2 + 64 * C.sl; LAUNDER_S(g);
#pragma unroll
            for (int i = 0; i < 4; ++i) { const int r = 16 * i + (ln >> 2); glds16(g + (long)r * st + 16 * (ln & 3), img + SQ_U + 1024 * i); }
        }
        const GAS char* cs = (const GAS char*)(F.ws + WS_CLS) + (size_t)p * 2048; LAUNDER_S(cs);
        glds16(cs + 16 * ln, img + SQ_C);
        if (KIND == 2) glds16(cs + 1024 + 16 * ln, img + SQ_C + 1024);
    }
}
#define SEQ_WAIT_DMA(younger) do { if ((younger) == 16) WAIT_VM(16); else WAIT_VM(0); } while (0)
template <int KIND>
DEV void seq_step(const Frame& F, const SeqCtx& C, int n, f32x16& acc, LAS unsigned char* lds) {
    int lz = F.lane; LAUNDER(lz); const int h = lz >> 5, l31 = lz & 31;
    LAS unsigned char* img = lds + (n & 1) * SQ_STAGE; LAS unsigned char* nimg = lds + ((n + 1) & 1) * SQ_STAGE;
    LAS bf16_t* Sb = (LAS bf16_t*)(lds + SQ_SB); LAS bf16_t* Vn = (LAS bf16_t*)(lds + SQ_VN); LAS float* nvec = (LAS float*)(lds + SQ_NV); LAS float* den = (LAS float*)(lds + SQ_DEN);
    const LAS float* CS = (const LAS float*)(img + SQ_C);
    if (C.probe != 3) seq_dma<KIND>(F, C, C.probe == 2 ? 0 : (n + 1 < NCH ? n + 1 : NCH - 1), nimg);
    if (F.wave < 2) {
        const int mt_ = F.wave;
#pragma unroll
        for (int r = 0; r < 16; ++r) acc[r] = bf2f(*(const LAS bf16_t*)(img + SQ_U + (32 * mt_ + 8 * (r >> 2) + 4 * h + (r & 3)) * 64 + 2 * l31));
        if (KIND == 0) {
            bf16x8 sb[8], wf[8]; const int rr = 32 * mt_ + l31;
#pragma unroll
            for (int s = 0; s < 8; ++s) { sb[s] = *(const LAS bf16x8*)(Sb + l31 * 136 + 16 * s + 8 * h); wf[s] = *(const LAS bf16x8*)(img + SQ_W + swz256(rr, 2 * s + h)); }
#pragma unroll
            for (int s = 0; s < 8; ++s) acc = mfma32(wf[s], sb[s], acc);
        }
#pragma unroll
        for (int g4 = 0; g4 < 4; ++g4) *(LAS u32x2*)(Vn + l31 * 72 + 32 * mt_ + 8 * g4 + 4 * h) = (u32x2){pk2(acc[4 * g4], acc[4 * g4 + 1]), pk2(acc[4 * g4 + 2], acc[4 * g4 + 3])};
    } else if (F.wave < 4) {
        const int rr = 32 * (F.wave - 2) + l31;
#pragma unroll
        for (int r = 0; r < 16; ++r) acc[r] = 0.f;
        bf16x8 sb[8], qf[8];
#pragma unroll
        for (int s = 0; s < 8; ++s) { sb[s] = *(const LAS bf16x8*)(Sb + l31 * 136 + 16 * s + 8 * h); qf[s] = *(const LAS bf16x8*)(img + SQ_Q + swz256(rr, 2 * s + h)); }
#pragma unroll
        for (int s = 0; s < 8; ++s) acc = mfma32(qf[s], sb[s], acc);
    } else if (KIND == 2) {
        const int t = F.tid - 256, i = t >> 2, q = t & 3; float s = 0.f;
#pragma unroll
        for (int c8 = 0; c8 < 4; ++c8) { const u32x4 w = *(const LAS u32x4*)(img + SQ_Q + swz256(i, 4 * q + c8)); const LAS float* nv = nvec + 32 * q + 8 * c8;
            s += bflo(w.x) * nv[0] + bfhi(w.x) * nv[1] + bflo(w.y) * nv[2] + bfhi(w.y) * nv[3] + bflo(w.z) * nv[4] + bfhi(w.z) * nv[5] + bflo(w.w) * nv[6] + bfhi(w.w) * nv[7]; }
        s = group_sum<4>(s);
        if (q == 0) den[i] = fmaxf(fabsf(CS[64 + i] + s), CS[128 + i]);
    }
    LDS_BARRIER();
    if (F.wave >= 2 && F.wave < 4) {
        const int mt_ = F.wave - 2, rr = 32 * mt_ + l31;
        bf16x8 vb[4], af[4];
#pragma unroll
        for (int s = 0; s < 4; ++s) { vb[s] = *(const LAS bf16x8*)(Vn + l31 * 72 + 16 * s + 8 * h); af[s] = *(const LAS bf16x8*)(img + SQ_A + swz128(rr, 2 * s + h)); }
#pragma unroll
        for (int s = 0; s < 4; ++s) acc = mfma32(af[s], vb[s], acc);
        const int r0 = tok_row(C.b, C.d, n * 64); const long st = C.d ? -2048l : 2048l;
        GAS char* Ob = (GAS char*)(F.ws + WS_O) + ((size_t)C.d * MROWS + r0) * 2048 + (long)(32 * mt_) * st; LAUNDER_S(Ob); const long lo = (long)(4 * h) * st + (long)((C.hh * 128 + 32 * C.sl + l31) * 2);
#pragma unroll
        for (int r = 0; r < 16; ++r) { const int i = 32 * mt_ + 8 * (r >> 2) + 4 * h + (r & 3); float v = acc[r];
            if (KIND == 2) v = v / den[i];
            if (!C.probe) *(GAS bf16_t*)(Ob + (long)(8 * (r >> 2) + (r & 3)) * st + lo) = (bf16_t)f2bf(v); }
        SEQ_WAIT_DMA(16);
    } else if (F.wave >= 4) {
        const int kb = F.wave - 4, rr = 32 * kb + l31; const float ge = CS[0];
        bf16x8 vb[4], kf[4];
#pragma unroll
        for (int s = 0; s < 4; ++s) { vb[s] = *(const LAS bf16x8*)(Vn + l31 * 72 + 16 * s + 8 * h); kf[s] = *(const LAS bf16x8*)(img + SQ_K + swz128(rr, 2 * s + h)); }
#pragma unroll
        for (int r = 0; r < 16; ++r) acc[r] *= ge;
#pragma unroll
        for (int s = 0; s < 4; ++s) acc = mfma32(kf[s], vb[s], acc);
#pragma unroll
        for (int g4 = 0; g4 < 4; ++g4) *(LAS u32x2*)(Sb + l31 * 136 + 32 * kb + 8 * g4 + 4 * h) = (u32x2){pk2(acc[4 * g4], acc[4 * g4 + 1]), pk2(acc[4 * g4 + 2], acc[4 * g4 + 3])};
        if (KIND == 2 && F.tid < 256 + 128) { const int dd = F.tid - 256; nvec[dd] = ge * nvec[dd] + CS[256 + dd]; }
        SEQ_WAIT_DMA(0);
    } else SEQ_WAIT_DMA(0);
    LDS_BARRIER();
}
template <int KIND>
DEV void seq_kind_loop(const Frame& F, const SeqCtx& C, LAS unsigned char* lds) {
    f32x16 acc;
#pragma unroll
    for (int r = 0; r < 16; ++r) acc[r] = 0.f;
    seq_dma<KIND>(F, C, 0, lds);
    WAIT_VM(0);
    LDS_BARRIER();
    for (int n = 0; n < NCH; ++n) seq_step<KIND>(F, C, n, acc, lds);
}
DEV void seq_linear_item(const Frame& F, int l, int item, int probe = 0) {
    const int odd = l & 1, nhh = odd ? 4 : 8;
    SeqCtx C; C.probe = probe; C.sl = item & 3; C.chain = item >> 2; C.d = C.chain & 1; C.hh = (C.chain >> 1) % nhh; C.b = C.chain / (2 * nhh);
    C.kind = odd ? 2 : (C.hh < 4 ? 0 : 1);
    const GAS bf16_t* P = (const GAS bf16_t*)(F.ws + WS_P); const GAS bf16_t* Q = (const GAS bf16_t*)(F.ws + WS_QKV);
    if (C.kind == 0) { C.vsrc = Q + 1024 + C.hh * 128; C.vld = 1536; } else if (C.kind == 1) { C.vsrc = P + 3072 + (C.hh - 4) * 128; C.vld = NIN_E; } else { C.vsrc = P + 1024 + C.hh * 128; C.vld = NIN_O; }
    for (int i = F.tid; i < 32 * 136 / 2; i += NTHREADS) ((LAS unsigned*)(F.lds + SQ_SB))[i] = 0u;
    if (F.tid < 128) ((LAS float*)(F.lds + SQ_NV))[F.tid] = 0.f;
    __syncthreads();
    if (C.kind == 0) seq_kind_loop<0>(F, C, F.lds); else if (C.kind == 1) seq_kind_loop<1>(F, C, F.lds); else seq_kind_loop<2>(F, C, F.lds);
    WAIT_VM(0);
}

DEV void seq_s5_item(const Frame& F, int l, int item, int which) {
    const int o = l >> 1; const int g = item & 31, d = (item >> 5) & 1, b = item >> 6;
    LAS float* El = (LAS float*)(F.lds);
    LAS unsigned char* wl = F.lds + 36864 + F.wave * 14336;
    LAS float* scr = (LAS float*)wl; LAS bf16_t* hb = (LAS bf16_t*)(wl + 10240);
    const bf16_t* P = (const bf16_t*)(F.ws + WS_P);
    const float* Ab = (const float*)(F.ws + WS_S5A) + (size_t)((o * 2 + d) * 32 + g) * 128;
    const bf16_t* Bb = (const bf16_t*)(F.ws + WS_S5B) + (size_t)((o * 2 + d) * 32 + g) * 128 * 16;
    const bf16_t* Cm = (const bf16_t*)(F.ws + WS_S5C) + (size_t)(o * 32 + g) * 16 * 128;
    const int l15 = F.lane & 15, kg = F.lane >> 4;
    const float ar = Ab[F.lane], ai = Ab[64 + F.lane];
    bf16x8 bB[8], cB[4]; const bf16x8 zero8 = (bf16x8){0, 0, 0, 0, 0, 0, 0, 0};
#pragma unroll
    for (int ct = 0; ct < 8; ++ct) bB[ct] = kg < 2 ? *(const bf16x8*)(Bb + (size_t)(16 * ct + l15) * 16 + 8 * kg) : zero8;
#pragma unroll
    for (int s = 0; s < 4; ++s) cB[s] = *(const bf16x8*)(Cm + (size_t)l15 * 128 + 32 * s + 8 * kg);
    bf16_t* Obase = (bf16_t*)(F.ws + WS_O) + (size_t)d * MROWS * 1024 + 512 + 16 * g;
    float* SE = (float*)(F.ws + WS_S5E) + (size_t)item * NCH * 128;
    if (which == 1) { for (int i = F.tid; i < NCH * 128; i += NTHREADS) El[i] = SE[i]; __syncthreads(); }
    for (int pass = which; pass < which + 1; ++pass) {
        bf16x8 an[4];
#pragma unroll
        for (int st = 0; st < 4; ++st) an[st] = kg < 2 ? *(const bf16x8*)(P + (size_t)tok_row(b, d, F.wave * 64 + 16 * st + l15) * NIN_O + 2048 + 16 * g + 8 * kg) : zero8;
        for (int n = F.wave; n < NCH; n += NWAVES) {
            float hr = 0.f, hi = 0.f;
            if (pass) { hr = El[n * 128 + F.lane]; hi = El[n * 128 + 64 + F.lane]; }
            bf16x8 ac[4];
#pragma unroll
            for (int st = 0; st < 4; ++st) ac[st] = an[st];
            { const int nn = n + NWAVES < NCH ? n + NWAVES : n;
#pragma unroll
              for (int st = 0; st < 4; ++st) an[st] = kg < 2 ? *(const bf16x8*)(P + (size_t)tok_row(b, d, nn * 64 + 16 * st + l15) * NIN_O + 2048 + 16 * g + 8 * kg) : zero8; }
            const int r0 = tok_row(b, d, n * 64); const int sg = d ? -1 : 1;
#pragma unroll
            for (int st = 0; st < 4; ++st) {
#pragma unroll
                for (int ct = 0; ct < 8; ++ct) { f32x4 acc = (f32x4){0.f, 0.f, 0.f, 0.f}; acc = mfma16(ac[st], bB[ct], acc);
                    *(LAS f32x4*)(scr + (ct >> 2) * 1280 + (16 * (ct & 3) + l15) * 20 + 4 * kg) = acc; }
                WAVE_LDS_SYNC();
                f32x4 br[4], bi[4];
#pragma unroll
                for (int q = 0; q < 4; ++q) { br[q] = *(const LAS f32x4*)(scr + F.lane * 20 + 4 * q); bi[q] = *(const LAS f32x4*)(scr + 1280 + F.lane * 20 + 4 * q); }
#pragma unroll
                for (int t = 0; t < 16; ++t) { const float nr = ar * hr - ai * hi + br[t >> 2][t & 3], ni = ar * hi + ai * hr + bi[t >> 2][t & 3]; hr = nr; hi = ni;
                    if (pass) *(LAS unsigned*)(hb + t * 128 + 2 * F.lane) = pk2(hr, hi); }
                WAVE_LDS_SYNC();
                if (pass) { f32x4 acc = (f32x4){0.f, 0.f, 0.f, 0.f};
#pragma unroll
                    for (int s = 0; s < 4; ++s) { const bf16x8 ha = *(const LAS bf16x8*)(hb + l15 * 128 + 32 * s + 8 * kg); acc = mfma16(ha, cB[s], acc); }
#pragma unroll
                    for (int r = 0; r < 4; ++r) Obase[(size_t)(r0 + sg * (16 * st + 4 * kg + r)) * 1024 + l15] = (bf16_t)f2bf(acc[r]);
                    WAVE_LDS_SYNC(); }
            }
            if (!pass) { El[n * 128 + F.lane] = hr; El[n * 128 + 64 + F.lane] = hi; }
        }
        __syncthreads();
        if (!pass) {
            if (F.wave == 0) { float pr = ar, pi = ai;
#pragma unroll
                for (int q = 0; q < 6; ++q) { const float nr = pr * pr - pi * pi, ni = 2.0f * pr * pi; pr = nr; pi = ni; }
                float hr = 0.f, hi = 0.f;
                for (int n = 0; n < NCH; ++n) { const float er = El[n * 128 + F.lane], ei = El[n * 128 + 64 + F.lane];
                    El[n * 128 + F.lane] = hr; El[n * 128 + 64 + F.lane] = hi;
                    const float nr = pr * hr - pi * hi + er, ni = pr * hi + pi * hr + ei; hr = nr; hi = ni; } }
            __syncthreads();
            for (int i = F.tid; i < NCH * 128; i += NTHREADS) SE[i] = El[i];
        }
    }
}

DEV void phase_seq(const Frame& F0, int l, int mode = 0) {
    const Frame F = refresh(F0);
    const int odd = l & 1; const int nlin = B_ * (odd ? 4 : 8) * 2 * 4; const int ns5 = odd ? B_ * 2 * 32 : 0;
    const int vcu = (F.G % 8 == 0) ? (F.bid % 8) * (F.G / 8) + F.bid / 8 : F.bid;
    if (!odd || F.G <= nlin) {
        for (int it = vcu; it < nlin + ns5; it += F.G) {
            if (it < nlin) { if (mode != 2) seq_linear_item(F, l, it, mode >= 10 ? mode - 10 : 0); } else if (mode != 1 && mode < 10) seq_s5_item(F, l, it - nlin, 1);
            __syncthreads();
        }
    } else if (vcu < nlin) { if (mode != 2) seq_linear_item(F, l, vcu, mode >= 10 ? mode - 10 : 0); }
    else { for (int it = vcu - nlin; it < ns5; it += F.G - nlin) { if (mode != 1 && mode < 10) seq_s5_item(F, l, it, 1); __syncthreads(); } }
}

DEV void phase_merge(const Frame& F0, int l) {
    const Frame F = refresh(F0);
    const int odd = l & 1, li = l >> 1; const bf16_t* P = (const bf16_t*)(F.ws + WS_P);
    const bf16_t* O0 = (const bf16_t*)(F.ws + WS_O); const bf16_t* O1 = O0 + (size_t)MROWS * 1024;
    bf16_t* MG = (bf16_t*)(F.ws + WS_MERGED);
    const int nrows = (l == DEPTH - 1) ? LATR : MROWS;
    ROW_LOOP(r, nrows) {
        if (!odd) {
            const int c0 = 16 * F.lane; float v[16];
#pragma unroll
            for (int q = 0; q < 4; ++q) { const u32x2 a = *(const u32x2*)(O0 + (size_t)r * 1024 + c0 + 4 * q), bq = *(const u32x2*)(O1 + (size_t)r * 1024 + c0 + 4 * q);
                v[4 * q] = bflo(a.x) + bflo(bq.x); v[4 * q + 1] = bfhi(a.x) + bfhi(bq.x); v[4 * q + 2] = bflo(a.y) + bflo(bq.y); v[4 * q + 3] = bfhi(a.y) + bfhi(bq.y); }
            float s = 0.f;
#pragma unroll
            for (int i = 0; i < 16; ++i) s += v[i];
            s = group_sum<8>(s);
            const bool ret = F.lane >= 32; const float mu = ret ? s * (1.0f / 128.0f) : 0.f; float q2 = 0.f;
#pragma unroll
            for (int i = 0; i < 16; ++i) { v[i] -= mu; q2 += v[i] * v[i]; }
            q2 = group_sum<8>(q2);
            const float rstd = 1.0f / sqrtf(q2 * (1.0f / 128.0f) + LN_EPS);
            const bf16_t* zp = P + (size_t)r * NIN_E + (ret ? 3584 + (c0 - 512) : 1536 + c0);
            const float* gp = ret ? GIN(I_EVRETN) + li * 512 + (c0 - 512) : GIN(I_EVGDNN) + li * 128 + (c0 & 127);
            unsigned ow[8]; const u32x4 zq0 = *(const u32x4*)zp, zq1 = *(const u32x4*)(zp + 8); const unsigned zw[8] = {zq0.x, zq0.y, zq0.z, zq0.w, zq1.x, zq1.y, zq1.z, zq1.w};
            f32x4 gq[4];
#pragma unroll
            for (int i = 0; i < 4; ++i) gq[i] = *(const f32x4*)(gp + 4 * i);
#pragma unroll
            for (int i = 0; i < 16; i += 2) { const float z0 = bflo(zw[i >> 1]), z1 = bfhi(zw[i >> 1]); ow[i >> 1] = pk2(v[i] * rstd * gq[i >> 2][i & 3] * fast_silu(z0), v[i + 1] * rstd * gq[i >> 2][(i & 3) + 1] * fast_silu(z1)); }
            u32x4* op = (u32x4*)(MG + (size_t)r * 1024 + c0); op[0] = (u32x4){ow[0], ow[1], ow[2], ow[3]}; op[1] = (u32x4){ow[4], ow[5], ow[6], ow[7]};
        } else {
            const int c0 = 8 * F.lane; float v[8];
#pragma unroll
            for (int q = 0; q < 2; ++q) { const u32x2 a = *(const u32x2*)(O0 + (size_t)r * 1024 + c0 + 4 * q), bq = *(const u32x2*)(O1 + (size_t)r * 1024 + c0 + 4 * q);
                v[4 * q] = bflo(a.x) + bflo(bq.x); v[4 * q + 1] = bfhi(a.x) + bfhi(bq.x); v[4 * q + 2] = bflo(a.y) + bflo(bq.y); v[4 * q + 3] = bfhi(a.y) + bfhi(bq.y); }
            float s = 0.f;
#pragma unroll
            for (int i = 0; i < 8; ++i) s += v[i];
            s = group_sum<16>(s);
            const float mu = s * (1.0f / 128.0f); float q2 = 0.f;
#pragma unroll
            for (int i = 0; i < 8; ++i) { v[i] -= mu; q2 += v[i] * v[i]; }
            q2 = group_sum<16>(q2);
            const float rstd = 1.0f / sqrtf(q2 * (1.0f / 128.0f) + LN_EPS);
            const bf16_t* zp = P + (size_t)r * NIN_O + 1536 + c0; const float* gp = GIN(I_ODMN) + li * 512 + c0;
            unsigned ow[4]; const u32x4 zq = *(const u32x4*)zp; const unsigned zw[4] = {zq.x, zq.y, zq.z, zq.w}; const f32x4 gq0 = *(const f32x4*)gp, gq1 = *(const f32x4*)(gp + 4);
#pragma unroll
            for (int i = 0; i < 8; i += 2) { const f32x4 gq = i < 4 ? gq0 : gq1; ow[i >> 1] = pk2(v[i] * rstd * gq[i & 3] * fast_sigmoid(bflo(zw[i >> 1])), v[i + 1] * rstd * gq[(i & 3) + 1] * fast_sigmoid(bfhi(zw[i >> 1]))); }
            *(u32x4*)(MG + (size_t)r * 1024 + c0) = (u32x4){ow[0], ow[1], ow[2], ow[3]};
            const bf16_t* up = P + (size_t)r * NIN_O + 2048 + c0; const float* dsk = GIN(I_ODDSKIP) + li * 512 + c0;
#pragma unroll
            for (int q = 0; q < 2; ++q) { const u32x2 a = *(const u32x2*)(O0 + (size_t)r * 1024 + 512 + c0 + 4 * q), bq = *(const u32x2*)(O1 + (size_t)r * 1024 + 512 + c0 + 4 * q);
                v[4 * q] = bflo(a.x) + bflo(bq.x); v[4 * q + 1] = bfhi(a.x) + bfhi(bq.x); v[4 * q + 2] = bflo(a.y) + bflo(bq.y); v[4 * q + 3] = bfhi(a.y) + bfhi(bq.y); }
            { const u32x4 uq = *(const u32x4*)up; const unsigned uw[4] = {uq.x, uq.y, uq.z, uq.w}; const f32x4 d0 = *(const f32x4*)dsk, d1 = *(const f32x4*)(dsk + 4);
#pragma unroll
              for (int i = 0; i < 8; i += 2) { const f32x4 dq = i < 4 ? d0 : d1; ow[i >> 1] = pk2(gelu_tanh_f(v[i] + dq[i & 3] * bflo(uw[i >> 1])), gelu_tanh_f(v[i + 1] + dq[(i & 3) + 1] * bfhi(uw[i >> 1]))); } }
            *(u32x4*)((bf16_t*)(F.ws + WS_YS) + (size_t)r * 512 + c0) = (u32x4){ow[0], ow[1], ow[2], ow[3]};
        }
    }
}

template <int RG> DEV void ln_rows(const Frame& F, f32x4 (&t)[RG][4], const float* lg, const float* lb) {
    float mean[RG], rstd[RG];
#pragma unroll
    for (int q = 0; q < RG; ++q) { float sum = 0.f;
#pragma unroll
        for (int j = 0; j < 4; ++j) sum += (t[q][j].x + t[q][j].y) + (t[q][j].z + t[q][j].w);
        mean[q] = wave_sum(sum) * (1.0f / 1024.0f); }
#pragma unroll
    for (int q = 0; q < RG; ++q) { float s2 = 0.f;
#pragma unroll
        for (int j = 0; j < 4; ++j) { t[q][j] = t[q][j] - mean[q]; s2 += (t[q][j].x * t[q][j].x + t[q][j].y * t[q][j].y) + (t[q][j].z * t[q][j].z + t[q][j].w * t[q][j].w); }
        rstd[q] = 1.0f / sqrtf(wave_sum(s2) * (1.0f / 1024.0f) + LN_EPS); }
#pragma unroll
    for (int j = 0; j < 4; ++j) { const f32x4 gg = *((const f32x4*)lg + F.lane + 64 * j), bb = *((const f32x4*)lb + F.lane + 64 * j);
#pragma unroll
        for (int q = 0; q < RG; ++q) t[q][j] = t[q][j] * rstd[q] * gg + bb; }
}
template <int RG> DEV void ln1_group(const Frame& F, int l, int r) {

    const bf16_t* Y = (const bf16_t*)(F.ws + WS_Y); float* H = (float*)(F.ws + WS_H);
    const float* lg = GIN(I_LN1G) + l * 1024; const float* lb = GIN(I_LN1B) + l * 1024; const float* wr = (const float*)(F.ws + WS_WR) + (size_t)l * NE * 1024;
    {
        int b, s; row_bs(r, b, s); const int mr = s < CTX ? B_ : b; const float* mod = (const float*)(F.ws + WS_MOD) + ((size_t)l * NR + mr) * 6144;
        f32x4 t[RG][4];
#pragma unroll
        for (int j = 0; j < 4; ++j) { const f32x4 g1 = *((const f32x4*)(mod + 2048) + F.lane + 64 * j);
#pragma unroll
            for (int q = 0; q < RG; ++q) { const f32x4 hv = *((const f32x4*)HROW(F, l, r + q) + F.lane + 64 * j); const u32x2 yw = *((const u32x2*)(Y + (size_t)(r + q) * 1024) + F.lane + 64 * j); const f32x4 yv = (f32x4){bflo(yw.x), bfhi(yw.x), bflo(yw.y), bfhi(yw.y)}; t[q][j] = ALPHA * hv + g1 * yv; }
            if (j & 1) COMPILER_FENCE(); }
        ln_rows<RG>(F, t, lg, lb);
        COMPILER_FENCE();
#pragma unroll
        for (int j = 0; j < 4; ++j) { const f32x4 sh = *((const f32x4*)(mod + 3072) + F.lane + 64 * j), scv = *((const f32x4*)(mod + 4096) + F.lane + 64 * j);
#pragma unroll
            for (int q = 0; q < RG; ++q) { *((f32x4*)(H + (size_t)(r + q) * 1024) + F.lane + 64 * j) = t[q][j]; t[q][j] = t[q][j] * (1.0f + scv) + sh; } }
        COMPILER_FENCE();
#pragma unroll
        for (int q = 0; q < RG; ++q) { u32x2* xo = (u32x2*)((bf16_t*)(F.ws + WS_XIN) + (size_t)(r + q) * 1024) + F.lane;
#pragma unroll
            for (int j = 0; j < 4; ++j) xo[64 * j] = (u32x2){pk2(t[q][j].x, t[q][j].y), pk2(t[q][j].z, t[q][j].w)}; }
        float mine[RG]; const int ei = F.lane % NE;
#pragma unroll
        for (int q = 0; q < RG; ++q) mine[q] = 0.f;
        f32x4 wc[4];
#pragma unroll
        for (int j = 0; j < 4; ++j) wc[j] = *((const f32x4*)wr + F.lane + 64 * j);
#pragma unroll 1
        for (int e = 0; e < NE; ++e) { f32x4 wn[4]; const int en = e + 1 < NE ? e + 1 : e;
#pragma unroll
            for (int j = 0; j < 4; ++j) wn[j] = *((const f32x4*)(wr + en * 1024) + F.lane + 64 * j);
#pragma unroll
            for (int q = 0; q < RG; ++q) { float p = 0.f;
#pragma unroll
                for (int j = 0; j < 4; ++j) p += t[q][j].x * wc[j].x + t[q][j].y * wc[j].y + t[q][j].z * wc[j].z + t[q][j].w * wc[j].w;
                const float ws_ = wave_sum(p); mine[q] = (ei == e) ? ws_ : mine[q]; }
#pragma unroll
            for (int j = 0; j < 4; ++j) wc[j] = wn[j]; }
#pragma unroll
        for (int q = 0; q < RG; ++q) { const float mx = group_max<NE>(mine[q]); const float ex = expf(mine[q] - mx); const float se = group_sum<NE>(ex);
            if (F.lane < NE) ((float*)(F.ws + WS_AFF))[(size_t)(r + q) * 16 + F.lane] = ex / se; }
    }
}
DEV void phase_ln1(const Frame& F0, int l) {
    const Frame F = refresh(F0);
    const int nrows = (l == DEPTH - 1) ? LATR : MROWS;
    ROW_GROUPS(nrows, ln1_group<4>(F, l, r), ln1_group<2>(F, l, r));
}

DEV void phase_topk(const Frame& F0, int l) {
    const Frame F = refresh(F0);
    const int nitems = (l == DEPTH - 1) ? B_ * NE : 2 * B_ * NE;
    LAS unsigned* hist = (LAS unsigned*)(F.lds);
    LAS unsigned* selw = (LAS unsigned*)(F.lds + 1024);
    LAS unsigned* cnt = (LAS unsigned*)(F.lds + 2048);
    LAS int* selrow = (LAS int*)(F.lds + 8192);
    const float* AFF = (const float*)(F.ws + WS_AFF); int* SLOT = (int*)(F.ws + WS_SLOT); float* EG = (float*)(F.ws + WS_EGATE);
    for (int it = F.bid; it < nitems; it += F.G) {
        const int e = it % NE, set = it / NE, kind = set / B_, b = set % B_;
        const int n = kind ? CTX : SEQ, cap = kind ? CAPC : CAPL; const int row0 = kind ? LATR + b * CTX : b * SEQ;
        const int sbase = kind ? B_ * CAPL + b * CAPC : b * CAPL;
        const int per = n >= NTHREADS ? n / NTHREADS : 1; const bool act = F.tid * per < n;
        unsigned key[8];
#pragma unroll
        for (int k = 0; k < 8; ++k) key[k] = (act && k < per) ? __builtin_bit_cast(unsigned, AFF[(size_t)(row0 + F.tid * per + k) * 16 + e]) : 0u;
        unsigned prefix = 0u, remaining = (unsigned)cap;
        for (int pass = 0; pass < 4; ++pass) {
            const int shift = 24 - 8 * pass; const unsigned mask = pass == 0 ? 0u : (0xFFFFFFFFu << (shift + 8));
            if (F.tid < 256) hist[F.tid] = 0u;
            __syncthreads();
#pragma unroll
            for (int k = 0; k < 8; ++k) if (act && k < per && ((key[k] & mask) == (prefix & mask))) lds_atomic_add(&hist[(key[k] >> shift) & 255u], 1u);
            __syncthreads();
            if (F.wave == 0) {
                const unsigned h0 = hist[4 * F.lane], h1 = hist[4 * F.lane + 1], h2 = hist[4 * F.lane + 2], h3 = hist[4 * F.lane + 3];
                unsigned suf = h0 + h1 + h2 + h3;
#pragma unroll
                for (int o = 1; o < 64; o <<= 1) { const unsigned tv = shfl_t(suf, F.lane + o); if (F.lane + o < 64) suf += tv; }
                unsigned cum = suf - (h0 + h1 + h2 + h3);
                int dsel = -1; unsigned above = 0u;
                if (cum < remaining) {
                    if (cum + h3 >= remaining) { dsel = 4 * F.lane + 3; above = cum; }
                    else if (cum + h3 + h2 >= remaining) { dsel = 4 * F.lane + 2; above = cum + h3; }
                    else if (cum + h3 + h2 + h1 >= remaining) { dsel = 4 * F.lane + 1; above = cum + h3 + h2; }
                    else if (cum + h3 + h2 + h1 + h0 >= remaining) { dsel = 4 * F.lane; above = cum + h3 + h2 + h1; }
                }
                if (dsel >= 0) { selw[0] = prefix | ((unsigned)dsel << shift); selw[1] = remaining - above; }
            }
            __syncthreads();
            prefix = selw[0]; remaining = selw[1];
            __syncthreads();
        }
        const unsigned T = prefix, need_eq = remaining;
        unsigned ngt = 0u, neq = 0u;
#pragma unroll
        for (int k = 0; k < 8; ++k) if (act && k < per) { ngt += key[k] > T ? 1u : 0u; neq += key[k] == T ? 1u : 0u; }
        unsigned pk = (ngt << 16) | neq;
#pragma unroll
        for (int o = 1; o < 64; o <<= 1) { const unsigned tv = shfl_t(pk, F.lane - o); if (F.lane >= o) pk += tv; }
        if (F.lane == 63) cnt[F.wave] = pk;
        __syncthreads();
        unsigned base = 0u;
#pragma unroll
        for (int w8 = 0; w8 < NWAVES; ++w8) base += (w8 < F.wave) ? cnt[w8] : 0u;
        const unsigned excl = base + pk - ((ngt << 16) | neq);
        unsigned gtb = excl >> 16, eqb = excl & 0xffffu;
#pragma unroll
        for (int k = 0; k < 8; ++k) if (act && k < per) {
            const int row = row0 + F.tid * per + k; int slot = -1;
            const bool isgt = key[k] > T, iseq = key[k] == T;
            if (isgt || (iseq && eqb < need_eq)) { slot = (int)(gtb + (eqb < need_eq ? eqb : need_eq)); selrow[slot] = row; EG[(size_t)e * EPAD + sbase + slot] = __builtin_bit_cast(float, key[k]); }
            SLOT[(size_t)row * 16 + e] = slot >= 0 ? sbase + slot : -1;
            gtb += isgt ? 1u : 0u; eqb += iseq ? 1u : 0u;
        }
        __syncthreads();
        for (int sl = F.tid; sl < cap; sl += NTHREADS) ((int*)(F.ws + WS_EIDX))[(size_t)e * EPAD + sbase + sl] = selrow[sl];
        if (it < NE) for (int pr = EROWS + F.tid; pr < EPAD; pr += NTHREADS) { EG[(size_t)e * EPAD + pr] = 0.f; ((int*)(F.ws + WS_EIDX))[(size_t)e * EPAD + pr] = ZROW; }
        __syncthreads();
    }
}

DEV void phase_gather(const Frame& F0, int l) {
    const Frame F = refresh(F0);
    const int erows = (l == DEPTH - 1) ? B_ * CAPL : EROWS;
    const int* EI = (const int*)(F.ws + WS_EIDX);
    for (int r0 = 4 * F.gw; r0 < NE * EPAD; r0 += 4 * F.NGW) {
        u32x4 v[4][2];
#pragma unroll
        for (int q = 0; q < 4; ++q) { const int r = r0 + q, sl = r % EPAD; v[q][0] = (u32x4){0u, 0u, 0u, 0u}; v[q][1] = v[q][0];
            if (sl < erows) { const u32x4* src = (const u32x4*)((const bf16_t*)(F.ws + WS_XIN) + (size_t)EI[r] * 1024) + F.lane; v[q][0] = src[0]; v[q][1] = src[64]; } }
#pragma unroll
        for (int q = 0; q < 4; ++q) { u32x4* dst = (u32x4*)((bf16_t*)(F.ws + WS_XS) + (size_t)(r0 + q) * 1024) + F.lane; dst[0] = v[q][0]; dst[64] = v[q][1]; }
    }
}

template <int RG> DEV void ln2_group(const Frame& F, int l, int r) {

    float* H = (float*)(F.ws + WS_H); const int* SLOT = (const int*)(F.ws + WS_SLOT); const bf16_t* YSE = (const bf16_t*)(F.ws + WS_YSE);
    const float* lg = GIN(I_LN2G) + l * 1024; const float* lb = GIN(I_LN2B) + l * 1024;
    {
        int b, s; row_bs(r, b, s); const int mr = s < CTX ? B_ : b; const float* mod = (const float*)(F.ws + WS_MOD) + ((size_t)l * NR + mr) * 6144;
        f32x4 t[RG][4];
#pragma unroll
        for (int q = 0; q < RG; ++q) {
#pragma unroll
            for (int j = 0; j < 4; ++j) t[q][j] = (f32x4){0.f, 0.f, 0.f, 0.f}; }
        const int myslot = F.lane < RG * 16 ? SLOT[(size_t)r * 16 + F.lane] : -1;
#pragma unroll
        for (int q = 0; q < RG; ++q)
#pragma unroll
            for (int e = 0; e < NE; ++e) { const int sl = bcast_lane(myslot, 16 * q + e);
                if (sl >= 0) { const u32x2* yp = (const u32x2*)(YSE + ((size_t)e * EPAD + sl) * 1024) + F.lane;
#pragma unroll
                    for (int j = 0; j < 4; ++j) { const u32x2 w = yp[64 * j]; t[q][j] += (f32x4){bflo(w.x), bfhi(w.x), bflo(w.y), bfhi(w.y)}; } } }
#pragma unroll
        for (int j = 0; j < 4; ++j) { const f32x4 g2 = *((const f32x4*)(mod + 5120) + F.lane + 64 * j);
#pragma unroll
            for (int q = 0; q < RG; ++q) { const f32x4 hv = *((const f32x4*)(H + (size_t)(r + q) * 1024) + F.lane + 64 * j); t[q][j] = ALPHA * hv + g2 * t[q][j]; } }
        ln_rows<RG>(F, t, lg, lb);
        if (l == DEPTH - 1) {
            {
#pragma unroll
                for (int q = 0; q < RG; ++q) { GAS f32x4* op = (GAS f32x4*)(F.out + (size_t)(r + q) * 1024) + F.lane;
#pragma unroll
                    for (int j = 0; j < 4; ++j) op[64 * j] = t[q][j]; } }
        } else {
#pragma unroll
            for (int q = 0; q < RG; ++q)
#pragma unroll
                for (int j = 0; j < 4; ++j) *((f32x4*)(H + (size_t)(r + q) * 1024) + F.lane + 64 * j) = t[q][j];
            xg_rows<RG>(F, l + 1, r, t);
        }
    }
}
DEV void phase_ln2(const Frame& F0, int l) {
    const Frame F = refresh(F0);
    const int nrows = (l == DEPTH - 1) ? LATR : MROWS;
    ROW_GROUPS(nrows, ln2_group<4>(F, l, r), ln2_group<2>(F, l, r));
}

struct EpiP {
    static constexpr bool PERM = true;
    bf16_t* O; int ldc;
    DEV void operator()(const f32x4 (&acc)[2][2][4][2], const pg8::Unit& u, int wr, int wc, int fr, int fq) const {
        const int row0 = u.pm * 256 + wr * 64 + fr, col0 = u.pn * 256 + wc * 32 + 8 * fq;
#pragma unroll
        for (int ai = 0; ai < 2; ++ai)
#pragma unroll
            for (int m = 0; m < 4; ++m) { bf16_t* rowp = O + (size_t)(row0 + ai * 128 + m * 16) * ldc + col0;
#pragma unroll
                for (int bj = 0; bj < 2; ++bj) { const f32x4 v0 = acc[ai][bj][m][0], v1 = acc[ai][bj][m][1];
                    u32x4 w; w.x = pg8::cvt_pk_bf16(v0[0], v0[1]); w.y = pg8::cvt_pk_bf16(v0[2], v0[3]); w.z = pg8::cvt_pk_bf16(v1[0], v1[1]); w.w = pg8::cvt_pk_bf16(v1[2], v1[3]);
                    *(u32x4*)(rowp + bj * 128) = w; } }
    }
};
struct EpiGlu {
    static constexpr bool PERM = true;
    bf16_t* MG; const bf16_t* YS; const float* bias;
    DEV void operator()(const f32x4 (&acc)[2][2][4][2], const pg8::Unit& u, int wr, int wc, int fr, int fq) const {
        const int row0 = u.pm * 256 + wr * 64 + fr, col0 = u.pn * 256 + wc * 32 + 8 * fq;
#pragma unroll
        for (int ai = 0; ai < 2; ++ai)
#pragma unroll
            for (int m = 0; m < 4; ++m) { const int row = row0 + ai * 128 + m * 16;
#pragma unroll
                for (int bj = 0; bj < 2; ++bj) { const int c = col0 + bj * 128; const f32x4 v0 = acc[ai][bj][m][0], v1 = acc[ai][bj][m][1];
                    const u32x4 yv = *(const u32x4*)(YS + (size_t)row * 512 + c); const f32x4 b0 = *(const f32x4*)(bias + c), b1 = *(const f32x4*)(bias + c + 4);
                    u32x4 w; w.x = pk2(bflo(yv.x) * fast_sigmoid(v0[0] + b0[0]), bfhi(yv.x) * fast_sigmoid(v0[1] + b0[1])); w.y = pk2(bflo(yv.y) * fast_sigmoid(v0[2] + b0[2]), bfhi(yv.y) * fast_sigmoid(v0[3] + b0[3]));
                    w.z = pk2(bflo(yv.z) * fast_sigmoid(v1[0] + b1[0]), bfhi(yv.z) * fast_sigmoid(v1[1] + b1[1])); w.w = pk2(bflo(yv.w) * fast_sigmoid(v1[2] + b1[2]), bfhi(yv.w) * fast_sigmoid(v1[3] + b1[3]));
                    *(u32x4*)(MG + (size_t)row * 1024 + 512 + c) = w; } }
    }
};
struct EpiF32 {
    static constexpr bool PERM = false;
    float* C; int ldc; const float* rowscale;
    DEV void operator()(const f32x4 (&acc)[2][2][4][2], const pg8::Unit& u, int wr, int wc, int fr, int fq) const {
        const int row0 = u.pm * 256 + wr * 64 + fr, col0 = u.pn * 256 + wc * 32 + 4 * fq;
        const size_t ebase = rowscale ? (size_t)u.e * EPAD : 0;
#pragma unroll
        for (int ai = 0; ai < 2; ++ai)
#pragma unroll
            for (int m = 0; m < 4; ++m) { const size_t row = ebase + row0 + ai * 128 + m * 16; const float sc = rowscale ? rowscale[row] : 1.0f; float* rowp = C + row * ldc + col0;
#pragma unroll
                for (int bj = 0; bj < 2; ++bj)
#pragma unroll
                    for (int n = 0; n < 2; ++n) *(f32x4*)(rowp + bj * 128 + n * 16) = acc[ai][bj][m][n] * sc; }
    }
};
struct EpiYse {
    static constexpr bool PERM = true;
    bf16_t* O; const float* rowscale;
    DEV void operator()(const f32x4 (&acc)[2][2][4][2], const pg8::Unit& u, int wr, int wc, int fr, int fq) const {
        const int row0 = u.pm * 256 + wr * 64 + fr, col0 = u.pn * 256 + wc * 32 + 8 * fq; const size_t ebase = (size_t)u.e * EPAD;
#pragma unroll
        for (int ai = 0; ai < 2; ++ai)
#pragma unroll
            for (int m = 0; m < 4; ++m) { const size_t row = ebase + row0 + ai * 128 + m * 16; const float sc = rowscale[row]; bf16_t* rowp = O + row * 1024 + col0;
#pragma unroll
                for (int bj = 0; bj < 2; ++bj) { const f32x4 v0 = acc[ai][bj][m][0] * sc, v1 = acc[ai][bj][m][1] * sc;
                    u32x4 w; w.x = pg8::cvt_pk_bf16(v0[0], v0[1]); w.y = pg8::cvt_pk_bf16(v0[2], v0[3]); w.z = pg8::cvt_pk_bf16(v1[0], v1[1]); w.w = pg8::cvt_pk_bf16(v1[2], v1[3]);
                    *(u32x4*)(rowp + bj * 128) = w; } }
    }
};
struct EpiSwiglu {
    static constexpr bool PERM = true;
    bf16_t* HID;
    DEV void operator()(const f32x4 (&acc)[2][2][4][2], const pg8::Unit& u, int wr, int wc, int fr, int fq) const {
        const int row0 = u.pm * 256 + wr * 64 + fr, col0 = u.pn * 128 + wc * 32 + 8 * fq;
#pragma unroll
        for (int ai = 0; ai < 2; ++ai)
#pragma unroll
            for (int m = 0; m < 4; ++m) { bf16_t* rowp = HID + ((size_t)u.e * EPAD + row0 + ai * 128 + m * 16) * FF + col0;
                const f32x4 g0 = acc[ai][0][m][0], g1 = acc[ai][0][m][1], u0 = acc[ai][1][m][0], u1 = acc[ai][1][m][1];
                u32x4 w; w.x = pk2(fast_silu(g0[0]) * u0[0], fast_silu(g0[1]) * u0[1]); w.y = pk2(fast_silu(g0[2]) * u0[2], fast_silu(g0[3]) * u0[3]);
                w.z = pk2(fast_silu(g1[0]) * u1[0], fast_silu(g1[1]) * u1[1]); w.w = pk2(fast_silu(g1[2]) * u1[2], fast_silu(g1[3]) * u1[3]);
                *(u32x4*)rowp = w; }
    }
};

DEV void gemm_g1(const Frame& F0, int l, int vcu) {
    const Frame F = refresh(F0);
    const int nin = (l & 1) ? NIN_O : NIN_E;
    pg8::PlainOrder S; S.init((const void*)(F.ws + WS_XIN), (const bf16_t*)(F.ws + WS_WIN) + (size_t)l * NINMAX * 1024, 1024, MPAD, nin, F.G, vcu);
    EpiP E; E.O = (bf16_t*)(F.ws + WS_P); E.ldc = nin;
    pg8::gemm_phase(F.lds, 1024, S, E, F.wave, F.lane);
}
DEV void gemm_glu(const Frame& F0, int l, int vcu) {
    const Frame F = refresh(F0);
    const int li = l >> 1;
    pg8::PlainOrder S; S.init((const void*)(F.ws + WS_YS), (const bf16_t*)(F.ws + WS_WGLU) + (size_t)li * 512 * 512, 512, (l == DEPTH - 1) ? LATPAD : MPAD, 512, F.G, vcu);
    EpiGlu E; E.MG = (bf16_t*)(F.ws + WS_MERGED); E.YS = (const bf16_t*)(F.ws + WS_YS); E.bias = GIN(I_ODBGLU) + li * 512;
    pg8::gemm_phase(F.lds, 512, S, E, F.wave, F.lane);
}
DEV void gemm_g3(const Frame& F0, int l, int vcu) {
    const Frame F = refresh(F0);
    pg8::PlainOrder S; S.init((const void*)(F.ws + WS_MERGED), (const bf16_t*)(F.ws + WS_WOUT) + (size_t)l * 1024 * 1024, 1024, (l == DEPTH - 1) ? LATPAD : MPAD, 1024, F.G, vcu);
    EpiP E; E.O = (bf16_t*)(F.ws + WS_Y); E.ldc = 1024;
    pg8::gemm_phase(F.lds, 1024, S, E, F.wave, F.lane);
}
DEV void gemm_g4(const Frame& F0, int l, int vcu) {
    const Frame F = refresh(F0);
    pg8::GatherOrder S; S.init((const void*)(F.ws + WS_XIN), (const bf16_t*)(F.ws + WS_WGU) + (size_t)l * NE * 2 * FF * 1024, 1024, 2 * FF, F.G, vcu, (l == DEPTH - 1) ? B_ * CAPL : EROWS); S.gidx = (const int*)(F.ws + WS_EIDX);
    EpiSwiglu E; E.HID = (bf16_t*)(F.ws + WS_HID);
    pg8::gemm_phase(F.lds, 1024, S, E, F.wave, F.lane);
}
DEV void gemm_g5(const Frame& F0, int l, int vcu) {
    const Frame F = refresh(F0);
    pg8::GroupedOrder S; S.init((const void*)(F.ws + WS_HID), (const bf16_t*)(F.ws + WS_WD) + (size_t)l * NE * 1024 * FF, FF, 1024, F.G, vcu, (l == DEPTH - 1) ? B_ * CAPL : EROWS);
    EpiYse E; E.O = (bf16_t*)(F.ws + WS_YSE); E.rowscale = (const float*)(F.ws + WS_EGATE);
    pg8::gemm_phase(F.lds, FF, S, E, F.wave, F.lane);
}

__global__ void __launch_bounds__(NTHREADS, 2) mega_fwd(Args args) {
#ifdef EMU
    LAS unsigned char* lds = emu::lds();
#else
    extern __shared__ __attribute__((aligned(16))) unsigned char lds_raw[];
    LAS unsigned char* lds = (LAS unsigned char*)lds_raw;
#endif
    Frame F;
    F.in = args.in; F.out = (GAS float*)args.out; F.ws = (GAS unsigned char*)args.ws; F.lds = lds;
    F.tid = threadIdx.x; F.lane = F.tid & 63; F.wave = readfirstlane_i(F.tid >> 6); F.G = gridDim.x; F.bid = blockIdx.x;
    F.gw = F.bid * NWAVES + F.wave; F.NGW = F.G * NWAVES;
    for (int u = F.tid; u < (LDS_BYTES - LDS_MISC) / 4; u += NTHREADS) ((LAS unsigned*)(lds + LDS_MISC))[u] = 0u;
    __syncthreads();
    XcdBarrier bar = xcd_barrier_post((unsigned*)(F.ws + WS_CTL), (volatile LAS unsigned*)(lds + LDS_MISC), F.wave);
#define GRID_BAR() xcd_barrier(bar)
    const int vcu = (F.G % 8 == 0) ? (F.bid % 8) * (F.G / 8) + F.bid / 8 : F.bid;

#ifndef PHASE_MASK
#define PHASE_MASK 0xFFFFF
#endif
#ifndef REPEAT_MASK
#define REPEAT_MASK 0x0
#endif
#ifndef TIMING_PROBE
#define TIMING_PROBE -1
#endif
    unsigned long long pt_acc = 0ull, pt_t0 = 0ull;
#define PT(k) do { if (TIMING_PROBE == (k)) pt_t0 = rt_now(); } while (0)
#define PTE(k) do { if (TIMING_PROBE == (k)) pt_acc += rt_now() - pt_t0; } while (0)
#define PH(k) if ((PHASE_MASK >> (k)) & 1)
#define RP(k) if ((REPEAT_MASK >> (k)) & 1)
    PT(0); PH(0) phase_prologue_a(F);
    RP(0) { GRID_BAR(); phase_prologue_a(F); }
    GRID_BAR(); PTE(0);
    PT(1); PH(1) phase_xg0(F);
    GRID_BAR(); PTE(1);
    for (int l = 0; l < DEPTH; ++l) {
        const int odd = l & 1;
        PT(2); PH(2) gemm_g1(F, l, F.bid);
        RP(2) { GRID_BAR(); gemm_g1(F, l, F.bid); }
        GRID_BAR(); PTE(2);
        PT(3); PH(3) phase_prep(F, l);
        RP(3) { GRID_BAR(); phase_prep(F, l); }
        GRID_BAR(); PTE(3);
        PT(4); PH(4) phase_cl(F, l);
        RP(4) { GRID_BAR(); phase_cl(F, l); }
        GRID_BAR(); PTE(4);
        PT(5); PH(5) phase_seq(F, l);
        RP(5) { GRID_BAR(); phase_seq(F, l); }
        GRID_BAR(); PTE(5);
#ifdef SEQ_XPROBE
        if ((l & 1) == SEQ_XPARITY) { PT(20); phase_seq(F, l, 10 + SEQ_XPROBE); GRID_BAR(); PTE(20); }
#endif
        PT(6); PH(6) phase_merge(F, l);
        RP(6) { GRID_BAR(); phase_merge(F, l); }
        GRID_BAR(); PTE(6);
        if (odd) { PT(7); PH(7) gemm_glu(F, l, F.bid); RP(7) { GRID_BAR(); gemm_glu(F, l, F.bid); } GRID_BAR(); PTE(7); }
        PT(8); PH(8) gemm_g3(F, l, F.bid);
        RP(8) { GRID_BAR(); gemm_g3(F, l, F.bid); }
        GRID_BAR(); PTE(8);
        PT(9); PH(9) phase_ln1(F, l);
        GRID_BAR(); PTE(9);
        PT(10); PH(10) phase_topk(F, l);
        RP(10) { GRID_BAR(); phase_topk(F, l); }
        GRID_BAR(); PTE(10);
        PT(11); PH(11) gemm_g4(F, l, F.bid);
        RP(11) { GRID_BAR(); gemm_g4(F, l, F.bid); }
        GRID_BAR(); PTE(11);
        PT(12); PH(12) gemm_g5(F, l, F.bid);
        RP(12) { GRID_BAR(); gemm_g5(F, l, F.bid); }
        GRID_BAR(); PTE(12);
        PT(13); PH(13) phase_ln2(F, l);
        if (l + 1 < DEPTH || TIMING_PROBE >= 0) GRID_BAR();
        PTE(13);
    }
    if (TIMING_PROBE >= 0 && F.bid == 0) { const unsigned long long t1 = rt_now() + pt_acc; while (rt_now() < t1) s_sleep1(); }
}

#ifndef EMU
extern "C" void kernel_launch(void* const* d_in, const int* in_sizes, int n_in, void* d_out, int out_size, void* d_ws, size_t ws_size, hipStream_t stream) {
    static int grid = 0;
    if (grid == 0) {
        if (n_in != N_IN || ws_size < WS_END) { fprintf(stderr, "kernel_launch: need %d inputs and %zu bytes of workspace; got %d, %zu\n", (int)N_IN, (size_t)WS_END, n_in, ws_size); grid = -1; return; }
        int dev = 0, cus = 0, per_cu = 0;
        if (hipGetDevice(&dev) != hipSuccess || hipDeviceGetAttribute(&cus, hipDeviceAttributeMultiprocessorCount, dev) != hipSuccess) { grid = -1; return; }
        if (hipFuncSetAttribute((const void*)mega_fwd, hipFuncAttributeMaxDynamicSharedMemorySize, LDS_BYTES) != hipSuccess) { fprintf(stderr, "kernel_launch: hipFuncSetAttribute failed\n"); grid = -1; return; }
        if (hipOccupancyMaxActiveBlocksPerMultiprocessor(&per_cu, (const void*)mega_fwd, NTHREADS, LDS_BYTES) != hipSuccess || per_cu < 1) { fprintf(stderr, "kernel_launch: occupancy query says %d\n", per_cu); }
        (void)hipGetLastError();
        grid = cus;
    }
    if (grid < 0) return;
    (void)hipMemsetAsync((char*)d_ws + WS_CTL, 0, CTL_BYTES, stream);
    Args a{};
    for (int i = 0; i < N_IN; ++i) a.in[i] = (const float*)d_in[i];
    a.out = (float*)d_out; a.ws = (unsigned char*)d_ws;
    hipLaunchKernelGGL(mega_fwd, dim3(grid), dim3(NTHREADS), LDS_BYTES, stream, a);
}
#endif
```
